# Optimizing an MI355X kernel written in HIP

```python
import math
import jax, jax.numpy as jnp
from jax import lax
import numpy as np

D_MODEL = 1024
BATCH = 8
SEQ = 4096
DEPTH = 1

CONV_DIM = 512
CONV_K = 3
N_HEADS = 8
N_KV_HEADS = 2
HEAD_DIM = 64
Q_DIM = N_HEADS * HEAD_DIM
KV_DIM = N_KV_HEADS * HEAD_DIM
GROUP = N_HEADS // N_KV_HEADS
WINDOW = 128
BLOCK = 128
N_BRANCHES = 2
N_BUCKETS = 32
MAX_DISTANCE = 128
PEER_HEADS = 8
N_KEYS = 128
N_EXPERTS = N_KEYS * N_KEYS
PEER_QDIM = 256
PEER_HALF = PEER_QDIM // 2
PEER_TOPK = 16
PEER_CHUNK = 128
EPS = 1e-6
IN_DIM = 3 * CONV_DIM + Q_DIM + 2 * KV_DIM + N_BRANCHES * D_MODEL

kernel_name = "hybrid_conv_swa_sink_peer_block"


def rms_norm(x, g):
    xf = x.astype(jnp.float32)
    y = xf * lax.rsqrt(jnp.mean(xf * xf, axis=-1, keepdims=True) + EPS)
    return (y * g.astype(jnp.float32)).astype(x.dtype)


def t5_causal_bucket(dist):
    max_exact = N_BUCKETS // 2
    d = jnp.maximum(dist, 0)
    df = jnp.maximum(d, 1).astype(jnp.float32)
    large = max_exact + (jnp.log(df / max_exact) / math.log(MAX_DISTANCE / max_exact)
                         * (N_BUCKETS - max_exact)).astype(jnp.int32)
    large = jnp.minimum(large, N_BUCKETS - 1)
    return jnp.where(d < max_exact, d, large)


def band_bias_and_mask(rel_bias, n_blocks):
    q_loc = jnp.arange(BLOCK, dtype=jnp.int32)[:, None]
    k_loc = jnp.arange(2 * BLOCK, dtype=jnp.int32)[None, :]
    dist = q_loc + BLOCK - k_loc
    bias = jnp.take(rel_bias, t5_causal_bucket(dist), axis=0)
    bias = jnp.transpose(bias, (2, 0, 1)).reshape(N_KV_HEADS, GROUP, 1, BLOCK, 2 * BLOCK)
    blk = jnp.arange(n_blocks, dtype=jnp.int32)[:, None, None]
    k_pos = blk * BLOCK - BLOCK + k_loc[None]
    valid = (dist[None] >= 0) & (dist[None] < WINDOW) & (k_pos >= 0)
    return bias.astype(jnp.float32), valid


def short_gated_conv(u, b_gate, c_gate, w_conv):
    h = c_gate * u
    kern = w_conv[:, None, :].astype(h.dtype)
    y = lax.conv_general_dilated(h, kern, window_strides=(1,), padding=[(CONV_K - 1, 0)],
                                 dimension_numbers=("NWC", "WIO", "NWC"),
                                 feature_group_count=CONV_DIM)
    return b_gate * y


def sliding_window_attention(q, k, v, sinks, bias, valid):
    bsz, s = q.shape[0], q.shape[1]
    nb = s // BLOCK
    qb = q.reshape(bsz, nb, BLOCK, N_KV_HEADS, GROUP, HEAD_DIM)
    kp = jnp.pad(k, ((0, 0), (BLOCK, 0), (0, 0), (0, 0)))
    vp = jnp.pad(v, ((0, 0), (BLOCK, 0), (0, 0), (0, 0)))
    kb = jnp.concatenate([kp[:, :s].reshape(bsz, nb, BLOCK, N_KV_HEADS, HEAD_DIM),
                          k.reshape(bsz, nb, BLOCK, N_KV_HEADS, HEAD_DIM)], axis=2)
    vb = jnp.concatenate([vp[:, :s].reshape(bsz, nb, BLOCK, N_KV_HEADS, HEAD_DIM),
                          v.reshape(bsz, nb, BLOCK, N_KV_HEADS, HEAD_DIM)], axis=2)
    logits = jnp.einsum("bnqkgd,bnskd->bkgnqs", qb, kb).astype(jnp.float32)
    logits = jnp.where(valid, logits + bias, -jnp.inf)
    sink = sinks.astype(jnp.float32).reshape(N_KV_HEADS, GROUP, 1, 1, 1)
    m = jnp.maximum(jnp.max(logits, axis=-1, keepdims=True), sink)
    p = jnp.exp(logits - m)
    denom = jnp.sum(p, axis=-1, keepdims=True) + jnp.exp(sink - m)
    p = (p / denom).astype(v.dtype)
    out = jnp.einsum("bkgnqs,bnskd->bnqkgd", p, vb)
    return out.reshape(bsz, s, Q_DIM)


def peer_ffn(x, w_query, sub_keys, expert_u, expert_v):
    bsz, s, d = x.shape
    t = bsz * s
    xt = x.reshape(t, d)
    q = (xt @ w_query).reshape(t, PEER_HEADS, 2, PEER_HALF)
    scores = jnp.einsum("thpd,hpnd->thpn", q, sub_keys).astype(jnp.float32)
    s_half, i_half = lax.top_k(scores, PEER_TOPK)
    cand_s = s_half[:, :, 0, :, None] + s_half[:, :, 1, None, :]
    cand_i = i_half[:, :, 0, :, None] * N_KEYS + i_half[:, :, 1, None, :]
    top_s, top_pos = lax.top_k(cand_s.reshape(t, PEER_HEADS, PEER_TOPK * PEER_TOPK), PEER_TOPK)
    idx = jnp.take_along_axis(cand_i.reshape(t, PEER_HEADS, PEER_TOPK * PEER_TOPK), top_pos, axis=-1)
    gates = jax.nn.softmax(top_s, axis=-1).astype(x.dtype)
    nc = t // PEER_CHUNK
    n_sel = PEER_HEADS * PEER_TOPK

    def chunk_fn(args):
        xc, ic, gc = args
        u = jnp.take(expert_u, ic, axis=0)
        a = jax.nn.gelu(jnp.einsum("cd,ced->ce", xc, u), approximate=False)
        vv = jnp.take(expert_v, ic, axis=0)
        return jnp.einsum("ce,ced->cd", (gc * a).astype(vv.dtype), vv)

    out = lax.map(chunk_fn, (xt.reshape(nc, PEER_CHUNK, d),
                             idx.reshape(nc, PEER_CHUNK, n_sel),
                             gates.reshape(nc, PEER_CHUNK, n_sel)))
    return out.reshape(bsz, s, d)


def setup_inputs(seed: int = 0) -> dict:
    key = jax.random.key(seed)
    ks = jax.random.split(key, 18)
    f32 = jnp.float32
    nrm = lambda k, shape, scale: jax.random.normal(k, shape, f32) * scale
    return {
        "x": nrm(ks[0], (BATCH, SEQ, D_MODEL), 1.0),
        "norm_mix": 1.0 + nrm(ks[1], (DEPTH, D_MODEL), 0.02),
        "norm_ffn": 1.0 + nrm(ks[2], (DEPTH, D_MODEL), 0.02),
        "w_in": nrm(ks[3], (DEPTH, D_MODEL, IN_DIM), D_MODEL ** -0.5),
        "b_gate": nrm(ks[4], (DEPTH, N_BRANCHES * D_MODEL), 0.02),
        "w_conv": nrm(ks[5], (DEPTH, CONV_K, CONV_DIM), CONV_K ** -0.5),
        "q_norm": 1.0 + nrm(ks[6], (DEPTH, HEAD_DIM), 0.02),
        "k_norm": 1.0 + nrm(ks[7], (DEPTH, HEAD_DIM), 0.02),
        "sinks": nrm(ks[8], (DEPTH, N_HEADS), 0.5),
        "rel_bias": nrm(ks[9], (N_BUCKETS, N_HEADS), 0.5),
        "w_conv_out": nrm(ks[10], (DEPTH, CONV_DIM, D_MODEL), CONV_DIM ** -0.5),
        "w_attn_out": nrm(ks[11], (DEPTH, Q_DIM, D_MODEL), Q_DIM ** -0.5),
        "w_out": nrm(ks[12], (DEPTH, D_MODEL, D_MODEL), D_MODEL ** -0.5),
        "w_query": nrm(ks[13], (DEPTH, D_MODEL, PEER_HEADS * PEER_QDIM), D_MODEL ** -0.5),
        "sub_keys": nrm(ks[14], (DEPTH, PEER_HEADS, 2, N_KEYS, PEER_HALF), PEER_HALF ** -0.5),
        "expert_u": nrm(ks[15], (DEPTH, N_EXPERTS, D_MODEL), D_MODEL ** -0.5),
        "expert_v": nrm(ks[16], (DEPTH, N_EXPERTS, D_MODEL), PEER_HEADS ** -0.5),
    }


def reference(x, norm_mix, norm_ffn, w_in, b_gate, w_conv, q_norm, k_norm, sinks, rel_bias,
              w_conv_out, w_attn_out, w_out, w_query, sub_keys, expert_u, expert_v):
    bsz, s, _ = x.shape
    bias, valid = band_bias_and_mask(rel_bias, s // BLOCK)
    offs = np.cumsum([CONV_DIM, CONV_DIM, CONV_DIM, Q_DIM, KV_DIM, KV_DIM, D_MODEL]).tolist()
    for l in range(DEPTH):
        h = rms_norm(x, norm_mix[l])
        proj = h @ w_in[l]
        u_c, b_c, c_c, q, k, v, g_c, g_a = jnp.split(proj, offs, axis=-1)
        bg_c, bg_a = jnp.split(b_gate[l], [D_MODEL])
        gate_conv = jax.nn.sigmoid(g_c + bg_c)
        gate_attn = jax.nn.sigmoid(g_a + bg_a)
        y_conv = short_gated_conv(u_c, b_c, c_c, w_conv[l]) @ w_conv_out[l]
        qh = rms_norm(q.reshape(bsz, s, N_HEADS, HEAD_DIM), q_norm[l]) * (HEAD_DIM ** -0.5)
        kh = rms_norm(k.reshape(bsz, s, N_KV_HEADS, HEAD_DIM), k_norm[l])
        vh = v.reshape(bsz, s, N_KV_HEADS, HEAD_DIM)
        y_attn = sliding_window_attention(qh, kh, vh, sinks[l], bias, valid) @ w_attn_out[l]
        mixed = gate_conv * y_conv + gate_attn * y_attn
        x = x + mixed @ w_out[l]
        h2 = rms_norm(x, norm_ffn[l])
        x = x + peer_ffn(h2, w_query[l], sub_keys[l], expert_u[l], expert_v[l])
    return x
```

```cpp
#include <hip/hip_runtime.h>
#include <hip/hip_cooperative_groups.h>
#include <cstdio>
#include <cstdint>
namespace pg8 {
#define PG8_LAS __attribute__((address_space(3)))
typedef unsigned short bf16_t;
typedef short bf16x8 __attribute__((ext_vector_type(8)));
typedef float f32x4 __attribute__((ext_vector_type(4)));
typedef unsigned u32x4 __attribute__((ext_vector_type(4)));
constexpr int BM = 256, BK = 64, HALF = 128, HTB = HALF * BK * 2  , STAGE_BYTES = 8 * HTB, NXCD = 8, WGM = 8;

__host__ __device__ __forceinline__ int lds_byte(int r, int c) { const int st = (r >> 4) * 2 + (c >> 5), rr = r & 15, cc = c & 31, ob = rr * 64 + cc * 2; return st * 1024 + (ob ^ (((ob >> 9) & 1) << 5)); }
__host__ __device__ __forceinline__ void stage_rc(int b, int& R, int& C) { const int st = b / 1024, sb = b % 1024, swz = sb ^ (((sb >> 9) & 1) << 5); R = (st >> 1) * 16 + swz / 64; C = (st & 1) * 32 + (swz % 64) / 2; }
__host__ __device__ __forceinline__ int perm32(int rho) { const int n = rho >> 4, i = rho & 15; return 8 * (i >> 2) + 4 * n + (i & 3); }

struct Unit { int pm, pn, which; };
struct Gemm { const bf16_t* A; const bf16_t* Bt; const bf16_t* A2; const bf16_t* Bt2; int M, N, K; };

struct StaticOrder {
    int nM, nN, nwg, G, c;
    __host__ __device__ void init(int M, int N, int G_, int c_) { nM = M / BM; nN = N / BM; nwg = nM * nN; G = G_; c = c_; }
    __host__ __device__ bool next(int i, Unit& u) const {
        const long L = (long)i * G + c; if (L >= nwg) return false;
        int wgid = (int)L; { const int q = nwg / NXCD, r = nwg % NXCD, xcd = wgid % NXCD, off = wgid / NXCD; wgid = (xcd < r ? xcd * (q + 1) : r * (q + 1) + (xcd - r) * q) + off; }
        const int nig = WGM * nN, gid = wgid / nig, fm = gid * WGM, gsz = (nM - fm) < WGM ? (nM - fm) : WGM;
        u.pm = fm + ((wgid % nig) % gsz); u.pn = (wgid % nig) / gsz; u.which = 0; return true;
    }
    __device__ __forceinline__ const char* a_base(const Gemm& g, const Unit& u, size_t tstep) const { return (const char*)g.A + (size_t)u.pm * tstep; }
    __device__ __forceinline__ const char* b_base(const Gemm& g, const Unit& u, size_t tstep) const { return (const char*)g.Bt + (size_t)u.pn * tstep; }
    __device__ __forceinline__ void a_ready(const Unit&) const {}
    __device__ __forceinline__ void done(const Unit&) const {}
};

__device__ __forceinline__ unsigned cvt_pk_bf16(float lo, float hi) { unsigned r; asm volatile("v_cvt_pk_bf16_f32 %0, %1, %2" : "=v"(r) : "v"(lo), "v"(hi)); return r; }
typedef float f32x2 __attribute__((ext_vector_type(2)));
__device__ __forceinline__ f32x2 gelu_pk(f32x2 v) {
    const f32x2 av = __builtin_elementwise_abs(v), d = av * 0.2316418882f + 1.0f;
    f32x2 t; t.x = __builtin_amdgcn_rcpf(d.x); t.y = __builtin_amdgcn_rcpf(d.y);
    f32x2 q = t * 0.5307027145f + (-0.7265760135f); q = q * t + 0.7107068705f; q = q * t + (-0.142248368f); q = q * t + 0.127414796f; q = q * t;
    const f32x2 s = (v * v) * (-0.72134752044f);
    f32x2 e; e.x = __builtin_amdgcn_exp2f(s.x); e.y = __builtin_amdgcn_exp2f(s.y);
    const f32x2 m = v * (q * e), r = v - m;
    f32x2 o; o.x = v.x < 0.f ? m.x : r.x; o.y = v.y < 0.f ? m.y : r.y; return o;
}

template <class Epi, class Sched, bool ALIGN_EPI = false, bool SP2 = false>
__device__ __forceinline__ void gemm_phase(PG8_LAS unsigned char* lds, const Gemm g, const Sched& S, const Epi& E) {
    const int tid = threadIdx.x, wid = __builtin_amdgcn_readfirstlane(tid >> 6), lane = tid & 63, wr = wid >> 2, wc = wid & 3, fr = lane & 15, fq = lane >> 4;
    const int K = g.K, nt = K / BK;
    unsigned voffA[2], voffB[2];
#pragma unroll
    for (int i = 0; i < 2; ++i) { int R, C; stage_rc(tid * 16 + i * 8192, R, C); const int Rb = Epi::PERM ? ((R & ~31) + perm32(R & 31)) : R;
        voffA[i] = (unsigned)(R * K + C) * 2u; voffB[i] = (unsigned)(Rb * K + C) * 2u; }
    const size_t kstep = (size_t)(BK * 2);
    const size_t hstep = (size_t)HALF * K * 2;
    const size_t tstep = 2 * hstep;
    const unsigned ldsw = (unsigned)wid * 1024u;
    const int aoff = lds_byte(wr * 64 + fr, fq * 8), boff = lds_byte(wc * 32 + fr, fq * 8);
#define PG8_SA(b, h) (((b) * 2 + (h)) * HTB)
#define PG8_SB(b, h) ((4 + (b) * 2 + (h)) * HTB)
#define PG8_STAGE(bufoff, gbase, voff) do { _Pragma("unroll") for (int _i = 0; _i < 2; ++_i) \
        __builtin_amdgcn_global_load_lds((const unsigned*)((const char*)(gbase) + (voff)[_i]), (PG8_LAS unsigned*)(lds + (bufoff) + ldsw + _i * 8192), 16, 0, 0); } while (0)
#define PG8_LDA(dst, b, h) do { _Pragma("unroll") for (int m = 0; m < 4; ++m) _Pragma("unroll") for (int k = 0; k < 2; ++k) dst[m][k] = *(const PG8_LAS bf16x8*)(lds + PG8_SA(b, h) + aoff + m * 2048 + k * 1024); } while (0)
#define PG8_LDB(dst, b, h) do { _Pragma("unroll") for (int n = 0; n < 2; ++n) _Pragma("unroll") for (int k = 0; k < 2; ++k) dst[n][k] = *(const PG8_LAS bf16x8*)(lds + PG8_SB(b, h) + boff + n * 2048 + k * 1024); } while (0)
#define PG8_MMA(ai, bj, At, Bt) do { __builtin_amdgcn_s_setprio(1); _Pragma("unroll") for (int m = 0; m < 4; ++m) _Pragma("unroll") for (int n = 0; n < 2; ++n) _Pragma("unroll") for (int k = 0; k < 2; ++k) \
        acc[ai][bj][m][n] = __builtin_amdgcn_mfma_f32_16x16x32_bf16(Bt[n][k], At[m][k], acc[ai][bj][m][n], 0, 0, 0); __builtin_amdgcn_s_setprio(0); } while (0)
#define PG8_WAIT_V(n) asm volatile("s_waitcnt vmcnt(" #n ")" ::: "memory")
#define PG8_WAIT_L(n) asm volatile("s_waitcnt lgkmcnt(" #n ")" ::: "memory")
#define PG8_BAR __builtin_amdgcn_s_barrier()
#define PG8_SCHED __builtin_amdgcn_sched_barrier(0)
    Unit cur, nxt; int ui = 0;
    if (!S.next(0, cur)) return;
    f32x4 acc[2][2][4][2];
#pragma unroll
    for (int a = 0; a < 2; ++a)
#pragma unroll
        for (int b = 0; b < 2; ++b)
#pragma unroll
            for (int m = 0; m < 4; ++m)
#pragma unroll
                for (int n = 0; n < 2; ++n) acc[a][b][m][n] = (f32x4){0.f, 0.f, 0.f, 0.f};
    bf16x8 At[4][2], B0[2][2], B1[2][2];
    const char* cA = S.a_base(g, cur, tstep); const char* cB = S.b_base(g, cur, tstep);
    S.a_ready(cur);
    if constexpr (SP2) {
        PG8_STAGE(PG8_SB(0, 0), cB, voffB); PG8_STAGE(PG8_SB(0, 1), cB + hstep, voffB); PG8_STAGE(PG8_SA(0, 0), cA, voffA); PG8_STAGE(PG8_SA(0, 1), cA + hstep, voffA);
        if (wr == 1) PG8_BAR;
        PG8_WAIT_V(2); PG8_BAR;
        PG8_STAGE(PG8_SB(1, 0), cB + kstep, voffB); PG8_STAGE(PG8_SA(1, 0), cA + kstep, voffA); PG8_STAGE(PG8_SB(1, 1), cB + hstep + kstep, voffB);
        PG8_WAIT_V(6); PG8_BAR;
    } else {
        PG8_STAGE(PG8_SB(0, 0), cB, voffB); PG8_STAGE(PG8_SA(0, 0), cA, voffA); PG8_STAGE(PG8_SB(0, 1), cB + hstep, voffB); PG8_STAGE(PG8_SA(0, 1), cA + hstep, voffA);
        if (wr == 1) PG8_BAR;
        PG8_WAIT_V(4); PG8_BAR;
        PG8_STAGE(PG8_SB(1, 0), cB + kstep, voffB); PG8_STAGE(PG8_SA(1, 0), cA + kstep, voffA); PG8_STAGE(PG8_SB(1, 1), cB + hstep + kstep, voffB);
        PG8_WAIT_V(6); PG8_BAR;
    }
    for (;;) {
        const bool has_next = S.next(ui + 1, nxt);
        const char* nA = has_next ? S.a_base(g, nxt, tstep) : cA; const char* nB = has_next ? S.b_base(g, nxt, tstep) : cB;
        for (int t = 0; t < nt; t += 2) {
            const bool last = (t == nt - 2);
            const char* a1 = cA + (size_t)(t + 1) * kstep;
            const char* a2 = last ? nA : cA + (size_t)(t + 2) * kstep; const char* b2 = last ? nB : cB + (size_t)(t + 2) * kstep;
            const char* a3 = a2 + kstep; const char* b3 = b2 + kstep;
            if (last && has_next) S.a_ready(nxt);
            if constexpr (SP2) {
            PG8_LDB(B0, 0, 0); PG8_LDB(B1, 0, 1); PG8_SCHED; PG8_LDA(At, 0, 0); PG8_STAGE(PG8_SA(1, 1), a1 + hstep, voffA);
            PG8_WAIT_V(8); PG8_WAIT_L(0); PG8_BAR; PG8_MMA(0, 0, At, B0); PG8_MMA(0, 1, At, B1); PG8_BAR; PG8_SCHED;
            PG8_LDA(At, 0, 1); PG8_STAGE(PG8_SB(0, 0), b2, voffB); PG8_STAGE(PG8_SB(0, 1), b2 + hstep, voffB); PG8_STAGE(PG8_SA(0, 0), a2, voffA);
            PG8_WAIT_V(8); PG8_WAIT_L(0); PG8_BAR; PG8_MMA(1, 0, At, B0); PG8_MMA(1, 1, At, B1); PG8_BAR; PG8_SCHED;
            PG8_LDB(B0, 1, 0); PG8_LDB(B1, 1, 1); PG8_SCHED; PG8_LDA(At, 1, 0); PG8_STAGE(PG8_SA(0, 1), a2 + hstep, voffA);
            PG8_WAIT_V(8); PG8_WAIT_L(0); PG8_BAR; PG8_MMA(0, 0, At, B0); PG8_MMA(0, 1, At, B1); PG8_BAR; PG8_SCHED;
            PG8_LDA(At, 1, 1); PG8_STAGE(PG8_SB(1, 0), b3, voffB); PG8_STAGE(PG8_SB(1, 1), b3 + hstep, voffB); PG8_STAGE(PG8_SA(1, 0), a3, voffA);
            PG8_WAIT_V(8); PG8_WAIT_L(0); PG8_BAR; PG8_MMA(1, 0, At, B0); PG8_MMA(1, 1, At, B1); PG8_BAR; PG8_SCHED;
            } else {
            PG8_LDB(B0, 0, 0); PG8_SCHED; PG8_LDA(At, 0, 0); PG8_STAGE(PG8_SA(1, 1), a1 + hstep, voffA);
            PG8_WAIT_L(8); PG8_BAR; PG8_WAIT_L(0); PG8_MMA(0, 0, At, B0); PG8_BAR; PG8_SCHED;
            PG8_LDB(B1, 0, 1); PG8_STAGE(PG8_SB(0, 0), b2, voffB);
            PG8_BAR; PG8_WAIT_L(0); PG8_MMA(0, 1, At, B1); PG8_BAR;
            PG8_LDA(At, 0, 1); PG8_STAGE(PG8_SA(0, 0), a2, voffA);
            PG8_BAR; PG8_WAIT_L(0); PG8_MMA(1, 0, At, B0); PG8_BAR; PG8_SCHED;
            PG8_STAGE(PG8_SB(0, 1), b2 + hstep, voffB);
            PG8_WAIT_V(6); PG8_BAR; PG8_MMA(1, 1, At, B1); PG8_BAR;
            PG8_LDB(B0, 1, 0); PG8_SCHED; PG8_LDA(At, 1, 0); PG8_STAGE(PG8_SA(0, 1), a2 + hstep, voffA);
            PG8_WAIT_L(8); PG8_BAR; PG8_WAIT_L(0); PG8_MMA(0, 0, At, B0); PG8_BAR; PG8_SCHED;
            PG8_LDB(B1, 1, 1); PG8_STAGE(PG8_SB(1, 0), b3, voffB);
            PG8_BAR; PG8_WAIT_L(0); PG8_MMA(0, 1, At, B1); PG8_BAR;
            PG8_LDA(At, 1, 1); PG8_STAGE(PG8_SA(1, 0), a3, voffA);
            PG8_BAR; PG8_WAIT_L(0); PG8_MMA(1, 0, At, B0); PG8_BAR; PG8_SCHED;
            PG8_STAGE(PG8_SB(1, 1), b3 + hstep, voffB);
            PG8_WAIT_V(6); PG8_BAR; PG8_MMA(1, 1, At, B1); PG8_BAR;
            }
        }
        if constexpr (ALIGN_EPI) { if (wr == 0) PG8_BAR; }
        if constexpr (!Epi::AFTER_DRAIN) { E(acc, cur, wr, wc, fr, fq); S.done(cur); }
        if (!has_next) break;
#pragma unroll
        for (int a = 0; a < 2; ++a)
#pragma unroll
            for (int b = 0; b < 2; ++b)
#pragma unroll
                for (int m = 0; m < 4; ++m)
#pragma unroll
                    for (int n = 0; n < 2; ++n) acc[a][b][m][n] = (f32x4){0.f, 0.f, 0.f, 0.f};
        cur = nxt; cA = nA; cB = nB; ++ui;
        if constexpr (ALIGN_EPI) { if (wr == 1) PG8_BAR; }
    }
    PG8_WAIT_V(0);
    if constexpr (!ALIGN_EPI) { if (wr == 0) PG8_BAR; }
    PG8_BAR;
    if constexpr (Epi::AFTER_DRAIN) { E.fused(acc, cur, wr, wc, fr, fq, lds, wid, lane); S.done(cur); }
#undef PG8_SA
#undef PG8_SB
#undef PG8_STAGE
#undef PG8_LDA
#undef PG8_LDB
#undef PG8_MMA
#undef PG8_WAIT_V
#undef PG8_WAIT_L
#undef PG8_BAR
#undef PG8_SCHED
}
}

#ifndef PG8_SP2
#define PG8_SP2 true
#endif
#ifndef PG8_ALIGN
#define PG8_ALIGN true
#endif
#define PEER_ALPHA (1.0f)
#ifndef MK_ONE_LAUNCH
#define MK_ONE_LAUNCH 0
#endif

constexpr int NWAVES = 8;
constexpr int T = 32768, D = 1024, SEQ = 4096;
constexpr int IN_DIM = 4352, PA_W = 2304, G_W = 2048;
constexpr int C_U = 0, C_B = 512, C_C = 1024, C_Q = 1536, C_K = 2048, C_V = 2176;
constexpr int CONV = 512, HD = 64, NH = 8, NKV = 2;
constexpr int PH = 8, NKEYS = 128, PQ = 2048, TOPK = 16, NEXP = 16384, NSEL = 128;
constexpr float EPS = 1e-6f;
constexpr int N_PHASES = 8;

constexpr size_t MiB = 1u << 20;
constexpr size_t WS_CTL = 0, CTL_ZERO_BYTES = 1 * MiB;
constexpr size_t WS_WIN = 2 * MiB;
constexpr size_t WS_WC = 11 * MiB;
constexpr size_t WS_WA = 12 * MiB;
constexpr size_t WS_WO = 13 * MiB;
constexpr size_t WS_WQ = 15 * MiB;
constexpr size_t WS_SK = 19 * MiB;
constexpr size_t WS_RSTD1 = 20 * MiB;
constexpr size_t WS_SSQ = 21 * MiB;
constexpr size_t WS_UB = 24 * MiB;
constexpr size_t WS_VB = 56 * MiB;
constexpr size_t WS_XB = 88 * MiB;
constexpr size_t WS_PA = 152 * MiB;
constexpr size_t WS_MIX = WS_PA;
constexpr size_t WS_G = 296 * MiB;
constexpr size_t WS_QP = WS_G;
constexpr size_t WS_Z = 424 * MiB;
constexpr size_t WS_ATT = 456 * MiB;
constexpr size_t WS_IDX = WS_Z, WS_GATE = WS_ATT;
constexpr size_t WS_END = 488 * MiB;
constexpr int CW_BAR = 4096;

constexpr int RING_OFF = 0, RING_BYTES = 131072;
constexpr int LDSCTL_OFF = RING_BYTES, MISC_OFF = LDSCTL_OFF + 320;
constexpr int LDS_BYTES = 147456;
#define GAS __attribute__((address_space(1)))
#define LAS __attribute__((address_space(3)))
typedef unsigned short bf16;
typedef unsigned v4u __attribute__((ext_vector_type(4)));
typedef float f32x4 __attribute__((ext_vector_type(4)));
typedef short bf16x8 __attribute__((ext_vector_type(8)));
typedef GAS unsigned gu32;
typedef GAS unsigned long long gu64;
#define RLX_AGENT __ATOMIC_RELAXED, __HIP_MEMORY_SCOPE_AGENT
#define LDS_WAIT() asm volatile("s_waitcnt lgkmcnt(0)" ::: "memory")
#define VM_WAIT() asm volatile("s_waitcnt vmcnt(0)" ::: "memory")
__device__ __forceinline__ unsigned long long rt() { return __builtin_amdgcn_s_memrealtime(); }
__device__ __forceinline__ unsigned f2bf(float f) { unsigned u = __builtin_bit_cast(unsigned, f); return (u + 0x7fffu + ((u >> 16) & 1u)) >> 16; }
__device__ __forceinline__ unsigned pk2(float lo, float hi) { return f2bf(lo) | (f2bf(hi) << 16); }

#define XB_TMO      128
#define XB_XCNT(j)  (256  + 64 * (j))
#define XB_XSUB(j)  (1280 + 64 * (j))
#define XB_XGEN(j)  (2304 + 64 * (j))
#define XB_TOP      3328
#define XB_TOPGEN   3392
#define XCD_BAR_WORDS 3456
#define XB_SPIN_CAP (1u << 18)

__device__ __forceinline__ unsigned xb_ld(unsigned* p)              { return __hip_atomic_load(p, __ATOMIC_RELAXED, __HIP_MEMORY_SCOPE_AGENT); }
__device__ __forceinline__ unsigned xb_add(unsigned* p, unsigned v) { return __hip_atomic_fetch_add(p, v, __ATOMIC_RELAXED, __HIP_MEMORY_SCOPE_AGENT); }
__device__ __forceinline__ unsigned xb_xcc_id() { return (unsigned)__builtin_amdgcn_s_getreg((3 << 11) | 20) & 0xFu; }
#define XB_SPIN(cond, bar) do { unsigned _sp = 0; while (cond) { __builtin_amdgcn_s_sleep(1); \
    if ((++_sp & 255u) == 0u) { if (xb_ld(&(bar)[XB_TMO])) break; if (_sp > XB_SPIN_CAP) { atomicAdd(&(bar)[XB_TMO], 1u); break; } } } } while (0)

struct XcdBarrier {
    unsigned* bar; unsigned x;
    volatile LAS unsigned* st;
};

__device__ __forceinline__ XcdBarrier xcd_barrier_post(unsigned* bar, volatile LAS unsigned* st) {
    XcdBarrier b; b.bar = bar; b.x = xb_xcc_id(); b.st = st;
    if (threadIdx.x == 0) (void)xb_add(&bar[XB_XCNT(b.x)], 1u);
    return b;
}
__device__ __forceinline__ void xcd_barrier_complete(unsigned* bar, unsigned x, unsigned& nloc, unsigned& nx) {
    const unsigned G = gridDim.x * gridDim.y * gridDim.z;
    unsigned sum, cnt, mine, sp = 0u;
    for (;;) {
        sum = 0u; cnt = 0u; mine = 0u;
#pragma unroll
        for (unsigned j = 0; j < 16; ++j) { const unsigned c = xb_ld(&bar[XB_XCNT(j)]); sum += c; cnt += (c > 0u) ? 1u : 0u; mine = (j == x) ? c : mine; }
        if (sum == G) break;
        __builtin_amdgcn_s_sleep(1);
        if ((++sp & 255u) == 0u) { if (xb_ld(&bar[XB_TMO])) break; if (sp > XB_SPIN_CAP) { atomicAdd(&bar[XB_TMO], 1u); break; } }
    }
    nloc = mine > 0u ? mine : 1u; nx = cnt > 0u ? cnt : 1u;
}

__device__ __forceinline__ void xcd_barrier(const XcdBarrier& b) {
    asm volatile("s_waitcnt vmcnt(0)" ::: "memory");
    __syncthreads();
    if (threadIdx.x == 0) {
        unsigned* bar = b.bar;
        __builtin_amdgcn_s_waitcnt(0);
        unsigned nloc = b.st[0], nx = b.st[1];
        if (nloc == 0u) { xcd_barrier_complete(bar, b.x, nloc, nx); b.st[0] = nloc; b.st[1] = nx; }
        const unsigned old = xb_add(&bar[XB_XSUB(b.x)], 1u);
        const unsigned gen = old / nloc;
        if (old + 1u == (gen + 1u) * nloc) {
            __builtin_amdgcn_fence(__ATOMIC_RELEASE, "agent");
            asm volatile("s_waitcnt vmcnt(0)" ::: "memory");
            const unsigned og = xb_add(&bar[XB_TOP], 1u);
            const unsigned tg = og / nx;
            if (og + 1u == (tg + 1u) * nx) xb_add(&bar[XB_TOPGEN], 1u);
            else XB_SPIN(xb_ld(&bar[XB_TOPGEN]) == tg, bar);
            __builtin_amdgcn_fence(__ATOMIC_ACQUIRE, "agent");
            xb_add(&bar[XB_XGEN(b.x)], 1u);
            asm volatile("s_waitcnt vmcnt(0)" ::: "memory");
        } else {
            XB_SPIN(xb_ld(&bar[XB_XGEN(b.x)]) == gen, bar);
            __builtin_amdgcn_fence(__ATOMIC_ACQUIRE, "agent");
            asm volatile("s_waitcnt vmcnt(0)" ::: "memory");
        }
    }
    __syncthreads();
}

typedef float f32x16 __attribute__((ext_vector_type(16)));
typedef unsigned v2u __attribute__((ext_vector_type(2)));
typedef int v4i __attribute__((ext_vector_type(4)));
typedef __bf16 bf2_t __attribute__((ext_vector_type(2)));
#define DI __device__ __forceinline__
struct Frame {
    LAS unsigned char* lds;
    volatile LAS unsigned* MISC;
    gu32* ctl;
    int tid, lane, wave, vcu, G;
    const float *x, *norm_mix, *norm_ffn, *w_in, *b_gate, *w_conv, *q_norm, *k_norm, *sinks, *rel_bias, *w_conv_out, *w_attn_out, *w_out, *w_query, *sub_keys, *expert_u, *expert_v;
    float* out;
    bf16 *WIN, *WC, *WA, *WO, *WQ, *SK, *UB, *VB, *XB, *PA, *MIX, *G_, *QP, *Z, *ATT;
    float *RSTD1, *SSQ, *GATE; int* IDX;
};
DI float wave_sum(float v) {
#pragma unroll
    for (int o = 1; o < 64; o <<= 1) v += __shfl_xor(v, o);
    return v;
}
DI float bf_lo(unsigned u) { return __builtin_bit_cast(float, u << 16); }
DI float bf_hi(unsigned u) { return __builtin_bit_cast(float, u & 0xffff0000u); }

DI void p0_transpose_item(const float* W, int K, int N, bf16* WT, const float* gsc, LAS float* scr, int item, int lane) {
    const int nblk = N / 32, kb = item / nblk, nb = item % nblk, k0 = 64 * kb, n0 = 32 * nb;
#pragma unroll 8
    for (int i = 0; i < 32; ++i) { const int kk = 2 * i + (lane >> 5); float v = W[(size_t)(k0 + kk) * N + n0 + (lane & 31)]; if (gsc) v *= gsc[k0 + kk]; scr[kk * 33 + (lane & 31)] = v; }
    LDS_WAIT(); asm volatile("" ::: "memory");
    const int c = lane & 7;
#pragma unroll
    for (int j = 0; j < 4; ++j) { const int n = (lane >> 3) + 8 * j; const LAS float* s = scr + (8 * c) * 33 + n;
        v4u o; o.x = pk2(s[0 * 33], s[1 * 33]); o.y = pk2(s[2 * 33], s[3 * 33]); o.z = pk2(s[4 * 33], s[5 * 33]); o.w = pk2(s[6 * 33], s[7 * 33]);
        *(GAS v4u*)(WT + (size_t)(n0 + n) * K + k0 + 8 * c) = o; }
    LDS_WAIT(); asm volatile("" ::: "memory");
}
DI void p0_convert(Frame& F, const float* src, bf16* dst, size_t n, const float* colscale) {
    const size_t n8 = n / 8, stride = (size_t)F.G * NWAVES * 64;
    for (size_t i = (size_t)F.vcu * NWAVES * 64 + F.tid; i < n8; i += stride) {
        f32x4 a = *(const GAS f32x4*)(src + i * 8), b = *(const GAS f32x4*)(src + i * 8 + 4);
        if (colscale) { const int c = (int)((i * 8) & 1023); const f32x4 s0 = *(const GAS f32x4*)(colscale + c), s1 = *(const GAS f32x4*)(colscale + c + 4); a = a * s0; b = b * s1; }
        v4u o; o.x = pk2(a.x, a.y); o.y = pk2(a.z, a.w); o.z = pk2(b.x, b.y); o.w = pk2(b.z, b.w);
        *(GAS v4u*)(dst + i * 8) = o;
    }
}
DI void p0_row(Frame& F, const float* xrow, bf16* orow, float* rstd_out) {
    const GAS f32x4* xr = (const GAS f32x4*)xrow + F.lane;
    f32x4 v[4]; float s = 0.f;
#pragma unroll
    for (int j = 0; j < 4; ++j) { v[j] = xr[64 * j]; s += (v[j].x * v[j].x + v[j].y * v[j].y) + (v[j].z * v[j].z + v[j].w * v[j].w); }
    s = wave_sum(s);
    if (F.lane == 0) *rstd_out = 1.f / sqrtf(s * (1.f / D) + EPS);
    GAS unsigned long long* o8 = (GAS unsigned long long*)orow + F.lane;
#pragma unroll
    for (int j = 0; j < 4; ++j) o8[64 * j] = (unsigned long long)pk2(v[j].x, v[j].y) | ((unsigned long long)pk2(v[j].z, v[j].w) << 32);
}
DI void p0_prologue(Frame& F) {
    LAS float* scr = (LAS float*)(F.lds + RING_OFF + F.wave * 16384);
    const int gw = F.vcu * NWAVES + F.wave, NGW = F.G * NWAVES;
    constexpr int I_IN = (D / 64) * (IN_DIM / 32), I_C = (CONV / 64) * (D / 32), I_O = (D / 64) * (D / 32), I_Q = (D / 64) * (PQ / 32);
    constexpr int NITEMS = I_IN + 2 * I_C + I_O + I_Q;
    for (int it = gw; it < NITEMS; it += NGW) {
        int r = it;
        if (r < I_IN) { p0_transpose_item(F.w_in, D, IN_DIM, F.WIN, F.norm_mix, scr, r, F.lane); continue; } r -= I_IN;
        if (r < I_C) { p0_transpose_item(F.w_conv_out, CONV, D, F.WC, nullptr, scr, r, F.lane); continue; } r -= I_C;
        if (r < I_C) { p0_transpose_item(F.w_attn_out, CONV, D, F.WA, nullptr, scr, r, F.lane); continue; } r -= I_C;
        if (r < I_O) { p0_transpose_item(F.w_out, D, D, F.WO, nullptr, scr, r, F.lane); continue; } r -= I_O;
        p0_transpose_item(F.w_query, D, PQ, F.WQ, F.norm_ffn, scr, r, F.lane);
    }
    p0_convert(F, F.sub_keys, F.SK, (size_t)PH * 2 * NKEYS * 128, nullptr);
    p0_convert(F, F.expert_u, F.UB, (size_t)NEXP * D, F.norm_ffn);
    p0_convert(F, F.expert_v, F.VB, (size_t)NEXP * D, nullptr);
    for (int m = gw; m < T; m += NGW) p0_row(F, F.x + (size_t)m * D, F.XB + (size_t)m * D, F.RSTD1 + m);
}

namespace pg8 {
DI float sigmoidf_(float v) { return __builtin_amdgcn_rcpf(1.f + __expf(-v)); }
struct EpiProj {
    static constexpr bool PERM = true, AFTER_DRAIN = false;
    bf16_t* PA; bf16_t* G; const float* rstd; const float* bgate;
    DI void operator()(const f32x4 (&acc)[2][2][4][2], const Unit& u, int wr, int wc, int fr, int fq) const {
        const int row0 = u.pm * BM + wr * 64 + fr; const bool gate = u.pn >= 9;
        bf16_t* base = gate ? G : PA; const int ldc = gate ? G_W : PA_W; const int col0 = (gate ? (u.pn - 9) : u.pn) * BM + wc * 32 + 8 * fq;
        f32x4 bv[2][2];
#pragma unroll
        for (int bj = 0; bj < 2; ++bj)
#pragma unroll
            for (int n = 0; n < 2; ++n) bv[bj][n] = gate ? *(const f32x4*)(bgate + col0 + bj * HALF + 4 * n) : (f32x4){0.f, 0.f, 0.f, 0.f};
#pragma unroll
        for (int ai = 0; ai < 2; ++ai)
#pragma unroll
            for (int m = 0; m < 4; ++m) { const int row = row0 + ai * HALF + m * 16; const float rs = rstd[row]; bf16_t* rowp = base + (size_t)row * ldc + col0;
#pragma unroll
                for (int bj = 0; bj < 2; ++bj) { f32x4 v0 = acc[ai][bj][m][0] * rs + bv[bj][0], v1 = acc[ai][bj][m][1] * rs + bv[bj][1];
                    if (gate) {
#pragma unroll
                        for (int j = 0; j < 4; ++j) { v0[j] = sigmoidf_(v0[j]); v1[j] = sigmoidf_(v1[j]); } }
                    u32x4 w; w.x = cvt_pk_bf16(v0[0], v0[1]); w.y = cvt_pk_bf16(v0[2], v0[3]); w.z = cvt_pk_bf16(v1[0], v1[1]); w.w = cvt_pk_bf16(v1[2], v1[3]);
                    *(u32x4*)(rowp + bj * HALF) = w; } }
    }
};
struct EpiMix {
    static constexpr bool PERM = true, AFTER_DRAIN = false;
    bf16_t* MIX; const bf16_t* G;
    DI void operator()(const f32x4 (&acc)[2][2][4][2], const Unit& u, int wr, int wc, int fr, int fq) const {
        const int row0 = u.pm * BM + wr * 64 + fr, col0 = u.pn * BM + wc * 32 + 8 * fq;
#pragma unroll
        for (int ai = 0; ai < 2; ++ai)
#pragma unroll
            for (int m = 0; m < 4; ++m) { const int row = row0 + ai * HALF + m * 16;
#pragma unroll
                for (int bj = 0; bj < 2; ++bj) { const int col = col0 + bj * HALF;
                    const u32x4 gv = *(const u32x4*)(G + (size_t)row * G_W + (u.which ? D : 0) + col);
                    f32x4 v0 = acc[ai][bj][m][0], v1 = acc[ai][bj][m][1];
                    v0[0] *= __builtin_bit_cast(float, gv.x << 16); v0[1] *= __builtin_bit_cast(float, gv.x & 0xffff0000u); v0[2] *= __builtin_bit_cast(float, gv.y << 16); v0[3] *= __builtin_bit_cast(float, gv.y & 0xffff0000u);
                    v1[0] *= __builtin_bit_cast(float, gv.z << 16); v1[1] *= __builtin_bit_cast(float, gv.z & 0xffff0000u); v1[2] *= __builtin_bit_cast(float, gv.w << 16); v1[3] *= __builtin_bit_cast(float, gv.w & 0xffff0000u);
                    bf16_t* p = MIX + (size_t)row * D + col;
                    if (u.which) { const u32x4 o = *(const u32x4*)p;
                        v0[0] += __builtin_bit_cast(float, o.x << 16); v0[1] += __builtin_bit_cast(float, o.x & 0xffff0000u); v0[2] += __builtin_bit_cast(float, o.y << 16); v0[3] += __builtin_bit_cast(float, o.y & 0xffff0000u);
                        v1[0] += __builtin_bit_cast(float, o.z << 16); v1[1] += __builtin_bit_cast(float, o.z & 0xffff0000u); v1[2] += __builtin_bit_cast(float, o.w << 16); v1[3] += __builtin_bit_cast(float, o.w & 0xffff0000u); }
                    u32x4 w; w.x = cvt_pk_bf16(v0[0], v0[1]); w.y = cvt_pk_bf16(v0[2], v0[3]); w.z = cvt_pk_bf16(v1[0], v1[1]); w.w = cvt_pk_bf16(v1[2], v1[3]);
                    *(u32x4*)p = w; } }
    }
};
struct PairOrder : StaticOrder {
    __device__ bool next(int i, Unit& u) const { const bool ok = StaticOrder::next(i >> 1, u); u.which = i & 1; return ok; }
    DI const char* a_base(const Gemm& g, const Unit& u, size_t tstep) const { return (const char*)(u.which ? g.A2 : g.A) + (size_t)u.pm * tstep; }
    DI const char* b_base(const Gemm& g, const Unit& u, size_t tstep) const { return (const char*)(u.which ? g.Bt2 : g.Bt) + (size_t)u.pn * tstep; }
};
struct EpiX1 {
    static constexpr bool PERM = false, AFTER_DRAIN = false;
    const float* x; float* out; bf16_t* XB; float* SSQ;
    DI void operator()(const f32x4 (&acc)[2][2][4][2], const Unit& u, int wr, int wc, int fr, int fq) const {
        const int row0 = u.pm * BM + wr * 64 + fr, col0 = u.pn * BM + wc * 32 + 4 * fq;
#pragma unroll
        for (int ai = 0; ai < 2; ++ai)
#pragma unroll
            for (int m = 0; m < 4; ++m) { const int row = row0 + ai * HALF + m * 16; float ss = 0.f;
#pragma unroll
                for (int bj = 0; bj < 2; ++bj)
#pragma unroll
                    for (int n = 0; n < 2; ++n) { const size_t off = (size_t)row * D + col0 + bj * HALF + n * 16;
                        const f32x4 o = *(const f32x4*)(x + off) + acc[ai][bj][m][n];
                        *(f32x4*)(out + off) = o; ss += (o[0] * o[0] + o[1] * o[1]) + (o[2] * o[2] + o[3] * o[3]);
                        v2u w; w.x = cvt_pk_bf16(o[0], o[1]); w.y = cvt_pk_bf16(o[2], o[3]); *(v2u*)(XB + off) = w; }
                ss += __shfl_xor(ss, 16); ss += __shfl_xor(ss, 32);
                if (fq == 0) SSQ[(size_t)row * 16 + u.pn * 4 + wc] = ss; }
    }
};
DI float rstd2_of(const float* SSQ, int row) {
    const f32x4 a = *(const f32x4*)(SSQ + (size_t)row * 16), b = *(const f32x4*)(SSQ + (size_t)row * 16 + 4), c = *(const f32x4*)(SSQ + (size_t)row * 16 + 8), d = *(const f32x4*)(SSQ + (size_t)row * 16 + 12);
    const float s = ((a[0] + a[1]) + (a[2] + a[3])) + ((b[0] + b[1]) + (b[2] + b[3])) + ((c[0] + c[1]) + (c[2] + c[3])) + ((d[0] + d[1]) + (d[2] + d[3]));
    return 1.f / sqrtf(s * (1.f / D) + EPS);
}
struct EpiQP {
    static constexpr bool PERM = true, AFTER_DRAIN = false;
    bf16_t* QP; const float* SSQ;
    DI void operator()(const f32x4 (&acc)[2][2][4][2], const Unit& u, int wr, int wc, int fr, int fq) const {
        const int row0 = u.pm * BM + wr * 64 + fr, col0 = u.pn * BM + wc * 32 + 8 * fq;
#pragma unroll
        for (int ai = 0; ai < 2; ++ai)
#pragma unroll
            for (int m = 0; m < 4; ++m) { const int row = row0 + ai * HALF + m * 16; const float rs = rstd2_of(SSQ, row); bf16_t* rowp = QP + (size_t)row * PQ + col0;
#pragma unroll
                for (int bj = 0; bj < 2; ++bj) { const f32x4 v0 = acc[ai][bj][m][0] * rs, v1 = acc[ai][bj][m][1] * rs;
                    u32x4 w; w.x = cvt_pk_bf16(v0[0], v0[1]); w.y = cvt_pk_bf16(v0[2], v0[3]); w.z = cvt_pk_bf16(v1[0], v1[1]); w.w = cvt_pk_bf16(v1[2], v1[3]);
                    *(u32x4*)(rowp + bj * HALF) = w; } }
    }
};
}

#define MFMA32(a, b, c) __builtin_amdgcn_mfma_f32_32x32x16_bf16((a), (b), (c), 0, 0, 0)
DI void p2_conv(Frame& F) {
    const size_t NT_ = (size_t)F.G * NWAVES * 64;
    for (size_t item = (size_t)F.vcu * NWAVES * 64 + F.tid; item < (size_t)T * 64; item += NT_) {
        const int t = (int)(item >> 6), c0 = (int)(item & 63) * 8, tl = t & (SEQ - 1);
        float acc[8];
#pragma unroll
        for (int e = 0; e < 8; ++e) acc[e] = 0.f;
#pragma unroll
        for (int j = 0; j < 3; ++j) {
            if (tl - 2 + j >= 0) {
                const bf16* rowp = F.PA + (size_t)(t - 2 + j) * PA_W;
                const v4u cg = *(const GAS v4u*)(rowp + C_C + c0), uu = *(const GAS v4u*)(rowp + C_U + c0);
                const f32x4 w0 = *(const GAS f32x4*)(F.w_conv + j * CONV + c0), w1 = *(const GAS f32x4*)(F.w_conv + j * CONV + c0 + 4);
                acc[0] += w0[0] * (bf_lo(cg.x) * bf_lo(uu.x)); acc[1] += w0[1] * (bf_hi(cg.x) * bf_hi(uu.x));
                acc[2] += w0[2] * (bf_lo(cg.y) * bf_lo(uu.y)); acc[3] += w0[3] * (bf_hi(cg.y) * bf_hi(uu.y));
                acc[4] += w1[0] * (bf_lo(cg.z) * bf_lo(uu.z)); acc[5] += w1[1] * (bf_hi(cg.z) * bf_hi(uu.z));
                acc[6] += w1[2] * (bf_lo(cg.w) * bf_lo(uu.w)); acc[7] += w1[3] * (bf_hi(cg.w) * bf_hi(uu.w));
            }
        }
        const v4u bg = *(const GAS v4u*)(F.PA + (size_t)t * PA_W + C_B + c0);
        v4u o; o.x = pk2(acc[0] * bf_lo(bg.x), acc[1] * bf_hi(bg.x)); o.y = pk2(acc[2] * bf_lo(bg.y), acc[3] * bf_hi(bg.y));
        o.z = pk2(acc[4] * bf_lo(bg.z), acc[5] * bf_hi(bg.z)); o.w = pk2(acc[6] * bf_lo(bg.w), acc[7] * bf_hi(bg.w));
#ifdef ZERO_Z
        o = (v4u){0u, 0u, 0u, 0u};
#endif
        *(GAS v4u*)(F.Z + (size_t)t * CONV + c0) = o;
    }
}
DI int t5_bucket(int d) {
    if (d < 16) return d;
    const int large = 16 + (int)(logf((float)d / 16.f) / logf(8.f) * 16.f);
    return large < 31 ? large : 31;
}
constexpr int KS_STRIDE = 72, VT_STRIDE = 264;
constexpr int ATT_KS = 0, ATT_VT = 256 * KS_STRIDE * 2, ATT_BIAS = ATT_VT + 64 * VT_STRIDE * 2, ATT_END = ATT_BIAS + 4 * 128 * 4;
static_assert(ATT_END <= RING_BYTES, "attention LDS");
DI void p2_attention(Frame& F) {
    LAS bf16* KS = (LAS bf16*)(F.lds + ATT_KS); LAS bf16* VT = (LAS bf16*)(F.lds + ATT_VT); LAS float* BIAS = (LAS float*)(F.lds + ATT_BIAS);
    const int lane = F.lane, r = lane & 31, hh = lane >> 5;
#pragma unroll 1
    for (int unit = F.vcu; unit < 8 * 32 * NKV; unit += F.G) {
        const int kv = unit & 1, n = (unit >> 1) & 31, b = unit >> 6;
        const int t0 = b * SEQ + n * 128;
        __syncthreads();
        {
            const int j = F.tid >> 1, hf = F.tid & 1; const bool valid = (n > 0) || (j >= 128);
            const bf16* rowp = F.PA + (size_t)(t0 - 128 + j) * PA_W;
            v4u kq[4], vq[4];
#pragma unroll
            for (int i = 0; i < 4; ++i) { kq[i] = (v4u){0u, 0u, 0u, 0u}; vq[i] = kq[i]; }
            if (valid) {
#pragma unroll
                for (int i = 0; i < 4; ++i) { kq[i] = *(const GAS v4u*)(rowp + C_K + kv * HD + hf * 32 + i * 8); vq[i] = *(const GAS v4u*)(rowp + C_V + kv * HD + hf * 32 + i * 8); }
            }
            float kf[32]; float ss = 0.f;
#pragma unroll
            for (int i = 0; i < 4; ++i) { kf[8 * i + 0] = bf_lo(kq[i].x); kf[8 * i + 1] = bf_hi(kq[i].x); kf[8 * i + 2] = bf_lo(kq[i].y); kf[8 * i + 3] = bf_hi(kq[i].y);
                kf[8 * i + 4] = bf_lo(kq[i].z); kf[8 * i + 5] = bf_hi(kq[i].z); kf[8 * i + 6] = bf_lo(kq[i].w); kf[8 * i + 7] = bf_hi(kq[i].w); }
#pragma unroll
            for (int e = 0; e < 32; ++e) ss += kf[e] * kf[e];
            ss += __shfl_xor(ss, 1);
            const float rs = 1.f / sqrtf(ss * (1.f / HD) + EPS);
#pragma unroll
            for (int i = 0; i < 4; ++i) { const f32x4 g0 = *(const GAS f32x4*)(F.k_norm + hf * 32 + 8 * i), g1 = *(const GAS f32x4*)(F.k_norm + hf * 32 + 8 * i + 4);
                v4u o; o.x = pk2(kf[8 * i + 0] * rs * g0[0], kf[8 * i + 1] * rs * g0[1]); o.y = pk2(kf[8 * i + 2] * rs * g0[2], kf[8 * i + 3] * rs * g0[3]);
                o.z = pk2(kf[8 * i + 4] * rs * g1[0], kf[8 * i + 5] * rs * g1[1]); o.w = pk2(kf[8 * i + 6] * rs * g1[2], kf[8 * i + 7] * rs * g1[3]);
                *(LAS v4u*)(KS + j * KS_STRIDE + hf * 32 + 8 * i) = o; }
#pragma unroll
            for (int i = 0; i < 4; ++i) { const int d0 = hf * 32 + 8 * i;
                VT[(d0 + 0) * VT_STRIDE + j] = (bf16)(vq[i].x & 0xffffu); VT[(d0 + 1) * VT_STRIDE + j] = (bf16)(vq[i].x >> 16);
                VT[(d0 + 2) * VT_STRIDE + j] = (bf16)(vq[i].y & 0xffffu); VT[(d0 + 3) * VT_STRIDE + j] = (bf16)(vq[i].y >> 16);
                VT[(d0 + 4) * VT_STRIDE + j] = (bf16)(vq[i].z & 0xffffu); VT[(d0 + 5) * VT_STRIDE + j] = (bf16)(vq[i].z >> 16);
                VT[(d0 + 6) * VT_STRIDE + j] = (bf16)(vq[i].w & 0xffffu); VT[(d0 + 7) * VT_STRIDE + j] = (bf16)(vq[i].w >> 16); }
            { const int g = F.tid >> 7, dist = F.tid & 127; BIAS[F.tid] = F.rel_bias[t5_bucket(dist) * NH + kv * 4 + g]; }
        }
        __syncthreads();
#pragma unroll 1
        for (int task = F.wave; task < 16; task += NWAVES) {
            const int g = task >> 2, c = task & 3, head = kv * 4 + g, r0 = 32 * c;
            bf16x8 qf[4];
            {
                const bf16* qp = F.PA + (size_t)(t0 + r0 + r) * PA_W + C_Q + head * HD + 8 * hh;
                v4u qq[4]; float qv[32]; float ss = 0.f;
#pragma unroll
                for (int s = 0; s < 4; ++s) qq[s] = *(const GAS v4u*)(qp + 16 * s);
#pragma unroll
                for (int s = 0; s < 4; ++s) { qv[8 * s + 0] = bf_lo(qq[s].x); qv[8 * s + 1] = bf_hi(qq[s].x); qv[8 * s + 2] = bf_lo(qq[s].y); qv[8 * s + 3] = bf_hi(qq[s].y);
                    qv[8 * s + 4] = bf_lo(qq[s].z); qv[8 * s + 5] = bf_hi(qq[s].z); qv[8 * s + 6] = bf_lo(qq[s].w); qv[8 * s + 7] = bf_hi(qq[s].w); }
#pragma unroll
                for (int e = 0; e < 32; ++e) ss += qv[e] * qv[e];
                ss += __shfl_xor(ss, 32);
                const float rs = 0.125f / sqrtf(ss * (1.f / HD) + EPS);
#pragma unroll
                for (int s = 0; s < 4; ++s) { const f32x4 g0 = *(const GAS f32x4*)(F.q_norm + 16 * s + 8 * hh), g1 = *(const GAS f32x4*)(F.q_norm + 16 * s + 8 * hh + 4);
                    v4u o; o.x = pk2(qv[8 * s + 0] * rs * g0[0], qv[8 * s + 1] * rs * g0[1]); o.y = pk2(qv[8 * s + 2] * rs * g0[2], qv[8 * s + 3] * rs * g0[3]);
                    o.z = pk2(qv[8 * s + 4] * rs * g1[0], qv[8 * s + 5] * rs * g1[1]); o.w = pk2(qv[8 * s + 6] * rs * g1[2], qv[8 * s + 7] * rs * g1[3]);
                    qf[s] = __builtin_bit_cast(bf16x8, o); }
            }
            f32x16 sacc[5];
#pragma unroll
            for (int i5 = 0; i5 < 5; ++i5) {
#pragma unroll
                for (int e = 0; e < 16; ++e) sacc[i5][e] = 0.f;
                const int kt = c + i5;
#pragma unroll
                for (int s = 0; s < 4; ++s) { const bf16x8 ka = *(const LAS bf16x8*)(KS + (32 * kt + r) * KS_STRIDE + 16 * s + 8 * hh); sacc[i5] = MFMA32(ka, qf[s], sacc[i5]); }
            }
            const float sink = F.sinks[head];
            const int dbase = r - 4 * hh + 128;
            const LAS float* bl = BIAS + g * 128;
            float mx = sink;
#pragma unroll
            for (int i5 = 0; i5 < 5; ++i5) {
                const bool tile_ok = (n > 0) || (c + i5 >= 4);
#pragma unroll
                for (int e = 0; e < 16; ++e) { const int dist = dbase - 32 * i5 - ((e & 3) + 8 * (e >> 2));
                    bool valid = tile_ok; if (i5 == 0) valid = valid && (dist < 128); if (i5 == 4) valid = valid && (dist >= 0);
                    const float lg = sacc[i5][e] + bl[dist & 127];
                    sacc[i5][e] = valid ? lg : -INFINITY; mx = fmaxf(mx, sacc[i5][e]); }
                __builtin_amdgcn_sched_barrier(0);
            }
            mx = fmaxf(mx, __shfl_xor(mx, 32));
            float sum = 0.f;
#pragma unroll
            for (int i5 = 0; i5 < 5; ++i5)
#pragma unroll
                for (int e = 0; e < 16; ++e) { const float p = __expf(sacc[i5][e] - mx); sacc[i5][e] = p; sum += p; }
            sum += __shfl_xor(sum, 32);
            const float inv = 1.f / (sum + __expf(sink - mx));
            f32x16 oacc[2];
#pragma unroll
            for (int dt = 0; dt < 2; ++dt)
#pragma unroll
                for (int e = 0; e < 16; ++e) oacc[dt][e] = 0.f;
#pragma unroll
            for (int i5 = 0; i5 < 5; ++i5)
#pragma unroll
                for (int s2 = 0; s2 < 2; ++s2) {
                    v4u pp; pp.x = pk2(sacc[i5][8 * s2 + 0] * inv, sacc[i5][8 * s2 + 1] * inv); pp.y = pk2(sacc[i5][8 * s2 + 2] * inv, sacc[i5][8 * s2 + 3] * inv);
                    pp.z = pk2(sacc[i5][8 * s2 + 4] * inv, sacc[i5][8 * s2 + 5] * inv); pp.w = pk2(sacc[i5][8 * s2 + 6] * inv, sacc[i5][8 * s2 + 7] * inv);
                    const bf16x8 pb = __builtin_bit_cast(bf16x8, pp);
                    const int kb = 32 * (c + i5) + 16 * s2 + 4 * hh;
#pragma unroll
                    for (int dt = 0; dt < 2; ++dt) {
                        const v2u lo = *(const LAS v2u*)(VT + (32 * dt + r) * VT_STRIDE + kb), hi = *(const LAS v2u*)(VT + (32 * dt + r) * VT_STRIDE + kb + 8);
                        v4u va; va.x = lo.x; va.y = lo.y; va.z = hi.x; va.w = hi.y;
                        oacc[dt] = MFMA32(__builtin_bit_cast(bf16x8, va), pb, oacc[dt]);
                    }
                    __builtin_amdgcn_sched_barrier(0);
                }
            bf16* op = F.ATT + (size_t)(t0 + r0 + r) * CONV + head * HD;
#pragma unroll
            for (int dt = 0; dt < 2; ++dt)
#pragma unroll
                for (int g4 = 0; g4 < 4; ++g4) { v2u w; w.x = pk2(oacc[dt][4 * g4 + 0], oacc[dt][4 * g4 + 1]); w.y = pk2(oacc[dt][4 * g4 + 2], oacc[dt][4 * g4 + 3]);
#ifdef ZERO_ATT
                    w.x = 0u; w.y = 0u;
#endif
                    *(GAS v2u*)(op + 32 * dt + 8 * g4 + 4 * hh) = w; }
        }
    }
}

DI unsigned f2ord(float f) { const unsigned b = __builtin_bit_cast(unsigned, f); return b ^ ((b >> 31) ? 0xffffffffu : 0x80000000u); }
DI float ord2f(unsigned k) { const unsigned b = k ^ ((k >> 31) ? 0x80000000u : 0xffffffffu); return __builtin_bit_cast(float, b); }
DI unsigned umax_(unsigned a, unsigned b) { return a > b ? a : b; }
DI unsigned umin_(unsigned a, unsigned b) { return a < b ? a : b; }
DI void sort16_desc(unsigned (&v)[16]) {
#pragma unroll
    for (int k = 2; k <= 16; k <<= 1)
#pragma unroll
        for (int j = k >> 1; j > 0; j >>= 1)
#pragma unroll
            for (int i = 0; i < 16; ++i) { const int l = i ^ j; if (l > i) { const bool desc = ((i & k) == 0) || (k == 16); const unsigned a = v[i], b = v[l], hi = umax_(a, b), lo = umin_(a, b); v[i] = desc ? hi : lo; v[l] = desc ? lo : hi; } }
}
DI void merge_top16(unsigned (&a)[16], const unsigned (&b)[16]) {
#pragma unroll
    for (int i = 0; i < 16; ++i) a[i] = umax_(a[i], b[15 - i]);
#pragma unroll
    for (int j = 8; j > 0; j >>= 1)
#pragma unroll
        for (int i = 0; i < 16; ++i) { const int l = i ^ j; if (l > i) { const unsigned x = a[i], y = a[l]; a[i] = umax_(x, y); a[l] = umin_(x, y); } }
}
constexpr int SK_STRIDE = 136;
constexpr int P6_KEYS = 0, P6_IB = 2 * NKEYS * SK_STRIDE * 2, P6_END = P6_IB + NWAVES * 64 * 32;
static_assert(P6_END <= RING_BYTES, "topk LDS");
DI void p6_topk(Frame& F) {
    LAS bf16* KL = (LAS bf16*)(F.lds + P6_KEYS); LAS unsigned char* IB = F.lds + P6_IB + (F.wave * 64 + F.lane) * 32;
    const int lane = F.lane, r = lane & 31, hh = lane >> 5;
    for (int unit = F.vcu; unit < (T / 256) * PH; unit += F.G) {
        const int h = unit & 7, tile = unit >> 3;
        __syncthreads();
        {
            const bf16* src = F.SK + (size_t)h * 2 * NKEYS * 128;
#pragma unroll
            for (int i = 0; i < 8; ++i) { const int ch = F.tid + 512 * i; const int row = ch >> 4, c8 = (ch & 15) * 8;
                *(LAS v4u*)(KL + row * SK_STRIDE + c8) = *(const GAS v4u*)(src + (size_t)row * 128 + c8); }
        }
        __syncthreads();
        const int t = tile * 256 + F.wave * 32 + r;
        unsigned S[2][16];
#pragma unroll
        for (int p = 0; p < 2; ++p) {
            bf16x8 qf[8];
            const bf16* qp = F.QP + (size_t)t * PQ + h * 256 + p * 128 + 8 * hh;
#pragma unroll
            for (int s = 0; s < 8; ++s) qf[s] = __builtin_bit_cast(bf16x8, *(const GAS v4u*)(qp + 16 * s));
            unsigned key[4][16];
#pragma unroll
            for (int kt = 0; kt < 4; ++kt) {
                f32x16 acc;
#pragma unroll
                for (int e = 0; e < 16; ++e) acc[e] = 0.f;
#pragma unroll
                for (int s = 0; s < 8; ++s) { const bf16x8 ka = *(const LAS bf16x8*)(KL + (p * NKEYS + 32 * kt + r) * SK_STRIDE + 16 * s + 8 * hh); acc = MFMA32(ka, qf[s], acc); }
#pragma unroll
                for (int e = 0; e < 16; ++e) { const int nk = 32 * kt + (e & 3) + 8 * (e >> 2) + 4 * hh; key[kt][e] = (f2ord(acc[e]) & ~127u) | (unsigned)(127 - nk); }
            }
#pragma unroll
            for (int kt = 0; kt < 4; ++kt) sort16_desc(key[kt]);
            merge_top16(key[0], key[1]); merge_top16(key[2], key[3]); merge_top16(key[0], key[2]);
            unsigned other[16];
#pragma unroll
            for (int i = 0; i < 16; ++i) other[i] = (unsigned)__shfl_xor((int)key[0][i], 32);
            merge_top16(key[0], other);
#pragma unroll
            for (int i = 0; i < 16; ++i) S[p][i] = key[0][i];
        }
        float s0[16], s1[16];
#pragma unroll
        for (int i = 0; i < 16; ++i) { s0[i] = ord2f(S[0][i] & ~127u); s1[i] = ord2f(S[1][i] & ~127u); }
        {
#pragma unroll
            for (int q4 = 0; q4 < 4; ++q4) { unsigned w0 = 0, w1 = 0;
#pragma unroll
                for (int e = 0; e < 4; ++e) { w0 |= (127u - (S[0][4 * q4 + e] & 127u)) << (8 * e); w1 |= (127u - (S[1][4 * q4 + e] & 127u)) << (8 * e); }
                *(LAS unsigned*)(IB + 4 * q4) = w0; *(LAS unsigned*)(IB + 16 + 4 * q4) = w1; }
        }
        unsigned cand[4][16];
#pragma unroll
        for (int i = 0; i < 4; ++i)
#pragma unroll
            for (int e = 0; e < 16; ++e) cand[i][e] = 0u;
        {
            int cnt = 0;
#pragma unroll
            for (int a = 0; a < 16; ++a)
#pragma unroll
                for (int b = 0; b < 16; ++b)
                    if ((a + 1) * (b + 1) <= 16) { cand[cnt & 3][cnt >> 2] = (f2ord(s0[a] + s1[b]) & ~255u) | (unsigned)(255 - (a * 16 + b)); ++cnt; }
        }
#pragma unroll
        for (int i = 0; i < 4; ++i) sort16_desc(cand[i]);
        merge_top16(cand[0], cand[1]); merge_top16(cand[2], cand[3]); merge_top16(cand[0], cand[2]);
        float gv[16]; int ev[16]; float gsum = 0.f; const float gmx = ord2f(cand[0][0] & ~255u);
#pragma unroll
        for (int i = 0; i < 16; ++i) { const unsigned k = cand[0][i]; const int pos = 255 - (int)(k & 255u); const int a = pos >> 4, b = pos & 15;
            ev[i] = (int)IB[a] * NKEYS + (int)IB[16 + b]; gv[i] = __expf(ord2f(k & ~255u) - gmx); gsum += gv[i]; }
        float ginv = 1.f / gsum;
#ifdef UNIFORM_GATES
#pragma unroll
        for (int i = 0; i < 16; ++i) gv[i] = 1.f;
        ginv = 1.f / 16.f;
#endif
        if (hh == 0) {
            int* ip = F.IDX + (size_t)t * NSEL + h * TOPK; float* gp = F.GATE + (size_t)t * NSEL + h * TOPK;
#pragma unroll
            for (int i = 0; i < 4; ++i) { *(GAS v4i*)(ip + 4 * i) = (v4i){ev[4 * i], ev[4 * i + 1], ev[4 * i + 2], ev[4 * i + 3]};
                *(GAS f32x4*)(gp + 4 * i) = (f32x4){gv[4 * i] * ginv, gv[4 * i + 1] * ginv, gv[4 * i + 2] * ginv, gv[4 * i + 3] * ginv}; }
        }
    }
}

DI float dot8(v4u a, v4u b, float acc) {
    acc += bf_lo(a.x) * bf_lo(b.x); acc += bf_hi(a.x) * bf_hi(b.x); acc += bf_lo(a.y) * bf_lo(b.y); acc += bf_hi(a.y) * bf_hi(b.y);
    acc += bf_lo(a.z) * bf_lo(b.z); acc += bf_hi(a.z) * bf_hi(b.z); acc += bf_lo(a.w) * bf_lo(b.w); acc += bf_hi(a.w) * bf_hi(b.w);
    return acc;
}
DI void axpy8(float (&acc)[8], float a, v4u v) {
    acc[0] += a * bf_lo(v.x); acc[1] += a * bf_hi(v.x); acc[2] += a * bf_lo(v.y); acc[3] += a * bf_hi(v.y);
    acc[4] += a * bf_lo(v.z); acc[5] += a * bf_hi(v.z); acc[6] += a * bf_lo(v.w); acc[7] += a * bf_hi(v.w);
}
DI void p7_peer(Frame& F) {
    const int lane = F.lane; const int gw = F.vcu * NWAVES + F.wave, NGW = F.G * NWAVES;
    for (int t = gw; t < T; t += NGW) {
        const bf16* xr = F.XB + (size_t)t * D;
        const v4u xa = *(const GAS v4u*)(xr + 8 * lane), xb = *(const GAS v4u*)(xr + 512 + 8 * lane);
        const int id0 = F.IDX[(size_t)t * NSEL + lane], id1 = F.IDX[(size_t)t * NSEL + 64 + lane];
        const float g0 = F.GATE[(size_t)t * NSEL + lane], g1 = F.GATE[(size_t)t * NSEL + 64 + lane];
        const float rs2 = pg8::rstd2_of(F.SSQ, t);
        float accA[8], accB[8];
#pragma unroll
        for (int e = 0; e < 8; ++e) { accA[e] = 0.f; accB[e] = 0.f; }
        for (int bt = 0; bt < 16; ++bt) {
            const int idv = bt < 8 ? id0 : id1; const float gtv = bt < 8 ? g0 : g1;
            v4u ua[8], ub[8], va[8], vb[8];
#pragma unroll
            for (int k = 0; k < 8; ++k) { const int e = __builtin_amdgcn_readlane(idv, (bt * 8 + k) & 63);
                const bf16* up = F.UB + (size_t)e * D; const bf16* vp = F.VB + (size_t)e * D;
                ua[k] = *(const GAS v4u*)(up + 8 * lane); ub[k] = *(const GAS v4u*)(up + 512 + 8 * lane);
                va[k] = *(const GAS v4u*)(vp + 8 * lane); vb[k] = *(const GAS v4u*)(vp + 512 + 8 * lane); }
            float d[8];
#pragma unroll
            for (int k = 0; k < 8; ++k) d[k] = dot8(xb, ub[k], dot8(xa, ua[k], 0.f));
            float w4[4], w2[2], z;
            { const bool b2 = (lane & 4) != 0;
#pragma unroll
              for (int i = 0; i < 4; ++i) { const float send = b2 ? d[i] : d[i + 4], keep = b2 ? d[i + 4] : d[i]; w4[i] = keep + __shfl_xor(send, 4); } }
            { const bool b1 = (lane & 2) != 0;
#pragma unroll
              for (int i = 0; i < 2; ++i) { const float send = b1 ? w4[i] : w4[i + 2], keep = b1 ? w4[i + 2] : w4[i]; w2[i] = keep + __shfl_xor(send, 2); } }
            { const bool b0 = (lane & 1) != 0; const float send = b0 ? w2[0] : w2[1], keep = b0 ? w2[1] : w2[0]; z = keep + __shfl_xor(send, 1); }
            z += __shfl_xor(z, 8); z += __shfl_xor(z, 16); z += __shfl_xor(z, 32);
            const float gt = __shfl(gtv, (bt * 8 + (lane & 7)) & 63);
            const float pre = z * rs2;
            const float act = 0.5f * pre * (1.f + erff(pre * 0.70710678118f)) * gt * PEER_ALPHA;
#pragma unroll
            for (int k = 0; k < 8; ++k) { const float ak = __builtin_bit_cast(float, __builtin_amdgcn_readlane(__builtin_bit_cast(int, act), k)); axpy8(accA, ak, va[k]); axpy8(accB, ak, vb[k]); }
        }
        float* op = F.out + (size_t)t * D;
        { f32x4 o0 = *(const GAS f32x4*)(op + 8 * lane), o1 = *(const GAS f32x4*)(op + 8 * lane + 4);
          o0 = o0 + (f32x4){accA[0], accA[1], accA[2], accA[3]}; o1 = o1 + (f32x4){accA[4], accA[5], accA[6], accA[7]};
          *(GAS f32x4*)(op + 8 * lane) = o0; *(GAS f32x4*)(op + 8 * lane + 4) = o1; }
        { f32x4 o0 = *(const GAS f32x4*)(op + 512 + 8 * lane), o1 = *(const GAS f32x4*)(op + 512 + 8 * lane + 4);
          o0 = o0 + (f32x4){accB[0], accB[1], accB[2], accB[3]}; o1 = o1 + (f32x4){accB[4], accB[5], accB[6], accB[7]};
          *(GAS f32x4*)(op + 512 + 8 * lane) = o0; *(GAS f32x4*)(op + 512 + 8 * lane + 4) = o1; }
    }
}

struct Args { const float* in[17]; float* out; unsigned char* ws; int ph_lo, ph_hi, li, pad; };
__global__ void __launch_bounds__(NWAVES * 64, 2) hyb_fwd(Args args) {
    extern __shared__ __attribute__((aligned(16))) unsigned char lds[];
    Frame F;
    F.lds = (LAS unsigned char*)lds;
    F.MISC = (volatile LAS unsigned*)(F.lds + MISC_OFF);
    F.tid = threadIdx.x; F.lane = F.tid & 63; F.wave = __builtin_amdgcn_readfirstlane(F.tid >> 6);
    F.G = gridDim.x; { const int bx = blockIdx.x; F.vcu = (F.G % 8 == 0) ? (bx % 8) * (F.G / 8) + bx / 8 : bx; }
    unsigned char* ws = args.ws;
    F.ctl = (gu32*)(ws + WS_CTL);
    F.x = args.in[0]; F.norm_mix = args.in[1]; F.norm_ffn = args.in[2]; F.w_in = args.in[3]; F.b_gate = args.in[4]; F.w_conv = args.in[5]; F.q_norm = args.in[6]; F.k_norm = args.in[7];
    F.sinks = args.in[8]; F.rel_bias = args.in[9]; F.w_conv_out = args.in[10]; F.w_attn_out = args.in[11]; F.w_out = args.in[12]; F.w_query = args.in[13]; F.sub_keys = args.in[14];
    F.expert_u = args.in[15]; F.expert_v = args.in[16]; F.out = args.out;
    F.WIN = (bf16*)(ws + WS_WIN); F.WC = (bf16*)(ws + WS_WC); F.WA = (bf16*)(ws + WS_WA); F.WO = (bf16*)(ws + WS_WO); F.WQ = (bf16*)(ws + WS_WQ); F.SK = (bf16*)(ws + WS_SK);
    F.UB = (bf16*)(ws + WS_UB); F.VB = (bf16*)(ws + WS_VB); F.XB = (bf16*)(ws + WS_XB); F.PA = (bf16*)(ws + WS_PA); F.MIX = (bf16*)(ws + WS_MIX); F.G_ = (bf16*)(ws + WS_G); F.QP = (bf16*)(ws + WS_QP);
    F.Z = (bf16*)(ws + WS_Z); F.ATT = (bf16*)(ws + WS_ATT); F.RSTD1 = (float*)(ws + WS_RSTD1); F.SSQ = (float*)(ws + WS_SSQ); F.GATE = (float*)(ws + WS_GATE); F.IDX = (int*)(ws + WS_IDX);
    for (int u = F.tid; u < (LDS_BYTES - LDSCTL_OFF) / 4; u += NWAVES * 64) ((LAS unsigned*)(F.lds + LDSCTL_OFF))[u] = 0u;
    __syncthreads();
    XcdBarrier bar; bar.bar = (unsigned*)(F.ctl + CW_BAR); bar.x = 0; bar.st = nullptr;
    const int lo = args.ph_lo, hi = args.ph_hi;
    if (hi - lo > 1) bar = xcd_barrier_post((unsigned*)(F.ctl + CW_BAR), F.MISC + 8);
#ifndef PH_MASK
#define PH_MASK 0xff
#endif
#define IN(k) (((PH_MASK >> (k)) & 1) && lo <= (k) && (k) < hi)
#define SEAM(k) do { if (IN(k) && IN((k) + 1)) xcd_barrier(bar); } while (0)

    if (IN(0)) { p0_prologue(F); SEAM(0); }
    if (IN(1)) {
        pg8::Gemm g{F.XB, F.WIN, nullptr, nullptr, T, IN_DIM, D}; pg8::StaticOrder S; S.init(T, IN_DIM, F.G, (int)blockIdx.x);
        pg8::EpiProj E{F.PA, F.G_, F.RSTD1, F.b_gate};
        pg8::gemm_phase<pg8::EpiProj, pg8::StaticOrder, PG8_ALIGN, PG8_SP2>(F.lds + RING_OFF, g, S, E);
        SEAM(1);
    }
    if (IN(2)) {
#ifndef NO_CONV
        p2_conv(F);
#endif
#ifndef NO_ATT
        p2_attention(F);
#endif
        SEAM(2); }
    if (IN(3)) {
        pg8::Gemm g{F.Z, F.WC, F.ATT, F.WA, T, D, CONV}; pg8::PairOrder S; S.init(T, D, F.G, (int)blockIdx.x);
        pg8::EpiMix E{F.MIX, F.G_};
        pg8::gemm_phase<pg8::EpiMix, pg8::PairOrder, PG8_ALIGN, PG8_SP2>(F.lds + RING_OFF, g, S, E);
        SEAM(3);
    }
    if (IN(4)) {
        pg8::Gemm g{F.MIX, F.WO, nullptr, nullptr, T, D, D}; pg8::StaticOrder S; S.init(T, D, F.G, (int)blockIdx.x);
        pg8::EpiX1 E{F.x, F.out, F.XB, F.SSQ};
        pg8::gemm_phase<pg8::EpiX1, pg8::StaticOrder, PG8_ALIGN, PG8_SP2>(F.lds + RING_OFF, g, S, E);
        SEAM(4);
    }
    if (IN(5)) {
        pg8::Gemm g{F.XB, F.WQ, nullptr, nullptr, T, PQ, D}; pg8::StaticOrder S; S.init(T, PQ, F.G, (int)blockIdx.x);
        pg8::EpiQP E{F.QP, F.SSQ};
        pg8::gemm_phase<pg8::EpiQP, pg8::StaticOrder, PG8_ALIGN, PG8_SP2>(F.lds + RING_OFF, g, S, E);
        SEAM(5);
    }
    if (IN(6)) { p6_topk(F); SEAM(6); }
    if (IN(7)) { p7_peer(F); }
#undef IN
#undef SEAM
}

extern "C" void kernel_launch(void* const* d_in, const int* in_sizes, int n_in, void* d_out, int out_size, void* d_ws, size_t ws_size, hipStream_t stream) {
    static int grid = 0;
    if (grid == 0) {
        if (n_in != 17 || in_sizes[0] != T * D || out_size != T * D || ws_size < WS_END) { fprintf(stderr, "kernel_launch: unexpected shapes (n_in %d, in0 %d, out %d, ws %zu)\n", n_in, n_in > 0 ? in_sizes[0] : -1, out_size, ws_size); grid = -1; return; }
        int dev = 0, cus = 0, per_cu = 0;
        if (hipGetDevice(&dev) != hipSuccess || hipDeviceGetAttribute(&cus, hipDeviceAttributeMultiprocessorCount, dev) != hipSuccess) { grid = -1; return; }
        if (hipFuncSetAttribute((const void*)hyb_fwd, hipFuncAttributeMaxDynamicSharedMemorySize, LDS_BYTES) != hipSuccess) { fprintf(stderr, "kernel_launch: hipFuncSetAttribute failed\n"); grid = -1; return; }
        if (hipOccupancyMaxActiveBlocksPerMultiprocessor(&per_cu, (const void*)hyb_fwd, NWAVES * 64, LDS_BYTES) != hipSuccess || per_cu < 1) { fprintf(stderr, "kernel_launch: occupancy query says %d blocks per CU\n", per_cu); (void)hipGetLastError(); grid = -1; return; }
        grid = cus * 1;
    }
    if (grid < 0) return;
    if (hipMemsetAsync((char*)d_ws + WS_CTL, 0, CTL_ZERO_BYTES, stream) != hipSuccess) { fprintf(stderr, "kernel_launch: memset failed\n"); return; }
    Args a{};
    for (int i = 0; i < 17; ++i) a.in[i] = (const float*)d_in[i];
    a.out = (float*)d_out; a.ws = (unsigned char*)d_ws;
#if MK_ONE_LAUNCH
    a.ph_lo = 0; a.ph_hi = N_PHASES; a.li = 0;
    void* kargs[] = {&a};
    const hipError_t le = hipLaunchCooperativeKernel((const void*)hyb_fwd, dim3(grid), dim3(NWAVES * 64), kargs, LDS_BYTES, stream);
    if (le != hipSuccess) fprintf(stderr, "kernel_launch: cooperative launch failed: %s (grid %d)\n", hipGetErrorName(le), grid);
#else
    for (int li = 0; li < N_PHASES; ++li) {
        a.ph_lo = li; a.ph_hi = li + 1; a.li = li;
        hipLaunchKernelGGL(hyb_fwd, dim3(grid), dim3(NWAVES * 64), LDS_BYTES, stream, a);
        const hipError_t le = hipPeekAtLastError();
        if (le != hipSuccess) { fprintf(stderr, "kernel_launch: launch %d failed: %s\n", li, hipGetErrorName(le)); break; }
    }
#endif
}
```

```cpp
#include <hip/hip_runtime.h>
#include <hip/hip_cooperative_groups.h>
#include <cstdio>
#include <cstdint>
namespace pg8 {
#define PG8_LAS __attribute__((address_space(3)))
typedef unsigned short bf16_t;
typedef short bf16x8 __attribute__((ext_vector_type(8)));
typedef float f32x4 __attribute__((ext_vector_type(4)));
typedef unsigned u32x4 __attribute__((ext_vector_type(4)));
typedef unsigned u32x2 __attribute__((ext_vector_type(2)));
constexpr int BM = 256, BK = 64, HALF = 128, HTB = HALF * BK * 2  , STAGE_BYTES = 8 * HTB, NXCD = 8, WGM = 8;

__host__ __device__ __forceinline__ int lds_byte(int r, int c) { const int st = (r >> 4) * 2 + (c >> 5), rr = r & 15, cc = c & 31, ob = rr * 64 + cc * 2; return st * 1024 + (ob ^ (((ob >> 9) & 1) << 5)); }
__host__ __device__ __forceinline__ void stage_rc(int b, int& R, int& C) { const int st = b / 1024, sb = b % 1024, swz = sb ^ (((sb >> 9) & 1) << 5); R = (st >> 1) * 16 + swz / 64; C = (st & 1) * 32 + (swz % 64) / 2; }
__host__ __device__ __forceinline__ int perm32(int rho) { const int n = rho >> 4, i = rho & 15; return 8 * (i >> 2) + 4 * n + (i & 3); }

struct Unit { int pm, pn, which; };
struct Gemm { const bf16_t* A; const bf16_t* Bt; const bf16_t* A2; const bf16_t* Bt2; int M, N, K; };

struct StaticOrder {
    static constexpr bool AFRAG = false;
    int nM, nN, nwg, G, c;
    __host__ __device__ void init(int M, int N, int G_, int c_) { nM = M / BM; nN = N / BM; nwg = nM * nN; G = G_; c = c_; }
    __host__ __device__ bool next(int i, Unit& u) const {
        const long L = (long)i * G + c; if (L >= nwg) return false;
        int wgid = (int)L; { const int q = nwg / NXCD, r = nwg % NXCD, xcd = wgid % NXCD, off = wgid / NXCD; wgid = (xcd < r ? xcd * (q + 1) : r * (q + 1) + (xcd - r) * q) + off; }
        const int nig = WGM * nN, gid = wgid / nig, fm = gid * WGM, gsz = (nM - fm) < WGM ? (nM - fm) : WGM;
        u.pm = fm + ((wgid % nig) % gsz); u.pn = (wgid % nig) / gsz; u.which = 0; return true;
    }
    __device__ __forceinline__ const char* a_base(const Gemm& g, const Unit& u, size_t tstep) const { return (const char*)g.A + (size_t)u.pm * tstep; }
    __device__ __forceinline__ const char* b_base(const Gemm& g, const Unit& u, size_t tstep) const { return (const char*)g.Bt + (size_t)u.pn * tstep; }
    __device__ __forceinline__ void a_ready(const Unit&) const {}
    __device__ __forceinline__ void done(const Unit&) const {}
};

__device__ __forceinline__ unsigned cvt_pk_bf16(float lo, float hi) { unsigned r; asm volatile("v_cvt_pk_bf16_f32 %0, %1, %2" : "=v"(r) : "v"(lo), "v"(hi)); return r; }
__device__ __forceinline__ void store16_wt(void* p, u32x4 v) { asm volatile("global_store_dwordx4 %0, %1, off sc1\n\ts_nop 1" :: "v"(p), "v"(v) : "memory"); }
__device__ __forceinline__ void store8_wt(void* p, u32x2 v) { asm volatile("global_store_dwordx2 %0, %1, off sc1\n\ts_nop 1" :: "v"(p), "v"(v) : "memory"); }
typedef float f32x2 __attribute__((ext_vector_type(2)));
__device__ __forceinline__ f32x2 gelu_pk(f32x2 v) {
    const f32x2 av = __builtin_elementwise_abs(v), d = av * 0.2316418882f + 1.0f;
    f32x2 t; t.x = __builtin_amdgcn_rcpf(d.x); t.y = __builtin_amdgcn_rcpf(d.y);
    f32x2 q = t * 0.5307027145f + (-0.7265760135f); q = q * t + 0.7107068705f; q = q * t + (-0.142248368f); q = q * t + 0.127414796f; q = q * t;
    const f32x2 s = (v * v) * (-0.72134752044f);
    f32x2 e; e.x = __builtin_amdgcn_exp2f(s.x); e.y = __builtin_amdgcn_exp2f(s.y);
    const f32x2 m = v * (q * e), r = v - m;
    f32x2 o; o.x = v.x < 0.f ? m.x : r.x; o.y = v.y < 0.f ? m.y : r.y; return o;
}

template <class Epi, class Sched, bool ALIGN_EPI = false, bool SP2 = false>
__device__ __forceinline__ void gemm_phase(PG8_LAS unsigned char* lds, const Gemm g, const Sched& S, const Epi& E) {
    const int tid = threadIdx.x, wid = __builtin_amdgcn_readfirstlane(tid >> 6), lane = tid & 63, wr = wid >> 2, wc = wid & 3, fr = lane & 15, fq = lane >> 4;
    const int K = g.K, nt = K / BK;
    unsigned voffA[2], voffB[2];
#pragma unroll
    for (int i = 0; i < 2; ++i) { int R, C; stage_rc(tid * 16 + i * 8192, R, C); const int Rb = Epi::PERM ? ((R & ~31) + perm32(R & 31)) : R;
        voffA[i] = Sched::AFRAG ? (unsigned)((((((R >> 6) * 4 + (C >> 5)) * 16 + ((R >> 4) & 3) * 2) * 64) + ((C & 31) >> 3) * 16 + (R & 15)) * 16) : (unsigned)(R * K + C) * 2u;
        voffB[i] = (unsigned)(Rb * K + C) * 2u; }
#define PG8_AP(base, h, kt) (Sched::AFRAG ? (base) + ((((size_t)((kt) >> 2) * 8 + ((kt) & 1) * 2) * 16 + (h) * 8 + (((kt) >> 1) & 1)) * 64) * 16 : (base) + (size_t)(h) * hstep + (size_t)(kt) * kstep)
    const size_t kstep = (size_t)(BK * 2);
    const size_t hstep = (size_t)HALF * K * 2;
    const size_t tstep = 2 * hstep;
    const unsigned ldsw = (unsigned)wid * 1024u;
    const int aoff = lds_byte(wr * 64 + fr, fq * 8), boff = lds_byte(wc * 32 + fr, fq * 8);
#define PG8_SA(b, h) (((b) * 2 + (h)) * HTB)
#define PG8_SB(b, h) ((4 + (b) * 2 + (h)) * HTB)
#define PG8_STAGE(bufoff, gbase, voff) do { _Pragma("unroll") for (int _i = 0; _i < 2; ++_i) \
        __builtin_amdgcn_global_load_lds((const unsigned*)((const char*)(gbase) + (voff)[_i]), (PG8_LAS unsigned*)(lds + (bufoff) + ldsw + _i * 8192), 16, 0, 0); } while (0)
#define PG8_LDA(dst, b, h) do { _Pragma("unroll") for (int m = 0; m < 4; ++m) _Pragma("unroll") for (int k = 0; k < 2; ++k) dst[m][k] = *(const PG8_LAS bf16x8*)(lds + PG8_SA(b, h) + aoff + m * 2048 + k * 1024); } while (0)
#define PG8_LDB(dst, b, h) do { _Pragma("unroll") for (int n = 0; n < 2; ++n) _Pragma("unroll") for (int k = 0; k < 2; ++k) dst[n][k] = *(const PG8_LAS bf16x8*)(lds + PG8_SB(b, h) + boff + n * 2048 + k * 1024); } while (0)
#define PG8_MMA(ai, bj, At, Bt) do { __builtin_amdgcn_s_setprio(1); _Pragma("unroll") for (int m = 0; m < 4; ++m) _Pragma("unroll") for (int n = 0; n < 2; ++n) _Pragma("unroll") for (int k = 0; k < 2; ++k) \
        acc[ai][bj][m][n] = __builtin_amdgcn_mfma_f32_16x16x32_bf16(Bt[n][k], At[m][k], acc[ai][bj][m][n], 0, 0, 0); __builtin_amdgcn_s_setprio(0); } while (0)
#define PG8_WAIT_V(n) asm volatile("s_waitcnt vmcnt(" #n ")" ::: "memory")
#define PG8_WAIT_L(n) asm volatile("s_waitcnt lgkmcnt(" #n ")" ::: "memory")
#define PG8_BAR __builtin_amdgcn_s_barrier()
#define PG8_SCHED __builtin_amdgcn_sched_barrier(0)
    Unit cur, nxt; int ui = 0;
    if (!S.next(0, cur)) return;
    f32x4 acc[2][2][4][2];
#pragma unroll
    for (int a = 0; a < 2; ++a)
#pragma unroll
        for (int b = 0; b < 2; ++b)
#pragma unroll
            for (int m = 0; m < 4; ++m)
#pragma unroll
                for (int n = 0; n < 2; ++n) acc[a][b][m][n] = (f32x4){0.f, 0.f, 0.f, 0.f};
    if constexpr (Epi::HAS_INIT) E.init(acc, cur, wr, wc, fr, fq);
    bf16x8 At[4][2], B0[2][2], B1[2][2];
    const char* cA = S.a_base(g, cur, tstep); const char* cB = S.b_base(g, cur, tstep);
    S.a_ready(cur);
    if constexpr (SP2) {
        PG8_STAGE(PG8_SB(0, 0), cB, voffB); PG8_STAGE(PG8_SB(0, 1), cB + hstep, voffB); PG8_STAGE(PG8_SA(0, 0), PG8_AP(cA, 0, 0), voffA); PG8_STAGE(PG8_SA(0, 1), PG8_AP(cA, 1, 0), voffA);
        if (wr == 1) PG8_BAR;
        PG8_WAIT_V(2); PG8_BAR;
        PG8_STAGE(PG8_SB(1, 0), cB + kstep, voffB); PG8_STAGE(PG8_SA(1, 0), PG8_AP(cA, 0, 1), voffA); PG8_STAGE(PG8_SB(1, 1), cB + hstep + kstep, voffB);
        PG8_WAIT_V(6); PG8_BAR;
    } else {
        PG8_STAGE(PG8_SB(0, 0), cB, voffB); PG8_STAGE(PG8_SA(0, 0), PG8_AP(cA, 0, 0), voffA); PG8_STAGE(PG8_SB(0, 1), cB + hstep, voffB); PG8_STAGE(PG8_SA(0, 1), PG8_AP(cA, 1, 0), voffA);
        if (wr == 1) PG8_BAR;
        PG8_WAIT_V(4); PG8_BAR;
        PG8_STAGE(PG8_SB(1, 0), cB + kstep, voffB); PG8_STAGE(PG8_SA(1, 0), PG8_AP(cA, 0, 1), voffA); PG8_STAGE(PG8_SB(1, 1), cB + hstep + kstep, voffB);
        PG8_WAIT_V(6); PG8_BAR;
    }
    for (;;) {
        const bool has_next = S.next(ui + 1, nxt);
        const char* nA = has_next ? S.a_base(g, nxt, tstep) : cA; const char* nB = has_next ? S.b_base(g, nxt, tstep) : cB;
        for (int t = 0; t < nt; t += 2) {
            const bool last = (t == nt - 2);
            const char* a2b = last ? nA : cA; const int a2k = last ? 0 : t + 2; const char* b2 = last ? nB : cB + (size_t)(t + 2) * kstep;
            const char* b3 = b2 + kstep;
            const char* a1h = PG8_AP(cA, 1, t + 1); const char* a2 = PG8_AP(a2b, 0, a2k); const char* a2h = PG8_AP(a2b, 1, a2k); const char* a3 = PG8_AP(a2b, 0, a2k + 1);
            if (last && has_next) S.a_ready(nxt);
            if constexpr (SP2) {
            PG8_LDB(B0, 0, 0); PG8_LDB(B1, 0, 1); PG8_SCHED; PG8_LDA(At, 0, 0); PG8_STAGE(PG8_SA(1, 1), a1h, voffA);
            PG8_WAIT_V(8); PG8_WAIT_L(0); PG8_BAR; PG8_MMA(0, 0, At, B0); PG8_MMA(0, 1, At, B1); PG8_BAR; PG8_SCHED;
            PG8_LDA(At, 0, 1); PG8_STAGE(PG8_SB(0, 0), b2, voffB); PG8_STAGE(PG8_SB(0, 1), b2 + hstep, voffB); PG8_STAGE(PG8_SA(0, 0), a2, voffA);
            PG8_WAIT_V(8); PG8_WAIT_L(0); PG8_BAR; PG8_MMA(1, 0, At, B0); PG8_MMA(1, 1, At, B1); PG8_BAR; PG8_SCHED;
            PG8_LDB(B0, 1, 0); PG8_LDB(B1, 1, 1); PG8_SCHED; PG8_LDA(At, 1, 0); PG8_STAGE(PG8_SA(0, 1), a2h, voffA);
            PG8_WAIT_V(8); PG8_WAIT_L(0); PG8_BAR; PG8_MMA(0, 0, At, B0); PG8_MMA(0, 1, At, B1); PG8_BAR; PG8_SCHED;
            PG8_LDA(At, 1, 1); PG8_STAGE(PG8_SB(1, 0), b3, voffB); PG8_STAGE(PG8_SB(1, 1), b3 + hstep, voffB); PG8_STAGE(PG8_SA(1, 0), a3, voffA);
            PG8_WAIT_V(8); PG8_WAIT_L(0); PG8_BAR; PG8_MMA(1, 0, At, B0); PG8_MMA(1, 1, At, B1); PG8_BAR; PG8_SCHED;
            } else {
            PG8_LDB(B0, 0, 0); PG8_SCHED; PG8_LDA(At, 0, 0); PG8_STAGE(PG8_SA(1, 1), a1h, voffA);
            PG8_WAIT_L(8); PG8_BAR; PG8_WAIT_L(0); PG8_MMA(0, 0, At, B0); PG8_BAR; PG8_SCHED;
            PG8_LDB(B1, 0, 1); PG8_STAGE(PG8_SB(0, 0), b2, voffB);
            PG8_BAR; PG8_WAIT_L(0); PG8_MMA(0, 1, At, B1); PG8_BAR;
            PG8_LDA(At, 0, 1); PG8_STAGE(PG8_SA(0, 0), a2, voffA);
            PG8_BAR; PG8_WAIT_L(0); PG8_MMA(1, 0, At, B0); PG8_BAR; PG8_SCHED;
            PG8_STAGE(PG8_SB(0, 1), b2 + hstep, voffB);
            PG8_WAIT_V(6); PG8_BAR; PG8_MMA(1, 1, At, B1); PG8_BAR;
            PG8_LDB(B0, 1, 0); PG8_SCHED; PG8_LDA(At, 1, 0); PG8_STAGE(PG8_SA(0, 1), a2h, voffA);
            PG8_WAIT_L(8); PG8_BAR; PG8_WAIT_L(0); PG8_MMA(0, 0, At, B0); PG8_BAR; PG8_SCHED;
            PG8_LDB(B1, 1, 1); PG8_STAGE(PG8_SB(1, 0), b3, voffB);
            PG8_BAR; PG8_WAIT_L(0); PG8_MMA(0, 1, At, B1); PG8_BAR;
            PG8_LDA(At, 1, 1); PG8_STAGE(PG8_SA(1, 0), a3, voffA);
            PG8_BAR; PG8_WAIT_L(0); PG8_MMA(1, 0, At, B0); PG8_BAR; PG8_SCHED;
            PG8_STAGE(PG8_SB(1, 1), b3 + hstep, voffB);
            PG8_WAIT_V(6); PG8_BAR; PG8_MMA(1, 1, At, B1); PG8_BAR;
            }
        }
        if constexpr (ALIGN_EPI) { if (wr == 0) PG8_BAR; }
        if constexpr (!Epi::AFTER_DRAIN) { E(acc, cur, wr, wc, fr, fq); S.done(cur); }
        if (!has_next) break;
#pragma unroll
        for (int a = 0; a < 2; ++a)
#pragma unroll
            for (int b = 0; b < 2; ++b)
#pragma unroll
                for (int m = 0; m < 4; ++m)
#pragma unroll
                    for (int n = 0; n < 2; ++n) acc[a][b][m][n] = (f32x4){0.f, 0.f, 0.f, 0.f};
        if constexpr (Epi::HAS_INIT) E.init(acc, nxt, wr, wc, fr, fq);
        cur = nxt; cA = nA; cB = nB; ++ui;
        if constexpr (ALIGN_EPI) { if (wr == 1) PG8_BAR; }
    }
    PG8_WAIT_V(0);
    if constexpr (!ALIGN_EPI) { if (wr == 0) PG8_BAR; }
    PG8_BAR;
    if constexpr (Epi::AFTER_DRAIN) { E.fused(acc, cur, wr, wc, fr, fq, lds, wid, lane); S.done(cur); }
#undef PG8_AP
#undef PG8_SA
#undef PG8_SB
#undef PG8_STAGE
#undef PG8_LDA
#undef PG8_LDB
#undef PG8_MMA
#undef PG8_WAIT_V
#undef PG8_WAIT_L
#undef PG8_BAR
#undef PG8_SCHED
}
}

#ifndef PG8_SP2
#define PG8_SP2 true
#endif
#ifndef PG8_ALIGN
#define PG8_ALIGN true
#endif
#ifndef MK_ONE_LAUNCH
#define MK_ONE_LAUNCH 1
#endif

constexpr int NWAVES = 8;
constexpr int T = 32768, D = 1024, SEQ = 4096;
constexpr int IN_DIM = 4352, PA_W = 2304, G_W = 2048;
constexpr int C_U = 0, C_B = 512, C_C = 1024, C_Q = 1536, C_K = 2048, C_V = 2176;
constexpr int CONV = 512, HD = 64, NH = 8, NKV = 2;
constexpr int PH = 8, NKEYS = 128, PQ = 2048, TOPK = 16, NEXP = 16384, NSEL = 128;
constexpr float EPS = 1e-6f;
constexpr int N_PHASES = 10;

constexpr size_t MiB = 1u << 20;
constexpr size_t WS_CTL = 0, CTL_ZERO_BYTES = 64 * 1024;
constexpr size_t WS_WIN = 2 * MiB;
constexpr size_t WS_WC = 11 * MiB;
constexpr size_t WS_WA = 12 * MiB;
constexpr size_t WS_WO = 13 * MiB;
constexpr size_t WS_WQ = 15 * MiB;
constexpr size_t WS_SK = 19 * MiB;
constexpr size_t WS_RSTD1 = 20 * MiB;
constexpr size_t WS_SSQ = 21 * MiB;
constexpr size_t WS_UB = 24 * MiB;
constexpr size_t WS_VB = 56 * MiB;
constexpr size_t WS_XB = 88 * MiB;
constexpr size_t WS_PA = 152 * MiB;
constexpr size_t WS_MIX = WS_PA;
constexpr size_t WS_G = 296 * MiB;
constexpr size_t WS_QP = WS_G;
constexpr size_t WS_Z = 424 * MiB;
constexpr size_t WS_ATT = 456 * MiB;
constexpr size_t WS_IDX = WS_Z, WS_GATE = WS_ATT;
constexpr size_t WS_PART = WS_PA;
constexpr size_t WS_ACT = WS_G;
constexpr size_t WS_END = 488 * MiB;
constexpr int CW_BAR = 4096;

constexpr int RING_OFF = 0, RING_BYTES = 131072;
constexpr int LDSCTL_OFF = 147456, MISC_OFF = LDSCTL_OFF + 320;
constexpr int LDS_BYTES = 148480;
#define GAS __attribute__((address_space(1)))
#define LAS __attribute__((address_space(3)))
typedef unsigned short bf16;
typedef unsigned v4u __attribute__((ext_vector_type(4)));
typedef float f32x4 __attribute__((ext_vector_type(4)));
typedef short bf16x8 __attribute__((ext_vector_type(8)));
typedef GAS unsigned gu32;
typedef GAS unsigned long long gu64;
#define RLX_AGENT __ATOMIC_RELAXED, __HIP_MEMORY_SCOPE_AGENT
#define LDS_WAIT() asm volatile("s_waitcnt lgkmcnt(0)" ::: "memory")
#define VM_WAIT() asm volatile("s_waitcnt vmcnt(0)" ::: "memory")
__device__ __forceinline__ unsigned long long rt() { return __builtin_amdgcn_s_memrealtime(); }
__device__ __forceinline__ unsigned f2bf(float f) { unsigned u = __builtin_bit_cast(unsigned, f); return (u + 0x7fffu + ((u >> 16) & 1u)) >> 16; }
__device__ __forceinline__ unsigned pk2(float lo, float hi) { return f2bf(lo) | (f2bf(hi) << 16); }

#define XB_TMO      128
#define XB_XCNT(j)  (256  + 64 * (j))
#define XB_XSUB(j)  (1280 + 64 * (j))
#define XB_XGEN(j)  (2304 + 64 * (j))
#define XB_TOP      3328
#define XB_TOPGEN   3392
#define XCD_BAR_WORDS 3456
#define XB_SPIN_CAP (1u << 18)

__device__ __forceinline__ unsigned xb_ld(unsigned* p)              { return __hip_atomic_load(p, __ATOMIC_RELAXED, __HIP_MEMORY_SCOPE_AGENT); }
__device__ __forceinline__ unsigned xb_add(unsigned* p, unsigned v) { return __hip_atomic_fetch_add(p, v, __ATOMIC_RELAXED, __HIP_MEMORY_SCOPE_AGENT); }
__device__ __forceinline__ unsigned xb_xcc_id() { return (unsigned)__builtin_amdgcn_s_getreg((3 << 11) | 20) & 0xFu; }
#define XB_SPIN(cond, bar) do { unsigned _sp = 0; while (cond) { __builtin_amdgcn_s_sleep(1); \
    if ((++_sp & 255u) == 0u) { if (xb_ld(&(bar)[XB_TMO])) break; if (_sp > XB_SPIN_CAP) { atomicAdd(&(bar)[XB_TMO], 1u); break; } } } } while (0)

struct XcdBarrier {
    unsigned* bar; unsigned x;
    volatile LAS unsigned* st;
};

__device__ __forceinline__ XcdBarrier xcd_barrier_post(unsigned* bar, volatile LAS unsigned* st) {
    XcdBarrier b; b.bar = bar; b.x = xb_xcc_id(); b.st = st;
    if (threadIdx.x == 0) st[2] = xb_add(&bar[XB_XCNT(b.x)], 1u);
    return b;
}
__device__ __forceinline__ void xcd_barrier_complete(unsigned* bar, unsigned x, unsigned& nloc, unsigned& nx) {
    const unsigned G = gridDim.x * gridDim.y * gridDim.z;
    unsigned sum, cnt, mine, sp = 0u;
    for (;;) {
        sum = 0u; cnt = 0u; mine = 0u;
#pragma unroll
        for (unsigned j = 0; j < 16; ++j) { const unsigned c = xb_ld(&bar[XB_XCNT(j)]); sum += c; cnt += (c > 0u) ? 1u : 0u; mine = (j == x) ? c : mine; }
        if (sum == G) break;
        __builtin_amdgcn_s_sleep(1);
        if ((++sp & 255u) == 0u) { if (xb_ld(&bar[XB_TMO])) break; if (sp > XB_SPIN_CAP) { atomicAdd(&bar[XB_TMO], 1u); break; } }
    }
    nloc = mine > 0u ? mine : 1u; nx = cnt > 0u ? cnt : 1u;
}

__device__ __forceinline__ void xcd_barrier(const XcdBarrier& b) {
    asm volatile("s_waitcnt vmcnt(0)" ::: "memory");
    __syncthreads();
    if (threadIdx.x == 0) {
        unsigned* bar = b.bar;
        __builtin_amdgcn_s_waitcnt(0);
        unsigned nloc = b.st[0], nx = b.st[1];
        if (nloc == 0u) { xcd_barrier_complete(bar, b.x, nloc, nx); b.st[0] = nloc; b.st[1] = nx; }
        const unsigned old = xb_add(&bar[XB_XSUB(b.x)], 1u);
        const unsigned gen = old / nloc;
        if (old + 1u == (gen + 1u) * nloc) {
            __builtin_amdgcn_fence(__ATOMIC_RELEASE, "agent");
            asm volatile("s_waitcnt vmcnt(0)" ::: "memory");
            const unsigned og = xb_add(&bar[XB_TOP], 1u);
            const unsigned tg = og / nx;
            if (og + 1u == (tg + 1u) * nx) xb_add(&bar[XB_TOPGEN], 1u);
            else XB_SPIN(xb_ld(&bar[XB_TOPGEN]) == tg, bar);
            __builtin_amdgcn_fence(__ATOMIC_ACQUIRE, "agent");
            xb_add(&bar[XB_XGEN(b.x)], 1u);
            asm volatile("s_waitcnt vmcnt(0)" ::: "memory");
        } else {
            XB_SPIN(xb_ld(&bar[XB_XGEN(b.x)]) == gen, bar);
            __builtin_amdgcn_fence(__ATOMIC_ACQUIRE, "agent");
            asm volatile("s_waitcnt vmcnt(0)" ::: "memory");
        }
    }
    __syncthreads();
}

typedef float f32x16 __attribute__((ext_vector_type(16)));
typedef unsigned v2u __attribute__((ext_vector_type(2)));
typedef int v4i __attribute__((ext_vector_type(4)));
typedef __bf16 bf2_t __attribute__((ext_vector_type(2)));
#define DI __device__ __forceinline__
struct Frame {
    LAS unsigned char* lds;
    volatile LAS unsigned* MISC;
    gu32* ctl;
    int tid, lane, wave, vcu, G;
    const float *x, *norm_mix, *norm_ffn, *w_in, *b_gate, *w_conv, *q_norm, *k_norm, *sinks, *rel_bias, *w_conv_out, *w_attn_out, *w_out, *w_query, *sub_keys, *expert_u, *expert_v;
    float* out;
    bf16 *WIN, *WC, *WA, *WO, *WQ, *SK, *UB, *VB, *XB, *PA, *MIX, *G_, *QP, *Z, *ATT;
    float *RSTD1, *SSQ, *GATE, *ACT; bf16* PARTB; unsigned short* IDX;
};
DI float wave_sum(float v) {
#pragma unroll
    for (int o = 1; o < 64; o <<= 1) v += __shfl_xor(v, o);
    return v;
}
DI float bf_lo(unsigned u) { return __builtin_bit_cast(float, u << 16); }
DI float bf_hi(unsigned u) { return __builtin_bit_cast(float, u & 0xffff0000u); }

DI void p0_transpose_item(const float* W, int K, int N, bf16* WT, const float* gsc, LAS float* scr, int item, int lane) {
    const int nblk = N / 32, kb = item / nblk, nb = item % nblk, k0 = 64 * kb, n0 = 32 * nb;
#pragma unroll 8
    for (int i = 0; i < 32; ++i) { const int kk = 2 * i + (lane >> 5); float v = W[(size_t)(k0 + kk) * N + n0 + (lane & 31)]; if (gsc) v *= gsc[k0 + kk]; scr[kk * 33 + (lane & 31)] = v; }
    LDS_WAIT(); asm volatile("" ::: "memory");
    const int c = lane & 7;
#pragma unroll
    for (int j = 0; j < 4; ++j) { const int n = (lane >> 3) + 8 * j; const LAS float* s = scr + (8 * c) * 33 + n;
        v4u o; o.x = pk2(s[0 * 33], s[1 * 33]); o.y = pk2(s[2 * 33], s[3 * 33]); o.z = pk2(s[4 * 33], s[5 * 33]); o.w = pk2(s[6 * 33], s[7 * 33]);
        *(GAS v4u*)(WT + (size_t)(n0 + n) * K + k0 + 8 * c) = o; }
    LDS_WAIT(); asm volatile("" ::: "memory");
}
DI void p0_convert(Frame& F, const float* src, bf16* dst, size_t n, const float* colscale) {
    const size_t n8 = n / 8, stride = (size_t)F.G * NWAVES * 64;
    for (size_t i = (size_t)F.vcu * NWAVES * 64 + F.tid; i < n8; i += stride) {
        f32x4 a = *(const GAS f32x4*)(src + i * 8), b = *(const GAS f32x4*)(src + i * 8 + 4);
        if (colscale) { const int c = (int)((i * 8) & 1023); const f32x4 s0 = *(const GAS f32x4*)(colscale + c), s1 = *(const GAS f32x4*)(colscale + c + 4); a = a * s0; b = b * s1; }
        v4u o; o.x = pk2(a.x, a.y); o.y = pk2(a.z, a.w); o.z = pk2(b.x, b.y); o.w = pk2(b.z, b.w);
        *(GAS v4u*)(dst + i * 8) = o;
    }
}
constexpr float U_SCALE = 32.f, V_SCALE = 4.f, A_SCALE = 32.f;
DI unsigned pk4_fp8(f32x4 v) { int r = 0; r = __builtin_amdgcn_cvt_pk_fp8_f32(v[0], v[1], r, false); r = __builtin_amdgcn_cvt_pk_fp8_f32(v[2], v[3], r, true); return (unsigned)r; }
DI void p0_convert_fp8(Frame& F, const float* src, unsigned char* dst, size_t n, const float* colscale, float scale, int bidx, int nblk) {
    const int gw = bidx * NWAVES + F.wave, NGW = nblk * NWAVES, lane = F.lane;
    f32x4 cs[4];
#pragma unroll
    for (int q = 0; q < 4; ++q) cs[q] = colscale ? *(const GAS f32x4*)(colscale + 4 * lane + 256 * q) * scale : (f32x4){scale, scale, scale, scale};
    const int nrows = (int)(n / D);
    for (int e = gw; e < nrows; e += NGW) {
        const GAS f32x4* rp = (const GAS f32x4*)(src + (size_t)e * D) + lane;
        f32x4 v[4];
#pragma unroll
        for (int q = 0; q < 4; ++q) v[q] = rp[64 * q];
#pragma unroll
        for (int q = 0; q < 4; ++q) *(GAS unsigned*)(dst + ((size_t)(2 * q + (lane >> 5)) * NEXP + e) * 128 + ((4 * lane) & 127)) = pk4_fp8(v[q] * cs[q]);
    }
}
template <int RB> DI void p0_rows(Frame& F, const float* xrow, bf16* orow) {
    f32x4 v[RB][4]; float s[RB];
#pragma unroll
    for (int r = 0; r < RB; ++r) { const GAS f32x4* xr = (const GAS f32x4*)(xrow + (size_t)r * D) + F.lane;
#pragma unroll
        for (int j = 0; j < 4; ++j) v[r][j] = xr[64 * j]; }
#pragma unroll
    for (int r = 0; r < RB; ++r) { s[r] = 0.f;
#pragma unroll
        for (int j = 0; j < 4; ++j) s[r] += (v[r][j].x * v[r][j].x + v[r][j].y * v[r][j].y) + (v[r][j].z * v[r][j].z + v[r][j].w * v[r][j].w); }
#pragma unroll
    for (int o = 1; o < 64; o <<= 1)
#pragma unroll
        for (int r = 0; r < RB; ++r) s[r] += __shfl_xor(s[r], o);
#pragma unroll
    for (int r = 0; r < RB; ++r) { const float rs = 1.f / sqrtf(s[r] * (1.f / D) + EPS);
        GAS unsigned long long* o8 = (GAS unsigned long long*)(orow + (size_t)r * D) + F.lane;
#pragma unroll
        for (int j = 0; j < 4; ++j) o8[64 * j] = (unsigned long long)pk2(v[r][j].x * rs, v[r][j].y * rs) | ((unsigned long long)pk2(v[r][j].z * rs, v[r][j].w * rs) << 32); }
}
DI void p0_prologue(Frame& F) {
    LAS float* scr = (LAS float*)(F.lds + RING_OFF + F.wave * 16384);
    const int gw = F.vcu * NWAVES + F.wave, NGW = F.G * NWAVES;
    constexpr int I_IN = (D / 64) * (IN_DIM / 32), I_C = (CONV / 64) * (D / 32), I_O = (D / 64) * (D / 32), I_Q = (D / 64) * (PQ / 32);
    constexpr int NITEMS = I_IN + 2 * I_C + I_O + I_Q;
    for (int it = gw; it < NITEMS; it += NGW) {
        int r = it;
        if (r < I_IN) { p0_transpose_item(F.w_in, D, IN_DIM, F.WIN, F.norm_mix, scr, r, F.lane); continue; } r -= I_IN;
        if (r < I_C) { p0_transpose_item(F.w_conv_out, CONV, D, F.WC, nullptr, scr, r, F.lane); continue; } r -= I_C;
        if (r < I_C) { p0_transpose_item(F.w_attn_out, CONV, D, F.WA, nullptr, scr, r, F.lane); continue; } r -= I_C;
        if (r < I_O) { p0_transpose_item(F.w_out, D, D, F.WO, nullptr, scr, r, F.lane); continue; } r -= I_O;
        p0_transpose_item(F.w_query, D, PQ, F.WQ, F.norm_ffn, scr, r, F.lane);
    }
    p0_convert(F, F.sub_keys, F.SK, (size_t)PH * 2 * NKEYS * 128, nullptr);
    for (int m = 4 * gw; m < T; m += 4 * NGW) p0_rows<4>(F, F.x + (size_t)m * D, F.XB + (size_t)m * D);
}

namespace pg8 {
DI float sigmoidf_(float v) { return __builtin_amdgcn_rcpf(1.f + __expf(-v)); }
DI size_t frag_off(int pm, int pn, int NT, int wave, int q, int lane) { return (((((size_t)pm * NT + pn) * 8 + wave) * 16 + q) * 64 + lane) * 8; }
struct EpiProj {
    static constexpr bool PERM = true, AFTER_DRAIN = false, HAS_INIT = false;
    bf16_t* PA; bf16_t* G; const PG8_LAS float* bgl;
    DI void operator()(const f32x4 (&acc)[2][2][4][2], const Unit& u, int wr, int wc, int fr, int fq) const {
        const int row0 = u.pm * BM + wr * 64 + fr; const bool gate = u.pn >= 9;
        const int col0 = (gate ? (u.pn - 9) : u.pn) * BM + wc * 32 + 8 * fq;
        if (!gate) {
#pragma unroll
            for (int ai = 0; ai < 2; ++ai)
#pragma unroll
                for (int m = 0; m < 4; ++m) { bf16_t* rowp = PA + (size_t)(row0 + ai * HALF + m * 16) * PA_W + col0;
#pragma unroll
                    for (int bj = 0; bj < 2; ++bj) { const f32x4 v0 = acc[ai][bj][m][0], v1 = acc[ai][bj][m][1];
                        u32x4 w; w.x = cvt_pk_bf16(v0[0], v0[1]); w.y = cvt_pk_bf16(v0[2], v0[3]); w.z = cvt_pk_bf16(v1[0], v1[1]); w.w = cvt_pk_bf16(v1[2], v1[3]);
                        store16_wt(rowp + bj * HALF, w); } }
        } else {
            f32x4 bv[2][2];
#pragma unroll
            for (int bj = 0; bj < 2; ++bj)
#pragma unroll
                for (int n = 0; n < 2; ++n) bv[bj][n] = *(const PG8_LAS f32x4*)(bgl + col0 + bj * HALF + 4 * n);
#pragma unroll
            for (int ai = 0; ai < 2; ++ai)
#pragma unroll
                for (int m = 0; m < 4; ++m)
#pragma unroll
                    for (int bj = 0; bj < 2; ++bj) { f32x4 v0 = acc[ai][bj][m][0] + bv[bj][0], v1 = acc[ai][bj][m][1] + bv[bj][1];
#pragma unroll
                        for (int j = 0; j < 4; ++j) { v0[j] = sigmoidf_(v0[j]) * 255.f; v1[j] = sigmoidf_(v1[j]) * 255.f; }
                        unsigned g0 = 0u, g1 = 0u;
                        g0 = __builtin_amdgcn_cvt_pk_u8_f32(v0[0], 0, g0); g0 = __builtin_amdgcn_cvt_pk_u8_f32(v0[1], 1, g0); g0 = __builtin_amdgcn_cvt_pk_u8_f32(v0[2], 2, g0); g0 = __builtin_amdgcn_cvt_pk_u8_f32(v0[3], 3, g0);
                        g1 = __builtin_amdgcn_cvt_pk_u8_f32(v1[0], 0, g1); g1 = __builtin_amdgcn_cvt_pk_u8_f32(v1[1], 1, g1); g1 = __builtin_amdgcn_cvt_pk_u8_f32(v1[2], 2, g1); g1 = __builtin_amdgcn_cvt_pk_u8_f32(v1[3], 3, g1);
                        u32x2 gw; gw.x = g0; gw.y = g1;
                        *(u32x2*)((unsigned char*)G + frag_off(u.pm, u.pn - 9, 8, wr * 4 + wc, ai * 8 + m * 2 + bj, fq * 16 + fr)) = gw; }
        }
    }
};
struct EpiMix {
    static constexpr bool PERM = true, AFTER_DRAIN = false, HAS_INIT = false;
    bf16_t* MIX; const bf16_t* G;
    DI void operator()(const f32x4 (&acc)[2][2][4][2], const Unit& u, int wr, int wc, int fr, int fq) const {
        const int wave = wr * 4 + wc, lane = fq * 16 + fr;
        const unsigned char* gp = (const unsigned char*)G + frag_off(u.pm, u.pn + (u.which ? 4 : 0), 8, wave, 0, lane); bf16_t* mp = MIX + frag_off(u.pm, u.pn, 4, wave, 0, lane);
#pragma unroll
        for (int ai = 0; ai < 2; ++ai) {
            u32x2 gv[8]; u32x4 ov[8];
#pragma unroll
            for (int q = 0; q < 8; ++q) gv[q] = *(const u32x2*)(gp + (ai * 8 + q) * 512);
            if (u.which) {
#pragma unroll
                for (int q = 0; q < 8; ++q) ov[q] = *(const u32x4*)(mp + (ai * 8 + q) * 512); }
#pragma unroll
            for (int m = 0; m < 4; ++m)
#pragma unroll
                for (int bj = 0; bj < 2; ++bj) { const int q = m * 2 + bj; const u32x2 g2 = gv[q]; constexpr float GI = 1.f / 255.f;
                    f32x4 v0 = acc[ai][bj][m][0], v1 = acc[ai][bj][m][1];
                    v0[0] *= (float)(g2.x & 0xffu) * GI; v0[1] *= (float)((g2.x >> 8) & 0xffu) * GI; v0[2] *= (float)((g2.x >> 16) & 0xffu) * GI; v0[3] *= (float)(g2.x >> 24) * GI;
                    v1[0] *= (float)(g2.y & 0xffu) * GI; v1[1] *= (float)((g2.y >> 8) & 0xffu) * GI; v1[2] *= (float)((g2.y >> 16) & 0xffu) * GI; v1[3] *= (float)(g2.y >> 24) * GI;
                    if (u.which) { const u32x4 o = ov[q];
                        v0[0] += __builtin_bit_cast(float, o.x << 16); v0[1] += __builtin_bit_cast(float, o.x & 0xffff0000u); v0[2] += __builtin_bit_cast(float, o.y << 16); v0[3] += __builtin_bit_cast(float, o.y & 0xffff0000u);
                        v1[0] += __builtin_bit_cast(float, o.z << 16); v1[1] += __builtin_bit_cast(float, o.z & 0xffff0000u); v1[2] += __builtin_bit_cast(float, o.w << 16); v1[3] += __builtin_bit_cast(float, o.w & 0xffff0000u); }
                    u32x4 w; w.x = cvt_pk_bf16(v0[0], v0[1]); w.y = cvt_pk_bf16(v0[2], v0[3]); w.z = cvt_pk_bf16(v1[0], v1[1]); w.w = cvt_pk_bf16(v1[2], v1[3]);
                    if (u.which) store16_wt(mp + (ai * 8 + q) * 512, w); else *(u32x4*)(mp + (ai * 8 + q) * 512) = w; }
        }
    }
};
struct FragOrder : StaticOrder { static constexpr bool AFRAG = true; };
struct PairOrder : StaticOrder {
    __device__ bool next(int i, Unit& u) const { const bool ok = StaticOrder::next(i >> 1, u); u.which = i & 1; return ok; }
    DI const char* a_base(const Gemm& g, const Unit& u, size_t tstep) const { return (const char*)(u.which ? g.A2 : g.A) + (size_t)u.pm * tstep; }
    DI const char* b_base(const Gemm& g, const Unit& u, size_t tstep) const { return (const char*)(u.which ? g.Bt2 : g.Bt) + (size_t)u.pn * tstep; }
};
struct EpiX1 {
    static constexpr bool PERM = true, AFTER_DRAIN = false, HAS_INIT = true;
    const float* x; bf16_t* XB; float* SSQ;
    DI void init(f32x4 (&acc)[2][2][4][2], const Unit& u, int wr, int wc, int fr, int fq) const {
        const int row0 = u.pm * BM + wr * 64 + fr, col0 = u.pn * BM + wc * 32 + 8 * fq;
#pragma unroll
        for (int ai = 0; ai < 2; ++ai)
#pragma unroll
            for (int m = 0; m < 4; ++m)
#pragma unroll
                for (int bj = 0; bj < 2; ++bj)
#pragma unroll
                    for (int n = 0; n < 2; ++n) acc[ai][bj][m][n] = *(const f32x4*)(x + (size_t)(row0 + ai * HALF + m * 16) * D + col0 + bj * HALF + 4 * n);
    }
    DI void operator()(const f32x4 (&acc)[2][2][4][2], const Unit& u, int wr, int wc, int fr, int fq) const {
        const int row0 = u.pm * BM + wr * 64 + fr, col0 = u.pn * BM + wc * 32 + 8 * fq;
#pragma unroll
        for (int ai = 0; ai < 2; ++ai)
#pragma unroll
            for (int m = 0; m < 4; ++m) { const int row = row0 + ai * HALF + m * 16; float ss = 0.f;
#pragma unroll
                for (int bj = 0; bj < 2; ++bj) { const f32x4 v0 = acc[ai][bj][m][0], v1 = acc[ai][bj][m][1];
                    ss += ((v0[0] * v0[0] + v0[1] * v0[1]) + (v0[2] * v0[2] + v0[3] * v0[3])) + ((v1[0] * v1[0] + v1[1] * v1[1]) + (v1[2] * v1[2] + v1[3] * v1[3]));
                    u32x4 w; w.x = cvt_pk_bf16(v0[0], v0[1]); w.y = cvt_pk_bf16(v0[2], v0[3]); w.z = cvt_pk_bf16(v1[0], v1[1]); w.w = cvt_pk_bf16(v1[2], v1[3]);
                    store16_wt(XB + (size_t)row * D + col0 + bj * HALF, w); }
                ss += __shfl_xor(ss, 16); ss += __shfl_xor(ss, 32);
                if (fq == 0) SSQ[(size_t)row * 16 + u.pn * 4 + wc] = ss; }
    }
};
DI float rstd2_of(const float* SSQ, int row) {
    const f32x4 a = *(const f32x4*)(SSQ + (size_t)row * 16), b = *(const f32x4*)(SSQ + (size_t)row * 16 + 4), c = *(const f32x4*)(SSQ + (size_t)row * 16 + 8), d = *(const f32x4*)(SSQ + (size_t)row * 16 + 12);
    const float s = ((a[0] + a[1]) + (a[2] + a[3])) + ((b[0] + b[1]) + (b[2] + b[3])) + ((c[0] + c[1]) + (c[2] + c[3])) + ((d[0] + d[1]) + (d[2] + d[3]));
    return 1.f / sqrtf(s * (1.f / D) + EPS);
}
struct EpiQP {
    static constexpr bool PERM = true, AFTER_DRAIN = false, HAS_INIT = false;
    bf16_t* QP;
    DI void operator()(const f32x4 (&acc)[2][2][4][2], const Unit& u, int wr, int wc, int fr, int fq) const {
        const int row0 = u.pm * BM + wr * 64 + fr, col0 = u.pn * BM + wc * 32 + 8 * fq;
#pragma unroll
        for (int ai = 0; ai < 2; ++ai)
#pragma unroll
            for (int m = 0; m < 4; ++m) {
#pragma unroll
                for (int bj = 0; bj < 2; ++bj) { const f32x4 v0 = acc[ai][bj][m][0], v1 = acc[ai][bj][m][1];
                    u32x4 w; w.x = cvt_pk_bf16(v0[0], v0[1]); w.y = cvt_pk_bf16(v0[2], v0[3]); w.z = cvt_pk_bf16(v1[0], v1[1]); w.w = cvt_pk_bf16(v1[2], v1[3]);
                    *(u32x4*)(QP + frag_off(u.pm, u.pn, 8, wr * 4 + wc, ai * 8 + m * 2 + bj, fq * 16 + fr)) = w; } }
    }
};
}

#define MFMA32(a, b, c) __builtin_amdgcn_mfma_f32_32x32x16_bf16((a), (b), (c), 0, 0, 0)
DI void p2_conv(Frame& F) {
    constexpr int CT = 4;
    const size_t NT_ = (size_t)F.G * NWAVES * 64;
    for (size_t item = (size_t)F.vcu * NWAVES * 64 + F.tid; item < (size_t)(T / CT) * 64; item += NT_) {
        const int tb = (int)(item >> 6) * CT, c0 = (int)(item & 63) * 8, tl = tb & (SEQ - 1);
        v4u cg[CT + 2], uu[CT + 2], bg[CT];
#pragma unroll
        for (int r = 0; r < CT + 2; ++r) { const bool ok = (tl + r - 2) >= 0; const bf16* rowp = F.PA + (size_t)(tb + (ok ? r - 2 : 0)) * PA_W;
            cg[r] = *(const GAS v4u*)(rowp + C_C + c0); uu[r] = *(const GAS v4u*)(rowp + C_U + c0);
            if (!ok) { cg[r] = (v4u){0u, 0u, 0u, 0u}; } }
#pragma unroll
        for (int r = 0; r < CT; ++r) bg[r] = *(const GAS v4u*)(F.PA + (size_t)(tb + r) * PA_W + C_B + c0);
        f32x4 w[3][2];
#pragma unroll
        for (int j = 0; j < 3; ++j) { w[j][0] = *(const GAS f32x4*)(F.w_conv + j * CONV + c0); w[j][1] = *(const GAS f32x4*)(F.w_conv + j * CONV + c0 + 4); }
        float h[CT + 2][8];
#pragma unroll
        for (int r = 0; r < CT + 2; ++r) { h[r][0] = bf_lo(cg[r].x) * bf_lo(uu[r].x); h[r][1] = bf_hi(cg[r].x) * bf_hi(uu[r].x); h[r][2] = bf_lo(cg[r].y) * bf_lo(uu[r].y); h[r][3] = bf_hi(cg[r].y) * bf_hi(uu[r].y);
            h[r][4] = bf_lo(cg[r].z) * bf_lo(uu[r].z); h[r][5] = bf_hi(cg[r].z) * bf_hi(uu[r].z); h[r][6] = bf_lo(cg[r].w) * bf_lo(uu[r].w); h[r][7] = bf_hi(cg[r].w) * bf_hi(uu[r].w); }
#pragma unroll
        for (int r = 0; r < CT; ++r) {
            float a[8];
#pragma unroll
            for (int e = 0; e < 8; ++e) a[e] = w[0][e >> 2][e & 3] * h[r][e] + w[1][e >> 2][e & 3] * h[r + 1][e] + w[2][e >> 2][e & 3] * h[r + 2][e];
            v4u o; o.x = pk2(a[0] * bf_lo(bg[r].x), a[1] * bf_hi(bg[r].x)); o.y = pk2(a[2] * bf_lo(bg[r].y), a[3] * bf_hi(bg[r].y));
            o.z = pk2(a[4] * bf_lo(bg[r].z), a[5] * bf_hi(bg[r].z)); o.w = pk2(a[6] * bf_lo(bg[r].w), a[7] * bf_hi(bg[r].w));
            *(GAS v4u*)(F.Z + (size_t)(tb + r) * CONV + c0) = o;
        }
    }
}
DI int t5_bucket(int d) {
    if (d < 16) return d;
    const int large = 16 + (int)(logf((float)d / 16.f) / logf(8.f) * 16.f);
    return large < 31 ? large : 31;
}
constexpr int KS_STRIDE = 72, VT_STRIDE = 264;
constexpr int ATT_KS = 0, ATT_VT = 256 * KS_STRIDE * 2, ATT_BIAS = ATT_VT + 64 * VT_STRIDE * 2, ATT_END = ATT_BIAS + 4 * 128 * 4;
static_assert(ATT_END <= RING_BYTES, "attention LDS");
DI void p2_attention(Frame& F) {
    LAS bf16* KS = (LAS bf16*)(F.lds + ATT_KS); LAS bf16* VT = (LAS bf16*)(F.lds + ATT_VT); LAS float* BIAS = (LAS float*)(F.lds + ATT_BIAS);
    const int lane = F.lane, r = lane & 31, hh = lane >> 5;
#pragma unroll 1
    for (int unit = F.vcu; unit < 8 * 32 * NKV; unit += F.G) {
        const int kv = unit & 1, n = (unit >> 1) & 31, b = unit >> 6;
        const int t0 = b * SEQ + n * 128;
        __syncthreads();
        {
            const int j = F.tid >> 1, hf = F.tid & 1; const bool valid = (n > 0) || (j >= 128);
            const bf16* rowp = F.PA + (size_t)(t0 - 128 + j) * PA_W;
            v4u kq[4], vq[4];
#pragma unroll
            for (int i = 0; i < 4; ++i) { kq[i] = (v4u){0u, 0u, 0u, 0u}; vq[i] = kq[i]; }
            if (valid) {
#pragma unroll
                for (int i = 0; i < 4; ++i) { kq[i] = *(const GAS v4u*)(rowp + C_K + kv * HD + hf * 32 + i * 8); vq[i] = *(const GAS v4u*)(rowp + C_V + kv * HD + hf * 32 + i * 8); }
            }
            float kf[32]; float ss = 0.f;
#pragma unroll
            for (int i = 0; i < 4; ++i) { kf[8 * i + 0] = bf_lo(kq[i].x); kf[8 * i + 1] = bf_hi(kq[i].x); kf[8 * i + 2] = bf_lo(kq[i].y); kf[8 * i + 3] = bf_hi(kq[i].y);
                kf[8 * i + 4] = bf_lo(kq[i].z); kf[8 * i + 5] = bf_hi(kq[i].z); kf[8 * i + 6] = bf_lo(kq[i].w); kf[8 * i + 7] = bf_hi(kq[i].w); }
#pragma unroll
            for (int e = 0; e < 32; ++e) ss += kf[e] * kf[e];
            ss += __shfl_xor(ss, 1);
            const float rs = 1.f / sqrtf(ss * (1.f / HD) + EPS);
#pragma unroll
            for (int i = 0; i < 4; ++i) { const f32x4 g0 = *(const GAS f32x4*)(F.k_norm + hf * 32 + 8 * i), g1 = *(const GAS f32x4*)(F.k_norm + hf * 32 + 8 * i + 4);
                v4u o; o.x = pk2(kf[8 * i + 0] * rs * g0[0], kf[8 * i + 1] * rs * g0[1]); o.y = pk2(kf[8 * i + 2] * rs * g0[2], kf[8 * i + 3] * rs * g0[3]);
                o.z = pk2(kf[8 * i + 4] * rs * g1[0], kf[8 * i + 5] * rs * g1[1]); o.w = pk2(kf[8 * i + 6] * rs * g1[2], kf[8 * i + 7] * rs * g1[3]);
                *(LAS v4u*)(KS + j * KS_STRIDE + hf * 32 + 8 * i) = o; }
#pragma unroll
            for (int i = 0; i < 4; ++i) { const int d0 = hf * 32 + 8 * i;
                VT[(d0 + 0) * VT_STRIDE + j] = (bf16)(vq[i].x & 0xffffu); VT[(d0 + 1) * VT_STRIDE + j] = (bf16)(vq[i].x >> 16);
                VT[(d0 + 2) * VT_STRIDE + j] = (bf16)(vq[i].y & 0xffffu); VT[(d0 + 3) * VT_STRIDE + j] = (bf16)(vq[i].y >> 16);
                VT[(d0 + 4) * VT_STRIDE + j] = (bf16)(vq[i].z & 0xffffu); VT[(d0 + 5) * VT_STRIDE + j] = (bf16)(vq[i].z >> 16);
                VT[(d0 + 6) * VT_STRIDE + j] = (bf16)(vq[i].w & 0xffffu); VT[(d0 + 7) * VT_STRIDE + j] = (bf16)(vq[i].w >> 16); }
            { const int g = F.tid >> 7, dist = F.tid & 127; BIAS[F.tid] = F.rel_bias[t5_bucket(dist) * NH + kv * 4 + g]; }
        }
        __syncthreads();
#pragma unroll 1
        for (int task = F.wave; task < 16; task += NWAVES) {
            const int g = task >> 2, c = task & 3, head = kv * 4 + g, r0 = 32 * c;
            bf16x8 qf[4];
            {
                const bf16* qp = F.PA + (size_t)(t0 + r0 + r) * PA_W + C_Q + head * HD + 8 * hh;
                v4u qq[4]; float qv[32]; float ss = 0.f;
#pragma unroll
                for (int s = 0; s < 4; ++s) qq[s] = *(const GAS v4u*)(qp + 16 * s);
#pragma unroll
                for (int s = 0; s < 4; ++s) { qv[8 * s + 0] = bf_lo(qq[s].x); qv[8 * s + 1] = bf_hi(qq[s].x); qv[8 * s + 2] = bf_lo(qq[s].y); qv[8 * s + 3] = bf_hi(qq[s].y);
                    qv[8 * s + 4] = bf_lo(qq[s].z); qv[8 * s + 5] = bf_hi(qq[s].z); qv[8 * s + 6] = bf_lo(qq[s].w); qv[8 * s + 7] = bf_hi(qq[s].w); }
#pragma unroll
                for (int e = 0; e < 32; ++e) ss += qv[e] * qv[e];
                ss += __shfl_xor(ss, 32);
                const float rs = 0.125f / sqrtf(ss * (1.f / HD) + EPS);
#pragma unroll
                for (int s = 0; s < 4; ++s) { const f32x4 g0 = *(const GAS f32x4*)(F.q_norm + 16 * s + 8 * hh), g1 = *(const GAS f32x4*)(F.q_norm + 16 * s + 8 * hh + 4);
                    v4u o; o.x = pk2(qv[8 * s + 0] * rs * g0[0], qv[8 * s + 1] * rs * g0[1]); o.y = pk2(qv[8 * s + 2] * rs * g0[2], qv[8 * s + 3] * rs * g0[3]);
                    o.z = pk2(qv[8 * s + 4] * rs * g1[0], qv[8 * s + 5] * rs * g1[1]); o.w = pk2(qv[8 * s + 6] * rs * g1[2], qv[8 * s + 7] * rs * g1[3]);
                    qf[s] = __builtin_bit_cast(bf16x8, o); }
            }
            f32x16 sacc[5];
#pragma unroll
            for (int i5 = 0; i5 < 5; ++i5) {
#pragma unroll
                for (int e = 0; e < 16; ++e) sacc[i5][e] = 0.f;
                const int kt = c + i5;
#pragma unroll
                for (int s = 0; s < 4; ++s) { const bf16x8 ka = *(const LAS bf16x8*)(KS + (32 * kt + r) * KS_STRIDE + 16 * s + 8 * hh); sacc[i5] = MFMA32(ka, qf[s], sacc[i5]); }
            }
            const float sink = F.sinks[head];
            const int dbase = r - 4 * hh + 128;
            const LAS float* bl = BIAS + g * 128;
            float mx = sink;
#pragma unroll
            for (int i5 = 0; i5 < 5; ++i5) {
                const bool tile_ok = (n > 0) || (c + i5 >= 4);
#pragma unroll
                for (int e = 0; e < 16; ++e) { const int dist = dbase - 32 * i5 - ((e & 3) + 8 * (e >> 2));
                    bool valid = tile_ok; if (i5 == 0) valid = valid && (dist < 128); if (i5 == 4) valid = valid && (dist >= 0);
                    const float lg = sacc[i5][e] + bl[dist & 127];
                    sacc[i5][e] = valid ? lg : -INFINITY; mx = fmaxf(mx, sacc[i5][e]); }
                __builtin_amdgcn_sched_barrier(0);
            }
            mx = fmaxf(mx, __shfl_xor(mx, 32));
            float sum = 0.f;
#pragma unroll
            for (int i5 = 0; i5 < 5; ++i5)
#pragma unroll
                for (int e = 0; e < 16; ++e) { const float p = __expf(sacc[i5][e] - mx); sacc[i5][e] = p; sum += p; }
            sum += __shfl_xor(sum, 32);
            const float inv = 1.f / (sum + __expf(sink - mx));
            f32x16 oacc[2];
#pragma unroll
            for (int dt = 0; dt < 2; ++dt)
#pragma unroll
                for (int e = 0; e < 16; ++e) oacc[dt][e] = 0.f;
#pragma unroll
            for (int i5 = 0; i5 < 5; ++i5)
#pragma unroll
                for (int s2 = 0; s2 < 2; ++s2) {
                    v4u pp; pp.x = pk2(sacc[i5][8 * s2 + 0] * inv, sacc[i5][8 * s2 + 1] * inv); pp.y = pk2(sacc[i5][8 * s2 + 2] * inv, sacc[i5][8 * s2 + 3] * inv);
                    pp.z = pk2(sacc[i5][8 * s2 + 4] * inv, sacc[i5][8 * s2 + 5] * inv); pp.w = pk2(sacc[i5][8 * s2 + 6] * inv, sacc[i5][8 * s2 + 7] * inv);
                    const bf16x8 pb = __builtin_bit_cast(bf16x8, pp);
                    const int kb = 32 * (c + i5) + 16 * s2 + 4 * hh;
#pragma unroll
                    for (int dt = 0; dt < 2; ++dt) {
                        const v2u lo = *(const LAS v2u*)(VT + (32 * dt + r) * VT_STRIDE + kb), hi = *(const LAS v2u*)(VT + (32 * dt + r) * VT_STRIDE + kb + 8);
                        v4u va; va.x = lo.x; va.y = lo.y; va.z = hi.x; va.w = hi.y;
                        oacc[dt] = MFMA32(__builtin_bit_cast(bf16x8, va), pb, oacc[dt]);
                    }
                    __builtin_amdgcn_sched_barrier(0);
                }
            bf16* op = F.ATT + (size_t)(t0 + r0 + r) * CONV + head * HD;
#pragma unroll
            for (int dt = 0; dt < 2; ++dt)
#pragma unroll
                for (int g4 = 0; g4 < 4; ++g4) { v2u w; w.x = pk2(oacc[dt][4 * g4 + 0], oacc[dt][4 * g4 + 1]); w.y = pk2(oacc[dt][4 * g4 + 2], oacc[dt][4 * g4 + 3]);
#ifdef ZERO_ATT
                    w.x = 0u; w.y = 0u;
#endif
                    *(GAS v2u*)(op + 32 * dt + 8 * g4 + 4 * hh) = w; }
        }
    }
}

DI unsigned f2ord(float f) { const unsigned b = __builtin_bit_cast(unsigned, f); return b ^ ((b >> 31) ? 0xffffffffu : 0x80000000u); }
DI float ord2f(unsigned k) { const unsigned b = k ^ ((k >> 31) ? 0x80000000u : 0xffffffffu); return __builtin_bit_cast(float, b); }
DI unsigned umax_(unsigned a, unsigned b) { return a > b ? a : b; }
DI unsigned umin_(unsigned a, unsigned b) { return a < b ? a : b; }
DI void sort16_desc(unsigned (&v)[16]) {
#pragma unroll
    for (int k = 2; k <= 16; k <<= 1)
#pragma unroll
        for (int j = k >> 1; j > 0; j >>= 1)
#pragma unroll
            for (int i = 0; i < 16; ++i) { const int l = i ^ j; if (l > i) { const bool desc = ((i & k) == 0) || (k == 16); const unsigned a = v[i], b = v[l], hi = umax_(a, b), lo = umin_(a, b); v[i] = desc ? hi : lo; v[l] = desc ? lo : hi; } }
}
DI void merge_top16(unsigned (&a)[16], const unsigned (&b)[16]) {
#pragma unroll
    for (int i = 0; i < 16; ++i) a[i] = umax_(a[i], b[15 - i]);
#pragma unroll
    for (int j = 8; j > 0; j >>= 1)
#pragma unroll
        for (int i = 0; i < 16; ++i) { const int l = i ^ j; if (l > i) { const unsigned x = a[i], y = a[l]; a[i] = umax_(x, y); a[l] = umin_(x, y); } }
}
constexpr int SK_STRIDE = 136;
constexpr int P6_KEYS = 0, P6_IB = 2 * NKEYS * SK_STRIDE * 2, P6_END = P6_IB + NWAVES * 64 * 32;
static_assert(P6_END <= RING_BYTES, "topk LDS");
DI void p6_topk(Frame& F) {
    LAS bf16* KL = (LAS bf16*)(F.lds + P6_KEYS); LAS unsigned char* IB = F.lds + P6_IB + (F.wave * 64 + F.lane) * 32;
    const int lane = F.lane, r = lane & 31, hh = lane >> 5;
    pg8::StaticOrder S; S.init(T, PQ, F.G, (int)blockIdx.x);
    pg8::Unit pu;
    for (int ui = 0; S.next(ui, pu); ++ui) {
        const int h = pu.pn, tile = pu.pm;
        __syncthreads();
        {
            const bf16* src = F.SK + (size_t)h * 2 * NKEYS * 128;
#pragma unroll
            for (int i = 0; i < 8; ++i) { const int ch = F.tid + 512 * i; const int row = ch >> 4, c8 = (ch & 15) * 8;
                *(LAS v4u*)(KL + row * SK_STRIDE + c8) = *(const GAS v4u*)(src + (size_t)row * 128 + c8); }
        }
        __syncthreads();
        const int t = tile * 256 + F.wave * 32 + r;
        unsigned S[2][16];
#pragma unroll
        for (int p = 0; p < 2; ++p) {
            bf16x8 qf[8];
            const int rt = F.wave * 32 + r, q_ai = rt >> 7, q_wr = (rt >> 6) & 1, q_m = (rt >> 4) & 3, q_fr = rt & 15;
#pragma unroll
            for (int s = 0; s < 8; ++s) qf[s] = __builtin_bit_cast(bf16x8, *(const GAS v4u*)(F.QP + pg8::frag_off(tile, h, 8, q_wr * 4 + (s >> 1), q_ai * 8 + q_m * 2 + p, (2 * (s & 1) + hh) * 16 + q_fr)));
            unsigned key[4][16];
#pragma unroll
            for (int kt = 0; kt < 4; ++kt) {
                f32x16 acc;
#pragma unroll
                for (int e = 0; e < 16; ++e) acc[e] = 0.f;
#pragma unroll
                for (int s = 0; s < 8; ++s) { const bf16x8 ka = *(const LAS bf16x8*)(KL + (p * NKEYS + 32 * kt + r) * SK_STRIDE + 16 * s + 8 * hh); acc = MFMA32(ka, qf[s], acc); }
#pragma unroll
                for (int e = 0; e < 16; ++e) { const int nk = 32 * kt + (e & 3) + 8 * (e >> 2) + 4 * hh; key[kt][e] = (f2ord(acc[e]) & ~127u) | (unsigned)(127 - nk); }
            }
#pragma unroll
            for (int kt = 0; kt < 4; ++kt) sort16_desc(key[kt]);
            merge_top16(key[0], key[1]); merge_top16(key[2], key[3]); merge_top16(key[0], key[2]);
            unsigned other[16];
#pragma unroll
            for (int i = 0; i < 16; ++i) other[i] = (unsigned)__shfl_xor((int)key[0][i], 32);
            merge_top16(key[0], other);
#pragma unroll
            for (int i = 0; i < 16; ++i) S[p][i] = key[0][i];
        }
        float s0[16], s1[16]; const float rs2 = pg8::rstd2_of(F.SSQ, t);
#pragma unroll
        for (int i = 0; i < 16; ++i) { s0[i] = ord2f(S[0][i] & ~127u) * rs2; s1[i] = ord2f(S[1][i] & ~127u) * rs2; }
        {
#pragma unroll
            for (int q4 = 0; q4 < 4; ++q4) { unsigned w0 = 0, w1 = 0;
#pragma unroll
                for (int e = 0; e < 4; ++e) { w0 |= (127u - (S[0][4 * q4 + e] & 127u)) << (8 * e); w1 |= (127u - (S[1][4 * q4 + e] & 127u)) << (8 * e); }
                *(LAS unsigned*)(IB + 4 * q4) = w0; *(LAS unsigned*)(IB + 16 + 4 * q4) = w1; }
        }
        unsigned cand[2][16];
#pragma unroll
        for (int i = 0; i < 2; ++i)
#pragma unroll
            for (int e = 0; e < 16; ++e) cand[i][e] = 0u;
        {
            int cnt = 0; float ea = 0.f, eb = 0.f; int ep = 0;
#pragma unroll
            for (int a = 0; a < 16; ++a)
#pragma unroll
                for (int b = 0; b < 16; ++b)
                    if ((a + 1) * (b + 1) <= 16) {
                        if ((cnt & 1) == 0) { ea = s0[a]; eb = s1[b]; ep = 255 - (a * 16 + b); }
                        else { const int slot = cnt >> 1; const float sa = hh ? s0[a] : ea, sb = hh ? s1[b] : eb; const int pp = hh ? 255 - (a * 16 + b) : ep;
                            cand[slot & 1][slot >> 1] = (f2ord(sa + sb) & ~255u) | (unsigned)pp; }
                        ++cnt; }
        }
        sort16_desc(cand[0]); sort16_desc(cand[1]); merge_top16(cand[0], cand[1]);
        {
            unsigned other[16];
#pragma unroll
            for (int i = 0; i < 16; ++i) other[i] = (unsigned)__shfl_xor((int)cand[0][i], 32);
            merge_top16(cand[0], other);
        }
        float gv[16]; int ev[16]; float gsum = 0.f; const float gmx = ord2f(cand[0][0] & ~255u);
#pragma unroll
        for (int i = 0; i < 16; ++i) { const unsigned k = cand[0][i]; const int pos = 255 - (int)(k & 255u); const int a = pos >> 4, b = pos & 15;
            ev[i] = (int)IB[a] * NKEYS + (int)IB[16 + b]; gv[i] = __expf(ord2f(k & ~255u) - gmx); gsum += gv[i]; }
        float ginv = 1.f / gsum;
#ifdef UNIFORM_GATES
#pragma unroll
        for (int i = 0; i < 16; ++i) gv[i] = 1.f;
        ginv = 1.f / 16.f;
#endif
        if (hh == 0) {
            unsigned short* ip = F.IDX + (size_t)t * NSEL + h * TOPK; float* gp = F.GATE + (size_t)t * NSEL + h * TOPK;
#pragma unroll
            for (int i = 0; i < 2; ++i) *(GAS v4i*)(ip + 8 * i) = (v4i){ev[8 * i] | (ev[8 * i + 1] << 16), ev[8 * i + 2] | (ev[8 * i + 3] << 16), ev[8 * i + 4] | (ev[8 * i + 5] << 16), ev[8 * i + 6] | (ev[8 * i + 7] << 16)};
#pragma unroll
            for (int i = 0; i < 4; ++i) *(GAS f32x4*)(gp + 4 * i) = (f32x4){gv[4 * i] * ginv, gv[4 * i + 1] * ginv, gv[4 * i + 2] * ginv, gv[4 * i + 3] * ginv};
        }
    }
}

typedef float f32x2_t __attribute__((ext_vector_type(2)));
DI void fp8x16_to_f32(v4u q, float (&f)[16]) {
#pragma unroll
    for (int w = 0; w < 4; ++w) { const f32x2_t lo = __builtin_amdgcn_cvt_pk_f32_fp8((int)q[w], false), hi = __builtin_amdgcn_cvt_pk_f32_fp8((int)q[w], true);
        f[4 * w + 0] = lo.x; f[4 * w + 1] = lo.y; f[4 * w + 2] = hi.x; f[4 * w + 3] = hi.y; }
}
struct XccInfo { int q, nx, nloc, rank; };
DI void xcc_info_build(const XcdBarrier& b) {
    if (threadIdx.x == 0) {
        unsigned q = 0, nx = 0, nloc = 1;
        for (unsigned j = 0; j < 16; ++j) { const unsigned c = xb_ld(&b.bar[XB_XCNT(j)]); if (c > 0u) { if (j < b.x) ++q; ++nx; } if (j == b.x) nloc = c; }
        b.st[3] = q; b.st[4] = nx > 0u ? nx : 1u; b.st[5] = nloc > 0u ? nloc : 1u;
    }
    __syncthreads();
}
DI XccInfo xcc_info(const XcdBarrier& b) {
    XccInfo I; I.rank = __builtin_amdgcn_readfirstlane((int)b.st[2]); I.q = __builtin_amdgcn_readfirstlane((int)b.st[3]); I.nx = __builtin_amdgcn_readfirstlane((int)b.st[4]); I.nloc = __builtin_amdgcn_readfirstlane((int)b.st[5]);
    return I;
}
DI float dpp_sum8(float s) {
    s += __builtin_bit_cast(float, __builtin_amdgcn_update_dpp(0, __builtin_bit_cast(int, s), 0xB1, 0xf, 0xf, false));
    s += __builtin_bit_cast(float, __builtin_amdgcn_update_dpp(0, __builtin_bit_cast(int, s), 0x4E, 0xf, 0xf, false));
    s += __builtin_bit_cast(float, __builtin_amdgcn_update_dpp(0, __builtin_bit_cast(int, s), 0x141, 0xf, 0xf, false));
    return s;
}
typedef long i64_t;
typedef long i64x2 __attribute__((ext_vector_type(2)));
constexpr int PEER_ROW = 144, PEER_WAVE_LDS = 128 * PEER_ROW;
#define P7_IDS(t_, ia_, ib_) do { ia_ = (int)F.IDX[(size_t)(t_) * NSEL + lane]; ib_ = (int)F.IDX[(size_t)(t_) * NSEL + 64 + lane]; } while (0)
#define P7_ISSUE(t_, ia_, ib_, uq_, x_) do { \
        const bf16* xr_ = F.XB + (size_t)(t_) * D + sl * 128 + 32 * g; \
        _Pragma("unroll") for (int q = 0; q < 4; ++q) x_[q] = *(const GAS v4u*)(xr_ + 8 * q); \
        _Pragma("unroll") for (int ld = 0; ld < 16; ++ld) { const int e_ = __shfl(ld < 8 ? ia_ : ib_, (8 * ld + row8) & 63); uq_[ld] = *(const GAS v4u*)(Us + (unsigned)(e_ * 128 + 16 * c8)); } } while (0)
#define P7_COMPUTE(t_, uq_, x_) do { \
        _Pragma("unroll") for (int ld = 0; ld < 16; ++ld) *(LAS v4u*)(wl + (8 * ld + row8) * PEER_ROW + 16 * c8) = uq_[ld]; \
        i64_t xk[4]; \
        _Pragma("unroll") for (int s2 = 0; s2 < 4; ++s2) { const v4u v_ = x_[s2]; \
            int lo_ = 0, hi_ = 0; \
            lo_ = __builtin_amdgcn_cvt_pk_fp8_f32(bf_lo(v_.x), bf_hi(v_.x), lo_, false); lo_ = __builtin_amdgcn_cvt_pk_fp8_f32(bf_lo(v_.y), bf_hi(v_.y), lo_, true); \
            hi_ = __builtin_amdgcn_cvt_pk_fp8_f32(bf_lo(v_.z), bf_hi(v_.z), hi_, false); hi_ = __builtin_amdgcn_cvt_pk_fp8_f32(bf_lo(v_.w), bf_hi(v_.w), hi_, true); \
            xk[s2] = (i64_t)(((unsigned long long)(unsigned)hi_ << 32) | (unsigned long long)(unsigned)lo_); } \
        f32x4 keep = {0.f, 0.f, 0.f, 0.f}; \
        _Pragma("unroll") for (int j = 0; j < 8; ++j) { f32x4 c_ = {0.f, 0.f, 0.f, 0.f}; \
            const i64x2 a0_ = *(const LAS i64x2*)(wl + (16 * j + m) * PEER_ROW + 32 * g), a1_ = *(const LAS i64x2*)(wl + (16 * j + m) * PEER_ROW + 32 * g + 16); \
            c_ = __builtin_amdgcn_mfma_f32_16x16x32_fp8_fp8(a0_[0], xk[0], c_, 0, 0, 0); c_ = __builtin_amdgcn_mfma_f32_16x16x32_fp8_fp8(a0_[1], xk[1], c_, 0, 0, 0); \
            c_ = __builtin_amdgcn_mfma_f32_16x16x32_fp8_fp8(a1_[0], xk[2], c_, 0, 0, 0); c_ = __builtin_amdgcn_mfma_f32_16x16x32_fp8_fp8(a1_[1], xk[3], c_, 0, 0, 0); \
            keep = (m == j) ? c_ : keep; } \
        { const bool ok_ = (m < 8) && ((t_) < T); bf16* dst_ = ok_ ? F.PARTB + ((size_t)sl * T + (t_)) * NSEL + 16 * m + 4 * g : F.PARTB + (size_t)8 * T * NSEL + 4 * lane; \
          v2u w_; w_.x = pk2(keep[0], keep[1]); w_.y = pk2(keep[2], keep[3]); *(GAS v2u*)dst_ = w_; } } while (0)
#define P7V_ISSUE(t_, ia_, ib_, uq_, x0_, x1_) do { \
        const bf16* xr_ = F.XB + (size_t)(t_) * D + sl * 128 + 16 * c8; x0_ = *(const GAS v4u*)xr_; x1_ = *(const GAS v4u*)(xr_ + 8); \
        _Pragma("unroll") for (int ld = 0; ld < 16; ++ld) { const int e_ = __shfl(ld < 8 ? ia_ : ib_, (8 * ld + row8) & 63); uq_[ld] = *(const GAS v4u*)(Us + (unsigned)(e_ * 128 + 16 * c8)); } } while (0)
#define P7V_COMPUTE(t_, uq_, x0_, x1_) do { \
        float xf[16]; \
        xf[0] = bf_lo(x0_.x); xf[1] = bf_hi(x0_.x); xf[2] = bf_lo(x0_.y); xf[3] = bf_hi(x0_.y); xf[4] = bf_lo(x0_.z); xf[5] = bf_hi(x0_.z); xf[6] = bf_lo(x0_.w); xf[7] = bf_hi(x0_.w); \
        xf[8] = bf_lo(x1_.x); xf[9] = bf_hi(x1_.x); xf[10] = bf_lo(x1_.y); xf[11] = bf_hi(x1_.y); xf[12] = bf_lo(x1_.z); xf[13] = bf_hi(x1_.z); xf[14] = bf_lo(x1_.w); xf[15] = bf_hi(x1_.w); \
        { v4u xq_;   \
          _Pragma("unroll") for (int w_ = 0; w_ < 4; ++w_) { int p_ = 0; p_ = __builtin_amdgcn_cvt_pk_fp8_f32(xf[4 * w_], xf[4 * w_ + 1], p_, false); p_ = __builtin_amdgcn_cvt_pk_fp8_f32(xf[4 * w_ + 2], xf[4 * w_ + 3], p_, true); xq_[w_] = (unsigned)p_; } \
          fp8x16_to_f32(xq_, xf); } \
        float res0 = 0.f, res1 = 0.f; \
        _Pragma("unroll") for (int ld = 0; ld < 16; ++ld) { float uf[16]; fp8x16_to_f32(uq_[ld], uf); float a0 = 0.f, a1 = 0.f; \
            _Pragma("unroll") for (int e = 0; e < 16; e += 2) { a0 += xf[e] * uf[e]; a1 += xf[e + 1] * uf[e + 1]; } \
            const float d = dpp_sum8(a0 + a1); \
            if (ld < 8) res0 = (c8 == ld) ? d : res0; else res1 = (c8 == ld - 8) ? d : res1; } \
        { bf16* pp_ = ((t_) < T) ? F.PARTB + ((size_t)sl * T + (t_)) * NSEL + 8 * c8 + row8 : F.PARTB + (size_t)8 * T * NSEL + 128 * (lane & 1) + 8 * c8 + row8; \
          pp_[0] = (bf16)f2bf(res0); pp_[64] = (bf16)f2bf(res1); } } while (0)
constexpr int NMF = 8;
DI int peer_next(volatile LAS unsigned* ctr, int lane) { unsigned k = 0u; if (lane == 0) k = __hip_atomic_fetch_add((LAS unsigned*)ctr, 1u, __ATOMIC_RELAXED, __HIP_MEMORY_SCOPE_WORKGROUP); return __builtin_amdgcn_readfirstlane((int)k); }
DI int peer_tok(int tbase, int tstride, int k) { return tbase + (k & 7) + (k >> 3) * tstride; }
DI void p7_udot(Frame& F, const XccInfo& I) {
    const int lane = F.lane, g = lane >> 4, m = lane & 15, row8 = lane >> 3, c8 = lane & 7;
    LAS unsigned char* wl = F.lds + F.wave * PEER_WAVE_LDS;
    const unsigned char* U8 = (const unsigned char*)F.UB;
    const int tstride = I.nloc * NWAVES, tbase = I.rank * NWAVES;
    int it = 0;
    for (int sl = I.q; sl < 8; sl += I.nx, ++it) {
        const unsigned char* Us = U8 + (size_t)sl * NEXP * 128;
        volatile LAS unsigned* ctr = F.MISC + 16 + it;
#define CL(t_) ((t_) < T ? (t_) : T - 1)
#define TOK(k_) peer_tok(tbase, tstride, (k_))
        v4u uqA[16], uqB[16]; int iA0, iA1, iB0, iB1;
        int tA = TOK(peer_next(ctr, lane)), tB = TOK(peer_next(ctr, lane));
        if (F.wave < NMF) {
            v4u xA[4], xB[4];
            P7_IDS(CL(tA), iA0, iA1);
            P7_ISSUE(CL(tA), iA0, iA1, uqA, xA);
            P7_IDS(CL(tB), iB0, iB1);
#pragma unroll 1
            while (tA < T) {
                const int tC = TOK(peer_next(ctr, lane)), tD = TOK(peer_next(ctr, lane));
                P7_IDS(CL(tC), iA0, iA1);
                P7_ISSUE(CL(tB), iB0, iB1, uqB, xB);
                P7_COMPUTE(tA, uqA, xA);
                P7_IDS(CL(tD), iB0, iB1);
                P7_ISSUE(CL(tC), iA0, iA1, uqA, xA);
                P7_COMPUTE(tB, uqB, xB);
                tA = tC; tB = tD;
            }
        } else {
            v4u xA0, xA1, xB0, xB1;
            P7_IDS(CL(tA), iA0, iA1);
            P7V_ISSUE(CL(tA), iA0, iA1, uqA, xA0, xA1);
            P7_IDS(CL(tB), iB0, iB1);
#pragma unroll 1
            while (tA < T) {
                const int tC = TOK(peer_next(ctr, lane)), tD = TOK(peer_next(ctr, lane));
                P7_IDS(CL(tC), iA0, iA1);
                P7V_ISSUE(CL(tB), iB0, iB1, uqB, xB0, xB1);
                P7V_COMPUTE(tA, uqA, xA0, xA1);
                P7_IDS(CL(tD), iB0, iB1);
                P7V_ISSUE(CL(tC), iA0, iA1, uqA, xA0, xA1);
                P7V_COMPUTE(tB, uqB, xB0, xB1);
                tA = tC; tB = tD;
            }
        }
#undef TOK
#undef CL
    }
}
DI void p8_act(Frame& F) {
    const size_t NT_ = (size_t)F.G * NWAVES * 64;
    for (size_t item = (size_t)F.vcu * NWAVES * 64 + F.tid; item < (size_t)T * NSEL / 4; item += NT_) {
        const int t = (int)(item >> 5);
        f32x4 s = {0.f, 0.f, 0.f, 0.f};
#pragma unroll
        for (int sl = 0; sl < 8; ++sl) { const v2u p = *(const GAS v2u*)(F.PARTB + (size_t)sl * T * NSEL + item * 4); s = s + (f32x4){bf_lo(p.x), bf_hi(p.x), bf_lo(p.y), bf_hi(p.y)}; }
        const float rs2 = pg8::rstd2_of(F.SSQ, t) * (1.f / U_SCALE);
        const f32x4 g = *(const GAS f32x4*)(F.GATE + item * 4);
        f32x4 o;
#pragma unroll
        for (int e = 0; e < 4; ++e) { const float pre = s[e] * rs2; o[e] = 0.5f * pre * (1.f + erff(pre * 0.70710678118f)) * g[e] * A_SCALE; }
        ((GAS unsigned*)F.ACT)[item] = pk4_fp8(o);
    }
}
typedef int v2i_t __attribute__((ext_vector_type(2)));
#define P9_IDS(t_, ia_, ib_, ak_) do { ia_ = (int)F.IDX[(size_t)(t_) * NSEL + lane]; ib_ = (int)F.IDX[(size_t)(t_) * NSEL + 64 + lane]; \
        const unsigned char* ap_ = (const unsigned char*)F.ACT + (size_t)(t_) * NSEL + 8 * g; \
        _Pragma("unroll") for (int s2 = 0; s2 < 4; ++s2) ak_[s2] = *(const GAS i64_t*)(ap_ + 32 * s2); } while (0)
#define P9_ISSUE(ia_, ib_, vq_) do { \
        _Pragma("unroll") for (int ld = 0; ld < 16; ++ld) { const int e_ = __shfl(ld < 8 ? ia_ : ib_, (8 * ld + row8) & 63); vq_[ld] = *(const GAS v4u*)(Vs + (unsigned)(e_ * 128 + 16 * c8)); } } while (0)
#define P9_COMPUTE(t_, vq_, ak_) do { \
        _Pragma("unroll") for (int ld = 0; ld < 16; ++ld) *(LAS v4u*)(wl + (8 * ld + row8) * PEER_ROW + 16 * c8) = vq_[ld]; \
        float keep0 = 0.f, keep1 = 0.f; \
        _Pragma("unroll") for (int ct = 0; ct < 8; ++ct) { f32x4 c_ = {0.f, 0.f, 0.f, 0.f}; \
            _Pragma("unroll") for (int s2 = 0; s2 < 4; ++s2) { \
                const v2i_t b_ = __builtin_amdgcn_ds_read_tr8_b64_v2i32((LAS v2i_t*)(wl + (32 * s2 + 8 * g + trr) * PEER_ROW + 16 * ct + 8 * trc)); \
                c_ = __builtin_amdgcn_mfma_f32_16x16x32_fp8_fp8(ak_[s2], __builtin_bit_cast(i64_t, b_), c_, 0, 0, 0); } \
            if ((ct & 1) == 0) keep0 = (g == (ct >> 1)) ? c_[0] : keep0; else keep1 = (g == (ct >> 1)) ? c_[0] : keep1; } \
        { const bool ok_ = (t_) < T; const size_t oo_ = (size_t)(ok_ ? (t_) : T - 1) * D + sl * 128 + 32 * g + n16; \
          const float r0_ = __builtin_bit_cast(float, (unsigned)F.XB[oo_] << 16), r1_ = __builtin_bit_cast(float, (unsigned)F.XB[oo_ + 16] << 16); \
          float* op_ = ok_ ? F.out + oo_ : (float*)F.PARTB + 2 * lane;                   \
          op_[0] = r0_ + keep0 * (1.f / (A_SCALE * V_SCALE)); op_[ok_ ? 16 : 1] = r1_ + keep1 * (1.f / (A_SCALE * V_SCALE)); } } while (0)
DI void p9_vacc(Frame& F, const XccInfo& I) {
    const int lane = F.lane, g = lane >> 4, n16 = lane & 15, row8 = lane >> 3, c8 = lane & 7, trr = n16 >> 1, trc = n16 & 1;
    LAS unsigned char* wl = F.lds + F.wave * PEER_WAVE_LDS;
    const unsigned char* V8 = (const unsigned char*)F.VB;
    const int tstride = I.nloc * NWAVES, tfirst = I.rank * NWAVES + F.wave;
    for (int sl = I.q; sl < 8; sl += I.nx) {
        const unsigned char* Vs = V8 + (size_t)sl * NEXP * 128;
        if (tfirst >= T) continue;
        v4u vqA[16], vqB[16]; i64_t akA[4], akB[4]; int iA0, iA1, iB0, iB1;
#define CL(t_) ((t_) < T ? (t_) : T - 1)
        P9_IDS(tfirst, iA0, iA1, akA);
        P9_ISSUE(iA0, iA1, vqA);
        P9_IDS(CL(tfirst + tstride), iB0, iB1, akB);
#pragma unroll 1
        for (int t = tfirst; t < T; t += 2 * tstride) {
            const int t1 = t + tstride, t2 = CL(t + 2 * tstride), t3 = CL(t + 3 * tstride);
            i64_t akN[4];
            i64_t akM[4];
            P9_IDS(t2, iA0, iA1, akN);
            P9_ISSUE(iB0, iB1, vqB);
            P9_COMPUTE(t, vqA, akA);
            P9_IDS(t3, iB0, iB1, akM);
            P9_ISSUE(iA0, iA1, vqA);
            P9_COMPUTE(t1, vqB, akB);
#pragma unroll
            for (int s2 = 0; s2 < 4; ++s2) { akA[s2] = akN[s2]; akB[s2] = akM[s2]; }
        }
#undef CL
    }
}

struct Args { const float* in[17]; float* out; unsigned char* ws; int ph_lo, ph_hi, li, pad; };
__global__ void __launch_bounds__(NWAVES * 64, 2) hyb_fwd(Args args) {
    extern __shared__ __attribute__((aligned(16))) unsigned char lds[];
    Frame F;
    F.lds = (LAS unsigned char*)lds;
    F.MISC = (volatile LAS unsigned*)(F.lds + MISC_OFF);
    F.tid = threadIdx.x; F.lane = F.tid & 63; F.wave = __builtin_amdgcn_readfirstlane(F.tid >> 6);
    F.G = gridDim.x; { const int bx = blockIdx.x; F.vcu = (F.G % 8 == 0) ? (bx % 8) * (F.G / 8) + bx / 8 : bx; }
    unsigned char* ws = args.ws;
    F.ctl = (gu32*)(ws + WS_CTL);
    F.x = args.in[0]; F.norm_mix = args.in[1]; F.norm_ffn = args.in[2]; F.w_in = args.in[3]; F.b_gate = args.in[4]; F.w_conv = args.in[5]; F.q_norm = args.in[6]; F.k_norm = args.in[7];
    F.sinks = args.in[8]; F.rel_bias = args.in[9]; F.w_conv_out = args.in[10]; F.w_attn_out = args.in[11]; F.w_out = args.in[12]; F.w_query = args.in[13]; F.sub_keys = args.in[14];
    F.expert_u = args.in[15]; F.expert_v = args.in[16]; F.out = args.out;
    F.WIN = (bf16*)(ws + WS_WIN); F.WC = (bf16*)(ws + WS_WC); F.WA = (bf16*)(ws + WS_WA); F.WO = (bf16*)(ws + WS_WO); F.WQ = (bf16*)(ws + WS_WQ); F.SK = (bf16*)(ws + WS_SK);
    F.UB = (bf16*)(ws + WS_UB); F.VB = (bf16*)(ws + WS_VB); F.XB = (bf16*)(ws + WS_XB); F.PA = (bf16*)(ws + WS_PA); F.MIX = (bf16*)(ws + WS_MIX); F.G_ = (bf16*)(ws + WS_G); F.QP = (bf16*)(ws + WS_QP);
    F.Z = (bf16*)(ws + WS_Z); F.ATT = (bf16*)(ws + WS_ATT); F.RSTD1 = (float*)(ws + WS_RSTD1); F.SSQ = (float*)(ws + WS_SSQ); F.GATE = (float*)(ws + WS_GATE); F.IDX = (unsigned short*)(ws + WS_IDX); F.PARTB = (bf16*)(ws + WS_PART); F.ACT = (float*)(ws + WS_ACT);
    for (int u = F.tid; u < (LDS_BYTES - LDSCTL_OFF) / 4; u += NWAVES * 64) ((LAS unsigned*)(F.lds + LDSCTL_OFF))[u] = 0u;
    __syncthreads();
    XcdBarrier bar; bar.bar = (unsigned*)(F.ctl + CW_BAR); bar.x = 0; bar.st = nullptr;
    const int lo = args.ph_lo, hi = args.ph_hi;
    if (hi - lo > 1) bar = xcd_barrier_post((unsigned*)(F.ctl + CW_BAR), F.MISC + 8);
#ifndef PH_MASK
#define PH_MASK 0x3ff
#endif
#define IN(k) (((PH_MASK >> (k)) & 1) && lo <= (k) && (k) < hi)
#define SEAM(k) do { if (IN(k) && IN((k) + 1)) xcd_barrier(bar); } while (0)
#ifndef PROBE_DUP
#define PROBE_DUP 0
#endif
#define REP(k) for (int rep_ = 0; rep_ < (((PROBE_DUP >> (k)) & 1) ? 2 : 1); ++rep_)

    if (IN(0)) { REP(0) p0_prologue(F); SEAM(0); }
    if (IN(1)) {
        pg8::Gemm g{F.XB, F.WIN, nullptr, nullptr, T, IN_DIM, D}; pg8::StaticOrder S; S.init(T, IN_DIM, F.G, (int)blockIdx.x);
        { LAS float* bgl = (LAS float*)(F.lds + RING_BYTES); for (int i = F.tid; i < 2 * D; i += NWAVES * 64) bgl[i] = F.b_gate[i]; __syncthreads(); }
        pg8::EpiProj E{F.PA, F.G_, (const PG8_LAS float*)(F.lds + RING_BYTES)};
        REP(1) pg8::gemm_phase<pg8::EpiProj, pg8::StaticOrder, PG8_ALIGN, PG8_SP2>(F.lds + RING_OFF, g, S, E);
        {
            const int nwg = (T / 256) * (IN_DIM / 256), rem = nwg % F.G, c = (int)blockIdx.x; const int nshort = rem ? F.G - rem : F.G, sidx = rem ? c - rem : c;
            if (sidx >= 0) { p0_convert_fp8(F, F.expert_u, (unsigned char*)F.UB, (size_t)NEXP * D, F.norm_ffn, U_SCALE, sidx, nshort);
                             p0_convert_fp8(F, F.expert_v, (unsigned char*)F.VB, (size_t)NEXP * D, nullptr, V_SCALE, sidx, nshort); } }
        SEAM(1);
    }
    if (IN(2)) {
        REP(2) { p2_conv(F); p2_attention(F); }
        SEAM(2); }
    if (IN(3)) {
        pg8::Gemm g{F.Z, F.WC, F.ATT, F.WA, T, D, CONV}; pg8::PairOrder S; S.init(T, D, F.G, (int)blockIdx.x);
        pg8::EpiMix E{F.MIX, F.G_};
        REP(3) pg8::gemm_phase<pg8::EpiMix, pg8::PairOrder, PG8_ALIGN, PG8_SP2>(F.lds + RING_OFF, g, S, E);
        SEAM(3);
    }
    if (IN(4)) {
        pg8::Gemm g{F.MIX, F.WO, nullptr, nullptr, T, D, D}; pg8::FragOrder S; S.init(T, D, F.G, (int)blockIdx.x);
        pg8::EpiX1 E{F.x, F.XB, F.SSQ};
        REP(4) pg8::gemm_phase<pg8::EpiX1, pg8::FragOrder, PG8_ALIGN, PG8_SP2>(F.lds + RING_OFF, g, S, E);
        SEAM(4);
    }
    if (IN(5)) {
        pg8::Gemm g{F.XB, F.WQ, nullptr, nullptr, T, PQ, D}; pg8::StaticOrder S; S.init(T, PQ, F.G, (int)blockIdx.x);
        pg8::EpiQP E{F.QP};
        REP(5) pg8::gemm_phase<pg8::EpiQP, pg8::StaticOrder, PG8_ALIGN, PG8_SP2>(F.lds + RING_OFF, g, S, E);
    }
    if (IN(6)) { REP(6) p6_topk(F); SEAM(6); }
    if (IN(7)) { xcc_info_build(bar); const XccInfo I = xcc_info(bar); REP(7) p7_udot(F, I); SEAM(7); }
    if (IN(8)) { REP(8) p8_act(F); SEAM(8); }
    if (IN(9)) { const XccInfo I = xcc_info(bar); p9_vacc(F, I); }
#undef IN
#undef SEAM
}

extern "C" void kernel_launch(void* const* d_in, const int* in_sizes, int n_in, void* d_out, int out_size, void* d_ws, size_t ws_size, hipStream_t stream) {
    static int grid = 0;
    if (grid == 0) {
        if (n_in != 17 || in_sizes[0] != T * D || out_size != T * D || ws_size < WS_END) { fprintf(stderr, "kernel_launch: unexpected shapes (n_in %d, in0 %d, out %d, ws %zu)\n", n_in, n_in > 0 ? in_sizes[0] : -1, out_size, ws_size); grid = -1; return; }
        int dev = 0, cus = 0, per_cu = 0;
        if (hipGetDevice(&dev) != hipSuccess || hipDeviceGetAttribute(&cus, hipDeviceAttributeMultiprocessorCount, dev) != hipSuccess) { grid = -1; return; }
        if (hipFuncSetAttribute((const void*)hyb_fwd, hipFuncAttributeMaxDynamicSharedMemorySize, LDS_BYTES) != hipSuccess) { fprintf(stderr, "kernel_launch: hipFuncSetAttribute failed\n"); grid = -1; return; }
        if (hipOccupancyMaxActiveBlocksPerMultiprocessor(&per_cu, (const void*)hyb_fwd, NWAVES * 64, LDS_BYTES) != hipSuccess || per_cu < 1) { fprintf(stderr, "kernel_launch: occupancy query says %d blocks per CU\n", per_cu); (void)hipGetLastError(); grid = -1; return; }
        grid = cus * 1;
    }
    if (grid < 0) return;
    if (hipMemsetAsync((char*)d_ws + WS_CTL, 0, CTL_ZERO_BYTES, stream) != hipSuccess) { fprintf(stderr, "kernel_launch: memset failed\n"); return; }
    Args a{};
    for (int i = 0; i < 17; ++i) a.in[i] = (const float*)d_in[i];
    a.out = (float*)d_out; a.ws = (unsigned char*)d_ws;
#if MK_ONE_LAUNCH
    a.ph_lo = 0; a.ph_hi = N_PHASES; a.li = 0;
    void* kargs[] = {&a};
    const hipError_t le = hipLaunchCooperativeKernel((const void*)hyb_fwd, dim3(grid), dim3(NWAVES * 64), kargs, LDS_BYTES, stream);
    if (le != hipSuccess) fprintf(stderr, "kernel_launch: cooperative launch failed: %s (grid %d)\n", hipGetErrorName(le), grid);
#else
    for (int li = 0; li < N_PHASES; ++li) {
        a.ph_lo = li; a.ph_hi = li + 1; a.li = li;
        hipLaunchKernelGGL(hyb_fwd, dim3(grid), dim3(NWAVES * 64), LDS_BYTES, stream, a);
        const hipError_t le = hipPeekAtLastError();
        if (le != hipSuccess) { fprintf(stderr, "kernel_launch: launch %d failed: %s\n", li, hipGetErrorName(le)); break; }
    }
#endif
}
```

```cpp
#include <hip/hip_runtime.h>
#include <hip/hip_cooperative_groups.h>
#include <cstdio>
#include <cstdint>
namespace pg8 {
#define PG8_LAS __attribute__((address_space(3)))
typedef unsigned short bf16_t;
typedef short bf16x8 __attribute__((ext_vector_type(8)));
typedef float f32x4 __attribute__((ext_vector_type(4)));
typedef unsigned u32x4 __attribute__((ext_vector_type(4)));
typedef unsigned u32x2 __attribute__((ext_vector_type(2)));
constexpr int BM = 256, BK = 64, HALF = 128, HTB = HALF * BK * 2  , STAGE_BYTES = 8 * HTB, NXCD = 8, WGM = 8;

__host__ __device__ __forceinline__ int lds_byte(int r, int c) { const int st = (r >> 4) * 2 + (c >> 5), rr = r & 15, cc = c & 31, ob = rr * 64 + cc * 2; return st * 1024 + (ob ^ (((ob >> 9) & 1) << 5)); }
__host__ __device__ __forceinline__ void stage_rc(int b, int& R, int& C) { const int st = b / 1024, sb = b % 1024, swz = sb ^ (((sb >> 9) & 1) << 5); R = (st >> 1) * 16 + swz / 64; C = (st & 1) * 32 + (swz % 64) / 2; }
__host__ __device__ __forceinline__ int perm32(int rho) { const int n = rho >> 4, i = rho & 15; return 8 * (i >> 2) + 4 * n + (i & 3); }

struct Unit { int pm, pn, which; };
struct Gemm { const bf16_t* A; const bf16_t* Bt; const bf16_t* A2; const bf16_t* Bt2; int M, N, K; };

struct StaticOrder {
    static constexpr bool AFRAG = false;
    int nM, nN, nwg, G, c;
    __host__ __device__ void init(int M, int N, int G_, int c_) { nM = M / BM; nN = N / BM; nwg = nM * nN; G = G_; c = c_; }
    __host__ __device__ bool next(int i, Unit& u) const {
        const long L = (long)i * G + c; if (L >= nwg) return false;
        int wgid = (int)L; { const int q = nwg / NXCD, r = nwg % NXCD, xcd = wgid % NXCD, off = wgid / NXCD; wgid = (xcd < r ? xcd * (q + 1) : r * (q + 1) + (xcd - r) * q) + off; }
        const int nig = WGM * nN, gid = wgid / nig, fm = gid * WGM, gsz = (nM - fm) < WGM ? (nM - fm) : WGM;
        u.pm = fm + ((wgid % nig) % gsz); u.pn = (wgid % nig) / gsz; u.which = 0; return true;
    }
    __device__ __forceinline__ const char* a_base(const Gemm& g, const Unit& u, size_t tstep) const { return (const char*)g.A + (size_t)u.pm * tstep; }
    __device__ __forceinline__ const char* b_base(const Gemm& g, const Unit& u, size_t tstep) const { return (const char*)g.Bt + (size_t)u.pn * tstep; }
    __device__ __forceinline__ void a_ready(const Unit&) const {}
    __device__ __forceinline__ void done(const Unit&) const {}
};

__device__ __forceinline__ unsigned cvt_pk_bf16(float lo, float hi) { unsigned r; asm volatile("v_cvt_pk_bf16_f32 %0, %1, %2" : "=v"(r) : "v"(lo), "v"(hi)); return r; }
__device__ __forceinline__ void store16_wt(void* p, u32x4 v) { asm volatile("global_store_dwordx4 %0, %1, off sc1\n\ts_nop 1" :: "v"(p), "v"(v) : "memory"); }
__device__ __forceinline__ void store8_wt(void* p, u32x2 v) { asm volatile("global_store_dwordx2 %0, %1, off sc1\n\ts_nop 1" :: "v"(p), "v"(v) : "memory"); }
typedef float f32x2 __attribute__((ext_vector_type(2)));
__device__ __forceinline__ f32x2 gelu_pk(f32x2 v) {
    const f32x2 av = __builtin_elementwise_abs(v), d = av * 0.2316418882f + 1.0f;
    f32x2 t; t.x = __builtin_amdgcn_rcpf(d.x); t.y = __builtin_amdgcn_rcpf(d.y);
    f32x2 q = t * 0.5307027145f + (-0.7265760135f); q = q * t + 0.7107068705f; q = q * t + (-0.142248368f); q = q * t + 0.127414796f; q = q * t;
    const f32x2 s = (v * v) * (-0.72134752044f);
    f32x2 e; e.x = __builtin_amdgcn_exp2f(s.x); e.y = __builtin_amdgcn_exp2f(s.y);
    const f32x2 m = v * (q * e), r = v - m;
    f32x2 o; o.x = v.x < 0.f ? m.x : r.x; o.y = v.y < 0.f ? m.y : r.y; return o;
}

template <class Epi, class Sched, bool ALIGN_EPI = false, bool SP2 = false>
__device__ __forceinline__ void gemm_phase(PG8_LAS unsigned char* lds, const Gemm g, const Sched& S, const Epi& E) {
    const int tid = threadIdx.x, wid = __builtin_amdgcn_readfirstlane(tid >> 6), lane = tid & 63, wr = wid >> 2, wc = wid & 3, fr = lane & 15, fq = lane >> 4;
    const int K = g.K, nt = K / BK;
    unsigned voffA[2], voffB[2];
#pragma unroll
    for (int i = 0; i < 2; ++i) { int R, C; stage_rc(tid * 16 + i * 8192, R, C); const int Rb = Epi::PERM ? ((R & ~31) + perm32(R & 31)) : R;
        voffA[i] = Sched::AFRAG ? (unsigned)((((((R >> 6) * 4 + (C >> 5)) * 16 + ((R >> 4) & 3) * 2) * 64) + ((C & 31) >> 3) * 16 + (R & 15)) * 16) : (unsigned)(R * K + C) * 2u;
        voffB[i] = (unsigned)(Rb * K + C) * 2u; }
#define PG8_AP(base, h, kt) (Sched::AFRAG ? (base) + ((((size_t)((kt) >> 2) * 8 + ((kt) & 1) * 2) * 16 + (h) * 8 + (((kt) >> 1) & 1)) * 64) * 16 : (base) + (size_t)(h) * hstep + (size_t)(kt) * kstep)
    const size_t kstep = (size_t)(BK * 2);
    const size_t hstep = (size_t)HALF * K * 2;
    const size_t tstep = 2 * hstep;
    const unsigned ldsw = (unsigned)wid * 1024u;
    const int aoff = lds_byte(wr * 64 + fr, fq * 8), boff = lds_byte(wc * 32 + fr, fq * 8);
#define PG8_SA(b, h) (((b) * 2 + (h)) * HTB)
#define PG8_SB(b, h) ((4 + (b) * 2 + (h)) * HTB)
#define PG8_STAGE(bufoff, gbase, voff) do { _Pragma("unroll") for (int _i = 0; _i < 2; ++_i) \
        __builtin_amdgcn_global_load_lds((const unsigned*)((const char*)(gbase) + (voff)[_i]), (PG8_LAS unsigned*)(lds + (bufoff) + ldsw + _i * 8192), 16, 0, 0); } while (0)
#define PG8_LDA(dst, b, h) do { _Pragma("unroll") for (int m = 0; m < 4; ++m) _Pragma("unroll") for (int k = 0; k < 2; ++k) dst[m][k] = *(const PG8_LAS bf16x8*)(lds + PG8_SA(b, h) + aoff + m * 2048 + k * 1024); } while (0)
#define PG8_LDB(dst, b, h) do { _Pragma("unroll") for (int n = 0; n < 2; ++n) _Pragma("unroll") for (int k = 0; k < 2; ++k) dst[n][k] = *(const PG8_LAS bf16x8*)(lds + PG8_SB(b, h) + boff + n * 2048 + k * 1024); } while (0)
#define PG8_MMA(ai, bj, At, Bt) do { __builtin_amdgcn_s_setprio(1); _Pragma("unroll") for (int m = 0; m < 4; ++m) _Pragma("unroll") for (int n = 0; n < 2; ++n) _Pragma("unroll") for (int k = 0; k < 2; ++k) \
        acc[ai][bj][m][n] = __builtin_amdgcn_mfma_f32_16x16x32_bf16(Bt[n][k], At[m][k], acc[ai][bj][m][n], 0, 0, 0); __builtin_amdgcn_s_setprio(0); } while (0)
#define PG8_WAIT_V(n) asm volatile("s_waitcnt vmcnt(" #n ")" ::: "memory")
#define PG8_WAIT_L(n) asm volatile("s_waitcnt lgkmcnt(" #n ")" ::: "memory")
#define PG8_BAR __builtin_amdgcn_s_barrier()
#define PG8_SCHED __builtin_amdgcn_sched_barrier(0)
    Unit cur, nxt; int ui = 0;
    if (!S.next(0, cur)) return;
    f32x4 acc[2][2][4][2];
#pragma unroll
    for (int a = 0; a < 2; ++a)
#pragma unroll
        for (int b = 0; b < 2; ++b)
#pragma unroll
            for (int m = 0; m < 4; ++m)
#pragma unroll
                for (int n = 0; n < 2; ++n) acc[a][b][m][n] = (f32x4){0.f, 0.f, 0.f, 0.f};
    if constexpr (Epi::HAS_INIT) E.init(acc, cur, wr, wc, fr, fq);
    bf16x8 At[4][2], B0[2][2], B1[2][2];
    const char* cA = S.a_base(g, cur, tstep); const char* cB = S.b_base(g, cur, tstep);
    S.a_ready(cur);
    if constexpr (SP2) {
        PG8_STAGE(PG8_SB(0, 0), cB, voffB); PG8_STAGE(PG8_SB(0, 1), cB + hstep, voffB); PG8_STAGE(PG8_SA(0, 0), PG8_AP(cA, 0, 0), voffA); PG8_STAGE(PG8_SA(0, 1), PG8_AP(cA, 1, 0), voffA);
        if (wr == 1) PG8_BAR;
        PG8_WAIT_V(2); PG8_BAR;
        PG8_STAGE(PG8_SB(1, 0), cB + kstep, voffB); PG8_STAGE(PG8_SA(1, 0), PG8_AP(cA, 0, 1), voffA); PG8_STAGE(PG8_SB(1, 1), cB + hstep + kstep, voffB);
        PG8_WAIT_V(6); PG8_BAR;
    } else {
        PG8_STAGE(PG8_SB(0, 0), cB, voffB); PG8_STAGE(PG8_SA(0, 0), PG8_AP(cA, 0, 0), voffA); PG8_STAGE(PG8_SB(0, 1), cB + hstep, voffB); PG8_STAGE(PG8_SA(0, 1), PG8_AP(cA, 1, 0), voffA);
        if (wr == 1) PG8_BAR;
        PG8_WAIT_V(4); PG8_BAR;
        PG8_STAGE(PG8_SB(1, 0), cB + kstep, voffB); PG8_STAGE(PG8_SA(1, 0), PG8_AP(cA, 0, 1), voffA); PG8_STAGE(PG8_SB(1, 1), cB + hstep + kstep, voffB);
        PG8_WAIT_V(6); PG8_BAR;
    }
    for (;;) {
        const bool has_next = S.next(ui + 1, nxt);
        const char* nA = has_next ? S.a_base(g, nxt, tstep) : cA; const char* nB = has_next ? S.b_base(g, nxt, tstep) : cB;
        for (int t = 0; t < nt; t += 2) {
            const bool last = (t == nt - 2);
            const char* a2b = last ? nA : cA; const int a2k = last ? 0 : t + 2; const char* b2 = last ? nB : cB + (size_t)(t + 2) * kstep;
            const char* b3 = b2 + kstep;
            const char* a1h = PG8_AP(cA, 1, t + 1); const char* a2 = PG8_AP(a2b, 0, a2k); const char* a2h = PG8_AP(a2b, 1, a2k); const char* a3 = PG8_AP(a2b, 0, a2k + 1);
            if (last && has_next) S.a_ready(nxt);
            if constexpr (SP2) {
            PG8_LDB(B0, 0, 0); PG8_LDB(B1, 0, 1); PG8_SCHED; PG8_LDA(At, 0, 0); PG8_STAGE(PG8_SA(1, 1), a1h, voffA);
            PG8_WAIT_V(8); PG8_WAIT_L(0); PG8_BAR; PG8_MMA(0, 0, At, B0); PG8_MMA(0, 1, At, B1); PG8_BAR; PG8_SCHED;
            PG8_LDA(At, 0, 1); PG8_STAGE(PG8_SB(0, 0), b2, voffB); PG8_STAGE(PG8_SB(0, 1), b2 + hstep, voffB); PG8_STAGE(PG8_SA(0, 0), a2, voffA);
            PG8_WAIT_V(8); PG8_WAIT_L(0); PG8_BAR; PG8_MMA(1, 0, At, B0); PG8_MMA(1, 1, At, B1); PG8_BAR; PG8_SCHED;
            PG8_LDB(B0, 1, 0); PG8_LDB(B1, 1, 1); PG8_SCHED; PG8_LDA(At, 1, 0); PG8_STAGE(PG8_SA(0, 1), a2h, voffA);
            PG8_WAIT_V(8); PG8_WAIT_L(0); PG8_BAR; PG8_MMA(0, 0, At, B0); PG8_MMA(0, 1, At, B1); PG8_BAR; PG8_SCHED;
            PG8_LDA(At, 1, 1); PG8_STAGE(PG8_SB(1, 0), b3, voffB); PG8_STAGE(PG8_SB(1, 1), b3 + hstep, voffB); PG8_STAGE(PG8_SA(1, 0), a3, voffA);
            PG8_WAIT_V(8); PG8_WAIT_L(0); PG8_BAR; PG8_MMA(1, 0, At, B0); PG8_MMA(1, 1, At, B1); PG8_BAR; PG8_SCHED;
            } else {
            PG8_LDB(B0, 0, 0); PG8_SCHED; PG8_LDA(At, 0, 0); PG8_STAGE(PG8_SA(1, 1), a1h, voffA);
            PG8_WAIT_L(8); PG8_BAR; PG8_WAIT_L(0); PG8_MMA(0, 0, At, B0); PG8_BAR; PG8_SCHED;
            PG8_LDB(B1, 0, 1); PG8_STAGE(PG8_SB(0, 0), b2, voffB);
            PG8_BAR; PG8_WAIT_L(0); PG8_MMA(0, 1, At, B1); PG8_BAR;
            PG8_LDA(At, 0, 1); PG8_STAGE(PG8_SA(0, 0), a2, voffA);
            PG8_BAR; PG8_WAIT_L(0); PG8_MMA(1, 0, At, B0); PG8_BAR; PG8_SCHED;
            PG8_STAGE(PG8_SB(0, 1), b2 + hstep, voffB);
            PG8_WAIT_V(6); PG8_BAR; PG8_MMA(1, 1, At, B1); PG8_BAR;
            PG8_LDB(B0, 1, 0); PG8_SCHED; PG8_LDA(At, 1, 0); PG8_STAGE(PG8_SA(0, 1), a2h, voffA);
            PG8_WAIT_L(8); PG8_BAR; PG8_WAIT_L(0); PG8_MMA(0, 0, At, B0); PG8_BAR; PG8_SCHED;
            PG8_LDB(B1, 1, 1); PG8_STAGE(PG8_SB(1, 0), b3, voffB);
            PG8_BAR; PG8_WAIT_L(0); PG8_MMA(0, 1, At, B1); PG8_BAR;
            PG8_LDA(At, 1, 1); PG8_STAGE(PG8_SA(1, 0), a3, voffA);
            PG8_BAR; PG8_WAIT_L(0); PG8_MMA(1, 0, At, B0); PG8_BAR; PG8_SCHED;
            PG8_STAGE(PG8_SB(1, 1), b3 + hstep, voffB);
            PG8_WAIT_V(6); PG8_BAR; PG8_MMA(1, 1, At, B1); PG8_BAR;
            }
        }
        if constexpr (ALIGN_EPI) { if (wr == 0) PG8_BAR; }
        if constexpr (!Epi::AFTER_DRAIN) { E(acc, cur, wr, wc, fr, fq); S.done(cur); }
        if (!has_next) break;
#pragma unroll
        for (int a = 0; a < 2; ++a)
#pragma unroll
            for (int b = 0; b < 2; ++b)
#pragma unroll
                for (int m = 0; m < 4; ++m)
#pragma unroll
                    for (int n = 0; n < 2; ++n) acc[a][b][m][n] = (f32x4){0.f, 0.f, 0.f, 0.f};
        if constexpr (Epi::HAS_INIT) E.init(acc, nxt, wr, wc, fr, fq);
        cur = nxt; cA = nA; cB = nB; ++ui;
        if constexpr (ALIGN_EPI) { if (wr == 1) PG8_BAR; }
    }
    PG8_WAIT_V(0);
    if constexpr (!ALIGN_EPI) { if (wr == 0) PG8_BAR; }
    PG8_BAR;
    if constexpr (Epi::AFTER_DRAIN) { E.fused(acc, cur, wr, wc, fr, fq, lds, wid, lane); S.done(cur); }
#undef PG8_AP
#undef PG8_SA
#undef PG8_SB
#undef PG8_STAGE
#undef PG8_LDA
#undef PG8_LDB
#undef PG8_MMA
#undef PG8_WAIT_V
#undef PG8_WAIT_L
#undef PG8_BAR
#undef PG8_SCHED
}
}

#ifndef PG8_SP2
#define PG8_SP2 true
#endif
#ifndef PG8_ALIGN
#define PG8_ALIGN true
#endif
#ifndef MK_ONE_LAUNCH
#define MK_ONE_LAUNCH 1
#endif

constexpr int NWAVES = 8;
constexpr int T = 32768, D = 1024, SEQ = 4096;
constexpr int IN_DIM = 4352, PA_W = 2304, G_W = 2048;
constexpr int C_U = 0, C_B = 512, C_C = 1024, C_Q = 1536, C_K = 2048, C_V = 2176;
constexpr int CONV = 512, HD = 64, NH = 8, NKV = 2;
constexpr int PH = 8, NKEYS = 128, PQ = 2048, TOPK = 16, NEXP = 16384, NSEL = 128;
constexpr float EPS = 1e-6f;
constexpr int N_PHASES = 10;

constexpr size_t MiB = 1u << 20;
constexpr size_t WS_CTL = 0, CTL_ZERO_BYTES = 1 * MiB;
constexpr size_t WS_WIN = 2 * MiB;
constexpr size_t WS_WC = 11 * MiB;
constexpr size_t WS_WA = 12 * MiB;
constexpr size_t WS_WO = 13 * MiB;
constexpr size_t WS_WQ = 15 * MiB;
constexpr size_t WS_SK = 19 * MiB;
constexpr size_t WS_RSTD1 = 20 * MiB;
constexpr size_t WS_SSQ = 21 * MiB;
constexpr size_t WS_UB = 24 * MiB;
constexpr size_t WS_VB = 56 * MiB;
constexpr size_t WS_XB = 88 * MiB;
constexpr size_t WS_PA = 152 * MiB;
constexpr size_t WS_MIX = WS_PA;
constexpr size_t WS_G = 296 * MiB;
constexpr size_t WS_QP = WS_G;
constexpr size_t WS_Z = 424 * MiB;
constexpr size_t WS_ATT = 456 * MiB;
constexpr size_t WS_IDX = WS_Z, WS_GATE = WS_ATT;
constexpr size_t WS_PART = WS_PA;
constexpr size_t WS_ACT = WS_G;
constexpr size_t WS_END = 488 * MiB;
constexpr int CW_BAR = 4096;

constexpr int RING_OFF = 0, RING_BYTES = 131072;
constexpr int LDSCTL_OFF = 147456, MISC_OFF = LDSCTL_OFF + 320;
constexpr int LDS_BYTES = 148480;
#define GAS __attribute__((address_space(1)))
#define LAS __attribute__((address_space(3)))
typedef unsigned short bf16;
typedef unsigned v4u __attribute__((ext_vector_type(4)));
typedef float f32x4 __attribute__((ext_vector_type(4)));
typedef short bf16x8 __attribute__((ext_vector_type(8)));
typedef GAS unsigned gu32;
typedef GAS unsigned long long gu64;
#define RLX_AGENT __ATOMIC_RELAXED, __HIP_MEMORY_SCOPE_AGENT
#define LDS_WAIT() asm volatile("s_waitcnt lgkmcnt(0)" ::: "memory")
#define VM_WAIT() asm volatile("s_waitcnt vmcnt(0)" ::: "memory")
__device__ __forceinline__ unsigned long long rt() { return __builtin_amdgcn_s_memrealtime(); }
__device__ __forceinline__ unsigned f2bf(float f) { unsigned u = __builtin_bit_cast(unsigned, f); return (u + 0x7fffu + ((u >> 16) & 1u)) >> 16; }
__device__ __forceinline__ unsigned pk2(float lo, float hi) { return f2bf(lo) | (f2bf(hi) << 16); }

#define XB_TMO      128
#define XB_XCNT(j)  (256  + 64 * (j))
#define XB_XSUB(j)  (1280 + 64 * (j))
#define XB_XGEN(j)  (2304 + 64 * (j))
#define XB_TOP      3328
#define XB_TOPGEN   3392
#define XCD_BAR_WORDS 3456
#define XB_SPIN_CAP (1u << 18)

__device__ __forceinline__ unsigned xb_ld(unsigned* p)              { return __hip_atomic_load(p, __ATOMIC_RELAXED, __HIP_MEMORY_SCOPE_AGENT); }
__device__ __forceinline__ unsigned xb_add(unsigned* p, unsigned v) { return __hip_atomic_fetch_add(p, v, __ATOMIC_RELAXED, __HIP_MEMORY_SCOPE_AGENT); }
__device__ __forceinline__ unsigned xb_xcc_id() { return (unsigned)__builtin_amdgcn_s_getreg((3 << 11) | 20) & 0xFu; }
#define XB_SPIN(cond, bar) do { unsigned _sp = 0; while (cond) { __builtin_amdgcn_s_sleep(1); \
    if ((++_sp & 255u) == 0u) { if (xb_ld(&(bar)[XB_TMO])) break; if (_sp > XB_SPIN_CAP) { atomicAdd(&(bar)[XB_TMO], 1u); break; } } } } while (0)

struct XcdBarrier {
    unsigned* bar; unsigned x;
    volatile LAS unsigned* st;
};

__device__ __forceinline__ XcdBarrier xcd_barrier_post(unsigned* bar, volatile LAS unsigned* st) {
    XcdBarrier b; b.bar = bar; b.x = xb_xcc_id(); b.st = st;
    if (threadIdx.x == 0) st[2] = xb_add(&bar[XB_XCNT(b.x)], 1u);
    return b;
}
__device__ __forceinline__ void xcd_barrier_complete(unsigned* bar, unsigned x, unsigned& nloc, unsigned& nx) {
    const unsigned G = gridDim.x * gridDim.y * gridDim.z;
    unsigned sum, cnt, mine, sp = 0u;
    for (;;) {
        sum = 0u; cnt = 0u; mine = 0u;
#pragma unroll
        for (unsigned j = 0; j < 16; ++j) { const unsigned c = xb_ld(&bar[XB_XCNT(j)]); sum += c; cnt += (c > 0u) ? 1u : 0u; mine = (j == x) ? c : mine; }
        if (sum == G) break;
        __builtin_amdgcn_s_sleep(1);
        if ((++sp & 255u) == 0u) { if (xb_ld(&bar[XB_TMO])) break; if (sp > XB_SPIN_CAP) { atomicAdd(&bar[XB_TMO], 1u); break; } }
    }
    nloc = mine > 0u ? mine : 1u; nx = cnt > 0u ? cnt : 1u;
}

__device__ __forceinline__ void xcd_barrier(const XcdBarrier& b) {
    asm volatile("s_waitcnt vmcnt(0)" ::: "memory");
    __syncthreads();
    if (threadIdx.x == 0) {
        unsigned* bar = b.bar;
        __builtin_amdgcn_s_waitcnt(0);
        unsigned nloc = b.st[0], nx = b.st[1];
        if (nloc == 0u) { xcd_barrier_complete(bar, b.x, nloc, nx); b.st[0] = nloc; b.st[1] = nx; }
        const unsigned old = xb_add(&bar[XB_XSUB(b.x)], 1u);
        const unsigned gen = old / nloc;
        if (old + 1u == (gen + 1u) * nloc) {
            __builtin_amdgcn_fence(__ATOMIC_RELEASE, "agent");
            asm volatile("s_waitcnt vmcnt(0)" ::: "memory");
            const unsigned og = xb_add(&bar[XB_TOP], 1u);
            const unsigned tg = og / nx;
            if (og + 1u == (tg + 1u) * nx) xb_add(&bar[XB_TOPGEN], 1u);
            else XB_SPIN(xb_ld(&bar[XB_TOPGEN]) == tg, bar);
            __builtin_amdgcn_fence(__ATOMIC_ACQUIRE, "agent");
            xb_add(&bar[XB_XGEN(b.x)], 1u);
            asm volatile("s_waitcnt vmcnt(0)" ::: "memory");
        } else {
            XB_SPIN(xb_ld(&bar[XB_XGEN(b.x)]) == gen, bar);
            __builtin_amdgcn_fence(__ATOMIC_ACQUIRE, "agent");
            asm volatile("s_waitcnt vmcnt(0)" ::: "memory");
        }
    }
    __syncthreads();
}

typedef float f32x16 __attribute__((ext_vector_type(16)));
typedef unsigned v2u __attribute__((ext_vector_type(2)));
typedef int v4i __attribute__((ext_vector_type(4)));
typedef __bf16 bf2_t __attribute__((ext_vector_type(2)));
#define DI __device__ __forceinline__
struct Frame {
    LAS unsigned char* lds;
    volatile LAS unsigned* MISC;
    gu32* ctl;
    int tid, lane, wave, vcu, G;
    const float *x, *norm_mix, *norm_ffn, *w_in, *b_gate, *w_conv, *q_norm, *k_norm, *sinks, *rel_bias, *w_conv_out, *w_attn_out, *w_out, *w_query, *sub_keys, *expert_u, *expert_v;
    float* out;
    bf16 *WIN, *WC, *WA, *WO, *WQ, *SK, *UB, *VB, *XB, *PA, *MIX, *G_, *QP, *Z, *ATT;
    float *RSTD1, *SSQ, *GATE, *ACT; bf16* PARTB; unsigned short* IDX;
};
DI float wave_sum(float v) {
#pragma unroll
    for (int o = 1; o < 64; o <<= 1) v += __shfl_xor(v, o);
    return v;
}
DI float bf_lo(unsigned u) { return __builtin_bit_cast(float, u << 16); }
DI float bf_hi(unsigned u) { return __builtin_bit_cast(float, u & 0xffff0000u); }

DI void p0_transpose_item(const float* W, int K, int N, bf16* WT, const float* gsc, LAS float* scr, int item, int lane) {
    const int nblk = N / 32, kb = item / nblk, nb = item % nblk, k0 = 64 * kb, n0 = 32 * nb;
#pragma unroll 8
    for (int i = 0; i < 32; ++i) { const int kk = 2 * i + (lane >> 5); float v = W[(size_t)(k0 + kk) * N + n0 + (lane & 31)]; if (gsc) v *= gsc[k0 + kk]; scr[kk * 33 + (lane & 31)] = v; }
    LDS_WAIT(); asm volatile("" ::: "memory");
    const int c = lane & 7;
#pragma unroll
    for (int j = 0; j < 4; ++j) { const int n = (lane >> 3) + 8 * j; const LAS float* s = scr + (8 * c) * 33 + n;
        v4u o; o.x = pk2(s[0 * 33], s[1 * 33]); o.y = pk2(s[2 * 33], s[3 * 33]); o.z = pk2(s[4 * 33], s[5 * 33]); o.w = pk2(s[6 * 33], s[7 * 33]);
        *(GAS v4u*)(WT + (size_t)(n0 + n) * K + k0 + 8 * c) = o; }
    LDS_WAIT(); asm volatile("" ::: "memory");
}
DI void p0_convert(Frame& F, const float* src, bf16* dst, size_t n, const float* colscale) {
    const size_t n8 = n / 8, stride = (size_t)F.G * NWAVES * 64;
    for (size_t i = (size_t)F.vcu * NWAVES * 64 + F.tid; i < n8; i += stride) {
        f32x4 a = *(const GAS f32x4*)(src + i * 8), b = *(const GAS f32x4*)(src + i * 8 + 4);
        if (colscale) { const int c = (int)((i * 8) & 1023); const f32x4 s0 = *(const GAS f32x4*)(colscale + c), s1 = *(const GAS f32x4*)(colscale + c + 4); a = a * s0; b = b * s1; }
        v4u o; o.x = pk2(a.x, a.y); o.y = pk2(a.z, a.w); o.z = pk2(b.x, b.y); o.w = pk2(b.z, b.w);
        *(GAS v4u*)(dst + i * 8) = o;
    }
}
constexpr float U_SCALE = 32.f, V_SCALE = 4.f, A_SCALE = 32.f;
DI unsigned pk4_fp8(f32x4 v) { int r = 0; r = __builtin_amdgcn_cvt_pk_fp8_f32(v[0], v[1], r, false); r = __builtin_amdgcn_cvt_pk_fp8_f32(v[2], v[3], r, true); return (unsigned)r; }
DI void p0_convert_fp8(Frame& F, const float* src, unsigned char* dst, size_t n, const float* colscale, float scale, int bidx, int nblk) {
    const int gw = bidx * NWAVES + F.wave, NGW = nblk * NWAVES, lane = F.lane;
    f32x4 cs[4];
#pragma unroll
    for (int q = 0; q < 4; ++q) cs[q] = colscale ? *(const GAS f32x4*)(colscale + 4 * lane + 256 * q) * scale : (f32x4){scale, scale, scale, scale};
    const int nrows = (int)(n / D);
    for (int e = gw; e < nrows; e += NGW) {
        const GAS f32x4* rp = (const GAS f32x4*)(src + (size_t)e * D) + lane;
        f32x4 v[4];
#pragma unroll
        for (int q = 0; q < 4; ++q) v[q] = rp[64 * q];
#pragma unroll
        for (int q = 0; q < 4; ++q) *(GAS unsigned*)(dst + ((size_t)(2 * q + (lane >> 5)) * NEXP + e) * 128 + ((4 * lane) & 127)) = pk4_fp8(v[q] * cs[q]);
    }
}
template <int RB> DI void p0_rows(Frame& F, const float* xrow, bf16* orow) {
    f32x4 v[RB][4]; float s[RB];
#pragma unroll
    for (int r = 0; r < RB; ++r) { const GAS f32x4* xr = (const GAS f32x4*)(xrow + (size_t)r * D) + F.lane;
#pragma unroll
        for (int j = 0; j < 4; ++j) v[r][j] = xr[64 * j]; }
#pragma unroll
    for (int r = 0; r < RB; ++r) { s[r] = 0.f;
#pragma unroll
        for (int j = 0; j < 4; ++j) s[r] += (v[r][j].x * v[r][j].x + v[r][j].y * v[r][j].y) + (v[r][j].z * v[r][j].z + v[r][j].w * v[r][j].w); }
#pragma unroll
    for (int o = 1; o < 64; o <<= 1)
#pragma unroll
        for (int r = 0; r < RB; ++r) s[r] += __shfl_xor(s[r], o);
#pragma unroll
    for (int r = 0; r < RB; ++r) { const float rs = 1.f / sqrtf(s[r] * (1.f / D) + EPS);
        GAS unsigned long long* o8 = (GAS unsigned long long*)(orow + (size_t)r * D) + F.lane;
#pragma unroll
        for (int j = 0; j < 4; ++j) o8[64 * j] = (unsigned long long)pk2(v[r][j].x * rs, v[r][j].y * rs) | ((unsigned long long)pk2(v[r][j].z * rs, v[r][j].w * rs) << 32); }
}
DI void p0_prologue(Frame& F) {
    LAS float* scr = (LAS float*)(F.lds + RING_OFF + F.wave * 16384);
    const int gw = F.vcu * NWAVES + F.wave, NGW = F.G * NWAVES;
    constexpr int I_IN = (D / 64) * (IN_DIM / 32), I_C = (CONV / 64) * (D / 32), I_O = (D / 64) * (D / 32), I_Q = (D / 64) * (PQ / 32);
    constexpr int NITEMS = I_IN + 2 * I_C + I_O + I_Q;
    for (int it = gw; it < NITEMS; it += NGW) {
        int r = it;
        if (r < I_IN) { p0_transpose_item(F.w_in, D, IN_DIM, F.WIN, F.norm_mix, scr, r, F.lane); continue; } r -= I_IN;
        if (r < I_C) { p0_transpose_item(F.w_conv_out, CONV, D, F.WC, nullptr, scr, r, F.lane); continue; } r -= I_C;
        if (r < I_C) { p0_transpose_item(F.w_attn_out, CONV, D, F.WA, nullptr, scr, r, F.lane); continue; } r -= I_C;
        if (r < I_O) { p0_transpose_item(F.w_out, D, D, F.WO, nullptr, scr, r, F.lane); continue; } r -= I_O;
        p0_transpose_item(F.w_query, D, PQ, F.WQ, F.norm_ffn, scr, r, F.lane);
    }
    p0_convert(F, F.sub_keys, F.SK, (size_t)PH * 2 * NKEYS * 128, nullptr);
    for (int m = 4 * gw; m < T; m += 4 * NGW) p0_rows<4>(F, F.x + (size_t)m * D, F.XB + (size_t)m * D);
}

namespace pg8 {
DI float sigmoidf_(float v) { return __builtin_amdgcn_rcpf(1.f + __expf(-v)); }
DI size_t frag_off(int pm, int pn, int NT, int wave, int q, int lane) { return (((((size_t)pm * NT + pn) * 8 + wave) * 16 + q) * 64 + lane) * 8; }
struct EpiProj {
    static constexpr bool PERM = true, AFTER_DRAIN = false, HAS_INIT = false;
    bf16_t* PA; bf16_t* G; const PG8_LAS float* bgl;
    DI void operator()(const f32x4 (&acc)[2][2][4][2], const Unit& u, int wr, int wc, int fr, int fq) const {
        const int row0 = u.pm * BM + wr * 64 + fr; const bool gate = u.pn >= 9;
        const int col0 = (gate ? (u.pn - 9) : u.pn) * BM + wc * 32 + 8 * fq;
        if (!gate) {
#pragma unroll
            for (int ai = 0; ai < 2; ++ai)
#pragma unroll
                for (int m = 0; m < 4; ++m) { bf16_t* rowp = PA + (size_t)(row0 + ai * HALF + m * 16) * PA_W + col0;
#pragma unroll
                    for (int bj = 0; bj < 2; ++bj) { const f32x4 v0 = acc[ai][bj][m][0], v1 = acc[ai][bj][m][1];
                        u32x4 w; w.x = cvt_pk_bf16(v0[0], v0[1]); w.y = cvt_pk_bf16(v0[2], v0[3]); w.z = cvt_pk_bf16(v1[0], v1[1]); w.w = cvt_pk_bf16(v1[2], v1[3]);
                        store16_wt(rowp + bj * HALF, w); } }
        } else {
            f32x4 bv[2][2];
#pragma unroll
            for (int bj = 0; bj < 2; ++bj)
#pragma unroll
                for (int n = 0; n < 2; ++n) bv[bj][n] = *(const PG8_LAS f32x4*)(bgl + col0 + bj * HALF + 4 * n);
#pragma unroll
            for (int ai = 0; ai < 2; ++ai)
#pragma unroll
                for (int m = 0; m < 4; ++m)
#pragma unroll
                    for (int bj = 0; bj < 2; ++bj) { f32x4 v0 = acc[ai][bj][m][0] + bv[bj][0], v1 = acc[ai][bj][m][1] + bv[bj][1];
#pragma unroll
                        for (int j = 0; j < 4; ++j) { v0[j] = sigmoidf_(v0[j]) * 255.f; v1[j] = sigmoidf_(v1[j]) * 255.f; }
                        unsigned g0 = 0u, g1 = 0u;
                        g0 = __builtin_amdgcn_cvt_pk_u8_f32(v0[0], 0, g0); g0 = __builtin_amdgcn_cvt_pk_u8_f32(v0[1], 1, g0); g0 = __builtin_amdgcn_cvt_pk_u8_f32(v0[2], 2, g0); g0 = __builtin_amdgcn_cvt_pk_u8_f32(v0[3], 3, g0);
                        g1 = __builtin_amdgcn_cvt_pk_u8_f32(v1[0], 0, g1); g1 = __builtin_amdgcn_cvt_pk_u8_f32(v1[1], 1, g1); g1 = __builtin_amdgcn_cvt_pk_u8_f32(v1[2], 2, g1); g1 = __builtin_amdgcn_cvt_pk_u8_f32(v1[3], 3, g1);
                        u32x2 gw; gw.x = g0; gw.y = g1;
                        *(u32x2*)((unsigned char*)G + frag_off(u.pm, u.pn - 9, 8, wr * 4 + wc, ai * 8 + m * 2 + bj, fq * 16 + fr)) = gw; }
        }
    }
};
struct EpiMix {
    static constexpr bool PERM = true, AFTER_DRAIN = false, HAS_INIT = false;
    bf16_t* MIX; const bf16_t* G;
    DI void operator()(const f32x4 (&acc)[2][2][4][2], const Unit& u, int wr, int wc, int fr, int fq) const {
        const int wave = wr * 4 + wc, lane = fq * 16 + fr;
        const unsigned char* gp = (const unsigned char*)G + frag_off(u.pm, u.pn + (u.which ? 4 : 0), 8, wave, 0, lane); bf16_t* mp = MIX + frag_off(u.pm, u.pn, 4, wave, 0, lane);
#pragma unroll
        for (int ai = 0; ai < 2; ++ai) {
            u32x2 gv[8]; u32x4 ov[8];
#pragma unroll
            for (int q = 0; q < 8; ++q) gv[q] = *(const u32x2*)(gp + (ai * 8 + q) * 512);
            if (u.which) {
#pragma unroll
                for (int q = 0; q < 8; ++q) ov[q] = *(const u32x4*)(mp + (ai * 8 + q) * 512); }
#pragma unroll
            for (int m = 0; m < 4; ++m)
#pragma unroll
                for (int bj = 0; bj < 2; ++bj) { const int q = m * 2 + bj; const u32x2 g2 = gv[q]; constexpr float GI = 1.f / 255.f;
                    f32x4 v0 = acc[ai][bj][m][0], v1 = acc[ai][bj][m][1];
                    v0[0] *= (float)(g2.x & 0xffu) * GI; v0[1] *= (float)((g2.x >> 8) & 0xffu) * GI; v0[2] *= (float)((g2.x >> 16) & 0xffu) * GI; v0[3] *= (float)(g2.x >> 24) * GI;
                    v1[0] *= (float)(g2.y & 0xffu) * GI; v1[1] *= (float)((g2.y >> 8) & 0xffu) * GI; v1[2] *= (float)((g2.y >> 16) & 0xffu) * GI; v1[3] *= (float)(g2.y >> 24) * GI;
                    if (u.which) { const u32x4 o = ov[q];
                        v0[0] += __builtin_bit_cast(float, o.x << 16); v0[1] += __builtin_bit_cast(float, o.x & 0xffff0000u); v0[2] += __builtin_bit_cast(float, o.y << 16); v0[3] += __builtin_bit_cast(float, o.y & 0xffff0000u);
                        v1[0] += __builtin_bit_cast(float, o.z << 16); v1[1] += __builtin_bit_cast(float, o.z & 0xffff0000u); v1[2] += __builtin_bit_cast(float, o.w << 16); v1[3] += __builtin_bit_cast(float, o.w & 0xffff0000u); }
                    u32x4 w; w.x = cvt_pk_bf16(v0[0], v0[1]); w.y = cvt_pk_bf16(v0[2], v0[3]); w.z = cvt_pk_bf16(v1[0], v1[1]); w.w = cvt_pk_bf16(v1[2], v1[3]);
                    if (u.which) store16_wt(mp + (ai * 8 + q) * 512, w); else *(u32x4*)(mp + (ai * 8 + q) * 512) = w; }
        }
    }
};
struct FragOrder : StaticOrder { static constexpr bool AFRAG = true; };
struct PairOrder : StaticOrder {
    __device__ bool next(int i, Unit& u) const { const bool ok = StaticOrder::next(i >> 1, u); u.which = i & 1; return ok; }
    DI const char* a_base(const Gemm& g, const Unit& u, size_t tstep) const { return (const char*)(u.which ? g.A2 : g.A) + (size_t)u.pm * tstep; }
    DI const char* b_base(const Gemm& g, const Unit& u, size_t tstep) const { return (const char*)(u.which ? g.Bt2 : g.Bt) + (size_t)u.pn * tstep; }
};
struct EpiX1 {
    static constexpr bool PERM = true, AFTER_DRAIN = false, HAS_INIT = true;
    const float* x; bf16_t* XB; float* SSQ;
    DI void init(f32x4 (&acc)[2][2][4][2], const Unit& u, int wr, int wc, int fr, int fq) const {
        const int row0 = u.pm * BM + wr * 64 + fr, col0 = u.pn * BM + wc * 32 + 8 * fq;
#pragma unroll
        for (int ai = 0; ai < 2; ++ai)
#pragma unroll
            for (int m = 0; m < 4; ++m)
#pragma unroll
                for (int bj = 0; bj < 2; ++bj)
#pragma unroll
                    for (int n = 0; n < 2; ++n) acc[ai][bj][m][n] = *(const f32x4*)(x + (size_t)(row0 + ai * HALF + m * 16) * D + col0 + bj * HALF + 4 * n);
    }
    DI void operator()(const f32x4 (&acc)[2][2][4][2], const Unit& u, int wr, int wc, int fr, int fq) const {
        const int row0 = u.pm * BM + wr * 64 + fr, col0 = u.pn * BM + wc * 32 + 8 * fq;
#pragma unroll
        for (int ai = 0; ai < 2; ++ai)
#pragma unroll
            for (int m = 0; m < 4; ++m) { const int row = row0 + ai * HALF + m * 16; float ss = 0.f;
#pragma unroll
                for (int bj = 0; bj < 2; ++bj) { const f32x4 v0 = acc[ai][bj][m][0], v1 = acc[ai][bj][m][1];
                    ss += ((v0[0] * v0[0] + v0[1] * v0[1]) + (v0[2] * v0[2] + v0[3] * v0[3])) + ((v1[0] * v1[0] + v1[1] * v1[1]) + (v1[2] * v1[2] + v1[3] * v1[3]));
                    u32x4 w; w.x = cvt_pk_bf16(v0[0], v0[1]); w.y = cvt_pk_bf16(v0[2], v0[3]); w.z = cvt_pk_bf16(v1[0], v1[1]); w.w = cvt_pk_bf16(v1[2], v1[3]);
                    store16_wt(XB + (size_t)row * D + col0 + bj * HALF, w); }
                ss += __shfl_xor(ss, 16); ss += __shfl_xor(ss, 32);
                if (fq == 0) SSQ[(size_t)row * 16 + u.pn * 4 + wc] = ss; }
    }
};
DI float rstd2_of(const float* SSQ, int row) {
    const f32x4 a = *(const f32x4*)(SSQ + (size_t)row * 16), b = *(const f32x4*)(SSQ + (size_t)row * 16 + 4), c = *(const f32x4*)(SSQ + (size_t)row * 16 + 8), d = *(const f32x4*)(SSQ + (size_t)row * 16 + 12);
    const float s = ((a[0] + a[1]) + (a[2] + a[3])) + ((b[0] + b[1]) + (b[2] + b[3])) + ((c[0] + c[1]) + (c[2] + c[3])) + ((d[0] + d[1]) + (d[2] + d[3]));
    return 1.f / sqrtf(s * (1.f / D) + EPS);
}
struct EpiQP {
    static constexpr bool PERM = true, AFTER_DRAIN = false, HAS_INIT = false;
    bf16_t* QP;
    DI void operator()(const f32x4 (&acc)[2][2][4][2], const Unit& u, int wr, int wc, int fr, int fq) const {
        const int row0 = u.pm * BM + wr * 64 + fr, col0 = u.pn * BM + wc * 32 + 8 * fq;
#pragma unroll
        for (int ai = 0; ai < 2; ++ai)
#pragma unroll
            for (int m = 0; m < 4; ++m) {
#pragma unroll
                for (int bj = 0; bj < 2; ++bj) { const f32x4 v0 = acc[ai][bj][m][0], v1 = acc[ai][bj][m][1];
                    u32x4 w; w.x = cvt_pk_bf16(v0[0], v0[1]); w.y = cvt_pk_bf16(v0[2], v0[3]); w.z = cvt_pk_bf16(v1[0], v1[1]); w.w = cvt_pk_bf16(v1[2], v1[3]);
                    *(u32x4*)(QP + frag_off(u.pm, u.pn, 8, wr * 4 + wc, ai * 8 + m * 2 + bj, fq * 16 + fr)) = w; } }
    }
};
}

#define MFMA32(a, b, c) __builtin_amdgcn_mfma_f32_32x32x16_bf16((a), (b), (c), 0, 0, 0)
DI void p2_conv(Frame& F) {
    constexpr int CT = 4;
    const size_t NT_ = (size_t)F.G * NWAVES * 64;
    for (size_t item = (size_t)F.vcu * NWAVES * 64 + F.tid; item < (size_t)(T / CT) * 64; item += NT_) {
        const int tb = (int)(item >> 6) * CT, c0 = (int)(item & 63) * 8, tl = tb & (SEQ - 1);
        v4u cg[CT + 2], uu[CT + 2], bg[CT];
#pragma unroll
        for (int r = 0; r < CT + 2; ++r) { const bool ok = (tl + r - 2) >= 0; const bf16* rowp = F.PA + (size_t)(tb + (ok ? r - 2 : 0)) * PA_W;
            cg[r] = *(const GAS v4u*)(rowp + C_C + c0); uu[r] = *(const GAS v4u*)(rowp + C_U + c0);
            if (!ok) { cg[r] = (v4u){0u, 0u, 0u, 0u}; } }
#pragma unroll
        for (int r = 0; r < CT; ++r) bg[r] = *(const GAS v4u*)(F.PA + (size_t)(tb + r) * PA_W + C_B + c0);
        f32x4 w[3][2];
#pragma unroll
        for (int j = 0; j < 3; ++j) { w[j][0] = *(const GAS f32x4*)(F.w_conv + j * CONV + c0); w[j][1] = *(const GAS f32x4*)(F.w_conv + j * CONV + c0 + 4); }
        float h[CT + 2][8];
#pragma unroll
        for (int r = 0; r < CT + 2; ++r) { h[r][0] = bf_lo(cg[r].x) * bf_lo(uu[r].x); h[r][1] = bf_hi(cg[r].x) * bf_hi(uu[r].x); h[r][2] = bf_lo(cg[r].y) * bf_lo(uu[r].y); h[r][3] = bf_hi(cg[r].y) * bf_hi(uu[r].y);
            h[r][4] = bf_lo(cg[r].z) * bf_lo(uu[r].z); h[r][5] = bf_hi(cg[r].z) * bf_hi(uu[r].z); h[r][6] = bf_lo(cg[r].w) * bf_lo(uu[r].w); h[r][7] = bf_hi(cg[r].w) * bf_hi(uu[r].w); }
#pragma unroll
        for (int r = 0; r < CT; ++r) {
            float a[8];
#pragma unroll
            for (int e = 0; e < 8; ++e) a[e] = w[0][e >> 2][e & 3] * h[r][e] + w[1][e >> 2][e & 3] * h[r + 1][e] + w[2][e >> 2][e & 3] * h[r + 2][e];
            v4u o; o.x = pk2(a[0] * bf_lo(bg[r].x), a[1] * bf_hi(bg[r].x)); o.y = pk2(a[2] * bf_lo(bg[r].y), a[3] * bf_hi(bg[r].y));
            o.z = pk2(a[4] * bf_lo(bg[r].z), a[5] * bf_hi(bg[r].z)); o.w = pk2(a[6] * bf_lo(bg[r].w), a[7] * bf_hi(bg[r].w));
            *(GAS v4u*)(F.Z + (size_t)(tb + r) * CONV + c0) = o;
        }
    }
}
DI int t5_bucket(int d) {
    if (d < 16) return d;
    const int large = 16 + (int)(logf((float)d / 16.f) / logf(8.f) * 16.f);
    return large < 31 ? large : 31;
}
constexpr int KS_STRIDE = 72, VT_STRIDE = 264;
constexpr int ATT_KS = 0, ATT_VT = 256 * KS_STRIDE * 2, ATT_BIAS = ATT_VT + 64 * VT_STRIDE * 2, ATT_END = ATT_BIAS + 4 * 128 * 4;
static_assert(ATT_END <= RING_BYTES, "attention LDS");
DI void p2_attention(Frame& F) {
    LAS bf16* KS = (LAS bf16*)(F.lds + ATT_KS); LAS bf16* VT = (LAS bf16*)(F.lds + ATT_VT); LAS float* BIAS = (LAS float*)(F.lds + ATT_BIAS);
    const int lane = F.lane, r = lane & 31, hh = lane >> 5;
#pragma unroll 1
    for (int unit = F.vcu; unit < 8 * 32 * NKV; unit += F.G) {
        const int kv = unit & 1, n = (unit >> 1) & 31, b = unit >> 6;
        const int t0 = b * SEQ + n * 128;
        __syncthreads();
        {
            const int j = F.tid >> 1, hf = F.tid & 1; const bool valid = (n > 0) || (j >= 128);
            const bf16* rowp = F.PA + (size_t)(t0 - 128 + j) * PA_W;
            v4u kq[4], vq[4];
#pragma unroll
            for (int i = 0; i < 4; ++i) { kq[i] = (v4u){0u, 0u, 0u, 0u}; vq[i] = kq[i]; }
            if (valid) {
#pragma unroll
                for (int i = 0; i < 4; ++i) { kq[i] = *(const GAS v4u*)(rowp + C_K + kv * HD + hf * 32 + i * 8); vq[i] = *(const GAS v4u*)(rowp + C_V + kv * HD + hf * 32 + i * 8); }
            }
            float kf[32]; float ss = 0.f;
#pragma unroll
            for (int i = 0; i < 4; ++i) { kf[8 * i + 0] = bf_lo(kq[i].x); kf[8 * i + 1] = bf_hi(kq[i].x); kf[8 * i + 2] = bf_lo(kq[i].y); kf[8 * i + 3] = bf_hi(kq[i].y);
                kf[8 * i + 4] = bf_lo(kq[i].z); kf[8 * i + 5] = bf_hi(kq[i].z); kf[8 * i + 6] = bf_lo(kq[i].w); kf[8 * i + 7] = bf_hi(kq[i].w); }
#pragma unroll
            for (int e = 0; e < 32; ++e) ss += kf[e] * kf[e];
            ss += __shfl_xor(ss, 1);
            const float rs = 1.f / sqrtf(ss * (1.f / HD) + EPS);
#pragma unroll
            for (int i = 0; i < 4; ++i) { const f32x4 g0 = *(const GAS f32x4*)(F.k_norm + hf * 32 + 8 * i), g1 = *(const GAS f32x4*)(F.k_norm + hf * 32 + 8 * i + 4);
                v4u o; o.x = pk2(kf[8 * i + 0] * rs * g0[0], kf[8 * i + 1] * rs * g0[1]); o.y = pk2(kf[8 * i + 2] * rs * g0[2], kf[8 * i + 3] * rs * g0[3]);
                o.z = pk2(kf[8 * i + 4] * rs * g1[0], kf[8 * i + 5] * rs * g1[1]); o.w = pk2(kf[8 * i + 6] * rs * g1[2], kf[8 * i + 7] * rs * g1[3]);
                *(LAS v4u*)(KS + j * KS_STRIDE + hf * 32 + 8 * i) = o; }
#pragma unroll
            for (int i = 0; i < 4; ++i) { const int d0 = hf * 32 + 8 * i;
                VT[(d0 + 0) * VT_STRIDE + j] = (bf16)(vq[i].x & 0xffffu); VT[(d0 + 1) * VT_STRIDE + j] = (bf16)(vq[i].x >> 16);
                VT[(d0 + 2) * VT_STRIDE + j] = (bf16)(vq[i].y & 0xffffu); VT[(d0 + 3) * VT_STRIDE + j] = (bf16)(vq[i].y >> 16);
                VT[(d0 + 4) * VT_STRIDE + j] = (bf16)(vq[i].z & 0xffffu); VT[(d0 + 5) * VT_STRIDE + j] = (bf16)(vq[i].z >> 16);
                VT[(d0 + 6) * VT_STRIDE + j] = (bf16)(vq[i].w & 0xffffu); VT[(d0 + 7) * VT_STRIDE + j] = (bf16)(vq[i].w >> 16); }
            { const int g = F.tid >> 7, dist = F.tid & 127; BIAS[F.tid] = F.rel_bias[t5_bucket(dist) * NH + kv * 4 + g]; }
        }
        __syncthreads();
#pragma unroll 1
        for (int task = F.wave; task < 16; task += NWAVES) {
            const int g = task >> 2, c = task & 3, head = kv * 4 + g, r0 = 32 * c;
            bf16x8 qf[4];
            {
                const bf16* qp = F.PA + (size_t)(t0 + r0 + r) * PA_W + C_Q + head * HD + 8 * hh;
                v4u qq[4]; float qv[32]; float ss = 0.f;
#pragma unroll
                for (int s = 0; s < 4; ++s) qq[s] = *(const GAS v4u*)(qp + 16 * s);
#pragma unroll
                for (int s = 0; s < 4; ++s) { qv[8 * s + 0] = bf_lo(qq[s].x); qv[8 * s + 1] = bf_hi(qq[s].x); qv[8 * s + 2] = bf_lo(qq[s].y); qv[8 * s + 3] = bf_hi(qq[s].y);
                    qv[8 * s + 4] = bf_lo(qq[s].z); qv[8 * s + 5] = bf_hi(qq[s].z); qv[8 * s + 6] = bf_lo(qq[s].w); qv[8 * s + 7] = bf_hi(qq[s].w); }
#pragma unroll
                for (int e = 0; e < 32; ++e) ss += qv[e] * qv[e];
                ss += __shfl_xor(ss, 32);
                const float rs = 0.125f / sqrtf(ss * (1.f / HD) + EPS);
#pragma unroll
                for (int s = 0; s < 4; ++s) { const f32x4 g0 = *(const GAS f32x4*)(F.q_norm + 16 * s + 8 * hh), g1 = *(const GAS f32x4*)(F.q_norm + 16 * s + 8 * hh + 4);
                    v4u o; o.x = pk2(qv[8 * s + 0] * rs * g0[0], qv[8 * s + 1] * rs * g0[1]); o.y = pk2(qv[8 * s + 2] * rs * g0[2], qv[8 * s + 3] * rs * g0[3]);
                    o.z = pk2(qv[8 * s + 4] * rs * g1[0], qv[8 * s + 5] * rs * g1[1]); o.w = pk2(qv[8 * s + 6] * rs * g1[2], qv[8 * s + 7] * rs * g1[3]);
                    qf[s] = __builtin_bit_cast(bf16x8, o); }
            }
            f32x16 sacc[5];
#pragma unroll
            for (int i5 = 0; i5 < 5; ++i5) {
#pragma unroll
                for (int e = 0; e < 16; ++e) sacc[i5][e] = 0.f;
                const int kt = c + i5;
#pragma unroll
                for (int s = 0; s < 4; ++s) { const bf16x8 ka = *(const LAS bf16x8*)(KS + (32 * kt + r) * KS_STRIDE + 16 * s + 8 * hh); sacc[i5] = MFMA32(ka, qf[s], sacc[i5]); }
            }
            const float sink = F.sinks[head];
            const int dbase = r - 4 * hh + 128;
            const LAS float* bl = BIAS + g * 128;
            float mx = sink;
#pragma unroll
            for (int i5 = 0; i5 < 5; ++i5) {
                const bool tile_ok = (n > 0) || (c + i5 >= 4);
#pragma unroll
                for (int e = 0; e < 16; ++e) { const int dist = dbase - 32 * i5 - ((e & 3) + 8 * (e >> 2));
                    bool valid = tile_ok; if (i5 == 0) valid = valid && (dist < 128); if (i5 == 4) valid = valid && (dist >= 0);
                    const float lg = sacc[i5][e] + bl[dist & 127];
                    sacc[i5][e] = valid ? lg : -INFINITY; mx = fmaxf(mx, sacc[i5][e]); }
                __builtin_amdgcn_sched_barrier(0);
            }
            mx = fmaxf(mx, __shfl_xor(mx, 32));
            float sum = 0.f;
#pragma unroll
            for (int i5 = 0; i5 < 5; ++i5)
#pragma unroll
                for (int e = 0; e < 16; ++e) { const float p = __expf(sacc[i5][e] - mx); sacc[i5][e] = p; sum += p; }
            sum += __shfl_xor(sum, 32);
            const float inv = 1.f / (sum + __expf(sink - mx));
            f32x16 oacc[2];
#pragma unroll
            for (int dt = 0; dt < 2; ++dt)
#pragma unroll
                for (int e = 0; e < 16; ++e) oacc[dt][e] = 0.f;
#pragma unroll
            for (int i5 = 0; i5 < 5; ++i5)
#pragma unroll
                for (int s2 = 0; s2 < 2; ++s2) {
                    v4u pp; pp.x = pk2(sacc[i5][8 * s2 + 0] * inv, sacc[i5][8 * s2 + 1] * inv); pp.y = pk2(sacc[i5][8 * s2 + 2] * inv, sacc[i5][8 * s2 + 3] * inv);
                    pp.z = pk2(sacc[i5][8 * s2 + 4] * inv, sacc[i5][8 * s2 + 5] * inv); pp.w = pk2(sacc[i5][8 * s2 + 6] * inv, sacc[i5][8 * s2 + 7] * inv);
                    const bf16x8 pb = __builtin_bit_cast(bf16x8, pp);
                    const int kb = 32 * (c + i5) + 16 * s2 + 4 * hh;
#pragma unroll
                    for (int dt = 0; dt < 2; ++dt) {
                        const v2u lo = *(const LAS v2u*)(VT + (32 * dt + r) * VT_STRIDE + kb), hi = *(const LAS v2u*)(VT + (32 * dt + r) * VT_STRIDE + kb + 8);
                        v4u va; va.x = lo.x; va.y = lo.y; va.z = hi.x; va.w = hi.y;
                        oacc[dt] = MFMA32(__builtin_bit_cast(bf16x8, va), pb, oacc[dt]);
                    }
                    __builtin_amdgcn_sched_barrier(0);
                }
            bf16* op = F.ATT + (size_t)(t0 + r0 + r) * CONV + head * HD;
#pragma unroll
            for (int dt = 0; dt < 2; ++dt)
#pragma unroll
                for (int g4 = 0; g4 < 4; ++g4) { v2u w; w.x = pk2(oacc[dt][4 * g4 + 0], oacc[dt][4 * g4 + 1]); w.y = pk2(oacc[dt][4 * g4 + 2], oacc[dt][4 * g4 + 3]);
#ifdef ZERO_ATT
                    w.x = 0u; w.y = 0u;
#endif
                    *(GAS v2u*)(op + 32 * dt + 8 * g4 + 4 * hh) = w; }
        }
    }
}

DI unsigned f2ord(float f) { const unsigned b = __builtin_bit_cast(unsigned, f); return b ^ ((b >> 31) ? 0xffffffffu : 0x80000000u); }
DI float ord2f(unsigned k) { const unsigned b = k ^ ((k >> 31) ? 0x80000000u : 0xffffffffu); return __builtin_bit_cast(float, b); }
DI unsigned umax_(unsigned a, unsigned b) { return a > b ? a : b; }
DI unsigned umin_(unsigned a, unsigned b) { return a < b ? a : b; }
DI void sort16_desc(unsigned (&v)[16]) {
#pragma unroll
    for (int k = 2; k <= 16; k <<= 1)
#pragma unroll
        for (int j = k >> 1; j > 0; j >>= 1)
#pragma unroll
            for (int i = 0; i < 16; ++i) { const int l = i ^ j; if (l > i) { const bool desc = ((i & k) == 0) || (k == 16); const unsigned a = v[i], b = v[l], hi = umax_(a, b), lo = umin_(a, b); v[i] = desc ? hi : lo; v[l] = desc ? lo : hi; } }
}
DI void merge_top16(unsigned (&a)[16], const unsigned (&b)[16]) {
#pragma unroll
    for (int i = 0; i < 16; ++i) a[i] = umax_(a[i], b[15 - i]);
#pragma unroll
    for (int j = 8; j > 0; j >>= 1)
#pragma unroll
        for (int i = 0; i < 16; ++i) { const int l = i ^ j; if (l > i) { const unsigned x = a[i], y = a[l]; a[i] = umax_(x, y); a[l] = umin_(x, y); } }
}
constexpr int SK_STRIDE = 136;
constexpr int P6_KEYS = 0, P6_IB = 2 * NKEYS * SK_STRIDE * 2, P6_END = P6_IB + NWAVES * 64 * 32;
static_assert(P6_END <= RING_BYTES, "topk LDS");
DI void p6_topk(Frame& F) {
    LAS bf16* KL = (LAS bf16*)(F.lds + P6_KEYS); LAS unsigned char* IB = F.lds + P6_IB + (F.wave * 64 + F.lane) * 32;
    const int lane = F.lane, r = lane & 31, hh = lane >> 5;
    pg8::StaticOrder S; S.init(T, PQ, F.G, (int)blockIdx.x);
    pg8::Unit pu;
    for (int ui = 0; S.next(ui, pu); ++ui) {
        const int h = pu.pn, tile = pu.pm;
        __syncthreads();
        {
            const bf16* src = F.SK + (size_t)h * 2 * NKEYS * 128;
#pragma unroll
            for (int i = 0; i < 8; ++i) { const int ch = F.tid + 512 * i; const int row = ch >> 4, c8 = (ch & 15) * 8;
                *(LAS v4u*)(KL + row * SK_STRIDE + c8) = *(const GAS v4u*)(src + (size_t)row * 128 + c8); }
        }
        __syncthreads();
        const int t = tile * 256 + F.wave * 32 + r;
        unsigned S[2][16];
#pragma unroll
        for (int p = 0; p < 2; ++p) {
            bf16x8 qf[8];
            const int rt = F.wave * 32 + r, q_ai = rt >> 7, q_wr = (rt >> 6) & 1, q_m = (rt >> 4) & 3, q_fr = rt & 15;
#pragma unroll
            for (int s = 0; s < 8; ++s) qf[s] = __builtin_bit_cast(bf16x8, *(const GAS v4u*)(F.QP + pg8::frag_off(tile, h, 8, q_wr * 4 + (s >> 1), q_ai * 8 + q_m * 2 + p, (2 * (s & 1) + hh) * 16 + q_fr)));
            unsigned key[4][16];
#pragma unroll
            for (int kt = 0; kt < 4; ++kt) {
                f32x16 acc;
#pragma unroll
                for (int e = 0; e < 16; ++e) acc[e] = 0.f;
#pragma unroll
                for (int s = 0; s < 8; ++s) { const bf16x8 ka = *(const LAS bf16x8*)(KL + (p * NKEYS + 32 * kt + r) * SK_STRIDE + 16 * s + 8 * hh); acc = MFMA32(ka, qf[s], acc); }
#pragma unroll
                for (int e = 0; e < 16; ++e) { const int nk = 32 * kt + (e & 3) + 8 * (e >> 2) + 4 * hh; key[kt][e] = (f2ord(acc[e]) & ~127u) | (unsigned)(127 - nk); }
            }
#pragma unroll
            for (int kt = 0; kt < 4; ++kt) sort16_desc(key[kt]);
            merge_top16(key[0], key[1]); merge_top16(key[2], key[3]); merge_top16(key[0], key[2]);
            unsigned other[16];
#pragma unroll
            for (int i = 0; i < 16; ++i) other[i] = (unsigned)__shfl_xor((int)key[0][i], 32);
            merge_top16(key[0], other);
#pragma unroll
            for (int i = 0; i < 16; ++i) S[p][i] = key[0][i];
        }
        float s0[16], s1[16]; const float rs2 = pg8::rstd2_of(F.SSQ, t);
#pragma unroll
        for (int i = 0; i < 16; ++i) { s0[i] = ord2f(S[0][i] & ~127u) * rs2; s1[i] = ord2f(S[1][i] & ~127u) * rs2; }
        {
#pragma unroll
            for (int q4 = 0; q4 < 4; ++q4) { unsigned w0 = 0, w1 = 0;
#pragma unroll
                for (int e = 0; e < 4; ++e) { w0 |= (127u - (S[0][4 * q4 + e] & 127u)) << (8 * e); w1 |= (127u - (S[1][4 * q4 + e] & 127u)) << (8 * e); }
                *(LAS unsigned*)(IB + 4 * q4) = w0; *(LAS unsigned*)(IB + 16 + 4 * q4) = w1; }
        }
        unsigned cand[2][16];
#pragma unroll
        for (int i = 0; i < 2; ++i)
#pragma unroll
            for (int e = 0; e < 16; ++e) cand[i][e] = 0u;
        {
            int cnt = 0; float ea = 0.f, eb = 0.f; int ep = 0;
#pragma unroll
            for (int a = 0; a < 16; ++a)
#pragma unroll
                for (int b = 0; b < 16; ++b)
                    if ((a + 1) * (b + 1) <= 16) {
                        if ((cnt & 1) == 0) { ea = s0[a]; eb = s1[b]; ep = 255 - (a * 16 + b); }
                        else { const int slot = cnt >> 1; const float sa = hh ? s0[a] : ea, sb = hh ? s1[b] : eb; const int pp = hh ? 255 - (a * 16 + b) : ep;
                            cand[slot & 1][slot >> 1] = (f2ord(sa + sb) & ~255u) | (unsigned)pp; }
                        ++cnt; }
        }
        sort16_desc(cand[0]); sort16_desc(cand[1]); merge_top16(cand[0], cand[1]);
        {
            unsigned other[16];
#pragma unroll
            for (int i = 0; i < 16; ++i) other[i] = (unsigned)__shfl_xor((int)cand[0][i], 32);
            merge_top16(cand[0], other);
        }
        float gv[16]; int ev[16]; float gsum = 0.f; const float gmx = ord2f(cand[0][0] & ~255u);
#pragma unroll
        for (int i = 0; i < 16; ++i) { const unsigned k = cand[0][i]; const int pos = 255 - (int)(k & 255u); const int a = pos >> 4, b = pos & 15;
            ev[i] = (int)IB[a] * NKEYS + (int)IB[16 + b]; gv[i] = __expf(ord2f(k & ~255u) - gmx); gsum += gv[i]; }
        float ginv = 1.f / gsum;
#ifdef UNIFORM_GATES
#pragma unroll
        for (int i = 0; i < 16; ++i) gv[i] = 1.f;
        ginv = 1.f / 16.f;
#endif
        if (hh == 0) {
            unsigned short* ip = F.IDX + (size_t)t * NSEL + h * TOPK; float* gp = F.GATE + (size_t)t * NSEL + h * TOPK;
#pragma unroll
            for (int i = 0; i < 2; ++i) *(GAS v4i*)(ip + 8 * i) = (v4i){ev[8 * i] | (ev[8 * i + 1] << 16), ev[8 * i + 2] | (ev[8 * i + 3] << 16), ev[8 * i + 4] | (ev[8 * i + 5] << 16), ev[8 * i + 6] | (ev[8 * i + 7] << 16)};
#pragma unroll
            for (int i = 0; i < 4; ++i) *(GAS f32x4*)(gp + 4 * i) = (f32x4){gv[4 * i] * ginv, gv[4 * i + 1] * ginv, gv[4 * i + 2] * ginv, gv[4 * i + 3] * ginv};
        }
    }
}

typedef float f32x2_t __attribute__((ext_vector_type(2)));
DI void fp8x16_to_f32(v4u q, float (&f)[16]) {
#pragma unroll
    for (int w = 0; w < 4; ++w) { const f32x2_t lo = __builtin_amdgcn_cvt_pk_f32_fp8((int)q[w], false), hi = __builtin_amdgcn_cvt_pk_f32_fp8((int)q[w], true);
        f[4 * w + 0] = lo.x; f[4 * w + 1] = lo.y; f[4 * w + 2] = hi.x; f[4 * w + 3] = hi.y; }
}
struct XccInfo { int q, nx, nloc, rank; };
DI void xcc_info_build(const XcdBarrier& b) {
    if (threadIdx.x == 0) {
        unsigned q = 0, nx = 0, nloc = 1;
        for (unsigned j = 0; j < 16; ++j) { const unsigned c = xb_ld(&b.bar[XB_XCNT(j)]); if (c > 0u) { if (j < b.x) ++q; ++nx; } if (j == b.x) nloc = c; }
        b.st[3] = q; b.st[4] = nx > 0u ? nx : 1u; b.st[5] = nloc > 0u ? nloc : 1u;
    }
    __syncthreads();
}
DI XccInfo xcc_info(const XcdBarrier& b) {
    XccInfo I; I.rank = __builtin_amdgcn_readfirstlane((int)b.st[2]); I.q = __builtin_amdgcn_readfirstlane((int)b.st[3]); I.nx = __builtin_amdgcn_readfirstlane((int)b.st[4]); I.nloc = __builtin_amdgcn_readfirstlane((int)b.st[5]);
    return I;
}
DI float dpp_sum8(float s) {
    s += __builtin_bit_cast(float, __builtin_amdgcn_update_dpp(0, __builtin_bit_cast(int, s), 0xB1, 0xf, 0xf, false));
    s += __builtin_bit_cast(float, __builtin_amdgcn_update_dpp(0, __builtin_bit_cast(int, s), 0x4E, 0xf, 0xf, false));
    s += __builtin_bit_cast(float, __builtin_amdgcn_update_dpp(0, __builtin_bit_cast(int, s), 0x141, 0xf, 0xf, false));
    return s;
}
typedef long i64_t;
typedef long i64x2 __attribute__((ext_vector_type(2)));
constexpr int PEER_ROW = 144, PEER_WAVE_LDS = 128 * PEER_ROW;
#define P7_IDS(t_, ia_, ib_) do { ia_ = (int)F.IDX[(size_t)(t_) * NSEL + lane]; ib_ = (int)F.IDX[(size_t)(t_) * NSEL + 64 + lane]; } while (0)
#define P7_ISSUE(t_, ia_, ib_, uq_, x_) do { \
        const bf16* xr_ = F.XB + (size_t)(t_) * D + sl * 128 + 32 * g; \
        _Pragma("unroll") for (int q = 0; q < 4; ++q) x_[q] = *(const GAS v4u*)(xr_ + 8 * q); \
        _Pragma("unroll") for (int ld = 0; ld < 16; ++ld) { const int e_ = __shfl(ld < 8 ? ia_ : ib_, (8 * ld + row8) & 63); uq_[ld] = *(const GAS v4u*)(Us + (unsigned)(e_ * 128 + 16 * c8)); } } while (0)
#define P7_COMPUTE(t_, uq_, x_) do { \
        _Pragma("unroll") for (int ld = 0; ld < 16; ++ld) *(LAS v4u*)(wl + (8 * ld + row8) * PEER_ROW + 16 * c8) = uq_[ld]; \
        i64_t xk[4]; \
        _Pragma("unroll") for (int s2 = 0; s2 < 4; ++s2) { const v4u v_ = x_[s2]; \
            int lo_ = 0, hi_ = 0; \
            lo_ = __builtin_amdgcn_cvt_pk_fp8_f32(bf_lo(v_.x), bf_hi(v_.x), lo_, false); lo_ = __builtin_amdgcn_cvt_pk_fp8_f32(bf_lo(v_.y), bf_hi(v_.y), lo_, true); \
            hi_ = __builtin_amdgcn_cvt_pk_fp8_f32(bf_lo(v_.z), bf_hi(v_.z), hi_, false); hi_ = __builtin_amdgcn_cvt_pk_fp8_f32(bf_lo(v_.w), bf_hi(v_.w), hi_, true); \
            xk[s2] = (i64_t)(((unsigned long long)(unsigned)hi_ << 32) | (unsigned long long)(unsigned)lo_); } \
        f32x4 keep = {0.f, 0.f, 0.f, 0.f}; \
        _Pragma("unroll") for (int j = 0; j < 8; ++j) { f32x4 c_ = {0.f, 0.f, 0.f, 0.f}; \
            const i64x2 a0_ = *(const LAS i64x2*)(wl + (16 * j + m) * PEER_ROW + 32 * g), a1_ = *(const LAS i64x2*)(wl + (16 * j + m) * PEER_ROW + 32 * g + 16); \
            c_ = __builtin_amdgcn_mfma_f32_16x16x32_fp8_fp8(a0_[0], xk[0], c_, 0, 0, 0); c_ = __builtin_amdgcn_mfma_f32_16x16x32_fp8_fp8(a0_[1], xk[1], c_, 0, 0, 0); \
            c_ = __builtin_amdgcn_mfma_f32_16x16x32_fp8_fp8(a1_[0], xk[2], c_, 0, 0, 0); c_ = __builtin_amdgcn_mfma_f32_16x16x32_fp8_fp8(a1_[1], xk[3], c_, 0, 0, 0); \
            keep = (m == j) ? c_ : keep; } \
        { const bool ok_ = (m < 8) && ((t_) < T); bf16* dst_ = ok_ ? F.PARTB + ((size_t)sl * T + (t_)) * NSEL + 16 * m + 4 * g : F.PARTB + (size_t)8 * T * NSEL + 4 * lane; \
          v2u w_; w_.x = pk2(keep[0], keep[1]); w_.y = pk2(keep[2], keep[3]); *(GAS v2u*)dst_ = w_; } } while (0)
#define P7V_ISSUE(t_, ia_, ib_, uq_, x0_, x1_) do { \
        const bf16* xr_ = F.XB + (size_t)(t_) * D + sl * 128 + 16 * c8; x0_ = *(const GAS v4u*)xr_; x1_ = *(const GAS v4u*)(xr_ + 8); \
        _Pragma("unroll") for (int ld = 0; ld < 16; ++ld) { const int e_ = __shfl(ld < 8 ? ia_ : ib_, (8 * ld + row8) & 63); uq_[ld] = *(const GAS v4u*)(Us + (unsigned)(e_ * 128 + 16 * c8)); } } while (0)
#define P7V_COMPUTE(t_, uq_, x0_, x1_) do { \
        float xf[16]; \
        xf[0] = bf_lo(x0_.x); xf[1] = bf_hi(x0_.x); xf[2] = bf_lo(x0_.y); xf[3] = bf_hi(x0_.y); xf[4] = bf_lo(x0_.z); xf[5] = bf_hi(x0_.z); xf[6] = bf_lo(x0_.w); xf[7] = bf_hi(x0_.w); \
        xf[8] = bf_lo(x1_.x); xf[9] = bf_hi(x1_.x); xf[10] = bf_lo(x1_.y); xf[11] = bf_hi(x1_.y); xf[12] = bf_lo(x1_.z); xf[13] = bf_hi(x1_.z); xf[14] = bf_lo(x1_.w); xf[15] = bf_hi(x1_.w); \
        { v4u xq_;   \
          _Pragma("unroll") for (int w_ = 0; w_ < 4; ++w_) { int p_ = 0; p_ = __builtin_amdgcn_cvt_pk_fp8_f32(xf[4 * w_], xf[4 * w_ + 1], p_, false); p_ = __builtin_amdgcn_cvt_pk_fp8_f32(xf[4 * w_ + 2], xf[4 * w_ + 3], p_, true); xq_[w_] = (unsigned)p_; } \
          fp8x16_to_f32(xq_, xf); } \
        float res0 = 0.f, res1 = 0.f; \
        _Pragma("unroll") for (int ld = 0; ld < 16; ++ld) { float uf[16]; fp8x16_to_f32(uq_[ld], uf); float a0 = 0.f, a1 = 0.f; \
            _Pragma("unroll") for (int e = 0; e < 16; e += 2) { a0 += xf[e] * uf[e]; a1 += xf[e + 1] * uf[e + 1]; } \
            const float d = dpp_sum8(a0 + a1); \
            if (ld < 8) res0 = (c8 == ld) ? d : res0; else res1 = (c8 == ld - 8) ? d : res1; } \
        { bf16* pp_ = ((t_) < T) ? F.PARTB + ((size_t)sl * T + (t_)) * NSEL + 8 * c8 + row8 : F.PARTB + (size_t)8 * T * NSEL + 128 * (lane & 1) + 8 * c8 + row8; \
          pp_[0] = (bf16)f2bf(res0); pp_[64] = (bf16)f2bf(res1); } } while (0)
constexpr int NMF = 8;
DI int peer_next(volatile LAS unsigned* ctr, int lane) { unsigned k = 0u; if (lane == 0) k = __hip_atomic_fetch_add((LAS unsigned*)ctr, 1u, __ATOMIC_RELAXED, __HIP_MEMORY_SCOPE_WORKGROUP); return __builtin_amdgcn_readfirstlane((int)k); }
DI int peer_tok(int tbase, int tstride, int k) { return tbase + (k & 7) + (k >> 3) * tstride; }
DI void p7_udot(Frame& F, const XccInfo& I) {
    const int lane = F.lane, g = lane >> 4, m = lane & 15, row8 = lane >> 3, c8 = lane & 7;
    LAS unsigned char* wl = F.lds + F.wave * PEER_WAVE_LDS;
    const unsigned char* U8 = (const unsigned char*)F.UB;
    const int tstride = I.nloc * NWAVES, tbase = I.rank * NWAVES;
    int it = 0;
    for (int sl = I.q; sl < 8; sl += I.nx, ++it) {
        const unsigned char* Us = U8 + (size_t)sl * NEXP * 128;
        volatile LAS unsigned* ctr = F.MISC + 16 + it;
#define CL(t_) ((t_) < T ? (t_) : T - 1)
#define TOK(k_) peer_tok(tbase, tstride, (k_))
        v4u uqA[16], uqB[16]; int iA0, iA1, iB0, iB1;
        int tA = TOK(peer_next(ctr, lane)), tB = TOK(peer_next(ctr, lane));
        if (F.wave < NMF) {
            v4u xA[4], xB[4];
            P7_IDS(CL(tA), iA0, iA1);
            P7_ISSUE(CL(tA), iA0, iA1, uqA, xA);
            P7_IDS(CL(tB), iB0, iB1);
#pragma unroll 1
            while (tA < T) {
                const int tC = TOK(peer_next(ctr, lane)), tD = TOK(peer_next(ctr, lane));
                P7_IDS(CL(tC), iA0, iA1);
                P7_ISSUE(CL(tB), iB0, iB1, uqB, xB);
                P7_COMPUTE(tA, uqA, xA);
                P7_IDS(CL(tD), iB0, iB1);
                P7_ISSUE(CL(tC), iA0, iA1, uqA, xA);
                P7_COMPUTE(tB, uqB, xB);
                tA = tC; tB = tD;
            }
        } else {
            v4u xA0, xA1, xB0, xB1;
            P7_IDS(CL(tA), iA0, iA1);
            P7V_ISSUE(CL(tA), iA0, iA1, uqA, xA0, xA1);
            P7_IDS(CL(tB), iB0, iB1);
#pragma unroll 1
            while (tA < T) {
                const int tC = TOK(peer_next(ctr, lane)), tD = TOK(peer_next(ctr, lane));
                P7_IDS(CL(tC), iA0, iA1);
                P7V_ISSUE(CL(tB), iB0, iB1, uqB, xB0, xB1);
                P7V_COMPUTE(tA, uqA, xA0, xA1);
                P7_IDS(CL(tD), iB0, iB1);
                P7V_ISSUE(CL(tC), iA0, iA1, uqA, xA0, xA1);
                P7V_COMPUTE(tB, uqB, xB0, xB1);
                tA = tC; tB = tD;
            }
        }
#undef TOK
#undef CL
    }
}
DI void p8_act(Frame& F) {
    const size_t NT_ = (size_t)F.G * NWAVES * 64;
    for (size_t item = (size_t)F.vcu * NWAVES * 64 + F.tid; item < (size_t)T * NSEL / 4; item += NT_) {
        const int t = (int)(item >> 5);
        f32x4 s = {0.f, 0.f, 0.f, 0.f};
#pragma unroll
        for (int sl = 0; sl < 8; ++sl) { const v2u p = *(const GAS v2u*)(F.PARTB + (size_t)sl * T * NSEL + item * 4); s = s + (f32x4){bf_lo(p.x), bf_hi(p.x), bf_lo(p.y), bf_hi(p.y)}; }
        const float rs2 = pg8::rstd2_of(F.SSQ, t) * (1.f / U_SCALE);
        const f32x4 g = *(const GAS f32x4*)(F.GATE + item * 4);
        f32x4 o;
#pragma unroll
        for (int e = 0; e < 4; ++e) { const float pre = s[e] * rs2; o[e] = 0.5f * pre * (1.f + erff(pre * 0.70710678118f)) * g[e] * A_SCALE; }
        ((GAS unsigned*)F.ACT)[item] = pk4_fp8(o);
    }
}
typedef int v2i_t __attribute__((ext_vector_type(2)));
#define P9_IDS(t_, ia_, ib_, ak_) do { ia_ = (int)F.IDX[(size_t)(t_) * NSEL + lane]; ib_ = (int)F.IDX[(size_t)(t_) * NSEL + 64 + lane]; \
        const unsigned char* ap_ = (const unsigned char*)F.ACT + (size_t)(t_) * NSEL + 8 * g; \
        _Pragma("unroll") for (int s2 = 0; s2 < 4; ++s2) ak_[s2] = *(const GAS i64_t*)(ap_ + 32 * s2); } while (0)
#define P9_ISSUE(ia_, ib_, vq_) do { \
        _Pragma("unroll") for (int ld = 0; ld < 16; ++ld) { const int e_ = __shfl(ld < 8 ? ia_ : ib_, (8 * ld + row8) & 63); vq_[ld] = *(const GAS v4u*)(Vs + (unsigned)(e_ * 128 + 16 * c8)); } } while (0)
#define P9_COMPUTE(t_, vq_, ak_) do { \
        _Pragma("unroll") for (int ld = 0; ld < 16; ++ld) *(LAS v4u*)(wl + (8 * ld + row8) * PEER_ROW + 16 * c8) = vq_[ld]; \
        float keep0 = 0.f, keep1 = 0.f; \
        _Pragma("unroll") for (int ct = 0; ct < 8; ++ct) { f32x4 c_ = {0.f, 0.f, 0.f, 0.f}; \
            _Pragma("unroll") for (int s2 = 0; s2 < 4; ++s2) { \
                const v2i_t b_ = __builtin_amdgcn_ds_read_tr8_b64_v2i32((LAS v2i_t*)(wl + (32 * s2 + 8 * g + trr) * PEER_ROW + 16 * ct + 8 * trc)); \
                c_ = __builtin_amdgcn_mfma_f32_16x16x32_fp8_fp8(ak_[s2], __builtin_bit_cast(i64_t, b_), c_, 0, 0, 0); } \
            if (ct < 4) keep0 = (g == ct) ? c_[0] : keep0; else keep1 = (g == ct - 4) ? c_[0] : keep1; }   \
        { const bool ok_ = (t_) < T; const size_t oo_ = (size_t)(ok_ ? (t_) : T - 1) * D + sl * 128 + 16 * g + n16; \
          const float r0_ = __builtin_bit_cast(float, (unsigned)F.XB[oo_] << 16), r1_ = __builtin_bit_cast(float, (unsigned)F.XB[oo_ + 64] << 16); \
          float* op_ = ok_ ? F.out + oo_ : (float*)F.PARTB + 2 * lane;                   \
          op_[0] = r0_ + keep0 * (1.f / (A_SCALE * V_SCALE)); op_[ok_ ? 64 : 1] = r1_ + keep1 * (1.f / (A_SCALE * V_SCALE)); } } while (0)
DI void p9_vacc(Frame& F, const XccInfo& I) {
    const int lane = F.lane, g = lane >> 4, n16 = lane & 15, row8 = lane >> 3, c8 = lane & 7, trr = n16 >> 1, trc = n16 & 1;
    LAS unsigned char* wl = F.lds + F.wave * PEER_WAVE_LDS;
    const unsigned char* V8 = (const unsigned char*)F.VB;
    const int tstride = I.nloc * NWAVES, tfirst = I.rank * NWAVES + F.wave;
    for (int sl = I.q; sl < 8; sl += I.nx) {
        const unsigned char* Vs = V8 + (size_t)sl * NEXP * 128;
        if (tfirst >= T) continue;
        v4u vqA[16], vqB[16]; i64_t akA[4], akB[4]; int iA0, iA1, iB0, iB1;
#define CL(t_) ((t_) < T ? (t_) : T - 1)
        P9_IDS(tfirst, iA0, iA1, akA);
        P9_ISSUE(iA0, iA1, vqA);
        P9_IDS(CL(tfirst + tstride), iB0, iB1, akB);
#pragma unroll 1
        for (int t = tfirst; t < T; t += 2 * tstride) {
            const int t1 = t + tstride, t2 = CL(t + 2 * tstride), t3 = CL(t + 3 * tstride);
            i64_t akN[4];
            i64_t akM[4];
            P9_IDS(t2, iA0, iA1, akN);
            P9_ISSUE(iB0, iB1, vqB);
            P9_COMPUTE(t, vqA, akA);
            P9_IDS(t3, iB0, iB1, akM);
            P9_ISSUE(iA0, iA1, vqA);
            P9_COMPUTE(t1, vqB, akB);
#pragma unroll
            for (int s2 = 0; s2 < 4; ++s2) { akA[s2] = akN[s2]; akB[s2] = akM[s2]; }
        }
#undef CL
    }
}

struct Args { const float* in[17]; float* out; unsigned char* ws; int ph_lo, ph_hi, li, pad; };
__global__ void __launch_bounds__(NWAVES * 64, 2) hyb_fwd(Args args) {
    extern __shared__ __attribute__((aligned(16))) unsigned char lds[];
    Frame F;
    F.lds = (LAS unsigned char*)lds;
    F.MISC = (volatile LAS unsigned*)(F.lds + MISC_OFF);
    F.tid = threadIdx.x; F.lane = F.tid & 63; F.wave = __builtin_amdgcn_readfirstlane(F.tid >> 6);
    F.G = gridDim.x; { const int bx = blockIdx.x; F.vcu = (F.G % 8 == 0) ? (bx % 8) * (F.G / 8) + bx / 8 : bx; }
    unsigned char* ws = args.ws;
    F.ctl = (gu32*)(ws + WS_CTL);
    F.x = args.in[0]; F.norm_mix = args.in[1]; F.norm_ffn = args.in[2]; F.w_in = args.in[3]; F.b_gate = args.in[4]; F.w_conv = args.in[5]; F.q_norm = args.in[6]; F.k_norm = args.in[7];
    F.sinks = args.in[8]; F.rel_bias = args.in[9]; F.w_conv_out = args.in[10]; F.w_attn_out = args.in[11]; F.w_out = args.in[12]; F.w_query = args.in[13]; F.sub_keys = args.in[14];
    F.expert_u = args.in[15]; F.expert_v = args.in[16]; F.out = args.out;
    F.WIN = (bf16*)(ws + WS_WIN); F.WC = (bf16*)(ws + WS_WC); F.WA = (bf16*)(ws + WS_WA); F.WO = (bf16*)(ws + WS_WO); F.WQ = (bf16*)(ws + WS_WQ); F.SK = (bf16*)(ws + WS_SK);
    F.UB = (bf16*)(ws + WS_UB); F.VB = (bf16*)(ws + WS_VB); F.XB = (bf16*)(ws + WS_XB); F.PA = (bf16*)(ws + WS_PA); F.MIX = (bf16*)(ws + WS_MIX); F.G_ = (bf16*)(ws + WS_G); F.QP = (bf16*)(ws + WS_QP);
    F.Z = (bf16*)(ws + WS_Z); F.ATT = (bf16*)(ws + WS_ATT); F.RSTD1 = (float*)(ws + WS_RSTD1); F.SSQ = (float*)(ws + WS_SSQ); F.GATE = (float*)(ws + WS_GATE); F.IDX = (unsigned short*)(ws + WS_IDX); F.PARTB = (bf16*)(ws + WS_PART); F.ACT = (float*)(ws + WS_ACT);
    for (int u = F.tid; u < (LDS_BYTES - LDSCTL_OFF) / 4; u += NWAVES * 64) ((LAS unsigned*)(F.lds + LDSCTL_OFF))[u] = 0u;
    __syncthreads();
    XcdBarrier bar; bar.bar = (unsigned*)(F.ctl + CW_BAR); bar.x = 0; bar.st = nullptr;
    const int lo = args.ph_lo, hi = args.ph_hi;
    if (hi - lo > 1) bar = xcd_barrier_post((unsigned*)(F.ctl + CW_BAR), F.MISC + 8);
#ifndef PH_MASK
#define PH_MASK 0x3ff
#endif
#define IN(k) (((PH_MASK >> (k)) & 1) && lo <= (k) && (k) < hi)
#define SEAM(k) do { if (IN(k) && IN((k) + 1)) xcd_barrier(bar); } while (0)
#ifndef PROBE_DUP
#define PROBE_DUP 0
#endif
#define REP(k) for (int rep_ = 0; rep_ < (((PROBE_DUP >> (k)) & 1) ? 2 : 1); ++rep_)

    if (IN(0)) { REP(0) p0_prologue(F); SEAM(0); }
    if (IN(1)) {
        pg8::Gemm g{F.XB, F.WIN, nullptr, nullptr, T, IN_DIM, D}; pg8::StaticOrder S; S.init(T, IN_DIM, F.G, (int)blockIdx.x);
        { LAS float* bgl = (LAS float*)(F.lds + RING_BYTES); for (int i = F.tid; i < 2 * D; i += NWAVES * 64) bgl[i] = F.b_gate[i]; __syncthreads(); }
        pg8::EpiProj E{F.PA, F.G_, (const PG8_LAS float*)(F.lds + RING_BYTES)};
        REP(1) pg8::gemm_phase<pg8::EpiProj, pg8::StaticOrder, PG8_ALIGN, PG8_SP2>(F.lds + RING_OFF, g, S, E);
        {
            const int nwg = (T / 256) * (IN_DIM / 256), rem = nwg % F.G, c = (int)blockIdx.x; const int nshort = rem ? F.G - rem : F.G, sidx = rem ? c - rem : c;
            if (sidx >= 0) { p0_convert_fp8(F, F.expert_u, (unsigned char*)F.UB, (size_t)NEXP * D, F.norm_ffn, U_SCALE, sidx, nshort);
                             p0_convert_fp8(F, F.expert_v, (unsigned char*)F.VB, (size_t)NEXP * D, nullptr, V_SCALE, sidx, nshort); } }
        SEAM(1);
    }
    if (IN(2)) {
        REP(2) { p2_conv(F); p2_attention(F); }
        SEAM(2); }
    if (IN(3)) {
        pg8::Gemm g{F.Z, F.WC, F.ATT, F.WA, T, D, CONV}; pg8::PairOrder S; S.init(T, D, F.G, (int)blockIdx.x);
        pg8::EpiMix E{F.MIX, F.G_};
        REP(3) pg8::gemm_phase<pg8::EpiMix, pg8::PairOrder, PG8_ALIGN, PG8_SP2>(F.lds + RING_OFF, g, S, E);
        SEAM(3);
    }
    if (IN(4)) {
        pg8::Gemm g{F.MIX, F.WO, nullptr, nullptr, T, D, D}; pg8::FragOrder S; S.init(T, D, F.G, (int)blockIdx.x);
        pg8::EpiX1 E{F.x, F.XB, F.SSQ};
        REP(4) pg8::gemm_phase<pg8::EpiX1, pg8::FragOrder, PG8_ALIGN, PG8_SP2>(F.lds + RING_OFF, g, S, E);
        SEAM(4);
    }
    if (IN(5)) {
        pg8::Gemm g{F.XB, F.WQ, nullptr, nullptr, T, PQ, D}; pg8::StaticOrder S; S.init(T, PQ, F.G, (int)blockIdx.x);
        pg8::EpiQP E{F.QP};
        REP(5) pg8::gemm_phase<pg8::EpiQP, pg8::StaticOrder, PG8_ALIGN, PG8_SP2>(F.lds + RING_OFF, g, S, E);
    }
    if (IN(6)) { REP(6) p6_topk(F); SEAM(6); }
    if (IN(7)) { xcc_info_build(bar); const XccInfo I = xcc_info(bar); REP(7) p7_udot(F, I); SEAM(7); }
    if (IN(8)) { REP(8) p8_act(F); SEAM(8); }
    if (IN(9)) { const XccInfo I = xcc_info(bar); p9_vacc(F, I); }
#undef IN
#undef SEAM
}

extern "C" void kernel_launch(void* const* d_in, const int* in_sizes, int n_in, void* d_out, int out_size, void* d_ws, size_t ws_size, hipStream_t stream) {
    static int grid = 0;
    if (grid == 0) {
        if (n_in != 17 || in_sizes[0] != T * D || out_size != T * D || ws_size < WS_END) { fprintf(stderr, "kernel_launch: unexpected shapes (n_in %d, in0 %d, out %d, ws %zu)\n", n_in, n_in > 0 ? in_sizes[0] : -1, out_size, ws_size); grid = -1; return; }
        int dev = 0, cus = 0, per_cu = 0;
        if (hipGetDevice(&dev) != hipSuccess || hipDeviceGetAttribute(&cus, hipDeviceAttributeMultiprocessorCount, dev) != hipSuccess) { grid = -1; return; }
        if (hipFuncSetAttribute((const void*)hyb_fwd, hipFuncAttributeMaxDynamicSharedMemorySize, LDS_BYTES) != hipSuccess) { fprintf(stderr, "kernel_launch: hipFuncSetAttribute failed\n"); grid = -1; return; }
        if (hipOccupancyMaxActiveBlocksPerMultiprocessor(&per_cu, (const void*)hyb_fwd, NWAVES * 64, LDS_BYTES) != hipSuccess || per_cu < 1) { fprintf(stderr, "kernel_launch: occupancy query says %d blocks per CU\n", per_cu); (void)hipGetLastError(); grid = -1; return; }
        grid = cus * 1;
    }
    if (grid < 0) return;
    if (hipMemsetAsync((char*)d_ws + WS_CTL, 0, CTL_ZERO_BYTES, stream) != hipSuccess) { fprintf(stderr, "kernel_launch: memset failed\n"); return; }
    Args a{};
    for (int i = 0; i < 17; ++i) a.in[i] = (const float*)d_in[i];
    a.out = (float*)d_out; a.ws = (unsigned char*)d_ws;
#if MK_ONE_LAUNCH
    a.ph_lo = 0; a.ph_hi = N_PHASES; a.li = 0;
    void* kargs[] = {&a};
    const hipError_t le = hipLaunchCooperativeKernel((const void*)hyb_fwd, dim3(grid), dim3(NWAVES * 64), kargs, LDS_BYTES, stream);
    if (le != hipSuccess) fprintf(stderr, "kernel_launch: cooperative launch failed: %s (grid %d)\n", hipGetErrorName(le), grid);
#else
    for (int li = 0; li < N_PHASES; ++li) {
        a.ph_lo = li; a.ph_hi = li + 1; a.li = li;
        hipLaunchKernelGGL(hyb_fwd, dim3(grid), dim3(NWAVES * 64), LDS_BYTES, stream, a);
        const hipError_t le = hipPeekAtLastError();
        if (le != hipSuccess) { fprintf(stderr, "kernel_launch: launch %d failed: %s\n", li, hipGetErrorName(le)); break; }
    }
#endif
}
```

```cpp
#include <hip/hip_runtime.h>
#include <hip/hip_cooperative_groups.h>
#include <cstdio>
#include <cstdint>
namespace pg8 {
#define PG8_LAS __attribute__((address_space(3)))
typedef unsigned short bf16_t;
typedef short bf16x8 __attribute__((ext_vector_type(8)));
typedef float f32x4 __attribute__((ext_vector_type(4)));
typedef unsigned u32x4 __attribute__((ext_vector_type(4)));
typedef unsigned u32x2 __attribute__((ext_vector_type(2)));
constexpr int BM = 256, BK = 64, HALF = 128, HTB = HALF * BK * 2  , STAGE_BYTES = 8 * HTB, NXCD = 8, WGM = 8;

__host__ __device__ __forceinline__ int lds_byte(int r, int c) { const int st = (r >> 4) * 2 + (c >> 5), rr = r & 15, cc = c & 31, ob = rr * 64 + cc * 2; return st * 1024 + (ob ^ (((ob >> 9) & 1) << 5)); }
__host__ __device__ __forceinline__ void stage_rc(int b, int& R, int& C) { const int st = b / 1024, sb = b % 1024, swz = sb ^ (((sb >> 9) & 1) << 5); R = (st >> 1) * 16 + swz / 64; C = (st & 1) * 32 + (swz % 64) / 2; }
__host__ __device__ __forceinline__ int perm32(int rho) { const int n = rho >> 4, i = rho & 15; return 8 * (i >> 2) + 4 * n + (i & 3); }

struct Unit { int pm, pn, which; };
struct Gemm { const bf16_t* A; const bf16_t* Bt; const bf16_t* A2; const bf16_t* Bt2; int M, N, K; };

struct StaticOrder {
    static constexpr bool AFRAG = false;
    int nM, nN, nwg, G, c;
    __host__ __device__ void init(int M, int N, int G_, int c_) { nM = M / BM; nN = N / BM; nwg = nM * nN; G = G_; c = c_; }
    __host__ __device__ bool next(int i, Unit& u) const {
        const long L = (long)i * G + c; if (L >= nwg) return false;
        int wgid = (int)L; { const int q = nwg / NXCD, r = nwg % NXCD, xcd = wgid % NXCD, off = wgid / NXCD; wgid = (xcd < r ? xcd * (q + 1) : r * (q + 1) + (xcd - r) * q) + off; }
        const int nig = WGM * nN, gid = wgid / nig, fm = gid * WGM, gsz = (nM - fm) < WGM ? (nM - fm) : WGM;
        u.pm = fm + ((wgid % nig) % gsz); u.pn = (wgid % nig) / gsz; u.which = 0; return true;
    }
    __device__ __forceinline__ const char* a_base(const Gemm& g, const Unit& u, size_t tstep) const { return (const char*)g.A + (size_t)u.pm * tstep; }
    __device__ __forceinline__ const char* b_base(const Gemm& g, const Unit& u, size_t tstep) const { return (const char*)g.Bt + (size_t)u.pn * tstep; }
    __device__ __forceinline__ void a_ready(const Unit&) const {}
    __device__ __forceinline__ void done(const Unit&) const {}
};

__device__ __forceinline__ unsigned cvt_pk_bf16(float lo, float hi) { unsigned r; asm volatile("v_cvt_pk_bf16_f32 %0, %1, %2" : "=v"(r) : "v"(lo), "v"(hi)); return r; }
__device__ __forceinline__ void store16_wt(void* p, u32x4 v) { asm volatile("global_store_dwordx4 %0, %1, off sc1\n\ts_nop 1" :: "v"(p), "v"(v) : "memory"); }
__device__ __forceinline__ void store8_wt(void* p, u32x2 v) { asm volatile("global_store_dwordx2 %0, %1, off sc1\n\ts_nop 1" :: "v"(p), "v"(v) : "memory"); }
typedef float f32x2 __attribute__((ext_vector_type(2)));
__device__ __forceinline__ f32x2 gelu_pk(f32x2 v) {
    const f32x2 av = __builtin_elementwise_abs(v), d = av * 0.2316418882f + 1.0f;
    f32x2 t; t.x = __builtin_amdgcn_rcpf(d.x); t.y = __builtin_amdgcn_rcpf(d.y);
    f32x2 q = t * 0.5307027145f + (-0.7265760135f); q = q * t + 0.7107068705f; q = q * t + (-0.142248368f); q = q * t + 0.127414796f; q = q * t;
    const f32x2 s = (v * v) * (-0.72134752044f);
    f32x2 e; e.x = __builtin_amdgcn_exp2f(s.x); e.y = __builtin_amdgcn_exp2f(s.y);
    const f32x2 m = v * (q * e), r = v - m;
    f32x2 o; o.x = v.x < 0.f ? m.x : r.x; o.y = v.y < 0.f ? m.y : r.y; return o;
}

template <class Epi, class Sched, bool ALIGN_EPI = false, bool SP2 = false>
__device__ __forceinline__ void gemm_phase(PG8_LAS unsigned char* lds, const Gemm g, const Sched& S, const Epi& E) {
    const int tid = threadIdx.x, wid = __builtin_amdgcn_readfirstlane(tid >> 6), lane = tid & 63, wr = wid >> 2, wc = wid & 3, fr = lane & 15, fq = lane >> 4;
    const int K = g.K, nt = K / BK;
    unsigned voffA[2], voffB[2];
#pragma unroll
    for (int i = 0; i < 2; ++i) { int R, C; stage_rc(tid * 16 + i * 8192, R, C); const int Rb = Epi::PERM ? ((R & ~31) + perm32(R & 31)) : R;
        voffA[i] = Sched::AFRAG ? (unsigned)((((((R >> 6) * 4 + (C >> 5)) * 16 + ((R >> 4) & 3) * 2) * 64) + ((C & 31) >> 3) * 16 + (R & 15)) * 16) : (unsigned)(R * K + C) * 2u;
        voffB[i] = (unsigned)(Rb * K + C) * 2u; }
#define PG8_AP(base, h, kt) (Sched::AFRAG ? (base) + ((((size_t)((kt) >> 2) * 8 + ((kt) & 1) * 2) * 16 + (h) * 8 + (((kt) >> 1) & 1)) * 64) * 16 : (base) + (size_t)(h) * hstep + (size_t)(kt) * kstep)
    const size_t kstep = (size_t)(BK * 2);
    const size_t hstep = (size_t)HALF * K * 2;
    const size_t tstep = 2 * hstep;
    const unsigned ldsw = (unsigned)wid * 1024u;
    const int aoff = lds_byte(wr * 64 + fr, fq * 8), boff = lds_byte(wc * 32 + fr, fq * 8);
#define PG8_SA(b, h) (((b) * 2 + (h)) * HTB)
#define PG8_SB(b, h) ((4 + (b) * 2 + (h)) * HTB)
#define PG8_STAGE(bufoff, gbase, voff) do { _Pragma("unroll") for (int _i = 0; _i < 2; ++_i) \
        __builtin_amdgcn_global_load_lds((const unsigned*)((const char*)(gbase) + (voff)[_i]), (PG8_LAS unsigned*)(lds + (bufoff) + ldsw + _i * 8192), 16, 0, 0); } while (0)
#define PG8_LDA(dst, b, h) do { _Pragma("unroll") for (int m = 0; m < 4; ++m) _Pragma("unroll") for (int k = 0; k < 2; ++k) dst[m][k] = *(const PG8_LAS bf16x8*)(lds + PG8_SA(b, h) + aoff + m * 2048 + k * 1024); } while (0)
#define PG8_LDB(dst, b, h) do { _Pragma("unroll") for (int n = 0; n < 2; ++n) _Pragma("unroll") for (int k = 0; k < 2; ++k) dst[n][k] = *(const PG8_LAS bf16x8*)(lds + PG8_SB(b, h) + boff + n * 2048 + k * 1024); } while (0)
#define PG8_MMA(ai, bj, At, Bt) do { __builtin_amdgcn_s_setprio(1); _Pragma("unroll") for (int m = 0; m < 4; ++m) _Pragma("unroll") for (int n = 0; n < 2; ++n) _Pragma("unroll") for (int k = 0; k < 2; ++k) \
        acc[ai][bj][m][n] = __builtin_amdgcn_mfma_f32_16x16x32_bf16(Bt[n][k], At[m][k], acc[ai][bj][m][n], 0, 0, 0); __builtin_amdgcn_s_setprio(0); } while (0)
#define PG8_WAIT_V(n) asm volatile("s_waitcnt vmcnt(" #n ")" ::: "memory")
#define PG8_WAIT_L(n) asm volatile("s_waitcnt lgkmcnt(" #n ")" ::: "memory")
#define PG8_BAR __builtin_amdgcn_s_barrier()
#define PG8_SCHED __builtin_amdgcn_sched_barrier(0)
    Unit cur, nxt; int ui = 0;
    if (!S.next(0, cur)) return;
    f32x4 acc[2][2][4][2];
#pragma unroll
    for (int a = 0; a < 2; ++a)
#pragma unroll
        for (int b = 0; b < 2; ++b)
#pragma unroll
            for (int m = 0; m < 4; ++m)
#pragma unroll
                for (int n = 0; n < 2; ++n) acc[a][b][m][n] = (f32x4){0.f, 0.f, 0.f, 0.f};
    if constexpr (Epi::HAS_INIT) E.init(acc, cur, wr, wc, fr, fq);
    bf16x8 At[4][2], B0[2][2], B1[2][2];
    const char* cA = S.a_base(g, cur, tstep); const char* cB = S.b_base(g, cur, tstep);
    S.a_ready(cur);
    if constexpr (SP2) {
        PG8_STAGE(PG8_SB(0, 0), cB, voffB); PG8_STAGE(PG8_SB(0, 1), cB + hstep, voffB); PG8_STAGE(PG8_SA(0, 0), PG8_AP(cA, 0, 0), voffA); PG8_STAGE(PG8_SA(0, 1), PG8_AP(cA, 1, 0), voffA);
        if (wr == 1) PG8_BAR;
        PG8_WAIT_V(2); PG8_BAR;
        PG8_STAGE(PG8_SB(1, 0), cB + kstep, voffB); PG8_STAGE(PG8_SA(1, 0), PG8_AP(cA, 0, 1), voffA); PG8_STAGE(PG8_SB(1, 1), cB + hstep + kstep, voffB);
        PG8_WAIT_V(6); PG8_BAR;
    } else {
        PG8_STAGE(PG8_SB(0, 0), cB, voffB); PG8_STAGE(PG8_SA(0, 0), PG8_AP(cA, 0, 0), voffA); PG8_STAGE(PG8_SB(0, 1), cB + hstep, voffB); PG8_STAGE(PG8_SA(0, 1), PG8_AP(cA, 1, 0), voffA);
        if (wr == 1) PG8_BAR;
        PG8_WAIT_V(4); PG8_BAR;
        PG8_STAGE(PG8_SB(1, 0), cB + kstep, voffB); PG8_STAGE(PG8_SA(1, 0), PG8_AP(cA, 0, 1), voffA); PG8_STAGE(PG8_SB(1, 1), cB + hstep + kstep, voffB);
        PG8_WAIT_V(6); PG8_BAR;
    }
    for (;;) {
        const bool has_next = S.next(ui + 1, nxt);
        const char* nA = has_next ? S.a_base(g, nxt, tstep) : cA; const char* nB = has_next ? S.b_base(g, nxt, tstep) : cB;
        for (int t = 0; t < nt; t += 2) {
            const bool last = (t == nt - 2);
            const char* a2b = last ? nA : cA; const int a2k = last ? 0 : t + 2; const char* b2 = last ? nB : cB + (size_t)(t + 2) * kstep;
            const char* b3 = b2 + kstep;
            const char* a1h = PG8_AP(cA, 1, t + 1); const char* a2 = PG8_AP(a2b, 0, a2k); const char* a2h = PG8_AP(a2b, 1, a2k); const char* a3 = PG8_AP(a2b, 0, a2k + 1);
            if (last && has_next) S.a_ready(nxt);
            if constexpr (SP2) {
            PG8_LDB(B0, 0, 0); PG8_LDB(B1, 0, 1); PG8_SCHED; PG8_LDA(At, 0, 0); PG8_STAGE(PG8_SA(1, 1), a1h, voffA);
            PG8_WAIT_V(8); PG8_WAIT_L(0); PG8_BAR; PG8_MMA(0, 0, At, B0); PG8_MMA(0, 1, At, B1); PG8_BAR; PG8_SCHED;
            PG8_LDA(At, 0, 1); PG8_STAGE(PG8_SB(0, 0), b2, voffB); PG8_STAGE(PG8_SB(0, 1), b2 + hstep, voffB); PG8_STAGE(PG8_SA(0, 0), a2, voffA);
            PG8_WAIT_V(8); PG8_WAIT_L(0); PG8_BAR; PG8_MMA(1, 0, At, B0); PG8_MMA(1, 1, At, B1); PG8_BAR; PG8_SCHED;
            PG8_LDB(B0, 1, 0); PG8_LDB(B1, 1, 1); PG8_SCHED; PG8_LDA(At, 1, 0); PG8_STAGE(PG8_SA(0, 1), a2h, voffA);
            PG8_WAIT_V(8); PG8_WAIT_L(0); PG8_BAR; PG8_MMA(0, 0, At, B0); PG8_MMA(0, 1, At, B1); PG8_BAR; PG8_SCHED;
            PG8_LDA(At, 1, 1); PG8_STAGE(PG8_SB(1, 0), b3, voffB); PG8_STAGE(PG8_SB(1, 1), b3 + hstep, voffB); PG8_STAGE(PG8_SA(1, 0), a3, voffA);
            PG8_WAIT_V(8); PG8_WAIT_L(0); PG8_BAR; PG8_MMA(1, 0, At, B0); PG8_MMA(1, 1, At, B1); PG8_BAR; PG8_SCHED;
            } else {
            PG8_LDB(B0, 0, 0); PG8_SCHED; PG8_LDA(At, 0, 0); PG8_STAGE(PG8_SA(1, 1), a1h, voffA);
            PG8_WAIT_L(8); PG8_BAR; PG8_WAIT_L(0); PG8_MMA(0, 0, At, B0); PG8_BAR; PG8_SCHED;
            PG8_LDB(B1, 0, 1); PG8_STAGE(PG8_SB(0, 0), b2, voffB);
            PG8_BAR; PG8_WAIT_L(0); PG8_MMA(0, 1, At, B1); PG8_BAR;
            PG8_LDA(At, 0, 1); PG8_STAGE(PG8_SA(0, 0), a2, voffA);
            PG8_BAR; PG8_WAIT_L(0); PG8_MMA(1, 0, At, B0); PG8_BAR; PG8_SCHED;
            PG8_STAGE(PG8_SB(0, 1), b2 + hstep, voffB);
            PG8_WAIT_V(6); PG8_BAR; PG8_MMA(1, 1, At, B1); PG8_BAR;
            PG8_LDB(B0, 1, 0); PG8_SCHED; PG8_LDA(At, 1, 0); PG8_STAGE(PG8_SA(0, 1), a2h, voffA);
            PG8_WAIT_L(8); PG8_BAR; PG8_WAIT_L(0); PG8_MMA(0, 0, At, B0); PG8_BAR; PG8_SCHED;
            PG8_LDB(B1, 1, 1); PG8_STAGE(PG8_SB(1, 0), b3, voffB);
            PG8_BAR; PG8_WAIT_L(0); PG8_MMA(0, 1, At, B1); PG8_BAR;
            PG8_LDA(At, 1, 1); PG8_STAGE(PG8_SA(1, 0), a3, voffA);
            PG8_BAR; PG8_WAIT_L(0); PG8_MMA(1, 0, At, B0); PG8_BAR; PG8_SCHED;
            PG8_STAGE(PG8_SB(1, 1), b3 + hstep, voffB);
            PG8_WAIT_V(6); PG8_BAR; PG8_MMA(1, 1, At, B1); PG8_BAR;
            }
        }
        if constexpr (ALIGN_EPI) { if (wr == 0) PG8_BAR; }
        if constexpr (!Epi::AFTER_DRAIN) { E(acc, cur, wr, wc, fr, fq); S.done(cur); }
        if (!has_next) break;
#pragma unroll
        for (int a = 0; a < 2; ++a)
#pragma unroll
            for (int b = 0; b < 2; ++b)
#pragma unroll
                for (int m = 0; m < 4; ++m)
#pragma unroll
                    for (int n = 0; n < 2; ++n) acc[a][b][m][n] = (f32x4){0.f, 0.f, 0.f, 0.f};
        if constexpr (Epi::HAS_INIT) E.init(acc, nxt, wr, wc, fr, fq);
        cur = nxt; cA = nA; cB = nB; ++ui;
        if constexpr (ALIGN_EPI) { if (wr == 1) PG8_BAR; }
    }
    PG8_WAIT_V(0);
    if constexpr (!ALIGN_EPI) { if (wr == 0) PG8_BAR; }
    PG8_BAR;
    if constexpr (Epi::AFTER_DRAIN) { E.fused(acc, cur, wr, wc, fr, fq, lds, wid, lane); S.done(cur); }
#undef PG8_AP
#undef PG8_SA
#undef PG8_SB
#undef PG8_STAGE
#undef PG8_LDA
#undef PG8_LDB
#undef PG8_MMA
#undef PG8_WAIT_V
#undef PG8_WAIT_L
#undef PG8_BAR
#undef PG8_SCHED
}
}

#ifndef PG8_SP2
#define PG8_SP2 true
#endif
#ifndef PG8_ALIGN
#define PG8_ALIGN true
#endif
#ifndef MK_ONE_LAUNCH
#define MK_ONE_LAUNCH 1
#endif

constexpr int NWAVES = 8;
constexpr int T = 32768, D = 1024, SEQ = 4096;
constexpr int IN_DIM = 4352, PA_W = 2304, G_W = 2048;
constexpr int C_U = 0, C_B = 512, C_C = 1024, C_Q = 1536, C_K = 2048, C_V = 2176;
constexpr int CONV = 512, HD = 64, NH = 8, NKV = 2;
constexpr int PH = 8, NKEYS = 128, PQ = 2048, TOPK = 16, NEXP = 16384, NSEL = 128;
constexpr float EPS = 1e-6f;
constexpr int N_PHASES = 10;

constexpr size_t MiB = 1u << 20;
constexpr size_t WS_CTL = 0, CTL_ZERO_BYTES = 1 * MiB;
constexpr size_t WS_WIN = 2 * MiB;
constexpr size_t WS_WC = 11 * MiB;
constexpr size_t WS_WA = 12 * MiB;
constexpr size_t WS_WO = 13 * MiB;
constexpr size_t WS_WQ = 15 * MiB;
constexpr size_t WS_SK = 19 * MiB;
constexpr size_t WS_RSTD1 = 20 * MiB;
constexpr size_t WS_SSQ = 21 * MiB;
constexpr size_t WS_UB = 24 * MiB;
constexpr size_t WS_SU = 32 * MiB;
constexpr size_t WS_VB = 40 * MiB;
constexpr size_t WS_XB8 = 56 * MiB;
constexpr size_t WS_XB = 88 * MiB;
constexpr size_t WS_PA = 152 * MiB;
constexpr size_t WS_MIX = WS_PA;
constexpr size_t WS_G = 296 * MiB;
constexpr size_t WS_QP = WS_G;
constexpr size_t WS_Z = 424 * MiB;
constexpr size_t WS_ATT = 456 * MiB;
constexpr size_t WS_IDX = WS_Z, WS_GATE = WS_ATT;
constexpr size_t WS_PART = WS_PA;
constexpr size_t WS_ACT = WS_G;
constexpr size_t WS_END = 488 * MiB;
constexpr int CW_BAR = 4096;

constexpr int RING_OFF = 0, RING_BYTES = 131072;
constexpr int LDSCTL_OFF = 147456, MISC_OFF = LDSCTL_OFF + 320;
constexpr int LDS_BYTES = 148480;
#define GAS __attribute__((address_space(1)))
#define LAS __attribute__((address_space(3)))
typedef unsigned short bf16;
typedef unsigned v4u __attribute__((ext_vector_type(4)));
typedef float f32x4 __attribute__((ext_vector_type(4)));
typedef short bf16x8 __attribute__((ext_vector_type(8)));
typedef GAS unsigned gu32;
typedef GAS unsigned long long gu64;
#define RLX_AGENT __ATOMIC_RELAXED, __HIP_MEMORY_SCOPE_AGENT
#define LDS_WAIT() asm volatile("s_waitcnt lgkmcnt(0)" ::: "memory")
#define VM_WAIT() asm volatile("s_waitcnt vmcnt(0)" ::: "memory")
__device__ __forceinline__ unsigned long long rt() { return __builtin_amdgcn_s_memrealtime(); }
__device__ __forceinline__ unsigned f2bf(float f) { unsigned u = __builtin_bit_cast(unsigned, f); return (u + 0x7fffu + ((u >> 16) & 1u)) >> 16; }
__device__ __forceinline__ unsigned pk2(float lo, float hi) { return f2bf(lo) | (f2bf(hi) << 16); }

#define XB_TMO      128
#define XB_XCNT(j)  (256  + 64 * (j))
#define XB_XSUB(j)  (1280 + 64 * (j))
#define XB_XGEN(j)  (2304 + 64 * (j))
#define XB_TOP      3328
#define XB_TOPGEN   3392
#define XCD_BAR_WORDS 3456
#define XB_SPIN_CAP (1u << 18)

__device__ __forceinline__ unsigned xb_ld(unsigned* p)              { return __hip_atomic_load(p, __ATOMIC_RELAXED, __HIP_MEMORY_SCOPE_AGENT); }
__device__ __forceinline__ unsigned xb_add(unsigned* p, unsigned v) { return __hip_atomic_fetch_add(p, v, __ATOMIC_RELAXED, __HIP_MEMORY_SCOPE_AGENT); }
__device__ __forceinline__ unsigned xb_xcc_id() { return (unsigned)__builtin_amdgcn_s_getreg((3 << 11) | 20) & 0xFu; }
#define XB_SPIN(cond, bar) do { unsigned _sp = 0; while (cond) { __builtin_amdgcn_s_sleep(1); \
    if ((++_sp & 255u) == 0u) { if (xb_ld(&(bar)[XB_TMO])) break; if (_sp > XB_SPIN_CAP) { atomicAdd(&(bar)[XB_TMO], 1u); break; } } } } while (0)

struct XcdBarrier {
    unsigned* bar; unsigned x;
    volatile LAS unsigned* st;
};

__device__ __forceinline__ XcdBarrier xcd_barrier_post(unsigned* bar, volatile LAS unsigned* st) {
    XcdBarrier b; b.bar = bar; b.x = xb_xcc_id(); b.st = st;
    if (threadIdx.x == 0) st[2] = xb_add(&bar[XB_XCNT(b.x)], 1u);
    return b;
}
__device__ __forceinline__ void xcd_barrier_complete(unsigned* bar, unsigned x, unsigned& nloc, unsigned& nx) {
    const unsigned G = gridDim.x * gridDim.y * gridDim.z;
    unsigned sum, cnt, mine, sp = 0u;
    for (;;) {
        sum = 0u; cnt = 0u; mine = 0u;
#pragma unroll
        for (unsigned j = 0; j < 16; ++j) { const unsigned c = xb_ld(&bar[XB_XCNT(j)]); sum += c; cnt += (c > 0u) ? 1u : 0u; mine = (j == x) ? c : mine; }
        if (sum == G) break;
        __builtin_amdgcn_s_sleep(1);
        if ((++sp & 255u) == 0u) { if (xb_ld(&bar[XB_TMO])) break; if (sp > XB_SPIN_CAP) { atomicAdd(&bar[XB_TMO], 1u); break; } }
    }
    nloc = mine > 0u ? mine : 1u; nx = cnt > 0u ? cnt : 1u;
}

__device__ __forceinline__ void xcd_barrier(const XcdBarrier& b) {
    asm volatile("s_waitcnt vmcnt(0)" ::: "memory");
    __syncthreads();
    if (threadIdx.x == 0) {
        unsigned* bar = b.bar;
        __builtin_amdgcn_s_waitcnt(0);
        unsigned nloc = b.st[0], nx = b.st[1];
        if (nloc == 0u) { xcd_barrier_complete(bar, b.x, nloc, nx); b.st[0] = nloc; b.st[1] = nx; }
        const unsigned old = xb_add(&bar[XB_XSUB(b.x)], 1u);
        const unsigned gen = old / nloc;
        if (old + 1u == (gen + 1u) * nloc) {
            __builtin_amdgcn_fence(__ATOMIC_RELEASE, "agent");
            asm volatile("s_waitcnt vmcnt(0)" ::: "memory");
            const unsigned og = xb_add(&bar[XB_TOP], 1u);
            const unsigned tg = og / nx;
            if (og + 1u == (tg + 1u) * nx) xb_add(&bar[XB_TOPGEN], 1u);
            else XB_SPIN(xb_ld(&bar[XB_TOPGEN]) == tg, bar);
            __builtin_amdgcn_fence(__ATOMIC_ACQUIRE, "agent");
            xb_add(&bar[XB_XGEN(b.x)], 1u);
            asm volatile("s_waitcnt vmcnt(0)" ::: "memory");
        } else {
            XB_SPIN(xb_ld(&bar[XB_XGEN(b.x)]) == gen, bar);
            __builtin_amdgcn_fence(__ATOMIC_ACQUIRE, "agent");
            asm volatile("s_waitcnt vmcnt(0)" ::: "memory");
        }
    }
    __syncthreads();
}

typedef float f32x16 __attribute__((ext_vector_type(16)));
typedef unsigned v2u __attribute__((ext_vector_type(2)));
typedef int v4i __attribute__((ext_vector_type(4)));
typedef __bf16 bf2_t __attribute__((ext_vector_type(2)));
#define DI __device__ __forceinline__
struct Frame {
    LAS unsigned char* lds;
    volatile LAS unsigned* MISC;
    gu32* ctl;
    int tid, lane, wave, vcu, G;
    const float *x, *norm_mix, *norm_ffn, *w_in, *b_gate, *w_conv, *q_norm, *k_norm, *sinks, *rel_bias, *w_conv_out, *w_attn_out, *w_out, *w_query, *sub_keys, *expert_u, *expert_v;
    float* out;
    bf16 *WIN, *WC, *WA, *WO, *WQ, *SK, *UB, *VB, *XB, *PA, *MIX, *G_, *QP, *Z, *ATT;
    float *RSTD1, *SSQ, *GATE, *ACT, *SU; bf16* PARTB; unsigned char* XB8; unsigned short* IDX;
};
DI float wave_sum(float v) {
#pragma unroll
    for (int o = 1; o < 64; o <<= 1) v += __shfl_xor(v, o);
    return v;
}
DI float bf_lo(unsigned u) { return __builtin_bit_cast(float, u << 16); }
DI float bf_hi(unsigned u) { return __builtin_bit_cast(float, u & 0xffff0000u); }

DI void p0_transpose_item(const float* W, int K, int N, bf16* WT, const float* gsc, LAS float* scr, int item, int lane) {
    const int nblk = N / 32, kb = item / nblk, nb = item % nblk, k0 = 64 * kb, n0 = 32 * nb;
#pragma unroll 8
    for (int i = 0; i < 32; ++i) { const int kk = 2 * i + (lane >> 5); float v = W[(size_t)(k0 + kk) * N + n0 + (lane & 31)]; if (gsc) v *= gsc[k0 + kk]; scr[kk * 33 + (lane & 31)] = v; }
    LDS_WAIT(); asm volatile("" ::: "memory");
    const int c = lane & 7;
#pragma unroll
    for (int j = 0; j < 4; ++j) { const int n = (lane >> 3) + 8 * j; const LAS float* s = scr + (8 * c) * 33 + n;
        v4u o; o.x = pk2(s[0 * 33], s[1 * 33]); o.y = pk2(s[2 * 33], s[3 * 33]); o.z = pk2(s[4 * 33], s[5 * 33]); o.w = pk2(s[6 * 33], s[7 * 33]);
        *(GAS v4u*)(WT + (size_t)(n0 + n) * K + k0 + 8 * c) = o; }
    LDS_WAIT(); asm volatile("" ::: "memory");
}
DI void p0_convert(Frame& F, const float* src, bf16* dst, size_t n, const float* colscale) {
    const size_t n8 = n / 8, stride = (size_t)F.G * NWAVES * 64;
    for (size_t i = (size_t)F.vcu * NWAVES * 64 + F.tid; i < n8; i += stride) {
        f32x4 a = *(const GAS f32x4*)(src + i * 8), b = *(const GAS f32x4*)(src + i * 8 + 4);
        if (colscale) { const int c = (int)((i * 8) & 1023); const f32x4 s0 = *(const GAS f32x4*)(colscale + c), s1 = *(const GAS f32x4*)(colscale + c + 4); a = a * s0; b = b * s1; }
        v4u o; o.x = pk2(a.x, a.y); o.y = pk2(a.z, a.w); o.z = pk2(b.x, b.y); o.w = pk2(b.z, b.w);
        *(GAS v4u*)(dst + i * 8) = o;
    }
}
constexpr float U_SCALE = 32.f, V_SCALE = 4.f, A_SCALE = 32.f;
DI unsigned pk4_fp8(f32x4 v) { int r = 0; r = __builtin_amdgcn_cvt_pk_fp8_f32(v[0], v[1], r, false); r = __builtin_amdgcn_cvt_pk_fp8_f32(v[2], v[3], r, true); return (unsigned)r; }
DI void p0_convert_fp8(Frame& F, const float* src, unsigned char* dst, size_t n, const float* colscale, float scale, int bidx, int nblk) {
    const int gw = bidx * NWAVES + F.wave, NGW = nblk * NWAVES, lane = F.lane;
    f32x4 cs[4];
#pragma unroll
    for (int q = 0; q < 4; ++q) cs[q] = colscale ? *(const GAS f32x4*)(colscale + 4 * lane + 256 * q) * scale : (f32x4){scale, scale, scale, scale};
    const int nrows = (int)(n / D);
    for (int e = gw; e < nrows; e += NGW) {
        const GAS f32x4* rp = (const GAS f32x4*)(src + (size_t)e * D) + lane;
        f32x4 v[4];
#pragma unroll
        for (int q = 0; q < 4; ++q) v[q] = rp[64 * q];
#pragma unroll
        for (int q = 0; q < 4; ++q) *(GAS unsigned*)(dst + ((size_t)(2 * q + (lane >> 5)) * NEXP + e) * 128 + ((4 * lane) & 127)) = pk4_fp8(v[q] * cs[q]);
    }
}
DI void p0_convert_u_fp4(Frame& F, int bidx, int nblk) {
    const int gw = bidx * NWAVES + F.wave, NGW = nblk * NWAVES, lane = F.lane;
    f32x4 cs[4];
#pragma unroll
    for (int q = 0; q < 4; ++q) cs[q] = *(const GAS f32x4*)(F.norm_ffn + 4 * lane + 256 * q);
    unsigned char* dst = (unsigned char*)F.UB;
    for (int e = gw; e < NEXP; e += NGW) {
        const GAS f32x4* rp = (const GAS f32x4*)(F.expert_u + (size_t)e * D) + lane;
        f32x4 v[4]; float mx = 0.f;
#pragma unroll
        for (int q = 0; q < 4; ++q) { v[q] = rp[64 * q] * cs[q]; mx = fmaxf(mx, fmaxf(fmaxf(fabsf(v[q][0]), fabsf(v[q][1])), fmaxf(fabsf(v[q][2]), fabsf(v[q][3])))); }
#pragma unroll
        for (int o = 1; o < 64; o <<= 1) mx = fmaxf(mx, __shfl_xor(mx, o));
        const float inv = mx > 0.f ? 6.f / mx : 0.f;
        if (lane == 0) F.SU[e] = mx * (1.f / 6.f);
#pragma unroll
        for (int q = 0; q < 4; ++q) { unsigned r = 0u;
            r = __builtin_amdgcn_cvt_scalef32_pk_fp4_f32(r, v[q][0] * inv, v[q][1] * inv, 1.0f, 0);
            r = __builtin_amdgcn_cvt_scalef32_pk_fp4_f32(r, v[q][2] * inv, v[q][3] * inv, 1.0f, 1);
            *(GAS unsigned short*)(dst + ((size_t)q * NEXP + e) * 128 + 2 * lane) = (unsigned short)r; }
    }
}
template <int RB> DI void p0_rows(Frame& F, const float* xrow, bf16* orow) {
    f32x4 v[RB][4]; float s[RB];
#pragma unroll
    for (int r = 0; r < RB; ++r) { const GAS f32x4* xr = (const GAS f32x4*)(xrow + (size_t)r * D) + F.lane;
#pragma unroll
        for (int j = 0; j < 4; ++j) v[r][j] = xr[64 * j]; }
#pragma unroll
    for (int r = 0; r < RB; ++r) { s[r] = 0.f;
#pragma unroll
        for (int j = 0; j < 4; ++j) s[r] += (v[r][j].x * v[r][j].x + v[r][j].y * v[r][j].y) + (v[r][j].z * v[r][j].z + v[r][j].w * v[r][j].w); }
#pragma unroll
    for (int o = 1; o < 64; o <<= 1)
#pragma unroll
        for (int r = 0; r < RB; ++r) s[r] += __shfl_xor(s[r], o);
#pragma unroll
    for (int r = 0; r < RB; ++r) { const float rs = 1.f / sqrtf(s[r] * (1.f / D) + EPS);
        GAS unsigned long long* o8 = (GAS unsigned long long*)(orow + (size_t)r * D) + F.lane;
#pragma unroll
        for (int j = 0; j < 4; ++j) o8[64 * j] = (unsigned long long)pk2(v[r][j].x * rs, v[r][j].y * rs) | ((unsigned long long)pk2(v[r][j].z * rs, v[r][j].w * rs) << 32); }
}
DI void p0_prologue(Frame& F) {
    LAS float* scr = (LAS float*)(F.lds + RING_OFF + F.wave * 16384);
    const int gw = F.vcu * NWAVES + F.wave, NGW = F.G * NWAVES;
    constexpr int I_IN = (D / 64) * (IN_DIM / 32), I_C = (CONV / 64) * (D / 32), I_O = (D / 64) * (D / 32), I_Q = (D / 64) * (PQ / 32);
    constexpr int NITEMS = I_IN + 2 * I_C + I_O + I_Q;
    for (int it = gw; it < NITEMS; it += NGW) {
        int r = it;
        if (r < I_IN) { p0_transpose_item(F.w_in, D, IN_DIM, F.WIN, F.norm_mix, scr, r, F.lane); continue; } r -= I_IN;
        if (r < I_C) { p0_transpose_item(F.w_conv_out, CONV, D, F.WC, nullptr, scr, r, F.lane); continue; } r -= I_C;
        if (r < I_C) { p0_transpose_item(F.w_attn_out, CONV, D, F.WA, nullptr, scr, r, F.lane); continue; } r -= I_C;
        if (r < I_O) { p0_transpose_item(F.w_out, D, D, F.WO, nullptr, scr, r, F.lane); continue; } r -= I_O;
        p0_transpose_item(F.w_query, D, PQ, F.WQ, F.norm_ffn, scr, r, F.lane);
    }
    p0_convert(F, F.sub_keys, F.SK, (size_t)PH * 2 * NKEYS * 128, nullptr);
    for (int m = 4 * gw; m < T; m += 4 * NGW) p0_rows<4>(F, F.x + (size_t)m * D, F.XB + (size_t)m * D);
}

namespace pg8 {
DI float sigmoidf_(float v) { return __builtin_amdgcn_rcpf(1.f + __expf(-v)); }
DI size_t frag_off(int pm, int pn, int NT, int wave, int q, int lane) { return (((((size_t)pm * NT + pn) * 8 + wave) * 16 + q) * 64 + lane) * 8; }
struct EpiProj {
    static constexpr bool PERM = true, AFTER_DRAIN = false, HAS_INIT = false;
    bf16_t* PA; bf16_t* G; const PG8_LAS float* bgl;
    DI void operator()(const f32x4 (&acc)[2][2][4][2], const Unit& u, int wr, int wc, int fr, int fq) const {
        const int row0 = u.pm * BM + wr * 64 + fr; const bool gate = u.pn >= 9;
        const int col0 = (gate ? (u.pn - 9) : u.pn) * BM + wc * 32 + 8 * fq;
        if (!gate) {
#pragma unroll
            for (int ai = 0; ai < 2; ++ai)
#pragma unroll
                for (int m = 0; m < 4; ++m) { bf16_t* rowp = PA + (size_t)(row0 + ai * HALF + m * 16) * PA_W + col0;
#pragma unroll
                    for (int bj = 0; bj < 2; ++bj) { const f32x4 v0 = acc[ai][bj][m][0], v1 = acc[ai][bj][m][1];
                        u32x4 w; w.x = cvt_pk_bf16(v0[0], v0[1]); w.y = cvt_pk_bf16(v0[2], v0[3]); w.z = cvt_pk_bf16(v1[0], v1[1]); w.w = cvt_pk_bf16(v1[2], v1[3]);
                        store16_wt(rowp + bj * HALF, w); } }
        } else {
            f32x4 bv[2][2];
#pragma unroll
            for (int bj = 0; bj < 2; ++bj)
#pragma unroll
                for (int n = 0; n < 2; ++n) bv[bj][n] = *(const PG8_LAS f32x4*)(bgl + col0 + bj * HALF + 4 * n);
#pragma unroll
            for (int ai = 0; ai < 2; ++ai)
#pragma unroll
                for (int m = 0; m < 4; ++m)
#pragma unroll
                    for (int bj = 0; bj < 2; ++bj) { f32x4 v0 = acc[ai][bj][m][0] + bv[bj][0], v1 = acc[ai][bj][m][1] + bv[bj][1];
#pragma unroll
                        for (int j = 0; j < 4; ++j) { v0[j] = sigmoidf_(v0[j]) * 255.f; v1[j] = sigmoidf_(v1[j]) * 255.f; }
                        unsigned g0 = 0u, g1 = 0u;
                        g0 = __builtin_amdgcn_cvt_pk_u8_f32(v0[0], 0, g0); g0 = __builtin_amdgcn_cvt_pk_u8_f32(v0[1], 1, g0); g0 = __builtin_amdgcn_cvt_pk_u8_f32(v0[2], 2, g0); g0 = __builtin_amdgcn_cvt_pk_u8_f32(v0[3], 3, g0);
                        g1 = __builtin_amdgcn_cvt_pk_u8_f32(v1[0], 0, g1); g1 = __builtin_amdgcn_cvt_pk_u8_f32(v1[1], 1, g1); g1 = __builtin_amdgcn_cvt_pk_u8_f32(v1[2], 2, g1); g1 = __builtin_amdgcn_cvt_pk_u8_f32(v1[3], 3, g1);
                        u32x2 gw; gw.x = g0; gw.y = g1;
                        *(u32x2*)((unsigned char*)G + frag_off(u.pm, u.pn - 9, 8, wr * 4 + wc, ai * 8 + m * 2 + bj, fq * 16 + fr)) = gw; }
        }
    }
};
struct EpiMix {
    static constexpr bool PERM = true, AFTER_DRAIN = false, HAS_INIT = false;
    bf16_t* MIX; const bf16_t* G;
    DI void operator()(const f32x4 (&acc)[2][2][4][2], const Unit& u, int wr, int wc, int fr, int fq) const {
        const int wave = wr * 4 + wc, lane = fq * 16 + fr;
        const unsigned char* gp = (const unsigned char*)G + frag_off(u.pm, u.pn + (u.which ? 4 : 0), 8, wave, 0, lane); bf16_t* mp = MIX + frag_off(u.pm, u.pn, 4, wave, 0, lane);
#pragma unroll
        for (int ai = 0; ai < 2; ++ai) {
            u32x2 gv[8]; u32x4 ov[8];
#pragma unroll
            for (int q = 0; q < 8; ++q) gv[q] = *(const u32x2*)(gp + (ai * 8 + q) * 512);
            if (u.which) {
#pragma unroll
                for (int q = 0; q < 8; ++q) ov[q] = *(const u32x4*)(mp + (ai * 8 + q) * 512); }
#pragma unroll
            for (int m = 0; m < 4; ++m)
#pragma unroll
                for (int bj = 0; bj < 2; ++bj) { const int q = m * 2 + bj; const u32x2 g2 = gv[q]; constexpr float GI = 1.f / 255.f;
                    f32x4 v0 = acc[ai][bj][m][0], v1 = acc[ai][bj][m][1];
                    v0[0] *= (float)(g2.x & 0xffu) * GI; v0[1] *= (float)((g2.x >> 8) & 0xffu) * GI; v0[2] *= (float)((g2.x >> 16) & 0xffu) * GI; v0[3] *= (float)(g2.x >> 24) * GI;
                    v1[0] *= (float)(g2.y & 0xffu) * GI; v1[1] *= (float)((g2.y >> 8) & 0xffu) * GI; v1[2] *= (float)((g2.y >> 16) & 0xffu) * GI; v1[3] *= (float)(g2.y >> 24) * GI;
                    if (u.which) { const u32x4 o = ov[q];
                        v0[0] += __builtin_bit_cast(float, o.x << 16); v0[1] += __builtin_bit_cast(float, o.x & 0xffff0000u); v0[2] += __builtin_bit_cast(float, o.y << 16); v0[3] += __builtin_bit_cast(float, o.y & 0xffff0000u);
                        v1[0] += __builtin_bit_cast(float, o.z << 16); v1[1] += __builtin_bit_cast(float, o.z & 0xffff0000u); v1[2] += __builtin_bit_cast(float, o.w << 16); v1[3] += __builtin_bit_cast(float, o.w & 0xffff0000u); }
                    u32x4 w; w.x = cvt_pk_bf16(v0[0], v0[1]); w.y = cvt_pk_bf16(v0[2], v0[3]); w.z = cvt_pk_bf16(v1[0], v1[1]); w.w = cvt_pk_bf16(v1[2], v1[3]);
                    if (u.which) store16_wt(mp + (ai * 8 + q) * 512, w); else *(u32x4*)(mp + (ai * 8 + q) * 512) = w; }
        }
    }
};
struct FragOrder : StaticOrder { static constexpr bool AFRAG = true; };
struct PairOrder : StaticOrder {
    __device__ bool next(int i, Unit& u) const { const bool ok = StaticOrder::next(i >> 1, u); u.which = i & 1; return ok; }
    DI const char* a_base(const Gemm& g, const Unit& u, size_t tstep) const { return (const char*)(u.which ? g.A2 : g.A) + (size_t)u.pm * tstep; }
    DI const char* b_base(const Gemm& g, const Unit& u, size_t tstep) const { return (const char*)(u.which ? g.Bt2 : g.Bt) + (size_t)u.pn * tstep; }
};
struct EpiX1 {
    static constexpr bool PERM = true, AFTER_DRAIN = false, HAS_INIT = true;
    const float* x; bf16_t* XB; float* SSQ; unsigned char* XB8;
    DI void init(f32x4 (&acc)[2][2][4][2], const Unit& u, int wr, int wc, int fr, int fq) const {
        const int row0 = u.pm * BM + wr * 64 + fr, col0 = u.pn * BM + wc * 32 + 8 * fq;
#pragma unroll
        for (int ai = 0; ai < 2; ++ai)
#pragma unroll
            for (int m = 0; m < 4; ++m)
#pragma unroll
                for (int bj = 0; bj < 2; ++bj)
#pragma unroll
                    for (int n = 0; n < 2; ++n) acc[ai][bj][m][n] = *(const f32x4*)(x + (size_t)(row0 + ai * HALF + m * 16) * D + col0 + bj * HALF + 4 * n);
    }
    DI void operator()(const f32x4 (&acc)[2][2][4][2], const Unit& u, int wr, int wc, int fr, int fq) const {
        const int row0 = u.pm * BM + wr * 64 + fr, col0 = u.pn * BM + wc * 32 + 8 * fq;
#pragma unroll
        for (int ai = 0; ai < 2; ++ai)
#pragma unroll
            for (int m = 0; m < 4; ++m) { const int row = row0 + ai * HALF + m * 16; float ss = 0.f;
#pragma unroll
                for (int bj = 0; bj < 2; ++bj) { const f32x4 v0 = acc[ai][bj][m][0], v1 = acc[ai][bj][m][1];
                    ss += ((v0[0] * v0[0] + v0[1] * v0[1]) + (v0[2] * v0[2] + v0[3] * v0[3])) + ((v1[0] * v1[0] + v1[1] * v1[1]) + (v1[2] * v1[2] + v1[3] * v1[3]));
                    u32x4 w; w.x = cvt_pk_bf16(v0[0], v0[1]); w.y = cvt_pk_bf16(v0[2], v0[3]); w.z = cvt_pk_bf16(v1[0], v1[1]); w.w = cvt_pk_bf16(v1[2], v1[3]);
                    store16_wt(XB + (size_t)row * D + col0 + bj * HALF, w);
                    { int p0_ = 0, p1_ = 0;
                      p0_ = __builtin_amdgcn_cvt_pk_fp8_f32(v0[0], v0[1], p0_, false); p0_ = __builtin_amdgcn_cvt_pk_fp8_f32(v0[2], v0[3], p0_, true);
                      p1_ = __builtin_amdgcn_cvt_pk_fp8_f32(v1[0], v1[1], p1_, false); p1_ = __builtin_amdgcn_cvt_pk_fp8_f32(v1[2], v1[3], p1_, true);
                      u32x2 w8; w8.x = (unsigned)p0_; w8.y = (unsigned)p1_; *(u32x2*)(XB8 + (size_t)row * D + col0 + bj * HALF) = w8; } }
                ss += __shfl_xor(ss, 16); ss += __shfl_xor(ss, 32);
                if (fq == 0) SSQ[(size_t)row * 16 + u.pn * 4 + wc] = ss; }
    }
};
DI float rstd2_of(const float* SSQ, int row) {
    const f32x4 a = *(const f32x4*)(SSQ + (size_t)row * 16), b = *(const f32x4*)(SSQ + (size_t)row * 16 + 4), c = *(const f32x4*)(SSQ + (size_t)row * 16 + 8), d = *(const f32x4*)(SSQ + (size_t)row * 16 + 12);
    const float s = ((a[0] + a[1]) + (a[2] + a[3])) + ((b[0] + b[1]) + (b[2] + b[3])) + ((c[0] + c[1]) + (c[2] + c[3])) + ((d[0] + d[1]) + (d[2] + d[3]));
    return 1.f / sqrtf(s * (1.f / D) + EPS);
}
struct EpiQP {
    static constexpr bool PERM = true, AFTER_DRAIN = false, HAS_INIT = false;
    bf16_t* QP;
    DI void operator()(const f32x4 (&acc)[2][2][4][2], const Unit& u, int wr, int wc, int fr, int fq) const {
        const int row0 = u.pm * BM + wr * 64 + fr, col0 = u.pn * BM + wc * 32 + 8 * fq;
#pragma unroll
        for (int ai = 0; ai < 2; ++ai)
#pragma unroll
            for (int m = 0; m < 4; ++m) {
#pragma unroll
                for (int bj = 0; bj < 2; ++bj) { const f32x4 v0 = acc[ai][bj][m][0], v1 = acc[ai][bj][m][1];
                    u32x4 w; w.x = cvt_pk_bf16(v0[0], v0[1]); w.y = cvt_pk_bf16(v0[2], v0[3]); w.z = cvt_pk_bf16(v1[0], v1[1]); w.w = cvt_pk_bf16(v1[2], v1[3]);
                    *(u32x4*)(QP + frag_off(u.pm, u.pn, 8, wr * 4 + wc, ai * 8 + m * 2 + bj, fq * 16 + fr)) = w; } }
    }
};
}

#define MFMA32(a, b, c) __builtin_amdgcn_mfma_f32_32x32x16_bf16((a), (b), (c), 0, 0, 0)
DI void p2_conv(Frame& F) {
    constexpr int CT = 4;
    const size_t NT_ = (size_t)F.G * NWAVES * 64;
    for (size_t item = (size_t)F.vcu * NWAVES * 64 + F.tid; item < (size_t)(T / CT) * 64; item += NT_) {
        const int tb = (int)(item >> 6) * CT, c0 = (int)(item & 63) * 8, tl = tb & (SEQ - 1);
        v4u cg[CT + 2], uu[CT + 2], bg[CT];
#pragma unroll
        for (int r = 0; r < CT + 2; ++r) { const bool ok = (tl + r - 2) >= 0; const bf16* rowp = F.PA + (size_t)(tb + (ok ? r - 2 : 0)) * PA_W;
            cg[r] = *(const GAS v4u*)(rowp + C_C + c0); uu[r] = *(const GAS v4u*)(rowp + C_U + c0);
            if (!ok) { cg[r] = (v4u){0u, 0u, 0u, 0u}; } }
#pragma unroll
        for (int r = 0; r < CT; ++r) bg[r] = *(const GAS v4u*)(F.PA + (size_t)(tb + r) * PA_W + C_B + c0);
        f32x4 w[3][2];
#pragma unroll
        for (int j = 0; j < 3; ++j) { w[j][0] = *(const GAS f32x4*)(F.w_conv + j * CONV + c0); w[j][1] = *(const GAS f32x4*)(F.w_conv + j * CONV + c0 + 4); }
        float h[CT + 2][8];
#pragma unroll
        for (int r = 0; r < CT + 2; ++r) { h[r][0] = bf_lo(cg[r].x) * bf_lo(uu[r].x); h[r][1] = bf_hi(cg[r].x) * bf_hi(uu[r].x); h[r][2] = bf_lo(cg[r].y) * bf_lo(uu[r].y); h[r][3] = bf_hi(cg[r].y) * bf_hi(uu[r].y);
            h[r][4] = bf_lo(cg[r].z) * bf_lo(uu[r].z); h[r][5] = bf_hi(cg[r].z) * bf_hi(uu[r].z); h[r][6] = bf_lo(cg[r].w) * bf_lo(uu[r].w); h[r][7] = bf_hi(cg[r].w) * bf_hi(uu[r].w); }
#pragma unroll
        for (int r = 0; r < CT; ++r) {
            float a[8];
#pragma unroll
            for (int e = 0; e < 8; ++e) a[e] = w[0][e >> 2][e & 3] * h[r][e] + w[1][e >> 2][e & 3] * h[r + 1][e] + w[2][e >> 2][e & 3] * h[r + 2][e];
            v4u o; o.x = pk2(a[0] * bf_lo(bg[r].x), a[1] * bf_hi(bg[r].x)); o.y = pk2(a[2] * bf_lo(bg[r].y), a[3] * bf_hi(bg[r].y));
            o.z = pk2(a[4] * bf_lo(bg[r].z), a[5] * bf_hi(bg[r].z)); o.w = pk2(a[6] * bf_lo(bg[r].w), a[7] * bf_hi(bg[r].w));
            *(GAS v4u*)(F.Z + (size_t)(tb + r) * CONV + c0) = o;
        }
    }
}
DI int t5_bucket(int d) {
    if (d < 16) return d;
    const int large = 16 + (int)(logf((float)d / 16.f) / logf(8.f) * 16.f);
    return large < 31 ? large : 31;
}
constexpr int KS_STRIDE = 72, VT_STRIDE = 264;
constexpr int ATT_KS = 0, ATT_VT = 256 * KS_STRIDE * 2, ATT_BIAS = ATT_VT + 64 * VT_STRIDE * 2, ATT_END = ATT_BIAS + 4 * 128 * 4;
static_assert(ATT_END <= RING_BYTES, "attention LDS");
DI void p2_attention(Frame& F) {
    LAS bf16* KS = (LAS bf16*)(F.lds + ATT_KS); LAS bf16* VT = (LAS bf16*)(F.lds + ATT_VT); LAS float* BIAS = (LAS float*)(F.lds + ATT_BIAS);
    const int lane = F.lane, r = lane & 31, hh = lane >> 5;
#pragma unroll 1
    for (int unit = F.vcu; unit < 8 * 32 * NKV; unit += F.G) {
        const int kv = unit & 1, n = (unit >> 1) & 31, b = unit >> 6;
        const int t0 = b * SEQ + n * 128;
        __syncthreads();
        {
            const int j = F.tid >> 1, hf = F.tid & 1; const bool valid = (n > 0) || (j >= 128);
            const bf16* rowp = F.PA + (size_t)(t0 - 128 + j) * PA_W;
            v4u kq[4], vq[4];
#pragma unroll
            for (int i = 0; i < 4; ++i) { kq[i] = (v4u){0u, 0u, 0u, 0u}; vq[i] = kq[i]; }
            if (valid) {
#pragma unroll
                for (int i = 0; i < 4; ++i) { kq[i] = *(const GAS v4u*)(rowp + C_K + kv * HD + hf * 32 + i * 8); vq[i] = *(const GAS v4u*)(rowp + C_V + kv * HD + hf * 32 + i * 8); }
            }
            float kf[32]; float ss = 0.f;
#pragma unroll
            for (int i = 0; i < 4; ++i) { kf[8 * i + 0] = bf_lo(kq[i].x); kf[8 * i + 1] = bf_hi(kq[i].x); kf[8 * i + 2] = bf_lo(kq[i].y); kf[8 * i + 3] = bf_hi(kq[i].y);
                kf[8 * i + 4] = bf_lo(kq[i].z); kf[8 * i + 5] = bf_hi(kq[i].z); kf[8 * i + 6] = bf_lo(kq[i].w); kf[8 * i + 7] = bf_hi(kq[i].w); }
#pragma unroll
            for (int e = 0; e < 32; ++e) ss += kf[e] * kf[e];
            ss += __shfl_xor(ss, 1);
            const float rs = 1.f / sqrtf(ss * (1.f / HD) + EPS);
#pragma unroll
            for (int i = 0; i < 4; ++i) { const f32x4 g0 = *(const GAS f32x4*)(F.k_norm + hf * 32 + 8 * i), g1 = *(const GAS f32x4*)(F.k_norm + hf * 32 + 8 * i + 4);
                v4u o; o.x = pk2(kf[8 * i + 0] * rs * g0[0], kf[8 * i + 1] * rs * g0[1]); o.y = pk2(kf[8 * i + 2] * rs * g0[2], kf[8 * i + 3] * rs * g0[3]);
                o.z = pk2(kf[8 * i + 4] * rs * g1[0], kf[8 * i + 5] * rs * g1[1]); o.w = pk2(kf[8 * i + 6] * rs * g1[2], kf[8 * i + 7] * rs * g1[3]);
                *(LAS v4u*)(KS + j * KS_STRIDE + hf * 32 + 8 * i) = o; }
#pragma unroll
            for (int i = 0; i < 4; ++i) { const int d0 = hf * 32 + 8 * i;
                VT[(d0 + 0) * VT_STRIDE + j] = (bf16)(vq[i].x & 0xffffu); VT[(d0 + 1) * VT_STRIDE + j] = (bf16)(vq[i].x >> 16);
                VT[(d0 + 2) * VT_STRIDE + j] = (bf16)(vq[i].y & 0xffffu); VT[(d0 + 3) * VT_STRIDE + j] = (bf16)(vq[i].y >> 16);
                VT[(d0 + 4) * VT_STRIDE + j] = (bf16)(vq[i].z & 0xffffu); VT[(d0 + 5) * VT_STRIDE + j] = (bf16)(vq[i].z >> 16);
                VT[(d0 + 6) * VT_STRIDE + j] = (bf16)(vq[i].w & 0xffffu); VT[(d0 + 7) * VT_STRIDE + j] = (bf16)(vq[i].w >> 16); }
            { const int g = F.tid >> 7, dist = F.tid & 127; BIAS[F.tid] = F.rel_bias[t5_bucket(dist) * NH + kv * 4 + g]; }
        }
        __syncthreads();
#pragma unroll 1
        for (int task = F.wave; task < 16; task += NWAVES) {
            const int g = task >> 2, c = task & 3, head = kv * 4 + g, r0 = 32 * c;
            bf16x8 qf[4];
            {
                const bf16* qp = F.PA + (size_t)(t0 + r0 + r) * PA_W + C_Q + head * HD + 8 * hh;
                v4u qq[4]; float qv[32]; float ss = 0.f;
#pragma unroll
                for (int s = 0; s < 4; ++s) qq[s] = *(const GAS v4u*)(qp + 16 * s);
#pragma unroll
                for (int s = 0; s < 4; ++s) { qv[8 * s + 0] = bf_lo(qq[s].x); qv[8 * s + 1] = bf_hi(qq[s].x); qv[8 * s + 2] = bf_lo(qq[s].y); qv[8 * s + 3] = bf_hi(qq[s].y);
                    qv[8 * s + 4] = bf_lo(qq[s].z); qv[8 * s + 5] = bf_hi(qq[s].z); qv[8 * s + 6] = bf_lo(qq[s].w); qv[8 * s + 7] = bf_hi(qq[s].w); }
#pragma unroll
                for (int e = 0; e < 32; ++e) ss += qv[e] * qv[e];
                ss += __shfl_xor(ss, 32);
                const float rs = 0.125f / sqrtf(ss * (1.f / HD) + EPS);
#pragma unroll
                for (int s = 0; s < 4; ++s) { const f32x4 g0 = *(const GAS f32x4*)(F.q_norm + 16 * s + 8 * hh), g1 = *(const GAS f32x4*)(F.q_norm + 16 * s + 8 * hh + 4);
                    v4u o; o.x = pk2(qv[8 * s + 0] * rs * g0[0], qv[8 * s + 1] * rs * g0[1]); o.y = pk2(qv[8 * s + 2] * rs * g0[2], qv[8 * s + 3] * rs * g0[3]);
                    o.z = pk2(qv[8 * s + 4] * rs * g1[0], qv[8 * s + 5] * rs * g1[1]); o.w = pk2(qv[8 * s + 6] * rs * g1[2], qv[8 * s + 7] * rs * g1[3]);
                    qf[s] = __builtin_bit_cast(bf16x8, o); }
            }
            f32x16 sacc[5];
#pragma unroll
            for (int i5 = 0; i5 < 5; ++i5) {
#pragma unroll
                for (int e = 0; e < 16; ++e) sacc[i5][e] = 0.f;
                const int kt = c + i5;
#pragma unroll
                for (int s = 0; s < 4; ++s) { const bf16x8 ka = *(const LAS bf16x8*)(KS + (32 * kt + r) * KS_STRIDE + 16 * s + 8 * hh); sacc[i5] = MFMA32(ka, qf[s], sacc[i5]); }
            }
            const float sink = F.sinks[head];
            const int dbase = r - 4 * hh + 128;
            const LAS float* bl = BIAS + g * 128;
            float mx = sink;
#pragma unroll
            for (int i5 = 0; i5 < 5; ++i5) {
                const bool tile_ok = (n > 0) || (c + i5 >= 4);
#pragma unroll
                for (int e = 0; e < 16; ++e) { const int dist = dbase - 32 * i5 - ((e & 3) + 8 * (e >> 2));
                    bool valid = tile_ok; if (i5 == 0) valid = valid && (dist < 128); if (i5 == 4) valid = valid && (dist >= 0);
                    const float lg = sacc[i5][e] + bl[dist & 127];
                    sacc[i5][e] = valid ? lg : -INFINITY; mx = fmaxf(mx, sacc[i5][e]); }
                __builtin_amdgcn_sched_barrier(0);
            }
            mx = fmaxf(mx, __shfl_xor(mx, 32));
            float sum = 0.f;
#pragma unroll
            for (int i5 = 0; i5 < 5; ++i5)
#pragma unroll
                for (int e = 0; e < 16; ++e) { const float p = __expf(sacc[i5][e] - mx); sacc[i5][e] = p; sum += p; }
            sum += __shfl_xor(sum, 32);
            const float inv = 1.f / (sum + __expf(sink - mx));
            f32x16 oacc[2];
#pragma unroll
            for (int dt = 0; dt < 2; ++dt)
#pragma unroll
                for (int e = 0; e < 16; ++e) oacc[dt][e] = 0.f;
#pragma unroll
            for (int i5 = 0; i5 < 5; ++i5)
#pragma unroll
                for (int s2 = 0; s2 < 2; ++s2) {
                    v4u pp; pp.x = pk2(sacc[i5][8 * s2 + 0] * inv, sacc[i5][8 * s2 + 1] * inv); pp.y = pk2(sacc[i5][8 * s2 + 2] * inv, sacc[i5][8 * s2 + 3] * inv);
                    pp.z = pk2(sacc[i5][8 * s2 + 4] * inv, sacc[i5][8 * s2 + 5] * inv); pp.w = pk2(sacc[i5][8 * s2 + 6] * inv, sacc[i5][8 * s2 + 7] * inv);
                    const bf16x8 pb = __builtin_bit_cast(bf16x8, pp);
                    const int kb = 32 * (c + i5) + 16 * s2 + 4 * hh;
#pragma unroll
                    for (int dt = 0; dt < 2; ++dt) {
                        const v2u lo = *(const LAS v2u*)(VT + (32 * dt + r) * VT_STRIDE + kb), hi = *(const LAS v2u*)(VT + (32 * dt + r) * VT_STRIDE + kb + 8);
                        v4u va; va.x = lo.x; va.y = lo.y; va.z = hi.x; va.w = hi.y;
                        oacc[dt] = MFMA32(__builtin_bit_cast(bf16x8, va), pb, oacc[dt]);
                    }
                    __builtin_amdgcn_sched_barrier(0);
                }
            bf16* op = F.ATT + (size_t)(t0 + r0 + r) * CONV + head * HD;
#pragma unroll
            for (int dt = 0; dt < 2; ++dt)
#pragma unroll
                for (int g4 = 0; g4 < 4; ++g4) { v2u w; w.x = pk2(oacc[dt][4 * g4 + 0], oacc[dt][4 * g4 + 1]); w.y = pk2(oacc[dt][4 * g4 + 2], oacc[dt][4 * g4 + 3]);
#ifdef ZERO_ATT
                    w.x = 0u; w.y = 0u;
#endif
                    *(GAS v2u*)(op + 32 * dt + 8 * g4 + 4 * hh) = w; }
        }
    }
}

DI unsigned f2ord(float f) { const unsigned b = __builtin_bit_cast(unsigned, f); return b ^ ((b >> 31) ? 0xffffffffu : 0x80000000u); }
DI float ord2f(unsigned k) { const unsigned b = k ^ ((k >> 31) ? 0x80000000u : 0xffffffffu); return __builtin_bit_cast(float, b); }
DI unsigned umax_(unsigned a, unsigned b) { return a > b ? a : b; }
DI unsigned umin_(unsigned a, unsigned b) { return a < b ? a : b; }
DI void sort16_desc(unsigned (&v)[16]) {
#pragma unroll
    for (int k = 2; k <= 16; k <<= 1)
#pragma unroll
        for (int j = k >> 1; j > 0; j >>= 1)
#pragma unroll
            for (int i = 0; i < 16; ++i) { const int l = i ^ j; if (l > i) { const bool desc = ((i & k) == 0) || (k == 16); const unsigned a = v[i], b = v[l], hi = umax_(a, b), lo = umin_(a, b); v[i] = desc ? hi : lo; v[l] = desc ? lo : hi; } }
}
DI void merge_top16(unsigned (&a)[16], const unsigned (&b)[16]) {
#pragma unroll
    for (int i = 0; i < 16; ++i) a[i] = umax_(a[i], b[15 - i]);
#pragma unroll
    for (int j = 8; j > 0; j >>= 1)
#pragma unroll
        for (int i = 0; i < 16; ++i) { const int l = i ^ j; if (l > i) { const unsigned x = a[i], y = a[l]; a[i] = umax_(x, y); a[l] = umin_(x, y); } }
}
constexpr int SK_STRIDE = 136;
constexpr int P6_KEYS = 0, P6_IB = 2 * NKEYS * SK_STRIDE * 2, P6_END = P6_IB + NWAVES * 64 * 32;
static_assert(P6_END <= RING_BYTES, "topk LDS");
DI void p6_topk(Frame& F) {
    LAS bf16* KL = (LAS bf16*)(F.lds + P6_KEYS); LAS unsigned char* IB = F.lds + P6_IB + (F.wave * 64 + F.lane) * 32;
    const int lane = F.lane, r = lane & 31, hh = lane >> 5;
    pg8::StaticOrder S; S.init(T, PQ, F.G, (int)blockIdx.x);
    pg8::Unit pu;
    for (int ui = 0; S.next(ui, pu); ++ui) {
        const int h = pu.pn, tile = pu.pm;
        __syncthreads();
        {
            const bf16* src = F.SK + (size_t)h * 2 * NKEYS * 128;
#pragma unroll
            for (int i = 0; i < 8; ++i) { const int ch = F.tid + 512 * i; const int row = ch >> 4, c8 = (ch & 15) * 8;
                *(LAS v4u*)(KL + row * SK_STRIDE + c8) = *(const GAS v4u*)(src + (size_t)row * 128 + c8); }
        }
        __syncthreads();
        const int t = tile * 256 + F.wave * 32 + r;
        unsigned S[2][16];
#pragma unroll
        for (int p = 0; p < 2; ++p) {
            bf16x8 qf[8];
            const int rt = F.wave * 32 + r, q_ai = rt >> 7, q_wr = (rt >> 6) & 1, q_m = (rt >> 4) & 3, q_fr = rt & 15;
#pragma unroll
            for (int s = 0; s < 8; ++s) qf[s] = __builtin_bit_cast(bf16x8, *(const GAS v4u*)(F.QP + pg8::frag_off(tile, h, 8, q_wr * 4 + (s >> 1), q_ai * 8 + q_m * 2 + p, (2 * (s & 1) + hh) * 16 + q_fr)));
            unsigned key[4][16];
#pragma unroll
            for (int kt = 0; kt < 4; ++kt) {
                f32x16 acc;
#pragma unroll
                for (int e = 0; e < 16; ++e) acc[e] = 0.f;
#pragma unroll
                for (int s = 0; s < 8; ++s) { const bf16x8 ka = *(const LAS bf16x8*)(KL + (p * NKEYS + 32 * kt + r) * SK_STRIDE + 16 * s + 8 * hh); acc = MFMA32(ka, qf[s], acc); }
#pragma unroll
                for (int e = 0; e < 16; ++e) { const int nk = 32 * kt + (e & 3) + 8 * (e >> 2) + 4 * hh; key[kt][e] = (f2ord(acc[e]) & ~127u) | (unsigned)(127 - nk); }
            }
#pragma unroll
            for (int kt = 0; kt < 4; ++kt) sort16_desc(key[kt]);
            merge_top16(key[0], key[1]); merge_top16(key[2], key[3]); merge_top16(key[0], key[2]);
            unsigned other[16];
#pragma unroll
            for (int i = 0; i < 16; ++i) other[i] = (unsigned)__shfl_xor((int)key[0][i], 32);
            merge_top16(key[0], other);
#pragma unroll
            for (int i = 0; i < 16; ++i) S[p][i] = key[0][i];
        }
        float s0[16], s1[16]; const float rs2 = pg8::rstd2_of(F.SSQ, t);
#pragma unroll
        for (int i = 0; i < 16; ++i) { s0[i] = ord2f(S[0][i] & ~127u) * rs2; s1[i] = ord2f(S[1][i] & ~127u) * rs2; }
        {
#pragma unroll
            for (int q4 = 0; q4 < 4; ++q4) { unsigned w0 = 0, w1 = 0;
#pragma unroll
                for (int e = 0; e < 4; ++e) { w0 |= (127u - (S[0][4 * q4 + e] & 127u)) << (8 * e); w1 |= (127u - (S[1][4 * q4 + e] & 127u)) << (8 * e); }
                *(LAS unsigned*)(IB + 4 * q4) = w0; *(LAS unsigned*)(IB + 16 + 4 * q4) = w1; }
        }
        unsigned cand[2][16];
#pragma unroll
        for (int i = 0; i < 2; ++i)
#pragma unroll
            for (int e = 0; e < 16; ++e) cand[i][e] = 0u;
        {
            int cnt = 0; float ea = 0.f, eb = 0.f; int ep = 0;
#pragma unroll
            for (int a = 0; a < 16; ++a)
#pragma unroll
                for (int b = 0; b < 16; ++b)
                    if ((a + 1) * (b + 1) <= 16) {
                        if ((cnt & 1) == 0) { ea = s0[a]; eb = s1[b]; ep = 255 - (a * 16 + b); }
                        else { const int slot = cnt >> 1; const float sa = hh ? s0[a] : ea, sb = hh ? s1[b] : eb; const int pp = hh ? 255 - (a * 16 + b) : ep;
                            cand[slot & 1][slot >> 1] = (f2ord(sa + sb) & ~255u) | (unsigned)pp; }
                        ++cnt; }
        }
        sort16_desc(cand[0]); sort16_desc(cand[1]); merge_top16(cand[0], cand[1]);
        {
            unsigned other[16];
#pragma unroll
            for (int i = 0; i < 16; ++i) other[i] = (unsigned)__shfl_xor((int)cand[0][i], 32);
            merge_top16(cand[0], other);
        }
        float gv[16]; int ev[16]; float gsum = 0.f; const float gmx = ord2f(cand[0][0] & ~255u);
#pragma unroll
        for (int i = 0; i < 16; ++i) { const unsigned k = cand[0][i]; const int pos = 255 - (int)(k & 255u); const int a = pos >> 4, b = pos & 15;
            ev[i] = (int)IB[a] * NKEYS + (int)IB[16 + b]; gv[i] = __expf(ord2f(k & ~255u) - gmx); gsum += gv[i]; }
        float ginv = 1.f / gsum;
#ifdef UNIFORM_GATES
#pragma unroll
        for (int i = 0; i < 16; ++i) gv[i] = 1.f;
        ginv = 1.f / 16.f;
#endif
        if (hh == 0) {
            unsigned short* ip = F.IDX + (size_t)t * NSEL + h * TOPK; float* gp = F.GATE + (size_t)t * NSEL + h * TOPK;
#pragma unroll
            for (int i = 0; i < 2; ++i) *(GAS v4i*)(ip + 8 * i) = (v4i){ev[8 * i] | (ev[8 * i + 1] << 16), ev[8 * i + 2] | (ev[8 * i + 3] << 16), ev[8 * i + 4] | (ev[8 * i + 5] << 16), ev[8 * i + 6] | (ev[8 * i + 7] << 16)};
#pragma unroll
            for (int i = 0; i < 4; ++i) *(GAS f32x4*)(gp + 4 * i) = (f32x4){gv[4 * i] * ginv, gv[4 * i + 1] * ginv, gv[4 * i + 2] * ginv, gv[4 * i + 3] * ginv};
        }
    }
}

typedef float f32x2_t __attribute__((ext_vector_type(2)));
DI void fp8x16_to_f32(v4u q, float (&f)[16]) {
#pragma unroll
    for (int w = 0; w < 4; ++w) { const f32x2_t lo = __builtin_amdgcn_cvt_pk_f32_fp8((int)q[w], false), hi = __builtin_amdgcn_cvt_pk_f32_fp8((int)q[w], true);
        f[4 * w + 0] = lo.x; f[4 * w + 1] = lo.y; f[4 * w + 2] = hi.x; f[4 * w + 3] = hi.y; }
}
struct XccInfo { int q, nx, nloc, rank; };
DI void xcc_info_build(const XcdBarrier& b) {
    if (threadIdx.x == 0) {
        unsigned q = 0, nx = 0, nloc = 1;
        for (unsigned j = 0; j < 16; ++j) { const unsigned c = xb_ld(&b.bar[XB_XCNT(j)]); if (c > 0u) { if (j < b.x) ++q; ++nx; } if (j == b.x) nloc = c; }
        b.st[3] = q; b.st[4] = nx > 0u ? nx : 1u; b.st[5] = nloc > 0u ? nloc : 1u;
    }
    __syncthreads();
}
DI XccInfo xcc_info(const XcdBarrier& b) {
    XccInfo I; I.rank = __builtin_amdgcn_readfirstlane((int)b.st[2]); I.q = __builtin_amdgcn_readfirstlane((int)b.st[3]); I.nx = __builtin_amdgcn_readfirstlane((int)b.st[4]); I.nloc = __builtin_amdgcn_readfirstlane((int)b.st[5]);
    return I;
}
DI float dpp_sum8(float s) {
    s += __builtin_bit_cast(float, __builtin_amdgcn_update_dpp(0, __builtin_bit_cast(int, s), 0xB1, 0xf, 0xf, false));
    s += __builtin_bit_cast(float, __builtin_amdgcn_update_dpp(0, __builtin_bit_cast(int, s), 0x4E, 0xf, 0xf, false));
    s += __builtin_bit_cast(float, __builtin_amdgcn_update_dpp(0, __builtin_bit_cast(int, s), 0x141, 0xf, 0xf, false));
    return s;
}
typedef long i64_t;
typedef long i64x2 __attribute__((ext_vector_type(2)));
typedef int v4i_t __attribute__((ext_vector_type(4)));
typedef int v8i_t __attribute__((ext_vector_type(8)));
constexpr int PEER_ROW = 144, PEER_WAVE_LDS = 128 * PEER_ROW;
constexpr int MX_ONE = 0x7f7f7f7f;
#define P7_IDS(t_, ia_, ib_) do { ia_ = (int)F.IDX[(size_t)(t_) * NSEL + lane]; ib_ = (int)F.IDX[(size_t)(t_) * NSEL + 64 + lane]; } while (0)
#define P7_ISSUE(t_, ia_, ib_, uq_, x_) do { \
        const unsigned char* xr_ = F.XB8 + (size_t)(t_) * D + sl * 256 + 16 * g;   \
        x_[0] = *(const GAS v4u*)(xr_); x_[1] = *(const GAS v4u*)(xr_ + 64); x_[2] = *(const GAS v4u*)(xr_ + 128); x_[3] = *(const GAS v4u*)(xr_ + 192); \
        _Pragma("unroll") for (int ld = 0; ld < 16; ++ld) { const int e_ = __shfl(ld < 8 ? ia_ : ib_, (8 * ld + row8) & 63); uq_[ld] = *(const GAS v4u*)(Us + (unsigned)(e_ * 128 + 16 * c8)); } } while (0)
#define P7_COMPUTE(t_, uq_, x_) do { \
        _Pragma("unroll") for (int ld = 0; ld < 16; ++ld) *(LAS v4u*)(wl + (8 * ld + row8) * PEER_ROW + 16 * c8) = uq_[ld]; \
        v8i_t xb0_, xb1_; \
        xb0_[0] = (int)x_[0].x; xb0_[1] = (int)x_[0].y; xb0_[2] = (int)x_[0].z; xb0_[3] = (int)x_[0].w; xb0_[4] = (int)x_[1].x; xb0_[5] = (int)x_[1].y; xb0_[6] = (int)x_[1].z; xb0_[7] = (int)x_[1].w; \
        xb1_[0] = (int)x_[2].x; xb1_[1] = (int)x_[2].y; xb1_[2] = (int)x_[2].z; xb1_[3] = (int)x_[2].w; xb1_[4] = (int)x_[3].x; xb1_[5] = (int)x_[3].y; xb1_[6] = (int)x_[3].z; xb1_[7] = (int)x_[3].w; \
        f32x4 keep = {0.f, 0.f, 0.f, 0.f}; \
        _Pragma("unroll") for (int j = 0; j < 8; ++j) { f32x4 c_ = {0.f, 0.f, 0.f, 0.f}; \
            const v4i_t a0_ = *(const LAS v4i_t*)(wl + (16 * j + m) * PEER_ROW + 16 * g), a1_ = *(const LAS v4i_t*)(wl + (16 * j + m) * PEER_ROW + 64 + 16 * g); \
            v8i_t A0_ = {a0_[0], a0_[1], a0_[2], a0_[3], 0, 0, 0, 0}, A1_ = {a1_[0], a1_[1], a1_[2], a1_[3], 0, 0, 0, 0}; \
            c_ = __builtin_amdgcn_mfma_scale_f32_16x16x128_f8f6f4(A0_, xb0_, c_, 4, 0, 0, MX_ONE, 0, MX_ONE); \
            c_ = __builtin_amdgcn_mfma_scale_f32_16x16x128_f8f6f4(A1_, xb1_, c_, 4, 0, 0, MX_ONE, 0, MX_ONE); \
            keep = (m == j) ? c_ : keep; } \
        { const bool ok_ = (m < 8) && ((t_) < T); bf16* dst_ = ok_ ? F.PARTB + ((size_t)sl * T + (t_)) * NSEL + 16 * m + 4 * g : F.PARTB + (size_t)8 * T * NSEL + 4 * lane; \
          v2u w_; w_.x = pk2(keep[0], keep[1]); w_.y = pk2(keep[2], keep[3]); *(GAS v2u*)dst_ = w_; } } while (0)
DI int peer_next(volatile LAS unsigned* ctr, int lane) { unsigned k = 0u; if (lane == 0) k = __hip_atomic_fetch_add((LAS unsigned*)ctr, 1u, __ATOMIC_RELAXED, __HIP_MEMORY_SCOPE_WORKGROUP); return __builtin_amdgcn_readfirstlane((int)k); }
DI int peer_tok(int tbase, int tstride, int k) { return tbase + (k & 7) + (k >> 3) * tstride; }
DI void p7_udot(Frame& F, const XccInfo& I) {
    const int lane = F.lane, g = lane >> 4, m = lane & 15, row8 = lane >> 3, c8 = lane & 7;
    LAS unsigned char* wl = F.lds + F.wave * PEER_WAVE_LDS;
    const unsigned char* U4 = (const unsigned char*)F.UB;
    const int tstride = I.nloc * NWAVES, tbase = I.rank * NWAVES;
    int it = 0;
    for (int share = I.q; share < 8; share += I.nx, ++it) {
        const int sl = share >> 1, half = share & 1;
        const unsigned char* Us = U4 + (size_t)sl * NEXP * 128;
        volatile LAS unsigned* ctr = F.MISC + 16 + it;
#define CL(t_) ((t_) < T ? (t_) : T - 1)
#define TOK(k_) (2 * peer_tok(tbase, tstride, (k_)) + half)
        v4u uqA[16], uqB[16]; int iA0, iA1, iB0, iB1;
        int kk = peer_next(ctr, lane); int tA = TOK(kk); kk = peer_next(ctr, lane); int tB = TOK(kk);
        {
            v4u xA[4], xB[4];
            P7_IDS(CL(tA), iA0, iA1);
            P7_ISSUE(CL(tA), iA0, iA1, uqA, xA);
            P7_IDS(CL(tB), iB0, iB1);
#pragma unroll 1
            while (tA < T) {
                kk = peer_next(ctr, lane); const int tC = TOK(kk); kk = peer_next(ctr, lane); const int tD = TOK(kk);
                P7_IDS(CL(tC), iA0, iA1);
                P7_ISSUE(CL(tB), iB0, iB1, uqB, xB);
                P7_COMPUTE(tA, uqA, xA);
                P7_IDS(CL(tD), iB0, iB1);
                P7_ISSUE(CL(tC), iA0, iA1, uqA, xA);
                P7_COMPUTE(tB, uqB, xB);
                tA = tC; tB = tD;
            }
        }
#undef TOK
#undef CL
    }
}
DI void p8_act(Frame& F) {
    const size_t NT_ = (size_t)F.G * NWAVES * 64;
    for (size_t item = (size_t)F.vcu * NWAVES * 64 + F.tid; item < (size_t)T * NSEL / 4; item += NT_) {
        const int t = (int)(item >> 5);
        f32x4 s = {0.f, 0.f, 0.f, 0.f};
#pragma unroll
        for (int sl = 0; sl < 4; ++sl) { const v2u p = *(const GAS v2u*)(F.PARTB + (size_t)sl * T * NSEL + item * 4); s = s + (f32x4){bf_lo(p.x), bf_hi(p.x), bf_lo(p.y), bf_hi(p.y)}; }
        { const v2u ids = *(const GAS v2u*)(F.IDX + item * 4);
          s[0] *= F.SU[ids.x & 0xffffu]; s[1] *= F.SU[ids.x >> 16]; s[2] *= F.SU[ids.y & 0xffffu]; s[3] *= F.SU[ids.y >> 16]; }
        const float rs2 = pg8::rstd2_of(F.SSQ, t);
        const f32x4 g = *(const GAS f32x4*)(F.GATE + item * 4);
        f32x4 o;
#pragma unroll
        for (int e = 0; e < 4; ++e) { const float pre = s[e] * rs2; o[e] = 0.5f * pre * (1.f + erff(pre * 0.70710678118f)) * g[e] * A_SCALE; }
        ((GAS unsigned*)F.ACT)[item] = pk4_fp8(o);
    }
}
typedef int v2i_t __attribute__((ext_vector_type(2)));
#define P9_IDS(t_, ia_, ib_, ak_) do { ia_ = (int)F.IDX[(size_t)(t_) * NSEL + lane]; ib_ = (int)F.IDX[(size_t)(t_) * NSEL + 64 + lane]; \
        const unsigned char* ap_ = (const unsigned char*)F.ACT + (size_t)(t_) * NSEL + 8 * g; \
        _Pragma("unroll") for (int s2 = 0; s2 < 4; ++s2) ak_[s2] = *(const GAS i64_t*)(ap_ + 32 * s2); } while (0)
#define P9_ISSUE(ia_, ib_, vq_) do { \
        _Pragma("unroll") for (int ld = 0; ld < 16; ++ld) { const int e_ = __shfl(ld < 8 ? ia_ : ib_, (8 * ld + row8) & 63); vq_[ld] = *(const GAS v4u*)(Vs + (unsigned)(e_ * 128 + 16 * c8)); } } while (0)
#define P9_COMPUTE(t_, vq_, ak_) do { \
        _Pragma("unroll") for (int ld = 0; ld < 16; ++ld) *(LAS v4u*)(wl + (8 * ld + row8) * PEER_ROW + 16 * c8) = vq_[ld]; \
        float keep0 = 0.f, keep1 = 0.f; \
        _Pragma("unroll") for (int ct = 0; ct < 8; ++ct) { f32x4 c_ = {0.f, 0.f, 0.f, 0.f}; \
            _Pragma("unroll") for (int s2 = 0; s2 < 4; ++s2) { \
                const v2i_t b_ = __builtin_amdgcn_ds_read_tr8_b64_v2i32((LAS v2i_t*)(wl + (32 * s2 + 8 * g + trr) * PEER_ROW + 16 * ct + 8 * trc)); \
                c_ = __builtin_amdgcn_mfma_f32_16x16x32_fp8_fp8(ak_[s2], __builtin_bit_cast(i64_t, b_), c_, 0, 0, 0); } \
            if (ct < 4) keep0 = (g == ct) ? c_[0] : keep0; else keep1 = (g == ct - 4) ? c_[0] : keep1; }   \
        { const bool ok_ = (t_) < T; const size_t oo_ = (size_t)(ok_ ? (t_) : T - 1) * D + sl * 128 + 16 * g + n16; \
          const float r0_ = __builtin_bit_cast(float, (unsigned)F.XB[oo_] << 16), r1_ = __builtin_bit_cast(float, (unsigned)F.XB[oo_ + 64] << 16); \
          float* op_ = ok_ ? F.out + oo_ : (float*)F.PARTB + 2 * lane;                   \
          op_[0] = r0_ + keep0 * (1.f / (A_SCALE * V_SCALE)); op_[ok_ ? 64 : 1] = r1_ + keep1 * (1.f / (A_SCALE * V_SCALE)); } } while (0)
DI void p9_vacc(Frame& F, const XccInfo& I) {
    const int lane = F.lane, g = lane >> 4, n16 = lane & 15, row8 = lane >> 3, c8 = lane & 7, trr = n16 >> 1, trc = n16 & 1;
    LAS unsigned char* wl = F.lds + F.wave * PEER_WAVE_LDS;
    const unsigned char* V8 = (const unsigned char*)F.VB;
    const int tstride = I.nloc * NWAVES, tfirst = I.rank * NWAVES + F.wave;
    for (int sl = I.q; sl < 8; sl += I.nx) {
        const unsigned char* Vs = V8 + (size_t)sl * NEXP * 128;
        if (tfirst >= T) continue;
        v4u vqA[16], vqB[16]; i64_t akA[4], akB[4]; int iA0, iA1, iB0, iB1;
#define CL(t_) ((t_) < T ? (t_) : T - 1)
        P9_IDS(tfirst, iA0, iA1, akA);
        P9_ISSUE(iA0, iA1, vqA);
        P9_IDS(CL(tfirst + tstride), iB0, iB1, akB);
#pragma unroll 1
        for (int t = tfirst; t < T; t += 2 * tstride) {
            const int t1 = t + tstride, t2 = CL(t + 2 * tstride), t3 = CL(t + 3 * tstride);
            i64_t akN[4];
            i64_t akM[4];
            P9_IDS(t2, iA0, iA1, akN);
            P9_ISSUE(iB0, iB1, vqB);
            P9_COMPUTE(t, vqA, akA);
            P9_IDS(t3, iB0, iB1, akM);
            P9_ISSUE(iA0, iA1, vqA);
            P9_COMPUTE(t1, vqB, akB);
#pragma unroll
            for (int s2 = 0; s2 < 4; ++s2) { akA[s2] = akN[s2]; akB[s2] = akM[s2]; }
        }
#undef CL
    }
}

struct Args { const float* in[17]; float* out; unsigned char* ws; int ph_lo, ph_hi, li, pad; };
__global__ void __launch_bounds__(NWAVES * 64, 2) hyb_fwd(Args args) {
    extern __shared__ __attribute__((aligned(16))) unsigned char lds[];
    Frame F;
    F.lds = (LAS unsigned char*)lds;
    F.MISC = (volatile LAS unsigned*)(F.lds + MISC_OFF);
    F.tid = threadIdx.x; F.lane = F.tid & 63; F.wave = __builtin_amdgcn_readfirstlane(F.tid >> 6);
    F.G = gridDim.x; { const int bx = blockIdx.x; F.vcu = (F.G % 8 == 0) ? (bx % 8) * (F.G / 8) + bx / 8 : bx; }
    unsigned char* ws = args.ws;
    F.ctl = (gu32*)(ws + WS_CTL);
    F.x = args.in[0]; F.norm_mix = args.in[1]; F.norm_ffn = args.in[2]; F.w_in = args.in[3]; F.b_gate = args.in[4]; F.w_conv = args.in[5]; F.q_norm = args.in[6]; F.k_norm = args.in[7];
    F.sinks = args.in[8]; F.rel_bias = args.in[9]; F.w_conv_out = args.in[10]; F.w_attn_out = args.in[11]; F.w_out = args.in[12]; F.w_query = args.in[13]; F.sub_keys = args.in[14];
    F.expert_u = args.in[15]; F.expert_v = args.in[16]; F.out = args.out;
    F.WIN = (bf16*)(ws + WS_WIN); F.WC = (bf16*)(ws + WS_WC); F.WA = (bf16*)(ws + WS_WA); F.WO = (bf16*)(ws + WS_WO); F.WQ = (bf16*)(ws + WS_WQ); F.SK = (bf16*)(ws + WS_SK);
    F.UB = (bf16*)(ws + WS_UB); F.VB = (bf16*)(ws + WS_VB); F.XB = (bf16*)(ws + WS_XB); F.PA = (bf16*)(ws + WS_PA); F.MIX = (bf16*)(ws + WS_MIX); F.G_ = (bf16*)(ws + WS_G); F.QP = (bf16*)(ws + WS_QP);
    F.Z = (bf16*)(ws + WS_Z); F.ATT = (bf16*)(ws + WS_ATT); F.RSTD1 = (float*)(ws + WS_RSTD1); F.SSQ = (float*)(ws + WS_SSQ); F.GATE = (float*)(ws + WS_GATE); F.IDX = (unsigned short*)(ws + WS_IDX); F.PARTB = (bf16*)(ws + WS_PART); F.SU = (float*)(ws + WS_SU); F.XB8 = (unsigned char*)(ws + WS_XB8); F.ACT = (float*)(ws + WS_ACT);
    for (int u = F.tid; u < (LDS_BYTES - LDSCTL_OFF) / 4; u += NWAVES * 64) ((LAS unsigned*)(F.lds + LDSCTL_OFF))[u] = 0u;
    __syncthreads();
    XcdBarrier bar; bar.bar = (unsigned*)(F.ctl + CW_BAR); bar.x = 0; bar.st = nullptr;
    const int lo = args.ph_lo, hi = args.ph_hi;
    if (hi - lo > 1) bar = xcd_barrier_post((unsigned*)(F.ctl + CW_BAR), F.MISC + 8);
#ifndef PH_MASK
#define PH_MASK 0x3ff
#endif
#define IN(k) (((PH_MASK >> (k)) & 1) && lo <= (k) && (k) < hi)
#define SEAM(k) do { if (IN(k) && IN((k) + 1)) xcd_barrier(bar); } while (0)
#ifndef PROBE_DUP
#define PROBE_DUP 0
#endif
#define REP(k) for (int rep_ = 0; rep_ < (((PROBE_DUP >> (k)) & 1) ? 2 : 1); ++rep_)

    if (IN(0)) { REP(0) p0_prologue(F); SEAM(0); }
    if (IN(1)) {
        pg8::Gemm g{F.XB, F.WIN, nullptr, nullptr, T, IN_DIM, D}; pg8::StaticOrder S; S.init(T, IN_DIM, F.G, (int)blockIdx.x);
        { LAS float* bgl = (LAS float*)(F.lds + RING_BYTES); for (int i = F.tid; i < 2 * D; i += NWAVES * 64) bgl[i] = F.b_gate[i]; __syncthreads(); }
        pg8::EpiProj E{F.PA, F.G_, (const PG8_LAS float*)(F.lds + RING_BYTES)};
        REP(1) pg8::gemm_phase<pg8::EpiProj, pg8::StaticOrder, PG8_ALIGN, PG8_SP2>(F.lds + RING_OFF, g, S, E);
        {
            const int nwg = (T / 256) * (IN_DIM / 256), rem = nwg % F.G, c = (int)blockIdx.x; const int nshort = rem ? F.G - rem : F.G, sidx = rem ? c - rem : c;
            if (sidx >= 0) { p0_convert_u_fp4(F, sidx, nshort);
                             p0_convert_fp8(F, F.expert_v, (unsigned char*)F.VB, (size_t)NEXP * D, nullptr, V_SCALE, sidx, nshort); } }
        SEAM(1);
    }
    if (IN(2)) {
        REP(2) { p2_conv(F); p2_attention(F); }
        SEAM(2); }
    if (IN(3)) {
        pg8::Gemm g{F.Z, F.WC, F.ATT, F.WA, T, D, CONV}; pg8::PairOrder S; S.init(T, D, F.G, (int)blockIdx.x);
        pg8::EpiMix E{F.MIX, F.G_};
        REP(3) pg8::gemm_phase<pg8::EpiMix, pg8::PairOrder, PG8_ALIGN, PG8_SP2>(F.lds + RING_OFF, g, S, E);
        SEAM(3);
    }
    if (IN(4)) {
        pg8::Gemm g{F.MIX, F.WO, nullptr, nullptr, T, D, D}; pg8::FragOrder S; S.init(T, D, F.G, (int)blockIdx.x);
        pg8::EpiX1 E{F.x, F.XB, F.SSQ, F.XB8};
        REP(4) pg8::gemm_phase<pg8::EpiX1, pg8::FragOrder, PG8_ALIGN, PG8_SP2>(F.lds + RING_OFF, g, S, E);
        SEAM(4);
    }
    if (IN(5)) {
        pg8::Gemm g{F.XB, F.WQ, nullptr, nullptr, T, PQ, D}; pg8::StaticOrder S; S.init(T, PQ, F.G, (int)blockIdx.x);
        pg8::EpiQP E{F.QP};
        REP(5) pg8::gemm_phase<pg8::EpiQP, pg8::StaticOrder, PG8_ALIGN, PG8_SP2>(F.lds + RING_OFF, g, S, E);
    }
    if (IN(6)) { REP(6) p6_topk(F); SEAM(6); }
    if (IN(7)) { xcc_info_build(bar); const XccInfo I = xcc_info(bar); REP(7) p7_udot(F, I); SEAM(7); }
    if (IN(8)) { REP(8) p8_act(F); SEAM(8); }
    if (IN(9)) { const XccInfo I = xcc_info(bar); p9_vacc(F, I); }
#undef IN
#undef SEAM
}

extern "C" void kernel_launch(void* const* d_in, const int* in_sizes, int n_in, void* d_out, int out_size, void* d_ws, size_t ws_size, hipStream_t stream) {
    static int grid = 0;
    if (grid == 0) {
        if (n_in != 17 || in_sizes[0] != T * D || out_size != T * D || ws_size < WS_END) { fprintf(stderr, "kernel_launch: unexpected shapes (n_in %d, in0 %d, out %d, ws %zu)\n", n_in, n_in > 0 ? in_sizes[0] : -1, out_size, ws_size); grid = -1; return; }
        int dev = 0, cus = 0, per_cu = 0;
        if (hipGetDevice(&dev) != hipSuccess || hipDeviceGetAttribute(&cus, hipDeviceAttributeMultiprocessorCount, dev) != hipSuccess) { grid = -1; return; }
        if (hipFuncSetAttribute((const void*)hyb_fwd, hipFuncAttributeMaxDynamicSharedMemorySize, LDS_BYTES) != hipSuccess) { fprintf(stderr, "kernel_launch: hipFuncSetAttribute failed\n"); grid = -1; return; }
        if (hipOccupancyMaxActiveBlocksPerMultiprocessor(&per_cu, (const void*)hyb_fwd, NWAVES * 64, LDS_BYTES) != hipSuccess || per_cu < 1) { fprintf(stderr, "kernel_launch: occupancy query says %d blocks per CU\n", per_cu); (void)hipGetLastError(); grid = -1; return; }
        grid = cus * 1;
    }
    if (grid < 0) return;
    if (hipMemsetAsync((char*)d_ws + WS_CTL, 0, CTL_ZERO_BYTES, stream) != hipSuccess) { fprintf(stderr, "kernel_launch: memset failed\n"); return; }
    Args a{};
    for (int i = 0; i < 17; ++i) a.in[i] = (const float*)d_in[i];
    a.out = (float*)d_out; a.ws = (unsigned char*)d_ws;
#if MK_ONE_LAUNCH
    a.ph_lo = 0; a.ph_hi = N_PHASES; a.li = 0;
    void* kargs[] = {&a};
    const hipError_t le = hipLaunchCooperativeKernel((const void*)hyb_fwd, dim3(grid), dim3(NWAVES * 64), kargs, LDS_BYTES, stream);
    if (le != hipSuccess) fprintf(stderr, "kernel_launch: cooperative launch failed: %s (grid %d)\n", hipGetErrorName(le), grid);
#else
    for (int li = 0; li < N_PHASES; ++li) {
        a.ph_lo = li; a.ph_hi = li + 1; a.li = li;
        hipLaunchKernelGGL(hyb_fwd, dim3(grid), dim3(NWAVES * 64), LDS_BYTES, stream, a);
        const hipError_t le = hipPeekAtLastError();
        if (le != hipSuccess) { fprintf(stderr, "kernel_launch: launch %d failed: %s\n", li, hipGetErrorName(le)); break; }
    }
#endif
}
```

```cpp
#include <hip/hip_runtime.h>
#include <hip/hip_cooperative_groups.h>
#include <cstdio>
#include <cstdint>
namespace pg8 {
#define PG8_LAS __attribute__((address_space(3)))
typedef unsigned short bf16_t;
typedef short bf16x8 __attribute__((ext_vector_type(8)));
typedef float f32x4 __attribute__((ext_vector_type(4)));
typedef unsigned u32x4 __attribute__((ext_vector_type(4)));
typedef unsigned u32x2 __attribute__((ext_vector_type(2)));
constexpr int BM = 256, BK = 64, HALF = 128, HTB = HALF * BK * 2  , STAGE_BYTES = 8 * HTB, NXCD = 8, WGM = 8;

__host__ __device__ __forceinline__ int lds_byte(int r, int c) { const int st = (r >> 4) * 2 + (c >> 5), rr = r & 15, cc = c & 31, ob = rr * 64 + cc * 2; return st * 1024 + (ob ^ (((ob >> 9) & 1) << 5)); }
__host__ __device__ __forceinline__ void stage_rc(int b, int& R, int& C) { const int st = b / 1024, sb = b % 1024, swz = sb ^ (((sb >> 9) & 1) << 5); R = (st >> 1) * 16 + swz / 64; C = (st & 1) * 32 + (swz % 64) / 2; }
__host__ __device__ __forceinline__ int perm32(int rho) { const int n = rho >> 4, i = rho & 15; return 8 * (i >> 2) + 4 * n + (i & 3); }

struct Unit { int pm, pn, which; };
struct Gemm { const bf16_t* A; const bf16_t* Bt; const bf16_t* A2; const bf16_t* Bt2; int M, N, K; };

struct StaticOrder {
    static constexpr bool AFRAG = false;
    int nM, nN, nwg, G, c;
    __host__ __device__ void init(int M, int N, int G_, int c_) { nM = M / BM; nN = N / BM; nwg = nM * nN; G = G_; c = c_; }
    __host__ __device__ bool next(int i, Unit& u) const {
        const long L = (long)i * G + c; if (L >= nwg) return false;
        int wgid = (int)L; { const int q = nwg / NXCD, r = nwg % NXCD, xcd = wgid % NXCD, off = wgid / NXCD; wgid = (xcd < r ? xcd * (q + 1) : r * (q + 1) + (xcd - r) * q) + off; }
        const int nig = WGM * nN, gid = wgid / nig, fm = gid * WGM, gsz = (nM - fm) < WGM ? (nM - fm) : WGM;
        u.pm = fm + ((wgid % nig) % gsz); u.pn = (wgid % nig) / gsz; u.which = 0; return true;
    }
    __device__ __forceinline__ const char* a_base(const Gemm& g, const Unit& u, size_t tstep) const { return (const char*)g.A + (size_t)u.pm * tstep; }
    __device__ __forceinline__ const char* b_base(const Gemm& g, const Unit& u, size_t tstep) const { return (const char*)g.Bt + (size_t)u.pn * tstep; }
    __device__ __forceinline__ void a_ready(const Unit&) const {}
    __device__ __forceinline__ void done(const Unit&) const {}
};

__device__ __forceinline__ unsigned cvt_pk_bf16(float lo, float hi) { unsigned r; asm volatile("v_cvt_pk_bf16_f32 %0, %1, %2" : "=v"(r) : "v"(lo), "v"(hi)); return r; }
__device__ __forceinline__ void store16_wt(void* p, u32x4 v) { asm volatile("global_store_dwordx4 %0, %1, off sc1\n\ts_nop 1" :: "v"(p), "v"(v) : "memory"); }
__device__ __forceinline__ void store8_wt(void* p, u32x2 v) { asm volatile("global_store_dwordx2 %0, %1, off sc1\n\ts_nop 1" :: "v"(p), "v"(v) : "memory"); }
typedef float f32x2 __attribute__((ext_vector_type(2)));
__device__ __forceinline__ f32x2 gelu_pk(f32x2 v) {
    const f32x2 av = __builtin_elementwise_abs(v), d = av * 0.2316418882f + 1.0f;
    f32x2 t; t.x = __builtin_amdgcn_rcpf(d.x); t.y = __builtin_amdgcn_rcpf(d.y);
    f32x2 q = t * 0.5307027145f + (-0.7265760135f); q = q * t + 0.7107068705f; q = q * t + (-0.142248368f); q = q * t + 0.127414796f; q = q * t;
    const f32x2 s = (v * v) * (-0.72134752044f);
    f32x2 e; e.x = __builtin_amdgcn_exp2f(s.x); e.y = __builtin_amdgcn_exp2f(s.y);
    const f32x2 m = v * (q * e), r = v - m;
    f32x2 o; o.x = v.x < 0.f ? m.x : r.x; o.y = v.y < 0.f ? m.y : r.y; return o;
}

template <class Epi, class Sched, bool ALIGN_EPI = false, bool SP2 = false>
__device__ __forceinline__ void gemm_phase(PG8_LAS unsigned char* lds, const Gemm g, const Sched& S, const Epi& E) {
    const int tid = threadIdx.x, wid = __builtin_amdgcn_readfirstlane(tid >> 6), lane = tid & 63, wr = wid >> 2, wc = wid & 3, fr = lane & 15, fq = lane >> 4;
    const int K = g.K, nt = K / BK;
    unsigned voffA[2], voffB[2];
#pragma unroll
    for (int i = 0; i < 2; ++i) { int R, C; stage_rc(tid * 16 + i * 8192, R, C); const int Rb = Epi::PERM ? ((R & ~31) + perm32(R & 31)) : R;
        voffA[i] = Sched::AFRAG ? (unsigned)((((((R >> 6) * 4 + (C >> 5)) * 16 + ((R >> 4) & 3) * 2) * 64) + ((C & 31) >> 3) * 16 + (R & 15)) * 16) : (unsigned)(R * K + C) * 2u;
        voffB[i] = (unsigned)(Rb * K + C) * 2u; }
#define PG8_AP(base, h, kt) (Sched::AFRAG ? (base) + ((((size_t)((kt) >> 2) * 8 + ((kt) & 1) * 2) * 16 + (h) * 8 + (((kt) >> 1) & 1)) * 64) * 16 : (base) + (size_t)(h) * hstep + (size_t)(kt) * kstep)
    const size_t kstep = (size_t)(BK * 2);
    const size_t hstep = (size_t)HALF * K * 2;
    const size_t tstep = 2 * hstep;
    const unsigned ldsw = (unsigned)wid * 1024u;
    const int aoff = lds_byte(wr * 64 + fr, fq * 8), boff = lds_byte(wc * 32 + fr, fq * 8);
#define PG8_SA(b, h) (((b) * 2 + (h)) * HTB)
#define PG8_SB(b, h) ((4 + (b) * 2 + (h)) * HTB)
#define PG8_STAGE(bufoff, gbase, voff) do { _Pragma("unroll") for (int _i = 0; _i < 2; ++_i) \
        __builtin_amdgcn_global_load_lds((const unsigned*)((const char*)(gbase) + (voff)[_i]), (PG8_LAS unsigned*)(lds + (bufoff) + ldsw + _i * 8192), 16, 0, 0); } while (0)
#define PG8_LDA(dst, b, h) do { _Pragma("unroll") for (int m = 0; m < 4; ++m) _Pragma("unroll") for (int k = 0; k < 2; ++k) dst[m][k] = *(const PG8_LAS bf16x8*)(lds + PG8_SA(b, h) + aoff + m * 2048 + k * 1024); } while (0)
#define PG8_LDB(dst, b, h) do { _Pragma("unroll") for (int n = 0; n < 2; ++n) _Pragma("unroll") for (int k = 0; k < 2; ++k) dst[n][k] = *(const PG8_LAS bf16x8*)(lds + PG8_SB(b, h) + boff + n * 2048 + k * 1024); } while (0)
#define PG8_MMA(ai, bj, At, Bt) do { __builtin_amdgcn_s_setprio(1); _Pragma("unroll") for (int m = 0; m < 4; ++m) _Pragma("unroll") for (int n = 0; n < 2; ++n) _Pragma("unroll") for (int k = 0; k < 2; ++k) \
        acc[ai][bj][m][n] = __builtin_amdgcn_mfma_f32_16x16x32_bf16(Bt[n][k], At[m][k], acc[ai][bj][m][n], 0, 0, 0); __builtin_amdgcn_s_setprio(0); } while (0)
#define PG8_WAIT_V(n) asm volatile("s_waitcnt vmcnt(" #n ")" ::: "memory")
#define PG8_WAIT_L(n) asm volatile("s_waitcnt lgkmcnt(" #n ")" ::: "memory")
#define PG8_BAR __builtin_amdgcn_s_barrier()
#define PG8_SCHED __builtin_amdgcn_sched_barrier(0)
    Unit cur, nxt; int ui = 0;
    if (!S.next(0, cur)) return;
    f32x4 acc[2][2][4][2];
#pragma unroll
    for (int a = 0; a < 2; ++a)
#pragma unroll
        for (int b = 0; b < 2; ++b)
#pragma unroll
            for (int m = 0; m < 4; ++m)
#pragma unroll
                for (int n = 0; n < 2; ++n) acc[a][b][m][n] = (f32x4){0.f, 0.f, 0.f, 0.f};
    if constexpr (Epi::HAS_INIT) E.init(acc, cur, wr, wc, fr, fq);
    bf16x8 At[4][2], B0[2][2], B1[2][2];
    const char* cA = S.a_base(g, cur, tstep); const char* cB = S.b_base(g, cur, tstep);
    S.a_ready(cur);
    if constexpr (SP2) {
        PG8_STAGE(PG8_SB(0, 0), cB, voffB); PG8_STAGE(PG8_SB(0, 1), cB + hstep, voffB); PG8_STAGE(PG8_SA(0, 0), PG8_AP(cA, 0, 0), voffA); PG8_STAGE(PG8_SA(0, 1), PG8_AP(cA, 1, 0), voffA);
        if (wr == 1) PG8_BAR;
        PG8_WAIT_V(2); PG8_BAR;
        PG8_STAGE(PG8_SB(1, 0), cB + kstep, voffB); PG8_STAGE(PG8_SA(1, 0), PG8_AP(cA, 0, 1), voffA); PG8_STAGE(PG8_SB(1, 1), cB + hstep + kstep, voffB);
        PG8_WAIT_V(6); PG8_BAR;
    } else {
        PG8_STAGE(PG8_SB(0, 0), cB, voffB); PG8_STAGE(PG8_SA(0, 0), PG8_AP(cA, 0, 0), voffA); PG8_STAGE(PG8_SB(0, 1), cB + hstep, voffB); PG8_STAGE(PG8_SA(0, 1), PG8_AP(cA, 1, 0), voffA);
        if (wr == 1) PG8_BAR;
        PG8_WAIT_V(4); PG8_BAR;
        PG8_STAGE(PG8_SB(1, 0), cB + kstep, voffB); PG8_STAGE(PG8_SA(1, 0), PG8_AP(cA, 0, 1), voffA); PG8_STAGE(PG8_SB(1, 1), cB + hstep + kstep, voffB);
        PG8_WAIT_V(6); PG8_BAR;
    }
    for (;;) {
        const bool has_next = S.next(ui + 1, nxt);
        const char* nA = has_next ? S.a_base(g, nxt, tstep) : cA; const char* nB = has_next ? S.b_base(g, nxt, tstep) : cB;
        for (int t = 0; t < nt; t += 2) {
            const bool last = (t == nt - 2);
            const char* a2b = last ? nA : cA; const int a2k = last ? 0 : t + 2; const char* b2 = last ? nB : cB + (size_t)(t + 2) * kstep;
            const char* b3 = b2 + kstep;
            const char* a1h = PG8_AP(cA, 1, t + 1); const char* a2 = PG8_AP(a2b, 0, a2k); const char* a2h = PG8_AP(a2b, 1, a2k); const char* a3 = PG8_AP(a2b, 0, a2k + 1);
            if (last && has_next) S.a_ready(nxt);
            if constexpr (SP2) {
            PG8_LDB(B0, 0, 0); PG8_LDB(B1, 0, 1); PG8_SCHED; PG8_LDA(At, 0, 0); PG8_STAGE(PG8_SA(1, 1), a1h, voffA);
            PG8_WAIT_V(8); PG8_WAIT_L(0); PG8_BAR; PG8_MMA(0, 0, At, B0); PG8_MMA(0, 1, At, B1); PG8_BAR; PG8_SCHED;
            PG8_LDA(At, 0, 1); PG8_STAGE(PG8_SB(0, 0), b2, voffB); PG8_STAGE(PG8_SB(0, 1), b2 + hstep, voffB); PG8_STAGE(PG8_SA(0, 0), a2, voffA);
            PG8_WAIT_V(8); PG8_WAIT_L(0); PG8_BAR; PG8_MMA(1, 0, At, B0); PG8_MMA(1, 1, At, B1); PG8_BAR; PG8_SCHED;
            PG8_LDB(B0, 1, 0); PG8_LDB(B1, 1, 1); PG8_SCHED; PG8_LDA(At, 1, 0); PG8_STAGE(PG8_SA(0, 1), a2h, voffA);
            PG8_WAIT_V(8); PG8_WAIT_L(0); PG8_BAR; PG8_MMA(0, 0, At, B0); PG8_MMA(0, 1, At, B1); PG8_BAR; PG8_SCHED;
            PG8_LDA(At, 1, 1); PG8_STAGE(PG8_SB(1, 0), b3, voffB); PG8_STAGE(PG8_SB(1, 1), b3 + hstep, voffB); PG8_STAGE(PG8_SA(1, 0), a3, voffA);
            PG8_WAIT_V(8); PG8_WAIT_L(0); PG8_BAR; PG8_MMA(1, 0, At, B0); PG8_MMA(1, 1, At, B1); PG8_BAR; PG8_SCHED;
            } else {
            PG8_LDB(B0, 0, 0); PG8_SCHED; PG8_LDA(At, 0, 0); PG8_STAGE(PG8_SA(1, 1), a1h, voffA);
            PG8_WAIT_L(8); PG8_BAR; PG8_WAIT_L(0); PG8_MMA(0, 0, At, B0); PG8_BAR; PG8_SCHED;
            PG8_LDB(B1, 0, 1); PG8_STAGE(PG8_SB(0, 0), b2, voffB);
            PG8_BAR; PG8_WAIT_L(0); PG8_MMA(0, 1, At, B1); PG8_BAR;
            PG8_LDA(At, 0, 1); PG8_STAGE(PG8_SA(0, 0), a2, voffA);
            PG8_BAR; PG8_WAIT_L(0); PG8_MMA(1, 0, At, B0); PG8_BAR; PG8_SCHED;
            PG8_STAGE(PG8_SB(0, 1), b2 + hstep, voffB);
            PG8_WAIT_V(6); PG8_BAR; PG8_MMA(1, 1, At, B1); PG8_BAR;
            PG8_LDB(B0, 1, 0); PG8_SCHED; PG8_LDA(At, 1, 0); PG8_STAGE(PG8_SA(0, 1), a2h, voffA);
            PG8_WAIT_L(8); PG8_BAR; PG8_WAIT_L(0); PG8_MMA(0, 0, At, B0); PG8_BAR; PG8_SCHED;
            PG8_LDB(B1, 1, 1); PG8_STAGE(PG8_SB(1, 0), b3, voffB);
            PG8_BAR; PG8_WAIT_L(0); PG8_MMA(0, 1, At, B1); PG8_BAR;
            PG8_LDA(At, 1, 1); PG8_STAGE(PG8_SA(1, 0), a3, voffA);
            PG8_BAR; PG8_WAIT_L(0); PG8_MMA(1, 0, At, B0); PG8_BAR; PG8_SCHED;
            PG8_STAGE(PG8_SB(1, 1), b3 + hstep, voffB);
            PG8_WAIT_V(6); PG8_BAR; PG8_MMA(1, 1, At, B1); PG8_BAR;
            }
        }
        if constexpr (ALIGN_EPI) { if (wr == 0) PG8_BAR; }
        if constexpr (!Epi::AFTER_DRAIN) { E(acc, cur, wr, wc, fr, fq); S.done(cur); }
        if (!has_next) break;
#pragma unroll
        for (int a = 0; a < 2; ++a)
#pragma unroll
            for (int b = 0; b < 2; ++b)
#pragma unroll
                for (int m = 0; m < 4; ++m)
#pragma unroll
                    for (int n = 0; n < 2; ++n) acc[a][b][m][n] = (f32x4){0.f, 0.f, 0.f, 0.f};
        if constexpr (Epi::HAS_INIT) E.init(acc, nxt, wr, wc, fr, fq);
        cur = nxt; cA = nA; cB = nB; ++ui;
        if constexpr (ALIGN_EPI) { if (wr == 1) PG8_BAR; }
    }
    PG8_WAIT_V(0);
    if constexpr (!ALIGN_EPI) { if (wr == 0) PG8_BAR; }
    PG8_BAR;
    if constexpr (Epi::AFTER_DRAIN) { E.fused(acc, cur, wr, wc, fr, fq, lds, wid, lane); S.done(cur); }
#undef PG8_AP
#undef PG8_SA
#undef PG8_SB
#undef PG8_STAGE
#undef PG8_LDA
#undef PG8_LDB
#undef PG8_MMA
#undef PG8_WAIT_V
#undef PG8_WAIT_L
#undef PG8_BAR
#undef PG8_SCHED
}
}

#ifndef PG8_SP2
#define PG8_SP2 true
#endif
#ifndef PG8_ALIGN
#define PG8_ALIGN true
#endif
#ifndef MK_ONE_LAUNCH
#define MK_ONE_LAUNCH 1
#endif

constexpr int NWAVES = 8;
constexpr int T = 32768, D = 1024, SEQ = 4096;
constexpr int IN_DIM = 4352, PA_W = 2304, G_W = 2048;
constexpr int C_U = 0, C_B = 512, C_C = 1024, C_Q = 1536, C_K = 2048, C_V = 2176;
constexpr int CONV = 512, HD = 64, NH = 8, NKV = 2;
constexpr int PH = 8, NKEYS = 128, PQ = 2048, TOPK = 16, NEXP = 16384, NSEL = 128;
constexpr float EPS = 1e-6f;
constexpr int N_PHASES = 10;

constexpr size_t MiB = 1u << 20;
constexpr size_t WS_CTL = 0, CTL_ZERO_BYTES = 1 * MiB;
constexpr size_t WS_WIN = 2 * MiB;
constexpr size_t WS_WC = 11 * MiB;
constexpr size_t WS_WA = 12 * MiB;
constexpr size_t WS_WO = 13 * MiB;
constexpr size_t WS_WQ = 15 * MiB;
constexpr size_t WS_SK = 19 * MiB;
constexpr size_t WS_RSTD1 = 20 * MiB;
constexpr size_t WS_SSQ = 21 * MiB;
constexpr size_t WS_UB = 24 * MiB;
constexpr size_t WS_SU = 32 * MiB;
constexpr size_t WS_VB = 40 * MiB;
constexpr size_t WS_SV = 48 * MiB;
constexpr size_t WS_XB8 = 56 * MiB;
constexpr size_t WS_XB = 88 * MiB;
constexpr size_t WS_PA = 152 * MiB;
constexpr size_t WS_MIX = WS_PA;
constexpr size_t WS_G = 296 * MiB;
constexpr size_t WS_QP = WS_G;
constexpr size_t WS_Z = 424 * MiB;
constexpr size_t WS_ATT = 456 * MiB;
constexpr size_t WS_IDX = WS_Z, WS_GATE = WS_ATT;
constexpr size_t WS_PART = WS_PA;
constexpr size_t WS_ACT = WS_G;
constexpr size_t WS_END = 488 * MiB;
constexpr int CW_BAR = 4096;

constexpr int RING_OFF = 0, RING_BYTES = 131072;
constexpr int LDSCTL_OFF = 147456, MISC_OFF = LDSCTL_OFF + 320;
constexpr int LDS_BYTES = 148480;
#define GAS __attribute__((address_space(1)))
#define LAS __attribute__((address_space(3)))
typedef unsigned short bf16;
typedef unsigned v4u __attribute__((ext_vector_type(4)));
typedef float f32x4 __attribute__((ext_vector_type(4)));
typedef short bf16x8 __attribute__((ext_vector_type(8)));
typedef GAS unsigned gu32;
typedef GAS unsigned long long gu64;
#define RLX_AGENT __ATOMIC_RELAXED, __HIP_MEMORY_SCOPE_AGENT
#define LDS_WAIT() asm volatile("s_waitcnt lgkmcnt(0)" ::: "memory")
#define VM_WAIT() asm volatile("s_waitcnt vmcnt(0)" ::: "memory")
__device__ __forceinline__ unsigned long long rt() { return __builtin_amdgcn_s_memrealtime(); }
__device__ __forceinline__ unsigned f2bf(float f) { unsigned u = __builtin_bit_cast(unsigned, f); return (u + 0x7fffu + ((u >> 16) & 1u)) >> 16; }
__device__ __forceinline__ unsigned pk2(float lo, float hi) { return f2bf(lo) | (f2bf(hi) << 16); }

#define XB_TMO      128
#define XB_XCNT(j)  (256  + 64 * (j))
#define XB_XSUB(j)  (1280 + 64 * (j))
#define XB_XGEN(j)  (2304 + 64 * (j))
#define XB_TOP      3328
#define XB_TOPGEN   3392
#define XCD_BAR_WORDS 3456
#define XB_SPIN_CAP (1u << 18)

__device__ __forceinline__ unsigned xb_ld(unsigned* p)              { return __hip_atomic_load(p, __ATOMIC_RELAXED, __HIP_MEMORY_SCOPE_AGENT); }
__device__ __forceinline__ unsigned xb_add(unsigned* p, unsigned v) { return __hip_atomic_fetch_add(p, v, __ATOMIC_RELAXED, __HIP_MEMORY_SCOPE_AGENT); }
__device__ __forceinline__ unsigned xb_xcc_id() { return (unsigned)__builtin_amdgcn_s_getreg((3 << 11) | 20) & 0xFu; }
#define XB_SPIN(cond, bar) do { unsigned _sp = 0; while (cond) { __builtin_amdgcn_s_sleep(1); \
    if ((++_sp & 255u) == 0u) { if (xb_ld(&(bar)[XB_TMO])) break; if (_sp > XB_SPIN_CAP) { atomicAdd(&(bar)[XB_TMO], 1u); break; } } } } while (0)

struct XcdBarrier {
    unsigned* bar; unsigned x;
    volatile LAS unsigned* st;
};

__device__ __forceinline__ XcdBarrier xcd_barrier_post(unsigned* bar, volatile LAS unsigned* st) {
    XcdBarrier b; b.bar = bar; b.x = xb_xcc_id(); b.st = st;
    if (threadIdx.x == 0) st[2] = xb_add(&bar[XB_XCNT(b.x)], 1u);
    return b;
}
__device__ __forceinline__ void xcd_barrier_complete(unsigned* bar, unsigned x, unsigned& nloc, unsigned& nx) {
    const unsigned G = gridDim.x * gridDim.y * gridDim.z;
    unsigned sum, cnt, mine, sp = 0u;
    for (;;) {
        sum = 0u; cnt = 0u; mine = 0u;
#pragma unroll
        for (unsigned j = 0; j < 16; ++j) { const unsigned c = xb_ld(&bar[XB_XCNT(j)]); sum += c; cnt += (c > 0u) ? 1u : 0u; mine = (j == x) ? c : mine; }
        if (sum == G) break;
        __builtin_amdgcn_s_sleep(1);
        if ((++sp & 255u) == 0u) { if (xb_ld(&bar[XB_TMO])) break; if (sp > XB_SPIN_CAP) { atomicAdd(&bar[XB_TMO], 1u); break; } }
    }
    nloc = mine > 0u ? mine : 1u; nx = cnt > 0u ? cnt : 1u;
}

__device__ __forceinline__ void xcd_barrier(const XcdBarrier& b) {
    asm volatile("s_waitcnt vmcnt(0)" ::: "memory");
    __syncthreads();
    if (threadIdx.x == 0) {
        unsigned* bar = b.bar;
        __builtin_amdgcn_s_waitcnt(0);
        unsigned nloc = b.st[0], nx = b.st[1];
        if (nloc == 0u) { xcd_barrier_complete(bar, b.x, nloc, nx); b.st[0] = nloc; b.st[1] = nx; }
        const unsigned old = xb_add(&bar[XB_XSUB(b.x)], 1u);
        const unsigned gen = old / nloc;
        if (old + 1u == (gen + 1u) * nloc) {
            __builtin_amdgcn_fence(__ATOMIC_RELEASE, "agent");
            asm volatile("s_waitcnt vmcnt(0)" ::: "memory");
            const unsigned og = xb_add(&bar[XB_TOP], 1u);
            const unsigned tg = og / nx;
            if (og + 1u == (tg + 1u) * nx) xb_add(&bar[XB_TOPGEN], 1u);
            else XB_SPIN(xb_ld(&bar[XB_TOPGEN]) == tg, bar);
            __builtin_amdgcn_fence(__ATOMIC_ACQUIRE, "agent");
            xb_add(&bar[XB_XGEN(b.x)], 1u);
            asm volatile("s_waitcnt vmcnt(0)" ::: "memory");
        } else {
            XB_SPIN(xb_ld(&bar[XB_XGEN(b.x)]) == gen, bar);
            __builtin_amdgcn_fence(__ATOMIC_ACQUIRE, "agent");
            asm volatile("s_waitcnt vmcnt(0)" ::: "memory");
        }
    }
    __syncthreads();
}

typedef float f32x16 __attribute__((ext_vector_type(16)));
typedef unsigned v2u __attribute__((ext_vector_type(2)));
typedef int v4i __attribute__((ext_vector_type(4)));
typedef __bf16 bf2_t __attribute__((ext_vector_type(2)));
#define DI __device__ __forceinline__
struct Frame {
    LAS unsigned char* lds;
    volatile LAS unsigned* MISC;
    gu32* ctl;
    int tid, lane, wave, vcu, G;
    const float *x, *norm_mix, *norm_ffn, *w_in, *b_gate, *w_conv, *q_norm, *k_norm, *sinks, *rel_bias, *w_conv_out, *w_attn_out, *w_out, *w_query, *sub_keys, *expert_u, *expert_v;
    float* out;
    bf16 *WIN, *WC, *WA, *WO, *WQ, *SK, *UB, *VB, *XB, *PA, *MIX, *G_, *QP, *Z, *ATT;
    float *RSTD1, *SSQ, *GATE, *ACT, *SU, *SV; bf16* PARTB; unsigned char* XB8; unsigned short* IDX;
};
DI float wave_sum(float v) {
#pragma unroll
    for (int o = 1; o < 64; o <<= 1) v += __shfl_xor(v, o);
    return v;
}
DI float bf_lo(unsigned u) { return __builtin_bit_cast(float, u << 16); }
DI float bf_hi(unsigned u) { return __builtin_bit_cast(float, u & 0xffff0000u); }

DI void p0_transpose_item(const float* W, int K, int N, bf16* WT, const float* gsc, LAS float* scr, int item, int lane) {
    const int nblk = N / 32, kb = item / nblk, nb = item % nblk, k0 = 64 * kb, n0 = 32 * nb;
#pragma unroll 8
    for (int i = 0; i < 32; ++i) { const int kk = 2 * i + (lane >> 5); float v = W[(size_t)(k0 + kk) * N + n0 + (lane & 31)]; if (gsc) v *= gsc[k0 + kk]; scr[kk * 33 + (lane & 31)] = v; }
    LDS_WAIT(); asm volatile("" ::: "memory");
    const int c = lane & 7;
#pragma unroll
    for (int j = 0; j < 4; ++j) { const int n = (lane >> 3) + 8 * j; const LAS float* s = scr + (8 * c) * 33 + n;
        v4u o; o.x = pk2(s[0 * 33], s[1 * 33]); o.y = pk2(s[2 * 33], s[3 * 33]); o.z = pk2(s[4 * 33], s[5 * 33]); o.w = pk2(s[6 * 33], s[7 * 33]);
        *(GAS v4u*)(WT + (size_t)(n0 + n) * K + k0 + 8 * c) = o; }
    LDS_WAIT(); asm volatile("" ::: "memory");
}
DI void p0_convert(Frame& F, const float* src, bf16* dst, size_t n, const float* colscale) {
    const size_t n8 = n / 8, stride = (size_t)F.G * NWAVES * 64;
    for (size_t i = (size_t)F.vcu * NWAVES * 64 + F.tid; i < n8; i += stride) {
        f32x4 a = *(const GAS f32x4*)(src + i * 8), b = *(const GAS f32x4*)(src + i * 8 + 4);
        if (colscale) { const int c = (int)((i * 8) & 1023); const f32x4 s0 = *(const GAS f32x4*)(colscale + c), s1 = *(const GAS f32x4*)(colscale + c + 4); a = a * s0; b = b * s1; }
        v4u o; o.x = pk2(a.x, a.y); o.y = pk2(a.z, a.w); o.z = pk2(b.x, b.y); o.w = pk2(b.z, b.w);
        *(GAS v4u*)(dst + i * 8) = o;
    }
}
constexpr float A_SCALE = 128.f;
DI unsigned pk4_fp8(f32x4 v) { int r = 0; r = __builtin_amdgcn_cvt_pk_fp8_f32(v[0], v[1], r, false); r = __builtin_amdgcn_cvt_pk_fp8_f32(v[2], v[3], r, true); return (unsigned)r; }
DI void p0_convert_fp8(Frame& F, const float* src, unsigned char* dst, size_t n, const float* colscale, float scale, int bidx, int nblk) {
    const int gw = bidx * NWAVES + F.wave, NGW = nblk * NWAVES, lane = F.lane;
    f32x4 cs[4];
#pragma unroll
    for (int q = 0; q < 4; ++q) cs[q] = colscale ? *(const GAS f32x4*)(colscale + 4 * lane + 256 * q) * scale : (f32x4){scale, scale, scale, scale};
    const int nrows = (int)(n / D);
    for (int e = gw; e < nrows; e += NGW) {
        const GAS f32x4* rp = (const GAS f32x4*)(src + (size_t)e * D) + lane;
        f32x4 v[4];
#pragma unroll
        for (int q = 0; q < 4; ++q) v[q] = rp[64 * q];
#pragma unroll
        for (int q = 0; q < 4; ++q) *(GAS unsigned*)(dst + ((size_t)(2 * q + (lane >> 5)) * NEXP + e) * 128 + ((4 * lane) & 127)) = pk4_fp8(v[q] * cs[q]);
    }
}
DI void p0_convert_fp4(Frame& F, const float* src, const float* gain, unsigned char* dst, float* scl, int bidx, int nblk) {
    const int gw = bidx * NWAVES + F.wave, NGW = nblk * NWAVES, lane = F.lane;
    f32x4 cs[4];
#pragma unroll
    for (int q = 0; q < 4; ++q) cs[q] = gain ? *(const GAS f32x4*)(gain + 4 * lane + 256 * q) : (f32x4){1.f, 1.f, 1.f, 1.f};
    for (int e = gw; e < NEXP; e += NGW) {
        const GAS f32x4* rp = (const GAS f32x4*)(src + (size_t)e * D) + lane;
        f32x4 v[4]; float mx = 0.f;
#pragma unroll
        for (int q = 0; q < 4; ++q) { v[q] = rp[64 * q] * cs[q]; mx = fmaxf(mx, fmaxf(fmaxf(fabsf(v[q][0]), fabsf(v[q][1])), fmaxf(fabsf(v[q][2]), fabsf(v[q][3])))); }
#pragma unroll
        for (int o = 1; o < 64; o <<= 1) mx = fmaxf(mx, __shfl_xor(mx, o));
        const float inv = mx > 0.f ? 6.f / mx : 0.f;
        if (lane == 0) scl[e] = mx * (1.f / 6.f);
#pragma unroll
        for (int q = 0; q < 4; ++q) { unsigned r = 0u;
            r = __builtin_amdgcn_cvt_scalef32_pk_fp4_f32(r, v[q][0] * inv, v[q][1] * inv, 1.0f, 0);
            r = __builtin_amdgcn_cvt_scalef32_pk_fp4_f32(r, v[q][2] * inv, v[q][3] * inv, 1.0f, 1);
            *(GAS unsigned short*)(dst + ((size_t)q * NEXP + e) * 128 + 2 * lane) = (unsigned short)r; }
    }
}
template <int RB> DI void p0_rows(Frame& F, const float* xrow, bf16* orow) {
    f32x4 v[RB][4]; float s[RB];
#pragma unroll
    for (int r = 0; r < RB; ++r) { const GAS f32x4* xr = (const GAS f32x4*)(xrow + (size_t)r * D) + F.lane;
#pragma unroll
        for (int j = 0; j < 4; ++j) v[r][j] = xr[64 * j]; }
#pragma unroll
    for (int r = 0; r < RB; ++r) { s[r] = 0.f;
#pragma unroll
        for (int j = 0; j < 4; ++j) s[r] += (v[r][j].x * v[r][j].x + v[r][j].y * v[r][j].y) + (v[r][j].z * v[r][j].z + v[r][j].w * v[r][j].w); }
#pragma unroll
    for (int o = 1; o < 64; o <<= 1)
#pragma unroll
        for (int r = 0; r < RB; ++r) s[r] += __shfl_xor(s[r], o);
#pragma unroll
    for (int r = 0; r < RB; ++r) { const float rs = 1.f / sqrtf(s[r] * (1.f / D) + EPS);
        GAS unsigned long long* o8 = (GAS unsigned long long*)(orow + (size_t)r * D) + F.lane;
#pragma unroll
        for (int j = 0; j < 4; ++j) o8[64 * j] = (unsigned long long)pk2(v[r][j].x * rs, v[r][j].y * rs) | ((unsigned long long)pk2(v[r][j].z * rs, v[r][j].w * rs) << 32); }
}
DI void p0_prologue(Frame& F) {
    LAS float* scr = (LAS float*)(F.lds + RING_OFF + F.wave * 16384);
    const int gw = F.vcu * NWAVES + F.wave, NGW = F.G * NWAVES;
    constexpr int I_IN = (D / 64) * (IN_DIM / 32), I_C = (CONV / 64) * (D / 32), I_O = (D / 64) * (D / 32), I_Q = (D / 64) * (PQ / 32);
    constexpr int NITEMS = I_IN + 2 * I_C + I_O + I_Q;
    for (int it = gw; it < NITEMS; it += NGW) {
        int r = it;
        if (r < I_IN) { p0_transpose_item(F.w_in, D, IN_DIM, F.WIN, F.norm_mix, scr, r, F.lane); continue; } r -= I_IN;
        if (r < I_C) { p0_transpose_item(F.w_conv_out, CONV, D, F.WC, nullptr, scr, r, F.lane); continue; } r -= I_C;
        if (r < I_C) { p0_transpose_item(F.w_attn_out, CONV, D, F.WA, nullptr, scr, r, F.lane); continue; } r -= I_C;
        if (r < I_O) { p0_transpose_item(F.w_out, D, D, F.WO, nullptr, scr, r, F.lane); continue; } r -= I_O;
        p0_transpose_item(F.w_query, D, PQ, F.WQ, F.norm_ffn, scr, r, F.lane);
    }
    p0_convert(F, F.sub_keys, F.SK, (size_t)PH * 2 * NKEYS * 128, nullptr);
    for (int m = 4 * gw; m < T; m += 4 * NGW) p0_rows<4>(F, F.x + (size_t)m * D, F.XB + (size_t)m * D);
}

namespace pg8 {
DI float sigmoidf_(float v) { return __builtin_amdgcn_rcpf(1.f + __expf(-v)); }
DI size_t frag_off(int pm, int pn, int NT, int wave, int q, int lane) { return (((((size_t)pm * NT + pn) * 8 + wave) * 16 + q) * 64 + lane) * 8; }
struct EpiProj {
    static constexpr bool PERM = true, AFTER_DRAIN = false, HAS_INIT = false;
    bf16_t* PA; bf16_t* G; const PG8_LAS float* bgl;
    DI void operator()(const f32x4 (&acc)[2][2][4][2], const Unit& u, int wr, int wc, int fr, int fq) const {
        const int row0 = u.pm * BM + wr * 64 + fr; const bool gate = u.pn >= 9;
        const int col0 = (gate ? (u.pn - 9) : u.pn) * BM + wc * 32 + 8 * fq;
        if (!gate) {
#pragma unroll
            for (int ai = 0; ai < 2; ++ai)
#pragma unroll
                for (int m = 0; m < 4; ++m) { bf16_t* rowp = PA + (size_t)(row0 + ai * HALF + m * 16) * PA_W + col0;
#pragma unroll
                    for (int bj = 0; bj < 2; ++bj) { const f32x4 v0 = acc[ai][bj][m][0], v1 = acc[ai][bj][m][1];
                        u32x4 w; w.x = cvt_pk_bf16(v0[0], v0[1]); w.y = cvt_pk_bf16(v0[2], v0[3]); w.z = cvt_pk_bf16(v1[0], v1[1]); w.w = cvt_pk_bf16(v1[2], v1[3]);
                        store16_wt(rowp + bj * HALF, w); } }
        } else {
            f32x4 bv[2][2];
#pragma unroll
            for (int bj = 0; bj < 2; ++bj)
#pragma unroll
                for (int n = 0; n < 2; ++n) bv[bj][n] = *(const PG8_LAS f32x4*)(bgl + col0 + bj * HALF + 4 * n);
#pragma unroll
            for (int ai = 0; ai < 2; ++ai)
#pragma unroll
                for (int m = 0; m < 4; ++m)
#pragma unroll
                    for (int bj = 0; bj < 2; ++bj) { f32x4 v0 = acc[ai][bj][m][0] + bv[bj][0], v1 = acc[ai][bj][m][1] + bv[bj][1];
#pragma unroll
                        for (int j = 0; j < 4; ++j) { v0[j] = sigmoidf_(v0[j]) * 255.f; v1[j] = sigmoidf_(v1[j]) * 255.f; }
                        unsigned g0 = 0u, g1 = 0u;
                        g0 = __builtin_amdgcn_cvt_pk_u8_f32(v0[0], 0, g0); g0 = __builtin_amdgcn_cvt_pk_u8_f32(v0[1], 1, g0); g0 = __builtin_amdgcn_cvt_pk_u8_f32(v0[2], 2, g0); g0 = __builtin_amdgcn_cvt_pk_u8_f32(v0[3], 3, g0);
                        g1 = __builtin_amdgcn_cvt_pk_u8_f32(v1[0], 0, g1); g1 = __builtin_amdgcn_cvt_pk_u8_f32(v1[1], 1, g1); g1 = __builtin_amdgcn_cvt_pk_u8_f32(v1[2], 2, g1); g1 = __builtin_amdgcn_cvt_pk_u8_f32(v1[3], 3, g1);
                        u32x2 gw; gw.x = g0; gw.y = g1;
                        *(u32x2*)((unsigned char*)G + frag_off(u.pm, u.pn - 9, 8, wr * 4 + wc, ai * 8 + m * 2 + bj, fq * 16 + fr)) = gw; }
        }
    }
};
struct EpiMix {
    static constexpr bool PERM = true, AFTER_DRAIN = false, HAS_INIT = false;
    bf16_t* MIX; const bf16_t* G;
    DI void operator()(const f32x4 (&acc)[2][2][4][2], const Unit& u, int wr, int wc, int fr, int fq) const {
        const int wave = wr * 4 + wc, lane = fq * 16 + fr;
        const unsigned char* gp = (const unsigned char*)G + frag_off(u.pm, u.pn + (u.which ? 4 : 0), 8, wave, 0, lane); bf16_t* mp = MIX + frag_off(u.pm, u.pn, 4, wave, 0, lane);
#pragma unroll
        for (int ai = 0; ai < 2; ++ai) {
            u32x2 gv[8]; u32x4 ov[8];
#pragma unroll
            for (int q = 0; q < 8; ++q) gv[q] = *(const u32x2*)(gp + (ai * 8 + q) * 512);
            if (u.which) {
#pragma unroll
                for (int q = 0; q < 8; ++q) ov[q] = *(const u32x4*)(mp + (ai * 8 + q) * 512); }
#pragma unroll
            for (int m = 0; m < 4; ++m)
#pragma unroll
                for (int bj = 0; bj < 2; ++bj) { const int q = m * 2 + bj; const u32x2 g2 = gv[q]; constexpr float GI = 1.f / 255.f;
                    f32x4 v0 = acc[ai][bj][m][0], v1 = acc[ai][bj][m][1];
                    v0[0] *= (float)(g2.x & 0xffu) * GI; v0[1] *= (float)((g2.x >> 8) & 0xffu) * GI; v0[2] *= (float)((g2.x >> 16) & 0xffu) * GI; v0[3] *= (float)(g2.x >> 24) * GI;
                    v1[0] *= (float)(g2.y & 0xffu) * GI; v1[1] *= (float)((g2.y >> 8) & 0xffu) * GI; v1[2] *= (float)((g2.y >> 16) & 0xffu) * GI; v1[3] *= (float)(g2.y >> 24) * GI;
                    if (u.which) { const u32x4 o = ov[q];
                        v0[0] += __builtin_bit_cast(float, o.x << 16); v0[1] += __builtin_bit_cast(float, o.x & 0xffff0000u); v0[2] += __builtin_bit_cast(float, o.y << 16); v0[3] += __builtin_bit_cast(float, o.y & 0xffff0000u);
                        v1[0] += __builtin_bit_cast(float, o.z << 16); v1[1] += __builtin_bit_cast(float, o.z & 0xffff0000u); v1[2] += __builtin_bit_cast(float, o.w << 16); v1[3] += __builtin_bit_cast(float, o.w & 0xffff0000u); }
                    u32x4 w; w.x = cvt_pk_bf16(v0[0], v0[1]); w.y = cvt_pk_bf16(v0[2], v0[3]); w.z = cvt_pk_bf16(v1[0], v1[1]); w.w = cvt_pk_bf16(v1[2], v1[3]);
                    if (u.which) store16_wt(mp + (ai * 8 + q) * 512, w); else *(u32x4*)(mp + (ai * 8 + q) * 512) = w; }
        }
    }
};
struct FragOrder : StaticOrder { static constexpr bool AFRAG = true; };
struct PairOrder : StaticOrder {
    __device__ bool next(int i, Unit& u) const { const bool ok = StaticOrder::next(i >> 1, u); u.which = i & 1; return ok; }
    DI const char* a_base(const Gemm& g, const Unit& u, size_t tstep) const { return (const char*)(u.which ? g.A2 : g.A) + (size_t)u.pm * tstep; }
    DI const char* b_base(const Gemm& g, const Unit& u, size_t tstep) const { return (const char*)(u.which ? g.Bt2 : g.Bt) + (size_t)u.pn * tstep; }
};
struct EpiX1 {
    static constexpr bool PERM = true, AFTER_DRAIN = false, HAS_INIT = true;
    const float* x; bf16_t* XB; float* SSQ; unsigned char* XB8;
    DI void init(f32x4 (&acc)[2][2][4][2], const Unit& u, int wr, int wc, int fr, int fq) const {
        const int row0 = u.pm * BM + wr * 64 + fr, col0 = u.pn * BM + wc * 32 + 8 * fq;
#pragma unroll
        for (int ai = 0; ai < 2; ++ai)
#pragma unroll
            for (int m = 0; m < 4; ++m)
#pragma unroll
                for (int bj = 0; bj < 2; ++bj)
#pragma unroll
                    for (int n = 0; n < 2; ++n) acc[ai][bj][m][n] = *(const f32x4*)(x + (size_t)(row0 + ai * HALF + m * 16) * D + col0 + bj * HALF + 4 * n);
    }
    DI void operator()(const f32x4 (&acc)[2][2][4][2], const Unit& u, int wr, int wc, int fr, int fq) const {
        const int row0 = u.pm * BM + wr * 64 + fr, col0 = u.pn * BM + wc * 32 + 8 * fq;
#pragma unroll
        for (int ai = 0; ai < 2; ++ai)
#pragma unroll
            for (int m = 0; m < 4; ++m) { const int row = row0 + ai * HALF + m * 16; float ss = 0.f;
#pragma unroll
                for (int bj = 0; bj < 2; ++bj) { const f32x4 v0 = acc[ai][bj][m][0], v1 = acc[ai][bj][m][1];
                    ss += ((v0[0] * v0[0] + v0[1] * v0[1]) + (v0[2] * v0[2] + v0[3] * v0[3])) + ((v1[0] * v1[0] + v1[1] * v1[1]) + (v1[2] * v1[2] + v1[3] * v1[3]));
                    u32x4 w; w.x = cvt_pk_bf16(v0[0], v0[1]); w.y = cvt_pk_bf16(v0[2], v0[3]); w.z = cvt_pk_bf16(v1[0], v1[1]); w.w = cvt_pk_bf16(v1[2], v1[3]);
                    store16_wt(XB + (size_t)row * D + col0 + bj * HALF, w);
                    { int p0_ = 0, p1_ = 0;
                      p0_ = __builtin_amdgcn_cvt_pk_fp8_f32(v0[0], v0[1], p0_, false); p0_ = __builtin_amdgcn_cvt_pk_fp8_f32(v0[2], v0[3], p0_, true);
                      p1_ = __builtin_amdgcn_cvt_pk_fp8_f32(v1[0], v1[1], p1_, false); p1_ = __builtin_amdgcn_cvt_pk_fp8_f32(v1[2], v1[3], p1_, true);
                      u32x2 w8; w8.x = (unsigned)p0_; w8.y = (unsigned)p1_; *(u32x2*)(XB8 + (size_t)row * D + col0 + bj * HALF) = w8; } }
                ss += __shfl_xor(ss, 16); ss += __shfl_xor(ss, 32);
                if (fq == 0) SSQ[(size_t)row * 16 + u.pn * 4 + wc] = ss; }
    }
};
DI float rstd2_of(const float* SSQ, int row) {
    const f32x4 a = *(const f32x4*)(SSQ + (size_t)row * 16), b = *(const f32x4*)(SSQ + (size_t)row * 16 + 4), c = *(const f32x4*)(SSQ + (size_t)row * 16 + 8), d = *(const f32x4*)(SSQ + (size_t)row * 16 + 12);
    const float s = ((a[0] + a[1]) + (a[2] + a[3])) + ((b[0] + b[1]) + (b[2] + b[3])) + ((c[0] + c[1]) + (c[2] + c[3])) + ((d[0] + d[1]) + (d[2] + d[3]));
    return 1.f / sqrtf(s * (1.f / D) + EPS);
}
struct EpiQP {
    static constexpr bool PERM = true, AFTER_DRAIN = false, HAS_INIT = false;
    bf16_t* QP;
    DI void operator()(const f32x4 (&acc)[2][2][4][2], const Unit& u, int wr, int wc, int fr, int fq) const {
        const int row0 = u.pm * BM + wr * 64 + fr, col0 = u.pn * BM + wc * 32 + 8 * fq;
#pragma unroll
        for (int ai = 0; ai < 2; ++ai)
#pragma unroll
            for (int m = 0; m < 4; ++m) {
#pragma unroll
                for (int bj = 0; bj < 2; ++bj) { const f32x4 v0 = acc[ai][bj][m][0], v1 = acc[ai][bj][m][1];
                    u32x4 w; w.x = cvt_pk_bf16(v0[0], v0[1]); w.y = cvt_pk_bf16(v0[2], v0[3]); w.z = cvt_pk_bf16(v1[0], v1[1]); w.w = cvt_pk_bf16(v1[2], v1[3]);
                    *(u32x4*)(QP + frag_off(u.pm, u.pn, 8, wr * 4 + wc, ai * 8 + m * 2 + bj, fq * 16 + fr)) = w; } }
    }
};
}

#define MFMA32(a, b, c) __builtin_amdgcn_mfma_f32_32x32x16_bf16((a), (b), (c), 0, 0, 0)
DI void p2_conv(Frame& F) {
    constexpr int CT = 4;
    const size_t NT_ = (size_t)F.G * NWAVES * 64;
    for (size_t item = (size_t)F.vcu * NWAVES * 64 + F.tid; item < (size_t)(T / CT) * 64; item += NT_) {
        const int tb = (int)(item >> 6) * CT, c0 = (int)(item & 63) * 8, tl = tb & (SEQ - 1);
        v4u cg[CT + 2], uu[CT + 2], bg[CT];
#pragma unroll
        for (int r = 0; r < CT + 2; ++r) { const bool ok = (tl + r - 2) >= 0; const bf16* rowp = F.PA + (size_t)(tb + (ok ? r - 2 : 0)) * PA_W;
            cg[r] = *(const GAS v4u*)(rowp + C_C + c0); uu[r] = *(const GAS v4u*)(rowp + C_U + c0);
            if (!ok) { cg[r] = (v4u){0u, 0u, 0u, 0u}; } }
#pragma unroll
        for (int r = 0; r < CT; ++r) bg[r] = *(const GAS v4u*)(F.PA + (size_t)(tb + r) * PA_W + C_B + c0);
        f32x4 w[3][2];
#pragma unroll
        for (int j = 0; j < 3; ++j) { w[j][0] = *(const GAS f32x4*)(F.w_conv + j * CONV + c0); w[j][1] = *(const GAS f32x4*)(F.w_conv + j * CONV + c0 + 4); }
        float h[CT + 2][8];
#pragma unroll
        for (int r = 0; r < CT + 2; ++r) { h[r][0] = bf_lo(cg[r].x) * bf_lo(uu[r].x); h[r][1] = bf_hi(cg[r].x) * bf_hi(uu[r].x); h[r][2] = bf_lo(cg[r].y) * bf_lo(uu[r].y); h[r][3] = bf_hi(cg[r].y) * bf_hi(uu[r].y);
            h[r][4] = bf_lo(cg[r].z) * bf_lo(uu[r].z); h[r][5] = bf_hi(cg[r].z) * bf_hi(uu[r].z); h[r][6] = bf_lo(cg[r].w) * bf_lo(uu[r].w); h[r][7] = bf_hi(cg[r].w) * bf_hi(uu[r].w); }
#pragma unroll
        for (int r = 0; r < CT; ++r) {
            float a[8];
#pragma unroll
            for (int e = 0; e < 8; ++e) a[e] = w[0][e >> 2][e & 3] * h[r][e] + w[1][e >> 2][e & 3] * h[r + 1][e] + w[2][e >> 2][e & 3] * h[r + 2][e];
            v4u o; o.x = pk2(a[0] * bf_lo(bg[r].x), a[1] * bf_hi(bg[r].x)); o.y = pk2(a[2] * bf_lo(bg[r].y), a[3] * bf_hi(bg[r].y));
            o.z = pk2(a[4] * bf_lo(bg[r].z), a[5] * bf_hi(bg[r].z)); o.w = pk2(a[6] * bf_lo(bg[r].w), a[7] * bf_hi(bg[r].w));
            *(GAS v4u*)(F.Z + (size_t)(tb + r) * CONV + c0) = o;
        }
    }
}
DI int t5_bucket(int d) {
    if (d < 16) return d;
    const int large = 16 + (int)(logf((float)d / 16.f) / logf(8.f) * 16.f);
    return large < 31 ? large : 31;
}
constexpr int KS_STRIDE = 72, VT_STRIDE = 264;
constexpr int ATT_KS = 0, ATT_VT = 256 * KS_STRIDE * 2, ATT_BIAS = ATT_VT + 64 * VT_STRIDE * 2, ATT_END = ATT_BIAS + 4 * 128 * 4;
static_assert(ATT_END <= RING_BYTES, "attention LDS");
DI void p2_attention(Frame& F) {
    LAS bf16* KS = (LAS bf16*)(F.lds + ATT_KS); LAS bf16* VT = (LAS bf16*)(F.lds + ATT_VT); LAS float* BIAS = (LAS float*)(F.lds + ATT_BIAS);
    const int lane = F.lane, r = lane & 31, hh = lane >> 5;
#pragma unroll 1
    for (int unit = F.vcu; unit < 8 * 32 * NKV; unit += F.G) {
        const int kv = unit & 1, n = (unit >> 1) & 31, b = unit >> 6;
        const int t0 = b * SEQ + n * 128;
        __syncthreads();
        {
            const int j = F.tid >> 1, hf = F.tid & 1; const bool valid = (n > 0) || (j >= 128);
            const bf16* rowp = F.PA + (size_t)(t0 - 128 + j) * PA_W;
            v4u kq[4], vq[4];
#pragma unroll
            for (int i = 0; i < 4; ++i) { kq[i] = (v4u){0u, 0u, 0u, 0u}; vq[i] = kq[i]; }
            if (valid) {
#pragma unroll
                for (int i = 0; i < 4; ++i) { kq[i] = *(const GAS v4u*)(rowp + C_K + kv * HD + hf * 32 + i * 8); vq[i] = *(const GAS v4u*)(rowp + C_V + kv * HD + hf * 32 + i * 8); }
            }
            float kf[32]; float ss = 0.f;
#pragma unroll
            for (int i = 0; i < 4; ++i) { kf[8 * i + 0] = bf_lo(kq[i].x); kf[8 * i + 1] = bf_hi(kq[i].x); kf[8 * i + 2] = bf_lo(kq[i].y); kf[8 * i + 3] = bf_hi(kq[i].y);
                kf[8 * i + 4] = bf_lo(kq[i].z); kf[8 * i + 5] = bf_hi(kq[i].z); kf[8 * i + 6] = bf_lo(kq[i].w); kf[8 * i + 7] = bf_hi(kq[i].w); }
#pragma unroll
            for (int e = 0; e < 32; ++e) ss += kf[e] * kf[e];
            ss += __shfl_xor(ss, 1);
            const float rs = 1.f / sqrtf(ss * (1.f / HD) + EPS);
#pragma unroll
            for (int i = 0; i < 4; ++i) { const f32x4 g0 = *(const GAS f32x4*)(F.k_norm + hf * 32 + 8 * i), g1 = *(const GAS f32x4*)(F.k_norm + hf * 32 + 8 * i + 4);
                v4u o; o.x = pk2(kf[8 * i + 0] * rs * g0[0], kf[8 * i + 1] * rs * g0[1]); o.y = pk2(kf[8 * i + 2] * rs * g0[2], kf[8 * i + 3] * rs * g0[3]);
                o.z = pk2(kf[8 * i + 4] * rs * g1[0], kf[8 * i + 5] * rs * g1[1]); o.w = pk2(kf[8 * i + 6] * rs * g1[2], kf[8 * i + 7] * rs * g1[3]);
                *(LAS v4u*)(KS + j * KS_STRIDE + hf * 32 + 8 * i) = o; }
#pragma unroll
            for (int i = 0; i < 4; ++i) { const int d0 = hf * 32 + 8 * i;
                VT[(d0 + 0) * VT_STRIDE + j] = (bf16)(vq[i].x & 0xffffu); VT[(d0 + 1) * VT_STRIDE + j] = (bf16)(vq[i].x >> 16);
                VT[(d0 + 2) * VT_STRIDE + j] = (bf16)(vq[i].y & 0xffffu); VT[(d0 + 3) * VT_STRIDE + j] = (bf16)(vq[i].y >> 16);
                VT[(d0 + 4) * VT_STRIDE + j] = (bf16)(vq[i].z & 0xffffu); VT[(d0 + 5) * VT_STRIDE + j] = (bf16)(vq[i].z >> 16);
                VT[(d0 + 6) * VT_STRIDE + j] = (bf16)(vq[i].w & 0xffffu); VT[(d0 + 7) * VT_STRIDE + j] = (bf16)(vq[i].w >> 16); }
            { const int g = F.tid >> 7, dist = F.tid & 127; BIAS[F.tid] = F.rel_bias[t5_bucket(dist) * NH + kv * 4 + g]; }
        }
        __syncthreads();
#pragma unroll 1
        for (int task = F.wave; task < 16; task += NWAVES) {
            const int g = task >> 2, c = task & 3, head = kv * 4 + g, r0 = 32 * c;
            bf16x8 qf[4];
            {
                const bf16* qp = F.PA + (size_t)(t0 + r0 + r) * PA_W + C_Q + head * HD + 8 * hh;
                v4u qq[4]; float qv[32]; float ss = 0.f;
#pragma unroll
                for (int s = 0; s < 4; ++s) qq[s] = *(const GAS v4u*)(qp + 16 * s);
#pragma unroll
                for (int s = 0; s < 4; ++s) { qv[8 * s + 0] = bf_lo(qq[s].x); qv[8 * s + 1] = bf_hi(qq[s].x); qv[8 * s + 2] = bf_lo(qq[s].y); qv[8 * s + 3] = bf_hi(qq[s].y);
                    qv[8 * s + 4] = bf_lo(qq[s].z); qv[8 * s + 5] = bf_hi(qq[s].z); qv[8 * s + 6] = bf_lo(qq[s].w); qv[8 * s + 7] = bf_hi(qq[s].w); }
#pragma unroll
                for (int e = 0; e < 32; ++e) ss += qv[e] * qv[e];
                ss += __shfl_xor(ss, 32);
                const float rs = 0.125f / sqrtf(ss * (1.f / HD) + EPS);
#pragma unroll
                for (int s = 0; s < 4; ++s) { const f32x4 g0 = *(const GAS f32x4*)(F.q_norm + 16 * s + 8 * hh), g1 = *(const GAS f32x4*)(F.q_norm + 16 * s + 8 * hh + 4);
                    v4u o; o.x = pk2(qv[8 * s + 0] * rs * g0[0], qv[8 * s + 1] * rs * g0[1]); o.y = pk2(qv[8 * s + 2] * rs * g0[2], qv[8 * s + 3] * rs * g0[3]);
                    o.z = pk2(qv[8 * s + 4] * rs * g1[0], qv[8 * s + 5] * rs * g1[1]); o.w = pk2(qv[8 * s + 6] * rs * g1[2], qv[8 * s + 7] * rs * g1[3]);
                    qf[s] = __builtin_bit_cast(bf16x8, o); }
            }
            f32x16 sacc[5];
#pragma unroll
            for (int i5 = 0; i5 < 5; ++i5) {
#pragma unroll
                for (int e = 0; e < 16; ++e) sacc[i5][e] = 0.f;
                const int kt = c + i5;
#pragma unroll
                for (int s = 0; s < 4; ++s) { const bf16x8 ka = *(const LAS bf16x8*)(KS + (32 * kt + r) * KS_STRIDE + 16 * s + 8 * hh); sacc[i5] = MFMA32(ka, qf[s], sacc[i5]); }
            }
            const float sink = F.sinks[head];
            const int dbase = r - 4 * hh + 128;
            const LAS float* bl = BIAS + g * 128;
            float mx = sink;
#pragma unroll
            for (int i5 = 0; i5 < 5; ++i5) {
                const bool tile_ok = (n > 0) || (c + i5 >= 4);
#pragma unroll
                for (int e = 0; e < 16; ++e) { const int dist = dbase - 32 * i5 - ((e & 3) + 8 * (e >> 2));
                    bool valid = tile_ok; if (i5 == 0) valid = valid && (dist < 128); if (i5 == 4) valid = valid && (dist >= 0);
                    const float lg = sacc[i5][e] + bl[dist & 127];
                    sacc[i5][e] = valid ? lg : -INFINITY; mx = fmaxf(mx, sacc[i5][e]); }
                __builtin_amdgcn_sched_barrier(0);
            }
            mx = fmaxf(mx, __shfl_xor(mx, 32));
            float sum = 0.f;
#pragma unroll
            for (int i5 = 0; i5 < 5; ++i5)
#pragma unroll
                for (int e = 0; e < 16; ++e) { const float p = __expf(sacc[i5][e] - mx); sacc[i5][e] = p; sum += p; }
            sum += __shfl_xor(sum, 32);
            const float inv = 1.f / (sum + __expf(sink - mx));
            f32x16 oacc[2];
#pragma unroll
            for (int dt = 0; dt < 2; ++dt)
#pragma unroll
                for (int e = 0; e < 16; ++e) oacc[dt][e] = 0.f;
#pragma unroll
            for (int i5 = 0; i5 < 5; ++i5)
#pragma unroll
                for (int s2 = 0; s2 < 2; ++s2) {
                    v4u pp; pp.x = pk2(sacc[i5][8 * s2 + 0] * inv, sacc[i5][8 * s2 + 1] * inv); pp.y = pk2(sacc[i5][8 * s2 + 2] * inv, sacc[i5][8 * s2 + 3] * inv);
                    pp.z = pk2(sacc[i5][8 * s2 + 4] * inv, sacc[i5][8 * s2 + 5] * inv); pp.w = pk2(sacc[i5][8 * s2 + 6] * inv, sacc[i5][8 * s2 + 7] * inv);
                    const bf16x8 pb = __builtin_bit_cast(bf16x8, pp);
                    const int kb = 32 * (c + i5) + 16 * s2 + 4 * hh;
#pragma unroll
                    for (int dt = 0; dt < 2; ++dt) {
                        const v2u lo = *(const LAS v2u*)(VT + (32 * dt + r) * VT_STRIDE + kb), hi = *(const LAS v2u*)(VT + (32 * dt + r) * VT_STRIDE + kb + 8);
                        v4u va; va.x = lo.x; va.y = lo.y; va.z = hi.x; va.w = hi.y;
                        oacc[dt] = MFMA32(__builtin_bit_cast(bf16x8, va), pb, oacc[dt]);
                    }
                    __builtin_amdgcn_sched_barrier(0);
                }
            bf16* op = F.ATT + (size_t)(t0 + r0 + r) * CONV + head * HD;
#pragma unroll
            for (int dt = 0; dt < 2; ++dt)
#pragma unroll
                for (int g4 = 0; g4 < 4; ++g4) { v2u w; w.x = pk2(oacc[dt][4 * g4 + 0], oacc[dt][4 * g4 + 1]); w.y = pk2(oacc[dt][4 * g4 + 2], oacc[dt][4 * g4 + 3]);
#ifdef ZERO_ATT
                    w.x = 0u; w.y = 0u;
#endif
                    *(GAS v2u*)(op + 32 * dt + 8 * g4 + 4 * hh) = w; }
        }
    }
}

DI unsigned f2ord(float f) { const unsigned b = __builtin_bit_cast(unsigned, f); return b ^ ((b >> 31) ? 0xffffffffu : 0x80000000u); }
DI float ord2f(unsigned k) { const unsigned b = k ^ ((k >> 31) ? 0x80000000u : 0xffffffffu); return __builtin_bit_cast(float, b); }
DI unsigned umax_(unsigned a, unsigned b) { return a > b ? a : b; }
DI unsigned umin_(unsigned a, unsigned b) { return a < b ? a : b; }
DI void sort16_desc(unsigned (&v)[16]) {
#pragma unroll
    for (int k = 2; k <= 16; k <<= 1)
#pragma unroll
        for (int j = k >> 1; j > 0; j >>= 1)
#pragma unroll
            for (int i = 0; i < 16; ++i) { const int l = i ^ j; if (l > i) { const bool desc = ((i & k) == 0) || (k == 16); const unsigned a = v[i], b = v[l], hi = umax_(a, b), lo = umin_(a, b); v[i] = desc ? hi : lo; v[l] = desc ? lo : hi; } }
}
DI void merge_top16(unsigned (&a)[16], const unsigned (&b)[16]) {
#pragma unroll
    for (int i = 0; i < 16; ++i) a[i] = umax_(a[i], b[15 - i]);
#pragma unroll
    for (int j = 8; j > 0; j >>= 1)
#pragma unroll
        for (int i = 0; i < 16; ++i) { const int l = i ^ j; if (l > i) { const unsigned x = a[i], y = a[l]; a[i] = umax_(x, y); a[l] = umin_(x, y); } }
}
constexpr int SK_STRIDE = 136;
constexpr int P6_KEYS = 0, P6_IB = 2 * NKEYS * SK_STRIDE * 2, P6_END = P6_IB + NWAVES * 64 * 32;
static_assert(P6_END <= RING_BYTES, "topk LDS");
DI void p6_topk(Frame& F) {
    LAS bf16* KL = (LAS bf16*)(F.lds + P6_KEYS); LAS unsigned char* IB = F.lds + P6_IB + (F.wave * 64 + F.lane) * 32;
    const int lane = F.lane, r = lane & 31, hh = lane >> 5;
    pg8::StaticOrder S; S.init(T, PQ, F.G, (int)blockIdx.x);
    pg8::Unit pu;
    for (int ui = 0; S.next(ui, pu); ++ui) {
        const int h = pu.pn, tile = pu.pm;
        __syncthreads();
        {
            const bf16* src = F.SK + (size_t)h * 2 * NKEYS * 128;
#pragma unroll
            for (int i = 0; i < 8; ++i) { const int ch = F.tid + 512 * i; const int row = ch >> 4, c8 = (ch & 15) * 8;
                *(LAS v4u*)(KL + row * SK_STRIDE + c8) = *(const GAS v4u*)(src + (size_t)row * 128 + c8); }
        }
        __syncthreads();
        const int t = tile * 256 + F.wave * 32 + r;
        unsigned S[2][16];
#pragma unroll
        for (int p = 0; p < 2; ++p) {
            bf16x8 qf[8];
            const int rt = F.wave * 32 + r, q_ai = rt >> 7, q_wr = (rt >> 6) & 1, q_m = (rt >> 4) & 3, q_fr = rt & 15;
#pragma unroll
            for (int s = 0; s < 8; ++s) qf[s] = __builtin_bit_cast(bf16x8, *(const GAS v4u*)(F.QP + pg8::frag_off(tile, h, 8, q_wr * 4 + (s >> 1), q_ai * 8 + q_m * 2 + p, (2 * (s & 1) + hh) * 16 + q_fr)));
            unsigned key[4][16];
#pragma unroll
            for (int kt = 0; kt < 4; ++kt) {
                f32x16 acc;
#pragma unroll
                for (int e = 0; e < 16; ++e) acc[e] = 0.f;
#pragma unroll
                for (int s = 0; s < 8; ++s) { const bf16x8 ka = *(const LAS bf16x8*)(KL + (p * NKEYS + 32 * kt + r) * SK_STRIDE + 16 * s + 8 * hh); acc = MFMA32(ka, qf[s], acc); }
#pragma unroll
                for (int e = 0; e < 16; ++e) { const int nk = 32 * kt + (e & 3) + 8 * (e >> 2) + 4 * hh; key[kt][e] = (f2ord(acc[e]) & ~127u) | (unsigned)(127 - nk); }
            }
#pragma unroll
            for (int kt = 0; kt < 4; ++kt) sort16_desc(key[kt]);
            merge_top16(key[0], key[1]); merge_top16(key[2], key[3]); merge_top16(key[0], key[2]);
            unsigned other[16];
#pragma unroll
            for (int i = 0; i < 16; ++i) other[i] = (unsigned)__shfl_xor((int)key[0][i], 32);
            merge_top16(key[0], other);
#pragma unroll
            for (int i = 0; i < 16; ++i) S[p][i] = key[0][i];
        }
        float s0[16], s1[16]; const float rs2 = pg8::rstd2_of(F.SSQ, t);
#pragma unroll
        for (int i = 0; i < 16; ++i) { s0[i] = ord2f(S[0][i] & ~127u) * rs2; s1[i] = ord2f(S[1][i] & ~127u) * rs2; }
        {
#pragma unroll
            for (int q4 = 0; q4 < 4; ++q4) { unsigned w0 = 0, w1 = 0;
#pragma unroll
                for (int e = 0; e < 4; ++e) { w0 |= (127u - (S[0][4 * q4 + e] & 127u)) << (8 * e); w1 |= (127u - (S[1][4 * q4 + e] & 127u)) << (8 * e); }
                *(LAS unsigned*)(IB + 4 * q4) = w0; *(LAS unsigned*)(IB + 16 + 4 * q4) = w1; }
        }
        unsigned cand[2][16];
#pragma unroll
        for (int i = 0; i < 2; ++i)
#pragma unroll
            for (int e = 0; e < 16; ++e) cand[i][e] = 0u;
        {
            int cnt = 0; float ea = 0.f, eb = 0.f; int ep = 0;
#pragma unroll
            for (int a = 0; a < 16; ++a)
#pragma unroll
                for (int b = 0; b < 16; ++b)
                    if ((a + 1) * (b + 1) <= 16) {
                        if ((cnt & 1) == 0) { ea = s0[a]; eb = s1[b]; ep = 255 - (a * 16 + b); }
                        else { const int slot = cnt >> 1; const float sa = hh ? s0[a] : ea, sb = hh ? s1[b] : eb; const int pp = hh ? 255 - (a * 16 + b) : ep;
                            cand[slot & 1][slot >> 1] = (f2ord(sa + sb) & ~255u) | (unsigned)pp; }
                        ++cnt; }
        }
        sort16_desc(cand[0]); sort16_desc(cand[1]); merge_top16(cand[0], cand[1]);
        {
            unsigned other[16];
#pragma unroll
            for (int i = 0; i < 16; ++i) other[i] = (unsigned)__shfl_xor((int)cand[0][i], 32);
            merge_top16(cand[0], other);
        }
        float gv[16]; int ev[16]; float gsum = 0.f; const float gmx = ord2f(cand[0][0] & ~255u);
#pragma unroll
        for (int i = 0; i < 16; ++i) { const unsigned k = cand[0][i]; const int pos = 255 - (int)(k & 255u); const int a = pos >> 4, b = pos & 15;
            ev[i] = (int)IB[a] * NKEYS + (int)IB[16 + b]; gv[i] = __expf(ord2f(k & ~255u) - gmx); gsum += gv[i]; }
        float ginv = 1.f / gsum;
#ifdef UNIFORM_GATES
#pragma unroll
        for (int i = 0; i < 16; ++i) gv[i] = 1.f;
        ginv = 1.f / 16.f;
#endif
        if (hh == 0) {
            unsigned short* ip = F.IDX + (size_t)t * NSEL + h * TOPK; float* gp = F.GATE + (size_t)t * NSEL + h * TOPK;
#pragma unroll
            for (int i = 0; i < 2; ++i) *(GAS v4i*)(ip + 8 * i) = (v4i){ev[8 * i] | (ev[8 * i + 1] << 16), ev[8 * i + 2] | (ev[8 * i + 3] << 16), ev[8 * i + 4] | (ev[8 * i + 5] << 16), ev[8 * i + 6] | (ev[8 * i + 7] << 16)};
#pragma unroll
            for (int i = 0; i < 4; ++i) *(GAS f32x4*)(gp + 4 * i) = (f32x4){gv[4 * i] * ginv, gv[4 * i + 1] * ginv, gv[4 * i + 2] * ginv, gv[4 * i + 3] * ginv};
        }
    }
}

typedef float f32x2_t __attribute__((ext_vector_type(2)));
DI void fp8x16_to_f32(v4u q, float (&f)[16]) {
#pragma unroll
    for (int w = 0; w < 4; ++w) { const f32x2_t lo = __builtin_amdgcn_cvt_pk_f32_fp8((int)q[w], false), hi = __builtin_amdgcn_cvt_pk_f32_fp8((int)q[w], true);
        f[4 * w + 0] = lo.x; f[4 * w + 1] = lo.y; f[4 * w + 2] = hi.x; f[4 * w + 3] = hi.y; }
}
struct XccInfo { int q, nx, nloc, rank; };
DI void xcc_info_build(const XcdBarrier& b) {
    if (threadIdx.x == 0) {
        unsigned q = 0, nx = 0, nloc = 1;
        for (unsigned j = 0; j < 16; ++j) { const unsigned c = xb_ld(&b.bar[XB_XCNT(j)]); if (c > 0u) { if (j < b.x) ++q; ++nx; } if (j == b.x) nloc = c; }
        b.st[3] = q; b.st[4] = nx > 0u ? nx : 1u; b.st[5] = nloc > 0u ? nloc : 1u;
    }
    __syncthreads();
}
DI XccInfo xcc_info(const XcdBarrier& b) {
    XccInfo I; I.rank = __builtin_amdgcn_readfirstlane((int)b.st[2]); I.q = __builtin_amdgcn_readfirstlane((int)b.st[3]); I.nx = __builtin_amdgcn_readfirstlane((int)b.st[4]); I.nloc = __builtin_amdgcn_readfirstlane((int)b.st[5]);
    return I;
}
DI float dpp_sum8(float s) {
    s += __builtin_bit_cast(float, __builtin_amdgcn_update_dpp(0, __builtin_bit_cast(int, s), 0xB1, 0xf, 0xf, false));
    s += __builtin_bit_cast(float, __builtin_amdgcn_update_dpp(0, __builtin_bit_cast(int, s), 0x4E, 0xf, 0xf, false));
    s += __builtin_bit_cast(float, __builtin_amdgcn_update_dpp(0, __builtin_bit_cast(int, s), 0x141, 0xf, 0xf, false));
    return s;
}
typedef long i64_t;
typedef long i64x2 __attribute__((ext_vector_type(2)));
typedef int v4i_t __attribute__((ext_vector_type(4)));
typedef int v8i_t __attribute__((ext_vector_type(8)));
constexpr int PEER_ROW = 144, PEER_WAVE_LDS = 128 * PEER_ROW;
constexpr int MX_ONE = 0x7f7f7f7f;
#define P7_IDS(t_, ia_, ib_) do { ia_ = (int)F.IDX[(size_t)(t_) * NSEL + lane]; ib_ = (int)F.IDX[(size_t)(t_) * NSEL + 64 + lane]; } while (0)
#define P7_ISSUE(t_, ia_, ib_, uq_, x_) do { \
        const unsigned char* xr_ = F.XB8 + (size_t)(t_) * D + sl * 256 + 16 * g;   \
        x_[0] = *(const GAS v4u*)(xr_); x_[1] = *(const GAS v4u*)(xr_ + 64); x_[2] = *(const GAS v4u*)(xr_ + 128); x_[3] = *(const GAS v4u*)(xr_ + 192); \
        _Pragma("unroll") for (int ld = 0; ld < 16; ++ld) { const int e_ = __shfl(ld < 8 ? ia_ : ib_, (8 * ld + row8) & 63); uq_[ld] = *(const GAS v4u*)(Us + (unsigned)(e_ * 128 + 16 * c8)); } } while (0)
#define P7_COMPUTE(t_, uq_, x_) do { \
        _Pragma("unroll") for (int ld = 0; ld < 16; ++ld) *(LAS v4u*)(wl + (8 * ld + row8) * PEER_ROW + 16 * c8) = uq_[ld]; \
        v8i_t xb0_, xb1_; \
        xb0_[0] = (int)x_[0].x; xb0_[1] = (int)x_[0].y; xb0_[2] = (int)x_[0].z; xb0_[3] = (int)x_[0].w; xb0_[4] = (int)x_[1].x; xb0_[5] = (int)x_[1].y; xb0_[6] = (int)x_[1].z; xb0_[7] = (int)x_[1].w; \
        xb1_[0] = (int)x_[2].x; xb1_[1] = (int)x_[2].y; xb1_[2] = (int)x_[2].z; xb1_[3] = (int)x_[2].w; xb1_[4] = (int)x_[3].x; xb1_[5] = (int)x_[3].y; xb1_[6] = (int)x_[3].z; xb1_[7] = (int)x_[3].w; \
        f32x4 keep = {0.f, 0.f, 0.f, 0.f}; \
        _Pragma("unroll") for (int j = 0; j < 8; ++j) { f32x4 c_ = {0.f, 0.f, 0.f, 0.f}; \
            const v4i_t a0_ = *(const LAS v4i_t*)(wl + (16 * j + m) * PEER_ROW + 16 * g), a1_ = *(const LAS v4i_t*)(wl + (16 * j + m) * PEER_ROW + 64 + 16 * g); \
            v8i_t A0_ = {a0_[0], a0_[1], a0_[2], a0_[3], 0, 0, 0, 0}, A1_ = {a1_[0], a1_[1], a1_[2], a1_[3], 0, 0, 0, 0}; \
            c_ = __builtin_amdgcn_mfma_scale_f32_16x16x128_f8f6f4(A0_, xb0_, c_, 4, 0, 0, MX_ONE, 0, MX_ONE); \
            c_ = __builtin_amdgcn_mfma_scale_f32_16x16x128_f8f6f4(A1_, xb1_, c_, 4, 0, 0, MX_ONE, 0, MX_ONE); \
            keep = (m == j) ? c_ : keep; } \
        { const bool ok_ = (m < 8) && ((t_) < T); bf16* dst_ = ok_ ? F.PARTB + ((size_t)sl * T + (t_)) * NSEL + 16 * m + 4 * g : F.PARTB + (size_t)8 * T * NSEL + 4 * lane; \
          v2u w_; w_.x = pk2(keep[0], keep[1]); w_.y = pk2(keep[2], keep[3]); *(GAS v2u*)dst_ = w_; } } while (0)
DI int peer_next(volatile LAS unsigned* ctr, int lane) { unsigned k = 0u; if (lane == 0) k = __hip_atomic_fetch_add((LAS unsigned*)ctr, 1u, __ATOMIC_RELAXED, __HIP_MEMORY_SCOPE_WORKGROUP); return __builtin_amdgcn_readfirstlane((int)k); }
DI int peer_tok(int tbase, int tstride, int k) { return tbase + (k & 7) + (k >> 3) * tstride; }
DI void p7_udot(Frame& F, const XccInfo& I) {
    const int lane = F.lane, g = lane >> 4, m = lane & 15, row8 = lane >> 3, c8 = lane & 7;
    LAS unsigned char* wl = F.lds + F.wave * PEER_WAVE_LDS;
    const unsigned char* U4 = (const unsigned char*)F.UB;
    const int tstride = I.nloc * NWAVES, tbase = I.rank * NWAVES;
    int it = 0;
    for (int share = I.q; share < 8; share += I.nx, ++it) {
        const int sl = share >> 1, half = share & 1;
        const unsigned char* Us = U4 + (size_t)sl * NEXP * 128;
        volatile LAS unsigned* ctr = F.MISC + 16 + it;
#define CL(t_) ((t_) < T ? (t_) : T - 1)
#define TOK(k_) (2 * peer_tok(tbase, tstride, (k_)) + half)
        v4u uqA[16], uqB[16]; int iA0, iA1, iB0, iB1;
        int kk = peer_next(ctr, lane); int tA = TOK(kk); kk = peer_next(ctr, lane); int tB = TOK(kk);
        {
            v4u xA[4], xB[4];
            P7_IDS(CL(tA), iA0, iA1);
            P7_ISSUE(CL(tA), iA0, iA1, uqA, xA);
            P7_IDS(CL(tB), iB0, iB1);
#pragma unroll 1
            while (tA < T) {
                kk = peer_next(ctr, lane); const int tC = TOK(kk); kk = peer_next(ctr, lane); const int tD = TOK(kk);
                P7_IDS(CL(tC), iA0, iA1);
                P7_ISSUE(CL(tB), iB0, iB1, uqB, xB);
                P7_COMPUTE(tA, uqA, xA);
                P7_IDS(CL(tD), iB0, iB1);
                P7_ISSUE(CL(tC), iA0, iA1, uqA, xA);
                P7_COMPUTE(tB, uqB, xB);
                tA = tC; tB = tD;
            }
        }
#undef TOK
#undef CL
    }
}
DI void p8_act(Frame& F) {
    const size_t NT_ = (size_t)F.G * NWAVES * 64;
    for (size_t item = (size_t)F.vcu * NWAVES * 64 + F.tid; item < (size_t)T * NSEL / 4; item += NT_) {
        const int t = (int)(item >> 5);
        f32x4 s = {0.f, 0.f, 0.f, 0.f}, vs4;
#pragma unroll
        for (int sl = 0; sl < 4; ++sl) { const v2u p = *(const GAS v2u*)(F.PARTB + (size_t)sl * T * NSEL + item * 4); s = s + (f32x4){bf_lo(p.x), bf_hi(p.x), bf_lo(p.y), bf_hi(p.y)}; }
        { const v2u ids = *(const GAS v2u*)(F.IDX + item * 4);
          s[0] *= F.SU[ids.x & 0xffffu]; s[1] *= F.SU[ids.x >> 16]; s[2] *= F.SU[ids.y & 0xffffu]; s[3] *= F.SU[ids.y >> 16];
          vs4 = (f32x4){F.SV[ids.x & 0xffffu], F.SV[ids.x >> 16], F.SV[ids.y & 0xffffu], F.SV[ids.y >> 16]}; }
        const float rs2 = pg8::rstd2_of(F.SSQ, t);
        const f32x4 g = *(const GAS f32x4*)(F.GATE + item * 4);
        f32x4 o;
#pragma unroll
        for (int e = 0; e < 4; ++e) { const float pre = s[e] * rs2; o[e] = 0.5f * pre * (1.f + erff(pre * 0.70710678118f)) * g[e] * vs4[e] * A_SCALE; }
        ((GAS unsigned*)F.ACT)[item] = pk4_fp8(o);
    }
}
typedef int v2i_t __attribute__((ext_vector_type(2)));
#define P9_IDS(t_, ia_, ib_, ak_) do { ia_ = (int)F.IDX[(size_t)(t_) * NSEL + lane]; ib_ = (int)F.IDX[(size_t)(t_) * NSEL + 64 + lane]; \
        const unsigned char* ap_ = (const unsigned char*)F.ACT + (size_t)(t_) * NSEL + 16 * g; \
        ak_[0] = *(const GAS v4u*)(ap_); ak_[1] = *(const GAS v4u*)(ap_ + 64); } while (0)
#define P9_ISSUE(ia_, ib_, vq_) do { \
        _Pragma("unroll") for (int ld = 0; ld < 16; ++ld) { const int e_ = __shfl(ld < 8 ? ia_ : ib_, (8 * ld + row8) & 63); vq_[ld] = *(const GAS v4u*)(Vs + (unsigned)(e_ * 128 + 16 * c8)); } } while (0)
#define P9_COMPUTE(t_, vq_, ak_) do { \
        _Pragma("unroll") for (int ld = 0; ld < 16; ++ld) *(LAS v4u*)(wl + (8 * ld + row8) * PEER_ROW + 16 * c8) = vq_[ld]; \
        const v8i_t A_ = {(int)ak_[0].x, (int)ak_[0].y, (int)ak_[0].z, (int)ak_[0].w, (int)ak_[1].x, (int)ak_[1].y, (int)ak_[1].z, (int)ak_[1].w}; \
        float keep[4] = {0.f, 0.f, 0.f, 0.f}; \
        _Pragma("unroll") for (int ct = 0; ct < 16; ++ct) { \
            const v2i_t b0_ = __builtin_amdgcn_ds_read_tr4_b64_v2i32((LAS v2i_t*)(wl + (32 * g + n16) * PEER_ROW + 8 * ct)); \
            const v2i_t b1_ = __builtin_amdgcn_ds_read_tr4_b64_v2i32((LAS v2i_t*)(wl + (32 * g + 16 + n16) * PEER_ROW + 8 * ct)); \
            const v8i_t B_ = {b0_[0], b0_[1], b1_[0], b1_[1], 0, 0, 0, 0}; f32x4 c_ = {0.f, 0.f, 0.f, 0.f}; \
            c_ = __builtin_amdgcn_mfma_scale_f32_16x16x128_f8f6f4(A_, B_, c_, 0, 4, 0, MX_ONE, 0, MX_ONE); \
            keep[ct >> 2] = (g == (ct & 3)) ? c_[0] : keep[ct >> 2]; }   \
        { const bool ok_ = (t_) < T; const size_t oo_ = (size_t)(ok_ ? (t_) : T - 1) * D + sl * 256 + 16 * g + n16; \
          float* op_ = ok_ ? F.out + oo_ : (float*)F.PARTB + 4 * lane;                   \
          _Pragma("unroll") for (int q = 0; q < 4; ++q) op_[ok_ ? 64 * q : q] = __builtin_bit_cast(float, (unsigned)F.XB[oo_ + 64 * q] << 16) + keep[q] * (1.f / A_SCALE); } } while (0)
DI void p9_vacc(Frame& F, const XccInfo& I) {
    const int lane = F.lane, g = lane >> 4, n16 = lane & 15, row8 = lane >> 3, c8 = lane & 7;
    LAS unsigned char* wl = F.lds + F.wave * PEER_WAVE_LDS;
    const unsigned char* V4 = (const unsigned char*)F.VB;
    const int tstride = I.nloc * NWAVES, tfirst = I.rank * NWAVES + F.wave;
    for (int share = I.q; share < 8; share += I.nx) {
        const int sl = share >> 1, half = share & 1;
        const unsigned char* Vs = V4 + (size_t)sl * NEXP * 128;
        if (2 * tfirst + half >= T) continue;
        v4u vqA[16], vqB[16]; v4u akA[2], akB[2]; int iA0, iA1, iB0, iB1;
#define CL(t_) ((t_) < T ? (t_) : T - 1)
#define TK(k_) (2 * (tfirst + (k_) * tstride) + half)
        P9_IDS(TK(0), iA0, iA1, akA);
        P9_ISSUE(iA0, iA1, vqA);
        P9_IDS(CL(TK(1)), iB0, iB1, akB);
#pragma unroll 1
        for (int k = 0; TK(k) < T; k += 2) {
            const int t = TK(k), t1 = TK(k + 1), t2 = CL(TK(k + 2)), t3 = CL(TK(k + 3));
            v4u akN[2], akM[2];
            P9_IDS(t2, iA0, iA1, akN);
            P9_ISSUE(iB0, iB1, vqB);
            P9_COMPUTE(t, vqA, akA);
            P9_IDS(t3, iB0, iB1, akM);
            P9_ISSUE(iA0, iA1, vqA);
            P9_COMPUTE(t1, vqB, akB);
            akA[0] = akN[0]; akA[1] = akN[1]; akB[0] = akM[0]; akB[1] = akM[1];
        }
#undef TK
#undef CL
    }
}

struct Args { const float* in[17]; float* out; unsigned char* ws; int ph_lo, ph_hi, li, pad; };
__global__ void __launch_bounds__(NWAVES * 64, 2) hyb_fwd(Args args) {
    extern __shared__ __attribute__((aligned(16))) unsigned char lds[];
    Frame F;
    F.lds = (LAS unsigned char*)lds;
    F.MISC = (volatile LAS unsigned*)(F.lds + MISC_OFF);
    F.tid = threadIdx.x; F.lane = F.tid & 63; F.wave = __builtin_amdgcn_readfirstlane(F.tid >> 6);
    F.G = gridDim.x; { const int bx = blockIdx.x; F.vcu = (F.G % 8 == 0) ? (bx % 8) * (F.G / 8) + bx / 8 : bx; }
    unsigned char* ws = args.ws;
    F.ctl = (gu32*)(ws + WS_CTL);
    F.x = args.in[0]; F.norm_mix = args.in[1]; F.norm_ffn = args.in[2]; F.w_in = args.in[3]; F.b_gate = args.in[4]; F.w_conv = args.in[5]; F.q_norm = args.in[6]; F.k_norm = args.in[7];
    F.sinks = args.in[8]; F.rel_bias = args.in[9]; F.w_conv_out = args.in[10]; F.w_attn_out = args.in[11]; F.w_out = args.in[12]; F.w_query = args.in[13]; F.sub_keys = args.in[14];
    F.expert_u = args.in[15]; F.expert_v = args.in[16]; F.out = args.out;
    F.WIN = (bf16*)(ws + WS_WIN); F.WC = (bf16*)(ws + WS_WC); F.WA = (bf16*)(ws + WS_WA); F.WO = (bf16*)(ws + WS_WO); F.WQ = (bf16*)(ws + WS_WQ); F.SK = (bf16*)(ws + WS_SK);
    F.UB = (bf16*)(ws + WS_UB); F.VB = (bf16*)(ws + WS_VB); F.XB = (bf16*)(ws + WS_XB); F.PA = (bf16*)(ws + WS_PA); F.MIX = (bf16*)(ws + WS_MIX); F.G_ = (bf16*)(ws + WS_G); F.QP = (bf16*)(ws + WS_QP);
    F.Z = (bf16*)(ws + WS_Z); F.ATT = (bf16*)(ws + WS_ATT); F.RSTD1 = (float*)(ws + WS_RSTD1); F.SSQ = (float*)(ws + WS_SSQ); F.GATE = (float*)(ws + WS_GATE); F.IDX = (unsigned short*)(ws + WS_IDX); F.PARTB = (bf16*)(ws + WS_PART); F.SU = (float*)(ws + WS_SU); F.SV = (float*)(ws + WS_SV); F.XB8 = (unsigned char*)(ws + WS_XB8); F.ACT = (float*)(ws + WS_ACT);
    for (int u = F.tid; u < (LDS_BYTES - LDSCTL_OFF) / 4; u += NWAVES * 64) ((LAS unsigned*)(F.lds + LDSCTL_OFF))[u] = 0u;
    __syncthreads();
    XcdBarrier bar; bar.bar = (unsigned*)(F.ctl + CW_BAR); bar.x = 0; bar.st = nullptr;
    const int lo = args.ph_lo, hi = args.ph_hi;
    if (hi - lo > 1) bar = xcd_barrier_post((unsigned*)(F.ctl + CW_BAR), F.MISC + 8);
#ifndef PH_MASK
#define PH_MASK 0x3ff
#endif
#define IN(k) (((PH_MASK >> (k)) & 1) && lo <= (k) && (k) < hi)
#define SEAM(k) do { if (IN(k) && IN((k) + 1)) xcd_barrier(bar); } while (0)
#ifndef PROBE_DUP
#define PROBE_DUP 0
#endif
#define REP(k) for (int rep_ = 0; rep_ < (((PROBE_DUP >> (k)) & 1) ? 2 : 1); ++rep_)

    if (IN(0)) { REP(0) p0_prologue(F); SEAM(0); }
    if (IN(1)) {
        pg8::Gemm g{F.XB, F.WIN, nullptr, nullptr, T, IN_DIM, D}; pg8::StaticOrder S; S.init(T, IN_DIM, F.G, (int)blockIdx.x);
        { LAS float* bgl = (LAS float*)(F.lds + RING_BYTES); for (int i = F.tid; i < 2 * D; i += NWAVES * 64) bgl[i] = F.b_gate[i]; __syncthreads(); }
        pg8::EpiProj E{F.PA, F.G_, (const PG8_LAS float*)(F.lds + RING_BYTES)};
        REP(1) pg8::gemm_phase<pg8::EpiProj, pg8::StaticOrder, PG8_ALIGN, PG8_SP2>(F.lds + RING_OFF, g, S, E);
        {
            const int nwg = (T / 256) * (IN_DIM / 256), rem = nwg % F.G, c = (int)blockIdx.x; const int nshort = rem ? F.G - rem : F.G, sidx = rem ? c - rem : c;
            if (sidx >= 0) { p0_convert_fp4(F, F.expert_u, F.norm_ffn, (unsigned char*)F.UB, F.SU, sidx, nshort);
                             p0_convert_fp4(F, F.expert_v, nullptr, (unsigned char*)F.VB, F.SV, sidx, nshort); } }
        SEAM(1);
    }
    if (IN(2)) {
        REP(2) { p2_conv(F); p2_attention(F); }
        SEAM(2); }
    if (IN(3)) {
        pg8::Gemm g{F.Z, F.WC, F.ATT, F.WA, T, D, CONV}; pg8::PairOrder S; S.init(T, D, F.G, (int)blockIdx.x);
        pg8::EpiMix E{F.MIX, F.G_};
        REP(3) pg8::gemm_phase<pg8::EpiMix, pg8::PairOrder, PG8_ALIGN, PG8_SP2>(F.lds + RING_OFF, g, S, E);
        SEAM(3);
    }
    if (IN(4)) {
        pg8::Gemm g{F.MIX, F.WO, nullptr, nullptr, T, D, D}; pg8::FragOrder S; S.init(T, D, F.G, (int)blockIdx.x);
        pg8::EpiX1 E{F.x, F.XB, F.SSQ, F.XB8};
        REP(4) pg8::gemm_phase<pg8::EpiX1, pg8::FragOrder, PG8_ALIGN, PG8_SP2>(F.lds + RING_OFF, g, S, E);
        SEAM(4);
    }
    if (IN(5)) {
        pg8::Gemm g{F.XB, F.WQ, nullptr, nullptr, T, PQ, D}; pg8::StaticOrder S; S.init(T, PQ, F.G, (int)blockIdx.x);
        pg8::EpiQP E{F.QP};
        REP(5) pg8::gemm_phase<pg8::EpiQP, pg8::StaticOrder, PG8_ALIGN, PG8_SP2>(F.lds + RING_OFF, g, S, E);
    }
    if (IN(6)) { REP(6) p6_topk(F); SEAM(6); }
    if (IN(7)) { xcc_info_build(bar); const XccInfo I = xcc_info(bar); REP(7) p7_udot(F, I); SEAM(7); }
    if (IN(8)) { REP(8) p8_act(F); SEAM(8); }
    if (IN(9)) { const XccInfo I = xcc_info(bar); p9_vacc(F, I); }
#undef IN
#undef SEAM
}

extern "C" void kernel_launch(void* const* d_in, const int* in_sizes, int n_in, void* d_out, int out_size, void* d_ws, size_t ws_size, hipStream_t stream) {
    static int grid = 0;
    if (grid == 0) {
        if (n_in != 17 || in_sizes[0] != T * D || out_size != T * D || ws_size < WS_END) { fprintf(stderr, "kernel_launch: unexpected shapes (n_in %d, in0 %d, out %d, ws %zu)\n", n_in, n_in > 0 ? in_sizes[0] : -1, out_size, ws_size); grid = -1; return; }
        int dev = 0, cus = 0, per_cu = 0;
        if (hipGetDevice(&dev) != hipSuccess || hipDeviceGetAttribute(&cus, hipDeviceAttributeMultiprocessorCount, dev) != hipSuccess) { grid = -1; return; }
        if (hipFuncSetAttribute((const void*)hyb_fwd, hipFuncAttributeMaxDynamicSharedMemorySize, LDS_BYTES) != hipSuccess) { fprintf(stderr, "kernel_launch: hipFuncSetAttribute failed\n"); grid = -1; return; }
        if (hipOccupancyMaxActiveBlocksPerMultiprocessor(&per_cu, (const void*)hyb_fwd, NWAVES * 64, LDS_BYTES) != hipSuccess || per_cu < 1) { fprintf(stderr, "kernel_launch: occupancy query says %d blocks per CU\n", per_cu); (void)hipGetLastError(); grid = -1; return; }
        grid = cus * 1;
    }
    if (grid < 0) return;
    if (hipMemsetAsync((char*)d_ws + WS_CTL, 0, CTL_ZERO_BYTES, stream) != hipSuccess) { fprintf(stderr, "kernel_launch: memset failed\n"); return; }
    Args a{};
    for (int i = 0; i < 17; ++i) a.in[i] = (const float*)d_in[i];
    a.out = (float*)d_out; a.ws = (unsigned char*)d_ws;
#if MK_ONE_LAUNCH
    a.ph_lo = 0; a.ph_hi = N_PHASES; a.li = 0;
    void* kargs[] = {&a};
    const hipError_t le = hipLaunchCooperativeKernel((const void*)hyb_fwd, dim3(grid), dim3(NWAVES * 64), kargs, LDS_BYTES, stream);
    if (le != hipSuccess) fprintf(stderr, "kernel_launch: cooperative launch failed: %s (grid %d)\n", hipGetErrorName(le), grid);
#else
    for (int li = 0; li < N_PHASES; ++li) {
        a.ph_lo = li; a.ph_hi = li + 1; a.li = li;
        hipLaunchKernelGGL(hyb_fwd, dim3(grid), dim3(NWAVES * 64), LDS_BYTES, stream, a);
        const hipError_t le = hipPeekAtLastError();
        if (le != hipSuccess) { fprintf(stderr, "kernel_launch: launch %d failed: %s\n", li, hipGetErrorName(le)); break; }
    }
#endif
}
```

```cpp
#include <hip/hip_runtime.h>
#include <hip/hip_cooperative_groups.h>
#include <cstdio>
#include <cstdint>
namespace pg8 {
#define PG8_LAS __attribute__((address_space(3)))
typedef unsigned short bf16_t;
typedef short bf16x8 __attribute__((ext_vector_type(8)));
typedef float f32x4 __attribute__((ext_vector_type(4)));
typedef unsigned u32x4 __attribute__((ext_vector_type(4)));
typedef unsigned u32x2 __attribute__((ext_vector_type(2)));
constexpr int BM = 256, BK = 64, HALF = 128, HTB = HALF * BK * 2  , STAGE_BYTES = 8 * HTB, NXCD = 8, WGM = 8;

__host__ __device__ __forceinline__ int lds_byte(int r, int c) { const int st = (r >> 4) * 2 + (c >> 5), rr = r & 15, cc = c & 31, ob = rr * 64 + cc * 2; return st * 1024 + (ob ^ (((ob >> 9) & 1) << 5)); }
__host__ __device__ __forceinline__ void stage_rc(int b, int& R, int& C) { const int st = b / 1024, sb = b % 1024, swz = sb ^ (((sb >> 9) & 1) << 5); R = (st >> 1) * 16 + swz / 64; C = (st & 1) * 32 + (swz % 64) / 2; }
__host__ __device__ __forceinline__ int perm32(int rho) { const int n = rho >> 4, i = rho & 15; return 8 * (i >> 2) + 4 * n + (i & 3); }

struct Unit { int pm, pn, which; };
struct Gemm { const bf16_t* A; const bf16_t* Bt; const bf16_t* A2; const bf16_t* Bt2; int M, N, K; };

struct StaticOrder {
    static constexpr bool AFRAG = false;
    int nM, nN, nwg, G, c;
    __host__ __device__ void init(int M, int N, int G_, int c_) { nM = M / BM; nN = N / BM; nwg = nM * nN; G = G_; c = c_; }
    __host__ __device__ bool next(int i, Unit& u) const {
        const long L = (long)i * G + c; if (L >= nwg) return false;
        int wgid = (int)L; { const int q = nwg / NXCD, r = nwg % NXCD, xcd = wgid % NXCD, off = wgid / NXCD; wgid = (xcd < r ? xcd * (q + 1) : r * (q + 1) + (xcd - r) * q) + off; }
        const int nig = WGM * nN, gid = wgid / nig, fm = gid * WGM, gsz = (nM - fm) < WGM ? (nM - fm) : WGM;
        u.pm = fm + ((wgid % nig) % gsz); u.pn = (wgid % nig) / gsz; u.which = 0; return true;
    }
    __device__ __forceinline__ const char* a_base(const Gemm& g, const Unit& u, size_t tstep) const { return (const char*)g.A + (size_t)u.pm * tstep; }
    __device__ __forceinline__ const char* b_base(const Gemm& g, const Unit& u, size_t tstep) const { return (const char*)g.Bt + (size_t)u.pn * tstep; }
    __device__ __forceinline__ void a_ready(const Unit&) const {}
    __device__ __forceinline__ void done(const Unit&) const {}
};

__device__ __forceinline__ unsigned cvt_pk_bf16(float lo, float hi) { unsigned r; asm volatile("v_cvt_pk_bf16_f32 %0, %1, %2" : "=v"(r) : "v"(lo), "v"(hi)); return r; }
__device__ __forceinline__ void store16_wt(void* p, u32x4 v) { asm volatile("global_store_dwordx4 %0, %1, off sc1\n\ts_nop 1" :: "v"(p), "v"(v) : "memory"); }
__device__ __forceinline__ void store8_wt(void* p, u32x2 v) { asm volatile("global_store_dwordx2 %0, %1, off sc1\n\ts_nop 1" :: "v"(p), "v"(v) : "memory"); }
typedef float f32x2 __attribute__((ext_vector_type(2)));
__device__ __forceinline__ f32x2 gelu_pk(f32x2 v) {
    const f32x2 av = __builtin_elementwise_abs(v), d = av * 0.2316418882f + 1.0f;
    f32x2 t; t.x = __builtin_amdgcn_rcpf(d.x); t.y = __builtin_amdgcn_rcpf(d.y);
    f32x2 q = t * 0.5307027145f + (-0.7265760135f); q = q * t + 0.7107068705f; q = q * t + (-0.142248368f); q = q * t + 0.127414796f; q = q * t;
    const f32x2 s = (v * v) * (-0.72134752044f);
    f32x2 e; e.x = __builtin_amdgcn_exp2f(s.x); e.y = __builtin_amdgcn_exp2f(s.y);
    const f32x2 m = v * (q * e), r = v - m;
    f32x2 o; o.x = v.x < 0.f ? m.x : r.x; o.y = v.y < 0.f ? m.y : r.y; return o;
}

template <class Epi, class Sched, bool ALIGN_EPI = false, bool SP2 = false>
__device__ __forceinline__ void gemm_phase(PG8_LAS unsigned char* lds, const Gemm g, const Sched& S, const Epi& E) {
    const int tid = threadIdx.x, wid = __builtin_amdgcn_readfirstlane(tid >> 6), lane = tid & 63, wr = wid >> 2, wc = wid & 3, fr = lane & 15, fq = lane >> 4;
    const int K = g.K, nt = K / BK;
    unsigned voffA[2], voffB[2];
#pragma unroll
    for (int i = 0; i < 2; ++i) { int R, C; stage_rc(tid * 16 + i * 8192, R, C); const int Rb = Epi::PERM ? ((R & ~31) + perm32(R & 31)) : R;
        voffA[i] = Sched::AFRAG ? (unsigned)((((((R >> 6) * 4 + (C >> 5)) * 16 + ((R >> 4) & 3) * 2) * 64) + ((C & 31) >> 3) * 16 + (R & 15)) * 16) : (unsigned)(R * K + C) * 2u;
        voffB[i] = (unsigned)(Rb * K + C) * 2u; }
#define PG8_AP(base, h, kt) (Sched::AFRAG ? (base) + ((((size_t)((kt) >> 2) * 8 + ((kt) & 1) * 2) * 16 + (h) * 8 + (((kt) >> 1) & 1)) * 64) * 16 : (base) + (size_t)(h) * hstep + (size_t)(kt) * kstep)
    const size_t kstep = (size_t)(BK * 2);
    const size_t hstep = (size_t)HALF * K * 2;
    const size_t tstep = 2 * hstep;
    const unsigned ldsw = (unsigned)wid * 1024u;
    const int aoff = lds_byte(wr * 64 + fr, fq * 8), boff = lds_byte(wc * 32 + fr, fq * 8);
#define PG8_SA(b, h) (((b) * 2 + (h)) * HTB)
#define PG8_SB(b, h) ((4 + (b) * 2 + (h)) * HTB)
#define PG8_STAGE(bufoff, gbase, voff) do { _Pragma("unroll") for (int _i = 0; _i < 2; ++_i) \
        __builtin_amdgcn_global_load_lds((const unsigned*)((const char*)(gbase) + (voff)[_i]), (PG8_LAS unsigned*)(lds + (bufoff) + ldsw + _i * 8192), 16, 0, 0); } while (0)
#define PG8_LDA(dst, b, h) do { _Pragma("unroll") for (int m = 0; m < 4; ++m) _Pragma("unroll") for (int k = 0; k < 2; ++k) dst[m][k] = *(const PG8_LAS bf16x8*)(lds + PG8_SA(b, h) + aoff + m * 2048 + k * 1024); } while (0)
#define PG8_LDB(dst, b, h) do { _Pragma("unroll") for (int n = 0; n < 2; ++n) _Pragma("unroll") for (int k = 0; k < 2; ++k) dst[n][k] = *(const PG8_LAS bf16x8*)(lds + PG8_SB(b, h) + boff + n * 2048 + k * 1024); } while (0)
#define PG8_MMA(ai, bj, At, Bt) do { __builtin_amdgcn_s_setprio(1); _Pragma("unroll") for (int m = 0; m < 4; ++m) _Pragma("unroll") for (int n = 0; n < 2; ++n) _Pragma("unroll") for (int k = 0; k < 2; ++k) \
        acc[ai][bj][m][n] = __builtin_amdgcn_mfma_f32_16x16x32_bf16(Bt[n][k], At[m][k], acc[ai][bj][m][n], 0, 0, 0); __builtin_amdgcn_s_setprio(0); } while (0)
#define PG8_WAIT_V(n) asm volatile("s_waitcnt vmcnt(" #n ")" ::: "memory")
#define PG8_WAIT_L(n) asm volatile("s_waitcnt lgkmcnt(" #n ")" ::: "memory")
#define PG8_BAR __builtin_amdgcn_s_barrier()
#define PG8_SCHED __builtin_amdgcn_sched_barrier(0)
    Unit cur, nxt; int ui = 0;
    if (!S.next(0, cur)) return;
    f32x4 acc[2][2][4][2];
#pragma unroll
    for (int a = 0; a < 2; ++a)
#pragma unroll
        for (int b = 0; b < 2; ++b)
#pragma unroll
            for (int m = 0; m < 4; ++m)
#pragma unroll
                for (int n = 0; n < 2; ++n) acc[a][b][m][n] = (f32x4){0.f, 0.f, 0.f, 0.f};
    if constexpr (Epi::HAS_INIT) E.init(acc, cur, wr, wc, fr, fq);
    bf16x8 At[4][2], B0[2][2], B1[2][2];
    const char* cA = S.a_base(g, cur, tstep); const char* cB = S.b_base(g, cur, tstep);
    S.a_ready(cur);
    if constexpr (SP2) {
        PG8_STAGE(PG8_SB(0, 0), cB, voffB); PG8_STAGE(PG8_SB(0, 1), cB + hstep, voffB); PG8_STAGE(PG8_SA(0, 0), PG8_AP(cA, 0, 0), voffA); PG8_STAGE(PG8_SA(0, 1), PG8_AP(cA, 1, 0), voffA);
        if (wr == 1) PG8_BAR;
        PG8_WAIT_V(2); PG8_BAR;
        PG8_STAGE(PG8_SB(1, 0), cB + kstep, voffB); PG8_STAGE(PG8_SA(1, 0), PG8_AP(cA, 0, 1), voffA); PG8_STAGE(PG8_SB(1, 1), cB + hstep + kstep, voffB);
        PG8_WAIT_V(6); PG8_BAR;
    } else {
        PG8_STAGE(PG8_SB(0, 0), cB, voffB); PG8_STAGE(PG8_SA(0, 0), PG8_AP(cA, 0, 0), voffA); PG8_STAGE(PG8_SB(0, 1), cB + hstep, voffB); PG8_STAGE(PG8_SA(0, 1), PG8_AP(cA, 1, 0), voffA);
        if (wr == 1) PG8_BAR;
        PG8_WAIT_V(4); PG8_BAR;
        PG8_STAGE(PG8_SB(1, 0), cB + kstep, voffB); PG8_STAGE(PG8_SA(1, 0), PG8_AP(cA, 0, 1), voffA); PG8_STAGE(PG8_SB(1, 1), cB + hstep + kstep, voffB);
        PG8_WAIT_V(6); PG8_BAR;
    }
    for (;;) {
        const bool has_next = S.next(ui + 1, nxt);
        const char* nA = has_next ? S.a_base(g, nxt, tstep) : cA; const char* nB = has_next ? S.b_base(g, nxt, tstep) : cB;
        for (int t = 0; t < nt; t += 2) {
            const bool last = (t == nt - 2);
            const char* a2b = last ? nA : cA; const int a2k = last ? 0 : t + 2; const char* b2 = last ? nB : cB + (size_t)(t + 2) * kstep;
            const char* b3 = b2 + kstep;
            const char* a1h = PG8_AP(cA, 1, t + 1); const char* a2 = PG8_AP(a2b, 0, a2k); const char* a2h = PG8_AP(a2b, 1, a2k); const char* a3 = PG8_AP(a2b, 0, a2k + 1);
            if (last && has_next) S.a_ready(nxt);
            if constexpr (SP2) {
            PG8_LDB(B0, 0, 0); PG8_LDB(B1, 0, 1); PG8_SCHED; PG8_LDA(At, 0, 0); PG8_STAGE(PG8_SA(1, 1), a1h, voffA);
            PG8_WAIT_V(8); PG8_WAIT_L(0); PG8_BAR; PG8_MMA(0, 0, At, B0); PG8_MMA(0, 1, At, B1); PG8_BAR; PG8_SCHED;
            PG8_LDA(At, 0, 1); PG8_STAGE(PG8_SB(0, 0), b2, voffB); PG8_STAGE(PG8_SB(0, 1), b2 + hstep, voffB); PG8_STAGE(PG8_SA(0, 0), a2, voffA);
            PG8_WAIT_V(8); PG8_WAIT_L(0); PG8_BAR; PG8_MMA(1, 0, At, B0); PG8_MMA(1, 1, At, B1); PG8_BAR; PG8_SCHED;
            PG8_LDB(B0, 1, 0); PG8_LDB(B1, 1, 1); PG8_SCHED; PG8_LDA(At, 1, 0); PG8_STAGE(PG8_SA(0, 1), a2h, voffA);
            PG8_WAIT_V(8); PG8_WAIT_L(0); PG8_BAR; PG8_MMA(0, 0, At, B0); PG8_MMA(0, 1, At, B1); PG8_BAR; PG8_SCHED;
            PG8_LDA(At, 1, 1); PG8_STAGE(PG8_SB(1, 0), b3, voffB); PG8_STAGE(PG8_SB(1, 1), b3 + hstep, voffB); PG8_STAGE(PG8_SA(1, 0), a3, voffA);
            PG8_WAIT_V(8); PG8_WAIT_L(0); PG8_BAR; PG8_MMA(1, 0, At, B0); PG8_MMA(1, 1, At, B1); PG8_BAR; PG8_SCHED;
            } else {
            PG8_LDB(B0, 0, 0); PG8_SCHED; PG8_LDA(At, 0, 0); PG8_STAGE(PG8_SA(1, 1), a1h, voffA);
            PG8_WAIT_L(8); PG8_BAR; PG8_WAIT_L(0); PG8_MMA(0, 0, At, B0); PG8_BAR; PG8_SCHED;
            PG8_LDB(B1, 0, 1); PG8_STAGE(PG8_SB(0, 0), b2, voffB);
            PG8_BAR; PG8_WAIT_L(0); PG8_MMA(0, 1, At, B1); PG8_BAR;
            PG8_LDA(At, 0, 1); PG8_STAGE(PG8_SA(0, 0), a2, voffA);
            PG8_BAR; PG8_WAIT_L(0); PG8_MMA(1, 0, At, B0); PG8_BAR; PG8_SCHED;
            PG8_STAGE(PG8_SB(0, 1), b2 + hstep, voffB);
            PG8_WAIT_V(6); PG8_BAR; PG8_MMA(1, 1, At, B1); PG8_BAR;
            PG8_LDB(B0, 1, 0); PG8_SCHED; PG8_LDA(At, 1, 0); PG8_STAGE(PG8_SA(0, 1), a2h, voffA);
            PG8_WAIT_L(8); PG8_BAR; PG8_WAIT_L(0); PG8_MMA(0, 0, At, B0); PG8_BAR; PG8_SCHED;
            PG8_LDB(B1, 1, 1); PG8_STAGE(PG8_SB(1, 0), b3, voffB);
            PG8_BAR; PG8_WAIT_L(0); PG8_MMA(0, 1, At, B1); PG8_BAR;
            PG8_LDA(At, 1, 1); PG8_STAGE(PG8_SA(1, 0), a3, voffA);
            PG8_BAR; PG8_WAIT_L(0); PG8_MMA(1, 0, At, B0); PG8_BAR; PG8_SCHED;
            PG8_STAGE(PG8_SB(1, 1), b3 + hstep, voffB);
            PG8_WAIT_V(6); PG8_BAR; PG8_MMA(1, 1, At, B1); PG8_BAR;
            }
        }
        if constexpr (ALIGN_EPI) { if (wr == 0) PG8_BAR; }
        if constexpr (!Epi::AFTER_DRAIN) { E(acc, cur, wr, wc, fr, fq); S.done(cur); }
        if (!has_next) break;
#pragma unroll
        for (int a = 0; a < 2; ++a)
#pragma unroll
            for (int b = 0; b < 2; ++b)
#pragma unroll
                for (int m = 0; m < 4; ++m)
#pragma unroll
                    for (int n = 0; n < 2; ++n) acc[a][b][m][n] = (f32x4){0.f, 0.f, 0.f, 0.f};
        if constexpr (Epi::HAS_INIT) E.init(acc, nxt, wr, wc, fr, fq);
        cur = nxt; cA = nA; cB = nB; ++ui;
        if constexpr (ALIGN_EPI) { if (wr == 1) PG8_BAR; }
    }
    PG8_WAIT_V(0);
    if constexpr (!ALIGN_EPI) { if (wr == 0) PG8_BAR; }
    PG8_BAR;
    if constexpr (Epi::AFTER_DRAIN) { E.fused(acc, cur, wr, wc, fr, fq, lds, wid, lane); S.done(cur); }
#undef PG8_AP
#undef PG8_SA
#undef PG8_SB
#undef PG8_STAGE
#undef PG8_LDA
#undef PG8_LDB
#undef PG8_MMA
#undef PG8_WAIT_V
#undef PG8_WAIT_L
#undef PG8_BAR
#undef PG8_SCHED
}
}

#ifndef PG8_SP2
#define PG8_SP2 true
#endif
#ifndef PG8_ALIGN
#define PG8_ALIGN true
#endif
#ifndef MK_ONE_LAUNCH
#define MK_ONE_LAUNCH 1
#endif

constexpr int NWAVES = 8;
constexpr int T = 32768, D = 1024, SEQ = 4096;
constexpr int IN_DIM = 4352, PA_W = 2304, G_W = 2048;
constexpr int C_U = 0, C_B = 512, C_C = 1024, C_Q = 1536, C_K = 2048, C_V = 2176;
constexpr int CONV = 512, HD = 64, NH = 8, NKV = 2;
constexpr int PH = 8, NKEYS = 128, PQ = 2048, TOPK = 16, NEXP = 16384, NSEL = 128;
constexpr float EPS = 1e-6f;
constexpr int N_PHASES = 10;

constexpr size_t MiB = 1u << 20;
constexpr size_t WS_CTL = 0, CTL_ZERO_BYTES = 1 * MiB;
constexpr size_t WS_WIN = 2 * MiB;
constexpr size_t WS_WC = 11 * MiB;
constexpr size_t WS_WA = 12 * MiB;
constexpr size_t WS_WO = 13 * MiB;
constexpr size_t WS_WQ = 15 * MiB;
constexpr size_t WS_SK = 19 * MiB;
constexpr size_t WS_RSTD1 = 20 * MiB;
constexpr size_t WS_SSQ = 21 * MiB;
constexpr size_t WS_UB = 24 * MiB;
constexpr size_t WS_SU = 32 * MiB;
constexpr size_t WS_VB = 40 * MiB;
constexpr size_t WS_SV = 48 * MiB;
constexpr size_t WS_XB8 = 56 * MiB;
constexpr size_t WS_XB = 88 * MiB;
constexpr size_t WS_PA = 152 * MiB;
constexpr size_t WS_MIX = WS_PA;
constexpr size_t WS_G = 296 * MiB;
constexpr size_t WS_QP = WS_G;
constexpr size_t WS_Z = 424 * MiB;
constexpr size_t WS_ATT = 456 * MiB;
constexpr size_t WS_IDX = WS_Z, WS_GATE = WS_ATT;
constexpr size_t WS_PART = WS_PA;
constexpr size_t WS_ACT = WS_G;
constexpr size_t WS_END = 488 * MiB;
constexpr int CW_BAR = 4096;

constexpr int RING_OFF = 0, RING_BYTES = 131072;
constexpr int LDSCTL_OFF = 147456, MISC_OFF = LDSCTL_OFF + 320;
constexpr int LDS_BYTES = 148480;
#define GAS __attribute__((address_space(1)))
#define LAS __attribute__((address_space(3)))
typedef unsigned short bf16;
typedef unsigned v4u __attribute__((ext_vector_type(4)));
typedef float f32x4 __attribute__((ext_vector_type(4)));
typedef short bf16x8 __attribute__((ext_vector_type(8)));
typedef GAS unsigned gu32;
typedef GAS unsigned long long gu64;
#define RLX_AGENT __ATOMIC_RELAXED, __HIP_MEMORY_SCOPE_AGENT
#define LDS_WAIT() asm volatile("s_waitcnt lgkmcnt(0)" ::: "memory")
#define VM_WAIT() asm volatile("s_waitcnt vmcnt(0)" ::: "memory")
__device__ __forceinline__ unsigned long long rt() { return __builtin_amdgcn_s_memrealtime(); }
__device__ __forceinline__ unsigned f2bf(float f) { unsigned u = __builtin_bit_cast(unsigned, f); return (u + 0x7fffu + ((u >> 16) & 1u)) >> 16; }
__device__ __forceinline__ unsigned pk2(float lo, float hi) { return f2bf(lo) | (f2bf(hi) << 16); }

#define XB_TMO      128
#define XB_XCNT(j)  (256  + 64 * (j))
#define XB_XSUB(j)  (1280 + 64 * (j))
#define XB_XGEN(j)  (2304 + 64 * (j))
#define XB_TOP      3328
#define XB_TOPGEN   3392
#define XCD_BAR_WORDS 3456
#define XB_SPIN_CAP (1u << 18)

__device__ __forceinline__ unsigned xb_ld(unsigned* p)              { return __hip_atomic_load(p, __ATOMIC_RELAXED, __HIP_MEMORY_SCOPE_AGENT); }
__device__ __forceinline__ unsigned xb_add(unsigned* p, unsigned v) { return __hip_atomic_fetch_add(p, v, __ATOMIC_RELAXED, __HIP_MEMORY_SCOPE_AGENT); }
__device__ __forceinline__ unsigned xb_xcc_id() { return (unsigned)__builtin_amdgcn_s_getreg((3 << 11) | 20) & 0xFu; }
#define XB_SPIN(cond, bar) do { unsigned _sp = 0; while (cond) { __builtin_amdgcn_s_sleep(1); \
    if ((++_sp & 255u) == 0u) { if (xb_ld(&(bar)[XB_TMO])) break; if (_sp > XB_SPIN_CAP) { atomicAdd(&(bar)[XB_TMO], 1u); break; } } } } while (0)

struct XcdBarrier {
    unsigned* bar; unsigned x;
    volatile LAS unsigned* st;
};

__device__ __forceinline__ XcdBarrier xcd_barrier_post(unsigned* bar, volatile LAS unsigned* st) {
    XcdBarrier b; b.bar = bar; b.x = xb_xcc_id(); b.st = st;
    if (threadIdx.x == 0) st[2] = xb_add(&bar[XB_XCNT(b.x)], 1u);
    return b;
}
__device__ __forceinline__ void xcd_barrier_complete(unsigned* bar, unsigned x, unsigned& nloc, unsigned& nx) {
    const unsigned G = gridDim.x * gridDim.y * gridDim.z;
    unsigned sum, cnt, mine, sp = 0u;
    for (;;) {
        sum = 0u; cnt = 0u; mine = 0u;
#pragma unroll
        for (unsigned j = 0; j < 16; ++j) { const unsigned c = xb_ld(&bar[XB_XCNT(j)]); sum += c; cnt += (c > 0u) ? 1u : 0u; mine = (j == x) ? c : mine; }
        if (sum == G) break;
        __builtin_amdgcn_s_sleep(1);
        if ((++sp & 255u) == 0u) { if (xb_ld(&bar[XB_TMO])) break; if (sp > XB_SPIN_CAP) { atomicAdd(&bar[XB_TMO], 1u); break; } }
    }
    nloc = mine > 0u ? mine : 1u; nx = cnt > 0u ? cnt : 1u;
}

__device__ __forceinline__ void xcd_barrier(const XcdBarrier& b) {
    asm volatile("s_waitcnt vmcnt(0)" ::: "memory");
    __syncthreads();
    if (threadIdx.x == 0) {
        unsigned* bar = b.bar;
        __builtin_amdgcn_s_waitcnt(0);
        unsigned nloc = b.st[0], nx = b.st[1];
        if (nloc == 0u) { xcd_barrier_complete(bar, b.x, nloc, nx); b.st[0] = nloc; b.st[1] = nx; }
        const unsigned old = xb_add(&bar[XB_XSUB(b.x)], 1u);
        const unsigned gen = old / nloc;
        if (old + 1u == (gen + 1u) * nloc) {
            __builtin_amdgcn_fence(__ATOMIC_RELEASE, "agent");
            asm volatile("s_waitcnt vmcnt(0)" ::: "memory");
            const unsigned og = xb_add(&bar[XB_TOP], 1u);
            const unsigned tg = og / nx;
            if (og + 1u == (tg + 1u) * nx) xb_add(&bar[XB_TOPGEN], 1u);
            else XB_SPIN(xb_ld(&bar[XB_TOPGEN]) == tg, bar);
            __builtin_amdgcn_fence(__ATOMIC_ACQUIRE, "agent");
            xb_add(&bar[XB_XGEN(b.x)], 1u);
            asm volatile("s_waitcnt vmcnt(0)" ::: "memory");
        } else {
            XB_SPIN(xb_ld(&bar[XB_XGEN(b.x)]) == gen, bar);
            __builtin_amdgcn_fence(__ATOMIC_ACQUIRE, "agent");
            asm volatile("s_waitcnt vmcnt(0)" ::: "memory");
        }
    }
    __syncthreads();
}

typedef float f32x16 __attribute__((ext_vector_type(16)));
typedef unsigned v2u __attribute__((ext_vector_type(2)));
typedef int v4i __attribute__((ext_vector_type(4)));
typedef __bf16 bf2_t __attribute__((ext_vector_type(2)));
#define DI __device__ __forceinline__
struct Frame {
    LAS unsigned char* lds;
    volatile LAS unsigned* MISC;
    gu32* ctl;
    int tid, lane, wave, vcu, G;
    const float *x, *norm_mix, *norm_ffn, *w_in, *b_gate, *w_conv, *q_norm, *k_norm, *sinks, *rel_bias, *w_conv_out, *w_attn_out, *w_out, *w_query, *sub_keys, *expert_u, *expert_v;
    float* out;
    bf16 *WIN, *WC, *WA, *WO, *WQ, *SK, *UB, *VB, *XB, *PA, *MIX, *G_, *QP, *Z, *ATT;
    float *RSTD1, *SSQ, *GATE, *ACT, *SU, *SV; bf16* PARTB; unsigned char* XB8; unsigned short* IDX;
};
DI float wave_sum(float v) {
#pragma unroll
    for (int o = 1; o < 64; o <<= 1) v += __shfl_xor(v, o);
    return v;
}
DI float bf_lo(unsigned u) { return __builtin_bit_cast(float, u << 16); }
DI float bf_hi(unsigned u) { return __builtin_bit_cast(float, u & 0xffff0000u); }

DI void p0_transpose_item(const float* W, int K, int N, bf16* WT, const float* gsc, LAS float* scr, int item, int lane) {
    const int nblk = N / 32, kb = item / nblk, nb = item % nblk, k0 = 64 * kb, n0 = 32 * nb;
#pragma unroll 8
    for (int i = 0; i < 32; ++i) { const int kk = 2 * i + (lane >> 5); float v = W[(size_t)(k0 + kk) * N + n0 + (lane & 31)]; if (gsc) v *= gsc[k0 + kk]; scr[kk * 33 + (lane & 31)] = v; }
    LDS_WAIT(); asm volatile("" ::: "memory");
    const int c = lane & 7;
#pragma unroll
    for (int j = 0; j < 4; ++j) { const int n = (lane >> 3) + 8 * j; const LAS float* s = scr + (8 * c) * 33 + n;
        v4u o; o.x = pk2(s[0 * 33], s[1 * 33]); o.y = pk2(s[2 * 33], s[3 * 33]); o.z = pk2(s[4 * 33], s[5 * 33]); o.w = pk2(s[6 * 33], s[7 * 33]);
        *(GAS v4u*)(WT + (size_t)(n0 + n) * K + k0 + 8 * c) = o; }
    LDS_WAIT(); asm volatile("" ::: "memory");
}
DI void p0_convert(Frame& F, const float* src, bf16* dst, size_t n, const float* colscale) {
    const size_t n8 = n / 8, stride = (size_t)F.G * NWAVES * 64;
    for (size_t i = (size_t)F.vcu * NWAVES * 64 + F.tid; i < n8; i += stride) {
        f32x4 a = *(const GAS f32x4*)(src + i * 8), b = *(const GAS f32x4*)(src + i * 8 + 4);
        if (colscale) { const int c = (int)((i * 8) & 1023); const f32x4 s0 = *(const GAS f32x4*)(colscale + c), s1 = *(const GAS f32x4*)(colscale + c + 4); a = a * s0; b = b * s1; }
        v4u o; o.x = pk2(a.x, a.y); o.y = pk2(a.z, a.w); o.z = pk2(b.x, b.y); o.w = pk2(b.z, b.w);
        *(GAS v4u*)(dst + i * 8) = o;
    }
}
constexpr float A_SCALE = 128.f;
DI unsigned pk4_fp8(f32x4 v) { int r = 0; r = __builtin_amdgcn_cvt_pk_fp8_f32(v[0], v[1], r, false); r = __builtin_amdgcn_cvt_pk_fp8_f32(v[2], v[3], r, true); return (unsigned)r; }
DI void p0_convert_fp8(Frame& F, const float* src, unsigned char* dst, size_t n, const float* colscale, float scale, int bidx, int nblk) {
    const int gw = bidx * NWAVES + F.wave, NGW = nblk * NWAVES, lane = F.lane;
    f32x4 cs[4];
#pragma unroll
    for (int q = 0; q < 4; ++q) cs[q] = colscale ? *(const GAS f32x4*)(colscale + 4 * lane + 256 * q) * scale : (f32x4){scale, scale, scale, scale};
    const int nrows = (int)(n / D);
    for (int e = gw; e < nrows; e += NGW) {
        const GAS f32x4* rp = (const GAS f32x4*)(src + (size_t)e * D) + lane;
        f32x4 v[4];
#pragma unroll
        for (int q = 0; q < 4; ++q) v[q] = rp[64 * q];
#pragma unroll
        for (int q = 0; q < 4; ++q) *(GAS unsigned*)(dst + ((size_t)(2 * q + (lane >> 5)) * NEXP + e) * 128 + ((4 * lane) & 127)) = pk4_fp8(v[q] * cs[q]);
    }
}
DI void p0_convert_fp4(Frame& F, const float* src, const float* gain, unsigned char* dst, float* scl, int e0, int e1) {
    const int gw = F.wave, NGW = NWAVES, lane = F.lane;
    f32x4 cs[4];
#pragma unroll
    for (int q = 0; q < 4; ++q) cs[q] = gain ? *(const GAS f32x4*)(gain + 4 * lane + 256 * q) : (f32x4){1.f, 1.f, 1.f, 1.f};
    for (int e = e0 + gw; e < e1; e += NGW) {
        const GAS f32x4* rp = (const GAS f32x4*)(src + (size_t)e * D) + lane;
        f32x4 v[4]; float mx = 0.f;
#pragma unroll
        for (int q = 0; q < 4; ++q) { v[q] = rp[64 * q] * cs[q]; mx = fmaxf(mx, fmaxf(fmaxf(fabsf(v[q][0]), fabsf(v[q][1])), fmaxf(fabsf(v[q][2]), fabsf(v[q][3])))); }
#pragma unroll
        for (int o = 1; o < 64; o <<= 1) mx = fmaxf(mx, __shfl_xor(mx, o));
        const float inv = mx > 0.f ? 6.f / mx : 0.f;
        if (lane == 0) scl[e] = mx * (1.f / 6.f);
#pragma unroll
        for (int q = 0; q < 4; ++q) { unsigned r = 0u;
            r = __builtin_amdgcn_cvt_scalef32_pk_fp4_f32(r, v[q][0] * inv, v[q][1] * inv, 1.0f, 0);
            r = __builtin_amdgcn_cvt_scalef32_pk_fp4_f32(r, v[q][2] * inv, v[q][3] * inv, 1.0f, 1);
            *(GAS unsigned short*)(dst + ((size_t)q * NEXP + e) * 128 + 2 * lane) = (unsigned short)r; }
    }
}
template <int RB> DI void p0_rows(Frame& F, const float* xrow, bf16* orow) {
    f32x4 v[RB][4]; float s[RB];
#pragma unroll
    for (int r = 0; r < RB; ++r) { const GAS f32x4* xr = (const GAS f32x4*)(xrow + (size_t)r * D) + F.lane;
#pragma unroll
        for (int j = 0; j < 4; ++j) v[r][j] = xr[64 * j]; }
#pragma unroll
    for (int r = 0; r < RB; ++r) { s[r] = 0.f;
#pragma unroll
        for (int j = 0; j < 4; ++j) s[r] += (v[r][j].x * v[r][j].x + v[r][j].y * v[r][j].y) + (v[r][j].z * v[r][j].z + v[r][j].w * v[r][j].w); }
#pragma unroll
    for (int o = 1; o < 64; o <<= 1)
#pragma unroll
        for (int r = 0; r < RB; ++r) s[r] += __shfl_xor(s[r], o);
#pragma unroll
    for (int r = 0; r < RB; ++r) { const float rs = 1.f / sqrtf(s[r] * (1.f / D) + EPS);
        GAS unsigned long long* o8 = (GAS unsigned long long*)(orow + (size_t)r * D) + F.lane;
#pragma unroll
        for (int j = 0; j < 4; ++j) o8[64 * j] = (unsigned long long)pk2(v[r][j].x * rs, v[r][j].y * rs) | ((unsigned long long)pk2(v[r][j].z * rs, v[r][j].w * rs) << 32); }
}
DI void p0_prologue(Frame& F) {
    LAS float* scr = (LAS float*)(F.lds + RING_OFF + F.wave * 16384);
    const int gw = F.vcu * NWAVES + F.wave, NGW = F.G * NWAVES;
    constexpr int I_IN = (D / 64) * (IN_DIM / 32), I_C = (CONV / 64) * (D / 32), I_O = (D / 64) * (D / 32), I_Q = (D / 64) * (PQ / 32);
    constexpr int NITEMS = I_IN + 2 * I_C + I_O + I_Q;
    for (int it = gw; it < NITEMS; it += NGW) {
        int r = it;
        if (r < I_IN) { p0_transpose_item(F.w_in, D, IN_DIM, F.WIN, F.norm_mix, scr, r, F.lane); continue; } r -= I_IN;
        if (r < I_C) { p0_transpose_item(F.w_conv_out, CONV, D, F.WC, nullptr, scr, r, F.lane); continue; } r -= I_C;
        if (r < I_C) { p0_transpose_item(F.w_attn_out, CONV, D, F.WA, nullptr, scr, r, F.lane); continue; } r -= I_C;
        if (r < I_O) { p0_transpose_item(F.w_out, D, D, F.WO, nullptr, scr, r, F.lane); continue; } r -= I_O;
        p0_transpose_item(F.w_query, D, PQ, F.WQ, F.norm_ffn, scr, r, F.lane);
    }
    p0_convert(F, F.sub_keys, F.SK, (size_t)PH * 2 * NKEYS * 128, nullptr);
    for (int m = 4 * gw; m < T; m += 4 * NGW) p0_rows<4>(F, F.x + (size_t)m * D, F.XB + (size_t)m * D);
}

namespace pg8 {
DI float sigmoidf_(float v) { return __builtin_amdgcn_rcpf(1.f + __expf(-v)); }
DI size_t frag_off(int pm, int pn, int NT, int wave, int q, int lane) { return (((((size_t)pm * NT + pn) * 8 + wave) * 16 + q) * 64 + lane) * 8; }
struct EpiProj {
    static constexpr bool PERM = true, AFTER_DRAIN = false, HAS_INIT = false;
    bf16_t* PA; bf16_t* G; const PG8_LAS float* bgl;
    DI void operator()(const f32x4 (&acc)[2][2][4][2], const Unit& u, int wr, int wc, int fr, int fq) const {
        const int row0 = u.pm * BM + wr * 64 + fr; const bool gate = u.pn >= 9;
        const int col0 = (gate ? (u.pn - 9) : u.pn) * BM + wc * 32 + 8 * fq;
        if (!gate) {
#pragma unroll
            for (int ai = 0; ai < 2; ++ai)
#pragma unroll
                for (int m = 0; m < 4; ++m) { bf16_t* rowp = PA + (size_t)(row0 + ai * HALF + m * 16) * PA_W + col0;
#pragma unroll
                    for (int bj = 0; bj < 2; ++bj) { const f32x4 v0 = acc[ai][bj][m][0], v1 = acc[ai][bj][m][1];
                        u32x4 w; w.x = cvt_pk_bf16(v0[0], v0[1]); w.y = cvt_pk_bf16(v0[2], v0[3]); w.z = cvt_pk_bf16(v1[0], v1[1]); w.w = cvt_pk_bf16(v1[2], v1[3]);
                        store16_wt(rowp + bj * HALF, w); } }
        } else {
            f32x4 bv[2][2];
#pragma unroll
            for (int bj = 0; bj < 2; ++bj)
#pragma unroll
                for (int n = 0; n < 2; ++n) bv[bj][n] = *(const PG8_LAS f32x4*)(bgl + col0 + bj * HALF + 4 * n);
#pragma unroll
            for (int ai = 0; ai < 2; ++ai)
#pragma unroll
                for (int m = 0; m < 4; ++m)
#pragma unroll
                    for (int bj = 0; bj < 2; ++bj) { f32x4 v0 = acc[ai][bj][m][0] + bv[bj][0], v1 = acc[ai][bj][m][1] + bv[bj][1];
#pragma unroll
                        for (int j = 0; j < 4; ++j) { v0[j] = sigmoidf_(v0[j]) * 255.f; v1[j] = sigmoidf_(v1[j]) * 255.f; }
                        unsigned g0 = 0u, g1 = 0u;
                        g0 = __builtin_amdgcn_cvt_pk_u8_f32(v0[0], 0, g0); g0 = __builtin_amdgcn_cvt_pk_u8_f32(v0[1], 1, g0); g0 = __builtin_amdgcn_cvt_pk_u8_f32(v0[2], 2, g0); g0 = __builtin_amdgcn_cvt_pk_u8_f32(v0[3], 3, g0);
                        g1 = __builtin_amdgcn_cvt_pk_u8_f32(v1[0], 0, g1); g1 = __builtin_amdgcn_cvt_pk_u8_f32(v1[1], 1, g1); g1 = __builtin_amdgcn_cvt_pk_u8_f32(v1[2], 2, g1); g1 = __builtin_amdgcn_cvt_pk_u8_f32(v1[3], 3, g1);
                        u32x2 gw; gw.x = g0; gw.y = g1;
                        *(u32x2*)((unsigned char*)G + frag_off(u.pm, u.pn - 9, 8, wr * 4 + wc, ai * 8 + m * 2 + bj, fq * 16 + fr)) = gw; }
        }
    }
};
struct EpiMix {
    static constexpr bool PERM = true, AFTER_DRAIN = false, HAS_INIT = false;
    bf16_t* MIX; const bf16_t* G;
    DI void operator()(const f32x4 (&acc)[2][2][4][2], const Unit& u, int wr, int wc, int fr, int fq) const {
        const int wave = wr * 4 + wc, lane = fq * 16 + fr;
        const unsigned char* gp = (const unsigned char*)G + frag_off(u.pm, u.pn + (u.which ? 4 : 0), 8, wave, 0, lane); bf16_t* mp = MIX + frag_off(u.pm, u.pn, 4, wave, 0, lane);
#pragma unroll
        for (int ai = 0; ai < 2; ++ai) {
            u32x2 gv[8]; u32x4 ov[8];
#pragma unroll
            for (int q = 0; q < 8; ++q) gv[q] = *(const u32x2*)(gp + (ai * 8 + q) * 512);
            if (u.which) {
#pragma unroll
                for (int q = 0; q < 8; ++q) ov[q] = *(const u32x4*)(mp + (ai * 8 + q) * 512); }
#pragma unroll
            for (int m = 0; m < 4; ++m)
#pragma unroll
                for (int bj = 0; bj < 2; ++bj) { const int q = m * 2 + bj; const u32x2 g2 = gv[q]; constexpr float GI = 1.f / 255.f;
                    f32x4 v0 = acc[ai][bj][m][0], v1 = acc[ai][bj][m][1];
                    v0[0] *= (float)(g2.x & 0xffu) * GI; v0[1] *= (float)((g2.x >> 8) & 0xffu) * GI; v0[2] *= (float)((g2.x >> 16) & 0xffu) * GI; v0[3] *= (float)(g2.x >> 24) * GI;
                    v1[0] *= (float)(g2.y & 0xffu) * GI; v1[1] *= (float)((g2.y >> 8) & 0xffu) * GI; v1[2] *= (float)((g2.y >> 16) & 0xffu) * GI; v1[3] *= (float)(g2.y >> 24) * GI;
                    if (u.which) { const u32x4 o = ov[q];
                        v0[0] += __builtin_bit_cast(float, o.x << 16); v0[1] += __builtin_bit_cast(float, o.x & 0xffff0000u); v0[2] += __builtin_bit_cast(float, o.y << 16); v0[3] += __builtin_bit_cast(float, o.y & 0xffff0000u);
                        v1[0] += __builtin_bit_cast(float, o.z << 16); v1[1] += __builtin_bit_cast(float, o.z & 0xffff0000u); v1[2] += __builtin_bit_cast(float, o.w << 16); v1[3] += __builtin_bit_cast(float, o.w & 0xffff0000u); }
                    u32x4 w; w.x = cvt_pk_bf16(v0[0], v0[1]); w.y = cvt_pk_bf16(v0[2], v0[3]); w.z = cvt_pk_bf16(v1[0], v1[1]); w.w = cvt_pk_bf16(v1[2], v1[3]);
                    if (u.which) store16_wt(mp + (ai * 8 + q) * 512, w); else *(u32x4*)(mp + (ai * 8 + q) * 512) = w; }
        }
    }
};
struct FragOrder : StaticOrder { static constexpr bool AFRAG = true; };
struct PairOrder : StaticOrder {
    __device__ bool next(int i, Unit& u) const { const bool ok = StaticOrder::next(i >> 1, u); u.which = i & 1; return ok; }
    DI const char* a_base(const Gemm& g, const Unit& u, size_t tstep) const { return (const char*)(u.which ? g.A2 : g.A) + (size_t)u.pm * tstep; }
    DI const char* b_base(const Gemm& g, const Unit& u, size_t tstep) const { return (const char*)(u.which ? g.Bt2 : g.Bt) + (size_t)u.pn * tstep; }
};
struct EpiX1 {
    static constexpr bool PERM = true, AFTER_DRAIN = false, HAS_INIT = true;
    const float* x; bf16_t* XB; float* SSQ; unsigned char* XB8;
    DI void init(f32x4 (&acc)[2][2][4][2], const Unit& u, int wr, int wc, int fr, int fq) const {
        const int row0 = u.pm * BM + wr * 64 + fr, col0 = u.pn * BM + wc * 32 + 8 * fq;
#pragma unroll
        for (int ai = 0; ai < 2; ++ai)
#pragma unroll
            for (int m = 0; m < 4; ++m)
#pragma unroll
                for (int bj = 0; bj < 2; ++bj)
#pragma unroll
                    for (int n = 0; n < 2; ++n) acc[ai][bj][m][n] = *(const f32x4*)(x + (size_t)(row0 + ai * HALF + m * 16) * D + col0 + bj * HALF + 4 * n);
    }
    DI void operator()(const f32x4 (&acc)[2][2][4][2], const Unit& u, int wr, int wc, int fr, int fq) const {
        const int row0 = u.pm * BM + wr * 64 + fr, col0 = u.pn * BM + wc * 32 + 8 * fq;
#pragma unroll
        for (int ai = 0; ai < 2; ++ai)
#pragma unroll
            for (int m = 0; m < 4; ++m) { const int row = row0 + ai * HALF + m * 16; float ss = 0.f;
#pragma unroll
                for (int bj = 0; bj < 2; ++bj) { const f32x4 v0 = acc[ai][bj][m][0], v1 = acc[ai][bj][m][1];
                    ss += ((v0[0] * v0[0] + v0[1] * v0[1]) + (v0[2] * v0[2] + v0[3] * v0[3])) + ((v1[0] * v1[0] + v1[1] * v1[1]) + (v1[2] * v1[2] + v1[3] * v1[3]));
                    u32x4 w; w.x = cvt_pk_bf16(v0[0], v0[1]); w.y = cvt_pk_bf16(v0[2], v0[3]); w.z = cvt_pk_bf16(v1[0], v1[1]); w.w = cvt_pk_bf16(v1[2], v1[3]);
                    store16_wt(XB + (size_t)row * D + col0 + bj * HALF, w);
                    { int p0_ = 0, p1_ = 0;
                      p0_ = __builtin_amdgcn_cvt_pk_fp8_f32(v0[0], v0[1], p0_, false); p0_ = __builtin_amdgcn_cvt_pk_fp8_f32(v0[2], v0[3], p0_, true);
                      p1_ = __builtin_amdgcn_cvt_pk_fp8_f32(v1[0], v1[1], p1_, false); p1_ = __builtin_amdgcn_cvt_pk_fp8_f32(v1[2], v1[3], p1_, true);
                      u32x2 w8; w8.x = (unsigned)p0_; w8.y = (unsigned)p1_; *(u32x2*)(XB8 + (size_t)row * D + col0 + bj * HALF) = w8; } }
                ss += __shfl_xor(ss, 16); ss += __shfl_xor(ss, 32);
                if (fq == 0) SSQ[(size_t)row * 16 + u.pn * 4 + wc] = ss; }
    }
};
DI float rstd2_of(const float* SSQ, int row) {
    const f32x4 a = *(const f32x4*)(SSQ + (size_t)row * 16), b = *(const f32x4*)(SSQ + (size_t)row * 16 + 4), c = *(const f32x4*)(SSQ + (size_t)row * 16 + 8), d = *(const f32x4*)(SSQ + (size_t)row * 16 + 12);
    const float s = ((a[0] + a[1]) + (a[2] + a[3])) + ((b[0] + b[1]) + (b[2] + b[3])) + ((c[0] + c[1]) + (c[2] + c[3])) + ((d[0] + d[1]) + (d[2] + d[3]));
    return 1.f / sqrtf(s * (1.f / D) + EPS);
}
struct EpiQP {
    static constexpr bool PERM = true, AFTER_DRAIN = false, HAS_INIT = false;
    bf16_t* QP;
    DI void operator()(const f32x4 (&acc)[2][2][4][2], const Unit& u, int wr, int wc, int fr, int fq) const {
        const int row0 = u.pm * BM + wr * 64 + fr, col0 = u.pn * BM + wc * 32 + 8 * fq;
#pragma unroll
        for (int ai = 0; ai < 2; ++ai)
#pragma unroll
            for (int m = 0; m < 4; ++m) {
#pragma unroll
                for (int bj = 0; bj < 2; ++bj) { const f32x4 v0 = acc[ai][bj][m][0], v1 = acc[ai][bj][m][1];
                    u32x4 w; w.x = cvt_pk_bf16(v0[0], v0[1]); w.y = cvt_pk_bf16(v0[2], v0[3]); w.z = cvt_pk_bf16(v1[0], v1[1]); w.w = cvt_pk_bf16(v1[2], v1[3]);
                    *(u32x4*)(QP + frag_off(u.pm, u.pn, 8, wr * 4 + wc, ai * 8 + m * 2 + bj, fq * 16 + fr)) = w; } }
    }
};
}

#define MFMA32(a, b, c) __builtin_amdgcn_mfma_f32_32x32x16_bf16((a), (b), (c), 0, 0, 0)
DI void p2_conv(Frame& F) {
    constexpr int CT = 4;
    const size_t NT_ = (size_t)F.G * NWAVES * 64;
    for (size_t item = (size_t)F.vcu * NWAVES * 64 + F.tid; item < (size_t)(T / CT) * 64; item += NT_) {
        const int tb = (int)(item >> 6) * CT, c0 = (int)(item & 63) * 8, tl = tb & (SEQ - 1);
        v4u cg[CT + 2], uu[CT + 2], bg[CT];
#pragma unroll
        for (int r = 0; r < CT + 2; ++r) { const bool ok = (tl + r - 2) >= 0; const bf16* rowp = F.PA + (size_t)(tb + (ok ? r - 2 : 0)) * PA_W;
            cg[r] = *(const GAS v4u*)(rowp + C_C + c0); uu[r] = *(const GAS v4u*)(rowp + C_U + c0);
            if (!ok) { cg[r] = (v4u){0u, 0u, 0u, 0u}; } }
#pragma unroll
        for (int r = 0; r < CT; ++r) bg[r] = *(const GAS v4u*)(F.PA + (size_t)(tb + r) * PA_W + C_B + c0);
        f32x4 w[3][2];
#pragma unroll
        for (int j = 0; j < 3; ++j) { w[j][0] = *(const GAS f32x4*)(F.w_conv + j * CONV + c0); w[j][1] = *(const GAS f32x4*)(F.w_conv + j * CONV + c0 + 4); }
        float h[CT + 2][8];
#pragma unroll
        for (int r = 0; r < CT + 2; ++r) { h[r][0] = bf_lo(cg[r].x) * bf_lo(uu[r].x); h[r][1] = bf_hi(cg[r].x) * bf_hi(uu[r].x); h[r][2] = bf_lo(cg[r].y) * bf_lo(uu[r].y); h[r][3] = bf_hi(cg[r].y) * bf_hi(uu[r].y);
            h[r][4] = bf_lo(cg[r].z) * bf_lo(uu[r].z); h[r][5] = bf_hi(cg[r].z) * bf_hi(uu[r].z); h[r][6] = bf_lo(cg[r].w) * bf_lo(uu[r].w); h[r][7] = bf_hi(cg[r].w) * bf_hi(uu[r].w); }
#pragma unroll
        for (int r = 0; r < CT; ++r) {
            float a[8];
#pragma unroll
            for (int e = 0; e < 8; ++e) a[e] = w[0][e >> 2][e & 3] * h[r][e] + w[1][e >> 2][e & 3] * h[r + 1][e] + w[2][e >> 2][e & 3] * h[r + 2][e];
            v4u o; o.x = pk2(a[0] * bf_lo(bg[r].x), a[1] * bf_hi(bg[r].x)); o.y = pk2(a[2] * bf_lo(bg[r].y), a[3] * bf_hi(bg[r].y));
            o.z = pk2(a[4] * bf_lo(bg[r].z), a[5] * bf_hi(bg[r].z)); o.w = pk2(a[6] * bf_lo(bg[r].w), a[7] * bf_hi(bg[r].w));
            *(GAS v4u*)(F.Z + (size_t)(tb + r) * CONV + c0) = o;
        }
    }
}
DI int t5_bucket(int d) {
    if (d < 16) return d;
    const int large = 16 + (int)(logf((float)d / 16.f) / logf(8.f) * 16.f);
    return large < 31 ? large : 31;
}
constexpr int KS_STRIDE = 72, VT_STRIDE = 264;
constexpr int ATT_KS = 0, ATT_VT = 256 * KS_STRIDE * 2, ATT_BIAS = ATT_VT + 64 * VT_STRIDE * 2, ATT_END = ATT_BIAS + 4 * 128 * 4;
static_assert(ATT_END <= RING_BYTES, "attention LDS");
DI void p2_attention(Frame& F) {
    LAS bf16* KS = (LAS bf16*)(F.lds + ATT_KS); LAS bf16* VT = (LAS bf16*)(F.lds + ATT_VT); LAS float* BIAS = (LAS float*)(F.lds + ATT_BIAS);
    const int lane = F.lane, r = lane & 31, hh = lane >> 5;
#pragma unroll 1
    for (int unit = F.vcu; unit < 8 * 32 * NKV; unit += F.G) {
        const int kv = unit & 1, n = (unit >> 1) & 31, b = unit >> 6;
        const int t0 = b * SEQ + n * 128;
        __syncthreads();
        {
            const int j = F.tid >> 1, hf = F.tid & 1; const bool valid = (n > 0) || (j >= 128);
            const bf16* rowp = F.PA + (size_t)(t0 - 128 + j) * PA_W;
            v4u kq[4], vq[4];
#pragma unroll
            for (int i = 0; i < 4; ++i) { kq[i] = (v4u){0u, 0u, 0u, 0u}; vq[i] = kq[i]; }
            if (valid) {
#pragma unroll
                for (int i = 0; i < 4; ++i) { kq[i] = *(const GAS v4u*)(rowp + C_K + kv * HD + hf * 32 + i * 8); vq[i] = *(const GAS v4u*)(rowp + C_V + kv * HD + hf * 32 + i * 8); }
            }
            float kf[32]; float ss = 0.f;
#pragma unroll
            for (int i = 0; i < 4; ++i) { kf[8 * i + 0] = bf_lo(kq[i].x); kf[8 * i + 1] = bf_hi(kq[i].x); kf[8 * i + 2] = bf_lo(kq[i].y); kf[8 * i + 3] = bf_hi(kq[i].y);
                kf[8 * i + 4] = bf_lo(kq[i].z); kf[8 * i + 5] = bf_hi(kq[i].z); kf[8 * i + 6] = bf_lo(kq[i].w); kf[8 * i + 7] = bf_hi(kq[i].w); }
#pragma unroll
            for (int e = 0; e < 32; ++e) ss += kf[e] * kf[e];
            ss += __shfl_xor(ss, 1);
            const float rs = 1.f / sqrtf(ss * (1.f / HD) + EPS);
#pragma unroll
            for (int i = 0; i < 4; ++i) { const f32x4 g0 = *(const GAS f32x4*)(F.k_norm + hf * 32 + 8 * i), g1 = *(const GAS f32x4*)(F.k_norm + hf * 32 + 8 * i + 4);
                v4u o; o.x = pk2(kf[8 * i + 0] * rs * g0[0], kf[8 * i + 1] * rs * g0[1]); o.y = pk2(kf[8 * i + 2] * rs * g0[2], kf[8 * i + 3] * rs * g0[3]);
                o.z = pk2(kf[8 * i + 4] * rs * g1[0], kf[8 * i + 5] * rs * g1[1]); o.w = pk2(kf[8 * i + 6] * rs * g1[2], kf[8 * i + 7] * rs * g1[3]);
                *(LAS v4u*)(KS + j * KS_STRIDE + hf * 32 + 8 * i) = o; }
#pragma unroll
            for (int i = 0; i < 4; ++i) { const int d0 = hf * 32 + 8 * i;
                VT[(d0 + 0) * VT_STRIDE + j] = (bf16)(vq[i].x & 0xffffu); VT[(d0 + 1) * VT_STRIDE + j] = (bf16)(vq[i].x >> 16);
                VT[(d0 + 2) * VT_STRIDE + j] = (bf16)(vq[i].y & 0xffffu); VT[(d0 + 3) * VT_STRIDE + j] = (bf16)(vq[i].y >> 16);
                VT[(d0 + 4) * VT_STRIDE + j] = (bf16)(vq[i].z & 0xffffu); VT[(d0 + 5) * VT_STRIDE + j] = (bf16)(vq[i].z >> 16);
                VT[(d0 + 6) * VT_STRIDE + j] = (bf16)(vq[i].w & 0xffffu); VT[(d0 + 7) * VT_STRIDE + j] = (bf16)(vq[i].w >> 16); }
            { const int g = F.tid >> 7, dist = F.tid & 127; BIAS[F.tid] = F.rel_bias[t5_bucket(dist) * NH + kv * 4 + g]; }
        }
        __syncthreads();
#pragma unroll 1
        for (int task = F.wave; task < 16; task += NWAVES) {
            const int g = task >> 2, c = task & 3, head = kv * 4 + g, r0 = 32 * c;
            bf16x8 qf[4];
            {
                const bf16* qp = F.PA + (size_t)(t0 + r0 + r) * PA_W + C_Q + head * HD + 8 * hh;
                v4u qq[4]; float qv[32]; float ss = 0.f;
#pragma unroll
                for (int s = 0; s < 4; ++s) qq[s] = *(const GAS v4u*)(qp + 16 * s);
#pragma unroll
                for (int s = 0; s < 4; ++s) { qv[8 * s + 0] = bf_lo(qq[s].x); qv[8 * s + 1] = bf_hi(qq[s].x); qv[8 * s + 2] = bf_lo(qq[s].y); qv[8 * s + 3] = bf_hi(qq[s].y);
                    qv[8 * s + 4] = bf_lo(qq[s].z); qv[8 * s + 5] = bf_hi(qq[s].z); qv[8 * s + 6] = bf_lo(qq[s].w); qv[8 * s + 7] = bf_hi(qq[s].w); }
#pragma unroll
                for (int e = 0; e < 32; ++e) ss += qv[e] * qv[e];
                ss += __shfl_xor(ss, 32);
                const float rs = 0.125f / sqrtf(ss * (1.f / HD) + EPS);
#pragma unroll
                for (int s = 0; s < 4; ++s) { const f32x4 g0 = *(const GAS f32x4*)(F.q_norm + 16 * s + 8 * hh), g1 = *(const GAS f32x4*)(F.q_norm + 16 * s + 8 * hh + 4);
                    v4u o; o.x = pk2(qv[8 * s + 0] * rs * g0[0], qv[8 * s + 1] * rs * g0[1]); o.y = pk2(qv[8 * s + 2] * rs * g0[2], qv[8 * s + 3] * rs * g0[3]);
                    o.z = pk2(qv[8 * s + 4] * rs * g1[0], qv[8 * s + 5] * rs * g1[1]); o.w = pk2(qv[8 * s + 6] * rs * g1[2], qv[8 * s + 7] * rs * g1[3]);
                    qf[s] = __builtin_bit_cast(bf16x8, o); }
            }
            f32x16 sacc[5];
#pragma unroll
            for (int i5 = 0; i5 < 5; ++i5) {
#pragma unroll
                for (int e = 0; e < 16; ++e) sacc[i5][e] = 0.f;
                const int kt = c + i5;
#pragma unroll
                for (int s = 0; s < 4; ++s) { const bf16x8 ka = *(const LAS bf16x8*)(KS + (32 * kt + r) * KS_STRIDE + 16 * s + 8 * hh); sacc[i5] = MFMA32(ka, qf[s], sacc[i5]); }
            }
            const float sink = F.sinks[head];
            const int dbase = r - 4 * hh + 128;
            const LAS float* bl = BIAS + g * 128;
            float mx = sink;
#pragma unroll
            for (int i5 = 0; i5 < 5; ++i5) {
                const bool tile_ok = (n > 0) || (c + i5 >= 4);
#pragma unroll
                for (int e = 0; e < 16; ++e) { const int dist = dbase - 32 * i5 - ((e & 3) + 8 * (e >> 2));
                    bool valid = tile_ok; if (i5 == 0) valid = valid && (dist < 128); if (i5 == 4) valid = valid && (dist >= 0);
                    const float lg = sacc[i5][e] + bl[dist & 127];
                    sacc[i5][e] = valid ? lg : -INFINITY; mx = fmaxf(mx, sacc[i5][e]); }
                __builtin_amdgcn_sched_barrier(0);
            }
            mx = fmaxf(mx, __shfl_xor(mx, 32));
            float sum = 0.f;
#pragma unroll
            for (int i5 = 0; i5 < 5; ++i5)
#pragma unroll
                for (int e = 0; e < 16; ++e) { const float p = __expf(sacc[i5][e] - mx); sacc[i5][e] = p; sum += p; }
            sum += __shfl_xor(sum, 32);
            const float inv = 1.f / (sum + __expf(sink - mx));
            f32x16 oacc[2];
#pragma unroll
            for (int dt = 0; dt < 2; ++dt)
#pragma unroll
                for (int e = 0; e < 16; ++e) oacc[dt][e] = 0.f;
#pragma unroll
            for (int i5 = 0; i5 < 5; ++i5)
#pragma unroll
                for (int s2 = 0; s2 < 2; ++s2) {
                    v4u pp; pp.x = pk2(sacc[i5][8 * s2 + 0] * inv, sacc[i5][8 * s2 + 1] * inv); pp.y = pk2(sacc[i5][8 * s2 + 2] * inv, sacc[i5][8 * s2 + 3] * inv);
                    pp.z = pk2(sacc[i5][8 * s2 + 4] * inv, sacc[i5][8 * s2 + 5] * inv); pp.w = pk2(sacc[i5][8 * s2 + 6] * inv, sacc[i5][8 * s2 + 7] * inv);
                    const bf16x8 pb = __builtin_bit_cast(bf16x8, pp);
                    const int kb = 32 * (c + i5) + 16 * s2 + 4 * hh;
#pragma unroll
                    for (int dt = 0; dt < 2; ++dt) {
                        const v2u lo = *(const LAS v2u*)(VT + (32 * dt + r) * VT_STRIDE + kb), hi = *(const LAS v2u*)(VT + (32 * dt + r) * VT_STRIDE + kb + 8);
                        v4u va; va.x = lo.x; va.y = lo.y; va.z = hi.x; va.w = hi.y;
                        oacc[dt] = MFMA32(__builtin_bit_cast(bf16x8, va), pb, oacc[dt]);
                    }
                    __builtin_amdgcn_sched_barrier(0);
                }
            bf16* op = F.ATT + (size_t)(t0 + r0 + r) * CONV + head * HD;
#pragma unroll
            for (int dt = 0; dt < 2; ++dt)
#pragma unroll
                for (int g4 = 0; g4 < 4; ++g4) { v2u w; w.x = pk2(oacc[dt][4 * g4 + 0], oacc[dt][4 * g4 + 1]); w.y = pk2(oacc[dt][4 * g4 + 2], oacc[dt][4 * g4 + 3]);
#ifdef ZERO_ATT
                    w.x = 0u; w.y = 0u;
#endif
                    *(GAS v2u*)(op + 32 * dt + 8 * g4 + 4 * hh) = w; }
        }
    }
}

DI unsigned f2ord(float f) { const unsigned b = __builtin_bit_cast(unsigned, f); return b ^ ((b >> 31) ? 0xffffffffu : 0x80000000u); }
DI float ord2f(unsigned k) { const unsigned b = k ^ ((k >> 31) ? 0x80000000u : 0xffffffffu); return __builtin_bit_cast(float, b); }
DI unsigned umax_(unsigned a, unsigned b) { return a > b ? a : b; }
DI unsigned umin_(unsigned a, unsigned b) { return a < b ? a : b; }
DI void sort16_desc(unsigned (&v)[16]) {
#pragma unroll
    for (int k = 2; k <= 16; k <<= 1)
#pragma unroll
        for (int j = k >> 1; j > 0; j >>= 1)
#pragma unroll
            for (int i = 0; i < 16; ++i) { const int l = i ^ j; if (l > i) { const bool desc = ((i & k) == 0) || (k == 16); const unsigned a = v[i], b = v[l], hi = umax_(a, b), lo = umin_(a, b); v[i] = desc ? hi : lo; v[l] = desc ? lo : hi; } }
}
DI void merge_top16(unsigned (&a)[16], const unsigned (&b)[16]) {
#pragma unroll
    for (int i = 0; i < 16; ++i) a[i] = umax_(a[i], b[15 - i]);
#pragma unroll
    for (int j = 8; j > 0; j >>= 1)
#pragma unroll
        for (int i = 0; i < 16; ++i) { const int l = i ^ j; if (l > i) { const unsigned x = a[i], y = a[l]; a[i] = umax_(x, y); a[l] = umin_(x, y); } }
}
constexpr int SK_STRIDE = 136;
constexpr int P6_KEYS = 0, P6_IB = 2 * NKEYS * SK_STRIDE * 2, P6_END = P6_IB + NWAVES * 64 * 32;
static_assert(P6_END <= RING_BYTES, "topk LDS");
DI void p6_topk(Frame& F) {
    LAS bf16* KL = (LAS bf16*)(F.lds + P6_KEYS); LAS unsigned char* IB = F.lds + P6_IB + (F.wave * 64 + F.lane) * 32;
    const int lane = F.lane, r = lane & 31, hh = lane >> 5;
    pg8::StaticOrder S; S.init(T, PQ, F.G, (int)blockIdx.x);
    pg8::Unit pu;
    for (int ui = 0; S.next(ui, pu); ++ui) {
        const int h = pu.pn, tile = pu.pm;
        __syncthreads();
        {
            const bf16* src = F.SK + (size_t)h * 2 * NKEYS * 128;
#pragma unroll
            for (int i = 0; i < 8; ++i) { const int ch = F.tid + 512 * i; const int row = ch >> 4, c8 = (ch & 15) * 8;
                *(LAS v4u*)(KL + row * SK_STRIDE + c8) = *(const GAS v4u*)(src + (size_t)row * 128 + c8); }
        }
        __syncthreads();
        const int t = tile * 256 + F.wave * 32 + r;
        unsigned S[2][16];
#pragma unroll
        for (int p = 0; p < 2; ++p) {
            bf16x8 qf[8];
            const int rt = F.wave * 32 + r, q_ai = rt >> 7, q_wr = (rt >> 6) & 1, q_m = (rt >> 4) & 3, q_fr = rt & 15;
#pragma unroll
            for (int s = 0; s < 8; ++s) qf[s] = __builtin_bit_cast(bf16x8, *(const GAS v4u*)(F.QP + pg8::frag_off(tile, h, 8, q_wr * 4 + (s >> 1), q_ai * 8 + q_m * 2 + p, (2 * (s & 1) + hh) * 16 + q_fr)));
            unsigned key[4][16];
#pragma unroll
            for (int kt = 0; kt < 4; ++kt) {
                f32x16 acc;
#pragma unroll
                for (int e = 0; e < 16; ++e) acc[e] = 0.f;
#pragma unroll
                for (int s = 0; s < 8; ++s) { const bf16x8 ka = *(const LAS bf16x8*)(KL + (p * NKEYS + 32 * kt + r) * SK_STRIDE + 16 * s + 8 * hh); acc = MFMA32(ka, qf[s], acc); }
#pragma unroll
                for (int e = 0; e < 16; ++e) { const int nk = 32 * kt + (e & 3) + 8 * (e >> 2) + 4 * hh; key[kt][e] = (f2ord(acc[e]) & ~127u) | (unsigned)(127 - nk); }
            }
#pragma unroll
            for (int kt = 0; kt < 4; ++kt) sort16_desc(key[kt]);
            merge_top16(key[0], key[1]); merge_top16(key[2], key[3]); merge_top16(key[0], key[2]);
            unsigned other[16];
#pragma unroll
            for (int i = 0; i < 16; ++i) other[i] = (unsigned)__shfl_xor((int)key[0][i], 32);
            merge_top16(key[0], other);
#pragma unroll
            for (int i = 0; i < 16; ++i) S[p][i] = key[0][i];
        }
        float s0[16], s1[16]; const float rs2 = pg8::rstd2_of(F.SSQ, t);
#pragma unroll
        for (int i = 0; i < 16; ++i) { s0[i] = ord2f(S[0][i] & ~127u) * rs2; s1[i] = ord2f(S[1][i] & ~127u) * rs2; }
        {
#pragma unroll
            for (int q4 = 0; q4 < 4; ++q4) { unsigned w0 = 0, w1 = 0;
#pragma unroll
                for (int e = 0; e < 4; ++e) { w0 |= (127u - (S[0][4 * q4 + e] & 127u)) << (8 * e); w1 |= (127u - (S[1][4 * q4 + e] & 127u)) << (8 * e); }
                *(LAS unsigned*)(IB + 4 * q4) = w0; *(LAS unsigned*)(IB + 16 + 4 * q4) = w1; }
        }
        unsigned cand[2][16];
#pragma unroll
        for (int i = 0; i < 2; ++i)
#pragma unroll
            for (int e = 0; e < 16; ++e) cand[i][e] = 0u;
        {
            int cnt = 0; float ea = 0.f, eb = 0.f; int ep = 0;
#pragma unroll
            for (int a = 0; a < 16; ++a)
#pragma unroll
                for (int b = 0; b < 16; ++b)
                    if ((a + 1) * (b + 1) <= 16) {
                        if ((cnt & 1) == 0) { ea = s0[a]; eb = s1[b]; ep = 255 - (a * 16 + b); }
                        else { const int slot = cnt >> 1; const float sa = hh ? s0[a] : ea, sb = hh ? s1[b] : eb; const int pp = hh ? 255 - (a * 16 + b) : ep;
                            cand[slot & 1][slot >> 1] = (f2ord(sa + sb) & ~255u) | (unsigned)pp; }
                        ++cnt; }
        }
        sort16_desc(cand[0]); sort16_desc(cand[1]); merge_top16(cand[0], cand[1]);
        {
            unsigned other[16];
#pragma unroll
            for (int i = 0; i < 16; ++i) other[i] = (unsigned)__shfl_xor((int)cand[0][i], 32);
            merge_top16(cand[0], other);
        }
        float gv[16]; int ev[16]; float gsum = 0.f; const float gmx = ord2f(cand[0][0] & ~255u);
#pragma unroll
        for (int i = 0; i < 16; ++i) { const unsigned k = cand[0][i]; const int pos = 255 - (int)(k & 255u); const int a = pos >> 4, b = pos & 15;
            ev[i] = (int)IB[a] * NKEYS + (int)IB[16 + b]; gv[i] = __expf(ord2f(k & ~255u) - gmx); gsum += gv[i]; }
        float ginv = 1.f / gsum;
#ifdef UNIFORM_GATES
#pragma unroll
        for (int i = 0; i < 16; ++i) gv[i] = 1.f;
        ginv = 1.f / 16.f;
#endif
        if (hh == 0) {
            unsigned short* ip = F.IDX + (size_t)t * NSEL + h * TOPK; float* gp = F.GATE + (size_t)t * NSEL + h * TOPK;
#pragma unroll
            for (int i = 0; i < 2; ++i) *(GAS v4i*)(ip + 8 * i) = (v4i){ev[8 * i] | (ev[8 * i + 1] << 16), ev[8 * i + 2] | (ev[8 * i + 3] << 16), ev[8 * i + 4] | (ev[8 * i + 5] << 16), ev[8 * i + 6] | (ev[8 * i + 7] << 16)};
#pragma unroll
            for (int i = 0; i < 4; ++i) *(GAS f32x4*)(gp + 4 * i) = (f32x4){gv[4 * i] * ginv, gv[4 * i + 1] * ginv, gv[4 * i + 2] * ginv, gv[4 * i + 3] * ginv};
        }
    }
}

typedef float f32x2_t __attribute__((ext_vector_type(2)));
DI void fp8x16_to_f32(v4u q, float (&f)[16]) {
#pragma unroll
    for (int w = 0; w < 4; ++w) { const f32x2_t lo = __builtin_amdgcn_cvt_pk_f32_fp8((int)q[w], false), hi = __builtin_amdgcn_cvt_pk_f32_fp8((int)q[w], true);
        f[4 * w + 0] = lo.x; f[4 * w + 1] = lo.y; f[4 * w + 2] = hi.x; f[4 * w + 3] = hi.y; }
}
struct XccInfo { int q, nx, nloc, rank; };
DI void xcc_info_build(const XcdBarrier& b) {
    if (threadIdx.x == 0) {
        unsigned q = 0, nx = 0, nloc = 1;
        for (unsigned j = 0; j < 16; ++j) { const unsigned c = xb_ld(&b.bar[XB_XCNT(j)]); if (c > 0u) { if (j < b.x) ++q; ++nx; } if (j == b.x) nloc = c; }
        b.st[3] = q; b.st[4] = nx > 0u ? nx : 1u; b.st[5] = nloc > 0u ? nloc : 1u;
    }
    __syncthreads();
}
DI XccInfo xcc_info(const XcdBarrier& b) {
    XccInfo I; I.rank = __builtin_amdgcn_readfirstlane((int)b.st[2]); I.q = __builtin_amdgcn_readfirstlane((int)b.st[3]); I.nx = __builtin_amdgcn_readfirstlane((int)b.st[4]); I.nloc = __builtin_amdgcn_readfirstlane((int)b.st[5]);
    return I;
}
DI float dpp_sum8(float s) {
    s += __builtin_bit_cast(float, __builtin_amdgcn_update_dpp(0, __builtin_bit_cast(int, s), 0xB1, 0xf, 0xf, false));
    s += __builtin_bit_cast(float, __builtin_amdgcn_update_dpp(0, __builtin_bit_cast(int, s), 0x4E, 0xf, 0xf, false));
    s += __builtin_bit_cast(float, __builtin_amdgcn_update_dpp(0, __builtin_bit_cast(int, s), 0x141, 0xf, 0xf, false));
    return s;
}
typedef long i64_t;
typedef long i64x2 __attribute__((ext_vector_type(2)));
typedef int v4i_t __attribute__((ext_vector_type(4)));
typedef int v8i_t __attribute__((ext_vector_type(8)));
constexpr int PEER_ROW = 144, PEER_WAVE_LDS = 128 * PEER_ROW;
constexpr int MX_ONE = 0x7f7f7f7f;
#define P7_IDS(t_, ia_, ib_) do { ia_ = (int)F.IDX[(size_t)(t_) * NSEL + lane]; ib_ = (int)F.IDX[(size_t)(t_) * NSEL + 64 + lane]; } while (0)
#define P7_ISSUE(t_, ia_, ib_, uq_, x_) do { \
        const unsigned char* xr_ = F.XB8 + (size_t)(t_) * D + sl * 256 + 16 * g;   \
        x_[0] = *(const GAS v4u*)(xr_); x_[1] = *(const GAS v4u*)(xr_ + 64); x_[2] = *(const GAS v4u*)(xr_ + 128); x_[3] = *(const GAS v4u*)(xr_ + 192); \
        _Pragma("unroll") for (int ld = 0; ld < 16; ++ld) { const int e_ = __shfl(ld < 8 ? ia_ : ib_, (8 * ld + row8) & 63); uq_[ld] = *(const GAS v4u*)(Us + (unsigned)(e_ * 128 + 16 * c8)); } } while (0)
#define P7_COMPUTE(t_, uq_, x_) do { \
        _Pragma("unroll") for (int ld = 0; ld < 16; ++ld) *(LAS v4u*)(wl + (8 * ld + row8) * PEER_ROW + 16 * c8) = uq_[ld]; \
        v8i_t xb0_, xb1_; \
        xb0_[0] = (int)x_[0].x; xb0_[1] = (int)x_[0].y; xb0_[2] = (int)x_[0].z; xb0_[3] = (int)x_[0].w; xb0_[4] = (int)x_[1].x; xb0_[5] = (int)x_[1].y; xb0_[6] = (int)x_[1].z; xb0_[7] = (int)x_[1].w; \
        xb1_[0] = (int)x_[2].x; xb1_[1] = (int)x_[2].y; xb1_[2] = (int)x_[2].z; xb1_[3] = (int)x_[2].w; xb1_[4] = (int)x_[3].x; xb1_[5] = (int)x_[3].y; xb1_[6] = (int)x_[3].z; xb1_[7] = (int)x_[3].w; \
        f32x4 keep = {0.f, 0.f, 0.f, 0.f}; \
        _Pragma("unroll") for (int j = 0; j < 8; ++j) { f32x4 c_ = {0.f, 0.f, 0.f, 0.f}; \
            const v4i_t a0_ = *(const LAS v4i_t*)(wl + (16 * j + m) * PEER_ROW + 16 * g), a1_ = *(const LAS v4i_t*)(wl + (16 * j + m) * PEER_ROW + 64 + 16 * g); \
            v8i_t A0_ = {a0_[0], a0_[1], a0_[2], a0_[3], 0, 0, 0, 0}, A1_ = {a1_[0], a1_[1], a1_[2], a1_[3], 0, 0, 0, 0}; \
            c_ = __builtin_amdgcn_mfma_scale_f32_16x16x128_f8f6f4(A0_, xb0_, c_, 4, 0, 0, MX_ONE, 0, MX_ONE); \
            c_ = __builtin_amdgcn_mfma_scale_f32_16x16x128_f8f6f4(A1_, xb1_, c_, 4, 0, 0, MX_ONE, 0, MX_ONE); \
            keep = (m == j) ? c_ : keep; } \
        { const bool ok_ = (m < 8) && ((t_) < T); bf16* dst_ = ok_ ? F.PARTB + ((size_t)sl * T + (t_)) * NSEL + 16 * m + 4 * g : F.PARTB + (size_t)8 * T * NSEL + 4 * lane; \
          v2u w_; w_.x = pk2(keep[0], keep[1]); w_.y = pk2(keep[2], keep[3]); *(GAS v2u*)dst_ = w_; } } while (0)
DI int peer_next(volatile LAS unsigned* ctr, int lane) { unsigned k = 0u; if (lane == 0) k = __hip_atomic_fetch_add((LAS unsigned*)ctr, 1u, __ATOMIC_RELAXED, __HIP_MEMORY_SCOPE_WORKGROUP); return __builtin_amdgcn_readfirstlane((int)k); }
DI int peer_tok(int tbase, int tstride, int k) { return tbase + (k & 7) + (k >> 3) * tstride; }
DI void p7_udot(Frame& F, const XccInfo& I) {
    const int lane = F.lane, g = lane >> 4, m = lane & 15, row8 = lane >> 3, c8 = lane & 7;
    LAS unsigned char* wl = F.lds + F.wave * PEER_WAVE_LDS;
    const unsigned char* U4 = (const unsigned char*)F.UB;
    const int tstride = I.nloc * NWAVES, tbase = I.rank * NWAVES;
    int it = 0;
    for (int share = I.q; share < 8; share += I.nx, ++it) {
        const int sl = share >> 1, half = share & 1;
        const unsigned char* Us = U4 + (size_t)sl * NEXP * 128;
        volatile LAS unsigned* ctr = F.MISC + 16 + it;
#define CL(t_) ((t_) < T ? (t_) : T - 1)
#define TOK(k_) (2 * peer_tok(tbase, tstride, (k_)) + half)
        v4u uqA[16], uqB[16]; int iA0, iA1, iB0, iB1;
        int kk = peer_next(ctr, lane); int tA = TOK(kk); kk = peer_next(ctr, lane); int tB = TOK(kk);
        {
            v4u xA[4], xB[4];
            P7_IDS(CL(tA), iA0, iA1);
            P7_ISSUE(CL(tA), iA0, iA1, uqA, xA);
            P7_IDS(CL(tB), iB0, iB1);
#pragma unroll 1
            while (tA < T) {
                kk = peer_next(ctr, lane); const int tC = TOK(kk); kk = peer_next(ctr, lane); const int tD = TOK(kk);
                P7_IDS(CL(tC), iA0, iA1);
                P7_ISSUE(CL(tB), iB0, iB1, uqB, xB);
                P7_COMPUTE(tA, uqA, xA);
                P7_IDS(CL(tD), iB0, iB1);
                P7_ISSUE(CL(tC), iA0, iA1, uqA, xA);
                P7_COMPUTE(tB, uqB, xB);
                tA = tC; tB = tD;
            }
        }
#undef TOK
#undef CL
    }
}
DI void p8_act(Frame& F) {
    const size_t NT_ = (size_t)F.G * NWAVES * 64;
    for (size_t item = (size_t)F.vcu * NWAVES * 64 + F.tid; item < (size_t)T * NSEL / 4; item += NT_) {
        const int t = (int)(item >> 5);
        f32x4 s = {0.f, 0.f, 0.f, 0.f}, vs4;
#pragma unroll
        for (int sl = 0; sl < 4; ++sl) { const v2u p = *(const GAS v2u*)(F.PARTB + (size_t)sl * T * NSEL + item * 4); s = s + (f32x4){bf_lo(p.x), bf_hi(p.x), bf_lo(p.y), bf_hi(p.y)}; }
        { const v2u ids = *(const GAS v2u*)(F.IDX + item * 4);
          s[0] *= F.SU[ids.x & 0xffffu]; s[1] *= F.SU[ids.x >> 16]; s[2] *= F.SU[ids.y & 0xffffu]; s[3] *= F.SU[ids.y >> 16];
          vs4 = (f32x4){F.SV[ids.x & 0xffffu], F.SV[ids.x >> 16], F.SV[ids.y & 0xffffu], F.SV[ids.y >> 16]}; }
        const float rs2 = pg8::rstd2_of(F.SSQ, t);
        const f32x4 g = *(const GAS f32x4*)(F.GATE + item * 4);
        f32x4 o;
#pragma unroll
        for (int e = 0; e < 4; ++e) { const float pre = s[e] * rs2; o[e] = 0.5f * pre * (1.f + erff(pre * 0.70710678118f)) * g[e] * vs4[e] * A_SCALE; }
        ((GAS unsigned*)F.ACT)[item] = pk4_fp8(o);
    }
}
typedef int v2i_t __attribute__((ext_vector_type(2)));
#define P9_IDS(t_, ia_, ib_, ak_) do { ia_ = (int)F.IDX[(size_t)(t_) * NSEL + lane]; ib_ = (int)F.IDX[(size_t)(t_) * NSEL + 64 + lane]; \
        const unsigned char* ap_ = (const unsigned char*)F.ACT + (size_t)(t_) * NSEL + 16 * g; \
        ak_[0] = *(const GAS v4u*)(ap_); ak_[1] = *(const GAS v4u*)(ap_ + 64); } while (0)
#define P9_ISSUE(ia_, ib_, vq_) do { \
        _Pragma("unroll") for (int ld = 0; ld < 16; ++ld) { const int e_ = __shfl(ld < 8 ? ia_ : ib_, (8 * ld + row8) & 63); vq_[ld] = *(const GAS v4u*)(Vs + (unsigned)(e_ * 128 + 16 * c8)); } } while (0)
#define P9_COMPUTE(t_, vq_, ak_) do { \
        _Pragma("unroll") for (int ld = 0; ld < 16; ++ld) *(LAS v4u*)(wl + (8 * ld + row8) * PEER_ROW + 16 * c8) = vq_[ld]; \
        const v8i_t A_ = {(int)ak_[0].x, (int)ak_[0].y, (int)ak_[0].z, (int)ak_[0].w, (int)ak_[1].x, (int)ak_[1].y, (int)ak_[1].z, (int)ak_[1].w}; \
        float keep[4] = {0.f, 0.f, 0.f, 0.f}; \
        _Pragma("unroll") for (int ct = 0; ct < 16; ++ct) { \
            const v2i_t b0_ = __builtin_amdgcn_ds_read_tr4_b64_v2i32((LAS v2i_t*)(wl + (32 * g + n16) * PEER_ROW + 8 * ct)); \
            const v2i_t b1_ = __builtin_amdgcn_ds_read_tr4_b64_v2i32((LAS v2i_t*)(wl + (32 * g + 16 + n16) * PEER_ROW + 8 * ct)); \
            const v8i_t B_ = {b0_[0], b0_[1], b1_[0], b1_[1], 0, 0, 0, 0}; f32x4 c_ = {0.f, 0.f, 0.f, 0.f}; \
            c_ = __builtin_amdgcn_mfma_scale_f32_16x16x128_f8f6f4(A_, B_, c_, 0, 4, 0, MX_ONE, 0, MX_ONE); \
            keep[ct >> 2] = (g == (ct & 3)) ? c_[0] : keep[ct >> 2]; }   \
        { const bool ok_ = (t_) < T; const size_t oo_ = (size_t)(ok_ ? (t_) : T - 1) * D + sl * 256 + 16 * g + n16; \
          float* op_ = ok_ ? F.out + oo_ : (float*)F.PARTB + 4 * lane;                   \
          _Pragma("unroll") for (int q = 0; q < 4; ++q) op_[ok_ ? 64 * q : q] = __builtin_bit_cast(float, (unsigned)F.XB[oo_ + 64 * q] << 16) + keep[q] * (1.f / A_SCALE); } } while (0)
DI void p9_vacc(Frame& F, const XccInfo& I) {
    const int lane = F.lane, g = lane >> 4, n16 = lane & 15, row8 = lane >> 3, c8 = lane & 7;
    LAS unsigned char* wl = F.lds + F.wave * PEER_WAVE_LDS;
    const unsigned char* V4 = (const unsigned char*)F.VB;
    const int tstride = I.nloc * NWAVES, tfirst = I.rank * NWAVES + F.wave;
    for (int share = I.q; share < 8; share += I.nx) {
        const int sl = share >> 1, half = share & 1;
        const unsigned char* Vs = V4 + (size_t)sl * NEXP * 128;
        if (2 * tfirst + half >= T) continue;
        v4u vqA[16], vqB[16]; v4u akA[2], akB[2]; int iA0, iA1, iB0, iB1;
#define CL(t_) ((t_) < T ? (t_) : T - 1)
#define TK(k_) (2 * (tfirst + (k_) * tstride) + half)
        P9_IDS(TK(0), iA0, iA1, akA);
        P9_ISSUE(iA0, iA1, vqA);
        P9_IDS(CL(TK(1)), iB0, iB1, akB);
#pragma unroll 1
        for (int k = 0; TK(k) < T; k += 2) {
            const int t = TK(k), t1 = TK(k + 1), t2 = CL(TK(k + 2)), t3 = CL(TK(k + 3));
            v4u akN[2], akM[2];
            P9_IDS(t2, iA0, iA1, akN);
            P9_ISSUE(iB0, iB1, vqB);
            P9_COMPUTE(t, vqA, akA);
            P9_IDS(t3, iB0, iB1, akM);
            P9_ISSUE(iA0, iA1, vqA);
            P9_COMPUTE(t1, vqB, akB);
            akA[0] = akN[0]; akA[1] = akN[1]; akB[0] = akM[0]; akB[1] = akM[1];
        }
#undef TK
#undef CL
    }
}

struct Args { const float* in[17]; float* out; unsigned char* ws; int ph_lo, ph_hi, li, pad; };
__global__ void __launch_bounds__(NWAVES * 64, 2) hyb_fwd(Args args) {
    extern __shared__ __attribute__((aligned(16))) unsigned char lds[];
    Frame F;
    F.lds = (LAS unsigned char*)lds;
    F.MISC = (volatile LAS unsigned*)(F.lds + MISC_OFF);
    F.tid = threadIdx.x; F.lane = F.tid & 63; F.wave = __builtin_amdgcn_readfirstlane(F.tid >> 6);
    F.G = gridDim.x; { const int bx = blockIdx.x; F.vcu = (F.G % 8 == 0) ? (bx % 8) * (F.G / 8) + bx / 8 : bx; }
    unsigned char* ws = args.ws;
    F.ctl = (gu32*)(ws + WS_CTL);
    F.x = args.in[0]; F.norm_mix = args.in[1]; F.norm_ffn = args.in[2]; F.w_in = args.in[3]; F.b_gate = args.in[4]; F.w_conv = args.in[5]; F.q_norm = args.in[6]; F.k_norm = args.in[7];
    F.sinks = args.in[8]; F.rel_bias = args.in[9]; F.w_conv_out = args.in[10]; F.w_attn_out = args.in[11]; F.w_out = args.in[12]; F.w_query = args.in[13]; F.sub_keys = args.in[14];
    F.expert_u = args.in[15]; F.expert_v = args.in[16]; F.out = args.out;
    F.WIN = (bf16*)(ws + WS_WIN); F.WC = (bf16*)(ws + WS_WC); F.WA = (bf16*)(ws + WS_WA); F.WO = (bf16*)(ws + WS_WO); F.WQ = (bf16*)(ws + WS_WQ); F.SK = (bf16*)(ws + WS_SK);
    F.UB = (bf16*)(ws + WS_UB); F.VB = (bf16*)(ws + WS_VB); F.XB = (bf16*)(ws + WS_XB); F.PA = (bf16*)(ws + WS_PA); F.MIX = (bf16*)(ws + WS_MIX); F.G_ = (bf16*)(ws + WS_G); F.QP = (bf16*)(ws + WS_QP);
    F.Z = (bf16*)(ws + WS_Z); F.ATT = (bf16*)(ws + WS_ATT); F.RSTD1 = (float*)(ws + WS_RSTD1); F.SSQ = (float*)(ws + WS_SSQ); F.GATE = (float*)(ws + WS_GATE); F.IDX = (unsigned short*)(ws + WS_IDX); F.PARTB = (bf16*)(ws + WS_PART); F.SU = (float*)(ws + WS_SU); F.SV = (float*)(ws + WS_SV); F.XB8 = (unsigned char*)(ws + WS_XB8); F.ACT = (float*)(ws + WS_ACT);
    for (int u = F.tid; u < (LDS_BYTES - LDSCTL_OFF) / 4; u += NWAVES * 64) ((LAS unsigned*)(F.lds + LDSCTL_OFF))[u] = 0u;
    __syncthreads();
    XcdBarrier bar; bar.bar = (unsigned*)(F.ctl + CW_BAR); bar.x = 0; bar.st = nullptr;
    const int lo = args.ph_lo, hi = args.ph_hi;
    if (hi - lo > 1) bar = xcd_barrier_post((unsigned*)(F.ctl + CW_BAR), F.MISC + 8);
#ifndef PH_MASK
#define PH_MASK 0x3ff
#endif
#define IN(k) (((PH_MASK >> (k)) & 1) && lo <= (k) && (k) < hi)
#define SEAM(k) do { if (IN(k) && IN((k) + 1)) xcd_barrier(bar); } while (0)
#ifndef PROBE_DUP
#define PROBE_DUP 0
#endif
#define REP(k) for (int rep_ = 0; rep_ < (((PROBE_DUP >> (k)) & 1) ? 2 : 1); ++rep_)

    if (IN(0)) { REP(0) p0_prologue(F); SEAM(0); }
    if (IN(1)) {
        pg8::Gemm g{F.XB, F.WIN, nullptr, nullptr, T, IN_DIM, D}; pg8::StaticOrder S; S.init(T, IN_DIM, F.G, (int)blockIdx.x);
        { LAS float* bgl = (LAS float*)(F.lds + RING_BYTES); for (int i = F.tid; i < 2 * D; i += NWAVES * 64) bgl[i] = F.b_gate[i]; __syncthreads(); }
        pg8::EpiProj E{F.PA, F.G_, (const PG8_LAS float*)(F.lds + RING_BYTES)};
        REP(1) pg8::gemm_phase<pg8::EpiProj, pg8::StaticOrder, PG8_ALIGN, PG8_SP2>(F.lds + RING_OFF, g, S, E);
        {
            const int nwg = (T / 256) * (IN_DIM / 256), rem = nwg % F.G, c = (int)blockIdx.x; const int nshort = rem ? F.G - rem : F.G, sidx = rem ? c - rem : c;
            (void)sidx; (void)nshort;
            constexpr int CH = 64, NCH = 2 * NEXP / CH;
            for (;;) {
                if (F.tid == 0) F.MISC[14] = __hip_atomic_fetch_add((unsigned*)(F.ctl + 2048), 1u, __ATOMIC_RELAXED, __HIP_MEMORY_SCOPE_AGENT);
                __syncthreads();
                const int ch = __builtin_amdgcn_readfirstlane((int)F.MISC[14]);
                __syncthreads();
                if (ch >= NCH) break;
                if (ch < NCH / 2) p0_convert_fp4(F, F.expert_u, F.norm_ffn, (unsigned char*)F.UB, F.SU, ch * CH, ch * CH + CH);
                else p0_convert_fp4(F, F.expert_v, nullptr, (unsigned char*)F.VB, F.SV, (ch - NCH / 2) * CH, (ch - NCH / 2) * CH + CH);
            } }
        SEAM(1);
    }
    if (IN(2)) {
        REP(2) { p2_conv(F); p2_attention(F); }
        SEAM(2); }
    if (IN(3)) {
        pg8::Gemm g{F.Z, F.WC, F.ATT, F.WA, T, D, CONV}; pg8::PairOrder S; S.init(T, D, F.G, (int)blockIdx.x);
        pg8::EpiMix E{F.MIX, F.G_};
        REP(3) pg8::gemm_phase<pg8::EpiMix, pg8::PairOrder, PG8_ALIGN, PG8_SP2>(F.lds + RING_OFF, g, S, E);
        SEAM(3);
    }
    if (IN(4)) {
        pg8::Gemm g{F.MIX, F.WO, nullptr, nullptr, T, D, D}; pg8::FragOrder S; S.init(T, D, F.G, (int)blockIdx.x);
        pg8::EpiX1 E{F.x, F.XB, F.SSQ, F.XB8};
        REP(4) pg8::gemm_phase<pg8::EpiX1, pg8::FragOrder, PG8_ALIGN, PG8_SP2>(F.lds + RING_OFF, g, S, E);
        SEAM(4);
    }
    if (IN(5)) {
        pg8::Gemm g{F.XB, F.WQ, nullptr, nullptr, T, PQ, D}; pg8::StaticOrder S; S.init(T, PQ, F.G, (int)blockIdx.x);
        pg8::EpiQP E{F.QP};
        REP(5) pg8::gemm_phase<pg8::EpiQP, pg8::StaticOrder, PG8_ALIGN, PG8_SP2>(F.lds + RING_OFF, g, S, E);
    }
    if (IN(6)) { REP(6) p6_topk(F); SEAM(6); }
    if (IN(7)) { xcc_info_build(bar); const XccInfo I = xcc_info(bar); REP(7) p7_udot(F, I); SEAM(7); }
    if (IN(8)) { REP(8) p8_act(F); SEAM(8); }
    if (IN(9)) { const XccInfo I = xcc_info(bar); p9_vacc(F, I); }
#undef IN
#undef SEAM
}

extern "C" void kernel_launch(void* const* d_in, const int* in_sizes, int n_in, void* d_out, int out_size, void* d_ws, size_t ws_size, hipStream_t stream) {
    static int grid = 0;
    if (grid == 0) {
        if (n_in != 17 || in_sizes[0] != T * D || out_size != T * D || ws_size < WS_END) { fprintf(stderr, "kernel_launch: unexpected shapes (n_in %d, in0 %d, out %d, ws %zu)\n", n_in, n_in > 0 ? in_sizes[0] : -1, out_size, ws_size); grid = -1; return; }
        int dev = 0, cus = 0, per_cu = 0;
        if (hipGetDevice(&dev) != hipSuccess || hipDeviceGetAttribute(&cus, hipDeviceAttributeMultiprocessorCount, dev) != hipSuccess) { grid = -1; return; }
        if (hipFuncSetAttribute((const void*)hyb_fwd, hipFuncAttributeMaxDynamicSharedMemorySize, LDS_BYTES) != hipSuccess) { fprintf(stderr, "kernel_launch: hipFuncSetAttribute failed\n"); grid = -1; return; }
        if (hipOccupancyMaxActiveBlocksPerMultiprocessor(&per_cu, (const void*)hyb_fwd, NWAVES * 64, LDS_BYTES) != hipSuccess || per_cu < 1) { fprintf(stderr, "kernel_launch: occupancy query says %d blocks per CU\n", per_cu); (void)hipGetLastError(); grid = -1; return; }
        grid = cus * 1;
    }
    if (grid < 0) return;
    if (hipMemsetAsync((char*)d_ws + WS_CTL, 0, CTL_ZERO_BYTES, stream) != hipSuccess) { fprintf(stderr, "kernel_launch: memset failed\n"); return; }
    Args a{};
    for (int i = 0; i < 17; ++i) a.in[i] = (const float*)d_in[i];
    a.out = (float*)d_out; a.ws = (unsigned char*)d_ws;
#if MK_ONE_LAUNCH
    a.ph_lo = 0; a.ph_hi = N_PHASES; a.li = 0;
    void* kargs[] = {&a};
    const hipError_t le = hipLaunchCooperativeKernel((const void*)hyb_fwd, dim3(grid), dim3(NWAVES * 64), kargs, LDS_BYTES, stream);
    if (le != hipSuccess) fprintf(stderr, "kernel_launch: cooperative launch failed: %s (grid %d)\n", hipGetErrorName(le), grid);
#else
    for (int li = 0; li < N_PHASES; ++li) {
        a.ph_lo = li; a.ph_hi = li + 1; a.li = li;
        hipLaunchKernelGGL(hyb_fwd, dim3(grid), dim3(NWAVES * 64), LDS_BYTES, stream, a);
        const hipError_t le = hipPeekAtLastError();
        if (le != hipSuccess) { fprintf(stderr, "kernel_launch: launch %d failed: %s\n", li, hipGetErrorName(le)); break; }
    }
#endif
}
```

```cpp
#include <hip/hip_runtime.h>
#include <hip/hip_cooperative_groups.h>
#include <cstdio>
#include <cstdint>
namespace pg8 {
#define PG8_LAS __attribute__((address_space(3)))
typedef unsigned short bf16_t;
typedef short bf16x8 __attribute__((ext_vector_type(8)));
typedef float f32x4 __attribute__((ext_vector_type(4)));
typedef unsigned u32x4 __attribute__((ext_vector_type(4)));
typedef unsigned u32x2 __attribute__((ext_vector_type(2)));
constexpr int BM = 256, BK = 64, HALF = 128, HTB = HALF * BK * 2  , STAGE_BYTES = 8 * HTB, NXCD = 8, WGM = 8;

__host__ __device__ __forceinline__ int lds_byte(int r, int c) { const int st = (r >> 4) * 2 + (c >> 5), rr = r & 15, cc = c & 31, ob = rr * 64 + cc * 2; return st * 1024 + (ob ^ (((ob >> 9) & 1) << 5)); }
__host__ __device__ __forceinline__ void stage_rc(int b, int& R, int& C) { const int st = b / 1024, sb = b % 1024, swz = sb ^ (((sb >> 9) & 1) << 5); R = (st >> 1) * 16 + swz / 64; C = (st & 1) * 32 + (swz % 64) / 2; }
__host__ __device__ __forceinline__ int perm32(int rho) { const int n = rho >> 4, i = rho & 15; return 8 * (i >> 2) + 4 * n + (i & 3); }

struct Unit { int pm, pn, which; };
struct Gemm { const bf16_t* A; const bf16_t* Bt; const bf16_t* A2; const bf16_t* Bt2; int M, N, K; };

struct StaticOrder {
    static constexpr bool AFRAG = false;
    int nM, nN, nwg, G, c;
    __host__ __device__ void init(int M, int N, int G_, int c_) { nM = M / BM; nN = N / BM; nwg = nM * nN; G = G_; c = c_; }
    __host__ __device__ bool next(int i, Unit& u) const {
        const long L = (long)i * G + c; if (L >= nwg) return false;
        int wgid = (int)L; { const int q = nwg / NXCD, r = nwg % NXCD, xcd = wgid % NXCD, off = wgid / NXCD; wgid = (xcd < r ? xcd * (q + 1) : r * (q + 1) + (xcd - r) * q) + off; }
        const int nig = WGM * nN, gid = wgid / nig, fm = gid * WGM, gsz = (nM - fm) < WGM ? (nM - fm) : WGM;
        u.pm = fm + ((wgid % nig) % gsz); u.pn = (wgid % nig) / gsz; u.which = 0; return true;
    }
    __device__ __forceinline__ const char* a_base(const Gemm& g, const Unit& u, size_t tstep) const { return (const char*)g.A + (size_t)u.pm * tstep; }
    __device__ __forceinline__ const char* b_base(const Gemm& g, const Unit& u, size_t tstep) const { return (const char*)g.Bt + (size_t)u.pn * tstep; }
    __device__ __forceinline__ void a_ready(const Unit&) const {}
    __device__ __forceinline__ void done(const Unit&) const {}
};

__device__ __forceinline__ unsigned cvt_pk_bf16(float lo, float hi) { unsigned r; asm volatile("v_cvt_pk_bf16_f32 %0, %1, %2" : "=v"(r) : "v"(lo), "v"(hi)); return r; }
__device__ __forceinline__ void store16_wt(void* p, u32x4 v) { asm volatile("global_store_dwordx4 %0, %1, off sc1\n\ts_nop 1" :: "v"(p), "v"(v) : "memory"); }
__device__ __forceinline__ void store8_wt(void* p, u32x2 v) { asm volatile("global_store_dwordx2 %0, %1, off sc1\n\ts_nop 1" :: "v"(p), "v"(v) : "memory"); }
typedef float f32x2 __attribute__((ext_vector_type(2)));
__device__ __forceinline__ f32x2 gelu_pk(f32x2 v) {
    const f32x2 av = __builtin_elementwise_abs(v), d = av * 0.2316418882f + 1.0f;
    f32x2 t; t.x = __builtin_amdgcn_rcpf(d.x); t.y = __builtin_amdgcn_rcpf(d.y);
    f32x2 q = t * 0.5307027145f + (-0.7265760135f); q = q * t + 0.7107068705f; q = q * t + (-0.142248368f); q = q * t + 0.127414796f; q = q * t;
    const f32x2 s = (v * v) * (-0.72134752044f);
    f32x2 e; e.x = __builtin_amdgcn_exp2f(s.x); e.y = __builtin_amdgcn_exp2f(s.y);
    const f32x2 m = v * (q * e), r = v - m;
    f32x2 o; o.x = v.x < 0.f ? m.x : r.x; o.y = v.y < 0.f ? m.y : r.y; return o;
}

template <class Epi, class Sched, bool ALIGN_EPI = false, bool SP2 = false>
__device__ __forceinline__ void gemm_phase(PG8_LAS unsigned char* lds, const Gemm g, const Sched& S, const Epi& E) {
    const int tid = threadIdx.x, wid = __builtin_amdgcn_readfirstlane(tid >> 6), lane = tid & 63, wr = wid >> 2, wc = wid & 3, fr = lane & 15, fq = lane >> 4;
    const int K = g.K, nt = K / BK;
    unsigned voffA[2], voffB[2];
#pragma unroll
    for (int i = 0; i < 2; ++i) { int R, C; stage_rc(tid * 16 + i * 8192, R, C); const int Rb = Epi::PERM ? ((R & ~31) + perm32(R & 31)) : R;
        voffA[i] = Sched::AFRAG ? (unsigned)((((((R >> 6) * 4 + (C >> 5)) * 16 + ((R >> 4) & 3) * 2) * 64) + ((C & 31) >> 3) * 16 + (R & 15)) * 16) : (unsigned)(R * K + C) * 2u;
        voffB[i] = (unsigned)(Rb * K + C) * 2u; }
#define PG8_AP(base, h, kt) (Sched::AFRAG ? (base) + ((((size_t)((kt) >> 2) * 8 + ((kt) & 1) * 2) * 16 + (h) * 8 + (((kt) >> 1) & 1)) * 64) * 16 : (base) + (size_t)(h) * hstep + (size_t)(kt) * kstep)
    const size_t kstep = (size_t)(BK * 2);
    const size_t hstep = (size_t)HALF * K * 2;
    const size_t tstep = 2 * hstep;
    const unsigned ldsw = (unsigned)wid * 1024u;
    const int aoff = lds_byte(wr * 64 + fr, fq * 8), boff = lds_byte(wc * 32 + fr, fq * 8);
#define PG8_SA(b, h) (((b) * 2 + (h)) * HTB)
#define PG8_SB(b, h) ((4 + (b) * 2 + (h)) * HTB)
#define PG8_STAGE(bufoff, gbase, voff) do { _Pragma("unroll") for (int _i = 0; _i < 2; ++_i) \
        __builtin_amdgcn_global_load_lds((const unsigned*)((const char*)(gbase) + (voff)[_i]), (PG8_LAS unsigned*)(lds + (bufoff) + ldsw + _i * 8192), 16, 0, 0); } while (0)
#define PG8_LDA(dst, b, h) do { _Pragma("unroll") for (int m = 0; m < 4; ++m) _Pragma("unroll") for (int k = 0; k < 2; ++k) dst[m][k] = *(const PG8_LAS bf16x8*)(lds + PG8_SA(b, h) + aoff + m * 2048 + k * 1024); } while (0)
#define PG8_LDB(dst, b, h) do { _Pragma("unroll") for (int n = 0; n < 2; ++n) _Pragma("unroll") for (int k = 0; k < 2; ++k) dst[n][k] = *(const PG8_LAS bf16x8*)(lds + PG8_SB(b, h) + boff + n * 2048 + k * 1024); } while (0)
#define PG8_MMA(ai, bj, At, Bt) do { __builtin_amdgcn_s_setprio(1); _Pragma("unroll") for (int m = 0; m < 4; ++m) _Pragma("unroll") for (int n = 0; n < 2; ++n) _Pragma("unroll") for (int k = 0; k < 2; ++k) \
        acc[ai][bj][m][n] = __builtin_amdgcn_mfma_f32_16x16x32_bf16(Bt[n][k], At[m][k], acc[ai][bj][m][n], 0, 0, 0); __builtin_amdgcn_s_setprio(0); } while (0)
#define PG8_WAIT_V(n) asm volatile("s_waitcnt vmcnt(" #n ")" ::: "memory")
#define PG8_WAIT_L(n) asm volatile("s_waitcnt lgkmcnt(" #n ")" ::: "memory")
#define PG8_BAR __builtin_amdgcn_s_barrier()
#define PG8_SCHED __builtin_amdgcn_sched_barrier(0)
    Unit cur, nxt; int ui = 0;
    if (!S.next(0, cur)) return;
    f32x4 acc[2][2][4][2];
#pragma unroll
    for (int a = 0; a < 2; ++a)
#pragma unroll
        for (int b = 0; b < 2; ++b)
#pragma unroll
            for (int m = 0; m < 4; ++m)
#pragma unroll
                for (int n = 0; n < 2; ++n) acc[a][b][m][n] = (f32x4){0.f, 0.f, 0.f, 0.f};
    if constexpr (Epi::HAS_INIT) E.init(acc, cur, wr, wc, fr, fq);
    bf16x8 At[4][2], B0[2][2], B1[2][2];
    const char* cA = S.a_base(g, cur, tstep); const char* cB = S.b_base(g, cur, tstep);
    S.a_ready(cur);
    if constexpr (SP2) {
        PG8_STAGE(PG8_SB(0, 0), cB, voffB); PG8_STAGE(PG8_SB(0, 1), cB + hstep, voffB); PG8_STAGE(PG8_SA(0, 0), PG8_AP(cA, 0, 0), voffA); PG8_STAGE(PG8_SA(0, 1), PG8_AP(cA, 1, 0), voffA);
        if (wr == 1) PG8_BAR;
        PG8_WAIT_V(2); PG8_BAR;
        PG8_STAGE(PG8_SB(1, 0), cB + kstep, voffB); PG8_STAGE(PG8_SA(1, 0), PG8_AP(cA, 0, 1), voffA); PG8_STAGE(PG8_SB(1, 1), cB + hstep + kstep, voffB);
        PG8_WAIT_V(6); PG8_BAR;
    } else {
        PG8_STAGE(PG8_SB(0, 0), cB, voffB); PG8_STAGE(PG8_SA(0, 0), PG8_AP(cA, 0, 0), voffA); PG8_STAGE(PG8_SB(0, 1), cB + hstep, voffB); PG8_STAGE(PG8_SA(0, 1), PG8_AP(cA, 1, 0), voffA);
        if (wr == 1) PG8_BAR;
        PG8_WAIT_V(4); PG8_BAR;
        PG8_STAGE(PG8_SB(1, 0), cB + kstep, voffB); PG8_STAGE(PG8_SA(1, 0), PG8_AP(cA, 0, 1), voffA); PG8_STAGE(PG8_SB(1, 1), cB + hstep + kstep, voffB);
        PG8_WAIT_V(6); PG8_BAR;
    }
    for (;;) {
        const bool has_next = S.next(ui + 1, nxt);
        const char* nA = has_next ? S.a_base(g, nxt, tstep) : cA; const char* nB = has_next ? S.b_base(g, nxt, tstep) : cB;
        for (int t = 0; t < nt; t += 2) {
            const bool last = (t == nt - 2);
            const char* a2b = last ? nA : cA; const int a2k = last ? 0 : t + 2; const char* b2 = last ? nB : cB + (size_t)(t + 2) * kstep;
            const char* b3 = b2 + kstep;
            const char* a1h = PG8_AP(cA, 1, t + 1); const char* a2 = PG8_AP(a2b, 0, a2k); const char* a2h = PG8_AP(a2b, 1, a2k); const char* a3 = PG8_AP(a2b, 0, a2k + 1);
            if (last && has_next) S.a_ready(nxt);
            if constexpr (SP2) {
            PG8_LDB(B0, 0, 0); PG8_LDB(B1, 0, 1); PG8_SCHED; PG8_LDA(At, 0, 0); PG8_STAGE(PG8_SA(1, 1), a1h, voffA);
            PG8_WAIT_V(8); PG8_WAIT_L(0); PG8_BAR; PG8_MMA(0, 0, At, B0); PG8_MMA(0, 1, At, B1); PG8_BAR; PG8_SCHED;
            PG8_LDA(At, 0, 1); PG8_STAGE(PG8_SB(0, 0), b2, voffB); PG8_STAGE(PG8_SB(0, 1), b2 + hstep, voffB); PG8_STAGE(PG8_SA(0, 0), a2, voffA);
            PG8_WAIT_V(8); PG8_WAIT_L(0); PG8_BAR; PG8_MMA(1, 0, At, B0); PG8_MMA(1, 1, At, B1); PG8_BAR; PG8_SCHED;
            PG8_LDB(B0, 1, 0); PG8_LDB(B1, 1, 1); PG8_SCHED; PG8_LDA(At, 1, 0); PG8_STAGE(PG8_SA(0, 1), a2h, voffA);
            PG8_WAIT_V(8); PG8_WAIT_L(0); PG8_BAR; PG8_MMA(0, 0, At, B0); PG8_MMA(0, 1, At, B1); PG8_BAR; PG8_SCHED;
            PG8_LDA(At, 1, 1); PG8_STAGE(PG8_SB(1, 0), b3, voffB); PG8_STAGE(PG8_SB(1, 1), b3 + hstep, voffB); PG8_STAGE(PG8_SA(1, 0), a3, voffA);
            PG8_WAIT_V(8); PG8_WAIT_L(0); PG8_BAR; PG8_MMA(1, 0, At, B0); PG8_MMA(1, 1, At, B1); PG8_BAR; PG8_SCHED;
            } else {
            PG8_LDB(B0, 0, 0); PG8_SCHED; PG8_LDA(At, 0, 0); PG8_STAGE(PG8_SA(1, 1), a1h, voffA);
            PG8_WAIT_L(8); PG8_BAR; PG8_WAIT_L(0); PG8_MMA(0, 0, At, B0); PG8_BAR; PG8_SCHED;
            PG8_LDB(B1, 0, 1); PG8_STAGE(PG8_SB(0, 0), b2, voffB);
            PG8_BAR; PG8_WAIT_L(0); PG8_MMA(0, 1, At, B1); PG8_BAR;
            PG8_LDA(At, 0, 1); PG8_STAGE(PG8_SA(0, 0), a2, voffA);
            PG8_BAR; PG8_WAIT_L(0); PG8_MMA(1, 0, At, B0); PG8_BAR; PG8_SCHED;
            PG8_STAGE(PG8_SB(0, 1), b2 + hstep, voffB);
            PG8_WAIT_V(6); PG8_BAR; PG8_MMA(1, 1, At, B1); PG8_BAR;
            PG8_LDB(B0, 1, 0); PG8_SCHED; PG8_LDA(At, 1, 0); PG8_STAGE(PG8_SA(0, 1), a2h, voffA);
            PG8_WAIT_L(8); PG8_BAR; PG8_WAIT_L(0); PG8_MMA(0, 0, At, B0); PG8_BAR; PG8_SCHED;
            PG8_LDB(B1, 1, 1); PG8_STAGE(PG8_SB(1, 0), b3, voffB);
            PG8_BAR; PG8_WAIT_L(0); PG8_MMA(0, 1, At, B1); PG8_BAR;
            PG8_LDA(At, 1, 1); PG8_STAGE(PG8_SA(1, 0), a3, voffA);
            PG8_BAR; PG8_WAIT_L(0); PG8_MMA(1, 0, At, B0); PG8_BAR; PG8_SCHED;
            PG8_STAGE(PG8_SB(1, 1), b3 + hstep, voffB);
            PG8_WAIT_V(6); PG8_BAR; PG8_MMA(1, 1, At, B1); PG8_BAR;
            }
        }
        if constexpr (ALIGN_EPI) { if (wr == 0) PG8_BAR; }
        if constexpr (!Epi::AFTER_DRAIN) { E(acc, cur, wr, wc, fr, fq); S.done(cur); }
        if (!has_next) break;
#pragma unroll
        for (int a = 0; a < 2; ++a)
#pragma unroll
            for (int b = 0; b < 2; ++b)
#pragma unroll
                for (int m = 0; m < 4; ++m)
#pragma unroll
                    for (int n = 0; n < 2; ++n) acc[a][b][m][n] = (f32x4){0.f, 0.f, 0.f, 0.f};
        if constexpr (Epi::HAS_INIT) E.init(acc, nxt, wr, wc, fr, fq);
        cur = nxt; cA = nA; cB = nB; ++ui;
        if constexpr (ALIGN_EPI) { if (wr == 1) PG8_BAR; }
    }
    PG8_WAIT_V(0);
    if constexpr (!ALIGN_EPI) { if (wr == 0) PG8_BAR; }
    PG8_BAR;
    if constexpr (Epi::AFTER_DRAIN) { E.fused(acc, cur, wr, wc, fr, fq, lds, wid, lane); S.done(cur); }
#undef PG8_AP
#undef PG8_SA
#undef PG8_SB
#undef PG8_STAGE
#undef PG8_LDA
#undef PG8_LDB
#undef PG8_MMA
#undef PG8_WAIT_V
#undef PG8_WAIT_L
#undef PG8_BAR
#undef PG8_SCHED
}
}

#ifndef PG8_SP2
#define PG8_SP2 true
#endif
#ifndef PG8_ALIGN
#define PG8_ALIGN true
#endif
#ifndef MK_ONE_LAUNCH
#define MK_ONE_LAUNCH 1
#endif

constexpr int NWAVES = 8;
constexpr int T = 32768, D = 1024, SEQ = 4096;
constexpr int IN_DIM = 4352, PA_W = 2304, G_W = 2048;
constexpr int C_U = 0, C_B = 512, C_C = 1024, C_Q = 1536, C_K = 2048, C_V = 2176;
constexpr int CONV = 512, HD = 64, NH = 8, NKV = 2;
constexpr int PH = 8, NKEYS = 128, PQ = 2048, TOPK = 16, NEXP = 16384, NSEL = 128;
constexpr float EPS = 1e-6f;
constexpr int N_PHASES = 10;

constexpr size_t MiB = 1u << 20;
constexpr size_t WS_CTL = 0, CTL_ZERO_BYTES = 1 * MiB;
constexpr size_t WS_WIN = 2 * MiB;
constexpr size_t WS_WC = 11 * MiB;
constexpr size_t WS_WA = 12 * MiB;
constexpr size_t WS_WO = 13 * MiB;
constexpr size_t WS_WQ = 15 * MiB;
constexpr size_t WS_SK = 19 * MiB;
constexpr size_t WS_RSTD1 = 20 * MiB;
constexpr size_t WS_SSQ = 21 * MiB;
constexpr size_t WS_UB = 24 * MiB;
constexpr size_t WS_SU = 32 * MiB;
constexpr size_t WS_VB = 40 * MiB;
constexpr size_t WS_SV = 48 * MiB;
constexpr size_t WS_XB8 = 56 * MiB;
constexpr size_t WS_XB = 88 * MiB;
constexpr size_t WS_PA = 152 * MiB;
constexpr size_t WS_MIX = WS_PA;
constexpr size_t WS_G = 296 * MiB;
constexpr size_t WS_QP = WS_G;
constexpr size_t WS_Z = 424 * MiB;
constexpr size_t WS_ATT = 456 * MiB;
constexpr size_t WS_IDX = WS_Z, WS_GATE = WS_ATT;
constexpr size_t WS_PART = WS_PA;
constexpr size_t WS_ACT = WS_G;
constexpr size_t WS_END = 488 * MiB;
constexpr int CW_BAR = 4096;

constexpr int RING_OFF = 0, RING_BYTES = 131072;
constexpr int LDSCTL_OFF = 147456, MISC_OFF = LDSCTL_OFF + 320;
constexpr int LDS_BYTES = 148480;
#define GAS __attribute__((address_space(1)))
#define LAS __attribute__((address_space(3)))
typedef unsigned short bf16;
typedef unsigned v4u __attribute__((ext_vector_type(4)));
typedef float f32x4 __attribute__((ext_vector_type(4)));
typedef short bf16x8 __attribute__((ext_vector_type(8)));
typedef GAS unsigned gu32;
typedef GAS unsigned long long gu64;
#define RLX_AGENT __ATOMIC_RELAXED, __HIP_MEMORY_SCOPE_AGENT
#define LDS_WAIT() asm volatile("s_waitcnt lgkmcnt(0)" ::: "memory")
#define VM_WAIT() asm volatile("s_waitcnt vmcnt(0)" ::: "memory")
__device__ __forceinline__ unsigned long long rt() { return __builtin_amdgcn_s_memrealtime(); }
__device__ __forceinline__ unsigned f2bf(float f) { unsigned u = __builtin_bit_cast(unsigned, f); return (u + 0x7fffu + ((u >> 16) & 1u)) >> 16; }
__device__ __forceinline__ unsigned pk2(float lo, float hi) { return f2bf(lo) | (f2bf(hi) << 16); }

#define XB_TMO      128
#define XB_XCNT(j)  (256  + 64 * (j))
#define XB_XSUB(j)  (1280 + 64 * (j))
#define XB_XGEN(j)  (2304 + 64 * (j))
#define XB_TOP      3328
#define XB_TOPGEN   3392
#define XCD_BAR_WORDS 3456
#define XB_SPIN_CAP (1u << 18)

__device__ __forceinline__ unsigned xb_ld(unsigned* p)              { return __hip_atomic_load(p, __ATOMIC_RELAXED, __HIP_MEMORY_SCOPE_AGENT); }
__device__ __forceinline__ unsigned xb_add(unsigned* p, unsigned v) { return __hip_atomic_fetch_add(p, v, __ATOMIC_RELAXED, __HIP_MEMORY_SCOPE_AGENT); }
__device__ __forceinline__ unsigned xb_xcc_id() { return (unsigned)__builtin_amdgcn_s_getreg((3 << 11) | 20) & 0xFu; }
#define XB_SPIN(cond, bar) do { unsigned _sp = 0; while (cond) { __builtin_amdgcn_s_sleep(1); \
    if ((++_sp & 255u) == 0u) { if (xb_ld(&(bar)[XB_TMO])) break; if (_sp > XB_SPIN_CAP) { atomicAdd(&(bar)[XB_TMO], 1u); break; } } } } while (0)

struct XcdBarrier {
    unsigned* bar; unsigned x;
    volatile LAS unsigned* st;
};

__device__ __forceinline__ XcdBarrier xcd_barrier_post(unsigned* bar, volatile LAS unsigned* st) {
    XcdBarrier b; b.bar = bar; b.x = xb_xcc_id(); b.st = st;
    if (threadIdx.x == 0) st[2] = xb_add(&bar[XB_XCNT(b.x)], 1u);
    return b;
}
__device__ __forceinline__ void xcd_barrier_complete(unsigned* bar, unsigned x, unsigned& nloc, unsigned& nx) {
    const unsigned G = gridDim.x * gridDim.y * gridDim.z;
    unsigned sum, cnt, mine, sp = 0u;
    for (;;) {
        sum = 0u; cnt = 0u; mine = 0u;
#pragma unroll
        for (unsigned j = 0; j < 16; ++j) { const unsigned c = xb_ld(&bar[XB_XCNT(j)]); sum += c; cnt += (c > 0u) ? 1u : 0u; mine = (j == x) ? c : mine; }
        if (sum == G) break;
        __builtin_amdgcn_s_sleep(1);
        if ((++sp & 255u) == 0u) { if (xb_ld(&bar[XB_TMO])) break; if (sp > XB_SPIN_CAP) { atomicAdd(&bar[XB_TMO], 1u); break; } }
    }
    nloc = mine > 0u ? mine : 1u; nx = cnt > 0u ? cnt : 1u;
}

__device__ __forceinline__ void xcd_barrier(const XcdBarrier& b) {
    asm volatile("s_waitcnt vmcnt(0)" ::: "memory");
    __syncthreads();
    if (threadIdx.x == 0) {
        unsigned* bar = b.bar;
        __builtin_amdgcn_s_waitcnt(0);
        unsigned nloc = b.st[0], nx = b.st[1];
        if (nloc == 0u) { xcd_barrier_complete(bar, b.x, nloc, nx); b.st[0] = nloc; b.st[1] = nx; }
        const unsigned old = xb_add(&bar[XB_XSUB(b.x)], 1u);
        const unsigned gen = old / nloc;
        if (old + 1u == (gen + 1u) * nloc) {
            __builtin_amdgcn_fence(__ATOMIC_RELEASE, "agent");
            asm volatile("s_waitcnt vmcnt(0)" ::: "memory");
            const unsigned og = xb_add(&bar[XB_TOP], 1u);
            const unsigned tg = og / nx;
            if (og + 1u == (tg + 1u) * nx) xb_add(&bar[XB_TOPGEN], 1u);
            else XB_SPIN(xb_ld(&bar[XB_TOPGEN]) == tg, bar);
            __builtin_amdgcn_fence(__ATOMIC_ACQUIRE, "agent");
            xb_add(&bar[XB_XGEN(b.x)], 1u);
            asm volatile("s_waitcnt vmcnt(0)" ::: "memory");
        } else {
            XB_SPIN(xb_ld(&bar[XB_XGEN(b.x)]) == gen, bar);
            __builtin_amdgcn_fence(__ATOMIC_ACQUIRE, "agent");
            asm volatile("s_waitcnt vmcnt(0)" ::: "memory");
        }
    }
    __syncthreads();
}

typedef float f32x16 __attribute__((ext_vector_type(16)));
typedef unsigned v2u __attribute__((ext_vector_type(2)));
typedef int v4i __attribute__((ext_vector_type(4)));
typedef __bf16 bf2_t __attribute__((ext_vector_type(2)));
#define DI __device__ __forceinline__
struct Frame {
    LAS unsigned char* lds;
    volatile LAS unsigned* MISC;
    gu32* ctl;
    int tid, lane, wave, vcu, G;
    const float *x, *norm_mix, *norm_ffn, *w_in, *b_gate, *w_conv, *q_norm, *k_norm, *sinks, *rel_bias, *w_conv_out, *w_attn_out, *w_out, *w_query, *sub_keys, *expert_u, *expert_v;
    float* out;
    bf16 *WIN, *WC, *WA, *WO, *WQ, *SK, *UB, *VB, *XB, *PA, *MIX, *G_, *QP, *Z, *ATT;
    float *RSTD1, *SSQ, *GATE, *ACT, *SU, *SV; bf16* PARTB; unsigned char* XB8; unsigned short* IDX;
};
DI float wave_sum(float v) {
#pragma unroll
    for (int o = 1; o < 64; o <<= 1) v += __shfl_xor(v, o);
    return v;
}
DI float bf_lo(unsigned u) { return __builtin_bit_cast(float, u << 16); }
DI float bf_hi(unsigned u) { return __builtin_bit_cast(float, u & 0xffff0000u); }

DI void p0_transpose_item(const float* W, int K, int N, bf16* WT, const float* gsc, LAS float* scr, int item, int lane) {
    const int nblk = N / 32, kb = item / nblk, nb = item % nblk, k0 = 64 * kb, n0 = 32 * nb;
#pragma unroll 8
    for (int i = 0; i < 32; ++i) { const int kk = 2 * i + (lane >> 5); float v = W[(size_t)(k0 + kk) * N + n0 + (lane & 31)]; if (gsc) v *= gsc[k0 + kk]; scr[kk * 33 + (lane & 31)] = v; }
    LDS_WAIT(); asm volatile("" ::: "memory");
    const int c = lane & 7;
#pragma unroll
    for (int j = 0; j < 4; ++j) { const int n = (lane >> 3) + 8 * j; const LAS float* s = scr + (8 * c) * 33 + n;
        v4u o; o.x = pk2(s[0 * 33], s[1 * 33]); o.y = pk2(s[2 * 33], s[3 * 33]); o.z = pk2(s[4 * 33], s[5 * 33]); o.w = pk2(s[6 * 33], s[7 * 33]);
        *(GAS v4u*)(WT + (size_t)(n0 + n) * K + k0 + 8 * c) = o; }
    LDS_WAIT(); asm volatile("" ::: "memory");
}
DI void p0_convert(Frame& F, const float* src, bf16* dst, size_t n, const float* colscale) {
    const size_t n8 = n / 8, stride = (size_t)F.G * NWAVES * 64;
    for (size_t i = (size_t)F.vcu * NWAVES * 64 + F.tid; i < n8; i += stride) {
        f32x4 a = *(const GAS f32x4*)(src + i * 8), b = *(const GAS f32x4*)(src + i * 8 + 4);
        if (colscale) { const int c = (int)((i * 8) & 1023); const f32x4 s0 = *(const GAS f32x4*)(colscale + c), s1 = *(const GAS f32x4*)(colscale + c + 4); a = a * s0; b = b * s1; }
        v4u o; o.x = pk2(a.x, a.y); o.y = pk2(a.z, a.w); o.z = pk2(b.x, b.y); o.w = pk2(b.z, b.w);
        *(GAS v4u*)(dst + i * 8) = o;
    }
}
constexpr float A_SCALE = 128.f;
DI unsigned pk4_fp8(f32x4 v) { int r = 0; r = __builtin_amdgcn_cvt_pk_fp8_f32(v[0], v[1], r, false); r = __builtin_amdgcn_cvt_pk_fp8_f32(v[2], v[3], r, true); return (unsigned)r; }
DI void p0_convert_fp8(Frame& F, const float* src, unsigned char* dst, size_t n, const float* colscale, float scale, int bidx, int nblk) {
    const int gw = bidx * NWAVES + F.wave, NGW = nblk * NWAVES, lane = F.lane;
    f32x4 cs[4];
#pragma unroll
    for (int q = 0; q < 4; ++q) cs[q] = colscale ? *(const GAS f32x4*)(colscale + 4 * lane + 256 * q) * scale : (f32x4){scale, scale, scale, scale};
    const int nrows = (int)(n / D);
    for (int e = gw; e < nrows; e += NGW) {
        const GAS f32x4* rp = (const GAS f32x4*)(src + (size_t)e * D) + lane;
        f32x4 v[4];
#pragma unroll
        for (int q = 0; q < 4; ++q) v[q] = rp[64 * q];
#pragma unroll
        for (int q = 0; q < 4; ++q) *(GAS unsigned*)(dst + ((size_t)(2 * q + (lane >> 5)) * NEXP + e) * 128 + ((4 * lane) & 127)) = pk4_fp8(v[q] * cs[q]);
    }
}
DI void p0_convert_fp4(Frame& F, const float* src, const float* gain, unsigned char* dst, float* scl, int e0, int e1) {
    const int gw = F.wave, NGW = NWAVES, lane = F.lane;
    f32x4 cs[4];
#pragma unroll
    for (int q = 0; q < 4; ++q) cs[q] = gain ? *(const GAS f32x4*)(gain + 4 * lane + 256 * q) : (f32x4){1.f, 1.f, 1.f, 1.f};
    for (int e = e0 + gw; e < e1; e += NGW) {
        const GAS f32x4* rp = (const GAS f32x4*)(src + (size_t)e * D) + lane;
        f32x4 v[4]; float mx = 0.f;
#pragma unroll
        for (int q = 0; q < 4; ++q) { v[q] = rp[64 * q] * cs[q]; mx = fmaxf(mx, fmaxf(fmaxf(fabsf(v[q][0]), fabsf(v[q][1])), fmaxf(fabsf(v[q][2]), fabsf(v[q][3])))); }
#pragma unroll
        for (int o = 1; o < 64; o <<= 1) mx = fmaxf(mx, __shfl_xor(mx, o));
        const float inv = mx > 0.f ? 6.f / mx : 0.f;
        if (lane == 0) scl[e] = mx * (1.f / 6.f);
#pragma unroll
        for (int q = 0; q < 4; ++q) { unsigned r = 0u;
            r = __builtin_amdgcn_cvt_scalef32_pk_fp4_f32(r, v[q][0] * inv, v[q][1] * inv, 1.0f, 0);
            r = __builtin_amdgcn_cvt_scalef32_pk_fp4_f32(r, v[q][2] * inv, v[q][3] * inv, 1.0f, 1);
            *(GAS unsigned short*)(dst + ((size_t)q * NEXP + e) * 128 + 2 * lane) = (unsigned short)r; }
    }
}
template <int RB> DI void p0_rows(Frame& F, const float* xrow, bf16* orow, float* rms_out) {
    f32x4 v[RB][4]; float s[RB];
#pragma unroll
    for (int r = 0; r < RB; ++r) { const GAS f32x4* xr = (const GAS f32x4*)(xrow + (size_t)r * D) + F.lane;
#pragma unroll
        for (int j = 0; j < 4; ++j) v[r][j] = xr[64 * j]; }
#pragma unroll
    for (int r = 0; r < RB; ++r) { s[r] = 0.f;
#pragma unroll
        for (int j = 0; j < 4; ++j) s[r] += (v[r][j].x * v[r][j].x + v[r][j].y * v[r][j].y) + (v[r][j].z * v[r][j].z + v[r][j].w * v[r][j].w); }
#pragma unroll
    for (int o = 1; o < 64; o <<= 1)
#pragma unroll
        for (int r = 0; r < RB; ++r) s[r] += __shfl_xor(s[r], o);
#pragma unroll
    for (int r = 0; r < RB; ++r) { const float rms = sqrtf(s[r] * (1.f / D) + EPS), rs = 1.f / rms; if (F.lane == 0) rms_out[r] = rms;
        GAS unsigned long long* o8 = (GAS unsigned long long*)(orow + (size_t)r * D) + F.lane;
#pragma unroll
        for (int j = 0; j < 4; ++j) o8[64 * j] = (unsigned long long)pk2(v[r][j].x * rs, v[r][j].y * rs) | ((unsigned long long)pk2(v[r][j].z * rs, v[r][j].w * rs) << 32); }
}
DI void p0_prologue(Frame& F) {
    LAS float* scr = (LAS float*)(F.lds + RING_OFF + F.wave * 16384);
    const int gw = F.vcu * NWAVES + F.wave, NGW = F.G * NWAVES;
    constexpr int I_IN = (D / 64) * (IN_DIM / 32), I_C = (CONV / 64) * (D / 32), I_O = (D / 64) * (D / 32), I_Q = (D / 64) * (PQ / 32);
    constexpr int NITEMS = I_IN + 2 * I_C + I_O + I_Q;
    for (int it = gw; it < NITEMS; it += NGW) {
        int r = it;
        if (r < I_IN) { p0_transpose_item(F.w_in, D, IN_DIM, F.WIN, F.norm_mix, scr, r, F.lane); continue; } r -= I_IN;
        if (r < I_C) { p0_transpose_item(F.w_conv_out, CONV, D, F.WC, nullptr, scr, r, F.lane); continue; } r -= I_C;
        if (r < I_C) { p0_transpose_item(F.w_attn_out, CONV, D, F.WA, nullptr, scr, r, F.lane); continue; } r -= I_C;
        if (r < I_O) { p0_transpose_item(F.w_out, D, D, F.WO, nullptr, scr, r, F.lane); continue; } r -= I_O;
        p0_transpose_item(F.w_query, D, PQ, F.WQ, F.norm_ffn, scr, r, F.lane);
    }
    p0_convert(F, F.sub_keys, F.SK, (size_t)PH * 2 * NKEYS * 128, nullptr);
    for (int m = 4 * gw; m < T; m += 4 * NGW) p0_rows<4>(F, F.x + (size_t)m * D, F.XB + (size_t)m * D, F.RSTD1 + m);
}

namespace pg8 {
DI float sigmoidf_(float v) { return __builtin_amdgcn_rcpf(1.f + __expf(-v)); }
DI size_t frag_off(int pm, int pn, int NT, int wave, int q, int lane) { return (((((size_t)pm * NT + pn) * 8 + wave) * 16 + q) * 64 + lane) * 8; }
struct EpiProj {
    static constexpr bool PERM = true, AFTER_DRAIN = false, HAS_INIT = false;
    bf16_t* PA; bf16_t* G; const PG8_LAS float* bgl;
    DI void operator()(const f32x4 (&acc)[2][2][4][2], const Unit& u, int wr, int wc, int fr, int fq) const {
        const int row0 = u.pm * BM + wr * 64 + fr; const bool gate = u.pn >= 9;
        const int col0 = (gate ? (u.pn - 9) : u.pn) * BM + wc * 32 + 8 * fq;
        if (!gate) {
#pragma unroll
            for (int ai = 0; ai < 2; ++ai)
#pragma unroll
                for (int m = 0; m < 4; ++m) { bf16_t* rowp = PA + (size_t)(row0 + ai * HALF + m * 16) * PA_W + col0;
#pragma unroll
                    for (int bj = 0; bj < 2; ++bj) { const f32x4 v0 = acc[ai][bj][m][0], v1 = acc[ai][bj][m][1];
                        u32x4 w; w.x = cvt_pk_bf16(v0[0], v0[1]); w.y = cvt_pk_bf16(v0[2], v0[3]); w.z = cvt_pk_bf16(v1[0], v1[1]); w.w = cvt_pk_bf16(v1[2], v1[3]);
                        store16_wt(rowp + bj * HALF, w); } }
        } else {
            f32x4 bv[2][2];
#pragma unroll
            for (int bj = 0; bj < 2; ++bj)
#pragma unroll
                for (int n = 0; n < 2; ++n) bv[bj][n] = *(const PG8_LAS f32x4*)(bgl + col0 + bj * HALF + 4 * n);
#pragma unroll
            for (int ai = 0; ai < 2; ++ai)
#pragma unroll
                for (int m = 0; m < 4; ++m)
#pragma unroll
                    for (int bj = 0; bj < 2; ++bj) { f32x4 v0 = acc[ai][bj][m][0] + bv[bj][0], v1 = acc[ai][bj][m][1] + bv[bj][1];
#pragma unroll
                        for (int j = 0; j < 4; ++j) { v0[j] = sigmoidf_(v0[j]) * 255.f; v1[j] = sigmoidf_(v1[j]) * 255.f; }
                        unsigned g0 = 0u, g1 = 0u;
                        g0 = __builtin_amdgcn_cvt_pk_u8_f32(v0[0], 0, g0); g0 = __builtin_amdgcn_cvt_pk_u8_f32(v0[1], 1, g0); g0 = __builtin_amdgcn_cvt_pk_u8_f32(v0[2], 2, g0); g0 = __builtin_amdgcn_cvt_pk_u8_f32(v0[3], 3, g0);
                        g1 = __builtin_amdgcn_cvt_pk_u8_f32(v1[0], 0, g1); g1 = __builtin_amdgcn_cvt_pk_u8_f32(v1[1], 1, g1); g1 = __builtin_amdgcn_cvt_pk_u8_f32(v1[2], 2, g1); g1 = __builtin_amdgcn_cvt_pk_u8_f32(v1[3], 3, g1);
                        u32x2 gw; gw.x = g0; gw.y = g1;
                        *(u32x2*)((unsigned char*)G + frag_off(u.pm, u.pn - 9, 8, wr * 4 + wc, ai * 8 + m * 2 + bj, fq * 16 + fr)) = gw; }
        }
    }
};
struct EpiMix {
    static constexpr bool PERM = true, AFTER_DRAIN = false, HAS_INIT = false;
    bf16_t* MIX; const bf16_t* G;
    DI void operator()(const f32x4 (&acc)[2][2][4][2], const Unit& u, int wr, int wc, int fr, int fq) const {
        const int wave = wr * 4 + wc, lane = fq * 16 + fr;
        const unsigned char* gp = (const unsigned char*)G + frag_off(u.pm, u.pn + (u.which ? 4 : 0), 8, wave, 0, lane); bf16_t* mp = MIX + frag_off(u.pm, u.pn, 4, wave, 0, lane);
#pragma unroll
        for (int ai = 0; ai < 2; ++ai) {
            u32x2 gv[8]; u32x4 ov[8];
#pragma unroll
            for (int q = 0; q < 8; ++q) gv[q] = *(const u32x2*)(gp + (ai * 8 + q) * 512);
            if (u.which) {
#pragma unroll
                for (int q = 0; q < 8; ++q) ov[q] = *(const u32x4*)(mp + (ai * 8 + q) * 512); }
#pragma unroll
            for (int m = 0; m < 4; ++m)
#pragma unroll
                for (int bj = 0; bj < 2; ++bj) { const int q = m * 2 + bj; const u32x2 g2 = gv[q]; constexpr float GI = 1.f / 255.f;
                    f32x4 v0 = acc[ai][bj][m][0], v1 = acc[ai][bj][m][1];
                    v0[0] *= (float)(g2.x & 0xffu) * GI; v0[1] *= (float)((g2.x >> 8) & 0xffu) * GI; v0[2] *= (float)((g2.x >> 16) & 0xffu) * GI; v0[3] *= (float)(g2.x >> 24) * GI;
                    v1[0] *= (float)(g2.y & 0xffu) * GI; v1[1] *= (float)((g2.y >> 8) & 0xffu) * GI; v1[2] *= (float)((g2.y >> 16) & 0xffu) * GI; v1[3] *= (float)(g2.y >> 24) * GI;
                    if (u.which) { const u32x4 o = ov[q];
                        v0[0] += __builtin_bit_cast(float, o.x << 16); v0[1] += __builtin_bit_cast(float, o.x & 0xffff0000u); v0[2] += __builtin_bit_cast(float, o.y << 16); v0[3] += __builtin_bit_cast(float, o.y & 0xffff0000u);
                        v1[0] += __builtin_bit_cast(float, o.z << 16); v1[1] += __builtin_bit_cast(float, o.z & 0xffff0000u); v1[2] += __builtin_bit_cast(float, o.w << 16); v1[3] += __builtin_bit_cast(float, o.w & 0xffff0000u); }
                    u32x4 w; w.x = cvt_pk_bf16(v0[0], v0[1]); w.y = cvt_pk_bf16(v0[2], v0[3]); w.z = cvt_pk_bf16(v1[0], v1[1]); w.w = cvt_pk_bf16(v1[2], v1[3]);
                    if (u.which) store16_wt(mp + (ai * 8 + q) * 512, w); else *(u32x4*)(mp + (ai * 8 + q) * 512) = w; }
        }
    }
};
struct FragOrder : StaticOrder { static constexpr bool AFRAG = true; };
struct PairOrder : StaticOrder {
    __device__ bool next(int i, Unit& u) const { const bool ok = StaticOrder::next(i >> 1, u); u.which = i & 1; return ok; }
    DI const char* a_base(const Gemm& g, const Unit& u, size_t tstep) const { return (const char*)(u.which ? g.A2 : g.A) + (size_t)u.pm * tstep; }
    DI const char* b_base(const Gemm& g, const Unit& u, size_t tstep) const { return (const char*)(u.which ? g.Bt2 : g.Bt) + (size_t)u.pn * tstep; }
};
struct EpiX1 {
    static constexpr bool PERM = true, AFTER_DRAIN = false, HAS_INIT = true;
    const float* RMS; bf16_t* XB; float* SSQ; unsigned char* XB8;
    DI void init(f32x4 (&acc)[2][2][4][2], const Unit& u, int wr, int wc, int fr, int fq) const {
        const int row0 = u.pm * BM + wr * 64 + fr, col0 = u.pn * BM + wc * 32 + 8 * fq;
#pragma unroll
        for (int ai = 0; ai < 2; ++ai)
#pragma unroll
            for (int m = 0; m < 4; ++m)
#pragma unroll
                for (int bj = 0; bj < 2; ++bj) { const int row = row0 + ai * HALF + m * 16; const float rm = RMS[row];
                    const u32x4 xn = *(const u32x4*)(XB + (size_t)row * D + col0 + bj * HALF);
                    acc[ai][bj][m][0] = (f32x4){__builtin_bit_cast(float, xn.x << 16), __builtin_bit_cast(float, xn.x & 0xffff0000u), __builtin_bit_cast(float, xn.y << 16), __builtin_bit_cast(float, xn.y & 0xffff0000u)} * rm;
                    acc[ai][bj][m][1] = (f32x4){__builtin_bit_cast(float, xn.z << 16), __builtin_bit_cast(float, xn.z & 0xffff0000u), __builtin_bit_cast(float, xn.w << 16), __builtin_bit_cast(float, xn.w & 0xffff0000u)} * rm; }
    }
    DI void operator()(const f32x4 (&acc)[2][2][4][2], const Unit& u, int wr, int wc, int fr, int fq) const {
        const int row0 = u.pm * BM + wr * 64 + fr, col0 = u.pn * BM + wc * 32 + 8 * fq;
#pragma unroll
        for (int ai = 0; ai < 2; ++ai)
#pragma unroll
            for (int m = 0; m < 4; ++m) { const int row = row0 + ai * HALF + m * 16; float ss = 0.f;
#pragma unroll
                for (int bj = 0; bj < 2; ++bj) { const f32x4 v0 = acc[ai][bj][m][0], v1 = acc[ai][bj][m][1];
                    ss += ((v0[0] * v0[0] + v0[1] * v0[1]) + (v0[2] * v0[2] + v0[3] * v0[3])) + ((v1[0] * v1[0] + v1[1] * v1[1]) + (v1[2] * v1[2] + v1[3] * v1[3]));
                    u32x4 w; w.x = cvt_pk_bf16(v0[0], v0[1]); w.y = cvt_pk_bf16(v0[2], v0[3]); w.z = cvt_pk_bf16(v1[0], v1[1]); w.w = cvt_pk_bf16(v1[2], v1[3]);
                    store16_wt(XB + (size_t)row * D + col0 + bj * HALF, w);
                    { int p0_ = 0, p1_ = 0;
                      p0_ = __builtin_amdgcn_cvt_pk_fp8_f32(v0[0], v0[1], p0_, false); p0_ = __builtin_amdgcn_cvt_pk_fp8_f32(v0[2], v0[3], p0_, true);
                      p1_ = __builtin_amdgcn_cvt_pk_fp8_f32(v1[0], v1[1], p1_, false); p1_ = __builtin_amdgcn_cvt_pk_fp8_f32(v1[2], v1[3], p1_, true);
                      u32x2 w8; w8.x = (unsigned)p0_; w8.y = (unsigned)p1_; *(u32x2*)(XB8 + (size_t)row * D + col0 + bj * HALF) = w8; } }
                ss += __shfl_xor(ss, 16); ss += __shfl_xor(ss, 32);
                if (fq == 0) SSQ[(size_t)row * 16 + u.pn * 4 + wc] = ss; }
    }
};
DI float rstd2_of(const float* SSQ, int row) {
    const f32x4 a = *(const f32x4*)(SSQ + (size_t)row * 16), b = *(const f32x4*)(SSQ + (size_t)row * 16 + 4), c = *(const f32x4*)(SSQ + (size_t)row * 16 + 8), d = *(const f32x4*)(SSQ + (size_t)row * 16 + 12);
    const float s = ((a[0] + a[1]) + (a[2] + a[3])) + ((b[0] + b[1]) + (b[2] + b[3])) + ((c[0] + c[1]) + (c[2] + c[3])) + ((d[0] + d[1]) + (d[2] + d[3]));
    return 1.f / sqrtf(s * (1.f / D) + EPS);
}
struct EpiQP {
    static constexpr bool PERM = true, AFTER_DRAIN = false, HAS_INIT = false;
    bf16_t* QP;
    DI void operator()(const f32x4 (&acc)[2][2][4][2], const Unit& u, int wr, int wc, int fr, int fq) const {
        const int row0 = u.pm * BM + wr * 64 + fr, col0 = u.pn * BM + wc * 32 + 8 * fq;
#pragma unroll
        for (int ai = 0; ai < 2; ++ai)
#pragma unroll
            for (int m = 0; m < 4; ++m) {
#pragma unroll
                for (int bj = 0; bj < 2; ++bj) { const f32x4 v0 = acc[ai][bj][m][0], v1 = acc[ai][bj][m][1];
                    u32x4 w; w.x = cvt_pk_bf16(v0[0], v0[1]); w.y = cvt_pk_bf16(v0[2], v0[3]); w.z = cvt_pk_bf16(v1[0], v1[1]); w.w = cvt_pk_bf16(v1[2], v1[3]);
                    *(u32x4*)(QP + frag_off(u.pm, u.pn, 8, wr * 4 + wc, ai * 8 + m * 2 + bj, fq * 16 + fr)) = w; } }
    }
};
}

#define MFMA32(a, b, c) __builtin_amdgcn_mfma_f32_32x32x16_bf16((a), (b), (c), 0, 0, 0)
DI void p2_conv(Frame& F) {
    constexpr int CT = 4;
    const size_t NT_ = (size_t)F.G * NWAVES * 64;
    for (size_t item = (size_t)F.vcu * NWAVES * 64 + F.tid; item < (size_t)(T / CT) * 64; item += NT_) {
        const int tb = (int)(item >> 6) * CT, c0 = (int)(item & 63) * 8, tl = tb & (SEQ - 1);
        v4u cg[CT + 2], uu[CT + 2], bg[CT];
#pragma unroll
        for (int r = 0; r < CT + 2; ++r) { const bool ok = (tl + r - 2) >= 0; const bf16* rowp = F.PA + (size_t)(tb + (ok ? r - 2 : 0)) * PA_W;
            cg[r] = *(const GAS v4u*)(rowp + C_C + c0); uu[r] = *(const GAS v4u*)(rowp + C_U + c0);
            if (!ok) { cg[r] = (v4u){0u, 0u, 0u, 0u}; } }
#pragma unroll
        for (int r = 0; r < CT; ++r) bg[r] = *(const GAS v4u*)(F.PA + (size_t)(tb + r) * PA_W + C_B + c0);
        f32x4 w[3][2];
#pragma unroll
        for (int j = 0; j < 3; ++j) { w[j][0] = *(const GAS f32x4*)(F.w_conv + j * CONV + c0); w[j][1] = *(const GAS f32x4*)(F.w_conv + j * CONV + c0 + 4); }
        float h[CT + 2][8];
#pragma unroll
        for (int r = 0; r < CT + 2; ++r) { h[r][0] = bf_lo(cg[r].x) * bf_lo(uu[r].x); h[r][1] = bf_hi(cg[r].x) * bf_hi(uu[r].x); h[r][2] = bf_lo(cg[r].y) * bf_lo(uu[r].y); h[r][3] = bf_hi(cg[r].y) * bf_hi(uu[r].y);
            h[r][4] = bf_lo(cg[r].z) * bf_lo(uu[r].z); h[r][5] = bf_hi(cg[r].z) * bf_hi(uu[r].z); h[r][6] = bf_lo(cg[r].w) * bf_lo(uu[r].w); h[r][7] = bf_hi(cg[r].w) * bf_hi(uu[r].w); }
#pragma unroll
        for (int r = 0; r < CT; ++r) {
            float a[8];
#pragma unroll
            for (int e = 0; e < 8; ++e) a[e] = w[0][e >> 2][e & 3] * h[r][e] + w[1][e >> 2][e & 3] * h[r + 1][e] + w[2][e >> 2][e & 3] * h[r + 2][e];
            v4u o; o.x = pk2(a[0] * bf_lo(bg[r].x), a[1] * bf_hi(bg[r].x)); o.y = pk2(a[2] * bf_lo(bg[r].y), a[3] * bf_hi(bg[r].y));
            o.z = pk2(a[4] * bf_lo(bg[r].z), a[5] * bf_hi(bg[r].z)); o.w = pk2(a[6] * bf_lo(bg[r].w), a[7] * bf_hi(bg[r].w));
            *(GAS v4u*)(F.Z + (size_t)(tb + r) * CONV + c0) = o;
        }
    }
}
DI int t5_bucket(int d) {
    if (d < 16) return d;
    const int large = 16 + (int)(logf((float)d / 16.f) / logf(8.f) * 16.f);
    return large < 31 ? large : 31;
}
constexpr int KS_STRIDE = 72, VT_STRIDE = 264;
constexpr int ATT_KS = 0, ATT_VT = 256 * KS_STRIDE * 2, ATT_BIAS = ATT_VT + 64 * VT_STRIDE * 2, ATT_END = ATT_BIAS + 4 * 128 * 4;
static_assert(ATT_END <= RING_BYTES, "attention LDS");
DI void p2_attention(Frame& F) {
    LAS bf16* KS = (LAS bf16*)(F.lds + ATT_KS); LAS bf16* VT = (LAS bf16*)(F.lds + ATT_VT); LAS float* BIAS = (LAS float*)(F.lds + ATT_BIAS);
    const int lane = F.lane, r = lane & 31, hh = lane >> 5;
#pragma unroll 1
    for (int unit = F.vcu; unit < 8 * 32 * NKV; unit += F.G) {
        const int kv = unit & 1, n = (unit >> 1) & 31, b = unit >> 6;
        const int t0 = b * SEQ + n * 128;
        __syncthreads();
        {
            const int j = F.tid >> 1, hf = F.tid & 1; const bool valid = (n > 0) || (j >= 128);
            const bf16* rowp = F.PA + (size_t)(t0 - 128 + j) * PA_W;
            v4u kq[4], vq[4];
#pragma unroll
            for (int i = 0; i < 4; ++i) { kq[i] = (v4u){0u, 0u, 0u, 0u}; vq[i] = kq[i]; }
            if (valid) {
#pragma unroll
                for (int i = 0; i < 4; ++i) { kq[i] = *(const GAS v4u*)(rowp + C_K + kv * HD + hf * 32 + i * 8); vq[i] = *(const GAS v4u*)(rowp + C_V + kv * HD + hf * 32 + i * 8); }
            }
            float kf[32]; float ss = 0.f;
#pragma unroll
            for (int i = 0; i < 4; ++i) { kf[8 * i + 0] = bf_lo(kq[i].x); kf[8 * i + 1] = bf_hi(kq[i].x); kf[8 * i + 2] = bf_lo(kq[i].y); kf[8 * i + 3] = bf_hi(kq[i].y);
                kf[8 * i + 4] = bf_lo(kq[i].z); kf[8 * i + 5] = bf_hi(kq[i].z); kf[8 * i + 6] = bf_lo(kq[i].w); kf[8 * i + 7] = bf_hi(kq[i].w); }
#pragma unroll
            for (int e = 0; e < 32; ++e) ss += kf[e] * kf[e];
            ss += __shfl_xor(ss, 1);
            const float rs = 1.f / sqrtf(ss * (1.f / HD) + EPS);
#pragma unroll
            for (int i = 0; i < 4; ++i) { const f32x4 g0 = *(const GAS f32x4*)(F.k_norm + hf * 32 + 8 * i), g1 = *(const GAS f32x4*)(F.k_norm + hf * 32 + 8 * i + 4);
                v4u o; o.x = pk2(kf[8 * i + 0] * rs * g0[0], kf[8 * i + 1] * rs * g0[1]); o.y = pk2(kf[8 * i + 2] * rs * g0[2], kf[8 * i + 3] * rs * g0[3]);
                o.z = pk2(kf[8 * i + 4] * rs * g1[0], kf[8 * i + 5] * rs * g1[1]); o.w = pk2(kf[8 * i + 6] * rs * g1[2], kf[8 * i + 7] * rs * g1[3]);
                *(LAS v4u*)(KS + j * KS_STRIDE + hf * 32 + 8 * i) = o; }
#pragma unroll
            for (int i = 0; i < 4; ++i) { const int d0 = hf * 32 + 8 * i;
                VT[(d0 + 0) * VT_STRIDE + j] = (bf16)(vq[i].x & 0xffffu); VT[(d0 + 1) * VT_STRIDE + j] = (bf16)(vq[i].x >> 16);
                VT[(d0 + 2) * VT_STRIDE + j] = (bf16)(vq[i].y & 0xffffu); VT[(d0 + 3) * VT_STRIDE + j] = (bf16)(vq[i].y >> 16);
                VT[(d0 + 4) * VT_STRIDE + j] = (bf16)(vq[i].z & 0xffffu); VT[(d0 + 5) * VT_STRIDE + j] = (bf16)(vq[i].z >> 16);
                VT[(d0 + 6) * VT_STRIDE + j] = (bf16)(vq[i].w & 0xffffu); VT[(d0 + 7) * VT_STRIDE + j] = (bf16)(vq[i].w >> 16); }
            { const int g = F.tid >> 7, dist = F.tid & 127; BIAS[F.tid] = F.rel_bias[t5_bucket(dist) * NH + kv * 4 + g]; }
        }
        __syncthreads();
#pragma unroll 1
        for (int task = F.wave; task < 16; task += NWAVES) {
            const int g = task >> 2, c = task & 3, head = kv * 4 + g, r0 = 32 * c;
            bf16x8 qf[4];
            {
                const bf16* qp = F.PA + (size_t)(t0 + r0 + r) * PA_W + C_Q + head * HD + 8 * hh;
                v4u qq[4]; float qv[32]; float ss = 0.f;
#pragma unroll
                for (int s = 0; s < 4; ++s) qq[s] = *(const GAS v4u*)(qp + 16 * s);
#pragma unroll
                for (int s = 0; s < 4; ++s) { qv[8 * s + 0] = bf_lo(qq[s].x); qv[8 * s + 1] = bf_hi(qq[s].x); qv[8 * s + 2] = bf_lo(qq[s].y); qv[8 * s + 3] = bf_hi(qq[s].y);
                    qv[8 * s + 4] = bf_lo(qq[s].z); qv[8 * s + 5] = bf_hi(qq[s].z); qv[8 * s + 6] = bf_lo(qq[s].w); qv[8 * s + 7] = bf_hi(qq[s].w); }
#pragma unroll
                for (int e = 0; e < 32; ++e) ss += qv[e] * qv[e];
                ss += __shfl_xor(ss, 32);
                const float rs = 0.125f / sqrtf(ss * (1.f / HD) + EPS);
#pragma unroll
                for (int s = 0; s < 4; ++s) { const f32x4 g0 = *(const GAS f32x4*)(F.q_norm + 16 * s + 8 * hh), g1 = *(const GAS f32x4*)(F.q_norm + 16 * s + 8 * hh + 4);
                    v4u o; o.x = pk2(qv[8 * s + 0] * rs * g0[0], qv[8 * s + 1] * rs * g0[1]); o.y = pk2(qv[8 * s + 2] * rs * g0[2], qv[8 * s + 3] * rs * g0[3]);
                    o.z = pk2(qv[8 * s + 4] * rs * g1[0], qv[8 * s + 5] * rs * g1[1]); o.w = pk2(qv[8 * s + 6] * rs * g1[2], qv[8 * s + 7] * rs * g1[3]);
                    qf[s] = __builtin_bit_cast(bf16x8, o); }
            }
            f32x16 sacc[5];
#pragma unroll
            for (int i5 = 0; i5 < 5; ++i5) {
#pragma unroll
                for (int e = 0; e < 16; ++e) sacc[i5][e] = 0.f;
                const int kt = c + i5;
#pragma unroll
                for (int s = 0; s < 4; ++s) { const bf16x8 ka = *(const LAS bf16x8*)(KS + (32 * kt + r) * KS_STRIDE + 16 * s + 8 * hh); sacc[i5] = MFMA32(ka, qf[s], sacc[i5]); }
            }
            const float sink = F.sinks[head];
            const int dbase = r - 4 * hh + 128;
            const LAS float* bl = BIAS + g * 128;
            float mx = sink;
#pragma unroll
            for (int i5 = 0; i5 < 5; ++i5) {
                const bool tile_ok = (n > 0) || (c + i5 >= 4);
#pragma unroll
                for (int e = 0; e < 16; ++e) { const int dist = dbase - 32 * i5 - ((e & 3) + 8 * (e >> 2));
                    bool valid = tile_ok; if (i5 == 0) valid = valid && (dist < 128); if (i5 == 4) valid = valid && (dist >= 0);
                    const float lg = sacc[i5][e] + bl[dist & 127];
                    sacc[i5][e] = valid ? lg : -INFINITY; mx = fmaxf(mx, sacc[i5][e]); }
                __builtin_amdgcn_sched_barrier(0);
            }
            mx = fmaxf(mx, __shfl_xor(mx, 32));
            float sum = 0.f;
#pragma unroll
            for (int i5 = 0; i5 < 5; ++i5)
#pragma unroll
                for (int e = 0; e < 16; ++e) { const float p = __expf(sacc[i5][e] - mx); sacc[i5][e] = p; sum += p; }
            sum += __shfl_xor(sum, 32);
            const float inv = 1.f / (sum + __expf(sink - mx));
            f32x16 oacc[2];
#pragma unroll
            for (int dt = 0; dt < 2; ++dt)
#pragma unroll
                for (int e = 0; e < 16; ++e) oacc[dt][e] = 0.f;
#pragma unroll
            for (int i5 = 0; i5 < 5; ++i5)
#pragma unroll
                for (int s2 = 0; s2 < 2; ++s2) {
                    v4u pp; pp.x = pk2(sacc[i5][8 * s2 + 0] * inv, sacc[i5][8 * s2 + 1] * inv); pp.y = pk2(sacc[i5][8 * s2 + 2] * inv, sacc[i5][8 * s2 + 3] * inv);
                    pp.z = pk2(sacc[i5][8 * s2 + 4] * inv, sacc[i5][8 * s2 + 5] * inv); pp.w = pk2(sacc[i5][8 * s2 + 6] * inv, sacc[i5][8 * s2 + 7] * inv);
                    const bf16x8 pb = __builtin_bit_cast(bf16x8, pp);
                    const int kb = 32 * (c + i5) + 16 * s2 + 4 * hh;
#pragma unroll
                    for (int dt = 0; dt < 2; ++dt) {
                        const v2u lo = *(const LAS v2u*)(VT + (32 * dt + r) * VT_STRIDE + kb), hi = *(const LAS v2u*)(VT + (32 * dt + r) * VT_STRIDE + kb + 8);
                        v4u va; va.x = lo.x; va.y = lo.y; va.z = hi.x; va.w = hi.y;
                        oacc[dt] = MFMA32(__builtin_bit_cast(bf16x8, va), pb, oacc[dt]);
                    }
                    __builtin_amdgcn_sched_barrier(0);
                }
            bf16* op = F.ATT + (size_t)(t0 + r0 + r) * CONV + head * HD;
#pragma unroll
            for (int dt = 0; dt < 2; ++dt)
#pragma unroll
                for (int g4 = 0; g4 < 4; ++g4) { v2u w; w.x = pk2(oacc[dt][4 * g4 + 0], oacc[dt][4 * g4 + 1]); w.y = pk2(oacc[dt][4 * g4 + 2], oacc[dt][4 * g4 + 3]);
#ifdef ZERO_ATT
                    w.x = 0u; w.y = 0u;
#endif
                    *(GAS v2u*)(op + 32 * dt + 8 * g4 + 4 * hh) = w; }
        }
    }
}

DI unsigned f2ord(float f) { const unsigned b = __builtin_bit_cast(unsigned, f); return b ^ ((b >> 31) ? 0xffffffffu : 0x80000000u); }
DI float ord2f(unsigned k) { const unsigned b = k ^ ((k >> 31) ? 0x80000000u : 0xffffffffu); return __builtin_bit_cast(float, b); }
DI unsigned umax_(unsigned a, unsigned b) { return a > b ? a : b; }
DI unsigned umin_(unsigned a, unsigned b) { return a < b ? a : b; }
DI void sort16_desc(unsigned (&v)[16]) {
#pragma unroll
    for (int k = 2; k <= 16; k <<= 1)
#pragma unroll
        for (int j = k >> 1; j > 0; j >>= 1)
#pragma unroll
            for (int i = 0; i < 16; ++i) { const int l = i ^ j; if (l > i) { const bool desc = ((i & k) == 0) || (k == 16); const unsigned a = v[i], b = v[l], hi = umax_(a, b), lo = umin_(a, b); v[i] = desc ? hi : lo; v[l] = desc ? lo : hi; } }
}
DI void merge_top16(unsigned (&a)[16], const unsigned (&b)[16]) {
#pragma unroll
    for (int i = 0; i < 16; ++i) a[i] = umax_(a[i], b[15 - i]);
#pragma unroll
    for (int j = 8; j > 0; j >>= 1)
#pragma unroll
        for (int i = 0; i < 16; ++i) { const int l = i ^ j; if (l > i) { const unsigned x = a[i], y = a[l]; a[i] = umax_(x, y); a[l] = umin_(x, y); } }
}
constexpr int SK_STRIDE = 136;
constexpr int P6_KEYS = 0, P6_IB = 2 * NKEYS * SK_STRIDE * 2, P6_END = P6_IB + NWAVES * 64 * 32;
static_assert(P6_END <= RING_BYTES, "topk LDS");
DI void p6_topk(Frame& F) {
    LAS bf16* KL = (LAS bf16*)(F.lds + P6_KEYS); LAS unsigned char* IB = F.lds + P6_IB + (F.wave * 64 + F.lane) * 32;
    const int lane = F.lane, r = lane & 31, hh = lane >> 5;
    pg8::StaticOrder S; S.init(T, PQ, F.G, (int)blockIdx.x);
    pg8::Unit pu;
    for (int ui = 0; S.next(ui, pu); ++ui) {
        const int h = pu.pn, tile = pu.pm;
        __syncthreads();
        {
            const bf16* src = F.SK + (size_t)h * 2 * NKEYS * 128;
#pragma unroll
            for (int i = 0; i < 8; ++i) { const int ch = F.tid + 512 * i; const int row = ch >> 4, c8 = (ch & 15) * 8;
                *(LAS v4u*)(KL + row * SK_STRIDE + c8) = *(const GAS v4u*)(src + (size_t)row * 128 + c8); }
        }
        __syncthreads();
        const int t = tile * 256 + F.wave * 32 + r;
        unsigned S[2][16];
#pragma unroll
        for (int p = 0; p < 2; ++p) {
            bf16x8 qf[8];
            const int rt = F.wave * 32 + r, q_ai = rt >> 7, q_wr = (rt >> 6) & 1, q_m = (rt >> 4) & 3, q_fr = rt & 15;
#pragma unroll
            for (int s = 0; s < 8; ++s) qf[s] = __builtin_bit_cast(bf16x8, *(const GAS v4u*)(F.QP + pg8::frag_off(tile, h, 8, q_wr * 4 + (s >> 1), q_ai * 8 + q_m * 2 + p, (2 * (s & 1) + hh) * 16 + q_fr)));
            unsigned key[4][16];
#pragma unroll
            for (int kt = 0; kt < 4; ++kt) {
                f32x16 acc;
#pragma unroll
                for (int e = 0; e < 16; ++e) acc[e] = 0.f;
#pragma unroll
                for (int s = 0; s < 8; ++s) { const bf16x8 ka = *(const LAS bf16x8*)(KL + (p * NKEYS + 32 * kt + r) * SK_STRIDE + 16 * s + 8 * hh); acc = MFMA32(ka, qf[s], acc); }
#pragma unroll
                for (int e = 0; e < 16; ++e) { const int nk = 32 * kt + (e & 3) + 8 * (e >> 2) + 4 * hh; key[kt][e] = (f2ord(acc[e]) & ~127u) | (unsigned)(127 - nk); }
            }
#pragma unroll
            for (int kt = 0; kt < 4; ++kt) sort16_desc(key[kt]);
            merge_top16(key[0], key[1]); merge_top16(key[2], key[3]); merge_top16(key[0], key[2]);
            unsigned other[16];
#pragma unroll
            for (int i = 0; i < 16; ++i) other[i] = (unsigned)__shfl_xor((int)key[0][i], 32);
            merge_top16(key[0], other);
#pragma unroll
            for (int i = 0; i < 16; ++i) S[p][i] = key[0][i];
        }
        float s0[16], s1[16]; const float rs2 = pg8::rstd2_of(F.SSQ, t);
#pragma unroll
        for (int i = 0; i < 16; ++i) { s0[i] = ord2f(S[0][i] & ~127u) * rs2; s1[i] = ord2f(S[1][i] & ~127u) * rs2; }
        {
#pragma unroll
            for (int q4 = 0; q4 < 4; ++q4) { unsigned w0 = 0, w1 = 0;
#pragma unroll
                for (int e = 0; e < 4; ++e) { w0 |= (127u - (S[0][4 * q4 + e] & 127u)) << (8 * e); w1 |= (127u - (S[1][4 * q4 + e] & 127u)) << (8 * e); }
                *(LAS unsigned*)(IB + 4 * q4) = w0; *(LAS unsigned*)(IB + 16 + 4 * q4) = w1; }
        }
        unsigned cand[2][16];
#pragma unroll
        for (int i = 0; i < 2; ++i)
#pragma unroll
            for (int e = 0; e < 16; ++e) cand[i][e] = 0u;
        {
            int cnt = 0; float ea = 0.f, eb = 0.f; int ep = 0;
#pragma unroll
            for (int a = 0; a < 16; ++a)
#pragma unroll
                for (int b = 0; b < 16; ++b)
                    if ((a + 1) * (b + 1) <= 16) {
                        if ((cnt & 1) == 0) { ea = s0[a]; eb = s1[b]; ep = 255 - (a * 16 + b); }
                        else { const int slot = cnt >> 1; const float sa = hh ? s0[a] : ea, sb = hh ? s1[b] : eb; const int pp = hh ? 255 - (a * 16 + b) : ep;
                            cand[slot & 1][slot >> 1] = (f2ord(sa + sb) & ~255u) | (unsigned)pp; }
                        ++cnt; }
        }
        sort16_desc(cand[0]); sort16_desc(cand[1]); merge_top16(cand[0], cand[1]);
        {
            unsigned other[16];
#pragma unroll
            for (int i = 0; i < 16; ++i) other[i] = (unsigned)__shfl_xor((int)cand[0][i], 32);
            merge_top16(cand[0], other);
        }
        float gv[16]; int ev[16]; float gsum = 0.f; const float gmx = ord2f(cand[0][0] & ~255u);
#pragma unroll
        for (int i = 0; i < 16; ++i) { const unsigned k = cand[0][i]; const int pos = 255 - (int)(k & 255u); const int a = pos >> 4, b = pos & 15;
            ev[i] = (int)IB[a] * NKEYS + (int)IB[16 + b]; gv[i] = __expf(ord2f(k & ~255u) - gmx); gsum += gv[i]; }
        float ginv = 1.f / gsum;
#ifdef UNIFORM_GATES
#pragma unroll
        for (int i = 0; i < 16; ++i) gv[i] = 1.f;
        ginv = 1.f / 16.f;
#endif
        if (hh == 0) {
            unsigned short* ip = F.IDX + (size_t)t * NSEL + h * TOPK; float* gp = F.GATE + (size_t)t * NSEL + h * TOPK;
#pragma unroll
            for (int i = 0; i < 2; ++i) *(GAS v4i*)(ip + 8 * i) = (v4i){ev[8 * i] | (ev[8 * i + 1] << 16), ev[8 * i + 2] | (ev[8 * i + 3] << 16), ev[8 * i + 4] | (ev[8 * i + 5] << 16), ev[8 * i + 6] | (ev[8 * i + 7] << 16)};
#pragma unroll
            for (int i = 0; i < 4; ++i) *(GAS f32x4*)(gp + 4 * i) = (f32x4){gv[4 * i] * ginv, gv[4 * i + 1] * ginv, gv[4 * i + 2] * ginv, gv[4 * i + 3] * ginv};
        }
    }
}

typedef float f32x2_t __attribute__((ext_vector_type(2)));
DI void fp8x16_to_f32(v4u q, float (&f)[16]) {
#pragma unroll
    for (int w = 0; w < 4; ++w) { const f32x2_t lo = __builtin_amdgcn_cvt_pk_f32_fp8((int)q[w], false), hi = __builtin_amdgcn_cvt_pk_f32_fp8((int)q[w], true);
        f[4 * w + 0] = lo.x; f[4 * w + 1] = lo.y; f[4 * w + 2] = hi.x; f[4 * w + 3] = hi.y; }
}
struct XccInfo { int q, nx, nloc, rank; };
DI void xcc_info_build(const XcdBarrier& b) {
    if (threadIdx.x == 0) {
        unsigned q = 0, nx = 0, nloc = 1;
        for (unsigned j = 0; j < 16; ++j) { const unsigned c = xb_ld(&b.bar[XB_XCNT(j)]); if (c > 0u) { if (j < b.x) ++q; ++nx; } if (j == b.x) nloc = c; }
        b.st[3] = q; b.st[4] = nx > 0u ? nx : 1u; b.st[5] = nloc > 0u ? nloc : 1u;
    }
    __syncthreads();
}
DI XccInfo xcc_info(const XcdBarrier& b) {
    XccInfo I; I.rank = __builtin_amdgcn_readfirstlane((int)b.st[2]); I.q = __builtin_amdgcn_readfirstlane((int)b.st[3]); I.nx = __builtin_amdgcn_readfirstlane((int)b.st[4]); I.nloc = __builtin_amdgcn_readfirstlane((int)b.st[5]);
    return I;
}
DI float dpp_sum8(float s) {
    s += __builtin_bit_cast(float, __builtin_amdgcn_update_dpp(0, __builtin_bit_cast(int, s), 0xB1, 0xf, 0xf, false));
    s += __builtin_bit_cast(float, __builtin_amdgcn_update_dpp(0, __builtin_bit_cast(int, s), 0x4E, 0xf, 0xf, false));
    s += __builtin_bit_cast(float, __builtin_amdgcn_update_dpp(0, __builtin_bit_cast(int, s), 0x141, 0xf, 0xf, false));
    return s;
}
typedef long i64_t;
typedef long i64x2 __attribute__((ext_vector_type(2)));
typedef int v4i_t __attribute__((ext_vector_type(4)));
typedef int v8i_t __attribute__((ext_vector_type(8)));
constexpr int PEER_ROW = 144, PEER_WAVE_LDS = 128 * PEER_ROW;
constexpr int MX_ONE = 0x7f7f7f7f;
#define P7_IDS(t_, ia_, ib_) do { ia_ = (int)F.IDX[(size_t)(t_) * NSEL + lane]; ib_ = (int)F.IDX[(size_t)(t_) * NSEL + 64 + lane]; } while (0)
#define P7_ISSUE(t_, ia_, ib_, uq_, x_) do { \
        const unsigned char* xr_ = F.XB8 + (size_t)(t_) * D + sl * 256 + 16 * g;   \
        x_[0] = *(const GAS v4u*)(xr_); x_[1] = *(const GAS v4u*)(xr_ + 64); x_[2] = *(const GAS v4u*)(xr_ + 128); x_[3] = *(const GAS v4u*)(xr_ + 192); \
        _Pragma("unroll") for (int ld = 0; ld < 16; ++ld) { const int e_ = __shfl(ld < 8 ? ia_ : ib_, (8 * ld + row8) & 63); uq_[ld] = *(const GAS v4u*)(Us + (unsigned)(e_ * 128 + 16 * c8)); } } while (0)
#define P7_COMPUTE(t_, uq_, x_) do { \
        _Pragma("unroll") for (int ld = 0; ld < 16; ++ld) *(LAS v4u*)(wl + (8 * ld + row8) * PEER_ROW + 16 * c8) = uq_[ld]; \
        v8i_t xb0_, xb1_; \
        xb0_[0] = (int)x_[0].x; xb0_[1] = (int)x_[0].y; xb0_[2] = (int)x_[0].z; xb0_[3] = (int)x_[0].w; xb0_[4] = (int)x_[1].x; xb0_[5] = (int)x_[1].y; xb0_[6] = (int)x_[1].z; xb0_[7] = (int)x_[1].w; \
        xb1_[0] = (int)x_[2].x; xb1_[1] = (int)x_[2].y; xb1_[2] = (int)x_[2].z; xb1_[3] = (int)x_[2].w; xb1_[4] = (int)x_[3].x; xb1_[5] = (int)x_[3].y; xb1_[6] = (int)x_[3].z; xb1_[7] = (int)x_[3].w; \
        f32x4 keep = {0.f, 0.f, 0.f, 0.f}; \
        _Pragma("unroll") for (int j = 0; j < 8; ++j) { f32x4 c_ = {0.f, 0.f, 0.f, 0.f}; \
            const v4i_t a0_ = *(const LAS v4i_t*)(wl + (16 * j + m) * PEER_ROW + 16 * g), a1_ = *(const LAS v4i_t*)(wl + (16 * j + m) * PEER_ROW + 64 + 16 * g); \
            v8i_t A0_ = {a0_[0], a0_[1], a0_[2], a0_[3], 0, 0, 0, 0}, A1_ = {a1_[0], a1_[1], a1_[2], a1_[3], 0, 0, 0, 0}; \
            c_ = __builtin_amdgcn_mfma_scale_f32_16x16x128_f8f6f4(A0_, xb0_, c_, 4, 0, 0, MX_ONE, 0, MX_ONE); \
            c_ = __builtin_amdgcn_mfma_scale_f32_16x16x128_f8f6f4(A1_, xb1_, c_, 4, 0, 0, MX_ONE, 0, MX_ONE); \
            keep = (m == j) ? c_ : keep; } \
        { const bool ok_ = (m < 8) && ((t_) < T); bf16* dst_ = ok_ ? F.PARTB + ((size_t)sl * T + (t_)) * NSEL + 16 * m + 4 * g : F.PARTB + (size_t)8 * T * NSEL + 4 * lane; \
          v2u w_; w_.x = pk2(keep[0], keep[1]); w_.y = pk2(keep[2], keep[3]); *(GAS v2u*)dst_ = w_; } } while (0)
DI int peer_next(volatile LAS unsigned* ctr, int lane) { unsigned k = 0u; if (lane == 0) k = __hip_atomic_fetch_add((LAS unsigned*)ctr, 1u, __ATOMIC_RELAXED, __HIP_MEMORY_SCOPE_WORKGROUP); return __builtin_amdgcn_readfirstlane((int)k); }
DI int peer_tok(int tbase, int tstride, int k) { return tbase + (k & 7) + (k >> 3) * tstride; }
DI void p7_udot(Frame& F, const XccInfo& I) {
    const int lane = F.lane, g = lane >> 4, m = lane & 15, row8 = lane >> 3, c8 = lane & 7;
    LAS unsigned char* wl = F.lds + F.wave * PEER_WAVE_LDS;
    const unsigned char* U4 = (const unsigned char*)F.UB;
    const int tstride = I.nloc * NWAVES, tbase = I.rank * NWAVES;
    int it = 0;
    for (int share = I.q; share < 8; share += I.nx, ++it) {
        const int sl = share >> 1, half = share & 1;
        const unsigned char* Us = U4 + (size_t)sl * NEXP * 128;
        volatile LAS unsigned* ctr = F.MISC + 16 + it;
#define CL(t_) ((t_) < T ? (t_) : T - 1)
#define TOK(k_) (2 * peer_tok(tbase, tstride, (k_)) + half)
        v4u uqA[16], uqB[16]; int iA0, iA1, iB0, iB1;
        int kk = peer_next(ctr, lane); int tA = TOK(kk); kk = peer_next(ctr, lane); int tB = TOK(kk);
        {
            v4u xA[4], xB[4];
            P7_IDS(CL(tA), iA0, iA1);
            P7_ISSUE(CL(tA), iA0, iA1, uqA, xA);
            P7_IDS(CL(tB), iB0, iB1);
#pragma unroll 1
            while (tA < T) {
                kk = peer_next(ctr, lane); const int tC = TOK(kk); kk = peer_next(ctr, lane); const int tD = TOK(kk);
                P7_IDS(CL(tC), iA0, iA1);
                P7_ISSUE(CL(tB), iB0, iB1, uqB, xB);
                P7_COMPUTE(tA, uqA, xA);
                P7_IDS(CL(tD), iB0, iB1);
                P7_ISSUE(CL(tC), iA0, iA1, uqA, xA);
                P7_COMPUTE(tB, uqB, xB);
                tA = tC; tB = tD;
            }
        }
#undef TOK
#undef CL
    }
}
DI void p8_act(Frame& F) {
    const size_t NT_ = (size_t)F.G * NWAVES * 64;
    for (size_t item = (size_t)F.vcu * NWAVES * 64 + F.tid; item < (size_t)T * NSEL / 4; item += NT_) {
        const int t = (int)(item >> 5);
        f32x4 s = {0.f, 0.f, 0.f, 0.f}, vs4;
#pragma unroll
        for (int sl = 0; sl < 4; ++sl) { const v2u p = *(const GAS v2u*)(F.PARTB + (size_t)sl * T * NSEL + item * 4); s = s + (f32x4){bf_lo(p.x), bf_hi(p.x), bf_lo(p.y), bf_hi(p.y)}; }
        { const v2u ids = *(const GAS v2u*)(F.IDX + item * 4);
          s[0] *= F.SU[ids.x & 0xffffu]; s[1] *= F.SU[ids.x >> 16]; s[2] *= F.SU[ids.y & 0xffffu]; s[3] *= F.SU[ids.y >> 16];
          vs4 = (f32x4){F.SV[ids.x & 0xffffu], F.SV[ids.x >> 16], F.SV[ids.y & 0xffffu], F.SV[ids.y >> 16]}; }
        const float rs2 = pg8::rstd2_of(F.SSQ, t);
        const f32x4 g = *(const GAS f32x4*)(F.GATE + item * 4);
        f32x4 o;
#pragma unroll
        for (int e = 0; e < 4; ++e) { const float pre = s[e] * rs2; o[e] = 0.5f * pre * (1.f + erff(pre * 0.70710678118f)) * g[e] * vs4[e] * A_SCALE; }
        ((GAS unsigned*)F.ACT)[item] = pk4_fp8(o);
    }
}
typedef int v2i_t __attribute__((ext_vector_type(2)));
#define P9_IDS(t_, ia_, ib_, ak_) do { ia_ = (int)F.IDX[(size_t)(t_) * NSEL + lane]; ib_ = (int)F.IDX[(size_t)(t_) * NSEL + 64 + lane]; \
        const unsigned char* ap_ = (const unsigned char*)F.ACT + (size_t)(t_) * NSEL + 16 * g; \
        ak_[0] = *(const GAS v4u*)(ap_); ak_[1] = *(const GAS v4u*)(ap_ + 64); } while (0)
#define P9_ISSUE(ia_, ib_, vq_) do { \
        _Pragma("unroll") for (int ld = 0; ld < 16; ++ld) { const int e_ = __shfl(ld < 8 ? ia_ : ib_, (8 * ld + row8) & 63); vq_[ld] = *(const GAS v4u*)(Vs + (unsigned)(e_ * 128 + 16 * c8)); } } while (0)
#define P9_COMPUTE(t_, vq_, ak_) do { \
        _Pragma("unroll") for (int ld = 0; ld < 16; ++ld) *(LAS v4u*)(wl + (8 * ld + row8) * PEER_ROW + 16 * c8) = vq_[ld]; \
        const v8i_t A_ = {(int)ak_[0].x, (int)ak_[0].y, (int)ak_[0].z, (int)ak_[0].w, (int)ak_[1].x, (int)ak_[1].y, (int)ak_[1].z, (int)ak_[1].w}; \
        float keep[4] = {0.f, 0.f, 0.f, 0.f}; \
        _Pragma("unroll") for (int ct = 0; ct < 16; ++ct) { \
            const v2i_t b0_ = __builtin_amdgcn_ds_read_tr4_b64_v2i32((LAS v2i_t*)(wl + (32 * g + n16) * PEER_ROW + 8 * ct)); \
            const v2i_t b1_ = __builtin_amdgcn_ds_read_tr4_b64_v2i32((LAS v2i_t*)(wl + (32 * g + 16 + n16) * PEER_ROW + 8 * ct)); \
            const v8i_t B_ = {b0_[0], b0_[1], b1_[0], b1_[1], 0, 0, 0, 0}; f32x4 c_ = {0.f, 0.f, 0.f, 0.f}; \
            c_ = __builtin_amdgcn_mfma_scale_f32_16x16x128_f8f6f4(A_, B_, c_, 0, 4, 0, MX_ONE, 0, MX_ONE); \
            keep[ct >> 2] = (g == (ct & 3)) ? c_[0] : keep[ct >> 2]; }   \
        { const bool ok_ = (t_) < T; const size_t oo_ = (size_t)(ok_ ? (t_) : T - 1) * D + sl * 256 + 16 * g + n16; \
          float* op_ = ok_ ? F.out + oo_ : (float*)F.PARTB + 4 * lane;                   \
          _Pragma("unroll") for (int q = 0; q < 4; ++q) op_[ok_ ? 64 * q : q] = __builtin_bit_cast(float, (unsigned)F.XB[oo_ + 64 * q] << 16) + keep[q] * (1.f / A_SCALE); } } while (0)
DI void p9_vacc(Frame& F, const XccInfo& I) {
    const int lane = F.lane, g = lane >> 4, n16 = lane & 15, row8 = lane >> 3, c8 = lane & 7;
    LAS unsigned char* wl = F.lds + F.wave * PEER_WAVE_LDS;
    const unsigned char* V4 = (const unsigned char*)F.VB;
    const int tstride = I.nloc * NWAVES, tfirst = I.rank * NWAVES + F.wave;
    for (int share = I.q; share < 8; share += I.nx) {
        const int sl = share >> 1, half = share & 1;
        const unsigned char* Vs = V4 + (size_t)sl * NEXP * 128;
        if (2 * tfirst + half >= T) continue;
        v4u vqA[16], vqB[16]; v4u akA[2], akB[2]; int iA0, iA1, iB0, iB1;
#define CL(t_) ((t_) < T ? (t_) : T - 1)
#define TK(k_) (2 * (tfirst + (k_) * tstride) + half)
        P9_IDS(TK(0), iA0, iA1, akA);
        P9_ISSUE(iA0, iA1, vqA);
        P9_IDS(CL(TK(1)), iB0, iB1, akB);
#pragma unroll 1
        for (int k = 0; TK(k) < T; k += 2) {
            const int t = TK(k), t1 = TK(k + 1), t2 = CL(TK(k + 2)), t3 = CL(TK(k + 3));
            v4u akN[2], akM[2];
            P9_IDS(t2, iA0, iA1, akN);
            P9_ISSUE(iB0, iB1, vqB);
            P9_COMPUTE(t, vqA, akA);
            P9_IDS(t3, iB0, iB1, akM);
            P9_ISSUE(iA0, iA1, vqA);
            P9_COMPUTE(t1, vqB, akB);
            akA[0] = akN[0]; akA[1] = akN[1]; akB[0] = akM[0]; akB[1] = akM[1];
        }
#undef TK
#undef CL
    }
}

struct Args { const float* in[17]; float* out; unsigned char* ws; int ph_lo, ph_hi, li, pad; };
__global__ void __launch_bounds__(NWAVES * 64, 2) hyb_fwd(Args args) {
    extern __shared__ __attribute__((aligned(16))) unsigned char lds[];
    Frame F;
    F.lds = (LAS unsigned char*)lds;
    F.MISC = (volatile LAS unsigned*)(F.lds + MISC_OFF);
    F.tid = threadIdx.x; F.lane = F.tid & 63; F.wave = __builtin_amdgcn_readfirstlane(F.tid >> 6);
    F.G = gridDim.x; { const int bx = blockIdx.x; F.vcu = (F.G % 8 == 0) ? (bx % 8) * (F.G / 8) + bx / 8 : bx; }
    unsigned char* ws = args.ws;
    F.ctl = (gu32*)(ws + WS_CTL);
    F.x = args.in[0]; F.norm_mix = args.in[1]; F.norm_ffn = args.in[2]; F.w_in = args.in[3]; F.b_gate = args.in[4]; F.w_conv = args.in[5]; F.q_norm = args.in[6]; F.k_norm = args.in[7];
    F.sinks = args.in[8]; F.rel_bias = args.in[9]; F.w_conv_out = args.in[10]; F.w_attn_out = args.in[11]; F.w_out = args.in[12]; F.w_query = args.in[13]; F.sub_keys = args.in[14];
    F.expert_u = args.in[15]; F.expert_v = args.in[16]; F.out = args.out;
    F.WIN = (bf16*)(ws + WS_WIN); F.WC = (bf16*)(ws + WS_WC); F.WA = (bf16*)(ws + WS_WA); F.WO = (bf16*)(ws + WS_WO); F.WQ = (bf16*)(ws + WS_WQ); F.SK = (bf16*)(ws + WS_SK);
    F.UB = (bf16*)(ws + WS_UB); F.VB = (bf16*)(ws + WS_VB); F.XB = (bf16*)(ws + WS_XB); F.PA = (bf16*)(ws + WS_PA); F.MIX = (bf16*)(ws + WS_MIX); F.G_ = (bf16*)(ws + WS_G); F.QP = (bf16*)(ws + WS_QP);
    F.Z = (bf16*)(ws + WS_Z); F.ATT = (bf16*)(ws + WS_ATT); F.RSTD1 = (float*)(ws + WS_RSTD1); F.SSQ = (float*)(ws + WS_SSQ); F.GATE = (float*)(ws + WS_GATE); F.IDX = (unsigned short*)(ws + WS_IDX); F.PARTB = (bf16*)(ws + WS_PART); F.SU = (float*)(ws + WS_SU); F.SV = (float*)(ws + WS_SV); F.XB8 = (unsigned char*)(ws + WS_XB8); F.ACT = (float*)(ws + WS_ACT);
    for (int u = F.tid; u < (LDS_BYTES - LDSCTL_OFF) / 4; u += NWAVES * 64) ((LAS unsigned*)(F.lds + LDSCTL_OFF))[u] = 0u;
    __syncthreads();
    XcdBarrier bar; bar.bar = (unsigned*)(F.ctl + CW_BAR); bar.x = 0; bar.st = nullptr;
    const int lo = args.ph_lo, hi = args.ph_hi;
    if (hi - lo > 1) bar = xcd_barrier_post((unsigned*)(F.ctl + CW_BAR), F.MISC + 8);
#ifndef PH_MASK
#define PH_MASK 0x3ff
#endif
#define IN(k) (((PH_MASK >> (k)) & 1) && lo <= (k) && (k) < hi)
#define SEAM(k) do { if (IN(k) && IN((k) + 1)) xcd_barrier(bar); } while (0)
#ifndef PROBE_DUP
#define PROBE_DUP 0
#endif
#define REP(k) for (int rep_ = 0; rep_ < (((PROBE_DUP >> (k)) & 1) ? 2 : 1); ++rep_)

    if (IN(0)) { REP(0) p0_prologue(F); SEAM(0); }
    if (IN(1)) {
        pg8::Gemm g{F.XB, F.WIN, nullptr, nullptr, T, IN_DIM, D}; pg8::StaticOrder S; S.init(T, IN_DIM, F.G, (int)blockIdx.x);
        { LAS float* bgl = (LAS float*)(F.lds + RING_BYTES); for (int i = F.tid; i < 2 * D; i += NWAVES * 64) bgl[i] = F.b_gate[i]; __syncthreads(); }
        pg8::EpiProj E{F.PA, F.G_, (const PG8_LAS float*)(F.lds + RING_BYTES)};
        REP(1) pg8::gemm_phase<pg8::EpiProj, pg8::StaticOrder, PG8_ALIGN, PG8_SP2>(F.lds + RING_OFF, g, S, E);
        {
            const int nwg = (T / 256) * (IN_DIM / 256), rem = nwg % F.G, c = (int)blockIdx.x; const int nshort = rem ? F.G - rem : F.G, sidx = rem ? c - rem : c;
            (void)sidx; (void)nshort;
            constexpr int CH = 64, NCH = 2 * NEXP / CH;
            for (;;) {
                if (F.tid == 0) F.MISC[14] = __hip_atomic_fetch_add((unsigned*)(F.ctl + 2048), 1u, __ATOMIC_RELAXED, __HIP_MEMORY_SCOPE_AGENT);
                __syncthreads();
                const int ch = __builtin_amdgcn_readfirstlane((int)F.MISC[14]);
                __syncthreads();
                if (ch >= NCH) break;
                if (ch < NCH / 2) p0_convert_fp4(F, F.expert_u, F.norm_ffn, (unsigned char*)F.UB, F.SU, ch * CH, ch * CH + CH);
                else p0_convert_fp4(F, F.expert_v, nullptr, (unsigned char*)F.VB, F.SV, (ch - NCH / 2) * CH, (ch - NCH / 2) * CH + CH);
            } }
        SEAM(1);
    }
    if (IN(2)) {
        REP(2) { p2_conv(F); p2_attention(F); }
        SEAM(2); }
    if (IN(3)) {
        pg8::Gemm g{F.Z, F.WC, F.ATT, F.WA, T, D, CONV}; pg8::PairOrder S; S.init(T, D, F.G, (int)blockIdx.x);
        pg8::EpiMix E{F.MIX, F.G_};
        REP(3) pg8::gemm_phase<pg8::EpiMix, pg8::PairOrder, PG8_ALIGN, PG8_SP2>(F.lds + RING_OFF, g, S, E);
        SEAM(3);
    }
    if (IN(4)) {
        pg8::Gemm g{F.MIX, F.WO, nullptr, nullptr, T, D, D}; pg8::FragOrder S; S.init(T, D, F.G, (int)blockIdx.x);
        pg8::EpiX1 E{F.RSTD1, F.XB, F.SSQ, F.XB8};
        REP(4) pg8::gemm_phase<pg8::EpiX1, pg8::FragOrder, PG8_ALIGN, PG8_SP2>(F.lds + RING_OFF, g, S, E);
        SEAM(4);
    }
    if (IN(5)) {
        pg8::Gemm g{F.XB, F.WQ, nullptr, nullptr, T, PQ, D}; pg8::StaticOrder S; S.init(T, PQ, F.G, (int)blockIdx.x);
        pg8::EpiQP E{F.QP};
        REP(5) pg8::gemm_phase<pg8::EpiQP, pg8::StaticOrder, PG8_ALIGN, PG8_SP2>(F.lds + RING_OFF, g, S, E);
    }
    if (IN(6)) { REP(6) p6_topk(F); SEAM(6); }
    if (IN(7)) { xcc_info_build(bar); const XccInfo I = xcc_info(bar); REP(7) p7_udot(F, I); SEAM(7); }
    if (IN(8)) { REP(8) p8_act(F); SEAM(8); }
    if (IN(9)) { const XccInfo I = xcc_info(bar); p9_vacc(F, I); }
#undef IN
#undef SEAM
}

extern "C" void kernel_launch(void* const* d_in, const int* in_sizes, int n_in, void* d_out, int out_size, void* d_ws, size_t ws_size, hipStream_t stream) {
    static int grid = 0;
    if (grid == 0) {
        if (n_in != 17 || in_sizes[0] != T * D || out_size != T * D || ws_size < WS_END) { fprintf(stderr, "kernel_launch: unexpected shapes (n_in %d, in0 %d, out %d, ws %zu)\n", n_in, n_in > 0 ? in_sizes[0] : -1, out_size, ws_size); grid = -1; return; }
        int dev = 0, cus = 0, per_cu = 0;
        if (hipGetDevice(&dev) != hipSuccess || hipDeviceGetAttribute(&cus, hipDeviceAttributeMultiprocessorCount, dev) != hipSuccess) { grid = -1; return; }
        if (hipFuncSetAttribute((const void*)hyb_fwd, hipFuncAttributeMaxDynamicSharedMemorySize, LDS_BYTES) != hipSuccess) { fprintf(stderr, "kernel_launch: hipFuncSetAttribute failed\n"); grid = -1; return; }
        if (hipOccupancyMaxActiveBlocksPerMultiprocessor(&per_cu, (const void*)hyb_fwd, NWAVES * 64, LDS_BYTES) != hipSuccess || per_cu < 1) { fprintf(stderr, "kernel_launch: occupancy query says %d blocks per CU\n", per_cu); (void)hipGetLastError(); grid = -1; return; }
        grid = cus * 1;
    }
    if (grid < 0) return;
    if (hipMemsetAsync((char*)d_ws + WS_CTL, 0, CTL_ZERO_BYTES, stream) != hipSuccess) { fprintf(stderr, "kernel_launch: memset failed\n"); return; }
    Args a{};
    for (int i = 0; i < 17; ++i) a.in[i] = (const float*)d_in[i];
    a.out = (float*)d_out; a.ws = (unsigned char*)d_ws;
#if MK_ONE_LAUNCH
    a.ph_lo = 0; a.ph_hi = N_PHASES; a.li = 0;
    void* kargs[] = {&a};
    const hipError_t le = hipLaunchCooperativeKernel((const void*)hyb_fwd, dim3(grid), dim3(NWAVES * 64), kargs, LDS_BYTES, stream);
    if (le != hipSuccess) fprintf(stderr, "kernel_launch: cooperative launch failed: %s (grid %d)\n", hipGetErrorName(le), grid);
#else
    for (int li = 0; li < N_PHASES; ++li) {
        a.ph_lo = li; a.ph_hi = li + 1; a.li = li;
        hipLaunchKernelGGL(hyb_fwd, dim3(grid), dim3(NWAVES * 64), LDS_BYTES, stream, a);
        const hipError_t le = hipPeekAtLastError();
        if (le != hipSuccess) { fprintf(stderr, "kernel_launch: launch %d failed: %s\n", li, hipGetErrorName(le)); break; }
    }
#endif
}
```

```cpp
#include <hip/hip_runtime.h>
#include <hip/hip_cooperative_groups.h>
#include <cstdio>
#include <cstdint>
namespace pg8 {
#define PG8_LAS __attribute__((address_space(3)))
typedef unsigned short bf16_t;
typedef short bf16x8 __attribute__((ext_vector_type(8)));
typedef float f32x4 __attribute__((ext_vector_type(4)));
typedef unsigned u32x4 __attribute__((ext_vector_type(4)));
typedef unsigned u32x2 __attribute__((ext_vector_type(2)));
constexpr int BM = 256, BK = 64, HALF = 128, HTB = HALF * BK * 2  , STAGE_BYTES = 8 * HTB, NXCD = 8, WGM = 8;

__host__ __device__ __forceinline__ int lds_byte(int r, int c) { const int st = (r >> 4) * 2 + (c >> 5), rr = r & 15, cc = c & 31, ob = rr * 64 + cc * 2; return st * 1024 + (ob ^ (((ob >> 9) & 1) << 5)); }
__host__ __device__ __forceinline__ void stage_rc(int b, int& R, int& C) { const int st = b / 1024, sb = b % 1024, swz = sb ^ (((sb >> 9) & 1) << 5); R = (st >> 1) * 16 + swz / 64; C = (st & 1) * 32 + (swz % 64) / 2; }
__host__ __device__ __forceinline__ int perm32(int rho) { const int n = rho >> 4, i = rho & 15; return 8 * (i >> 2) + 4 * n + (i & 3); }

struct Unit { int pm, pn, which; };
struct Gemm { const bf16_t* A; const bf16_t* Bt; const bf16_t* A2; const bf16_t* Bt2; int M, N, K; };

struct StaticOrder {
    static constexpr bool AFRAG = false;
    int nM, nN, nwg, G, c;
    __host__ __device__ void init(int M, int N, int G_, int c_) { nM = M / BM; nN = N / BM; nwg = nM * nN; G = G_; c = c_; }
    __host__ __device__ bool next(int i, Unit& u) const {
        const long L = (long)i * G + c; if (L >= nwg) return false;
        int wgid = (int)L; { const int q = nwg / NXCD, r = nwg % NXCD, xcd = wgid % NXCD, off = wgid / NXCD; wgid = (xcd < r ? xcd * (q + 1) : r * (q + 1) + (xcd - r) * q) + off; }
        const int nig = WGM * nN, gid = wgid / nig, fm = gid * WGM, gsz = (nM - fm) < WGM ? (nM - fm) : WGM;
        u.pm = fm + ((wgid % nig) % gsz); u.pn = (wgid % nig) / gsz; u.which = 0; return true;
    }
    __device__ __forceinline__ const char* a_base(const Gemm& g, const Unit& u, size_t tstep) const { return (const char*)g.A + (size_t)u.pm * tstep; }
    __device__ __forceinline__ const char* b_base(const Gemm& g, const Unit& u, size_t tstep) const { return (const char*)g.Bt + (size_t)u.pn * tstep; }
    __device__ __forceinline__ void a_ready(const Unit&) const {}
    __device__ __forceinline__ void done(const Unit&) const {}
};

__device__ __forceinline__ unsigned cvt_pk_bf16(float lo, float hi) { unsigned r; asm volatile("v_cvt_pk_bf16_f32 %0, %1, %2" : "=v"(r) : "v"(lo), "v"(hi)); return r; }
__device__ __forceinline__ void store16_wt(void* p, u32x4 v) { asm volatile("global_store_dwordx4 %0, %1, off sc1\n\ts_nop 1" :: "v"(p), "v"(v) : "memory"); }
__device__ __forceinline__ void store8_wt(void* p, u32x2 v) { asm volatile("global_store_dwordx2 %0, %1, off sc1\n\ts_nop 1" :: "v"(p), "v"(v) : "memory"); }
typedef float f32x2 __attribute__((ext_vector_type(2)));
__device__ __forceinline__ f32x2 gelu_pk(f32x2 v) {
    const f32x2 av = __builtin_elementwise_abs(v), d = av * 0.2316418882f + 1.0f;
    f32x2 t; t.x = __builtin_amdgcn_rcpf(d.x); t.y = __builtin_amdgcn_rcpf(d.y);
    f32x2 q = t * 0.5307027145f + (-0.7265760135f); q = q * t + 0.7107068705f; q = q * t + (-0.142248368f); q = q * t + 0.127414796f; q = q * t;
    const f32x2 s = (v * v) * (-0.72134752044f);
    f32x2 e; e.x = __builtin_amdgcn_exp2f(s.x); e.y = __builtin_amdgcn_exp2f(s.y);
    const f32x2 m = v * (q * e), r = v - m;
    f32x2 o; o.x = v.x < 0.f ? m.x : r.x; o.y = v.y < 0.f ? m.y : r.y; return o;
}

template <class Epi, class Sched, bool ALIGN_EPI = false, bool SP2 = false>
__device__ __forceinline__ void gemm_phase(PG8_LAS unsigned char* lds, const Gemm g, const Sched& S, const Epi& E) {
    const int tid = threadIdx.x, wid = __builtin_amdgcn_readfirstlane(tid >> 6), lane = tid & 63, wr = wid >> 2, wc = wid & 3, fr = lane & 15, fq = lane >> 4;
    const int K = g.K, nt = K / BK;
    unsigned voffA[2], voffB[2];
#pragma unroll
    for (int i = 0; i < 2; ++i) { int R, C; stage_rc(tid * 16 + i * 8192, R, C); const int Rb = Epi::PERM ? ((R & ~31) + perm32(R & 31)) : R;
        voffA[i] = Sched::AFRAG ? (unsigned)((((((R >> 6) * 4 + (C >> 5)) * 16 + ((R >> 4) & 3) * 2) * 64) + ((C & 31) >> 3) * 16 + (R & 15)) * 16) : (unsigned)(R * K + C) * 2u;
        voffB[i] = (unsigned)(Rb * K + C) * 2u; }
#define PG8_AP(base, h, kt) (Sched::AFRAG ? (base) + ((((size_t)((kt) >> 2) * 8 + ((kt) & 1) * 2) * 16 + (h) * 8 + (((kt) >> 1) & 1)) * 64) * 16 : (base) + (size_t)(h) * hstep + (size_t)(kt) * kstep)
    const size_t kstep = (size_t)(BK * 2);
    const size_t hstep = (size_t)HALF * K * 2;
    const size_t tstep = 2 * hstep;
    const unsigned ldsw = (unsigned)wid * 1024u;
    const int aoff = lds_byte(wr * 64 + fr, fq * 8), boff = lds_byte(wc * 32 + fr, fq * 8);
#define PG8_SA(b, h) (((b) * 2 + (h)) * HTB)
#define PG8_SB(b, h) ((4 + (b) * 2 + (h)) * HTB)
#define PG8_STAGE(bufoff, gbase, voff) do { _Pragma("unroll") for (int _i = 0; _i < 2; ++_i) \
        __builtin_amdgcn_global_load_lds((const unsigned*)((const char*)(gbase) + (voff)[_i]), (PG8_LAS unsigned*)(lds + (bufoff) + ldsw + _i * 8192), 16, 0, 0); } while (0)
#define PG8_LDA(dst, b, h) do { _Pragma("unroll") for (int m = 0; m < 4; ++m) _Pragma("unroll") for (int k = 0; k < 2; ++k) dst[m][k] = *(const PG8_LAS bf16x8*)(lds + PG8_SA(b, h) + aoff + m * 2048 + k * 1024); } while (0)
#define PG8_LDB(dst, b, h) do { _Pragma("unroll") for (int n = 0; n < 2; ++n) _Pragma("unroll") for (int k = 0; k < 2; ++k) dst[n][k] = *(const PG8_LAS bf16x8*)(lds + PG8_SB(b, h) + boff + n * 2048 + k * 1024); } while (0)
#define PG8_MMA(ai, bj, At, Bt) do { __builtin_amdgcn_s_setprio(1); _Pragma("unroll") for (int m = 0; m < 4; ++m) _Pragma("unroll") for (int n = 0; n < 2; ++n) _Pragma("unroll") for (int k = 0; k < 2; ++k) \
        acc[ai][bj][m][n] = __builtin_amdgcn_mfma_f32_16x16x32_bf16(Bt[n][k], At[m][k], acc[ai][bj][m][n], 0, 0, 0); __builtin_amdgcn_s_setprio(0); } while (0)
#define PG8_WAIT_V(n) asm volatile("s_waitcnt vmcnt(" #n ")" ::: "memory")
#define PG8_WAIT_L(n) asm volatile("s_waitcnt lgkmcnt(" #n ")" ::: "memory")
#define PG8_BAR __builtin_amdgcn_s_barrier()
#define PG8_SCHED __builtin_amdgcn_sched_barrier(0)
    Unit cur, nxt; int ui = 0;
    if (!S.next(0, cur)) return;
    f32x4 acc[2][2][4][2];
#pragma unroll
    for (int a = 0; a < 2; ++a)
#pragma unroll
        for (int b = 0; b < 2; ++b)
#pragma unroll
            for (int m = 0; m < 4; ++m)
#pragma unroll
                for (int n = 0; n < 2; ++n) acc[a][b][m][n] = (f32x4){0.f, 0.f, 0.f, 0.f};
    if constexpr (Epi::HAS_INIT) E.init(acc, cur, wr, wc, fr, fq);
    bf16x8 At[4][2], B0[2][2], B1[2][2];
    const char* cA = S.a_base(g, cur, tstep); const char* cB = S.b_base(g, cur, tstep);
    S.a_ready(cur);
    if constexpr (SP2) {
        PG8_STAGE(PG8_SB(0, 0), cB, voffB); PG8_STAGE(PG8_SB(0, 1), cB + hstep, voffB); PG8_STAGE(PG8_SA(0, 0), PG8_AP(cA, 0, 0), voffA); PG8_STAGE(PG8_SA(0, 1), PG8_AP(cA, 1, 0), voffA);
        if (wr == 1) PG8_BAR;
        PG8_WAIT_V(2); PG8_BAR;
        PG8_STAGE(PG8_SB(1, 0), cB + kstep, voffB); PG8_STAGE(PG8_SA(1, 0), PG8_AP(cA, 0, 1), voffA); PG8_STAGE(PG8_SB(1, 1), cB + hstep + kstep, voffB);
        PG8_WAIT_V(6); PG8_BAR;
    } else {
        PG8_STAGE(PG8_SB(0, 0), cB, voffB); PG8_STAGE(PG8_SA(0, 0), PG8_AP(cA, 0, 0), voffA); PG8_STAGE(PG8_SB(0, 1), cB + hstep, voffB); PG8_STAGE(PG8_SA(0, 1), PG8_AP(cA, 1, 0), voffA);
        if (wr == 1) PG8_BAR;
        PG8_WAIT_V(4); PG8_BAR;
        PG8_STAGE(PG8_SB(1, 0), cB + kstep, voffB); PG8_STAGE(PG8_SA(1, 0), PG8_AP(cA, 0, 1), voffA); PG8_STAGE(PG8_SB(1, 1), cB + hstep + kstep, voffB);
        PG8_WAIT_V(6); PG8_BAR;
    }
    for (;;) {
        const bool has_next = S.next(ui + 1, nxt);
        const char* nA = has_next ? S.a_base(g, nxt, tstep) : cA; const char* nB = has_next ? S.b_base(g, nxt, tstep) : cB;
        for (int t = 0; t < nt; t += 2) {
            const bool last = (t == nt - 2);
            const char* a2b = last ? nA : cA; const int a2k = last ? 0 : t + 2; const char* b2 = last ? nB : cB + (size_t)(t + 2) * kstep;
            const char* b3 = b2 + kstep;
            const char* a1h = PG8_AP(cA, 1, t + 1); const char* a2 = PG8_AP(a2b, 0, a2k); const char* a2h = PG8_AP(a2b, 1, a2k); const char* a3 = PG8_AP(a2b, 0, a2k + 1);
            if (last && has_next) S.a_ready(nxt);
            if constexpr (SP2) {
            PG8_LDB(B0, 0, 0); PG8_LDB(B1, 0, 1); PG8_SCHED; PG8_LDA(At, 0, 0); PG8_STAGE(PG8_SA(1, 1), a1h, voffA);
            PG8_WAIT_V(8); PG8_WAIT_L(0); PG8_BAR; PG8_MMA(0, 0, At, B0); PG8_MMA(0, 1, At, B1); PG8_BAR; PG8_SCHED;
            PG8_LDA(At, 0, 1); PG8_STAGE(PG8_SB(0, 0), b2, voffB); PG8_STAGE(PG8_SB(0, 1), b2 + hstep, voffB); PG8_STAGE(PG8_SA(0, 0), a2, voffA);
            PG8_WAIT_V(8); PG8_WAIT_L(0); PG8_BAR; PG8_MMA(1, 0, At, B0); PG8_MMA(1, 1, At, B1); PG8_BAR; PG8_SCHED;
            PG8_LDB(B0, 1, 0); PG8_LDB(B1, 1, 1); PG8_SCHED; PG8_LDA(At, 1, 0); PG8_STAGE(PG8_SA(0, 1), a2h, voffA);
            PG8_WAIT_V(8); PG8_WAIT_L(0); PG8_BAR; PG8_MMA(0, 0, At, B0); PG8_MMA(0, 1, At, B1); PG8_BAR; PG8_SCHED;
            PG8_LDA(At, 1, 1); PG8_STAGE(PG8_SB(1, 0), b3, voffB); PG8_STAGE(PG8_SB(1, 1), b3 + hstep, voffB); PG8_STAGE(PG8_SA(1, 0), a3, voffA);
            PG8_WAIT_V(8); PG8_WAIT_L(0); PG8_BAR; PG8_MMA(1, 0, At, B0); PG8_MMA(1, 1, At, B1); PG8_BAR; PG8_SCHED;
            } else {
            PG8_LDB(B0, 0, 0); PG8_SCHED; PG8_LDA(At, 0, 0); PG8_STAGE(PG8_SA(1, 1), a1h, voffA);
            PG8_WAIT_L(8); PG8_BAR; PG8_WAIT_L(0); PG8_MMA(0, 0, At, B0); PG8_BAR; PG8_SCHED;
            PG8_LDB(B1, 0, 1); PG8_STAGE(PG8_SB(0, 0), b2, voffB);
            PG8_BAR; PG8_WAIT_L(0); PG8_MMA(0, 1, At, B1); PG8_BAR;
            PG8_LDA(At, 0, 1); PG8_STAGE(PG8_SA(0, 0), a2, voffA);
            PG8_BAR; PG8_WAIT_L(0); PG8_MMA(1, 0, At, B0); PG8_BAR; PG8_SCHED;
            PG8_STAGE(PG8_SB(0, 1), b2 + hstep, voffB);
            PG8_WAIT_V(6); PG8_BAR; PG8_MMA(1, 1, At, B1); PG8_BAR;
            PG8_LDB(B0, 1, 0); PG8_SCHED; PG8_LDA(At, 1, 0); PG8_STAGE(PG8_SA(0, 1), a2h, voffA);
            PG8_WAIT_L(8); PG8_BAR; PG8_WAIT_L(0); PG8_MMA(0, 0, At, B0); PG8_BAR; PG8_SCHED;
            PG8_LDB(B1, 1, 1); PG8_STAGE(PG8_SB(1, 0), b3, voffB);
            PG8_BAR; PG8_WAIT_L(0); PG8_MMA(0, 1, At, B1); PG8_BAR;
            PG8_LDA(At, 1, 1); PG8_STAGE(PG8_SA(1, 0), a3, voffA);
            PG8_BAR; PG8_WAIT_L(0); PG8_MMA(1, 0, At, B0); PG8_BAR; PG8_SCHED;
            PG8_STAGE(PG8_SB(1, 1), b3 + hstep, voffB);
            PG8_WAIT_V(6); PG8_BAR; PG8_MMA(1, 1, At, B1); PG8_BAR;
            }
        }
        if constexpr (ALIGN_EPI) { if (wr == 0) PG8_BAR; }
        if constexpr (!Epi::AFTER_DRAIN) { E(acc, cur, wr, wc, fr, fq); S.done(cur); }
        if (!has_next) break;
        if (!(Epi::CARRY && cur.which == 0)) {
#pragma unroll
        for (int a = 0; a < 2; ++a)
#pragma unroll
            for (int b = 0; b < 2; ++b)
#pragma unroll
                for (int m = 0; m < 4; ++m)
#pragma unroll
                    for (int n = 0; n < 2; ++n) acc[a][b][m][n] = (f32x4){0.f, 0.f, 0.f, 0.f};
        }
        if constexpr (Epi::HAS_INIT) E.init(acc, nxt, wr, wc, fr, fq);
        cur = nxt; cA = nA; cB = nB; ++ui;
        if constexpr (ALIGN_EPI) { if (wr == 1) PG8_BAR; }
    }
    PG8_WAIT_V(0);
    if constexpr (!ALIGN_EPI) { if (wr == 0) PG8_BAR; }
    PG8_BAR;
    if constexpr (Epi::AFTER_DRAIN) { E.fused(acc, cur, wr, wc, fr, fq, lds, wid, lane); S.done(cur); }
#undef PG8_AP
#undef PG8_SA
#undef PG8_SB
#undef PG8_STAGE
#undef PG8_LDA
#undef PG8_LDB
#undef PG8_MMA
#undef PG8_WAIT_V
#undef PG8_WAIT_L
#undef PG8_BAR
#undef PG8_SCHED
}
}

#ifndef PG8_SP2
#define PG8_SP2 true
#endif
#ifndef PG8_ALIGN
#define PG8_ALIGN true
#endif
#ifndef MK_ONE_LAUNCH
#define MK_ONE_LAUNCH 1
#endif

constexpr int NWAVES = 8;
constexpr int T = 32768, D = 1024, SEQ = 4096;
constexpr int IN_DIM = 4352, PA_W = 2304, G_W = 2048;
constexpr int C_U = 0, C_B = 512, C_C = 1024, C_Q = 1536, C_K = 2048, C_V = 2176;
constexpr int CONV = 512, HD = 64, NH = 8, NKV = 2;
constexpr int PH = 8, NKEYS = 128, PQ = 2048, TOPK = 16, NEXP = 16384, NSEL = 128;
constexpr float EPS = 1e-6f;
constexpr int N_PHASES = 10;

constexpr size_t MiB = 1u << 20;
constexpr size_t WS_CTL = 0, CTL_ZERO_BYTES = 1 * MiB;
constexpr size_t WS_WIN = 2 * MiB;
constexpr size_t WS_WC = 11 * MiB;
constexpr size_t WS_WA = 12 * MiB;
constexpr size_t WS_WO = 13 * MiB;
constexpr size_t WS_WQ = 15 * MiB;
constexpr size_t WS_SK = 19 * MiB;
constexpr size_t WS_RSTD1 = 20 * MiB;
constexpr size_t WS_SSQ = 21 * MiB;
constexpr size_t WS_UB = 24 * MiB;
constexpr size_t WS_SU = 32 * MiB;
constexpr size_t WS_VB = 40 * MiB;
constexpr size_t WS_SV = 48 * MiB;
constexpr size_t WS_XB8 = 56 * MiB;
constexpr size_t WS_XB = 88 * MiB;
constexpr size_t WS_PA = 152 * MiB;
constexpr size_t WS_MIX = WS_PA;
constexpr size_t WS_G = 296 * MiB;
constexpr size_t WS_QP = WS_G;
constexpr size_t WS_Z = 424 * MiB;
constexpr size_t WS_ATT = 456 * MiB;
constexpr size_t WS_IDX = WS_Z, WS_GATE = WS_ATT;
constexpr size_t WS_PART = WS_PA;
constexpr size_t WS_ACT = WS_G;
constexpr size_t WS_END = 488 * MiB;
constexpr int CW_BAR = 4096;

constexpr int RING_OFF = 0, RING_BYTES = 131072;
constexpr int LDSCTL_OFF = 147456, MISC_OFF = LDSCTL_OFF + 320;
constexpr int LDS_BYTES = 148480;
#define GAS __attribute__((address_space(1)))
#define LAS __attribute__((address_space(3)))
typedef unsigned short bf16;
typedef unsigned v4u __attribute__((ext_vector_type(4)));
typedef float f32x4 __attribute__((ext_vector_type(4)));
typedef short bf16x8 __attribute__((ext_vector_type(8)));
typedef GAS unsigned gu32;
typedef GAS unsigned long long gu64;
#define RLX_AGENT __ATOMIC_RELAXED, __HIP_MEMORY_SCOPE_AGENT
#define LDS_WAIT() asm volatile("s_waitcnt lgkmcnt(0)" ::: "memory")
#define VM_WAIT() asm volatile("s_waitcnt vmcnt(0)" ::: "memory")
__device__ __forceinline__ unsigned long long rt() { return __builtin_amdgcn_s_memrealtime(); }
__device__ __forceinline__ unsigned f2bf(float f) { unsigned u = __builtin_bit_cast(unsigned, f); return (u + 0x7fffu + ((u >> 16) & 1u)) >> 16; }
__device__ __forceinline__ unsigned pk2(float lo, float hi) { return f2bf(lo) | (f2bf(hi) << 16); }

#define XB_TMO      128
#define XB_XCNT(j)  (256  + 64 * (j))
#define XB_XSUB(j)  (1280 + 64 * (j))
#define XB_XGEN(j)  (2304 + 64 * (j))
#define XB_TOP      3328
#define XB_TOPGEN   3392
#define XCD_BAR_WORDS 3456
#define XB_SPIN_CAP (1u << 18)

__device__ __forceinline__ unsigned xb_ld(unsigned* p)              { return __hip_atomic_load(p, __ATOMIC_RELAXED, __HIP_MEMORY_SCOPE_AGENT); }
__device__ __forceinline__ unsigned xb_add(unsigned* p, unsigned v) { return __hip_atomic_fetch_add(p, v, __ATOMIC_RELAXED, __HIP_MEMORY_SCOPE_AGENT); }
__device__ __forceinline__ unsigned xb_xcc_id() { return (unsigned)__builtin_amdgcn_s_getreg((3 << 11) | 20) & 0xFu; }
#define XB_SPIN(cond, bar) do { unsigned _sp = 0; while (cond) { __builtin_amdgcn_s_sleep(1); \
    if ((++_sp & 255u) == 0u) { if (xb_ld(&(bar)[XB_TMO])) break; if (_sp > XB_SPIN_CAP) { atomicAdd(&(bar)[XB_TMO], 1u); break; } } } } while (0)

struct XcdBarrier {
    unsigned* bar; unsigned x;
    volatile LAS unsigned* st;
};

__device__ __forceinline__ XcdBarrier xcd_barrier_post(unsigned* bar, volatile LAS unsigned* st) {
    XcdBarrier b; b.bar = bar; b.x = xb_xcc_id(); b.st = st;
    if (threadIdx.x == 0) st[2] = xb_add(&bar[XB_XCNT(b.x)], 1u);
    return b;
}
__device__ __forceinline__ void xcd_barrier_complete(unsigned* bar, unsigned x, unsigned& nloc, unsigned& nx) {
    const unsigned G = gridDim.x * gridDim.y * gridDim.z;
    unsigned sum, cnt, mine, sp = 0u;
    for (;;) {
        sum = 0u; cnt = 0u; mine = 0u;
#pragma unroll
        for (unsigned j = 0; j < 16; ++j) { const unsigned c = xb_ld(&bar[XB_XCNT(j)]); sum += c; cnt += (c > 0u) ? 1u : 0u; mine = (j == x) ? c : mine; }
        if (sum == G) break;
        __builtin_amdgcn_s_sleep(1);
        if ((++sp & 255u) == 0u) { if (xb_ld(&bar[XB_TMO])) break; if (sp > XB_SPIN_CAP) { atomicAdd(&bar[XB_TMO], 1u); break; } }
    }
    nloc = mine > 0u ? mine : 1u; nx = cnt > 0u ? cnt : 1u;
}

__device__ __forceinline__ void xcd_barrier(const XcdBarrier& b) {
    asm volatile("s_waitcnt vmcnt(0)" ::: "memory");
    __syncthreads();
    if (threadIdx.x == 0) {
        unsigned* bar = b.bar;
        __builtin_amdgcn_s_waitcnt(0);
        unsigned nloc = b.st[0], nx = b.st[1];
        if (nloc == 0u) { xcd_barrier_complete(bar, b.x, nloc, nx); b.st[0] = nloc; b.st[1] = nx; }
        const unsigned old = xb_add(&bar[XB_XSUB(b.x)], 1u);
        const unsigned gen = old / nloc;
        if (old + 1u == (gen + 1u) * nloc) {
            __builtin_amdgcn_fence(__ATOMIC_RELEASE, "agent");
            asm volatile("s_waitcnt vmcnt(0)" ::: "memory");
            const unsigned og = xb_add(&bar[XB_TOP], 1u);
            const unsigned tg = og / nx;
            if (og + 1u == (tg + 1u) * nx) xb_add(&bar[XB_TOPGEN], 1u);
            else XB_SPIN(xb_ld(&bar[XB_TOPGEN]) == tg, bar);
            __builtin_amdgcn_fence(__ATOMIC_ACQUIRE, "agent");
            xb_add(&bar[XB_XGEN(b.x)], 1u);
            asm volatile("s_waitcnt vmcnt(0)" ::: "memory");
        } else {
            XB_SPIN(xb_ld(&bar[XB_XGEN(b.x)]) == gen, bar);
            __builtin_amdgcn_fence(__ATOMIC_ACQUIRE, "agent");
            asm volatile("s_waitcnt vmcnt(0)" ::: "memory");
        }
    }
    __syncthreads();
}

typedef float f32x16 __attribute__((ext_vector_type(16)));
typedef unsigned v2u __attribute__((ext_vector_type(2)));
typedef int v4i __attribute__((ext_vector_type(4)));
typedef __bf16 bf2_t __attribute__((ext_vector_type(2)));
#define DI __device__ __forceinline__
struct Frame {
    LAS unsigned char* lds;
    volatile LAS unsigned* MISC;
    gu32* ctl;
    int tid, lane, wave, vcu, G;
    const float *x, *norm_mix, *norm_ffn, *w_in, *b_gate, *w_conv, *q_norm, *k_norm, *sinks, *rel_bias, *w_conv_out, *w_attn_out, *w_out, *w_query, *sub_keys, *expert_u, *expert_v;
    float* out;
    bf16 *WIN, *WC, *WA, *WO, *WQ, *SK, *UB, *VB, *XB, *PA, *MIX, *G_, *QP, *Z, *ATT;
    float *RSTD1, *SSQ, *GATE, *ACT, *SU, *SV; bf16* PARTB; unsigned char* XB8; unsigned short* IDX;
};
DI float wave_sum(float v) {
#pragma unroll
    for (int o = 1; o < 64; o <<= 1) v += __shfl_xor(v, o);
    return v;
}
DI float bf_lo(unsigned u) { return __builtin_bit_cast(float, u << 16); }
DI float bf_hi(unsigned u) { return __builtin_bit_cast(float, u & 0xffff0000u); }

DI void p0_transpose_item(const float* W, int K, int N, bf16* WT, const float* gsc, LAS float* scr, int item, int lane) {
    const int nblk = N / 32, kb = item / nblk, nb = item % nblk, k0 = 64 * kb, n0 = 32 * nb;
#pragma unroll 8
    for (int i = 0; i < 32; ++i) { const int kk = 2 * i + (lane >> 5); float v = W[(size_t)(k0 + kk) * N + n0 + (lane & 31)]; if (gsc) v *= gsc[k0 + kk]; scr[kk * 33 + (lane & 31)] = v; }
    LDS_WAIT(); asm volatile("" ::: "memory");
    const int c = lane & 7;
#pragma unroll
    for (int j = 0; j < 4; ++j) { const int n = (lane >> 3) + 8 * j; const LAS float* s = scr + (8 * c) * 33 + n;
        v4u o; o.x = pk2(s[0 * 33], s[1 * 33]); o.y = pk2(s[2 * 33], s[3 * 33]); o.z = pk2(s[4 * 33], s[5 * 33]); o.w = pk2(s[6 * 33], s[7 * 33]);
        *(GAS v4u*)(WT + (size_t)(n0 + n) * K + k0 + 8 * c) = o; }
    LDS_WAIT(); asm volatile("" ::: "memory");
}
DI void p0_convert(Frame& F, const float* src, bf16* dst, size_t n, const float* colscale) {
    const size_t n8 = n / 8, stride = (size_t)F.G * NWAVES * 64;
    for (size_t i = (size_t)F.vcu * NWAVES * 64 + F.tid; i < n8; i += stride) {
        f32x4 a = *(const GAS f32x4*)(src + i * 8), b = *(const GAS f32x4*)(src + i * 8 + 4);
        if (colscale) { const int c = (int)((i * 8) & 1023); const f32x4 s0 = *(const GAS f32x4*)(colscale + c), s1 = *(const GAS f32x4*)(colscale + c + 4); a = a * s0; b = b * s1; }
        v4u o; o.x = pk2(a.x, a.y); o.y = pk2(a.z, a.w); o.z = pk2(b.x, b.y); o.w = pk2(b.z, b.w);
        *(GAS v4u*)(dst + i * 8) = o;
    }
}
constexpr float A_SCALE = 128.f;
DI unsigned pk4_fp8(f32x4 v) { int r = 0; r = __builtin_amdgcn_cvt_pk_fp8_f32(v[0], v[1], r, false); r = __builtin_amdgcn_cvt_pk_fp8_f32(v[2], v[3], r, true); return (unsigned)r; }
DI void p0_convert_fp8(Frame& F, const float* src, unsigned char* dst, size_t n, const float* colscale, float scale, int bidx, int nblk) {
    const int gw = bidx * NWAVES + F.wave, NGW = nblk * NWAVES, lane = F.lane;
    f32x4 cs[4];
#pragma unroll
    for (int q = 0; q < 4; ++q) cs[q] = colscale ? *(const GAS f32x4*)(colscale + 4 * lane + 256 * q) * scale : (f32x4){scale, scale, scale, scale};
    const int nrows = (int)(n / D);
    for (int e = gw; e < nrows; e += NGW) {
        const GAS f32x4* rp = (const GAS f32x4*)(src + (size_t)e * D) + lane;
        f32x4 v[4];
#pragma unroll
        for (int q = 0; q < 4; ++q) v[q] = rp[64 * q];
#pragma unroll
        for (int q = 0; q < 4; ++q) *(GAS unsigned*)(dst + ((size_t)(2 * q + (lane >> 5)) * NEXP + e) * 128 + ((4 * lane) & 127)) = pk4_fp8(v[q] * cs[q]);
    }
}
DI void p0_convert_fp4(Frame& F, const float* src, const float* gain, unsigned char* dst, float* scl, int e0, int e1) {
    const int gw = F.wave, NGW = NWAVES, lane = F.lane;
    f32x4 cs[4];
#pragma unroll
    for (int q = 0; q < 4; ++q) cs[q] = gain ? *(const GAS f32x4*)(gain + 4 * lane + 256 * q) : (f32x4){1.f, 1.f, 1.f, 1.f};
    for (int e = e0 + gw; e < e1; e += NGW) {
        const GAS f32x4* rp = (const GAS f32x4*)(src + (size_t)e * D) + lane;
        f32x4 v[4]; float mx = 0.f;
#pragma unroll
        for (int q = 0; q < 4; ++q) { v[q] = rp[64 * q] * cs[q]; mx = fmaxf(mx, fmaxf(fmaxf(fabsf(v[q][0]), fabsf(v[q][1])), fmaxf(fabsf(v[q][2]), fabsf(v[q][3])))); }
#pragma unroll
        for (int o = 1; o < 64; o <<= 1) mx = fmaxf(mx, __shfl_xor(mx, o));
        const float inv = mx > 0.f ? 6.f / mx : 0.f;
        if (lane == 0) scl[e] = mx * (1.f / 6.f);
#pragma unroll
        for (int q = 0; q < 4; ++q) { unsigned r = 0u;
            r = __builtin_amdgcn_cvt_scalef32_pk_fp4_f32(r, v[q][0] * inv, v[q][1] * inv, 1.0f, 0);
            r = __builtin_amdgcn_cvt_scalef32_pk_fp4_f32(r, v[q][2] * inv, v[q][3] * inv, 1.0f, 1);
            *(GAS unsigned short*)(dst + ((size_t)q * NEXP + e) * 128 + 2 * lane) = (unsigned short)r; }
    }
}
template <int RB> DI void p0_rows(Frame& F, const float* xrow, bf16* orow, float* rms_out) {
    f32x4 v[RB][4]; float s[RB];
#pragma unroll
    for (int r = 0; r < RB; ++r) { const GAS f32x4* xr = (const GAS f32x4*)(xrow + (size_t)r * D) + F.lane;
#pragma unroll
        for (int j = 0; j < 4; ++j) v[r][j] = xr[64 * j]; }
#pragma unroll
    for (int r = 0; r < RB; ++r) { s[r] = 0.f;
#pragma unroll
        for (int j = 0; j < 4; ++j) s[r] += (v[r][j].x * v[r][j].x + v[r][j].y * v[r][j].y) + (v[r][j].z * v[r][j].z + v[r][j].w * v[r][j].w); }
#pragma unroll
    for (int o = 1; o < 64; o <<= 1)
#pragma unroll
        for (int r = 0; r < RB; ++r) s[r] += __shfl_xor(s[r], o);
#pragma unroll
    for (int r = 0; r < RB; ++r) { const float rms = sqrtf(s[r] * (1.f / D) + EPS), rs = 1.f / rms; if (F.lane == 0) rms_out[r] = rms;
        GAS unsigned long long* o8 = (GAS unsigned long long*)(orow + (size_t)r * D) + F.lane;
#pragma unroll
        for (int j = 0; j < 4; ++j) o8[64 * j] = (unsigned long long)pk2(v[r][j].x * rs, v[r][j].y * rs) | ((unsigned long long)pk2(v[r][j].z * rs, v[r][j].w * rs) << 32); }
}
DI void p0_prologue(Frame& F) {
    LAS float* scr = (LAS float*)(F.lds + RING_OFF + F.wave * 16384);
    const int gw = F.vcu * NWAVES + F.wave, NGW = F.G * NWAVES;
    constexpr int I_IN = (D / 64) * (IN_DIM / 32), I_C = (CONV / 64) * (D / 32), I_O = (D / 64) * (D / 32), I_Q = (D / 64) * (PQ / 32);
    constexpr int NITEMS = I_IN + 2 * I_C + I_O + I_Q;
    for (int it = gw; it < NITEMS; it += NGW) {
        int r = it;
        if (r < I_IN) { p0_transpose_item(F.w_in, D, IN_DIM, F.WIN, F.norm_mix, scr, r, F.lane); continue; } r -= I_IN;
        if (r < I_C) { p0_transpose_item(F.w_conv_out, CONV, D, F.WC, nullptr, scr, r, F.lane); continue; } r -= I_C;
        if (r < I_C) { p0_transpose_item(F.w_attn_out, CONV, D, F.WA, nullptr, scr, r, F.lane); continue; } r -= I_C;
        if (r < I_O) { p0_transpose_item(F.w_out, D, D, F.WO, nullptr, scr, r, F.lane); continue; } r -= I_O;
        p0_transpose_item(F.w_query, D, PQ, F.WQ, F.norm_ffn, scr, r, F.lane);
    }
    p0_convert(F, F.sub_keys, F.SK, (size_t)PH * 2 * NKEYS * 128, nullptr);
    for (int m = 4 * gw; m < T; m += 4 * NGW) p0_rows<4>(F, F.x + (size_t)m * D, F.XB + (size_t)m * D, F.RSTD1 + m);
}

namespace pg8 {
DI float sigmoidf_(float v) { return __builtin_amdgcn_rcpf(1.f + __expf(-v)); }
DI size_t frag_off(int pm, int pn, int NT, int wave, int q, int lane) { return (((((size_t)pm * NT + pn) * 8 + wave) * 16 + q) * 64 + lane) * 8; }
struct EpiProj {
    static constexpr bool PERM = true, AFTER_DRAIN = false, HAS_INIT = false, CARRY = false;
    bf16_t* PA; bf16_t* G; const PG8_LAS float* bgl;
    DI void operator()(const f32x4 (&acc)[2][2][4][2], const Unit& u, int wr, int wc, int fr, int fq) const {
        const int row0 = u.pm * BM + wr * 64 + fr; const bool gate = u.pn >= 9;
        const int col0 = (gate ? (u.pn - 9) : u.pn) * BM + wc * 32 + 8 * fq;
        if (!gate) {
#pragma unroll
            for (int ai = 0; ai < 2; ++ai)
#pragma unroll
                for (int m = 0; m < 4; ++m) { bf16_t* rowp = PA + (size_t)(row0 + ai * HALF + m * 16) * PA_W + col0;
#pragma unroll
                    for (int bj = 0; bj < 2; ++bj) { const f32x4 v0 = acc[ai][bj][m][0], v1 = acc[ai][bj][m][1];
                        u32x4 w; w.x = cvt_pk_bf16(v0[0], v0[1]); w.y = cvt_pk_bf16(v0[2], v0[3]); w.z = cvt_pk_bf16(v1[0], v1[1]); w.w = cvt_pk_bf16(v1[2], v1[3]);
                        store16_wt(rowp + bj * HALF, w); } }
        } else {
            f32x4 bv[2][2];
#pragma unroll
            for (int bj = 0; bj < 2; ++bj)
#pragma unroll
                for (int n = 0; n < 2; ++n) bv[bj][n] = *(const PG8_LAS f32x4*)(bgl + col0 + bj * HALF + 4 * n);
#pragma unroll
            for (int ai = 0; ai < 2; ++ai)
#pragma unroll
                for (int m = 0; m < 4; ++m)
#pragma unroll
                    for (int bj = 0; bj < 2; ++bj) { f32x4 v0 = acc[ai][bj][m][0] + bv[bj][0], v1 = acc[ai][bj][m][1] + bv[bj][1];
#pragma unroll
                        for (int j = 0; j < 4; ++j) { v0[j] = fmaxf(sigmoidf_(v0[j]) * 255.f, 1.f); v1[j] = fmaxf(sigmoidf_(v1[j]) * 255.f, 1.f); }
                        unsigned g0 = 0u, g1 = 0u;
                        g0 = __builtin_amdgcn_cvt_pk_u8_f32(v0[0], 0, g0); g0 = __builtin_amdgcn_cvt_pk_u8_f32(v0[1], 1, g0); g0 = __builtin_amdgcn_cvt_pk_u8_f32(v0[2], 2, g0); g0 = __builtin_amdgcn_cvt_pk_u8_f32(v0[3], 3, g0);
                        g1 = __builtin_amdgcn_cvt_pk_u8_f32(v1[0], 0, g1); g1 = __builtin_amdgcn_cvt_pk_u8_f32(v1[1], 1, g1); g1 = __builtin_amdgcn_cvt_pk_u8_f32(v1[2], 2, g1); g1 = __builtin_amdgcn_cvt_pk_u8_f32(v1[3], 3, g1);
                        u32x2 gw; gw.x = g0; gw.y = g1;
                        *(u32x2*)((unsigned char*)G + frag_off(u.pm, u.pn - 9, 8, wr * 4 + wc, ai * 8 + m * 2 + bj, fq * 16 + fr)) = gw; }
        }
    }
};
struct EpiMix {
    static constexpr bool PERM = true, AFTER_DRAIN = false, HAS_INIT = false, CARRY = true;
    bf16_t* MIX; const bf16_t* G;
    DI void operator()(f32x4 (&acc)[2][2][4][2], const Unit& u, int wr, int wc, int fr, int fq) const {
        const int wave = wr * 4 + wc, lane = fq * 16 + fr;
        const unsigned char* gc = (const unsigned char*)G + frag_off(u.pm, u.pn, 8, wave, 0, lane); const unsigned char* ga = (const unsigned char*)G + frag_off(u.pm, u.pn + 4, 8, wave, 0, lane);
        bf16_t* mp = MIX + frag_off(u.pm, u.pn, 4, wave, 0, lane);
#pragma unroll
        for (int ai = 0; ai < 2; ++ai) {
            u32x2 gav[8], gcv[8];
#pragma unroll
            for (int q = 0; q < 8; ++q) gav[q] = *(const u32x2*)(ga + (ai * 8 + q) * 512);
            if (!u.which) {
#pragma unroll
                for (int q = 0; q < 8; ++q) gcv[q] = *(const u32x2*)(gc + (ai * 8 + q) * 512); }
#pragma unroll
            for (int m = 0; m < 4; ++m)
#pragma unroll
                for (int bj = 0; bj < 2; ++bj) { const int q = m * 2 + bj; const u32x2 a2 = gav[q];
                    float fa[8] = {(float)(a2.x & 0xffu), (float)((a2.x >> 8) & 0xffu), (float)((a2.x >> 16) & 0xffu), (float)(a2.x >> 24), (float)(a2.y & 0xffu), (float)((a2.y >> 8) & 0xffu), (float)((a2.y >> 16) & 0xffu), (float)(a2.y >> 24)};
                    if (!u.which) { const u32x2 c2 = gcv[q];
                        const float fc[8] = {(float)(c2.x & 0xffu), (float)((c2.x >> 8) & 0xffu), (float)((c2.x >> 16) & 0xffu), (float)(c2.x >> 24), (float)(c2.y & 0xffu), (float)((c2.y >> 8) & 0xffu), (float)((c2.y >> 16) & 0xffu), (float)(c2.y >> 24)};
#pragma unroll
                        for (int e = 0; e < 4; ++e) { acc[ai][bj][m][0][e] *= fc[e] * __builtin_amdgcn_rcpf(fa[e]); acc[ai][bj][m][1][e] *= fc[4 + e] * __builtin_amdgcn_rcpf(fa[4 + e]); }
                    } else { constexpr float GI = 1.f / 255.f;
                        const f32x4 v0 = acc[ai][bj][m][0], v1 = acc[ai][bj][m][1];
                        u32x4 w; w.x = cvt_pk_bf16(v0[0] * fa[0] * GI, v0[1] * fa[1] * GI); w.y = cvt_pk_bf16(v0[2] * fa[2] * GI, v0[3] * fa[3] * GI);
                        w.z = cvt_pk_bf16(v1[0] * fa[4] * GI, v1[1] * fa[5] * GI); w.w = cvt_pk_bf16(v1[2] * fa[6] * GI, v1[3] * fa[7] * GI);
                        store16_wt(mp + (ai * 8 + q) * 512, w); } }
        }
    }
};
struct FragOrder : StaticOrder { static constexpr bool AFRAG = true; };
struct PairOrder : StaticOrder {
    __device__ bool next(int i, Unit& u) const { const bool ok = StaticOrder::next(i >> 1, u); u.which = i & 1; return ok; }
    DI const char* a_base(const Gemm& g, const Unit& u, size_t tstep) const { return (const char*)(u.which ? g.A2 : g.A) + (size_t)u.pm * tstep; }
    DI const char* b_base(const Gemm& g, const Unit& u, size_t tstep) const { return (const char*)(u.which ? g.Bt2 : g.Bt) + (size_t)u.pn * tstep; }
};
struct EpiX1 {
    static constexpr bool PERM = true, AFTER_DRAIN = false, HAS_INIT = true, CARRY = false;
    const float* RMS; bf16_t* XB; float* SSQ; unsigned char* XB8;
    DI void init(f32x4 (&acc)[2][2][4][2], const Unit& u, int wr, int wc, int fr, int fq) const {
        const int row0 = u.pm * BM + wr * 64 + fr, col0 = u.pn * BM + wc * 32 + 8 * fq;
#pragma unroll
        for (int ai = 0; ai < 2; ++ai)
#pragma unroll
            for (int m = 0; m < 4; ++m)
#pragma unroll
                for (int bj = 0; bj < 2; ++bj) { const int row = row0 + ai * HALF + m * 16; const float rm = RMS[row];
                    const u32x4 xn = *(const u32x4*)(XB + (size_t)row * D + col0 + bj * HALF);
                    acc[ai][bj][m][0] = (f32x4){__builtin_bit_cast(float, xn.x << 16), __builtin_bit_cast(float, xn.x & 0xffff0000u), __builtin_bit_cast(float, xn.y << 16), __builtin_bit_cast(float, xn.y & 0xffff0000u)} * rm;
                    acc[ai][bj][m][1] = (f32x4){__builtin_bit_cast(float, xn.z << 16), __builtin_bit_cast(float, xn.z & 0xffff0000u), __builtin_bit_cast(float, xn.w << 16), __builtin_bit_cast(float, xn.w & 0xffff0000u)} * rm; }
    }
    DI void operator()(const f32x4 (&acc)[2][2][4][2], const Unit& u, int wr, int wc, int fr, int fq) const {
        const int row0 = u.pm * BM + wr * 64 + fr, col0 = u.pn * BM + wc * 32 + 8 * fq;
#pragma unroll
        for (int ai = 0; ai < 2; ++ai)
#pragma unroll
            for (int m = 0; m < 4; ++m) { const int row = row0 + ai * HALF + m * 16; float ss = 0.f;
#pragma unroll
                for (int bj = 0; bj < 2; ++bj) { const f32x4 v0 = acc[ai][bj][m][0], v1 = acc[ai][bj][m][1];
                    ss += ((v0[0] * v0[0] + v0[1] * v0[1]) + (v0[2] * v0[2] + v0[3] * v0[3])) + ((v1[0] * v1[0] + v1[1] * v1[1]) + (v1[2] * v1[2] + v1[3] * v1[3]));
                    u32x4 w; w.x = cvt_pk_bf16(v0[0], v0[1]); w.y = cvt_pk_bf16(v0[2], v0[3]); w.z = cvt_pk_bf16(v1[0], v1[1]); w.w = cvt_pk_bf16(v1[2], v1[3]);
                    store16_wt(XB + (size_t)row * D + col0 + bj * HALF, w);
                    { int p0_ = 0, p1_ = 0;
                      p0_ = __builtin_amdgcn_cvt_pk_fp8_f32(v0[0], v0[1], p0_, false); p0_ = __builtin_amdgcn_cvt_pk_fp8_f32(v0[2], v0[3], p0_, true);
                      p1_ = __builtin_amdgcn_cvt_pk_fp8_f32(v1[0], v1[1], p1_, false); p1_ = __builtin_amdgcn_cvt_pk_fp8_f32(v1[2], v1[3], p1_, true);
                      u32x2 w8; w8.x = (unsigned)p0_; w8.y = (unsigned)p1_; *(u32x2*)(XB8 + (size_t)row * D + col0 + bj * HALF) = w8; } }
                ss += __shfl_xor(ss, 16); ss += __shfl_xor(ss, 32);
                if (fq == 0) SSQ[(size_t)row * 16 + u.pn * 4 + wc] = ss; }
    }
};
DI float rstd2_of(const float* SSQ, int row) {
    const f32x4 a = *(const f32x4*)(SSQ + (size_t)row * 16), b = *(const f32x4*)(SSQ + (size_t)row * 16 + 4), c = *(const f32x4*)(SSQ + (size_t)row * 16 + 8), d = *(const f32x4*)(SSQ + (size_t)row * 16 + 12);
    const float s = ((a[0] + a[1]) + (a[2] + a[3])) + ((b[0] + b[1]) + (b[2] + b[3])) + ((c[0] + c[1]) + (c[2] + c[3])) + ((d[0] + d[1]) + (d[2] + d[3]));
    return 1.f / sqrtf(s * (1.f / D) + EPS);
}
struct EpiQP {
    static constexpr bool PERM = true, AFTER_DRAIN = false, HAS_INIT = false, CARRY = false;
    bf16_t* QP;
    DI void operator()(const f32x4 (&acc)[2][2][4][2], const Unit& u, int wr, int wc, int fr, int fq) const {
        const int row0 = u.pm * BM + wr * 64 + fr, col0 = u.pn * BM + wc * 32 + 8 * fq;
#pragma unroll
        for (int ai = 0; ai < 2; ++ai)
#pragma unroll
            for (int m = 0; m < 4; ++m) {
#pragma unroll
                for (int bj = 0; bj < 2; ++bj) { const f32x4 v0 = acc[ai][bj][m][0], v1 = acc[ai][bj][m][1];
                    u32x4 w; w.x = cvt_pk_bf16(v0[0], v0[1]); w.y = cvt_pk_bf16(v0[2], v0[3]); w.z = cvt_pk_bf16(v1[0], v1[1]); w.w = cvt_pk_bf16(v1[2], v1[3]);
                    *(u32x4*)(QP + frag_off(u.pm, u.pn, 8, wr * 4 + wc, ai * 8 + m * 2 + bj, fq * 16 + fr)) = w; } }
    }
};
}

#define MFMA32(a, b, c) __builtin_amdgcn_mfma_f32_32x32x16_bf16((a), (b), (c), 0, 0, 0)
DI void p2_conv(Frame& F) {
    constexpr int CT = 4;
    const size_t NT_ = (size_t)F.G * NWAVES * 64;
    for (size_t item = (size_t)F.vcu * NWAVES * 64 + F.tid; item < (size_t)(T / CT) * 64; item += NT_) {
        const int tb = (int)(item >> 6) * CT, c0 = (int)(item & 63) * 8, tl = tb & (SEQ - 1);
        v4u cg[CT + 2], uu[CT + 2], bg[CT];
#pragma unroll
        for (int r = 0; r < CT + 2; ++r) { const bool ok = (tl + r - 2) >= 0; const bf16* rowp = F.PA + (size_t)(tb + (ok ? r - 2 : 0)) * PA_W;
            cg[r] = *(const GAS v4u*)(rowp + C_C + c0); uu[r] = *(const GAS v4u*)(rowp + C_U + c0);
            if (!ok) { cg[r] = (v4u){0u, 0u, 0u, 0u}; } }
#pragma unroll
        for (int r = 0; r < CT; ++r) bg[r] = *(const GAS v4u*)(F.PA + (size_t)(tb + r) * PA_W + C_B + c0);
        f32x4 w[3][2];
#pragma unroll
        for (int j = 0; j < 3; ++j) { w[j][0] = *(const GAS f32x4*)(F.w_conv + j * CONV + c0); w[j][1] = *(const GAS f32x4*)(F.w_conv + j * CONV + c0 + 4); }
        float h[CT + 2][8];
#pragma unroll
        for (int r = 0; r < CT + 2; ++r) { h[r][0] = bf_lo(cg[r].x) * bf_lo(uu[r].x); h[r][1] = bf_hi(cg[r].x) * bf_hi(uu[r].x); h[r][2] = bf_lo(cg[r].y) * bf_lo(uu[r].y); h[r][3] = bf_hi(cg[r].y) * bf_hi(uu[r].y);
            h[r][4] = bf_lo(cg[r].z) * bf_lo(uu[r].z); h[r][5] = bf_hi(cg[r].z) * bf_hi(uu[r].z); h[r][6] = bf_lo(cg[r].w) * bf_lo(uu[r].w); h[r][7] = bf_hi(cg[r].w) * bf_hi(uu[r].w); }
#pragma unroll
        for (int r = 0; r < CT; ++r) {
            float a[8];
#pragma unroll
            for (int e = 0; e < 8; ++e) a[e] = w[0][e >> 2][e & 3] * h[r][e] + w[1][e >> 2][e & 3] * h[r + 1][e] + w[2][e >> 2][e & 3] * h[r + 2][e];
            v4u o; o.x = pk2(a[0] * bf_lo(bg[r].x), a[1] * bf_hi(bg[r].x)); o.y = pk2(a[2] * bf_lo(bg[r].y), a[3] * bf_hi(bg[r].y));
            o.z = pk2(a[4] * bf_lo(bg[r].z), a[5] * bf_hi(bg[r].z)); o.w = pk2(a[6] * bf_lo(bg[r].w), a[7] * bf_hi(bg[r].w));
            *(GAS v4u*)(F.Z + (size_t)(tb + r) * CONV + c0) = o;
        }
    }
}
DI int t5_bucket(int d) {
    if (d < 16) return d;
    const int large = 16 + (int)(logf((float)d / 16.f) / logf(8.f) * 16.f);
    return large < 31 ? large : 31;
}
constexpr int KS_STRIDE = 72, VT_STRIDE = 264;
constexpr int ATT_KS = 0, ATT_VT = 256 * KS_STRIDE * 2, ATT_BIAS = ATT_VT + 64 * VT_STRIDE * 2, ATT_END = ATT_BIAS + 4 * 128 * 4;
static_assert(ATT_END <= RING_BYTES, "attention LDS");
DI void p2_attention(Frame& F) {
    LAS bf16* KS = (LAS bf16*)(F.lds + ATT_KS); LAS bf16* VT = (LAS bf16*)(F.lds + ATT_VT); LAS float* BIAS = (LAS float*)(F.lds + ATT_BIAS);
    const int lane = F.lane, r = lane & 31, hh = lane >> 5;
#pragma unroll 1
    for (int unit = F.vcu; unit < 8 * 32 * NKV; unit += F.G) {
        const int kv = unit & 1, n = (unit >> 1) & 31, b = unit >> 6;
        const int t0 = b * SEQ + n * 128;
        __syncthreads();
        {
            const int j = F.tid >> 1, hf = F.tid & 1; const bool valid = (n > 0) || (j >= 128);
            const bf16* rowp = F.PA + (size_t)(t0 - 128 + j) * PA_W;
            v4u kq[4], vq[4];
#pragma unroll
            for (int i = 0; i < 4; ++i) { kq[i] = (v4u){0u, 0u, 0u, 0u}; vq[i] = kq[i]; }
            if (valid) {
#pragma unroll
                for (int i = 0; i < 4; ++i) { kq[i] = *(const GAS v4u*)(rowp + C_K + kv * HD + hf * 32 + i * 8); vq[i] = *(const GAS v4u*)(rowp + C_V + kv * HD + hf * 32 + i * 8); }
            }
            float kf[32]; float ss = 0.f;
#pragma unroll
            for (int i = 0; i < 4; ++i) { kf[8 * i + 0] = bf_lo(kq[i].x); kf[8 * i + 1] = bf_hi(kq[i].x); kf[8 * i + 2] = bf_lo(kq[i].y); kf[8 * i + 3] = bf_hi(kq[i].y);
                kf[8 * i + 4] = bf_lo(kq[i].z); kf[8 * i + 5] = bf_hi(kq[i].z); kf[8 * i + 6] = bf_lo(kq[i].w); kf[8 * i + 7] = bf_hi(kq[i].w); }
#pragma unroll
            for (int e = 0; e < 32; ++e) ss += kf[e] * kf[e];
            ss += __shfl_xor(ss, 1);
            const float rs = 1.f / sqrtf(ss * (1.f / HD) + EPS);
#pragma unroll
            for (int i = 0; i < 4; ++i) { const f32x4 g0 = *(const GAS f32x4*)(F.k_norm + hf * 32 + 8 * i), g1 = *(const GAS f32x4*)(F.k_norm + hf * 32 + 8 * i + 4);
                v4u o; o.x = pk2(kf[8 * i + 0] * rs * g0[0], kf[8 * i + 1] * rs * g0[1]); o.y = pk2(kf[8 * i + 2] * rs * g0[2], kf[8 * i + 3] * rs * g0[3]);
                o.z = pk2(kf[8 * i + 4] * rs * g1[0], kf[8 * i + 5] * rs * g1[1]); o.w = pk2(kf[8 * i + 6] * rs * g1[2], kf[8 * i + 7] * rs * g1[3]);
                *(LAS v4u*)(KS + j * KS_STRIDE + hf * 32 + 8 * i) = o; }
#pragma unroll
            for (int i = 0; i < 4; ++i) { const int d0 = hf * 32 + 8 * i;
                VT[(d0 + 0) * VT_STRIDE + j] = (bf16)(vq[i].x & 0xffffu); VT[(d0 + 1) * VT_STRIDE + j] = (bf16)(vq[i].x >> 16);
                VT[(d0 + 2) * VT_STRIDE + j] = (bf16)(vq[i].y & 0xffffu); VT[(d0 + 3) * VT_STRIDE + j] = (bf16)(vq[i].y >> 16);
                VT[(d0 + 4) * VT_STRIDE + j] = (bf16)(vq[i].z & 0xffffu); VT[(d0 + 5) * VT_STRIDE + j] = (bf16)(vq[i].z >> 16);
                VT[(d0 + 6) * VT_STRIDE + j] = (bf16)(vq[i].w & 0xffffu); VT[(d0 + 7) * VT_STRIDE + j] = (bf16)(vq[i].w >> 16); }
            { const int g = F.tid >> 7, dist = F.tid & 127; BIAS[F.tid] = F.rel_bias[t5_bucket(dist) * NH + kv * 4 + g]; }
        }
        __syncthreads();
#pragma unroll 1
        for (int task = F.wave; task < 16; task += NWAVES) {
            const int g = task >> 2, c = task & 3, head = kv * 4 + g, r0 = 32 * c;
            bf16x8 qf[4];
            {
                const bf16* qp = F.PA + (size_t)(t0 + r0 + r) * PA_W + C_Q + head * HD + 8 * hh;
                v4u qq[4]; float qv[32]; float ss = 0.f;
#pragma unroll
                for (int s = 0; s < 4; ++s) qq[s] = *(const GAS v4u*)(qp + 16 * s);
#pragma unroll
                for (int s = 0; s < 4; ++s) { qv[8 * s + 0] = bf_lo(qq[s].x); qv[8 * s + 1] = bf_hi(qq[s].x); qv[8 * s + 2] = bf_lo(qq[s].y); qv[8 * s + 3] = bf_hi(qq[s].y);
                    qv[8 * s + 4] = bf_lo(qq[s].z); qv[8 * s + 5] = bf_hi(qq[s].z); qv[8 * s + 6] = bf_lo(qq[s].w); qv[8 * s + 7] = bf_hi(qq[s].w); }
#pragma unroll
                for (int e = 0; e < 32; ++e) ss += qv[e] * qv[e];
                ss += __shfl_xor(ss, 32);
                const float rs = 0.125f / sqrtf(ss * (1.f / HD) + EPS);
#pragma unroll
                for (int s = 0; s < 4; ++s) { const f32x4 g0 = *(const GAS f32x4*)(F.q_norm + 16 * s + 8 * hh), g1 = *(const GAS f32x4*)(F.q_norm + 16 * s + 8 * hh + 4);
                    v4u o; o.x = pk2(qv[8 * s + 0] * rs * g0[0], qv[8 * s + 1] * rs * g0[1]); o.y = pk2(qv[8 * s + 2] * rs * g0[2], qv[8 * s + 3] * rs * g0[3]);
                    o.z = pk2(qv[8 * s + 4] * rs * g1[0], qv[8 * s + 5] * rs * g1[1]); o.w = pk2(qv[8 * s + 6] * rs * g1[2], qv[8 * s + 7] * rs * g1[3]);
                    qf[s] = __builtin_bit_cast(bf16x8, o); }
            }
            f32x16 sacc[5];
#pragma unroll
            for (int i5 = 0; i5 < 5; ++i5) {
#pragma unroll
                for (int e = 0; e < 16; ++e) sacc[i5][e] = 0.f;
                const int kt = c + i5;
#pragma unroll
                for (int s = 0; s < 4; ++s) { const bf16x8 ka = *(const LAS bf16x8*)(KS + (32 * kt + r) * KS_STRIDE + 16 * s + 8 * hh); sacc[i5] = MFMA32(ka, qf[s], sacc[i5]); }
            }
            const float sink = F.sinks[head];
            const int dbase = r - 4 * hh + 128;
            const LAS float* bl = BIAS + g * 128;
            float mx = sink;
#pragma unroll
            for (int i5 = 0; i5 < 5; ++i5) {
                const bool tile_ok = (n > 0) || (c + i5 >= 4);
#pragma unroll
                for (int e = 0; e < 16; ++e) { const int dist = dbase - 32 * i5 - ((e & 3) + 8 * (e >> 2));
                    bool valid = tile_ok; if (i5 == 0) valid = valid && (dist < 128); if (i5 == 4) valid = valid && (dist >= 0);
                    const float lg = sacc[i5][e] + bl[dist & 127];
                    sacc[i5][e] = valid ? lg : -INFINITY; mx = fmaxf(mx, sacc[i5][e]); }
                __builtin_amdgcn_sched_barrier(0);
            }
            mx = fmaxf(mx, __shfl_xor(mx, 32));
            float sum = 0.f;
#pragma unroll
            for (int i5 = 0; i5 < 5; ++i5)
#pragma unroll
                for (int e = 0; e < 16; ++e) { const float p = __expf(sacc[i5][e] - mx); sacc[i5][e] = p; sum += p; }
            sum += __shfl_xor(sum, 32);
            const float inv = 1.f / (sum + __expf(sink - mx));
            f32x16 oacc[2];
#pragma unroll
            for (int dt = 0; dt < 2; ++dt)
#pragma unroll
                for (int e = 0; e < 16; ++e) oacc[dt][e] = 0.f;
#pragma unroll
            for (int i5 = 0; i5 < 5; ++i5)
#pragma unroll
                for (int s2 = 0; s2 < 2; ++s2) {
                    v4u pp; pp.x = pk2(sacc[i5][8 * s2 + 0] * inv, sacc[i5][8 * s2 + 1] * inv); pp.y = pk2(sacc[i5][8 * s2 + 2] * inv, sacc[i5][8 * s2 + 3] * inv);
                    pp.z = pk2(sacc[i5][8 * s2 + 4] * inv, sacc[i5][8 * s2 + 5] * inv); pp.w = pk2(sacc[i5][8 * s2 + 6] * inv, sacc[i5][8 * s2 + 7] * inv);
                    const bf16x8 pb = __builtin_bit_cast(bf16x8, pp);
                    const int kb = 32 * (c + i5) + 16 * s2 + 4 * hh;
#pragma unroll
                    for (int dt = 0; dt < 2; ++dt) {
                        const v2u lo = *(const LAS v2u*)(VT + (32 * dt + r) * VT_STRIDE + kb), hi = *(const LAS v2u*)(VT + (32 * dt + r) * VT_STRIDE + kb + 8);
                        v4u va; va.x = lo.x; va.y = lo.y; va.z = hi.x; va.w = hi.y;
                        oacc[dt] = MFMA32(__builtin_bit_cast(bf16x8, va), pb, oacc[dt]);
                    }
                    __builtin_amdgcn_sched_barrier(0);
                }
            bf16* op = F.ATT + (size_t)(t0 + r0 + r) * CONV + head * HD;
#pragma unroll
            for (int dt = 0; dt < 2; ++dt)
#pragma unroll
                for (int g4 = 0; g4 < 4; ++g4) { v2u w; w.x = pk2(oacc[dt][4 * g4 + 0], oacc[dt][4 * g4 + 1]); w.y = pk2(oacc[dt][4 * g4 + 2], oacc[dt][4 * g4 + 3]);
#ifdef ZERO_ATT
                    w.x = 0u; w.y = 0u;
#endif
                    *(GAS v2u*)(op + 32 * dt + 8 * g4 + 4 * hh) = w; }
        }
    }
}

DI unsigned f2ord(float f) { const unsigned b = __builtin_bit_cast(unsigned, f); return b ^ ((b >> 31) ? 0xffffffffu : 0x80000000u); }
DI float ord2f(unsigned k) { const unsigned b = k ^ ((k >> 31) ? 0x80000000u : 0xffffffffu); return __builtin_bit_cast(float, b); }
DI unsigned umax_(unsigned a, unsigned b) { return a > b ? a : b; }
DI unsigned umin_(unsigned a, unsigned b) { return a < b ? a : b; }
DI void sort16_desc(unsigned (&v)[16]) {
#pragma unroll
    for (int k = 2; k <= 16; k <<= 1)
#pragma unroll
        for (int j = k >> 1; j > 0; j >>= 1)
#pragma unroll
            for (int i = 0; i < 16; ++i) { const int l = i ^ j; if (l > i) { const bool desc = ((i & k) == 0) || (k == 16); const unsigned a = v[i], b = v[l], hi = umax_(a, b), lo = umin_(a, b); v[i] = desc ? hi : lo; v[l] = desc ? lo : hi; } }
}
DI void merge_top16(unsigned (&a)[16], const unsigned (&b)[16]) {
#pragma unroll
    for (int i = 0; i < 16; ++i) a[i] = umax_(a[i], b[15 - i]);
#pragma unroll
    for (int j = 8; j > 0; j >>= 1)
#pragma unroll
        for (int i = 0; i < 16; ++i) { const int l = i ^ j; if (l > i) { const unsigned x = a[i], y = a[l]; a[i] = umax_(x, y); a[l] = umin_(x, y); } }
}
constexpr int SK_STRIDE = 136;
constexpr int P6_KEYS = 0, P6_IB = 2 * NKEYS * SK_STRIDE * 2, P6_END = P6_IB + NWAVES * 64 * 32;
static_assert(P6_END <= RING_BYTES, "topk LDS");
DI void p6_topk(Frame& F) {
    LAS bf16* KL = (LAS bf16*)(F.lds + P6_KEYS); LAS unsigned char* IB = F.lds + P6_IB + (F.wave * 64 + F.lane) * 32;
    const int lane = F.lane, r = lane & 31, hh = lane >> 5;
    pg8::StaticOrder S; S.init(T, PQ, F.G, (int)blockIdx.x);
    pg8::Unit pu;
    for (int ui = 0; S.next(ui, pu); ++ui) {
        const int h = pu.pn, tile = pu.pm;
        __syncthreads();
        {
            const bf16* src = F.SK + (size_t)h * 2 * NKEYS * 128;
#pragma unroll
            for (int i = 0; i < 8; ++i) { const int ch = F.tid + 512 * i; const int row = ch >> 4, c8 = (ch & 15) * 8;
                *(LAS v4u*)(KL + row * SK_STRIDE + c8) = *(const GAS v4u*)(src + (size_t)row * 128 + c8); }
        }
        __syncthreads();
        const int t = tile * 256 + F.wave * 32 + r;
        unsigned S[2][16];
#pragma unroll
        for (int p = 0; p < 2; ++p) {
            bf16x8 qf[8];
            const int rt = F.wave * 32 + r, q_ai = rt >> 7, q_wr = (rt >> 6) & 1, q_m = (rt >> 4) & 3, q_fr = rt & 15;
#pragma unroll
            for (int s = 0; s < 8; ++s) qf[s] = __builtin_bit_cast(bf16x8, *(const GAS v4u*)(F.QP + pg8::frag_off(tile, h, 8, q_wr * 4 + (s >> 1), q_ai * 8 + q_m * 2 + p, (2 * (s & 1) + hh) * 16 + q_fr)));
            unsigned key[4][16];
#pragma unroll
            for (int kt = 0; kt < 4; ++kt) {
                f32x16 acc;
#pragma unroll
                for (int e = 0; e < 16; ++e) acc[e] = 0.f;
#pragma unroll
                for (int s = 0; s < 8; ++s) { const bf16x8 ka = *(const LAS bf16x8*)(KL + (p * NKEYS + 32 * kt + r) * SK_STRIDE + 16 * s + 8 * hh); acc = MFMA32(ka, qf[s], acc); }
#pragma unroll
                for (int e = 0; e < 16; ++e) { const int nk = 32 * kt + (e & 3) + 8 * (e >> 2) + 4 * hh; key[kt][e] = (f2ord(acc[e]) & ~127u) | (unsigned)(127 - nk); }
            }
#pragma unroll
            for (int kt = 0; kt < 4; ++kt) sort16_desc(key[kt]);
            merge_top16(key[0], key[1]); merge_top16(key[2], key[3]); merge_top16(key[0], key[2]);
            unsigned other[16];
#pragma unroll
            for (int i = 0; i < 16; ++i) other[i] = (unsigned)__shfl_xor((int)key[0][i], 32);
            merge_top16(key[0], other);
#pragma unroll
            for (int i = 0; i < 16; ++i) S[p][i] = key[0][i];
        }
        float s0[16], s1[16]; const float rs2 = pg8::rstd2_of(F.SSQ, t);
#pragma unroll
        for (int i = 0; i < 16; ++i) { s0[i] = ord2f(S[0][i] & ~127u) * rs2; s1[i] = ord2f(S[1][i] & ~127u) * rs2; }
        {
#pragma unroll
            for (int q4 = 0; q4 < 4; ++q4) { unsigned w0 = 0, w1 = 0;
#pragma unroll
                for (int e = 0; e < 4; ++e) { w0 |= (127u - (S[0][4 * q4 + e] & 127u)) << (8 * e); w1 |= (127u - (S[1][4 * q4 + e] & 127u)) << (8 * e); }
                *(LAS unsigned*)(IB + 4 * q4) = w0; *(LAS unsigned*)(IB + 16 + 4 * q4) = w1; }
        }
        unsigned cand[2][16];
#pragma unroll
        for (int i = 0; i < 2; ++i)
#pragma unroll
            for (int e = 0; e < 16; ++e) cand[i][e] = 0u;
        {
            int cnt = 0; float ea = 0.f, eb = 0.f; int ep = 0;
#pragma unroll
            for (int a = 0; a < 16; ++a)
#pragma unroll
                for (int b = 0; b < 16; ++b)
                    if ((a + 1) * (b + 1) <= 16) {
                        if ((cnt & 1) == 0) { ea = s0[a]; eb = s1[b]; ep = 255 - (a * 16 + b); }
                        else { const int slot = cnt >> 1; const float sa = hh ? s0[a] : ea, sb = hh ? s1[b] : eb; const int pp = hh ? 255 - (a * 16 + b) : ep;
                            cand[slot & 1][slot >> 1] = (f2ord(sa + sb) & ~255u) | (unsigned)pp; }
                        ++cnt; }
        }
        sort16_desc(cand[0]); sort16_desc(cand[1]); merge_top16(cand[0], cand[1]);
        {
            unsigned other[16];
#pragma unroll
            for (int i = 0; i < 16; ++i) other[i] = (unsigned)__shfl_xor((int)cand[0][i], 32);
            merge_top16(cand[0], other);
        }
        float gv[16]; int ev[16]; float gsum = 0.f; const float gmx = ord2f(cand[0][0] & ~255u);
#pragma unroll
        for (int i = 0; i < 16; ++i) { const unsigned k = cand[0][i]; const int pos = 255 - (int)(k & 255u); const int a = pos >> 4, b = pos & 15;
            ev[i] = (int)IB[a] * NKEYS + (int)IB[16 + b]; gv[i] = __expf(ord2f(k & ~255u) - gmx); gsum += gv[i]; }
        float ginv = 1.f / gsum;
#ifdef UNIFORM_GATES
#pragma unroll
        for (int i = 0; i < 16; ++i) gv[i] = 1.f;
        ginv = 1.f / 16.f;
#endif
        if (hh == 0) {
            unsigned short* ip = F.IDX + (size_t)t * NSEL + h * TOPK; float* gp = F.GATE + (size_t)t * NSEL + h * TOPK;
#pragma unroll
            for (int i = 0; i < 2; ++i) *(GAS v4i*)(ip + 8 * i) = (v4i){ev[8 * i] | (ev[8 * i + 1] << 16), ev[8 * i + 2] | (ev[8 * i + 3] << 16), ev[8 * i + 4] | (ev[8 * i + 5] << 16), ev[8 * i + 6] | (ev[8 * i + 7] << 16)};
#pragma unroll
            for (int i = 0; i < 4; ++i) *(GAS f32x4*)(gp + 4 * i) = (f32x4){gv[4 * i] * ginv, gv[4 * i + 1] * ginv, gv[4 * i + 2] * ginv, gv[4 * i + 3] * ginv};
        }
    }
}

typedef float f32x2_t __attribute__((ext_vector_type(2)));
DI void fp8x16_to_f32(v4u q, float (&f)[16]) {
#pragma unroll
    for (int w = 0; w < 4; ++w) { const f32x2_t lo = __builtin_amdgcn_cvt_pk_f32_fp8((int)q[w], false), hi = __builtin_amdgcn_cvt_pk_f32_fp8((int)q[w], true);
        f[4 * w + 0] = lo.x; f[4 * w + 1] = lo.y; f[4 * w + 2] = hi.x; f[4 * w + 3] = hi.y; }
}
struct XccInfo { int q, nx, nloc, rank; };
DI void xcc_info_build(const XcdBarrier& b) {
    if (threadIdx.x == 0) {
        unsigned q = 0, nx = 0, nloc = 1;
        for (unsigned j = 0; j < 16; ++j) { const unsigned c = xb_ld(&b.bar[XB_XCNT(j)]); if (c > 0u) { if (j < b.x) ++q; ++nx; } if (j == b.x) nloc = c; }
        b.st[3] = q; b.st[4] = nx > 0u ? nx : 1u; b.st[5] = nloc > 0u ? nloc : 1u;
    }
    __syncthreads();
}
DI XccInfo xcc_info(const XcdBarrier& b) {
    XccInfo I; I.rank = __builtin_amdgcn_readfirstlane((int)b.st[2]); I.q = __builtin_amdgcn_readfirstlane((int)b.st[3]); I.nx = __builtin_amdgcn_readfirstlane((int)b.st[4]); I.nloc = __builtin_amdgcn_readfirstlane((int)b.st[5]);
    return I;
}
DI float dpp_sum8(float s) {
    s += __builtin_bit_cast(float, __builtin_amdgcn_update_dpp(0, __builtin_bit_cast(int, s), 0xB1, 0xf, 0xf, false));
    s += __builtin_bit_cast(float, __builtin_amdgcn_update_dpp(0, __builtin_bit_cast(int, s), 0x4E, 0xf, 0xf, false));
    s += __builtin_bit_cast(float, __builtin_amdgcn_update_dpp(0, __builtin_bit_cast(int, s), 0x141, 0xf, 0xf, false));
    return s;
}
typedef long i64_t;
typedef long i64x2 __attribute__((ext_vector_type(2)));
typedef int v4i_t __attribute__((ext_vector_type(4)));
typedef int v8i_t __attribute__((ext_vector_type(8)));
constexpr int PEER_ROW = 144, PEER_WAVE_LDS = 128 * PEER_ROW;
constexpr int MX_ONE = 0x7f7f7f7f;
#define P7_IDS(t_, ia_, ib_) do { ia_ = (int)F.IDX[(size_t)(t_) * NSEL + lane]; ib_ = (int)F.IDX[(size_t)(t_) * NSEL + 64 + lane]; } while (0)
#define P7_ISSUE(t_, ia_, ib_, uq_, x_) do { \
        const unsigned char* xr_ = F.XB8 + (size_t)(t_) * D + sl * 256 + 16 * g;   \
        x_[0] = *(const GAS v4u*)(xr_); x_[1] = *(const GAS v4u*)(xr_ + 64); x_[2] = *(const GAS v4u*)(xr_ + 128); x_[3] = *(const GAS v4u*)(xr_ + 192); \
        _Pragma("unroll") for (int ld = 0; ld < 16; ++ld) { const int e_ = __shfl(ld < 8 ? ia_ : ib_, (8 * ld + row8) & 63); uq_[ld] = *(const GAS v4u*)(Us + (unsigned)(e_ * 128 + 16 * c8)); } } while (0)
#define P7_COMPUTE(t_, uq_, x_) do { \
        _Pragma("unroll") for (int ld = 0; ld < 16; ++ld) *(LAS v4u*)(wl + (8 * ld + row8) * PEER_ROW + 16 * c8) = uq_[ld]; \
        v8i_t xb0_, xb1_; \
        xb0_[0] = (int)x_[0].x; xb0_[1] = (int)x_[0].y; xb0_[2] = (int)x_[0].z; xb0_[3] = (int)x_[0].w; xb0_[4] = (int)x_[1].x; xb0_[5] = (int)x_[1].y; xb0_[6] = (int)x_[1].z; xb0_[7] = (int)x_[1].w; \
        xb1_[0] = (int)x_[2].x; xb1_[1] = (int)x_[2].y; xb1_[2] = (int)x_[2].z; xb1_[3] = (int)x_[2].w; xb1_[4] = (int)x_[3].x; xb1_[5] = (int)x_[3].y; xb1_[6] = (int)x_[3].z; xb1_[7] = (int)x_[3].w; \
        f32x4 keep = {0.f, 0.f, 0.f, 0.f}; \
        _Pragma("unroll") for (int j = 0; j < 8; ++j) { f32x4 c_ = {0.f, 0.f, 0.f, 0.f}; \
            const v4i_t a0_ = *(const LAS v4i_t*)(wl + (16 * j + m) * PEER_ROW + 16 * g), a1_ = *(const LAS v4i_t*)(wl + (16 * j + m) * PEER_ROW + 64 + 16 * g); \
            v8i_t A0_ = {a0_[0], a0_[1], a0_[2], a0_[3], 0, 0, 0, 0}, A1_ = {a1_[0], a1_[1], a1_[2], a1_[3], 0, 0, 0, 0}; \
            c_ = __builtin_amdgcn_mfma_scale_f32_16x16x128_f8f6f4(A0_, xb0_, c_, 4, 0, 0, MX_ONE, 0, MX_ONE); \
            c_ = __builtin_amdgcn_mfma_scale_f32_16x16x128_f8f6f4(A1_, xb1_, c_, 4, 0, 0, MX_ONE, 0, MX_ONE); \
            keep = (m == j) ? c_ : keep; } \
        { const bool ok_ = (m < 8) && ((t_) < T); bf16* dst_ = ok_ ? F.PARTB + ((size_t)sl * T + (t_)) * NSEL + 16 * m + 4 * g : F.PARTB + (size_t)8 * T * NSEL + 4 * lane; \
          v2u w_; w_.x = pk2(keep[0], keep[1]); w_.y = pk2(keep[2], keep[3]); *(GAS v2u*)dst_ = w_; } } while (0)
DI int peer_next(volatile LAS unsigned* ctr, int lane) { unsigned k = 0u; if (lane == 0) k = __hip_atomic_fetch_add((LAS unsigned*)ctr, 1u, __ATOMIC_RELAXED, __HIP_MEMORY_SCOPE_WORKGROUP); return __builtin_amdgcn_readfirstlane((int)k); }
DI int peer_tok(int tbase, int tstride, int k) { return tbase + (k & 7) + (k >> 3) * tstride; }
DI void p7_udot(Frame& F, const XccInfo& I) {
    const int lane = F.lane, g = lane >> 4, m = lane & 15, row8 = lane >> 3, c8 = lane & 7;
    LAS unsigned char* wl = F.lds + F.wave * PEER_WAVE_LDS;
    const unsigned char* U4 = (const unsigned char*)F.UB;
    const int tstride = I.nloc * NWAVES, tbase = I.rank * NWAVES;
    int it = 0;
    for (int share = I.q; share < 8; share += I.nx, ++it) {
        const int sl = share >> 1, half = share & 1;
        const unsigned char* Us = U4 + (size_t)sl * NEXP * 128;
        volatile LAS unsigned* ctr = F.MISC + 16 + it;
#define CL(t_) ((t_) < T ? (t_) : T - 1)
#define TOK(k_) (2 * peer_tok(tbase, tstride, (k_)) + half)
        v4u uqA[16], uqB[16]; int iA0, iA1, iB0, iB1;
        int kk = peer_next(ctr, lane); int tA = TOK(kk); kk = peer_next(ctr, lane); int tB = TOK(kk);
        {
            v4u xA[4], xB[4];
            P7_IDS(CL(tA), iA0, iA1);
            P7_ISSUE(CL(tA), iA0, iA1, uqA, xA);
            P7_IDS(CL(tB), iB0, iB1);
#pragma unroll 1
            while (tA < T) {
                kk = peer_next(ctr, lane); const int tC = TOK(kk); kk = peer_next(ctr, lane); const int tD = TOK(kk);
                P7_IDS(CL(tC), iA0, iA1);
                P7_ISSUE(CL(tB), iB0, iB1, uqB, xB);
                P7_COMPUTE(tA, uqA, xA);
                P7_IDS(CL(tD), iB0, iB1);
                P7_ISSUE(CL(tC), iA0, iA1, uqA, xA);
                P7_COMPUTE(tB, uqB, xB);
                tA = tC; tB = tD;
            }
        }
#undef TOK
#undef CL
    }
}
DI void p8_act(Frame& F) {
    const size_t NT_ = (size_t)F.G * NWAVES * 64;
    for (size_t item = (size_t)F.vcu * NWAVES * 64 + F.tid; item < (size_t)T * NSEL / 4; item += NT_) {
        const int t = (int)(item >> 5);
        f32x4 s = {0.f, 0.f, 0.f, 0.f}, vs4;
#pragma unroll
        for (int sl = 0; sl < 4; ++sl) { const v2u p = *(const GAS v2u*)(F.PARTB + (size_t)sl * T * NSEL + item * 4); s = s + (f32x4){bf_lo(p.x), bf_hi(p.x), bf_lo(p.y), bf_hi(p.y)}; }
        { const v2u ids = *(const GAS v2u*)(F.IDX + item * 4);
          s[0] *= F.SU[ids.x & 0xffffu]; s[1] *= F.SU[ids.x >> 16]; s[2] *= F.SU[ids.y & 0xffffu]; s[3] *= F.SU[ids.y >> 16];
          vs4 = (f32x4){F.SV[ids.x & 0xffffu], F.SV[ids.x >> 16], F.SV[ids.y & 0xffffu], F.SV[ids.y >> 16]}; }
        const float rs2 = pg8::rstd2_of(F.SSQ, t);
        const f32x4 g = *(const GAS f32x4*)(F.GATE + item * 4);
        f32x4 o;
#pragma unroll
        for (int e = 0; e < 4; ++e) { const float pre = s[e] * rs2; o[e] = 0.5f * pre * (1.f + erff(pre * 0.70710678118f)) * g[e] * vs4[e] * A_SCALE; }
        ((GAS unsigned*)F.ACT)[item] = pk4_fp8(o);
    }
}
typedef int v2i_t __attribute__((ext_vector_type(2)));
#define P9_IDS(t_, ia_, ib_, ak_) do { ia_ = (int)F.IDX[(size_t)(t_) * NSEL + lane]; ib_ = (int)F.IDX[(size_t)(t_) * NSEL + 64 + lane]; \
        const unsigned char* ap_ = (const unsigned char*)F.ACT + (size_t)(t_) * NSEL + 16 * g; \
        ak_[0] = *(const GAS v4u*)(ap_); ak_[1] = *(const GAS v4u*)(ap_ + 64); } while (0)
#define P9_ISSUE(ia_, ib_, vq_) do { \
        _Pragma("unroll") for (int ld = 0; ld < 16; ++ld) { const int e_ = __shfl(ld < 8 ? ia_ : ib_, (8 * ld + row8) & 63); vq_[ld] = *(const GAS v4u*)(Vs + (unsigned)(e_ * 128 + 16 * c8)); } } while (0)
#define P9_COMPUTE(t_, vq_, ak_) do { \
        _Pragma("unroll") for (int ld = 0; ld < 16; ++ld) *(LAS v4u*)(wl + (8 * ld + row8) * PEER_ROW + 16 * c8) = vq_[ld]; \
        const v8i_t A_ = {(int)ak_[0].x, (int)ak_[0].y, (int)ak_[0].z, (int)ak_[0].w, (int)ak_[1].x, (int)ak_[1].y, (int)ak_[1].z, (int)ak_[1].w}; \
        float keep[4] = {0.f, 0.f, 0.f, 0.f}; \
        _Pragma("unroll") for (int ct = 0; ct < 16; ++ct) { \
            const v2i_t b0_ = __builtin_amdgcn_ds_read_tr4_b64_v2i32((LAS v2i_t*)(wl + (32 * g + n16) * PEER_ROW + 8 * ct)); \
            const v2i_t b1_ = __builtin_amdgcn_ds_read_tr4_b64_v2i32((LAS v2i_t*)(wl + (32 * g + 16 + n16) * PEER_ROW + 8 * ct)); \
            const v8i_t B_ = {b0_[0], b0_[1], b1_[0], b1_[1], 0, 0, 0, 0}; f32x4 c_ = {0.f, 0.f, 0.f, 0.f}; \
            c_ = __builtin_amdgcn_mfma_scale_f32_16x16x128_f8f6f4(A_, B_, c_, 0, 4, 0, MX_ONE, 0, MX_ONE); \
            keep[ct >> 2] = (g == (ct & 3)) ? c_[0] : keep[ct >> 2]; }   \
        { const bool ok_ = (t_) < T; const size_t oo_ = (size_t)(ok_ ? (t_) : T - 1) * D + sl * 256 + 16 * g + n16; \
          float* op_ = ok_ ? F.out + oo_ : (float*)F.PARTB + 4 * lane;                   \
          _Pragma("unroll") for (int q = 0; q < 4; ++q) op_[ok_ ? 64 * q : q] = __builtin_bit_cast(float, (unsigned)F.XB[oo_ + 64 * q] << 16) + keep[q] * (1.f / A_SCALE); } } while (0)
DI void p9_vacc(Frame& F, const XccInfo& I) {
    const int lane = F.lane, g = lane >> 4, n16 = lane & 15, row8 = lane >> 3, c8 = lane & 7;
    LAS unsigned char* wl = F.lds + F.wave * PEER_WAVE_LDS;
    const unsigned char* V4 = (const unsigned char*)F.VB;
    const int tstride = I.nloc * NWAVES, tfirst = I.rank * NWAVES + F.wave;
    for (int share = I.q; share < 8; share += I.nx) {
        const int sl = share >> 1, half = share & 1;
        const unsigned char* Vs = V4 + (size_t)sl * NEXP * 128;
        if (2 * tfirst + half >= T) continue;
        v4u vqA[16], vqB[16]; v4u akA[2], akB[2]; int iA0, iA1, iB0, iB1;
#define CL(t_) ((t_) < T ? (t_) : T - 1)
#define TK(k_) (2 * (tfirst + (k_) * tstride) + half)
        P9_IDS(TK(0), iA0, iA1, akA);
        P9_ISSUE(iA0, iA1, vqA);
        P9_IDS(CL(TK(1)), iB0, iB1, akB);
#pragma unroll 1
        for (int k = 0; TK(k) < T; k += 2) {
            const int t = TK(k), t1 = TK(k + 1), t2 = CL(TK(k + 2)), t3 = CL(TK(k + 3));
            v4u akN[2], akM[2];
            P9_IDS(t2, iA0, iA1, akN);
            P9_ISSUE(iB0, iB1, vqB);
            P9_COMPUTE(t, vqA, akA);
            P9_IDS(t3, iB0, iB1, akM);
            P9_ISSUE(iA0, iA1, vqA);
            P9_COMPUTE(t1, vqB, akB);
            akA[0] = akN[0]; akA[1] = akN[1]; akB[0] = akM[0]; akB[1] = akM[1];
        }
#undef TK
#undef CL
    }
}

struct Args { const float* in[17]; float* out; unsigned char* ws; int ph_lo, ph_hi, li, pad; };
__global__ void __launch_bounds__(NWAVES * 64, 2) hyb_fwd(Args args) {
    extern __shared__ __attribute__((aligned(16))) unsigned char lds[];
    Frame F;
    F.lds = (LAS unsigned char*)lds;
    F.MISC = (volatile LAS unsigned*)(F.lds + MISC_OFF);
    F.tid = threadIdx.x; F.lane = F.tid & 63; F.wave = __builtin_amdgcn_readfirstlane(F.tid >> 6);
    F.G = gridDim.x; { const int bx = blockIdx.x; F.vcu = (F.G % 8 == 0) ? (bx % 8) * (F.G / 8) + bx / 8 : bx; }
    unsigned char* ws = args.ws;
    F.ctl = (gu32*)(ws + WS_CTL);
    F.x = args.in[0]; F.norm_mix = args.in[1]; F.norm_ffn = args.in[2]; F.w_in = args.in[3]; F.b_gate = args.in[4]; F.w_conv = args.in[5]; F.q_norm = args.in[6]; F.k_norm = args.in[7];
    F.sinks = args.in[8]; F.rel_bias = args.in[9]; F.w_conv_out = args.in[10]; F.w_attn_out = args.in[11]; F.w_out = args.in[12]; F.w_query = args.in[13]; F.sub_keys = args.in[14];
    F.expert_u = args.in[15]; F.expert_v = args.in[16]; F.out = args.out;
    F.WIN = (bf16*)(ws + WS_WIN); F.WC = (bf16*)(ws + WS_WC); F.WA = (bf16*)(ws + WS_WA); F.WO = (bf16*)(ws + WS_WO); F.WQ = (bf16*)(ws + WS_WQ); F.SK = (bf16*)(ws + WS_SK);
    F.UB = (bf16*)(ws + WS_UB); F.VB = (bf16*)(ws + WS_VB); F.XB = (bf16*)(ws + WS_XB); F.PA = (bf16*)(ws + WS_PA); F.MIX = (bf16*)(ws + WS_MIX); F.G_ = (bf16*)(ws + WS_G); F.QP = (bf16*)(ws + WS_QP);
    F.Z = (bf16*)(ws + WS_Z); F.ATT = (bf16*)(ws + WS_ATT); F.RSTD1 = (float*)(ws + WS_RSTD1); F.SSQ = (float*)(ws + WS_SSQ); F.GATE = (float*)(ws + WS_GATE); F.IDX = (unsigned short*)(ws + WS_IDX); F.PARTB = (bf16*)(ws + WS_PART); F.SU = (float*)(ws + WS_SU); F.SV = (float*)(ws + WS_SV); F.XB8 = (unsigned char*)(ws + WS_XB8); F.ACT = (float*)(ws + WS_ACT);
    for (int u = F.tid; u < (LDS_BYTES - LDSCTL_OFF) / 4; u += NWAVES * 64) ((LAS unsigned*)(F.lds + LDSCTL_OFF))[u] = 0u;
    __syncthreads();
    XcdBarrier bar; bar.bar = (unsigned*)(F.ctl + CW_BAR); bar.x = 0; bar.st = nullptr;
    const int lo = args.ph_lo, hi = args.ph_hi;
    if (hi - lo > 1) bar = xcd_barrier_post((unsigned*)(F.ctl + CW_BAR), F.MISC + 8);
#ifndef PH_MASK
#define PH_MASK 0x3ff
#endif
#define IN(k) (((PH_MASK >> (k)) & 1) && lo <= (k) && (k) < hi)
#define SEAM(k) do { if (IN(k) && IN((k) + 1)) xcd_barrier(bar); } while (0)
#ifndef PROBE_DUP
#define PROBE_DUP 0
#endif
#define REP(k) for (int rep_ = 0; rep_ < (((PROBE_DUP >> (k)) & 1) ? 2 : 1); ++rep_)

    if (IN(0)) { REP(0) p0_prologue(F); SEAM(0); }
    if (IN(1)) {
        pg8::Gemm g{F.XB, F.WIN, nullptr, nullptr, T, IN_DIM, D}; pg8::StaticOrder S; S.init(T, IN_DIM, F.G, (int)blockIdx.x);
        { LAS float* bgl = (LAS float*)(F.lds + RING_BYTES); for (int i = F.tid; i < 2 * D; i += NWAVES * 64) bgl[i] = F.b_gate[i]; __syncthreads(); }
        pg8::EpiProj E{F.PA, F.G_, (const PG8_LAS float*)(F.lds + RING_BYTES)};
        REP(1) pg8::gemm_phase<pg8::EpiProj, pg8::StaticOrder, PG8_ALIGN, PG8_SP2>(F.lds + RING_OFF, g, S, E);
        {
            const int nwg = (T / 256) * (IN_DIM / 256), rem = nwg % F.G, c = (int)blockIdx.x; const int nshort = rem ? F.G - rem : F.G, sidx = rem ? c - rem : c;
            (void)sidx; (void)nshort;
            constexpr int CH = 64, NCH = 2 * NEXP / CH;
            for (;;) {
                if (F.tid == 0) F.MISC[14] = __hip_atomic_fetch_add((unsigned*)(F.ctl + 2048), 1u, __ATOMIC_RELAXED, __HIP_MEMORY_SCOPE_AGENT);
                __syncthreads();
                const int ch = __builtin_amdgcn_readfirstlane((int)F.MISC[14]);
                __syncthreads();
                if (ch >= NCH) break;
                if (ch < NCH / 2) p0_convert_fp4(F, F.expert_u, F.norm_ffn, (unsigned char*)F.UB, F.SU, ch * CH, ch * CH + CH);
                else p0_convert_fp4(F, F.expert_v, nullptr, (unsigned char*)F.VB, F.SV, (ch - NCH / 2) * CH, (ch - NCH / 2) * CH + CH);
            } }
        SEAM(1);
    }
    if (IN(2)) {
        REP(2) { p2_conv(F); p2_attention(F); }
        SEAM(2); }
    if (IN(3)) {
        pg8::Gemm g{F.Z, F.WC, F.ATT, F.WA, T, D, CONV}; pg8::PairOrder S; S.init(T, D, F.G, (int)blockIdx.x);
        pg8::EpiMix E{F.MIX, F.G_};
        REP(3) pg8::gemm_phase<pg8::EpiMix, pg8::PairOrder, PG8_ALIGN, PG8_SP2>(F.lds + RING_OFF, g, S, E);
        SEAM(3);
    }
    if (IN(4)) {
        pg8::Gemm g{F.MIX, F.WO, nullptr, nullptr, T, D, D}; pg8::FragOrder S; S.init(T, D, F.G, (int)blockIdx.x);
        pg8::EpiX1 E{F.RSTD1, F.XB, F.SSQ, F.XB8};
        REP(4) pg8::gemm_phase<pg8::EpiX1, pg8::FragOrder, PG8_ALIGN, PG8_SP2>(F.lds + RING_OFF, g, S, E);
        SEAM(4);
    }
    if (IN(5)) {
        pg8::Gemm g{F.XB, F.WQ, nullptr, nullptr, T, PQ, D}; pg8::StaticOrder S; S.init(T, PQ, F.G, (int)blockIdx.x);
        pg8::EpiQP E{F.QP};
        REP(5) pg8::gemm_phase<pg8::EpiQP, pg8::StaticOrder, PG8_ALIGN, PG8_SP2>(F.lds + RING_OFF, g, S, E);
    }
    if (IN(6)) { REP(6) p6_topk(F); SEAM(6); }
    if (IN(7)) { xcc_info_build(bar); const XccInfo I = xcc_info(bar); REP(7) p7_udot(F, I); SEAM(7); }
    if (IN(8)) { REP(8) p8_act(F); SEAM(8); }
    if (IN(9)) { const XccInfo I = xcc_info(bar); p9_vacc(F, I); }
#undef IN
#undef SEAM
}

extern "C" void kernel_launch(void* const* d_in, const int* in_sizes, int n_in, void* d_out, int out_size, void* d_ws, size_t ws_size, hipStream_t stream) {
    static int grid = 0;
    if (grid == 0) {
        if (n_in != 17 || in_sizes[0] != T * D || out_size != T * D || ws_size < WS_END) { fprintf(stderr, "kernel_launch: unexpected shapes (n_in %d, in0 %d, out %d, ws %zu)\n", n_in, n_in > 0 ? in_sizes[0] : -1, out_size, ws_size); grid = -1; return; }
        int dev = 0, cus = 0, per_cu = 0;
        if (hipGetDevice(&dev) != hipSuccess || hipDeviceGetAttribute(&cus, hipDeviceAttributeMultiprocessorCount, dev) != hipSuccess) { grid = -1; return; }
        if (hipFuncSetAttribute((const void*)hyb_fwd, hipFuncAttributeMaxDynamicSharedMemorySize, LDS_BYTES) != hipSuccess) { fprintf(stderr, "kernel_launch: hipFuncSetAttribute failed\n"); grid = -1; return; }
        if (hipOccupancyMaxActiveBlocksPerMultiprocessor(&per_cu, (const void*)hyb_fwd, NWAVES * 64, LDS_BYTES) != hipSuccess || per_cu < 1) { fprintf(stderr, "kernel_launch: occupancy query says %d blocks per CU\n", per_cu); (void)hipGetLastError(); grid = -1; return; }
        grid = cus * 1;
    }
    if (grid < 0) return;
    if (hipMemsetAsync((char*)d_ws + WS_CTL, 0, CTL_ZERO_BYTES, stream) != hipSuccess) { fprintf(stderr, "kernel_launch: memset failed\n"); return; }
    Args a{};
    for (int i = 0; i < 17; ++i) a.in[i] = (const float*)d_in[i];
    a.out = (float*)d_out; a.ws = (unsigned char*)d_ws;
#if MK_ONE_LAUNCH
    a.ph_lo = 0; a.ph_hi = N_PHASES; a.li = 0;
    void* kargs[] = {&a};
    const hipError_t le = hipLaunchCooperativeKernel((const void*)hyb_fwd, dim3(grid), dim3(NWAVES * 64), kargs, LDS_BYTES, stream);
    if (le != hipSuccess) fprintf(stderr, "kernel_launch: cooperative launch failed: %s (grid %d)\n", hipGetErrorName(le), grid);
#else
    for (int li = 0; li < N_PHASES; ++li) {
        a.ph_lo = li; a.ph_hi = li + 1; a.li = li;
        hipLaunchKernelGGL(hyb_fwd, dim3(grid), dim3(NWAVES * 64), LDS_BYTES, stream, a);
        const hipError_t le = hipPeekAtLastError();
        if (le != hipSuccess) { fprintf(stderr, "kernel_launch: launch %d failed: %s\n", li, hipGetErrorName(le)); break; }
    }
#endif
}
```

```cpp
#include <hip/hip_runtime.h>
#include <hip/hip_cooperative_groups.h>
#include <cstdio>
#include <cstdint>
namespace pg8 {
#define PG8_LAS __attribute__((address_space(3)))
typedef unsigned short bf16_t;
typedef short bf16x8 __attribute__((ext_vector_type(8)));
typedef float f32x4 __attribute__((ext_vector_type(4)));
typedef unsigned u32x4 __attribute__((ext_vector_type(4)));
typedef unsigned u32x2 __attribute__((ext_vector_type(2)));
constexpr int BM = 256, BK = 64, HALF = 128, HTB = HALF * BK * 2  , STAGE_BYTES = 8 * HTB, NXCD = 8, WGM = 8;

__host__ __device__ __forceinline__ int lds_byte(int r, int c) { const int st = (r >> 4) * 2 + (c >> 5), rr = r & 15, cc = c & 31, ob = rr * 64 + cc * 2; return st * 1024 + (ob ^ (((ob >> 9) & 1) << 5)); }
__host__ __device__ __forceinline__ void stage_rc(int b, int& R, int& C) { const int st = b / 1024, sb = b % 1024, swz = sb ^ (((sb >> 9) & 1) << 5); R = (st >> 1) * 16 + swz / 64; C = (st & 1) * 32 + (swz % 64) / 2; }
__host__ __device__ __forceinline__ int perm32(int rho) { const int n = rho >> 4, i = rho & 15; return 8 * (i >> 2) + 4 * n + (i & 3); }

struct Unit { int pm, pn, which; };
struct Gemm { const bf16_t* A; const bf16_t* Bt; const bf16_t* A2; const bf16_t* Bt2; int M, N, K; };

struct StaticOrder {
    static constexpr bool AFRAG = false;
    int nM, nN, nwg, G, c;
    __host__ __device__ void init(int M, int N, int G_, int c_) { nM = M / BM; nN = N / BM; nwg = nM * nN; G = G_; c = c_; }
    __host__ __device__ bool next(int i, Unit& u) const {
        const long L = (long)i * G + c; if (L >= nwg) return false;
        int wgid = (int)L; { const int q = nwg / NXCD, r = nwg % NXCD, xcd = wgid % NXCD, off = wgid / NXCD; wgid = (xcd < r ? xcd * (q + 1) : r * (q + 1) + (xcd - r) * q) + off; }
        const int nig = WGM * nN, gid = wgid / nig, fm = gid * WGM, gsz = (nM - fm) < WGM ? (nM - fm) : WGM;
        u.pm = fm + ((wgid % nig) % gsz); u.pn = (wgid % nig) / gsz; u.which = 0; return true;
    }
    __device__ __forceinline__ const char* a_base(const Gemm& g, const Unit& u, size_t tstep) const { return (const char*)g.A + (size_t)u.pm * tstep; }
    __device__ __forceinline__ const char* b_base(const Gemm& g, const Unit& u, size_t tstep) const { return (const char*)g.Bt + (size_t)u.pn * tstep; }
    __device__ __forceinline__ void a_ready(const Unit&) const {}
    __device__ __forceinline__ void done(const Unit&) const {}
};

__device__ __forceinline__ unsigned cvt_pk_bf16(float lo, float hi) { unsigned r; asm volatile("v_cvt_pk_bf16_f32 %0, %1, %2" : "=v"(r) : "v"(lo), "v"(hi)); return r; }
__device__ __forceinline__ void store16_wt(void* p, u32x4 v) { asm volatile("global_store_dwordx4 %0, %1, off sc1\n\ts_nop 1" :: "v"(p), "v"(v) : "memory"); }
__device__ __forceinline__ void store8_wt(void* p, u32x2 v) { asm volatile("global_store_dwordx2 %0, %1, off sc1\n\ts_nop 1" :: "v"(p), "v"(v) : "memory"); }
typedef float f32x2 __attribute__((ext_vector_type(2)));
__device__ __forceinline__ f32x2 gelu_pk(f32x2 v) {
    const f32x2 av = __builtin_elementwise_abs(v), d = av * 0.2316418882f + 1.0f;
    f32x2 t; t.x = __builtin_amdgcn_rcpf(d.x); t.y = __builtin_amdgcn_rcpf(d.y);
    f32x2 q = t * 0.5307027145f + (-0.7265760135f); q = q * t + 0.7107068705f; q = q * t + (-0.142248368f); q = q * t + 0.127414796f; q = q * t;
    const f32x2 s = (v * v) * (-0.72134752044f);
    f32x2 e; e.x = __builtin_amdgcn_exp2f(s.x); e.y = __builtin_amdgcn_exp2f(s.y);
    const f32x2 m = v * (q * e), r = v - m;
    f32x2 o; o.x = v.x < 0.f ? m.x : r.x; o.y = v.y < 0.f ? m.y : r.y; return o;
}

template <class Epi, class Sched, bool ALIGN_EPI = false, bool SP2 = false, bool FP8 = false>
__device__ __forceinline__ void gemm_phase(PG8_LAS unsigned char* lds, const Gemm g, const Sched& S, const Epi& E) {
    const int tid = threadIdx.x, wid = __builtin_amdgcn_readfirstlane(tid >> 6), lane = tid & 63, wr = wid >> 2, wc = wid & 3, fr = lane & 15, fq = lane >> 4;
    const int K = g.K, nt = K / BK;
    unsigned voffA[2], voffB[2];
#pragma unroll
    for (int i = 0; i < 2; ++i) { int R, C; stage_rc(tid * 16 + i * 8192, R, C); const int Rb = Epi::PERM ? ((R & ~31) + perm32(R & 31)) : R;
        voffA[i] = Sched::AFRAG ? (unsigned)((((((R >> 6) * 4 + (C >> 5)) * 16 + ((R >> 4) & 3) * 2) * 64) + ((C & 31) >> 3) * 16 + (R & 15)) * 16) : (unsigned)(R * K + C) * 2u;
        voffB[i] = (unsigned)(Rb * K + C) * 2u; }
#define PG8_AP(base, h, kt) (Sched::AFRAG ? (base) + ((((size_t)((kt) >> 2) * 8 + ((kt) & 1) * 2) * 16 + (h) * 8 + (((kt) >> 1) & 1)) * 64) * 16 : (base) + (size_t)(h) * hstep + (size_t)(kt) * kstep)
    const size_t kstep = (size_t)(BK * 2);
    const size_t hstep = (size_t)HALF * K * 2;
    const size_t tstep = 2 * hstep;
    const unsigned ldsw = (unsigned)wid * 1024u;
    const int aoff = lds_byte(wr * 64 + fr, fq * 8), boff = lds_byte(wc * 32 + fr, fq * 8);
#define PG8_SA(b, h) (((b) * 2 + (h)) * HTB)
#define PG8_SB(b, h) ((4 + (b) * 2 + (h)) * HTB)
#define PG8_STAGE(bufoff, gbase, voff) do { _Pragma("unroll") for (int _i = 0; _i < 2; ++_i) \
        __builtin_amdgcn_global_load_lds((const unsigned*)((const char*)(gbase) + (voff)[_i]), (PG8_LAS unsigned*)(lds + (bufoff) + ldsw + _i * 8192), 16, 0, 0); } while (0)
#define PG8_LDA(dst, b, h) do { _Pragma("unroll") for (int m = 0; m < 4; ++m) dst[m] = __builtin_shufflevector(*(const PG8_LAS bf16x8*)(lds + PG8_SA(b, h) + aoff + m * 2048), *(const PG8_LAS bf16x8*)(lds + PG8_SA(b, h) + aoff + m * 2048 + 1024), 0, 1, 2, 3, 4, 5, 6, 7, 8, 9, 10, 11, 12, 13, 14, 15); } while (0)
#define PG8_LDB(dst, b, h) do { _Pragma("unroll") for (int n = 0; n < 2; ++n) dst[n] = __builtin_shufflevector(*(const PG8_LAS bf16x8*)(lds + PG8_SB(b, h) + boff + n * 2048), *(const PG8_LAS bf16x8*)(lds + PG8_SB(b, h) + boff + n * 2048 + 1024), 0, 1, 2, 3, 4, 5, 6, 7, 8, 9, 10, 11, 12, 13, 14, 15); } while (0)
#define PG8_MMA(ai, bj, At, Bt) do { __builtin_amdgcn_s_setprio(1); _Pragma("unroll") for (int m = 0; m < 4; ++m) _Pragma("unroll") for (int n = 0; n < 2; ++n) { \
        if constexpr (FP8) { typedef int v8i_ __attribute__((ext_vector_type(8)));   \
            asm volatile("v_mfma_scale_f32_16x16x128_f8f6f4 %0, %1, %2, %0, %3, %3 op_sel_hi:[0,0,0]" : "+v"(acc[ai][bj][m][n]) : "v"(__builtin_bit_cast(v8i_, Bt[n])), "v"(__builtin_bit_cast(v8i_, At[m])), "v"(mx_one)); \
        } else { \
            acc[ai][bj][m][n] = __builtin_amdgcn_mfma_f32_16x16x32_bf16(__builtin_shufflevector(Bt[n], Bt[n], 0, 1, 2, 3, 4, 5, 6, 7), __builtin_shufflevector(At[m], At[m], 0, 1, 2, 3, 4, 5, 6, 7), acc[ai][bj][m][n], 0, 0, 0); \
            acc[ai][bj][m][n] = __builtin_amdgcn_mfma_f32_16x16x32_bf16(__builtin_shufflevector(Bt[n], Bt[n], 8, 9, 10, 11, 12, 13, 14, 15), __builtin_shufflevector(At[m], At[m], 8, 9, 10, 11, 12, 13, 14, 15), acc[ai][bj][m][n], 0, 0, 0); } } \
        __builtin_amdgcn_s_setprio(0); } while (0)
#define PG8_WAIT_V(n) asm volatile("s_waitcnt vmcnt(" #n ")" ::: "memory")
#define PG8_WAIT_L(n) asm volatile("s_waitcnt lgkmcnt(" #n ")" ::: "memory")
#define PG8_BAR __builtin_amdgcn_s_barrier()
#define PG8_SCHED __builtin_amdgcn_sched_barrier(0)
    Unit cur, nxt; int ui = 0;
    if (!S.next(0, cur)) return;
    f32x4 acc[2][2][4][2];
#pragma unroll
    for (int a = 0; a < 2; ++a)
#pragma unroll
        for (int b = 0; b < 2; ++b)
#pragma unroll
            for (int m = 0; m < 4; ++m)
#pragma unroll
                for (int n = 0; n < 2; ++n) acc[a][b][m][n] = (f32x4){0.f, 0.f, 0.f, 0.f};
    if constexpr (Epi::HAS_INIT) E.init(acc, cur, wr, wc, fr, fq);
    const int mx_one = 0x7f7f7f7f;
    typedef short bf16x16 __attribute__((ext_vector_type(16)));
    bf16x16 At[4], B0[2], B1[2];
    const char* cA = S.a_base(g, cur, tstep); const char* cB = S.b_base(g, cur, tstep);
    S.a_ready(cur);
    if constexpr (SP2) {
        PG8_STAGE(PG8_SB(0, 0), cB, voffB); PG8_STAGE(PG8_SB(0, 1), cB + hstep, voffB); PG8_STAGE(PG8_SA(0, 0), PG8_AP(cA, 0, 0), voffA); PG8_STAGE(PG8_SA(0, 1), PG8_AP(cA, 1, 0), voffA);
        if (wr == 1) PG8_BAR;
        PG8_WAIT_V(2); PG8_BAR;
        PG8_STAGE(PG8_SB(1, 0), cB + kstep, voffB); PG8_STAGE(PG8_SA(1, 0), PG8_AP(cA, 0, 1), voffA); PG8_STAGE(PG8_SB(1, 1), cB + hstep + kstep, voffB);
        PG8_WAIT_V(6); PG8_BAR;
    } else {
        PG8_STAGE(PG8_SB(0, 0), cB, voffB); PG8_STAGE(PG8_SA(0, 0), PG8_AP(cA, 0, 0), voffA); PG8_STAGE(PG8_SB(0, 1), cB + hstep, voffB); PG8_STAGE(PG8_SA(0, 1), PG8_AP(cA, 1, 0), voffA);
        if (wr == 1) PG8_BAR;
        PG8_WAIT_V(4); PG8_BAR;
        PG8_STAGE(PG8_SB(1, 0), cB + kstep, voffB); PG8_STAGE(PG8_SA(1, 0), PG8_AP(cA, 0, 1), voffA); PG8_STAGE(PG8_SB(1, 1), cB + hstep + kstep, voffB);
        PG8_WAIT_V(6); PG8_BAR;
    }
    for (;;) {
        const bool has_next = S.next(ui + 1, nxt);
        const char* nA = has_next ? S.a_base(g, nxt, tstep) : cA; const char* nB = has_next ? S.b_base(g, nxt, tstep) : cB;
        for (int t = 0; t < nt; t += 2) {
            const bool last = (t == nt - 2);
            const char* a2b = last ? nA : cA; const int a2k = last ? 0 : t + 2; const char* b2 = last ? nB : cB + (size_t)(t + 2) * kstep;
            const char* b3 = b2 + kstep;
            const char* a1h = PG8_AP(cA, 1, t + 1); const char* a2 = PG8_AP(a2b, 0, a2k); const char* a2h = PG8_AP(a2b, 1, a2k); const char* a3 = PG8_AP(a2b, 0, a2k + 1);
            if (last && has_next) S.a_ready(nxt);
            if constexpr (SP2) {
            PG8_LDB(B0, 0, 0); PG8_LDB(B1, 0, 1); PG8_SCHED; PG8_LDA(At, 0, 0); PG8_STAGE(PG8_SA(1, 1), a1h, voffA);
            PG8_WAIT_V(8); PG8_WAIT_L(0); PG8_BAR; PG8_MMA(0, 0, At, B0); PG8_MMA(0, 1, At, B1); PG8_BAR; PG8_SCHED;
            PG8_LDA(At, 0, 1); PG8_STAGE(PG8_SB(0, 0), b2, voffB); PG8_STAGE(PG8_SB(0, 1), b2 + hstep, voffB); PG8_STAGE(PG8_SA(0, 0), a2, voffA);
            PG8_WAIT_V(8); PG8_WAIT_L(0); PG8_BAR; PG8_MMA(1, 0, At, B0); PG8_MMA(1, 1, At, B1); PG8_BAR; PG8_SCHED;
            PG8_LDB(B0, 1, 0); PG8_LDB(B1, 1, 1); PG8_SCHED; PG8_LDA(At, 1, 0); PG8_STAGE(PG8_SA(0, 1), a2h, voffA);
            PG8_WAIT_V(8); PG8_WAIT_L(0); PG8_BAR; PG8_MMA(0, 0, At, B0); PG8_MMA(0, 1, At, B1); PG8_BAR; PG8_SCHED;
            PG8_LDA(At, 1, 1); PG8_STAGE(PG8_SB(1, 0), b3, voffB); PG8_STAGE(PG8_SB(1, 1), b3 + hstep, voffB); PG8_STAGE(PG8_SA(1, 0), a3, voffA);
            PG8_WAIT_V(8); PG8_WAIT_L(0); PG8_BAR; PG8_MMA(1, 0, At, B0); PG8_MMA(1, 1, At, B1); PG8_BAR; PG8_SCHED;
            } else {
            PG8_LDB(B0, 0, 0); PG8_SCHED; PG8_LDA(At, 0, 0); PG8_STAGE(PG8_SA(1, 1), a1h, voffA);
            PG8_WAIT_L(8); PG8_BAR; PG8_WAIT_L(0); PG8_MMA(0, 0, At, B0); PG8_BAR; PG8_SCHED;
            PG8_LDB(B1, 0, 1); PG8_STAGE(PG8_SB(0, 0), b2, voffB);
            PG8_BAR; PG8_WAIT_L(0); PG8_MMA(0, 1, At, B1); PG8_BAR;
            PG8_LDA(At, 0, 1); PG8_STAGE(PG8_SA(0, 0), a2, voffA);
            PG8_BAR; PG8_WAIT_L(0); PG8_MMA(1, 0, At, B0); PG8_BAR; PG8_SCHED;
            PG8_STAGE(PG8_SB(0, 1), b2 + hstep, voffB);
            PG8_WAIT_V(6); PG8_BAR; PG8_MMA(1, 1, At, B1); PG8_BAR;
            PG8_LDB(B0, 1, 0); PG8_SCHED; PG8_LDA(At, 1, 0); PG8_STAGE(PG8_SA(0, 1), a2h, voffA);
            PG8_WAIT_L(8); PG8_BAR; PG8_WAIT_L(0); PG8_MMA(0, 0, At, B0); PG8_BAR; PG8_SCHED;
            PG8_LDB(B1, 1, 1); PG8_STAGE(PG8_SB(1, 0), b3, voffB);
            PG8_BAR; PG8_WAIT_L(0); PG8_MMA(0, 1, At, B1); PG8_BAR;
            PG8_LDA(At, 1, 1); PG8_STAGE(PG8_SA(1, 0), a3, voffA);
            PG8_BAR; PG8_WAIT_L(0); PG8_MMA(1, 0, At, B0); PG8_BAR; PG8_SCHED;
            PG8_STAGE(PG8_SB(1, 1), b3 + hstep, voffB);
            PG8_WAIT_V(6); PG8_BAR; PG8_MMA(1, 1, At, B1); PG8_BAR;
            }
        }
        if constexpr (ALIGN_EPI) { if (wr == 0) PG8_BAR; }
        if constexpr (!Epi::AFTER_DRAIN) { E(acc, cur, wr, wc, fr, fq); S.done(cur); }
        if (!has_next) break;
        if (!(Epi::CARRY && cur.which == 0)) {
#pragma unroll
        for (int a = 0; a < 2; ++a)
#pragma unroll
            for (int b = 0; b < 2; ++b)
#pragma unroll
                for (int m = 0; m < 4; ++m)
#pragma unroll
                    for (int n = 0; n < 2; ++n) acc[a][b][m][n] = (f32x4){0.f, 0.f, 0.f, 0.f};
        }
        if constexpr (Epi::HAS_INIT) E.init(acc, nxt, wr, wc, fr, fq);
        cur = nxt; cA = nA; cB = nB; ++ui;
        if constexpr (ALIGN_EPI) { if (wr == 1) PG8_BAR; }
    }
    PG8_WAIT_V(0);
    if constexpr (!ALIGN_EPI) { if (wr == 0) PG8_BAR; }
    PG8_BAR;
    if constexpr (Epi::AFTER_DRAIN) { E.fused(acc, cur, wr, wc, fr, fq, lds, wid, lane); S.done(cur); }
#undef PG8_AP
#undef PG8_SA
#undef PG8_SB
#undef PG8_STAGE
#undef PG8_LDA
#undef PG8_LDB
#undef PG8_MMA
#undef PG8_WAIT_V
#undef PG8_WAIT_L
#undef PG8_BAR
#undef PG8_SCHED
}
}

#ifndef PG8_SP2
#define PG8_SP2 true
#endif
#ifndef PG8_ALIGN
#define PG8_ALIGN true
#endif
#ifndef MK_ONE_LAUNCH
#define MK_ONE_LAUNCH 1
#endif

constexpr int NWAVES = 8;
constexpr int T = 32768, D = 1024, SEQ = 4096;
constexpr int IN_DIM = 4352, PA_W = 2304, G_W = 2048;
constexpr int C_U = 0, C_B = 512, C_C = 1024, C_Q = 1536, C_K = 2048, C_V = 2176;
constexpr int CONV = 512, HD = 64, NH = 8, NKV = 2;
constexpr int PH = 8, NKEYS = 128, PQ = 2048, TOPK = 16, NEXP = 16384, NSEL = 128;
constexpr float EPS = 1e-6f;
constexpr int N_PHASES = 10;

constexpr size_t MiB = 1u << 20;
constexpr size_t WS_CTL = 0, CTL_ZERO_BYTES = 1 * MiB;
constexpr size_t WS_WIN = 2 * MiB;
constexpr size_t WS_WG8 = WS_WIN + 4608 * 1024;
constexpr size_t WS_WC = 11 * MiB;
constexpr size_t WS_WA = 12 * MiB;
constexpr size_t WS_WO = 13 * MiB;
constexpr size_t WS_WQ = 15 * MiB;
constexpr size_t WS_SK = 19 * MiB;
constexpr size_t WS_RSTD1 = 20 * MiB;
constexpr size_t WS_SSQ = 21 * MiB;
constexpr size_t WS_UB = 24 * MiB;
constexpr size_t WS_SU = 32 * MiB;
constexpr size_t WS_VB = 40 * MiB;
constexpr size_t WS_SV = 48 * MiB;
constexpr size_t WS_XB8 = 56 * MiB;
constexpr size_t WS_XB = 88 * MiB;
constexpr size_t WS_PA = 152 * MiB;
constexpr size_t WS_MIX = WS_PA;
constexpr size_t WS_G = 296 * MiB;
constexpr size_t WS_QP = WS_G;
constexpr size_t WS_Z = 424 * MiB;
constexpr size_t WS_ATT = 456 * MiB;
constexpr size_t WS_IDX = WS_Z, WS_GATE = WS_ATT;
constexpr size_t WS_PART = WS_PA;
constexpr size_t WS_ACT = WS_G;
constexpr size_t WS_END = 488 * MiB;
constexpr int CW_BAR = 4096;

constexpr int RING_OFF = 0, RING_BYTES = 131072;
constexpr int LDSCTL_OFF = 147456, MISC_OFF = LDSCTL_OFF + 320;
constexpr int LDS_BYTES = 148480;
#define GAS __attribute__((address_space(1)))
#define LAS __attribute__((address_space(3)))
typedef unsigned short bf16;
typedef unsigned v4u __attribute__((ext_vector_type(4)));
typedef float f32x4 __attribute__((ext_vector_type(4)));
typedef short bf16x8 __attribute__((ext_vector_type(8)));
typedef GAS unsigned gu32;
typedef GAS unsigned long long gu64;
#define RLX_AGENT __ATOMIC_RELAXED, __HIP_MEMORY_SCOPE_AGENT
#define LDS_WAIT() asm volatile("s_waitcnt lgkmcnt(0)" ::: "memory")
#define VM_WAIT() asm volatile("s_waitcnt vmcnt(0)" ::: "memory")
__device__ __forceinline__ unsigned long long rt() { return __builtin_amdgcn_s_memrealtime(); }
__device__ __forceinline__ unsigned f2bf(float f) { unsigned u = __builtin_bit_cast(unsigned, f); return (u + 0x7fffu + ((u >> 16) & 1u)) >> 16; }
__device__ __forceinline__ unsigned pk2(float lo, float hi) { return f2bf(lo) | (f2bf(hi) << 16); }

#define XB_TMO      128
#define XB_XCNT(j)  (256  + 64 * (j))
#define XB_XSUB(j)  (1280 + 64 * (j))
#define XB_XGEN(j)  (2304 + 64 * (j))
#define XB_TOP      3328
#define XB_TOPGEN   3392
#define XCD_BAR_WORDS 3456
#define XB_SPIN_CAP (1u << 18)

__device__ __forceinline__ unsigned xb_ld(unsigned* p)              { return __hip_atomic_load(p, __ATOMIC_RELAXED, __HIP_MEMORY_SCOPE_AGENT); }
__device__ __forceinline__ unsigned xb_add(unsigned* p, unsigned v) { return __hip_atomic_fetch_add(p, v, __ATOMIC_RELAXED, __HIP_MEMORY_SCOPE_AGENT); }
__device__ __forceinline__ unsigned xb_xcc_id() { return (unsigned)__builtin_amdgcn_s_getreg((3 << 11) | 20) & 0xFu; }
#define XB_SPIN(cond, bar) do { unsigned _sp = 0; while (cond) { __builtin_amdgcn_s_sleep(1); \
    if ((++_sp & 255u) == 0u) { if (xb_ld(&(bar)[XB_TMO])) break; if (_sp > XB_SPIN_CAP) { atomicAdd(&(bar)[XB_TMO], 1u); break; } } } } while (0)

struct XcdBarrier {
    unsigned* bar; unsigned x;
    volatile LAS unsigned* st;
};

__device__ __forceinline__ XcdBarrier xcd_barrier_post(unsigned* bar, volatile LAS unsigned* st) {
    XcdBarrier b; b.bar = bar; b.x = xb_xcc_id(); b.st = st;
    if (threadIdx.x == 0) st[2] = xb_add(&bar[XB_XCNT(b.x)], 1u);
    return b;
}
__device__ __forceinline__ void xcd_barrier_complete(unsigned* bar, unsigned x, unsigned& nloc, unsigned& nx) {
    const unsigned G = gridDim.x * gridDim.y * gridDim.z;
    unsigned sum, cnt, mine, sp = 0u;
    for (;;) {
        sum = 0u; cnt = 0u; mine = 0u;
#pragma unroll
        for (unsigned j = 0; j < 16; ++j) { const unsigned c = xb_ld(&bar[XB_XCNT(j)]); sum += c; cnt += (c > 0u) ? 1u : 0u; mine = (j == x) ? c : mine; }
        if (sum == G) break;
        __builtin_amdgcn_s_sleep(1);
        if ((++sp & 255u) == 0u) { if (xb_ld(&bar[XB_TMO])) break; if (sp > XB_SPIN_CAP) { atomicAdd(&bar[XB_TMO], 1u); break; } }
    }
    nloc = mine > 0u ? mine : 1u; nx = cnt > 0u ? cnt : 1u;
}

__device__ __forceinline__ void xcd_barrier(const XcdBarrier& b) {
    asm volatile("s_waitcnt vmcnt(0)" ::: "memory");
    __syncthreads();
    if (threadIdx.x == 0) {
        unsigned* bar = b.bar;
        __builtin_amdgcn_s_waitcnt(0);
        unsigned nloc = b.st[0], nx = b.st[1];
        if (nloc == 0u) { xcd_barrier_complete(bar, b.x, nloc, nx); b.st[0] = nloc; b.st[1] = nx; }
        const unsigned old = xb_add(&bar[XB_XSUB(b.x)], 1u);
        const unsigned gen = old / nloc;
        if (old + 1u == (gen + 1u) * nloc) {
            __builtin_amdgcn_fence(__ATOMIC_RELEASE, "agent");
            asm volatile("s_waitcnt vmcnt(0)" ::: "memory");
            const unsigned og = xb_add(&bar[XB_TOP], 1u);
            const unsigned tg = og / nx;
            if (og + 1u == (tg + 1u) * nx) xb_add(&bar[XB_TOPGEN], 1u);
            else XB_SPIN(xb_ld(&bar[XB_TOPGEN]) == tg, bar);
            __builtin_amdgcn_fence(__ATOMIC_ACQUIRE, "agent");
            xb_add(&bar[XB_XGEN(b.x)], 1u);
            asm volatile("s_waitcnt vmcnt(0)" ::: "memory");
        } else {
            XB_SPIN(xb_ld(&bar[XB_XGEN(b.x)]) == gen, bar);
            __builtin_amdgcn_fence(__ATOMIC_ACQUIRE, "agent");
            asm volatile("s_waitcnt vmcnt(0)" ::: "memory");
        }
    }
    __syncthreads();
}

typedef float f32x16 __attribute__((ext_vector_type(16)));
typedef unsigned v2u __attribute__((ext_vector_type(2)));
typedef int v4i __attribute__((ext_vector_type(4)));
typedef __bf16 bf2_t __attribute__((ext_vector_type(2)));
#define DI __device__ __forceinline__
struct Frame {
    LAS unsigned char* lds;
    volatile LAS unsigned* MISC;
    gu32* ctl;
    int tid, lane, wave, vcu, G;
    const float *x, *norm_mix, *norm_ffn, *w_in, *b_gate, *w_conv, *q_norm, *k_norm, *sinks, *rel_bias, *w_conv_out, *w_attn_out, *w_out, *w_query, *sub_keys, *expert_u, *expert_v;
    float* out;
    unsigned char* WG8; bf16 *WIN, *WC, *WA, *WO, *WQ, *SK, *UB, *VB, *XB, *PA, *MIX, *G_, *QP, *Z, *ATT;
    float *RSTD1, *SSQ, *GATE, *ACT, *SU, *SV; bf16* PARTB; unsigned char* XB8; unsigned short* IDX;
};
DI float wave_sum(float v) {
#pragma unroll
    for (int o = 1; o < 64; o <<= 1) v += __shfl_xor(v, o);
    return v;
}
DI float bf_lo(unsigned u) { return __builtin_bit_cast(float, u << 16); }
DI float bf_hi(unsigned u) { return __builtin_bit_cast(float, u & 0xffff0000u); }

constexpr float WG_SCALE = 32.f;
DI void p0_transpose_item(const float* W, int K, int N, bf16* WT, const float* gsc, LAS float* scr, int item, int lane, int n8 = 1 << 30, unsigned char* W8 = nullptr) {
    const int nblk = N / 32, kb = item / nblk, nb = item % nblk, k0 = 64 * kb, n0 = 32 * nb;
#pragma unroll 8
    for (int i = 0; i < 32; ++i) { const int kk = 2 * i + (lane >> 5); float v = W[(size_t)(k0 + kk) * N + n0 + (lane & 31)]; if (gsc) v *= gsc[k0 + kk]; scr[kk * 33 + (lane & 31)] = v; }
    LDS_WAIT(); asm volatile("" ::: "memory");
    const int c = lane & 7;
#pragma unroll
    for (int j = 0; j < 4; ++j) { const int n = (lane >> 3) + 8 * j; const LAS float* s = scr + (8 * c) * 33 + n;
        if (n0 >= n8) {
            int p0_ = 0, p1_ = 0;
            p0_ = __builtin_amdgcn_cvt_pk_fp8_f32(s[0 * 33] * WG_SCALE, s[1 * 33] * WG_SCALE, p0_, false); p0_ = __builtin_amdgcn_cvt_pk_fp8_f32(s[2 * 33] * WG_SCALE, s[3 * 33] * WG_SCALE, p0_, true);
            p1_ = __builtin_amdgcn_cvt_pk_fp8_f32(s[4 * 33] * WG_SCALE, s[5 * 33] * WG_SCALE, p1_, false); p1_ = __builtin_amdgcn_cvt_pk_fp8_f32(s[6 * 33] * WG_SCALE, s[7 * 33] * WG_SCALE, p1_, true);
            v2u o8; o8.x = (unsigned)p0_; o8.y = (unsigned)p1_; *(GAS v2u*)(W8 + (size_t)(n0 + n - n8) * K + k0 + 8 * c) = o8; continue; }
        v4u o; o.x = pk2(s[0 * 33], s[1 * 33]); o.y = pk2(s[2 * 33], s[3 * 33]); o.z = pk2(s[4 * 33], s[5 * 33]); o.w = pk2(s[6 * 33], s[7 * 33]);
        *(GAS v4u*)(WT + (size_t)(n0 + n) * K + k0 + 8 * c) = o; }
    LDS_WAIT(); asm volatile("" ::: "memory");
}
DI void p0_convert(Frame& F, const float* src, bf16* dst, size_t n, const float* colscale) {
    const size_t n8 = n / 8, stride = (size_t)F.G * NWAVES * 64;
    for (size_t i = (size_t)F.vcu * NWAVES * 64 + F.tid; i < n8; i += stride) {
        f32x4 a = *(const GAS f32x4*)(src + i * 8), b = *(const GAS f32x4*)(src + i * 8 + 4);
        if (colscale) { const int c = (int)((i * 8) & 1023); const f32x4 s0 = *(const GAS f32x4*)(colscale + c), s1 = *(const GAS f32x4*)(colscale + c + 4); a = a * s0; b = b * s1; }
        v4u o; o.x = pk2(a.x, a.y); o.y = pk2(a.z, a.w); o.z = pk2(b.x, b.y); o.w = pk2(b.z, b.w);
        *(GAS v4u*)(dst + i * 8) = o;
    }
}
constexpr float A_SCALE = 128.f;
DI unsigned pk4_fp8(f32x4 v) { int r = 0; r = __builtin_amdgcn_cvt_pk_fp8_f32(v[0], v[1], r, false); r = __builtin_amdgcn_cvt_pk_fp8_f32(v[2], v[3], r, true); return (unsigned)r; }
DI void p0_convert_fp8(Frame& F, const float* src, unsigned char* dst, size_t n, const float* colscale, float scale, int bidx, int nblk) {
    const int gw = bidx * NWAVES + F.wave, NGW = nblk * NWAVES, lane = F.lane;
    f32x4 cs[4];
#pragma unroll
    for (int q = 0; q < 4; ++q) cs[q] = colscale ? *(const GAS f32x4*)(colscale + 4 * lane + 256 * q) * scale : (f32x4){scale, scale, scale, scale};
    const int nrows = (int)(n / D);
    for (int e = gw; e < nrows; e += NGW) {
        const GAS f32x4* rp = (const GAS f32x4*)(src + (size_t)e * D) + lane;
        f32x4 v[4];
#pragma unroll
        for (int q = 0; q < 4; ++q) v[q] = rp[64 * q];
#pragma unroll
        for (int q = 0; q < 4; ++q) *(GAS unsigned*)(dst + ((size_t)(2 * q + (lane >> 5)) * NEXP + e) * 128 + ((4 * lane) & 127)) = pk4_fp8(v[q] * cs[q]);
    }
}
DI void p0_convert_fp4(Frame& F, const float* src, const float* gain, unsigned char* dst, float* scl, int e0, int e1) {
    const int gw = F.wave, NGW = NWAVES, lane = F.lane;
    f32x4 cs[4];
#pragma unroll
    for (int q = 0; q < 4; ++q) cs[q] = gain ? *(const GAS f32x4*)(gain + 4 * lane + 256 * q) : (f32x4){1.f, 1.f, 1.f, 1.f};
    for (int e = e0 + gw; e < e1; e += NGW) {
        const GAS f32x4* rp = (const GAS f32x4*)(src + (size_t)e * D) + lane;
        f32x4 v[4]; float mx = 0.f;
#pragma unroll
        for (int q = 0; q < 4; ++q) { v[q] = rp[64 * q] * cs[q]; mx = fmaxf(mx, fmaxf(fmaxf(fabsf(v[q][0]), fabsf(v[q][1])), fmaxf(fabsf(v[q][2]), fabsf(v[q][3])))); }
#pragma unroll
        for (int o = 1; o < 64; o <<= 1) mx = fmaxf(mx, __shfl_xor(mx, o));
        const float inv = mx > 0.f ? 6.f / mx : 0.f;
        if (lane == 0) scl[e] = mx * (1.f / 6.f);
#pragma unroll
        for (int q = 0; q < 4; ++q) { unsigned r = 0u;
            r = __builtin_amdgcn_cvt_scalef32_pk_fp4_f32(r, v[q][0] * inv, v[q][1] * inv, 1.0f, 0);
            r = __builtin_amdgcn_cvt_scalef32_pk_fp4_f32(r, v[q][2] * inv, v[q][3] * inv, 1.0f, 1);
            *(GAS unsigned short*)(dst + ((size_t)q * NEXP + e) * 128 + 2 * lane) = (unsigned short)r; }
    }
}
template <int RB> DI void p0_rows(Frame& F, const float* xrow, bf16* orow, float* rms_out, unsigned char* o8row) {
    f32x4 v[RB][4]; float s[RB];
#pragma unroll
    for (int r = 0; r < RB; ++r) { const GAS f32x4* xr = (const GAS f32x4*)(xrow + (size_t)r * D) + F.lane;
#pragma unroll
        for (int j = 0; j < 4; ++j) v[r][j] = xr[64 * j]; }
#pragma unroll
    for (int r = 0; r < RB; ++r) { s[r] = 0.f;
#pragma unroll
        for (int j = 0; j < 4; ++j) s[r] += (v[r][j].x * v[r][j].x + v[r][j].y * v[r][j].y) + (v[r][j].z * v[r][j].z + v[r][j].w * v[r][j].w); }
#pragma unroll
    for (int o = 1; o < 64; o <<= 1)
#pragma unroll
        for (int r = 0; r < RB; ++r) s[r] += __shfl_xor(s[r], o);
#pragma unroll
    for (int r = 0; r < RB; ++r) { const float rms = sqrtf(s[r] * (1.f / D) + EPS), rs = 1.f / rms; if (F.lane == 0) rms_out[r] = rms;
        GAS unsigned long long* o8 = (GAS unsigned long long*)(orow + (size_t)r * D) + F.lane;
#pragma unroll
        for (int j = 0; j < 4; ++j) { o8[64 * j] = (unsigned long long)pk2(v[r][j].x * rs, v[r][j].y * rs) | ((unsigned long long)pk2(v[r][j].z * rs, v[r][j].w * rs) << 32);
            *(GAS unsigned*)(o8row + (size_t)r * D + 4 * F.lane + 256 * j) = pk4_fp8(v[r][j] * rs); } }
}
DI void p0_prologue(Frame& F) {
    LAS float* scr = (LAS float*)(F.lds + RING_OFF + F.wave * 16384);
    const int gw = F.vcu * NWAVES + F.wave, NGW = F.G * NWAVES;
    constexpr int I_IN = (D / 64) * (IN_DIM / 32), I_C = (CONV / 64) * (D / 32), I_O = (D / 64) * (D / 32), I_Q = (D / 64) * (PQ / 32);
    constexpr int NITEMS = I_IN + 2 * I_C + I_O + I_Q;
    for (int it = gw; it < NITEMS; it += NGW) {
        int r = it;
        if (r < I_IN) { p0_transpose_item(F.w_in, D, IN_DIM, F.WIN, F.norm_mix, scr, r, F.lane, PA_W, F.WG8); continue; } r -= I_IN;
        if (r < I_C) { p0_transpose_item(F.w_conv_out, CONV, D, F.WC, nullptr, scr, r, F.lane); continue; } r -= I_C;
        if (r < I_C) { p0_transpose_item(F.w_attn_out, CONV, D, F.WA, nullptr, scr, r, F.lane); continue; } r -= I_C;
        if (r < I_O) { p0_transpose_item(F.w_out, D, D, F.WO, nullptr, scr, r, F.lane); continue; } r -= I_O;
        p0_transpose_item(F.w_query, D, PQ, F.WQ, F.norm_ffn, scr, r, F.lane);
    }
    p0_convert(F, F.sub_keys, F.SK, (size_t)PH * 2 * NKEYS * 128, nullptr);
    for (int m = 4 * gw; m < T; m += 4 * NGW) p0_rows<4>(F, F.x + (size_t)m * D, F.XB + (size_t)m * D, F.RSTD1 + m, F.XB8 + (size_t)m * D);
}

namespace pg8 {
DI float sigmoidf_(float v) { return __builtin_amdgcn_rcpf(1.f + __expf(-v)); }
DI size_t frag_off(int pm, int pn, int NT, int wave, int q, int lane) { return (((((size_t)pm * NT + pn) * 8 + wave) * 16 + q) * 64 + lane) * 8; }
struct EpiProj {
    static constexpr bool PERM = true, AFTER_DRAIN = false, HAS_INIT = false, CARRY = false;
    bf16_t* PA; bf16_t* G; const PG8_LAS float* bgl; bool gate; float gsc;
    DI void operator()(const f32x4 (&acc)[2][2][4][2], const Unit& u, int wr, int wc, int fr, int fq) const {
        const int row0 = u.pm * BM + wr * 64 + fr;
        const int col0 = u.pn * BM + wc * 32 + 8 * fq;
        if (!gate) {
#pragma unroll
            for (int ai = 0; ai < 2; ++ai)
#pragma unroll
                for (int m = 0; m < 4; ++m) { bf16_t* rowp = PA + (size_t)(row0 + ai * HALF + m * 16) * PA_W + col0;
#pragma unroll
                    for (int bj = 0; bj < 2; ++bj) { const f32x4 v0 = acc[ai][bj][m][0], v1 = acc[ai][bj][m][1];
                        u32x4 w; w.x = cvt_pk_bf16(v0[0], v0[1]); w.y = cvt_pk_bf16(v0[2], v0[3]); w.z = cvt_pk_bf16(v1[0], v1[1]); w.w = cvt_pk_bf16(v1[2], v1[3]);
                        store16_wt(rowp + bj * HALF, w); } }
        } else {
            f32x4 bv[2][2];
#pragma unroll
            for (int bj = 0; bj < 2; ++bj)
#pragma unroll
                for (int n = 0; n < 2; ++n) bv[bj][n] = *(const PG8_LAS f32x4*)(bgl + col0 + bj * HALF + 4 * n);
#pragma unroll
            for (int ai = 0; ai < 2; ++ai)
#pragma unroll
                for (int m = 0; m < 4; ++m)
#pragma unroll
                    for (int bj = 0; bj < 2; ++bj) { f32x4 v0 = acc[ai][bj][m][0] * gsc + bv[bj][0], v1 = acc[ai][bj][m][1] * gsc + bv[bj][1];
#pragma unroll
                        for (int j = 0; j < 4; ++j) { v0[j] = fmaxf(sigmoidf_(v0[j]) * 255.f, 1.f); v1[j] = fmaxf(sigmoidf_(v1[j]) * 255.f, 1.f); }
                        unsigned g0 = 0u, g1 = 0u;
                        g0 = __builtin_amdgcn_cvt_pk_u8_f32(v0[0], 0, g0); g0 = __builtin_amdgcn_cvt_pk_u8_f32(v0[1], 1, g0); g0 = __builtin_amdgcn_cvt_pk_u8_f32(v0[2], 2, g0); g0 = __builtin_amdgcn_cvt_pk_u8_f32(v0[3], 3, g0);
                        g1 = __builtin_amdgcn_cvt_pk_u8_f32(v1[0], 0, g1); g1 = __builtin_amdgcn_cvt_pk_u8_f32(v1[1], 1, g1); g1 = __builtin_amdgcn_cvt_pk_u8_f32(v1[2], 2, g1); g1 = __builtin_amdgcn_cvt_pk_u8_f32(v1[3], 3, g1);
                        u32x2 gw; gw.x = g0; gw.y = g1;
                        *(u32x2*)((unsigned char*)G + frag_off(u.pm, u.pn, 8, wr * 4 + wc, ai * 8 + m * 2 + bj, fq * 16 + fr)) = gw; }
        }
    }
};
struct EpiMix {
    static constexpr bool PERM = true, AFTER_DRAIN = false, HAS_INIT = false, CARRY = true;
    bf16_t* MIX; const bf16_t* G;
    DI void operator()(f32x4 (&acc)[2][2][4][2], const Unit& u, int wr, int wc, int fr, int fq) const {
        const int wave = wr * 4 + wc, lane = fq * 16 + fr;
        const unsigned char* gc = (const unsigned char*)G + frag_off(u.pm, u.pn, 8, wave, 0, lane); const unsigned char* ga = (const unsigned char*)G + frag_off(u.pm, u.pn + 4, 8, wave, 0, lane);
        bf16_t* mp = MIX + frag_off(u.pm, u.pn, 4, wave, 0, lane);
#pragma unroll
        for (int ai = 0; ai < 2; ++ai) {
            u32x2 gav[8], gcv[8];
#pragma unroll
            for (int q = 0; q < 8; ++q) gav[q] = *(const u32x2*)(ga + (ai * 8 + q) * 512);
            if (!u.which) {
#pragma unroll
                for (int q = 0; q < 8; ++q) gcv[q] = *(const u32x2*)(gc + (ai * 8 + q) * 512); }
#pragma unroll
            for (int m = 0; m < 4; ++m)
#pragma unroll
                for (int bj = 0; bj < 2; ++bj) { const int q = m * 2 + bj; const u32x2 a2 = gav[q];
                    float fa[8] = {(float)(a2.x & 0xffu), (float)((a2.x >> 8) & 0xffu), (float)((a2.x >> 16) & 0xffu), (float)(a2.x >> 24), (float)(a2.y & 0xffu), (float)((a2.y >> 8) & 0xffu), (float)((a2.y >> 16) & 0xffu), (float)(a2.y >> 24)};
                    if (!u.which) { const u32x2 c2 = gcv[q];
                        const float fc[8] = {(float)(c2.x & 0xffu), (float)((c2.x >> 8) & 0xffu), (float)((c2.x >> 16) & 0xffu), (float)(c2.x >> 24), (float)(c2.y & 0xffu), (float)((c2.y >> 8) & 0xffu), (float)((c2.y >> 16) & 0xffu), (float)(c2.y >> 24)};
#pragma unroll
                        for (int e = 0; e < 4; ++e) { acc[ai][bj][m][0][e] *= fc[e] * __builtin_amdgcn_rcpf(fa[e]); acc[ai][bj][m][1][e] *= fc[4 + e] * __builtin_amdgcn_rcpf(fa[4 + e]); }
                    } else { constexpr float GI = 1.f / 255.f;
                        const f32x4 v0 = acc[ai][bj][m][0], v1 = acc[ai][bj][m][1];
                        u32x4 w; w.x = cvt_pk_bf16(v0[0] * fa[0] * GI, v0[1] * fa[1] * GI); w.y = cvt_pk_bf16(v0[2] * fa[2] * GI, v0[3] * fa[3] * GI);
                        w.z = cvt_pk_bf16(v1[0] * fa[4] * GI, v1[1] * fa[5] * GI); w.w = cvt_pk_bf16(v1[2] * fa[6] * GI, v1[3] * fa[7] * GI);
                        store16_wt(mp + (ai * 8 + q) * 512, w); } }
        }
    }
};
struct FragOrder : StaticOrder { static constexpr bool AFRAG = true; };
struct PairOrder : StaticOrder {
    __device__ bool next(int i, Unit& u) const { const bool ok = StaticOrder::next(i >> 1, u); u.which = i & 1; return ok; }
    DI const char* a_base(const Gemm& g, const Unit& u, size_t tstep) const { return (const char*)(u.which ? g.A2 : g.A) + (size_t)u.pm * tstep; }
    DI const char* b_base(const Gemm& g, const Unit& u, size_t tstep) const { return (const char*)(u.which ? g.Bt2 : g.Bt) + (size_t)u.pn * tstep; }
};
struct EpiX1 {
    static constexpr bool PERM = true, AFTER_DRAIN = false, HAS_INIT = true, CARRY = false;
    const float* RMS; bf16_t* XB; float* SSQ; unsigned char* XB8;
    DI void init(f32x4 (&acc)[2][2][4][2], const Unit& u, int wr, int wc, int fr, int fq) const {
        const int row0 = u.pm * BM + wr * 64 + fr, col0 = u.pn * BM + wc * 32 + 8 * fq;
#pragma unroll
        for (int ai = 0; ai < 2; ++ai)
#pragma unroll
            for (int m = 0; m < 4; ++m)
#pragma unroll
                for (int bj = 0; bj < 2; ++bj) { const int row = row0 + ai * HALF + m * 16; const float rm = RMS[row];
                    const u32x4 xn = *(const u32x4*)(XB + (size_t)row * D + col0 + bj * HALF);
                    acc[ai][bj][m][0] = (f32x4){__builtin_bit_cast(float, xn.x << 16), __builtin_bit_cast(float, xn.x & 0xffff0000u), __builtin_bit_cast(float, xn.y << 16), __builtin_bit_cast(float, xn.y & 0xffff0000u)} * rm;
                    acc[ai][bj][m][1] = (f32x4){__builtin_bit_cast(float, xn.z << 16), __builtin_bit_cast(float, xn.z & 0xffff0000u), __builtin_bit_cast(float, xn.w << 16), __builtin_bit_cast(float, xn.w & 0xffff0000u)} * rm; }
    }
    DI void operator()(const f32x4 (&acc)[2][2][4][2], const Unit& u, int wr, int wc, int fr, int fq) const {
        const int row0 = u.pm * BM + wr * 64 + fr, col0 = u.pn * BM + wc * 32 + 8 * fq;
#pragma unroll
        for (int ai = 0; ai < 2; ++ai)
#pragma unroll
            for (int m = 0; m < 4; ++m) { const int row = row0 + ai * HALF + m * 16; float ss = 0.f;
#pragma unroll
                for (int bj = 0; bj < 2; ++bj) { const f32x4 v0 = acc[ai][bj][m][0], v1 = acc[ai][bj][m][1];
                    ss += ((v0[0] * v0[0] + v0[1] * v0[1]) + (v0[2] * v0[2] + v0[3] * v0[3])) + ((v1[0] * v1[0] + v1[1] * v1[1]) + (v1[2] * v1[2] + v1[3] * v1[3]));
                    u32x4 w; w.x = cvt_pk_bf16(v0[0], v0[1]); w.y = cvt_pk_bf16(v0[2], v0[3]); w.z = cvt_pk_bf16(v1[0], v1[1]); w.w = cvt_pk_bf16(v1[2], v1[3]);
                    store16_wt(XB + (size_t)row * D + col0 + bj * HALF, w);
                    { int p0_ = 0, p1_ = 0;
                      p0_ = __builtin_amdgcn_cvt_pk_fp8_f32(v0[0], v0[1], p0_, false); p0_ = __builtin_amdgcn_cvt_pk_fp8_f32(v0[2], v0[3], p0_, true);
                      p1_ = __builtin_amdgcn_cvt_pk_fp8_f32(v1[0], v1[1], p1_, false); p1_ = __builtin_amdgcn_cvt_pk_fp8_f32(v1[2], v1[3], p1_, true);
                      u32x2 w8; w8.x = (unsigned)p0_; w8.y = (unsigned)p1_; *(u32x2*)(XB8 + (size_t)row * D + col0 + bj * HALF) = w8; } }
                ss += __shfl_xor(ss, 16); ss += __shfl_xor(ss, 32);
                if (fq == 0) SSQ[(size_t)row * 16 + u.pn * 4 + wc] = ss; }
    }
};
DI float rstd2_of(const float* SSQ, int row) {
    const f32x4 a = *(const f32x4*)(SSQ + (size_t)row * 16), b = *(const f32x4*)(SSQ + (size_t)row * 16 + 4), c = *(const f32x4*)(SSQ + (size_t)row * 16 + 8), d = *(const f32x4*)(SSQ + (size_t)row * 16 + 12);
    const float s = ((a[0] + a[1]) + (a[2] + a[3])) + ((b[0] + b[1]) + (b[2] + b[3])) + ((c[0] + c[1]) + (c[2] + c[3])) + ((d[0] + d[1]) + (d[2] + d[3]));
    return 1.f / sqrtf(s * (1.f / D) + EPS);
}
struct EpiQP {
    static constexpr bool PERM = true, AFTER_DRAIN = false, HAS_INIT = false, CARRY = false;
    bf16_t* QP;
    DI void operator()(const f32x4 (&acc)[2][2][4][2], const Unit& u, int wr, int wc, int fr, int fq) const {
        const int row0 = u.pm * BM + wr * 64 + fr, col0 = u.pn * BM + wc * 32 + 8 * fq;
#pragma unroll
        for (int ai = 0; ai < 2; ++ai)
#pragma unroll
            for (int m = 0; m < 4; ++m) {
#pragma unroll
                for (int bj = 0; bj < 2; ++bj) { const f32x4 v0 = acc[ai][bj][m][0], v1 = acc[ai][bj][m][1];
                    u32x4 w; w.x = cvt_pk_bf16(v0[0], v0[1]); w.y = cvt_pk_bf16(v0[2], v0[3]); w.z = cvt_pk_bf16(v1[0], v1[1]); w.w = cvt_pk_bf16(v1[2], v1[3]);
                    *(u32x4*)(QP + frag_off(u.pm, u.pn, 8, wr * 4 + wc, ai * 8 + m * 2 + bj, fq * 16 + fr)) = w; } }
    }
};
}

#define MFMA32(a, b, c) __builtin_amdgcn_mfma_f32_32x32x16_bf16((a), (b), (c), 0, 0, 0)
DI void p2_conv(Frame& F) {
    constexpr int CT = 4;
    const size_t NT_ = (size_t)F.G * NWAVES * 64;
    for (size_t item = (size_t)F.vcu * NWAVES * 64 + F.tid; item < (size_t)(T / CT) * 64; item += NT_) {
        const int tb = (int)(item >> 6) * CT, c0 = (int)(item & 63) * 8, tl = tb & (SEQ - 1);
        v4u cg[CT + 2], uu[CT + 2], bg[CT];
#pragma unroll
        for (int r = 0; r < CT + 2; ++r) { const bool ok = (tl + r - 2) >= 0; const bf16* rowp = F.PA + (size_t)(tb + (ok ? r - 2 : 0)) * PA_W;
            cg[r] = *(const GAS v4u*)(rowp + C_C + c0); uu[r] = *(const GAS v4u*)(rowp + C_U + c0);
            if (!ok) { cg[r] = (v4u){0u, 0u, 0u, 0u}; } }
#pragma unroll
        for (int r = 0; r < CT; ++r) bg[r] = *(const GAS v4u*)(F.PA + (size_t)(tb + r) * PA_W + C_B + c0);
        f32x4 w[3][2];
#pragma unroll
        for (int j = 0; j < 3; ++j) { w[j][0] = *(const GAS f32x4*)(F.w_conv + j * CONV + c0); w[j][1] = *(const GAS f32x4*)(F.w_conv + j * CONV + c0 + 4); }
        float h[CT + 2][8];
#pragma unroll
        for (int r = 0; r < CT + 2; ++r) { h[r][0] = bf_lo(cg[r].x) * bf_lo(uu[r].x); h[r][1] = bf_hi(cg[r].x) * bf_hi(uu[r].x); h[r][2] = bf_lo(cg[r].y) * bf_lo(uu[r].y); h[r][3] = bf_hi(cg[r].y) * bf_hi(uu[r].y);
            h[r][4] = bf_lo(cg[r].z) * bf_lo(uu[r].z); h[r][5] = bf_hi(cg[r].z) * bf_hi(uu[r].z); h[r][6] = bf_lo(cg[r].w) * bf_lo(uu[r].w); h[r][7] = bf_hi(cg[r].w) * bf_hi(uu[r].w); }
#pragma unroll
        for (int r = 0; r < CT; ++r) {
            float a[8];
#pragma unroll
            for (int e = 0; e < 8; ++e) a[e] = w[0][e >> 2][e & 3] * h[r][e] + w[1][e >> 2][e & 3] * h[r + 1][e] + w[2][e >> 2][e & 3] * h[r + 2][e];
            v4u o; o.x = pk2(a[0] * bf_lo(bg[r].x), a[1] * bf_hi(bg[r].x)); o.y = pk2(a[2] * bf_lo(bg[r].y), a[3] * bf_hi(bg[r].y));
            o.z = pk2(a[4] * bf_lo(bg[r].z), a[5] * bf_hi(bg[r].z)); o.w = pk2(a[6] * bf_lo(bg[r].w), a[7] * bf_hi(bg[r].w));
            *(GAS v4u*)(F.Z + (size_t)(tb + r) * CONV + c0) = o;
        }
    }
}
DI int t5_bucket(int d) {
    if (d < 16) return d;
    const int large = 16 + (int)(logf((float)d / 16.f) / logf(8.f) * 16.f);
    return large < 31 ? large : 31;
}
constexpr int KS_STRIDE = 72, VT_STRIDE = 264;
constexpr int ATT_KS = 0, ATT_VT = 256 * KS_STRIDE * 2, ATT_BIAS = ATT_VT + 64 * VT_STRIDE * 2, ATT_END = ATT_BIAS + 4 * 128 * 4;
static_assert(ATT_END <= RING_BYTES, "attention LDS");
DI void p2_attention(Frame& F) {
    LAS bf16* KS = (LAS bf16*)(F.lds + ATT_KS); LAS bf16* VT = (LAS bf16*)(F.lds + ATT_VT); LAS float* BIAS = (LAS float*)(F.lds + ATT_BIAS);
    const int lane = F.lane, r = lane & 31, hh = lane >> 5;
#pragma unroll 1
    for (int unit = F.vcu; unit < 8 * 32 * NKV; unit += F.G) {
        const int kv = unit & 1, n = (unit >> 1) & 31, b = unit >> 6;
        const int t0 = b * SEQ + n * 128;
        __syncthreads();
        {
            const int j = F.tid >> 1, hf = F.tid & 1; const bool valid = (n > 0) || (j >= 128);
            const bf16* rowp = F.PA + (size_t)(t0 - 128 + j) * PA_W;
            v4u kq[4], vq[4];
#pragma unroll
            for (int i = 0; i < 4; ++i) { kq[i] = (v4u){0u, 0u, 0u, 0u}; vq[i] = kq[i]; }
            if (valid) {
#pragma unroll
                for (int i = 0; i < 4; ++i) { kq[i] = *(const GAS v4u*)(rowp + C_K + kv * HD + hf * 32 + i * 8); vq[i] = *(const GAS v4u*)(rowp + C_V + kv * HD + hf * 32 + i * 8); }
            }
            float kf[32]; float ss = 0.f;
#pragma unroll
            for (int i = 0; i < 4; ++i) { kf[8 * i + 0] = bf_lo(kq[i].x); kf[8 * i + 1] = bf_hi(kq[i].x); kf[8 * i + 2] = bf_lo(kq[i].y); kf[8 * i + 3] = bf_hi(kq[i].y);
                kf[8 * i + 4] = bf_lo(kq[i].z); kf[8 * i + 5] = bf_hi(kq[i].z); kf[8 * i + 6] = bf_lo(kq[i].w); kf[8 * i + 7] = bf_hi(kq[i].w); }
#pragma unroll
            for (int e = 0; e < 32; ++e) ss += kf[e] * kf[e];
            ss += __shfl_xor(ss, 1);
            const float rs = 1.f / sqrtf(ss * (1.f / HD) + EPS);
#pragma unroll
            for (int i = 0; i < 4; ++i) { const f32x4 g0 = *(const GAS f32x4*)(F.k_norm + hf * 32 + 8 * i), g1 = *(const GAS f32x4*)(F.k_norm + hf * 32 + 8 * i + 4);
                v4u o; o.x = pk2(kf[8 * i + 0] * rs * g0[0], kf[8 * i + 1] * rs * g0[1]); o.y = pk2(kf[8 * i + 2] * rs * g0[2], kf[8 * i + 3] * rs * g0[3]);
                o.z = pk2(kf[8 * i + 4] * rs * g1[0], kf[8 * i + 5] * rs * g1[1]); o.w = pk2(kf[8 * i + 6] * rs * g1[2], kf[8 * i + 7] * rs * g1[3]);
                *(LAS v4u*)(KS + j * KS_STRIDE + hf * 32 + 8 * i) = o; }
#pragma unroll
            for (int i = 0; i < 4; ++i) { const int d0 = hf * 32 + 8 * i;
                VT[(d0 + 0) * VT_STRIDE + j] = (bf16)(vq[i].x & 0xffffu); VT[(d0 + 1) * VT_STRIDE + j] = (bf16)(vq[i].x >> 16);
                VT[(d0 + 2) * VT_STRIDE + j] = (bf16)(vq[i].y & 0xffffu); VT[(d0 + 3) * VT_STRIDE + j] = (bf16)(vq[i].y >> 16);
                VT[(d0 + 4) * VT_STRIDE + j] = (bf16)(vq[i].z & 0xffffu); VT[(d0 + 5) * VT_STRIDE + j] = (bf16)(vq[i].z >> 16);
                VT[(d0 + 6) * VT_STRIDE + j] = (bf16)(vq[i].w & 0xffffu); VT[(d0 + 7) * VT_STRIDE + j] = (bf16)(vq[i].w >> 16); }
            { const int g = F.tid >> 7, dist = F.tid & 127; BIAS[F.tid] = F.rel_bias[t5_bucket(dist) * NH + kv * 4 + g]; }
        }
        __syncthreads();
#pragma unroll 1
        for (int task = F.wave; task < 16; task += NWAVES) {
            const int g = task >> 2, c = task & 3, head = kv * 4 + g, r0 = 32 * c;
            bf16x8 qf[4];
            {
                const bf16* qp = F.PA + (size_t)(t0 + r0 + r) * PA_W + C_Q + head * HD + 8 * hh;
                v4u qq[4]; float qv[32]; float ss = 0.f;
#pragma unroll
                for (int s = 0; s < 4; ++s) qq[s] = *(const GAS v4u*)(qp + 16 * s);
#pragma unroll
                for (int s = 0; s < 4; ++s) { qv[8 * s + 0] = bf_lo(qq[s].x); qv[8 * s + 1] = bf_hi(qq[s].x); qv[8 * s + 2] = bf_lo(qq[s].y); qv[8 * s + 3] = bf_hi(qq[s].y);
                    qv[8 * s + 4] = bf_lo(qq[s].z); qv[8 * s + 5] = bf_hi(qq[s].z); qv[8 * s + 6] = bf_lo(qq[s].w); qv[8 * s + 7] = bf_hi(qq[s].w); }
#pragma unroll
                for (int e = 0; e < 32; ++e) ss += qv[e] * qv[e];
                ss += __shfl_xor(ss, 32);
                const float rs = 0.125f / sqrtf(ss * (1.f / HD) + EPS);
#pragma unroll
                for (int s = 0; s < 4; ++s) { const f32x4 g0 = *(const GAS f32x4*)(F.q_norm + 16 * s + 8 * hh), g1 = *(const GAS f32x4*)(F.q_norm + 16 * s + 8 * hh + 4);
                    v4u o; o.x = pk2(qv[8 * s + 0] * rs * g0[0], qv[8 * s + 1] * rs * g0[1]); o.y = pk2(qv[8 * s + 2] * rs * g0[2], qv[8 * s + 3] * rs * g0[3]);
                    o.z = pk2(qv[8 * s + 4] * rs * g1[0], qv[8 * s + 5] * rs * g1[1]); o.w = pk2(qv[8 * s + 6] * rs * g1[2], qv[8 * s + 7] * rs * g1[3]);
                    qf[s] = __builtin_bit_cast(bf16x8, o); }
            }
            f32x16 sacc[5];
#pragma unroll
            for (int i5 = 0; i5 < 5; ++i5) {
#pragma unroll
                for (int e = 0; e < 16; ++e) sacc[i5][e] = 0.f;
                const int kt = c + i5;
#pragma unroll
                for (int s = 0; s < 4; ++s) { const bf16x8 ka = *(const LAS bf16x8*)(KS + (32 * kt + r) * KS_STRIDE + 16 * s + 8 * hh); sacc[i5] = MFMA32(ka, qf[s], sacc[i5]); }
            }
            const float sink = F.sinks[head];
            const int dbase = r - 4 * hh + 128;
            const LAS float* bl = BIAS + g * 128;
            float mx = sink;
#pragma unroll
            for (int i5 = 0; i5 < 5; ++i5) {
                const bool tile_ok = (n > 0) || (c + i5 >= 4);
#pragma unroll
                for (int e = 0; e < 16; ++e) { const int dist = dbase - 32 * i5 - ((e & 3) + 8 * (e >> 2));
                    bool valid = tile_ok; if (i5 == 0) valid = valid && (dist < 128); if (i5 == 4) valid = valid && (dist >= 0);
                    const float lg = sacc[i5][e] + bl[dist & 127];
                    sacc[i5][e] = valid ? lg : -INFINITY; mx = fmaxf(mx, sacc[i5][e]); }
                __builtin_amdgcn_sched_barrier(0);
            }
            mx = fmaxf(mx, __shfl_xor(mx, 32));
            float sum = 0.f;
#pragma unroll
            for (int i5 = 0; i5 < 5; ++i5)
#pragma unroll
                for (int e = 0; e < 16; ++e) { const float p = __expf(sacc[i5][e] - mx); sacc[i5][e] = p; sum += p; }
            sum += __shfl_xor(sum, 32);
            const float inv = 1.f / (sum + __expf(sink - mx));
            f32x16 oacc[2];
#pragma unroll
            for (int dt = 0; dt < 2; ++dt)
#pragma unroll
                for (int e = 0; e < 16; ++e) oacc[dt][e] = 0.f;
#pragma unroll
            for (int i5 = 0; i5 < 5; ++i5)
#pragma unroll
                for (int s2 = 0; s2 < 2; ++s2) {
                    v4u pp; pp.x = pk2(sacc[i5][8 * s2 + 0] * inv, sacc[i5][8 * s2 + 1] * inv); pp.y = pk2(sacc[i5][8 * s2 + 2] * inv, sacc[i5][8 * s2 + 3] * inv);
                    pp.z = pk2(sacc[i5][8 * s2 + 4] * inv, sacc[i5][8 * s2 + 5] * inv); pp.w = pk2(sacc[i5][8 * s2 + 6] * inv, sacc[i5][8 * s2 + 7] * inv);
                    const bf16x8 pb = __builtin_bit_cast(bf16x8, pp);
                    const int kb = 32 * (c + i5) + 16 * s2 + 4 * hh;
#pragma unroll
                    for (int dt = 0; dt < 2; ++dt) {
                        const v2u lo = *(const LAS v2u*)(VT + (32 * dt + r) * VT_STRIDE + kb), hi = *(const LAS v2u*)(VT + (32 * dt + r) * VT_STRIDE + kb + 8);
                        v4u va; va.x = lo.x; va.y = lo.y; va.z = hi.x; va.w = hi.y;
                        oacc[dt] = MFMA32(__builtin_bit_cast(bf16x8, va), pb, oacc[dt]);
                    }
                    __builtin_amdgcn_sched_barrier(0);
                }
            bf16* op = F.ATT + (size_t)(t0 + r0 + r) * CONV + head * HD;
#pragma unroll
            for (int dt = 0; dt < 2; ++dt)
#pragma unroll
                for (int g4 = 0; g4 < 4; ++g4) { v2u w; w.x = pk2(oacc[dt][4 * g4 + 0], oacc[dt][4 * g4 + 1]); w.y = pk2(oacc[dt][4 * g4 + 2], oacc[dt][4 * g4 + 3]);
#ifdef ZERO_ATT
                    w.x = 0u; w.y = 0u;
#endif
                    *(GAS v2u*)(op + 32 * dt + 8 * g4 + 4 * hh) = w; }
        }
    }
}

DI unsigned f2ord(float f) { const unsigned b = __builtin_bit_cast(unsigned, f); return b ^ ((b >> 31) ? 0xffffffffu : 0x80000000u); }
DI float ord2f(unsigned k) { const unsigned b = k ^ ((k >> 31) ? 0x80000000u : 0xffffffffu); return __builtin_bit_cast(float, b); }
DI unsigned umax_(unsigned a, unsigned b) { return a > b ? a : b; }
DI unsigned umin_(unsigned a, unsigned b) { return a < b ? a : b; }
DI void sort16_desc(unsigned (&v)[16]) {
#pragma unroll
    for (int k = 2; k <= 16; k <<= 1)
#pragma unroll
        for (int j = k >> 1; j > 0; j >>= 1)
#pragma unroll
            for (int i = 0; i < 16; ++i) { const int l = i ^ j; if (l > i) { const bool desc = ((i & k) == 0) || (k == 16); const unsigned a = v[i], b = v[l], hi = umax_(a, b), lo = umin_(a, b); v[i] = desc ? hi : lo; v[l] = desc ? lo : hi; } }
}
DI void merge_top16(unsigned (&a)[16], const unsigned (&b)[16]) {
#pragma unroll
    for (int i = 0; i < 16; ++i) a[i] = umax_(a[i], b[15 - i]);
#pragma unroll
    for (int j = 8; j > 0; j >>= 1)
#pragma unroll
        for (int i = 0; i < 16; ++i) { const int l = i ^ j; if (l > i) { const unsigned x = a[i], y = a[l]; a[i] = umax_(x, y); a[l] = umin_(x, y); } }
}
constexpr int SK_STRIDE = 136;
constexpr int P6_KEYS = 0, P6_IB = 2 * NKEYS * SK_STRIDE * 2, P6_END = P6_IB + NWAVES * 64 * 32;
static_assert(P6_END <= RING_BYTES, "topk LDS");
DI void p6_topk(Frame& F) {
    LAS bf16* KL = (LAS bf16*)(F.lds + P6_KEYS); LAS unsigned char* IB = F.lds + P6_IB + (F.wave * 64 + F.lane) * 32;
    const int lane = F.lane, r = lane & 31, hh = lane >> 5;
    pg8::StaticOrder S; S.init(T, PQ, F.G, (int)blockIdx.x);
    pg8::Unit pu;
    for (int ui = 0; S.next(ui, pu); ++ui) {
        const int h = pu.pn, tile = pu.pm;
        __syncthreads();
        {
            const bf16* src = F.SK + (size_t)h * 2 * NKEYS * 128;
#pragma unroll
            for (int i = 0; i < 8; ++i) { const int ch = F.tid + 512 * i; const int row = ch >> 4, c8 = (ch & 15) * 8;
                *(LAS v4u*)(KL + row * SK_STRIDE + c8) = *(const GAS v4u*)(src + (size_t)row * 128 + c8); }
        }
        __syncthreads();
        const int t = tile * 256 + F.wave * 32 + r;
        unsigned S[2][16];
#pragma unroll
        for (int p = 0; p < 2; ++p) {
            bf16x8 qf[8];
            const int rt = F.wave * 32 + r, q_ai = rt >> 7, q_wr = (rt >> 6) & 1, q_m = (rt >> 4) & 3, q_fr = rt & 15;
#pragma unroll
            for (int s = 0; s < 8; ++s) qf[s] = __builtin_bit_cast(bf16x8, *(const GAS v4u*)(F.QP + pg8::frag_off(tile, h, 8, q_wr * 4 + (s >> 1), q_ai * 8 + q_m * 2 + p, (2 * (s & 1) + hh) * 16 + q_fr)));
            unsigned key[4][16];
#pragma unroll
            for (int kt = 0; kt < 4; ++kt) {
                f32x16 acc;
#pragma unroll
                for (int e = 0; e < 16; ++e) acc[e] = 0.f;
#pragma unroll
                for (int s = 0; s < 8; ++s) { const bf16x8 ka = *(const LAS bf16x8*)(KL + (p * NKEYS + 32 * kt + r) * SK_STRIDE + 16 * s + 8 * hh); acc = MFMA32(ka, qf[s], acc); }
#pragma unroll
                for (int e = 0; e < 16; ++e) { const int nk = 32 * kt + (e & 3) + 8 * (e >> 2) + 4 * hh; key[kt][e] = (f2ord(acc[e]) & ~127u) | (unsigned)(127 - nk); }
            }
#pragma unroll
            for (int kt = 0; kt < 4; ++kt) sort16_desc(key[kt]);
            merge_top16(key[0], key[1]); merge_top16(key[2], key[3]); merge_top16(key[0], key[2]);
            unsigned other[16];
#pragma unroll
            for (int i = 0; i < 16; ++i) other[i] = (unsigned)__shfl_xor((int)key[0][i], 32);
            merge_top16(key[0], other);
#pragma unroll
            for (int i = 0; i < 16; ++i) S[p][i] = key[0][i];
        }
        float s0[16], s1[16]; const float rs2 = pg8::rstd2_of(F.SSQ, t);
#pragma unroll
        for (int i = 0; i < 16; ++i) { s0[i] = ord2f(S[0][i] & ~127u) * rs2; s1[i] = ord2f(S[1][i] & ~127u) * rs2; }
        {
#pragma unroll
            for (int q4 = 0; q4 < 4; ++q4) { unsigned w0 = 0, w1 = 0;
#pragma unroll
                for (int e = 0; e < 4; ++e) { w0 |= (127u - (S[0][4 * q4 + e] & 127u)) << (8 * e); w1 |= (127u - (S[1][4 * q4 + e] & 127u)) << (8 * e); }
                *(LAS unsigned*)(IB + 4 * q4) = w0; *(LAS unsigned*)(IB + 16 + 4 * q4) = w1; }
        }
        unsigned cand[2][16];
#pragma unroll
        for (int i = 0; i < 2; ++i)
#pragma unroll
            for (int e = 0; e < 16; ++e) cand[i][e] = 0u;
        {
            int cnt = 0; float ea = 0.f, eb = 0.f; int ep = 0;
#pragma unroll
            for (int a = 0; a < 16; ++a)
#pragma unroll
                for (int b = 0; b < 16; ++b)
                    if ((a + 1) * (b + 1) <= 16) {
                        if ((cnt & 1) == 0) { ea = s0[a]; eb = s1[b]; ep = 255 - (a * 16 + b); }
                        else { const int slot = cnt >> 1; const float sa = hh ? s0[a] : ea, sb = hh ? s1[b] : eb; const int pp = hh ? 255 - (a * 16 + b) : ep;
                            cand[slot & 1][slot >> 1] = (f2ord(sa + sb) & ~255u) | (unsigned)pp; }
                        ++cnt; }
        }
        sort16_desc(cand[0]); sort16_desc(cand[1]); merge_top16(cand[0], cand[1]);
        {
            unsigned other[16];
#pragma unroll
            for (int i = 0; i < 16; ++i) other[i] = (unsigned)__shfl_xor((int)cand[0][i], 32);
            merge_top16(cand[0], other);
        }
        float gv[16]; int ev[16]; float gsum = 0.f; const float gmx = ord2f(cand[0][0] & ~255u);
#pragma unroll
        for (int i = 0; i < 16; ++i) { const unsigned k = cand[0][i]; const int pos = 255 - (int)(k & 255u); const int a = pos >> 4, b = pos & 15;
            ev[i] = (int)IB[a] * NKEYS + (int)IB[16 + b]; gv[i] = __expf(ord2f(k & ~255u) - gmx); gsum += gv[i]; }
        float ginv = 1.f / gsum;
#ifdef UNIFORM_GATES
#pragma unroll
        for (int i = 0; i < 16; ++i) gv[i] = 1.f;
        ginv = 1.f / 16.f;
#endif
        if (hh == 0) {
            unsigned short* ip = F.IDX + (size_t)t * NSEL + h * TOPK; float* gp = F.GATE + (size_t)t * NSEL + h * TOPK;
#pragma unroll
            for (int i = 0; i < 2; ++i) *(GAS v4i*)(ip + 8 * i) = (v4i){ev[8 * i] | (ev[8 * i + 1] << 16), ev[8 * i + 2] | (ev[8 * i + 3] << 16), ev[8 * i + 4] | (ev[8 * i + 5] << 16), ev[8 * i + 6] | (ev[8 * i + 7] << 16)};
#pragma unroll
            for (int i = 0; i < 4; ++i) *(GAS f32x4*)(gp + 4 * i) = (f32x4){gv[4 * i] * ginv, gv[4 * i + 1] * ginv, gv[4 * i + 2] * ginv, gv[4 * i + 3] * ginv};
        }
    }
}

typedef float f32x2_t __attribute__((ext_vector_type(2)));
DI void fp8x16_to_f32(v4u q, float (&f)[16]) {
#pragma unroll
    for (int w = 0; w < 4; ++w) { const f32x2_t lo = __builtin_amdgcn_cvt_pk_f32_fp8((int)q[w], false), hi = __builtin_amdgcn_cvt_pk_f32_fp8((int)q[w], true);
        f[4 * w + 0] = lo.x; f[4 * w + 1] = lo.y; f[4 * w + 2] = hi.x; f[4 * w + 3] = hi.y; }
}
struct XccInfo { int q, nx, nloc, rank; };
DI void xcc_info_build(const XcdBarrier& b) {
    if (threadIdx.x == 0) {
        unsigned q = 0, nx = 0, nloc = 1;
        for (unsigned j = 0; j < 16; ++j) { const unsigned c = xb_ld(&b.bar[XB_XCNT(j)]); if (c > 0u) { if (j < b.x) ++q; ++nx; } if (j == b.x) nloc = c; }
        b.st[3] = q; b.st[4] = nx > 0u ? nx : 1u; b.st[5] = nloc > 0u ? nloc : 1u;
    }
    __syncthreads();
}
DI XccInfo xcc_info(const XcdBarrier& b) {
    XccInfo I; I.rank = __builtin_amdgcn_readfirstlane((int)b.st[2]); I.q = __builtin_amdgcn_readfirstlane((int)b.st[3]); I.nx = __builtin_amdgcn_readfirstlane((int)b.st[4]); I.nloc = __builtin_amdgcn_readfirstlane((int)b.st[5]);
    return I;
}
DI float dpp_sum8(float s) {
    s += __builtin_bit_cast(float, __builtin_amdgcn_update_dpp(0, __builtin_bit_cast(int, s), 0xB1, 0xf, 0xf, false));
    s += __builtin_bit_cast(float, __builtin_amdgcn_update_dpp(0, __builtin_bit_cast(int, s), 0x4E, 0xf, 0xf, false));
    s += __builtin_bit_cast(float, __builtin_amdgcn_update_dpp(0, __builtin_bit_cast(int, s), 0x141, 0xf, 0xf, false));
    return s;
}
typedef long i64_t;
typedef long i64x2 __attribute__((ext_vector_type(2)));
typedef int v4i_t __attribute__((ext_vector_type(4)));
typedef int v8i_t __attribute__((ext_vector_type(8)));
constexpr int PEER_ROW = 144, PEER_WAVE_LDS = 128 * PEER_ROW;
constexpr int MX_ONE = 0x7f7f7f7f;
#define P7_IDS(t_, ia_, ib_) do { ia_ = (int)F.IDX[(size_t)(t_) * NSEL + lane]; ib_ = (int)F.IDX[(size_t)(t_) * NSEL + 64 + lane]; } while (0)
#define P7_ISSUE(t_, ia_, ib_, uq_, x_) do { \
        const unsigned char* xr_ = F.XB8 + (size_t)(t_) * D + sl * 256 + 16 * g;   \
        x_[0] = *(const GAS v4u*)(xr_); x_[1] = *(const GAS v4u*)(xr_ + 64); x_[2] = *(const GAS v4u*)(xr_ + 128); x_[3] = *(const GAS v4u*)(xr_ + 192); \
        _Pragma("unroll") for (int ld = 0; ld < 16; ++ld) { const int e_ = __shfl(ld < 8 ? ia_ : ib_, (8 * ld + row8) & 63); uq_[ld] = *(const GAS v4u*)(Us + (unsigned)(e_ * 128 + 16 * c8)); } } while (0)
#define P7_COMPUTE(t_, uq_, x_) do { \
        _Pragma("unroll") for (int ld = 0; ld < 16; ++ld) *(LAS v4u*)(wl + (8 * ld + row8) * PEER_ROW + 16 * c8) = uq_[ld]; \
        v8i_t xb0_, xb1_; \
        xb0_[0] = (int)x_[0].x; xb0_[1] = (int)x_[0].y; xb0_[2] = (int)x_[0].z; xb0_[3] = (int)x_[0].w; xb0_[4] = (int)x_[1].x; xb0_[5] = (int)x_[1].y; xb0_[6] = (int)x_[1].z; xb0_[7] = (int)x_[1].w; \
        xb1_[0] = (int)x_[2].x; xb1_[1] = (int)x_[2].y; xb1_[2] = (int)x_[2].z; xb1_[3] = (int)x_[2].w; xb1_[4] = (int)x_[3].x; xb1_[5] = (int)x_[3].y; xb1_[6] = (int)x_[3].z; xb1_[7] = (int)x_[3].w; \
        f32x4 keep = {0.f, 0.f, 0.f, 0.f}; \
        _Pragma("unroll") for (int j = 0; j < 8; ++j) { f32x4 c_ = {0.f, 0.f, 0.f, 0.f}; \
            const v4i_t a0_ = *(const LAS v4i_t*)(wl + (16 * j + m) * PEER_ROW + 16 * g), a1_ = *(const LAS v4i_t*)(wl + (16 * j + m) * PEER_ROW + 64 + 16 * g); \
            v8i_t A0_ = {a0_[0], a0_[1], a0_[2], a0_[3], 0, 0, 0, 0}, A1_ = {a1_[0], a1_[1], a1_[2], a1_[3], 0, 0, 0, 0}; \
            c_ = __builtin_amdgcn_mfma_scale_f32_16x16x128_f8f6f4(A0_, xb0_, c_, 4, 0, 0, MX_ONE, 0, MX_ONE); \
            c_ = __builtin_amdgcn_mfma_scale_f32_16x16x128_f8f6f4(A1_, xb1_, c_, 4, 0, 0, MX_ONE, 0, MX_ONE); \
            keep = (m == j) ? c_ : keep; } \
        { const bool ok_ = (m < 8) && ((t_) < T); bf16* dst_ = ok_ ? F.PARTB + ((size_t)sl * T + (t_)) * NSEL + 16 * m + 4 * g : F.PARTB + (size_t)8 * T * NSEL + 4 * lane; \
          v2u w_; w_.x = pk2(keep[0], keep[1]); w_.y = pk2(keep[2], keep[3]); *(GAS v2u*)dst_ = w_; } } while (0)
DI int peer_next(volatile LAS unsigned* ctr, int lane) { unsigned k = 0u; if (lane == 0) k = __hip_atomic_fetch_add((LAS unsigned*)ctr, 1u, __ATOMIC_RELAXED, __HIP_MEMORY_SCOPE_WORKGROUP); return __builtin_amdgcn_readfirstlane((int)k); }
DI int peer_tok(int tbase, int tstride, int k) { return tbase + (k & 7) + (k >> 3) * tstride; }
DI void p7_udot(Frame& F, const XccInfo& I) {
    const int lane = F.lane, g = lane >> 4, m = lane & 15, row8 = lane >> 3, c8 = lane & 7;
    LAS unsigned char* wl = F.lds + F.wave * PEER_WAVE_LDS;
    const unsigned char* U4 = (const unsigned char*)F.UB;
    const int tstride = I.nloc * NWAVES, tbase = I.rank * NWAVES;
    int it = 0;
    for (int share = I.q; share < 8; share += I.nx, ++it) {
        const int sl = share >> 1, half = share & 1;
        const unsigned char* Us = U4 + (size_t)sl * NEXP * 128;
        volatile LAS unsigned* ctr = F.MISC + 16 + it;
#define CL(t_) ((t_) < T ? (t_) : T - 1)
#define TOK(k_) (2 * peer_tok(tbase, tstride, (k_)) + half)
        v4u uqA[16], uqB[16]; int iA0, iA1, iB0, iB1;
        int kk = peer_next(ctr, lane); int tA = TOK(kk); kk = peer_next(ctr, lane); int tB = TOK(kk);
        {
            v4u xA[4], xB[4];
            P7_IDS(CL(tA), iA0, iA1);
            P7_ISSUE(CL(tA), iA0, iA1, uqA, xA);
            P7_IDS(CL(tB), iB0, iB1);
#pragma unroll 1
            while (tA < T) {
                kk = peer_next(ctr, lane); const int tC = TOK(kk); kk = peer_next(ctr, lane); const int tD = TOK(kk);
                P7_IDS(CL(tC), iA0, iA1);
                P7_ISSUE(CL(tB), iB0, iB1, uqB, xB);
                P7_COMPUTE(tA, uqA, xA);
                P7_IDS(CL(tD), iB0, iB1);
                P7_ISSUE(CL(tC), iA0, iA1, uqA, xA);
                P7_COMPUTE(tB, uqB, xB);
                tA = tC; tB = tD;
            }
        }
#undef TOK
#undef CL
    }
}
DI void p8_act(Frame& F) {
    const size_t NT_ = (size_t)F.G * NWAVES * 64;
    for (size_t item = (size_t)F.vcu * NWAVES * 64 + F.tid; item < (size_t)T * NSEL / 4; item += NT_) {
        const int t = (int)(item >> 5);
        f32x4 s = {0.f, 0.f, 0.f, 0.f}, vs4;
#pragma unroll
        for (int sl = 0; sl < 4; ++sl) { const v2u p = *(const GAS v2u*)(F.PARTB + (size_t)sl * T * NSEL + item * 4); s = s + (f32x4){bf_lo(p.x), bf_hi(p.x), bf_lo(p.y), bf_hi(p.y)}; }
        { const v2u ids = *(const GAS v2u*)(F.IDX + item * 4);
          s[0] *= F.SU[ids.x & 0xffffu]; s[1] *= F.SU[ids.x >> 16]; s[2] *= F.SU[ids.y & 0xffffu]; s[3] *= F.SU[ids.y >> 16];
          vs4 = (f32x4){F.SV[ids.x & 0xffffu], F.SV[ids.x >> 16], F.SV[ids.y & 0xffffu], F.SV[ids.y >> 16]}; }
        const float rs2 = pg8::rstd2_of(F.SSQ, t);
        const f32x4 g = *(const GAS f32x4*)(F.GATE + item * 4);
        f32x4 o;
#pragma unroll
        for (int e = 0; e < 4; ++e) { const float pre = s[e] * rs2; o[e] = 0.5f * pre * (1.f + erff(pre * 0.70710678118f)) * g[e] * vs4[e] * A_SCALE; }
        ((GAS unsigned*)F.ACT)[item] = pk4_fp8(o);
    }
}
typedef int v2i_t __attribute__((ext_vector_type(2)));
#define P9_IDS(t_, ia_, ib_, ak_) do { ia_ = (int)F.IDX[(size_t)(t_) * NSEL + lane]; ib_ = (int)F.IDX[(size_t)(t_) * NSEL + 64 + lane]; \
        const unsigned char* ap_ = (const unsigned char*)F.ACT + (size_t)(t_) * NSEL + 16 * g; \
        ak_[0] = *(const GAS v4u*)(ap_); ak_[1] = *(const GAS v4u*)(ap_ + 64); } while (0)
#define P9_ISSUE(ia_, ib_, vq_) do { \
        _Pragma("unroll") for (int ld = 0; ld < 16; ++ld) { const int e_ = __shfl(ld < 8 ? ia_ : ib_, (8 * ld + row8) & 63); vq_[ld] = *(const GAS v4u*)(Vs + (unsigned)(e_ * 128 + 16 * c8)); } } while (0)
#define P9_COMPUTE(t_, vq_, ak_) do { \
        _Pragma("unroll") for (int ld = 0; ld < 16; ++ld) *(LAS v4u*)(wl + (8 * ld + row8) * PEER_ROW + 16 * c8) = vq_[ld]; \
        const v8i_t A_ = {(int)ak_[0].x, (int)ak_[0].y, (int)ak_[0].z, (int)ak_[0].w, (int)ak_[1].x, (int)ak_[1].y, (int)ak_[1].z, (int)ak_[1].w}; \
        float keep[4] = {0.f, 0.f, 0.f, 0.f}; \
        _Pragma("unroll") for (int ct = 0; ct < 16; ++ct) { \
            const v2i_t b0_ = __builtin_amdgcn_ds_read_tr4_b64_v2i32((LAS v2i_t*)(wl + (32 * g + n16) * PEER_ROW + 8 * ct)); \
            const v2i_t b1_ = __builtin_amdgcn_ds_read_tr4_b64_v2i32((LAS v2i_t*)(wl + (32 * g + 16 + n16) * PEER_ROW + 8 * ct)); \
            const v8i_t B_ = {b0_[0], b0_[1], b1_[0], b1_[1], 0, 0, 0, 0}; f32x4 c_ = {0.f, 0.f, 0.f, 0.f}; \
            c_ = __builtin_amdgcn_mfma_scale_f32_16x16x128_f8f6f4(A_, B_, c_, 0, 4, 0, MX_ONE, 0, MX_ONE); \
            keep[ct >> 2] = (g == (ct & 3)) ? c_[0] : keep[ct >> 2]; }   \
        { const bool ok_ = (t_) < T; const size_t oo_ = (size_t)(ok_ ? (t_) : T - 1) * D + sl * 256 + 16 * g + n16; \
          float* op_ = ok_ ? F.out + oo_ : (float*)F.PARTB + 4 * lane;                   \
          _Pragma("unroll") for (int q = 0; q < 4; ++q) op_[ok_ ? 64 * q : q] = __builtin_bit_cast(float, (unsigned)F.XB[oo_ + 64 * q] << 16) + keep[q] * (1.f / A_SCALE); } } while (0)
DI void p9_vacc(Frame& F, const XccInfo& I) {
    const int lane = F.lane, g = lane >> 4, n16 = lane & 15, row8 = lane >> 3, c8 = lane & 7;
    LAS unsigned char* wl = F.lds + F.wave * PEER_WAVE_LDS;
    const unsigned char* V4 = (const unsigned char*)F.VB;
    const int tstride = I.nloc * NWAVES, tfirst = I.rank * NWAVES + F.wave;
    for (int share = I.q; share < 8; share += I.nx) {
        const int sl = share >> 1, half = share & 1;
        const unsigned char* Vs = V4 + (size_t)sl * NEXP * 128;
        if (2 * tfirst + half >= T) continue;
        v4u vqA[16], vqB[16]; v4u akA[2], akB[2]; int iA0, iA1, iB0, iB1;
#define CL(t_) ((t_) < T ? (t_) : T - 1)
#define TK(k_) (2 * (tfirst + (k_) * tstride) + half)
        P9_IDS(TK(0), iA0, iA1, akA);
        P9_ISSUE(iA0, iA1, vqA);
        P9_IDS(CL(TK(1)), iB0, iB1, akB);
#pragma unroll 1
        for (int k = 0; TK(k) < T; k += 2) {
            const int t = TK(k), t1 = TK(k + 1), t2 = CL(TK(k + 2)), t3 = CL(TK(k + 3));
            v4u akN[2], akM[2];
            P9_IDS(t2, iA0, iA1, akN);
            P9_ISSUE(iB0, iB1, vqB);
            P9_COMPUTE(t, vqA, akA);
            P9_IDS(t3, iB0, iB1, akM);
            P9_ISSUE(iA0, iA1, vqA);
            P9_COMPUTE(t1, vqB, akB);
            akA[0] = akN[0]; akA[1] = akN[1]; akB[0] = akM[0]; akB[1] = akM[1];
        }
#undef TK
#undef CL
    }
}

struct Args { const float* in[17]; float* out; unsigned char* ws; int ph_lo, ph_hi, li, pad; };
__global__ void __launch_bounds__(NWAVES * 64, 2) hyb_fwd(Args args) {
    extern __shared__ __attribute__((aligned(16))) unsigned char lds[];
    Frame F;
    F.lds = (LAS unsigned char*)lds;
    F.MISC = (volatile LAS unsigned*)(F.lds + MISC_OFF);
    F.tid = threadIdx.x; F.lane = F.tid & 63; F.wave = __builtin_amdgcn_readfirstlane(F.tid >> 6);
    F.G = gridDim.x; { const int bx = blockIdx.x; F.vcu = (F.G % 8 == 0) ? (bx % 8) * (F.G / 8) + bx / 8 : bx; }
    unsigned char* ws = args.ws;
    F.ctl = (gu32*)(ws + WS_CTL);
    F.x = args.in[0]; F.norm_mix = args.in[1]; F.norm_ffn = args.in[2]; F.w_in = args.in[3]; F.b_gate = args.in[4]; F.w_conv = args.in[5]; F.q_norm = args.in[6]; F.k_norm = args.in[7];
    F.sinks = args.in[8]; F.rel_bias = args.in[9]; F.w_conv_out = args.in[10]; F.w_attn_out = args.in[11]; F.w_out = args.in[12]; F.w_query = args.in[13]; F.sub_keys = args.in[14];
    F.expert_u = args.in[15]; F.expert_v = args.in[16]; F.out = args.out;
    F.WIN = (bf16*)(ws + WS_WIN); F.WG8 = ws + WS_WG8; F.WC = (bf16*)(ws + WS_WC); F.WA = (bf16*)(ws + WS_WA); F.WO = (bf16*)(ws + WS_WO); F.WQ = (bf16*)(ws + WS_WQ); F.SK = (bf16*)(ws + WS_SK);
    F.UB = (bf16*)(ws + WS_UB); F.VB = (bf16*)(ws + WS_VB); F.XB = (bf16*)(ws + WS_XB); F.PA = (bf16*)(ws + WS_PA); F.MIX = (bf16*)(ws + WS_MIX); F.G_ = (bf16*)(ws + WS_G); F.QP = (bf16*)(ws + WS_QP);
    F.Z = (bf16*)(ws + WS_Z); F.ATT = (bf16*)(ws + WS_ATT); F.RSTD1 = (float*)(ws + WS_RSTD1); F.SSQ = (float*)(ws + WS_SSQ); F.GATE = (float*)(ws + WS_GATE); F.IDX = (unsigned short*)(ws + WS_IDX); F.PARTB = (bf16*)(ws + WS_PART); F.SU = (float*)(ws + WS_SU); F.SV = (float*)(ws + WS_SV); F.XB8 = (unsigned char*)(ws + WS_XB8); F.ACT = (float*)(ws + WS_ACT);
    for (int u = F.tid; u < (LDS_BYTES - LDSCTL_OFF) / 4; u += NWAVES * 64) ((LAS unsigned*)(F.lds + LDSCTL_OFF))[u] = 0u;
    __syncthreads();
    XcdBarrier bar; bar.bar = (unsigned*)(F.ctl + CW_BAR); bar.x = 0; bar.st = nullptr;
    const int lo = args.ph_lo, hi = args.ph_hi;
    if (hi - lo > 1) bar = xcd_barrier_post((unsigned*)(F.ctl + CW_BAR), F.MISC + 8);
#ifndef PH_MASK
#define PH_MASK 0x3ff
#endif
#define IN(k) (((PH_MASK >> (k)) & 1) && lo <= (k) && (k) < hi)
#define SEAM(k) do { if (IN(k) && IN((k) + 1)) xcd_barrier(bar); } while (0)
#ifndef PROBE_DUP
#define PROBE_DUP 0
#endif
#define REP(k) for (int rep_ = 0; rep_ < (((PROBE_DUP >> (k)) & 1) ? 2 : 1); ++rep_)

    if (IN(0)) { REP(0) p0_prologue(F); SEAM(0); }
    if (IN(1)) {
        pg8::Gemm g{F.XB, F.WIN, nullptr, nullptr, T, PA_W, D}; pg8::StaticOrder S; S.init(T, PA_W, F.G, (int)blockIdx.x);
        pg8::Gemm g8{(const pg8::bf16_t*)F.XB8, (const pg8::bf16_t*)F.WG8, nullptr, nullptr, T, G_W, D / 2}; pg8::StaticOrder S8; S8.init(T, G_W, F.G, (int)blockIdx.x);
        { LAS float* bgl = (LAS float*)(F.lds + RING_BYTES); for (int i = F.tid; i < 2 * D; i += NWAVES * 64) bgl[i] = F.b_gate[i]; __syncthreads(); }
        pg8::EpiProj E{F.PA, F.G_, (const PG8_LAS float*)(F.lds + RING_BYTES), false, 1.f}, E8{F.PA, F.G_, (const PG8_LAS float*)(F.lds + RING_BYTES), true, 1.f / WG_SCALE};
        REP(1) { pg8::gemm_phase<pg8::EpiProj, pg8::StaticOrder, PG8_ALIGN, PG8_SP2, true>(F.lds + RING_OFF, g8, S8, E8);
                 pg8::gemm_phase<pg8::EpiProj, pg8::StaticOrder, PG8_ALIGN, PG8_SP2>(F.lds + RING_OFF, g, S, E); }
        {
            const int nwg = (T / 256) * (PA_W / 256), rem = nwg % F.G, c = (int)blockIdx.x; const int nshort = rem ? F.G - rem : F.G, sidx = rem ? c - rem : c;
            (void)sidx; (void)nshort;
            constexpr int CH = 64, NCH = 2 * NEXP / CH;
            for (;;) {
                if (F.tid == 0) F.MISC[14] = __hip_atomic_fetch_add((unsigned*)(F.ctl + 2048), 1u, __ATOMIC_RELAXED, __HIP_MEMORY_SCOPE_AGENT);
                __syncthreads();
                const int ch = __builtin_amdgcn_readfirstlane((int)F.MISC[14]);
                __syncthreads();
                if (ch >= NCH) break;
                if (ch < NCH / 2) p0_convert_fp4(F, F.expert_u, F.norm_ffn, (unsigned char*)F.UB, F.SU, ch * CH, ch * CH + CH);
                else p0_convert_fp4(F, F.expert_v, nullptr, (unsigned char*)F.VB, F.SV, (ch - NCH / 2) * CH, (ch - NCH / 2) * CH + CH);
            } }
        SEAM(1);
    }
    if (IN(2)) {
        REP(2) { p2_conv(F); p2_attention(F); }
        SEAM(2); }
    if (IN(3)) {
        pg8::Gemm g{F.Z, F.WC, F.ATT, F.WA, T, D, CONV}; pg8::PairOrder S; S.init(T, D, F.G, (int)blockIdx.x);
        pg8::EpiMix E{F.MIX, F.G_};
        REP(3) pg8::gemm_phase<pg8::EpiMix, pg8::PairOrder, PG8_ALIGN, PG8_SP2>(F.lds + RING_OFF, g, S, E);
        SEAM(3);
    }
    if (IN(4)) {
        pg8::Gemm g{F.MIX, F.WO, nullptr, nullptr, T, D, D}; pg8::FragOrder S; S.init(T, D, F.G, (int)blockIdx.x);
        pg8::EpiX1 E{F.RSTD1, F.XB, F.SSQ, F.XB8};
        REP(4) pg8::gemm_phase<pg8::EpiX1, pg8::FragOrder, PG8_ALIGN, PG8_SP2>(F.lds + RING_OFF, g, S, E);
        SEAM(4);
    }
    if (IN(5)) {
        pg8::Gemm g{F.XB, F.WQ, nullptr, nullptr, T, PQ, D}; pg8::StaticOrder S; S.init(T, PQ, F.G, (int)blockIdx.x);
        pg8::EpiQP E{F.QP};
        REP(5) pg8::gemm_phase<pg8::EpiQP, pg8::StaticOrder, PG8_ALIGN, PG8_SP2>(F.lds + RING_OFF, g, S, E);
    }
    if (IN(6)) { REP(6) p6_topk(F); SEAM(6); }
    if (IN(7)) { xcc_info_build(bar); const XccInfo I = xcc_info(bar); REP(7) p7_udot(F, I); SEAM(7); }
    if (IN(8)) { REP(8) p8_act(F); SEAM(8); }
    if (IN(9)) { const XccInfo I = xcc_info(bar); p9_vacc(F, I); }
#undef IN
#undef SEAM
}

extern "C" void kernel_launch(void* const* d_in, const int* in_sizes, int n_in, void* d_out, int out_size, void* d_ws, size_t ws_size, hipStream_t stream) {
    static int grid = 0;
    if (grid == 0) {
        if (n_in != 17 || in_sizes[0] != T * D || out_size != T * D || ws_size < WS_END) { fprintf(stderr, "kernel_launch: unexpected shapes (n_in %d, in0 %d, out %d, ws %zu)\n", n_in, n_in > 0 ? in_sizes[0] : -1, out_size, ws_size); grid = -1; return; }
        int dev = 0, cus = 0, per_cu = 0;
        if (hipGetDevice(&dev) != hipSuccess || hipDeviceGetAttribute(&cus, hipDeviceAttributeMultiprocessorCount, dev) != hipSuccess) { grid = -1; return; }
        if (hipFuncSetAttribute((const void*)hyb_fwd, hipFuncAttributeMaxDynamicSharedMemorySize, LDS_BYTES) != hipSuccess) { fprintf(stderr, "kernel_launch: hipFuncSetAttribute failed\n"); grid = -1; return; }
        if (hipOccupancyMaxActiveBlocksPerMultiprocessor(&per_cu, (const void*)hyb_fwd, NWAVES * 64, LDS_BYTES) != hipSuccess || per_cu < 1) { fprintf(stderr, "kernel_launch: occupancy query says %d blocks per CU\n", per_cu); (void)hipGetLastError(); grid = -1; return; }
        grid = cus * 1;
    }
    if (grid < 0) return;
    if (hipMemsetAsync((char*)d_ws + WS_CTL, 0, CTL_ZERO_BYTES, stream) != hipSuccess) { fprintf(stderr, "kernel_launch: memset failed\n"); return; }
    Args a{};
    for (int i = 0; i < 17; ++i) a.in[i] = (const float*)d_in[i];
    a.out = (float*)d_out; a.ws = (unsigned char*)d_ws;
#if MK_ONE_LAUNCH
    a.ph_lo = 0; a.ph_hi = N_PHASES; a.li = 0;
    void* kargs[] = {&a};
    const hipError_t le = hipLaunchCooperativeKernel((const void*)hyb_fwd, dim3(grid), dim3(NWAVES * 64), kargs, LDS_BYTES, stream);
    if (le != hipSuccess) fprintf(stderr, "kernel_launch: cooperative launch failed: %s (grid %d)\n", hipGetErrorName(le), grid);
#else
    for (int li = 0; li < N_PHASES; ++li) {
        a.ph_lo = li; a.ph_hi = li + 1; a.li = li;
        hipLaunchKernelGGL(hyb_fwd, dim3(grid), dim3(NWAVES * 64), LDS_BYTES, stream, a);
        const hipError_t le = hipPeekAtLastError();
        if (le != hipSuccess) { fprintf(stderr, "kernel_launch: launch %d failed: %s\n", li, hipGetErrorName(le)); break; }
    }
#endif
}
```

```cpp
#include <hip/hip_runtime.h>
#include <hip/hip_cooperative_groups.h>
#include <cstdio>
#include <cstdint>
namespace pg8 {
#define PG8_LAS __attribute__((address_space(3)))
typedef unsigned short bf16_t;
typedef short bf16x8 __attribute__((ext_vector_type(8)));
typedef float f32x4 __attribute__((ext_vector_type(4)));
typedef unsigned u32x4 __attribute__((ext_vector_type(4)));
typedef unsigned u32x2 __attribute__((ext_vector_type(2)));
constexpr int BM = 256, BK = 64, HALF = 128, HTB = HALF * BK * 2  , STAGE_BYTES = 8 * HTB, NXCD = 8, WGM = 8;

__host__ __device__ __forceinline__ int lds_byte(int r, int c) { const int st = (r >> 4) * 2 + (c >> 5), rr = r & 15, cc = c & 31, ob = rr * 64 + cc * 2; return st * 1024 + (ob ^ (((ob >> 9) & 1) << 5)); }
__host__ __device__ __forceinline__ void stage_rc(int b, int& R, int& C) { const int st = b / 1024, sb = b % 1024, swz = sb ^ (((sb >> 9) & 1) << 5); R = (st >> 1) * 16 + swz / 64; C = (st & 1) * 32 + (swz % 64) / 2; }
__host__ __device__ __forceinline__ int perm32(int rho) { const int n = rho >> 4, i = rho & 15; return 8 * (i >> 2) + 4 * n + (i & 3); }

struct Unit { int pm, pn, which; };
struct Gemm { const bf16_t* A; const bf16_t* Bt; const bf16_t* A2; const bf16_t* Bt2; int M, N, K; };

struct StaticOrder {
    static constexpr bool AFRAG = false;
    int nM, nN, nwg, G, c;
    __host__ __device__ void init(int M, int N, int G_, int c_) { nM = M / BM; nN = N / BM; nwg = nM * nN; G = G_; c = c_; }
    __host__ __device__ bool next(int i, Unit& u) const {
        const long L = (long)i * G + c; if (L >= nwg) return false;
        int wgid = (int)L; { const int q = nwg / NXCD, r = nwg % NXCD, xcd = wgid % NXCD, off = wgid / NXCD; wgid = (xcd < r ? xcd * (q + 1) : r * (q + 1) + (xcd - r) * q) + off; }
        const int nig = WGM * nN, gid = wgid / nig, fm = gid * WGM, gsz = (nM - fm) < WGM ? (nM - fm) : WGM;
        u.pm = fm + ((wgid % nig) % gsz); u.pn = (wgid % nig) / gsz; u.which = 0; return true;
    }
    __device__ __forceinline__ const char* a_base(const Gemm& g, const Unit& u, size_t tstep) const { return (const char*)g.A + (size_t)u.pm * tstep; }
    __device__ __forceinline__ const char* b_base(const Gemm& g, const Unit& u, size_t tstep) const { return (const char*)g.Bt + (size_t)u.pn * tstep; }
    __device__ __forceinline__ void a_ready(const Unit&) const {}
    __device__ __forceinline__ void done(const Unit&) const {}
};

__device__ __forceinline__ unsigned cvt_pk_bf16(float lo, float hi) { unsigned r; asm volatile("v_cvt_pk_bf16_f32 %0, %1, %2" : "=v"(r) : "v"(lo), "v"(hi)); return r; }
__device__ __forceinline__ void store16_wt(void* p, u32x4 v) { asm volatile("global_store_dwordx4 %0, %1, off sc1\n\ts_nop 1" :: "v"(p), "v"(v) : "memory"); }
__device__ __forceinline__ void store8_wt(void* p, u32x2 v) { asm volatile("global_store_dwordx2 %0, %1, off sc1\n\ts_nop 1" :: "v"(p), "v"(v) : "memory"); }
typedef float f32x2 __attribute__((ext_vector_type(2)));
__device__ __forceinline__ f32x2 gelu_pk(f32x2 v) {
    const f32x2 av = __builtin_elementwise_abs(v), d = av * 0.2316418882f + 1.0f;
    f32x2 t; t.x = __builtin_amdgcn_rcpf(d.x); t.y = __builtin_amdgcn_rcpf(d.y);
    f32x2 q = t * 0.5307027145f + (-0.7265760135f); q = q * t + 0.7107068705f; q = q * t + (-0.142248368f); q = q * t + 0.127414796f; q = q * t;
    const f32x2 s = (v * v) * (-0.72134752044f);
    f32x2 e; e.x = __builtin_amdgcn_exp2f(s.x); e.y = __builtin_amdgcn_exp2f(s.y);
    const f32x2 m = v * (q * e), r = v - m;
    f32x2 o; o.x = v.x < 0.f ? m.x : r.x; o.y = v.y < 0.f ? m.y : r.y; return o;
}

template <class Epi, class Sched, bool ALIGN_EPI = false, bool SP2 = false, bool FP8 = false>
__device__ __forceinline__ void gemm_phase(PG8_LAS unsigned char* lds, const Gemm g, const Sched& S, const Epi& E) {
    const int tid = threadIdx.x, wid = __builtin_amdgcn_readfirstlane(tid >> 6), lane = tid & 63, wr = wid >> 2, wc = wid & 3, fr = lane & 15, fq = lane >> 4;
    const int K = g.K, nt = K / BK;
    unsigned voffA[2], voffB[2];
#pragma unroll
    for (int i = 0; i < 2; ++i) { int R, C; stage_rc(tid * 16 + i * 8192, R, C); const int Rb = Epi::PERM ? ((R & ~31) + perm32(R & 31)) : R;
        voffA[i] = Sched::AFRAG ? (unsigned)((((((R >> 6) * 4 + (C >> 5)) * 16 + ((R >> 4) & 3) * 2) * 64) + ((C & 31) >> 3) * 16 + (R & 15)) * 16) : (unsigned)(R * K + C) * 2u;
        voffB[i] = (unsigned)(Rb * K + C) * 2u; }
#define PG8_AP(base, h, kt) (Sched::AFRAG ? (base) + ((((size_t)((kt) >> 2) * 8 + ((kt) & 1) * 2) * 16 + (h) * 8 + (((kt) >> 1) & 1)) * 64) * 16 : (base) + (size_t)(h) * hstep + (size_t)(kt) * kstep)
    const size_t kstep = (size_t)(BK * 2);
    const size_t hstep = (size_t)HALF * K * 2;
    const size_t tstep = 2 * hstep;
    const unsigned ldsw = (unsigned)wid * 1024u;
    const int aoff = lds_byte(wr * 64 + fr, fq * 8), boff = lds_byte(wc * 32 + fr, fq * 8);
#define PG8_SA(b, h) (((b) * 2 + (h)) * HTB)
#define PG8_SB(b, h) ((4 + (b) * 2 + (h)) * HTB)
#define PG8_STAGE(bufoff, gbase, voff) do { _Pragma("unroll") for (int _i = 0; _i < 2; ++_i) \
        __builtin_amdgcn_global_load_lds((const unsigned*)((const char*)(gbase) + (voff)[_i]), (PG8_LAS unsigned*)(lds + (bufoff) + ldsw + _i * 8192), 16, 0, 0); } while (0)
#define PG8_LDA(dst, b, h) do { _Pragma("unroll") for (int m = 0; m < 4; ++m) dst[m] = __builtin_shufflevector(*(const PG8_LAS bf16x8*)(lds + PG8_SA(b, h) + aoff + m * 2048), *(const PG8_LAS bf16x8*)(lds + PG8_SA(b, h) + aoff + m * 2048 + 1024), 0, 1, 2, 3, 4, 5, 6, 7, 8, 9, 10, 11, 12, 13, 14, 15); } while (0)
#define PG8_LDB(dst, b, h) do { _Pragma("unroll") for (int n = 0; n < 2; ++n) dst[n] = __builtin_shufflevector(*(const PG8_LAS bf16x8*)(lds + PG8_SB(b, h) + boff + n * 2048), *(const PG8_LAS bf16x8*)(lds + PG8_SB(b, h) + boff + n * 2048 + 1024), 0, 1, 2, 3, 4, 5, 6, 7, 8, 9, 10, 11, 12, 13, 14, 15); } while (0)
#define PG8_MMA(ai, bj, At, Bt) do { __builtin_amdgcn_s_setprio(1); _Pragma("unroll") for (int m = 0; m < 4; ++m) _Pragma("unroll") for (int n = 0; n < 2; ++n) { \
        if constexpr (FP8) { typedef int v8i_ __attribute__((ext_vector_type(8)));   \
            asm volatile("v_mfma_scale_f32_16x16x128_f8f6f4 %0, %1, %2, %0, %3, %3 op_sel_hi:[0,0,0]" : "+v"(acc[ai][bj][m][n]) : "v"(__builtin_bit_cast(v8i_, Bt[n])), "v"(__builtin_bit_cast(v8i_, At[m])), "v"(mx_one)); \
        } else { \
            acc[ai][bj][m][n] = __builtin_amdgcn_mfma_f32_16x16x32_bf16(__builtin_shufflevector(Bt[n], Bt[n], 0, 1, 2, 3, 4, 5, 6, 7), __builtin_shufflevector(At[m], At[m], 0, 1, 2, 3, 4, 5, 6, 7), acc[ai][bj][m][n], 0, 0, 0); \
            acc[ai][bj][m][n] = __builtin_amdgcn_mfma_f32_16x16x32_bf16(__builtin_shufflevector(Bt[n], Bt[n], 8, 9, 10, 11, 12, 13, 14, 15), __builtin_shufflevector(At[m], At[m], 8, 9, 10, 11, 12, 13, 14, 15), acc[ai][bj][m][n], 0, 0, 0); } } \
        __builtin_amdgcn_s_setprio(0); } while (0)
#define PG8_WAIT_V(n) asm volatile("s_waitcnt vmcnt(" #n ")" ::: "memory")
#define PG8_WAIT_L(n) asm volatile("s_waitcnt lgkmcnt(" #n ")" ::: "memory")
#define PG8_BAR __builtin_amdgcn_s_barrier()
#define PG8_SCHED __builtin_amdgcn_sched_barrier(0)
    Unit cur, nxt; int ui = 0;
    if (!S.next(0, cur)) return;
    f32x4 acc[2][2][4][2];
#pragma unroll
    for (int a = 0; a < 2; ++a)
#pragma unroll
        for (int b = 0; b < 2; ++b)
#pragma unroll
            for (int m = 0; m < 4; ++m)
#pragma unroll
                for (int n = 0; n < 2; ++n) acc[a][b][m][n] = (f32x4){0.f, 0.f, 0.f, 0.f};
    if constexpr (Epi::HAS_INIT) E.init(acc, cur, wr, wc, fr, fq);
    const int mx_one = 0x7f7f7f7f;
    typedef short bf16x16 __attribute__((ext_vector_type(16)));
    bf16x16 At[4], B0[2], B1[2];
    const char* cA = S.a_base(g, cur, tstep); const char* cB = S.b_base(g, cur, tstep);
    S.a_ready(cur);
    if constexpr (SP2) {
        PG8_STAGE(PG8_SB(0, 0), cB, voffB); PG8_STAGE(PG8_SB(0, 1), cB + hstep, voffB); PG8_STAGE(PG8_SA(0, 0), PG8_AP(cA, 0, 0), voffA); PG8_STAGE(PG8_SA(0, 1), PG8_AP(cA, 1, 0), voffA);
        if (wr == 1) PG8_BAR;
        PG8_WAIT_V(2); PG8_BAR;
        PG8_STAGE(PG8_SB(1, 0), cB + kstep, voffB); PG8_STAGE(PG8_SA(1, 0), PG8_AP(cA, 0, 1), voffA); PG8_STAGE(PG8_SB(1, 1), cB + hstep + kstep, voffB);
        PG8_WAIT_V(6); PG8_BAR;
    } else {
        PG8_STAGE(PG8_SB(0, 0), cB, voffB); PG8_STAGE(PG8_SA(0, 0), PG8_AP(cA, 0, 0), voffA); PG8_STAGE(PG8_SB(0, 1), cB + hstep, voffB); PG8_STAGE(PG8_SA(0, 1), PG8_AP(cA, 1, 0), voffA);
        if (wr == 1) PG8_BAR;
        PG8_WAIT_V(4); PG8_BAR;
        PG8_STAGE(PG8_SB(1, 0), cB + kstep, voffB); PG8_STAGE(PG8_SA(1, 0), PG8_AP(cA, 0, 1), voffA); PG8_STAGE(PG8_SB(1, 1), cB + hstep + kstep, voffB);
        PG8_WAIT_V(6); PG8_BAR;
    }
    for (;;) {
        const bool has_next = S.next(ui + 1, nxt);
        const char* nA = has_next ? S.a_base(g, nxt, tstep) : cA; const char* nB = has_next ? S.b_base(g, nxt, tstep) : cB;
        for (int t = 0; t < nt; t += 2) {
            const bool last = (t == nt - 2);
            const char* a2b = last ? nA : cA; const int a2k = last ? 0 : t + 2; const char* b2 = last ? nB : cB + (size_t)(t + 2) * kstep;
            const char* b3 = b2 + kstep;
            const char* a1h = PG8_AP(cA, 1, t + 1); const char* a2 = PG8_AP(a2b, 0, a2k); const char* a2h = PG8_AP(a2b, 1, a2k); const char* a3 = PG8_AP(a2b, 0, a2k + 1);
            if (last && has_next) S.a_ready(nxt);
            if constexpr (SP2) {
            PG8_LDB(B0, 0, 0); PG8_LDB(B1, 0, 1); PG8_SCHED; PG8_LDA(At, 0, 0); PG8_STAGE(PG8_SA(1, 1), a1h, voffA);
            PG8_WAIT_V(8); PG8_WAIT_L(0); PG8_BAR; PG8_MMA(0, 0, At, B0); PG8_MMA(0, 1, At, B1); PG8_BAR; PG8_SCHED;
            PG8_LDA(At, 0, 1); PG8_STAGE(PG8_SB(0, 0), b2, voffB); PG8_STAGE(PG8_SB(0, 1), b2 + hstep, voffB); PG8_STAGE(PG8_SA(0, 0), a2, voffA);
            PG8_WAIT_V(8); PG8_WAIT_L(0); PG8_BAR; PG8_MMA(1, 0, At, B0); PG8_MMA(1, 1, At, B1); PG8_BAR; PG8_SCHED;
            PG8_LDB(B0, 1, 0); PG8_LDB(B1, 1, 1); PG8_SCHED; PG8_LDA(At, 1, 0); PG8_STAGE(PG8_SA(0, 1), a2h, voffA);
            PG8_WAIT_V(8); PG8_WAIT_L(0); PG8_BAR; PG8_MMA(0, 0, At, B0); PG8_MMA(0, 1, At, B1); PG8_BAR; PG8_SCHED;
            PG8_LDA(At, 1, 1); PG8_STAGE(PG8_SB(1, 0), b3, voffB); PG8_STAGE(PG8_SB(1, 1), b3 + hstep, voffB); PG8_STAGE(PG8_SA(1, 0), a3, voffA);
            PG8_WAIT_V(8); PG8_WAIT_L(0); PG8_BAR; PG8_MMA(1, 0, At, B0); PG8_MMA(1, 1, At, B1); PG8_BAR; PG8_SCHED;
            } else {
            PG8_LDB(B0, 0, 0); PG8_SCHED; PG8_LDA(At, 0, 0); PG8_STAGE(PG8_SA(1, 1), a1h, voffA);
            PG8_WAIT_L(8); PG8_BAR; PG8_WAIT_L(0); PG8_MMA(0, 0, At, B0); PG8_BAR; PG8_SCHED;
            PG8_LDB(B1, 0, 1); PG8_STAGE(PG8_SB(0, 0), b2, voffB);
            PG8_BAR; PG8_WAIT_L(0); PG8_MMA(0, 1, At, B1); PG8_BAR;
            PG8_LDA(At, 0, 1); PG8_STAGE(PG8_SA(0, 0), a2, voffA);
            PG8_BAR; PG8_WAIT_L(0); PG8_MMA(1, 0, At, B0); PG8_BAR; PG8_SCHED;
            PG8_STAGE(PG8_SB(0, 1), b2 + hstep, voffB);
            PG8_WAIT_V(6); PG8_BAR; PG8_MMA(1, 1, At, B1); PG8_BAR;
            PG8_LDB(B0, 1, 0); PG8_SCHED; PG8_LDA(At, 1, 0); PG8_STAGE(PG8_SA(0, 1), a2h, voffA);
            PG8_WAIT_L(8); PG8_BAR; PG8_WAIT_L(0); PG8_MMA(0, 0, At, B0); PG8_BAR; PG8_SCHED;
            PG8_LDB(B1, 1, 1); PG8_STAGE(PG8_SB(1, 0), b3, voffB);
            PG8_BAR; PG8_WAIT_L(0); PG8_MMA(0, 1, At, B1); PG8_BAR;
            PG8_LDA(At, 1, 1); PG8_STAGE(PG8_SA(1, 0), a3, voffA);
            PG8_BAR; PG8_WAIT_L(0); PG8_MMA(1, 0, At, B0); PG8_BAR; PG8_SCHED;
            PG8_STAGE(PG8_SB(1, 1), b3 + hstep, voffB);
            PG8_WAIT_V(6); PG8_BAR; PG8_MMA(1, 1, At, B1); PG8_BAR;
            }
        }
        if constexpr (ALIGN_EPI) { if (wr == 0) PG8_BAR; }
        if constexpr (!Epi::AFTER_DRAIN) { E(acc, cur, wr, wc, fr, fq); S.done(cur); }
        if (!has_next) break;
        if (!(Epi::CARRY && cur.which == 0)) {
#pragma unroll
        for (int a = 0; a < 2; ++a)
#pragma unroll
            for (int b = 0; b < 2; ++b)
#pragma unroll
                for (int m = 0; m < 4; ++m)
#pragma unroll
                    for (int n = 0; n < 2; ++n) acc[a][b][m][n] = (f32x4){0.f, 0.f, 0.f, 0.f};
        }
        if constexpr (Epi::HAS_INIT) E.init(acc, nxt, wr, wc, fr, fq);
        cur = nxt; cA = nA; cB = nB; ++ui;
        if constexpr (ALIGN_EPI) { if (wr == 1) PG8_BAR; }
    }
    PG8_WAIT_V(0);
    if constexpr (!ALIGN_EPI) { if (wr == 0) PG8_BAR; }
    PG8_BAR;
    if constexpr (Epi::AFTER_DRAIN) { E.fused(acc, cur, wr, wc, fr, fq, lds, wid, lane); S.done(cur); }
#undef PG8_AP
#undef PG8_SA
#undef PG8_SB
#undef PG8_STAGE
#undef PG8_LDA
#undef PG8_LDB
#undef PG8_MMA
#undef PG8_WAIT_V
#undef PG8_WAIT_L
#undef PG8_BAR
#undef PG8_SCHED
}
}

#ifndef PG8_SP2
#define PG8_SP2 true
#endif
#ifndef PG8_ALIGN
#define PG8_ALIGN true
#endif
#ifndef MK_ONE_LAUNCH
#define MK_ONE_LAUNCH 1
#endif

constexpr int NWAVES = 8;
constexpr int T = 32768, D = 1024, SEQ = 4096;
constexpr int IN_DIM = 4352, PA_W = 2304, G_W = 2048;
constexpr int N16 = 1536, N8 = IN_DIM - N16;
constexpr int C_U = 0, C_B = 512, C_C = 1024, C_Q = 1536, C_K = 2048, C_V = 2176;
constexpr int CONV = 512, HD = 64, NH = 8, NKV = 2;
constexpr int PH = 8, NKEYS = 128, PQ = 2048, TOPK = 16, NEXP = 16384, NSEL = 128;
constexpr float EPS = 1e-6f;
constexpr int N_PHASES = 10;

constexpr size_t MiB = 1u << 20;
constexpr size_t WS_CTL = 0, CTL_ZERO_BYTES = 1 * MiB;
constexpr size_t WS_WIN = 2 * MiB;
constexpr size_t WS_WG8 = WS_WIN + 3072 * 1024;
constexpr size_t WS_WC = 11 * MiB;
constexpr size_t WS_WA = 12 * MiB;
constexpr size_t WS_WO = 13 * MiB;
constexpr size_t WS_WQ = 15 * MiB;
constexpr size_t WS_SK = 19 * MiB;
constexpr size_t WS_RSTD1 = 20 * MiB;
constexpr size_t WS_SSQ = 21 * MiB;
constexpr size_t WS_UB = 24 * MiB;
constexpr size_t WS_SU = 32 * MiB;
constexpr size_t WS_VB = 40 * MiB;
constexpr size_t WS_SV = 48 * MiB;
constexpr size_t WS_XB8 = 56 * MiB;
constexpr size_t WS_XB = 88 * MiB;
constexpr size_t WS_PA = 152 * MiB;
constexpr size_t WS_MIX = WS_PA;
constexpr size_t WS_G = 296 * MiB;
constexpr size_t WS_QP = WS_G;
constexpr size_t WS_Z = 424 * MiB;
constexpr size_t WS_ATT = 456 * MiB;
constexpr size_t WS_IDX = WS_Z, WS_GATE = WS_ATT;
constexpr size_t WS_PART = WS_PA;
constexpr size_t WS_ACT = WS_G;
constexpr size_t WS_END = 488 * MiB;
constexpr int CW_BAR = 4096;

constexpr int RING_OFF = 0, RING_BYTES = 131072;
constexpr int LDSCTL_OFF = 147456, MISC_OFF = LDSCTL_OFF + 320;
constexpr int LDS_BYTES = 148480;
#define GAS __attribute__((address_space(1)))
#define LAS __attribute__((address_space(3)))
typedef unsigned short bf16;
typedef unsigned v4u __attribute__((ext_vector_type(4)));
typedef float f32x4 __attribute__((ext_vector_type(4)));
typedef short bf16x8 __attribute__((ext_vector_type(8)));
typedef GAS unsigned gu32;
typedef GAS unsigned long long gu64;
#define RLX_AGENT __ATOMIC_RELAXED, __HIP_MEMORY_SCOPE_AGENT
#define LDS_WAIT() asm volatile("s_waitcnt lgkmcnt(0)" ::: "memory")
#define VM_WAIT() asm volatile("s_waitcnt vmcnt(0)" ::: "memory")
__device__ __forceinline__ unsigned long long rt() { return __builtin_amdgcn_s_memrealtime(); }
__device__ __forceinline__ unsigned f2bf(float f) { unsigned u = __builtin_bit_cast(unsigned, f); return (u + 0x7fffu + ((u >> 16) & 1u)) >> 16; }
__device__ __forceinline__ unsigned pk2(float lo, float hi) { return f2bf(lo) | (f2bf(hi) << 16); }

#define XB_TMO      128
#define XB_XCNT(j)  (256  + 64 * (j))
#define XB_XSUB(j)  (1280 + 64 * (j))
#define XB_XGEN(j)  (2304 + 64 * (j))
#define XB_TOP      3328
#define XB_TOPGEN   3392
#define XCD_BAR_WORDS 3456
#define XB_SPIN_CAP (1u << 18)

__device__ __forceinline__ unsigned xb_ld(unsigned* p)              { return __hip_atomic_load(p, __ATOMIC_RELAXED, __HIP_MEMORY_SCOPE_AGENT); }
__device__ __forceinline__ unsigned xb_add(unsigned* p, unsigned v) { return __hip_atomic_fetch_add(p, v, __ATOMIC_RELAXED, __HIP_MEMORY_SCOPE_AGENT); }
__device__ __forceinline__ unsigned xb_xcc_id() { return (unsigned)__builtin_amdgcn_s_getreg((3 << 11) | 20) & 0xFu; }
#define XB_SPIN(cond, bar) do { unsigned _sp = 0; while (cond) { __builtin_amdgcn_s_sleep(1); \
    if ((++_sp & 255u) == 0u) { if (xb_ld(&(bar)[XB_TMO])) break; if (_sp > XB_SPIN_CAP) { atomicAdd(&(bar)[XB_TMO], 1u); break; } } } } while (0)

struct XcdBarrier {
    unsigned* bar; unsigned x;
    volatile LAS unsigned* st;
};

__device__ __forceinline__ XcdBarrier xcd_barrier_post(unsigned* bar, volatile LAS unsigned* st) {
    XcdBarrier b; b.bar = bar; b.x = xb_xcc_id(); b.st = st;
    if (threadIdx.x == 0) st[2] = xb_add(&bar[XB_XCNT(b.x)], 1u);
    return b;
}
__device__ __forceinline__ void xcd_barrier_complete(unsigned* bar, unsigned x, unsigned& nloc, unsigned& nx) {
    const unsigned G = gridDim.x * gridDim.y * gridDim.z;
    unsigned sum, cnt, mine, sp = 0u;
    for (;;) {
        sum = 0u; cnt = 0u; mine = 0u;
#pragma unroll
        for (unsigned j = 0; j < 16; ++j) { const unsigned c = xb_ld(&bar[XB_XCNT(j)]); sum += c; cnt += (c > 0u) ? 1u : 0u; mine = (j == x) ? c : mine; }
        if (sum == G) break;
        __builtin_amdgcn_s_sleep(1);
        if ((++sp & 255u) == 0u) { if (xb_ld(&bar[XB_TMO])) break; if (sp > XB_SPIN_CAP) { atomicAdd(&bar[XB_TMO], 1u); break; } }
    }
    nloc = mine > 0u ? mine : 1u; nx = cnt > 0u ? cnt : 1u;
}

__device__ __forceinline__ void xcd_barrier(const XcdBarrier& b) {
    asm volatile("s_waitcnt vmcnt(0)" ::: "memory");
    __syncthreads();
    if (threadIdx.x == 0) {
        unsigned* bar = b.bar;
        __builtin_amdgcn_s_waitcnt(0);
        unsigned nloc = b.st[0], nx = b.st[1];
        if (nloc == 0u) { xcd_barrier_complete(bar, b.x, nloc, nx); b.st[0] = nloc; b.st[1] = nx; }
        const unsigned old = xb_add(&bar[XB_XSUB(b.x)], 1u);
        const unsigned gen = old / nloc;
        if (old + 1u == (gen + 1u) * nloc) {
            __builtin_amdgcn_fence(__ATOMIC_RELEASE, "agent");
            asm volatile("s_waitcnt vmcnt(0)" ::: "memory");
            const unsigned og = xb_add(&bar[XB_TOP], 1u);
            const unsigned tg = og / nx;
            if (og + 1u == (tg + 1u) * nx) xb_add(&bar[XB_TOPGEN], 1u);
            else XB_SPIN(xb_ld(&bar[XB_TOPGEN]) == tg, bar);
            __builtin_amdgcn_fence(__ATOMIC_ACQUIRE, "agent");
            xb_add(&bar[XB_XGEN(b.x)], 1u);
            asm volatile("s_waitcnt vmcnt(0)" ::: "memory");
        } else {
            XB_SPIN(xb_ld(&bar[XB_XGEN(b.x)]) == gen, bar);
            __builtin_amdgcn_fence(__ATOMIC_ACQUIRE, "agent");
            asm volatile("s_waitcnt vmcnt(0)" ::: "memory");
        }
    }
    __syncthreads();
}

typedef float f32x16 __attribute__((ext_vector_type(16)));
typedef unsigned v2u __attribute__((ext_vector_type(2)));
typedef int v4i __attribute__((ext_vector_type(4)));
typedef __bf16 bf2_t __attribute__((ext_vector_type(2)));
#define DI __device__ __forceinline__
struct Frame {
    LAS unsigned char* lds;
    volatile LAS unsigned* MISC;
    gu32* ctl;
    int tid, lane, wave, vcu, G;
    const float *x, *norm_mix, *norm_ffn, *w_in, *b_gate, *w_conv, *q_norm, *k_norm, *sinks, *rel_bias, *w_conv_out, *w_attn_out, *w_out, *w_query, *sub_keys, *expert_u, *expert_v;
    float* out;
    unsigned char* WG8; bf16 *WIN, *WC, *WA, *WO, *WQ, *SK, *UB, *VB, *XB, *PA, *MIX, *G_, *QP, *Z, *ATT;
    float *RSTD1, *SSQ, *GATE, *ACT, *SU, *SV; bf16* PARTB; unsigned char* XB8; unsigned short* IDX;
};
DI float wave_sum(float v) {
#pragma unroll
    for (int o = 1; o < 64; o <<= 1) v += __shfl_xor(v, o);
    return v;
}
DI float bf_lo(unsigned u) { return __builtin_bit_cast(float, u << 16); }
DI float bf_hi(unsigned u) { return __builtin_bit_cast(float, u & 0xffff0000u); }

constexpr float WG_SCALE = 32.f;
DI void p0_transpose_item(const float* W, int K, int N, bf16* WT, const float* gsc, LAS float* scr, int item, int lane, int n8 = 1 << 30, unsigned char* W8 = nullptr) {
    const int nblk = N / 32, kb = item / nblk, nb = item % nblk, k0 = 64 * kb, n0 = 32 * nb;
#pragma unroll 8
    for (int i = 0; i < 32; ++i) { const int kk = 2 * i + (lane >> 5); float v = W[(size_t)(k0 + kk) * N + n0 + (lane & 31)]; if (gsc) v *= gsc[k0 + kk]; scr[kk * 33 + (lane & 31)] = v; }
    LDS_WAIT(); asm volatile("" ::: "memory");
    const int c = lane & 7;
#pragma unroll
    for (int j = 0; j < 4; ++j) { const int n = (lane >> 3) + 8 * j; const LAS float* s = scr + (8 * c) * 33 + n;
        if (n0 >= n8) {
            int p0_ = 0, p1_ = 0;
            p0_ = __builtin_amdgcn_cvt_pk_fp8_f32(s[0 * 33] * WG_SCALE, s[1 * 33] * WG_SCALE, p0_, false); p0_ = __builtin_amdgcn_cvt_pk_fp8_f32(s[2 * 33] * WG_SCALE, s[3 * 33] * WG_SCALE, p0_, true);
            p1_ = __builtin_amdgcn_cvt_pk_fp8_f32(s[4 * 33] * WG_SCALE, s[5 * 33] * WG_SCALE, p1_, false); p1_ = __builtin_amdgcn_cvt_pk_fp8_f32(s[6 * 33] * WG_SCALE, s[7 * 33] * WG_SCALE, p1_, true);
            v2u o8; o8.x = (unsigned)p0_; o8.y = (unsigned)p1_; *(GAS v2u*)(W8 + (size_t)(n0 + n - n8) * K + k0 + 8 * c) = o8; continue; }
        v4u o; o.x = pk2(s[0 * 33], s[1 * 33]); o.y = pk2(s[2 * 33], s[3 * 33]); o.z = pk2(s[4 * 33], s[5 * 33]); o.w = pk2(s[6 * 33], s[7 * 33]);
        *(GAS v4u*)(WT + (size_t)(n0 + n) * K + k0 + 8 * c) = o; }
    LDS_WAIT(); asm volatile("" ::: "memory");
}
DI void p0_convert(Frame& F, const float* src, bf16* dst, size_t n, const float* colscale) {
    const size_t n8 = n / 8, stride = (size_t)F.G * NWAVES * 64;
    for (size_t i = (size_t)F.vcu * NWAVES * 64 + F.tid; i < n8; i += stride) {
        f32x4 a = *(const GAS f32x4*)(src + i * 8), b = *(const GAS f32x4*)(src + i * 8 + 4);
        if (colscale) { const int c = (int)((i * 8) & 1023); const f32x4 s0 = *(const GAS f32x4*)(colscale + c), s1 = *(const GAS f32x4*)(colscale + c + 4); a = a * s0; b = b * s1; }
        v4u o; o.x = pk2(a.x, a.y); o.y = pk2(a.z, a.w); o.z = pk2(b.x, b.y); o.w = pk2(b.z, b.w);
        *(GAS v4u*)(dst + i * 8) = o;
    }
}
constexpr float A_SCALE = 128.f;
DI unsigned pk4_fp8(f32x4 v) { int r = 0; r = __builtin_amdgcn_cvt_pk_fp8_f32(v[0], v[1], r, false); r = __builtin_amdgcn_cvt_pk_fp8_f32(v[2], v[3], r, true); return (unsigned)r; }
DI void p0_convert_fp8(Frame& F, const float* src, unsigned char* dst, size_t n, const float* colscale, float scale, int bidx, int nblk) {
    const int gw = bidx * NWAVES + F.wave, NGW = nblk * NWAVES, lane = F.lane;
    f32x4 cs[4];
#pragma unroll
    for (int q = 0; q < 4; ++q) cs[q] = colscale ? *(const GAS f32x4*)(colscale + 4 * lane + 256 * q) * scale : (f32x4){scale, scale, scale, scale};
    const int nrows = (int)(n / D);
    for (int e = gw; e < nrows; e += NGW) {
        const GAS f32x4* rp = (const GAS f32x4*)(src + (size_t)e * D) + lane;
        f32x4 v[4];
#pragma unroll
        for (int q = 0; q < 4; ++q) v[q] = rp[64 * q];
#pragma unroll
        for (int q = 0; q < 4; ++q) *(GAS unsigned*)(dst + ((size_t)(2 * q + (lane >> 5)) * NEXP + e) * 128 + ((4 * lane) & 127)) = pk4_fp8(v[q] * cs[q]);
    }
}
DI void p0_convert_fp4(Frame& F, const float* src, const float* gain, unsigned char* dst, float* scl, int e0, int e1) {
    const int gw = F.wave, NGW = NWAVES, lane = F.lane;
    f32x4 cs[4];
#pragma unroll
    for (int q = 0; q < 4; ++q) cs[q] = gain ? *(const GAS f32x4*)(gain + 4 * lane + 256 * q) : (f32x4){1.f, 1.f, 1.f, 1.f};
    for (int e = e0 + gw; e < e1; e += NGW) {
        const GAS f32x4* rp = (const GAS f32x4*)(src + (size_t)e * D) + lane;
        f32x4 v[4]; float mx = 0.f;
#pragma unroll
        for (int q = 0; q < 4; ++q) { v[q] = rp[64 * q] * cs[q]; mx = fmaxf(mx, fmaxf(fmaxf(fabsf(v[q][0]), fabsf(v[q][1])), fmaxf(fabsf(v[q][2]), fabsf(v[q][3])))); }
#pragma unroll
        for (int o = 1; o < 64; o <<= 1) mx = fmaxf(mx, __shfl_xor(mx, o));
        const float inv = mx > 0.f ? 6.f / mx : 0.f;
        if (lane == 0) scl[e] = mx * (1.f / 6.f);
#pragma unroll
        for (int q = 0; q < 4; ++q) { unsigned r = 0u;
            r = __builtin_amdgcn_cvt_scalef32_pk_fp4_f32(r, v[q][0] * inv, v[q][1] * inv, 1.0f, 0);
            r = __builtin_amdgcn_cvt_scalef32_pk_fp4_f32(r, v[q][2] * inv, v[q][3] * inv, 1.0f, 1);
            *(GAS unsigned short*)(dst + ((size_t)q * NEXP + e) * 128 + 2 * lane) = (unsigned short)r; }
    }
}
template <int RB> DI void p0_rows(Frame& F, const float* xrow, bf16* orow, float* rms_out, unsigned char* o8row) {
    f32x4 v[RB][4]; float s[RB];
#pragma unroll
    for (int r = 0; r < RB; ++r) { const GAS f32x4* xr = (const GAS f32x4*)(xrow + (size_t)r * D) + F.lane;
#pragma unroll
        for (int j = 0; j < 4; ++j) v[r][j] = xr[64 * j]; }
#pragma unroll
    for (int r = 0; r < RB; ++r) { s[r] = 0.f;
#pragma unroll
        for (int j = 0; j < 4; ++j) s[r] += (v[r][j].x * v[r][j].x + v[r][j].y * v[r][j].y) + (v[r][j].z * v[r][j].z + v[r][j].w * v[r][j].w); }
#pragma unroll
    for (int o = 1; o < 64; o <<= 1)
#pragma unroll
        for (int r = 0; r < RB; ++r) s[r] += __shfl_xor(s[r], o);
#pragma unroll
    for (int r = 0; r < RB; ++r) { const float rms = sqrtf(s[r] * (1.f / D) + EPS), rs = 1.f / rms; if (F.lane == 0) rms_out[r] = rms;
        GAS unsigned long long* o8 = (GAS unsigned long long*)(orow + (size_t)r * D) + F.lane;
#pragma unroll
        for (int j = 0; j < 4; ++j) { o8[64 * j] = (unsigned long long)pk2(v[r][j].x * rs, v[r][j].y * rs) | ((unsigned long long)pk2(v[r][j].z * rs, v[r][j].w * rs) << 32);
            *(GAS unsigned*)(o8row + (size_t)r * D + 4 * F.lane + 256 * j) = pk4_fp8(v[r][j] * rs); } }
}
DI void p0_prologue(Frame& F) {
    LAS float* scr = (LAS float*)(F.lds + RING_OFF + F.wave * 16384);
    const int gw = F.vcu * NWAVES + F.wave, NGW = F.G * NWAVES;
    constexpr int I_IN = (D / 64) * (IN_DIM / 32), I_C = (CONV / 64) * (D / 32), I_O = (D / 64) * (D / 32), I_Q = (D / 64) * (PQ / 32);
    constexpr int NITEMS = I_IN + 2 * I_C + I_O + I_Q;
    for (int it = gw; it < NITEMS; it += NGW) {
        int r = it;
        if (r < I_IN) { p0_transpose_item(F.w_in, D, IN_DIM, F.WIN, F.norm_mix, scr, r, F.lane, N16, F.WG8); continue; } r -= I_IN;
        if (r < I_C) { p0_transpose_item(F.w_conv_out, CONV, D, F.WC, nullptr, scr, r, F.lane); continue; } r -= I_C;
        if (r < I_C) { p0_transpose_item(F.w_attn_out, CONV, D, F.WA, nullptr, scr, r, F.lane); continue; } r -= I_C;
        if (r < I_O) { p0_transpose_item(F.w_out, D, D, F.WO, nullptr, scr, r, F.lane); continue; } r -= I_O;
        p0_transpose_item(F.w_query, D, PQ, F.WQ, F.norm_ffn, scr, r, F.lane);
    }
    p0_convert(F, F.sub_keys, F.SK, (size_t)PH * 2 * NKEYS * 128, nullptr);
    for (int m = 4 * gw; m < T; m += 4 * NGW) p0_rows<4>(F, F.x + (size_t)m * D, F.XB + (size_t)m * D, F.RSTD1 + m, F.XB8 + (size_t)m * D);
}

namespace pg8 {
DI float sigmoidf_(float v) { return __builtin_amdgcn_rcpf(1.f + __expf(-v)); }
DI size_t frag_off(int pm, int pn, int NT, int wave, int q, int lane) { return (((((size_t)pm * NT + pn) * 8 + wave) * 16 + q) * 64 + lane) * 8; }
struct EpiProj {
    static constexpr bool PERM = true, AFTER_DRAIN = false, HAS_INIT = false, CARRY = false;
    bf16_t* PA; bf16_t* G; const PG8_LAS float* bgl; int pa_col0, pn_gate0; float gsc;
    DI void operator()(const f32x4 (&acc)[2][2][4][2], const Unit& u, int wr, int wc, int fr, int fq) const {
        const int row0 = u.pm * BM + wr * 64 + fr; const bool gate = u.pn >= pn_gate0;
        const int col0 = (gate ? (u.pn - pn_gate0) * BM : pa_col0 + u.pn * BM) + wc * 32 + 8 * fq;
        if (!gate) {
#pragma unroll
            for (int ai = 0; ai < 2; ++ai)
#pragma unroll
                for (int m = 0; m < 4; ++m) { bf16_t* rowp = PA + (size_t)(row0 + ai * HALF + m * 16) * PA_W + col0;
#pragma unroll
                    for (int bj = 0; bj < 2; ++bj) { const f32x4 v0 = acc[ai][bj][m][0] * gsc, v1 = acc[ai][bj][m][1] * gsc;
                        u32x4 w; w.x = cvt_pk_bf16(v0[0], v0[1]); w.y = cvt_pk_bf16(v0[2], v0[3]); w.z = cvt_pk_bf16(v1[0], v1[1]); w.w = cvt_pk_bf16(v1[2], v1[3]);
                        store16_wt(rowp + bj * HALF, w); } }
        } else {
            f32x4 bv[2][2];
#pragma unroll
            for (int bj = 0; bj < 2; ++bj)
#pragma unroll
                for (int n = 0; n < 2; ++n) bv[bj][n] = *(const PG8_LAS f32x4*)(bgl + col0 + bj * HALF + 4 * n);
#pragma unroll
            for (int ai = 0; ai < 2; ++ai)
#pragma unroll
                for (int m = 0; m < 4; ++m)
#pragma unroll
                    for (int bj = 0; bj < 2; ++bj) { f32x4 v0 = acc[ai][bj][m][0] * gsc + bv[bj][0], v1 = acc[ai][bj][m][1] * gsc + bv[bj][1];
#pragma unroll
                        for (int j = 0; j < 4; ++j) { v0[j] = fmaxf(sigmoidf_(v0[j]) * 255.f, 1.f); v1[j] = fmaxf(sigmoidf_(v1[j]) * 255.f, 1.f); }
                        unsigned g0 = 0u, g1 = 0u;
                        g0 = __builtin_amdgcn_cvt_pk_u8_f32(v0[0], 0, g0); g0 = __builtin_amdgcn_cvt_pk_u8_f32(v0[1], 1, g0); g0 = __builtin_amdgcn_cvt_pk_u8_f32(v0[2], 2, g0); g0 = __builtin_amdgcn_cvt_pk_u8_f32(v0[3], 3, g0);
                        g1 = __builtin_amdgcn_cvt_pk_u8_f32(v1[0], 0, g1); g1 = __builtin_amdgcn_cvt_pk_u8_f32(v1[1], 1, g1); g1 = __builtin_amdgcn_cvt_pk_u8_f32(v1[2], 2, g1); g1 = __builtin_amdgcn_cvt_pk_u8_f32(v1[3], 3, g1);
                        u32x2 gw; gw.x = g0; gw.y = g1;
                        *(u32x2*)((unsigned char*)G + frag_off(u.pm, u.pn - pn_gate0, 8, wr * 4 + wc, ai * 8 + m * 2 + bj, fq * 16 + fr)) = gw; }
        }
    }
};
struct EpiMix {
    static constexpr bool PERM = true, AFTER_DRAIN = false, HAS_INIT = false, CARRY = true;
    bf16_t* MIX; const bf16_t* G;
    DI void operator()(f32x4 (&acc)[2][2][4][2], const Unit& u, int wr, int wc, int fr, int fq) const {
        const int wave = wr * 4 + wc, lane = fq * 16 + fr;
        const unsigned char* gc = (const unsigned char*)G + frag_off(u.pm, u.pn, 8, wave, 0, lane); const unsigned char* ga = (const unsigned char*)G + frag_off(u.pm, u.pn + 4, 8, wave, 0, lane);
        bf16_t* mp = MIX + frag_off(u.pm, u.pn, 4, wave, 0, lane);
#pragma unroll
        for (int ai = 0; ai < 2; ++ai) {
            u32x2 gav[8], gcv[8];
#pragma unroll
            for (int q = 0; q < 8; ++q) gav[q] = *(const u32x2*)(ga + (ai * 8 + q) * 512);
            if (!u.which) {
#pragma unroll
                for (int q = 0; q < 8; ++q) gcv[q] = *(const u32x2*)(gc + (ai * 8 + q) * 512); }
#pragma unroll
            for (int m = 0; m < 4; ++m)
#pragma unroll
                for (int bj = 0; bj < 2; ++bj) { const int q = m * 2 + bj; const u32x2 a2 = gav[q];
                    float fa[8] = {(float)(a2.x & 0xffu), (float)((a2.x >> 8) & 0xffu), (float)((a2.x >> 16) & 0xffu), (float)(a2.x >> 24), (float)(a2.y & 0xffu), (float)((a2.y >> 8) & 0xffu), (float)((a2.y >> 16) & 0xffu), (float)(a2.y >> 24)};
                    if (!u.which) { const u32x2 c2 = gcv[q];
                        const float fc[8] = {(float)(c2.x & 0xffu), (float)((c2.x >> 8) & 0xffu), (float)((c2.x >> 16) & 0xffu), (float)(c2.x >> 24), (float)(c2.y & 0xffu), (float)((c2.y >> 8) & 0xffu), (float)((c2.y >> 16) & 0xffu), (float)(c2.y >> 24)};
#pragma unroll
                        for (int e = 0; e < 4; ++e) { acc[ai][bj][m][0][e] *= fc[e] * __builtin_amdgcn_rcpf(fa[e]); acc[ai][bj][m][1][e] *= fc[4 + e] * __builtin_amdgcn_rcpf(fa[4 + e]); }
                    } else { constexpr float GI = 1.f / 255.f;
                        const f32x4 v0 = acc[ai][bj][m][0], v1 = acc[ai][bj][m][1];
                        u32x4 w; w.x = cvt_pk_bf16(v0[0] * fa[0] * GI, v0[1] * fa[1] * GI); w.y = cvt_pk_bf16(v0[2] * fa[2] * GI, v0[3] * fa[3] * GI);
                        w.z = cvt_pk_bf16(v1[0] * fa[4] * GI, v1[1] * fa[5] * GI); w.w = cvt_pk_bf16(v1[2] * fa[6] * GI, v1[3] * fa[7] * GI);
                        store16_wt(mp + (ai * 8 + q) * 512, w); } }
        }
    }
};
struct FragOrder : StaticOrder { static constexpr bool AFRAG = true; };
struct PairOrder : StaticOrder {
    __device__ bool next(int i, Unit& u) const { const bool ok = StaticOrder::next(i >> 1, u); u.which = i & 1; return ok; }
    DI const char* a_base(const Gemm& g, const Unit& u, size_t tstep) const { return (const char*)(u.which ? g.A2 : g.A) + (size_t)u.pm * tstep; }
    DI const char* b_base(const Gemm& g, const Unit& u, size_t tstep) const { return (const char*)(u.which ? g.Bt2 : g.Bt) + (size_t)u.pn * tstep; }
};
struct EpiX1 {
    static constexpr bool PERM = true, AFTER_DRAIN = false, HAS_INIT = true, CARRY = false;
    const float* RMS; bf16_t* XB; float* SSQ; unsigned char* XB8;
    DI void init(f32x4 (&acc)[2][2][4][2], const Unit& u, int wr, int wc, int fr, int fq) const {
        const int row0 = u.pm * BM + wr * 64 + fr, col0 = u.pn * BM + wc * 32 + 8 * fq;
#pragma unroll
        for (int ai = 0; ai < 2; ++ai)
#pragma unroll
            for (int m = 0; m < 4; ++m)
#pragma unroll
                for (int bj = 0; bj < 2; ++bj) { const int row = row0 + ai * HALF + m * 16; const float rm = RMS[row];
                    const u32x4 xn = *(const u32x4*)(XB + (size_t)row * D + col0 + bj * HALF);
                    acc[ai][bj][m][0] = (f32x4){__builtin_bit_cast(float, xn.x << 16), __builtin_bit_cast(float, xn.x & 0xffff0000u), __builtin_bit_cast(float, xn.y << 16), __builtin_bit_cast(float, xn.y & 0xffff0000u)} * rm;
                    acc[ai][bj][m][1] = (f32x4){__builtin_bit_cast(float, xn.z << 16), __builtin_bit_cast(float, xn.z & 0xffff0000u), __builtin_bit_cast(float, xn.w << 16), __builtin_bit_cast(float, xn.w & 0xffff0000u)} * rm; }
    }
    DI void operator()(const f32x4 (&acc)[2][2][4][2], const Unit& u, int wr, int wc, int fr, int fq) const {
        const int row0 = u.pm * BM + wr * 64 + fr, col0 = u.pn * BM + wc * 32 + 8 * fq;
#pragma unroll
        for (int ai = 0; ai < 2; ++ai)
#pragma unroll
            for (int m = 0; m < 4; ++m) { const int row = row0 + ai * HALF + m * 16; float ss = 0.f;
#pragma unroll
                for (int bj = 0; bj < 2; ++bj) { const f32x4 v0 = acc[ai][bj][m][0], v1 = acc[ai][bj][m][1];
                    ss += ((v0[0] * v0[0] + v0[1] * v0[1]) + (v0[2] * v0[2] + v0[3] * v0[3])) + ((v1[0] * v1[0] + v1[1] * v1[1]) + (v1[2] * v1[2] + v1[3] * v1[3]));
                    u32x4 w; w.x = cvt_pk_bf16(v0[0], v0[1]); w.y = cvt_pk_bf16(v0[2], v0[3]); w.z = cvt_pk_bf16(v1[0], v1[1]); w.w = cvt_pk_bf16(v1[2], v1[3]);
                    store16_wt(XB + (size_t)row * D + col0 + bj * HALF, w);
                    { int p0_ = 0, p1_ = 0;
                      p0_ = __builtin_amdgcn_cvt_pk_fp8_f32(v0[0], v0[1], p0_, false); p0_ = __builtin_amdgcn_cvt_pk_fp8_f32(v0[2], v0[3], p0_, true);
                      p1_ = __builtin_amdgcn_cvt_pk_fp8_f32(v1[0], v1[1], p1_, false); p1_ = __builtin_amdgcn_cvt_pk_fp8_f32(v1[2], v1[3], p1_, true);
                      u32x2 w8; w8.x = (unsigned)p0_; w8.y = (unsigned)p1_; *(u32x2*)(XB8 + (size_t)row * D + col0 + bj * HALF) = w8; } }
                ss += __shfl_xor(ss, 16); ss += __shfl_xor(ss, 32);
                if (fq == 0) SSQ[(size_t)row * 16 + u.pn * 4 + wc] = ss; }
    }
};
DI float rstd2_of(const float* SSQ, int row) {
    const f32x4 a = *(const f32x4*)(SSQ + (size_t)row * 16), b = *(const f32x4*)(SSQ + (size_t)row * 16 + 4), c = *(const f32x4*)(SSQ + (size_t)row * 16 + 8), d = *(const f32x4*)(SSQ + (size_t)row * 16 + 12);
    const float s = ((a[0] + a[1]) + (a[2] + a[3])) + ((b[0] + b[1]) + (b[2] + b[3])) + ((c[0] + c[1]) + (c[2] + c[3])) + ((d[0] + d[1]) + (d[2] + d[3]));
    return 1.f / sqrtf(s * (1.f / D) + EPS);
}
struct EpiQP {
    static constexpr bool PERM = true, AFTER_DRAIN = false, HAS_INIT = false, CARRY = false;
    bf16_t* QP;
    DI void operator()(const f32x4 (&acc)[2][2][4][2], const Unit& u, int wr, int wc, int fr, int fq) const {
        const int row0 = u.pm * BM + wr * 64 + fr, col0 = u.pn * BM + wc * 32 + 8 * fq;
#pragma unroll
        for (int ai = 0; ai < 2; ++ai)
#pragma unroll
            for (int m = 0; m < 4; ++m) {
#pragma unroll
                for (int bj = 0; bj < 2; ++bj) { const f32x4 v0 = acc[ai][bj][m][0], v1 = acc[ai][bj][m][1];
                    u32x4 w; w.x = cvt_pk_bf16(v0[0], v0[1]); w.y = cvt_pk_bf16(v0[2], v0[3]); w.z = cvt_pk_bf16(v1[0], v1[1]); w.w = cvt_pk_bf16(v1[2], v1[3]);
                    *(u32x4*)(QP + frag_off(u.pm, u.pn, 8, wr * 4 + wc, ai * 8 + m * 2 + bj, fq * 16 + fr)) = w; } }
    }
};
}

#define MFMA32(a, b, c) __builtin_amdgcn_mfma_f32_32x32x16_bf16((a), (b), (c), 0, 0, 0)
DI void p2_conv(Frame& F) {
    constexpr int CT = 4;
    const size_t NT_ = (size_t)F.G * NWAVES * 64;
    for (size_t item = (size_t)F.vcu * NWAVES * 64 + F.tid; item < (size_t)(T / CT) * 64; item += NT_) {
        const int tb = (int)(item >> 6) * CT, c0 = (int)(item & 63) * 8, tl = tb & (SEQ - 1);
        v4u cg[CT + 2], uu[CT + 2], bg[CT];
#pragma unroll
        for (int r = 0; r < CT + 2; ++r) { const bool ok = (tl + r - 2) >= 0; const bf16* rowp = F.PA + (size_t)(tb + (ok ? r - 2 : 0)) * PA_W;
            cg[r] = *(const GAS v4u*)(rowp + C_C + c0); uu[r] = *(const GAS v4u*)(rowp + C_U + c0);
            if (!ok) { cg[r] = (v4u){0u, 0u, 0u, 0u}; } }
#pragma unroll
        for (int r = 0; r < CT; ++r) bg[r] = *(const GAS v4u*)(F.PA + (size_t)(tb + r) * PA_W + C_B + c0);
        f32x4 w[3][2];
#pragma unroll
        for (int j = 0; j < 3; ++j) { w[j][0] = *(const GAS f32x4*)(F.w_conv + j * CONV + c0); w[j][1] = *(const GAS f32x4*)(F.w_conv + j * CONV + c0 + 4); }
        float h[CT + 2][8];
#pragma unroll
        for (int r = 0; r < CT + 2; ++r) { h[r][0] = bf_lo(cg[r].x) * bf_lo(uu[r].x); h[r][1] = bf_hi(cg[r].x) * bf_hi(uu[r].x); h[r][2] = bf_lo(cg[r].y) * bf_lo(uu[r].y); h[r][3] = bf_hi(cg[r].y) * bf_hi(uu[r].y);
            h[r][4] = bf_lo(cg[r].z) * bf_lo(uu[r].z); h[r][5] = bf_hi(cg[r].z) * bf_hi(uu[r].z); h[r][6] = bf_lo(cg[r].w) * bf_lo(uu[r].w); h[r][7] = bf_hi(cg[r].w) * bf_hi(uu[r].w); }
#pragma unroll
        for (int r = 0; r < CT; ++r) {
            float a[8];
#pragma unroll
            for (int e = 0; e < 8; ++e) a[e] = w[0][e >> 2][e & 3] * h[r][e] + w[1][e >> 2][e & 3] * h[r + 1][e] + w[2][e >> 2][e & 3] * h[r + 2][e];
            v4u o; o.x = pk2(a[0] * bf_lo(bg[r].x), a[1] * bf_hi(bg[r].x)); o.y = pk2(a[2] * bf_lo(bg[r].y), a[3] * bf_hi(bg[r].y));
            o.z = pk2(a[4] * bf_lo(bg[r].z), a[5] * bf_hi(bg[r].z)); o.w = pk2(a[6] * bf_lo(bg[r].w), a[7] * bf_hi(bg[r].w));
            *(GAS v4u*)(F.Z + (size_t)(tb + r) * CONV + c0) = o;
        }
    }
}
DI int t5_bucket(int d) {
    if (d < 16) return d;
    const int large = 16 + (int)(logf((float)d / 16.f) / logf(8.f) * 16.f);
    return large < 31 ? large : 31;
}
constexpr int KS_STRIDE = 72, VT_STRIDE = 264;
constexpr int ATT_KS = 0, ATT_VT = 256 * KS_STRIDE * 2, ATT_BIAS = ATT_VT + 64 * VT_STRIDE * 2, ATT_END = ATT_BIAS + 4 * 128 * 4;
static_assert(ATT_END <= RING_BYTES, "attention LDS");
DI void p2_attention(Frame& F) {
    LAS bf16* KS = (LAS bf16*)(F.lds + ATT_KS); LAS bf16* VT = (LAS bf16*)(F.lds + ATT_VT); LAS float* BIAS = (LAS float*)(F.lds + ATT_BIAS);
    const int lane = F.lane, r = lane & 31, hh = lane >> 5;
#pragma unroll 1
    for (int unit = F.vcu; unit < 8 * 32 * NKV; unit += F.G) {
        const int kv = unit & 1, n = (unit >> 1) & 31, b = unit >> 6;
        const int t0 = b * SEQ + n * 128;
        __syncthreads();
        {
            const int j = F.tid >> 1, hf = F.tid & 1; const bool valid = (n > 0) || (j >= 128);
            const bf16* rowp = F.PA + (size_t)(t0 - 128 + j) * PA_W;
            v4u kq[4], vq[4];
#pragma unroll
            for (int i = 0; i < 4; ++i) { kq[i] = (v4u){0u, 0u, 0u, 0u}; vq[i] = kq[i]; }
            if (valid) {
#pragma unroll
                for (int i = 0; i < 4; ++i) { kq[i] = *(const GAS v4u*)(rowp + C_K + kv * HD + hf * 32 + i * 8); vq[i] = *(const GAS v4u*)(rowp + C_V + kv * HD + hf * 32 + i * 8); }
            }
            float kf[32]; float ss = 0.f;
#pragma unroll
            for (int i = 0; i < 4; ++i) { kf[8 * i + 0] = bf_lo(kq[i].x); kf[8 * i + 1] = bf_hi(kq[i].x); kf[8 * i + 2] = bf_lo(kq[i].y); kf[8 * i + 3] = bf_hi(kq[i].y);
                kf[8 * i + 4] = bf_lo(kq[i].z); kf[8 * i + 5] = bf_hi(kq[i].z); kf[8 * i + 6] = bf_lo(kq[i].w); kf[8 * i + 7] = bf_hi(kq[i].w); }
#pragma unroll
            for (int e = 0; e < 32; ++e) ss += kf[e] * kf[e];
            ss += __shfl_xor(ss, 1);
            const float rs = 1.f / sqrtf(ss * (1.f / HD) + EPS);
#pragma unroll
            for (int i = 0; i < 4; ++i) { const f32x4 g0 = *(const GAS f32x4*)(F.k_norm + hf * 32 + 8 * i), g1 = *(const GAS f32x4*)(F.k_norm + hf * 32 + 8 * i + 4);
                v4u o; o.x = pk2(kf[8 * i + 0] * rs * g0[0], kf[8 * i + 1] * rs * g0[1]); o.y = pk2(kf[8 * i + 2] * rs * g0[2], kf[8 * i + 3] * rs * g0[3]);
                o.z = pk2(kf[8 * i + 4] * rs * g1[0], kf[8 * i + 5] * rs * g1[1]); o.w = pk2(kf[8 * i + 6] * rs * g1[2], kf[8 * i + 7] * rs * g1[3]);
                *(LAS v4u*)(KS + j * KS_STRIDE + hf * 32 + 8 * i) = o; }
#pragma unroll
            for (int i = 0; i < 4; ++i) { const int d0 = hf * 32 + 8 * i;
                VT[(d0 + 0) * VT_STRIDE + j] = (bf16)(vq[i].x & 0xffffu); VT[(d0 + 1) * VT_STRIDE + j] = (bf16)(vq[i].x >> 16);
                VT[(d0 + 2) * VT_STRIDE + j] = (bf16)(vq[i].y & 0xffffu); VT[(d0 + 3) * VT_STRIDE + j] = (bf16)(vq[i].y >> 16);
                VT[(d0 + 4) * VT_STRIDE + j] = (bf16)(vq[i].z & 0xffffu); VT[(d0 + 5) * VT_STRIDE + j] = (bf16)(vq[i].z >> 16);
                VT[(d0 + 6) * VT_STRIDE + j] = (bf16)(vq[i].w & 0xffffu); VT[(d0 + 7) * VT_STRIDE + j] = (bf16)(vq[i].w >> 16); }
            { const int g = F.tid >> 7, dist = F.tid & 127; BIAS[F.tid] = F.rel_bias[t5_bucket(dist) * NH + kv * 4 + g]; }
        }
        __syncthreads();
#pragma unroll 1
        for (int task = F.wave; task < 16; task += NWAVES) {
            const int g = task >> 2, c = task & 3, head = kv * 4 + g, r0 = 32 * c;
            bf16x8 qf[4];
            {
                const bf16* qp = F.PA + (size_t)(t0 + r0 + r) * PA_W + C_Q + head * HD + 8 * hh;
                v4u qq[4]; float qv[32]; float ss = 0.f;
#pragma unroll
                for (int s = 0; s < 4; ++s) qq[s] = *(const GAS v4u*)(qp + 16 * s);
#pragma unroll
                for (int s = 0; s < 4; ++s) { qv[8 * s + 0] = bf_lo(qq[s].x); qv[8 * s + 1] = bf_hi(qq[s].x); qv[8 * s + 2] = bf_lo(qq[s].y); qv[8 * s + 3] = bf_hi(qq[s].y);
                    qv[8 * s + 4] = bf_lo(qq[s].z); qv[8 * s + 5] = bf_hi(qq[s].z); qv[8 * s + 6] = bf_lo(qq[s].w); qv[8 * s + 7] = bf_hi(qq[s].w); }
#pragma unroll
                for (int e = 0; e < 32; ++e) ss += qv[e] * qv[e];
                ss += __shfl_xor(ss, 32);
                const float rs = 0.125f / sqrtf(ss * (1.f / HD) + EPS);
#pragma unroll
                for (int s = 0; s < 4; ++s) { const f32x4 g0 = *(const GAS f32x4*)(F.q_norm + 16 * s + 8 * hh), g1 = *(const GAS f32x4*)(F.q_norm + 16 * s + 8 * hh + 4);
                    v4u o; o.x = pk2(qv[8 * s + 0] * rs * g0[0], qv[8 * s + 1] * rs * g0[1]); o.y = pk2(qv[8 * s + 2] * rs * g0[2], qv[8 * s + 3] * rs * g0[3]);
                    o.z = pk2(qv[8 * s + 4] * rs * g1[0], qv[8 * s + 5] * rs * g1[1]); o.w = pk2(qv[8 * s + 6] * rs * g1[2], qv[8 * s + 7] * rs * g1[3]);
                    qf[s] = __builtin_bit_cast(bf16x8, o); }
            }
            f32x16 sacc[5];
#pragma unroll
            for (int i5 = 0; i5 < 5; ++i5) {
#pragma unroll
                for (int e = 0; e < 16; ++e) sacc[i5][e] = 0.f;
                const int kt = c + i5;
#pragma unroll
                for (int s = 0; s < 4; ++s) { const bf16x8 ka = *(const LAS bf16x8*)(KS + (32 * kt + r) * KS_STRIDE + 16 * s + 8 * hh); sacc[i5] = MFMA32(ka, qf[s], sacc[i5]); }
            }
            const float sink = F.sinks[head];
            const int dbase = r - 4 * hh + 128;
            const LAS float* bl = BIAS + g * 128;
            float mx = sink;
#pragma unroll
            for (int i5 = 0; i5 < 5; ++i5) {
                const bool tile_ok = (n > 0) || (c + i5 >= 4);
#pragma unroll
                for (int e = 0; e < 16; ++e) { const int dist = dbase - 32 * i5 - ((e & 3) + 8 * (e >> 2));
                    bool valid = tile_ok; if (i5 == 0) valid = valid && (dist < 128); if (i5 == 4) valid = valid && (dist >= 0);
                    const float lg = sacc[i5][e] + bl[dist & 127];
                    sacc[i5][e] = valid ? lg : -INFINITY; mx = fmaxf(mx, sacc[i5][e]); }
                __builtin_amdgcn_sched_barrier(0);
            }
            mx = fmaxf(mx, __shfl_xor(mx, 32));
            float sum = 0.f;
#pragma unroll
            for (int i5 = 0; i5 < 5; ++i5)
#pragma unroll
                for (int e = 0; e < 16; ++e) { const float p = __expf(sacc[i5][e] - mx); sacc[i5][e] = p; sum += p; }
            sum += __shfl_xor(sum, 32);
            const float inv = 1.f / (sum + __expf(sink - mx));
            f32x16 oacc[2];
#pragma unroll
            for (int dt = 0; dt < 2; ++dt)
#pragma unroll
                for (int e = 0; e < 16; ++e) oacc[dt][e] = 0.f;
#pragma unroll
            for (int i5 = 0; i5 < 5; ++i5)
#pragma unroll
                for (int s2 = 0; s2 < 2; ++s2) {
                    v4u pp; pp.x = pk2(sacc[i5][8 * s2 + 0] * inv, sacc[i5][8 * s2 + 1] * inv); pp.y = pk2(sacc[i5][8 * s2 + 2] * inv, sacc[i5][8 * s2 + 3] * inv);
                    pp.z = pk2(sacc[i5][8 * s2 + 4] * inv, sacc[i5][8 * s2 + 5] * inv); pp.w = pk2(sacc[i5][8 * s2 + 6] * inv, sacc[i5][8 * s2 + 7] * inv);
                    const bf16x8 pb = __builtin_bit_cast(bf16x8, pp);
                    const int kb = 32 * (c + i5) + 16 * s2 + 4 * hh;
#pragma unroll
                    for (int dt = 0; dt < 2; ++dt) {
                        const v2u lo = *(const LAS v2u*)(VT + (32 * dt + r) * VT_STRIDE + kb), hi = *(const LAS v2u*)(VT + (32 * dt + r) * VT_STRIDE + kb + 8);
                        v4u va; va.x = lo.x; va.y = lo.y; va.z = hi.x; va.w = hi.y;
                        oacc[dt] = MFMA32(__builtin_bit_cast(bf16x8, va), pb, oacc[dt]);
                    }
                    __builtin_amdgcn_sched_barrier(0);
                }
            bf16* op = F.ATT + (size_t)(t0 + r0 + r) * CONV + head * HD;
#pragma unroll
            for (int dt = 0; dt < 2; ++dt)
#pragma unroll
                for (int g4 = 0; g4 < 4; ++g4) { v2u w; w.x = pk2(oacc[dt][4 * g4 + 0], oacc[dt][4 * g4 + 1]); w.y = pk2(oacc[dt][4 * g4 + 2], oacc[dt][4 * g4 + 3]);
#ifdef ZERO_ATT
                    w.x = 0u; w.y = 0u;
#endif
                    *(GAS v2u*)(op + 32 * dt + 8 * g4 + 4 * hh) = w; }
        }
    }
}

DI unsigned f2ord(float f) { const unsigned b = __builtin_bit_cast(unsigned, f); return b ^ ((b >> 31) ? 0xffffffffu : 0x80000000u); }
DI float ord2f(unsigned k) { const unsigned b = k ^ ((k >> 31) ? 0x80000000u : 0xffffffffu); return __builtin_bit_cast(float, b); }
DI unsigned umax_(unsigned a, unsigned b) { return a > b ? a : b; }
DI unsigned umin_(unsigned a, unsigned b) { return a < b ? a : b; }
DI void sort16_desc(unsigned (&v)[16]) {
#pragma unroll
    for (int k = 2; k <= 16; k <<= 1)
#pragma unroll
        for (int j = k >> 1; j > 0; j >>= 1)
#pragma unroll
            for (int i = 0; i < 16; ++i) { const int l = i ^ j; if (l > i) { const bool desc = ((i & k) == 0) || (k == 16); const unsigned a = v[i], b = v[l], hi = umax_(a, b), lo = umin_(a, b); v[i] = desc ? hi : lo; v[l] = desc ? lo : hi; } }
}
DI void merge_top16(unsigned (&a)[16], const unsigned (&b)[16]) {
#pragma unroll
    for (int i = 0; i < 16; ++i) a[i] = umax_(a[i], b[15 - i]);
#pragma unroll
    for (int j = 8; j > 0; j >>= 1)
#pragma unroll
        for (int i = 0; i < 16; ++i) { const int l = i ^ j; if (l > i) { const unsigned x = a[i], y = a[l]; a[i] = umax_(x, y); a[l] = umin_(x, y); } }
}
constexpr int SK_STRIDE = 136;
constexpr int P6_KEYS = 0, P6_IB = 2 * NKEYS * SK_STRIDE * 2, P6_END = P6_IB + NWAVES * 64 * 32;
static_assert(P6_END <= RING_BYTES, "topk LDS");
DI void p6_topk(Frame& F) {
    LAS bf16* KL = (LAS bf16*)(F.lds + P6_KEYS); LAS unsigned char* IB = F.lds + P6_IB + (F.wave * 64 + F.lane) * 32;
    const int lane = F.lane, r = lane & 31, hh = lane >> 5;
    pg8::StaticOrder S; S.init(T, PQ, F.G, (int)blockIdx.x);
    pg8::Unit pu;
    for (int ui = 0; S.next(ui, pu); ++ui) {
        const int h = pu.pn, tile = pu.pm;
        __syncthreads();
        {
            const bf16* src = F.SK + (size_t)h * 2 * NKEYS * 128;
#pragma unroll
            for (int i = 0; i < 8; ++i) { const int ch = F.tid + 512 * i; const int row = ch >> 4, c8 = (ch & 15) * 8;
                *(LAS v4u*)(KL + row * SK_STRIDE + c8) = *(const GAS v4u*)(src + (size_t)row * 128 + c8); }
        }
        __syncthreads();
        const int t = tile * 256 + F.wave * 32 + r;
        unsigned S[2][16];
#pragma unroll
        for (int p = 0; p < 2; ++p) {
            bf16x8 qf[8];
            const int rt = F.wave * 32 + r, q_ai = rt >> 7, q_wr = (rt >> 6) & 1, q_m = (rt >> 4) & 3, q_fr = rt & 15;
#pragma unroll
            for (int s = 0; s < 8; ++s) qf[s] = __builtin_bit_cast(bf16x8, *(const GAS v4u*)(F.QP + pg8::frag_off(tile, h, 8, q_wr * 4 + (s >> 1), q_ai * 8 + q_m * 2 + p, (2 * (s & 1) + hh) * 16 + q_fr)));
            unsigned key[4][16];
#pragma unroll
            for (int kt = 0; kt < 4; ++kt) {
                f32x16 acc;
#pragma unroll
                for (int e = 0; e < 16; ++e) acc[e] = 0.f;
#pragma unroll
                for (int s = 0; s < 8; ++s) { const bf16x8 ka = *(const LAS bf16x8*)(KL + (p * NKEYS + 32 * kt + r) * SK_STRIDE + 16 * s + 8 * hh); acc = MFMA32(ka, qf[s], acc); }
#pragma unroll
                for (int e = 0; e < 16; ++e) { const int nk = 32 * kt + (e & 3) + 8 * (e >> 2) + 4 * hh; key[kt][e] = (f2ord(acc[e]) & ~127u) | (unsigned)(127 - nk); }
            }
#pragma unroll
            for (int kt = 0; kt < 4; ++kt) sort16_desc(key[kt]);
            merge_top16(key[0], key[1]); merge_top16(key[2], key[3]); merge_top16(key[0], key[2]);
            unsigned other[16];
#pragma unroll
            for (int i = 0; i < 16; ++i) other[i] = (unsigned)__shfl_xor((int)key[0][i], 32);
            merge_top16(key[0], other);
#pragma unroll
            for (int i = 0; i < 16; ++i) S[p][i] = key[0][i];
        }
        float s0[16], s1[16]; const float rs2 = pg8::rstd2_of(F.SSQ, t);
#pragma unroll
        for (int i = 0; i < 16; ++i) { s0[i] = ord2f(S[0][i] & ~127u) * rs2; s1[i] = ord2f(S[1][i] & ~127u) * rs2; }
        {
#pragma unroll
            for (int q4 = 0; q4 < 4; ++q4) { unsigned w0 = 0, w1 = 0;
#pragma unroll
                for (int e = 0; e < 4; ++e) { w0 |= (127u - (S[0][4 * q4 + e] & 127u)) << (8 * e); w1 |= (127u - (S[1][4 * q4 + e] & 127u)) << (8 * e); }
                *(LAS unsigned*)(IB + 4 * q4) = w0; *(LAS unsigned*)(IB + 16 + 4 * q4) = w1; }
        }
        unsigned cand[2][16];
#pragma unroll
        for (int i = 0; i < 2; ++i)
#pragma unroll
            for (int e = 0; e < 16; ++e) cand[i][e] = 0u;
        {
            int cnt = 0; float ea = 0.f, eb = 0.f; int ep = 0;
#pragma unroll
            for (int a = 0; a < 16; ++a)
#pragma unroll
                for (int b = 0; b < 16; ++b)
                    if ((a + 1) * (b + 1) <= 16) {
                        if ((cnt & 1) == 0) { ea = s0[a]; eb = s1[b]; ep = 255 - (a * 16 + b); }
                        else { const int slot = cnt >> 1; const float sa = hh ? s0[a] : ea, sb = hh ? s1[b] : eb; const int pp = hh ? 255 - (a * 16 + b) : ep;
                            cand[slot & 1][slot >> 1] = (f2ord(sa + sb) & ~255u) | (unsigned)pp; }
                        ++cnt; }
        }
        sort16_desc(cand[0]); sort16_desc(cand[1]); merge_top16(cand[0], cand[1]);
        {
            unsigned other[16];
#pragma unroll
            for (int i = 0; i < 16; ++i) other[i] = (unsigned)__shfl_xor((int)cand[0][i], 32);
            merge_top16(cand[0], other);
        }
        float gv[16]; int ev[16]; float gsum = 0.f; const float gmx = ord2f(cand[0][0] & ~255u);
#pragma unroll
        for (int i = 0; i < 16; ++i) { const unsigned k = cand[0][i]; const int pos = 255 - (int)(k & 255u); const int a = pos >> 4, b = pos & 15;
            ev[i] = (int)IB[a] * NKEYS + (int)IB[16 + b]; gv[i] = __expf(ord2f(k & ~255u) - gmx); gsum += gv[i]; }
        float ginv = 1.f / gsum;
#ifdef UNIFORM_GATES
#pragma unroll
        for (int i = 0; i < 16; ++i) gv[i] = 1.f;
        ginv = 1.f / 16.f;
#endif
        if (hh == 0) {
            unsigned short* ip = F.IDX + (size_t)t * NSEL + h * TOPK; float* gp = F.GATE + (size_t)t * NSEL + h * TOPK;
#pragma unroll
            for (int i = 0; i < 2; ++i) *(GAS v4i*)(ip + 8 * i) = (v4i){ev[8 * i] | (ev[8 * i + 1] << 16), ev[8 * i + 2] | (ev[8 * i + 3] << 16), ev[8 * i + 4] | (ev[8 * i + 5] << 16), ev[8 * i + 6] | (ev[8 * i + 7] << 16)};
#pragma unroll
            for (int i = 0; i < 4; ++i) *(GAS f32x4*)(gp + 4 * i) = (f32x4){gv[4 * i] * ginv, gv[4 * i + 1] * ginv, gv[4 * i + 2] * ginv, gv[4 * i + 3] * ginv};
        }
    }
}

typedef float f32x2_t __attribute__((ext_vector_type(2)));
DI void fp8x16_to_f32(v4u q, float (&f)[16]) {
#pragma unroll
    for (int w = 0; w < 4; ++w) { const f32x2_t lo = __builtin_amdgcn_cvt_pk_f32_fp8((int)q[w], false), hi = __builtin_amdgcn_cvt_pk_f32_fp8((int)q[w], true);
        f[4 * w + 0] = lo.x; f[4 * w + 1] = lo.y; f[4 * w + 2] = hi.x; f[4 * w + 3] = hi.y; }
}
struct XccInfo { int q, nx, nloc, rank; };
DI void xcc_info_build(const XcdBarrier& b) {
    if (threadIdx.x == 0) {
        unsigned q = 0, nx = 0, nloc = 1;
        for (unsigned j = 0; j < 16; ++j) { const unsigned c = xb_ld(&b.bar[XB_XCNT(j)]); if (c > 0u) { if (j < b.x) ++q; ++nx; } if (j == b.x) nloc = c; }
        b.st[3] = q; b.st[4] = nx > 0u ? nx : 1u; b.st[5] = nloc > 0u ? nloc : 1u;
    }
    __syncthreads();
}
DI XccInfo xcc_info(const XcdBarrier& b) {
    XccInfo I; I.rank = __builtin_amdgcn_readfirstlane((int)b.st[2]); I.q = __builtin_amdgcn_readfirstlane((int)b.st[3]); I.nx = __builtin_amdgcn_readfirstlane((int)b.st[4]); I.nloc = __builtin_amdgcn_readfirstlane((int)b.st[5]);
    return I;
}
DI float dpp_sum8(float s) {
    s += __builtin_bit_cast(float, __builtin_amdgcn_update_dpp(0, __builtin_bit_cast(int, s), 0xB1, 0xf, 0xf, false));
    s += __builtin_bit_cast(float, __builtin_amdgcn_update_dpp(0, __builtin_bit_cast(int, s), 0x4E, 0xf, 0xf, false));
    s += __builtin_bit_cast(float, __builtin_amdgcn_update_dpp(0, __builtin_bit_cast(int, s), 0x141, 0xf, 0xf, false));
    return s;
}
typedef long i64_t;
typedef long i64x2 __attribute__((ext_vector_type(2)));
typedef int v4i_t __attribute__((ext_vector_type(4)));
typedef int v8i_t __attribute__((ext_vector_type(8)));
constexpr int PEER_ROW = 144, PEER_WAVE_LDS = 128 * PEER_ROW;
constexpr int MX_ONE = 0x7f7f7f7f;
#define P7_IDS(t_, ia_, ib_) do { ia_ = (int)F.IDX[(size_t)(t_) * NSEL + lane]; ib_ = (int)F.IDX[(size_t)(t_) * NSEL + 64 + lane]; } while (0)
#define P7_ISSUE(t_, ia_, ib_, uq_, x_) do { \
        const unsigned char* xr_ = F.XB8 + (size_t)(t_) * D + sl * 256 + 16 * g;   \
        x_[0] = *(const GAS v4u*)(xr_); x_[1] = *(const GAS v4u*)(xr_ + 64); x_[2] = *(const GAS v4u*)(xr_ + 128); x_[3] = *(const GAS v4u*)(xr_ + 192); \
        _Pragma("unroll") for (int ld = 0; ld < 16; ++ld) { const int e_ = __shfl(ld < 8 ? ia_ : ib_, (8 * ld + row8) & 63); uq_[ld] = *(const GAS v4u*)(Us + (unsigned)(e_ * 128 + 16 * c8)); } } while (0)
#define P7_COMPUTE(t_, uq_, x_) do { \
        _Pragma("unroll") for (int ld = 0; ld < 16; ++ld) *(LAS v4u*)(wl + (8 * ld + row8) * PEER_ROW + 16 * c8) = uq_[ld]; \
        v8i_t xb0_, xb1_; \
        xb0_[0] = (int)x_[0].x; xb0_[1] = (int)x_[0].y; xb0_[2] = (int)x_[0].z; xb0_[3] = (int)x_[0].w; xb0_[4] = (int)x_[1].x; xb0_[5] = (int)x_[1].y; xb0_[6] = (int)x_[1].z; xb0_[7] = (int)x_[1].w; \
        xb1_[0] = (int)x_[2].x; xb1_[1] = (int)x_[2].y; xb1_[2] = (int)x_[2].z; xb1_[3] = (int)x_[2].w; xb1_[4] = (int)x_[3].x; xb1_[5] = (int)x_[3].y; xb1_[6] = (int)x_[3].z; xb1_[7] = (int)x_[3].w; \
        f32x4 keep = {0.f, 0.f, 0.f, 0.f}; \
        _Pragma("unroll") for (int j = 0; j < 8; ++j) { f32x4 c_ = {0.f, 0.f, 0.f, 0.f}; \
            const v4i_t a0_ = *(const LAS v4i_t*)(wl + (16 * j + m) * PEER_ROW + 16 * g), a1_ = *(const LAS v4i_t*)(wl + (16 * j + m) * PEER_ROW + 64 + 16 * g); \
            v8i_t A0_ = {a0_[0], a0_[1], a0_[2], a0_[3], 0, 0, 0, 0}, A1_ = {a1_[0], a1_[1], a1_[2], a1_[3], 0, 0, 0, 0}; \
            c_ = __builtin_amdgcn_mfma_scale_f32_16x16x128_f8f6f4(A0_, xb0_, c_, 4, 0, 0, MX_ONE, 0, MX_ONE); \
            c_ = __builtin_amdgcn_mfma_scale_f32_16x16x128_f8f6f4(A1_, xb1_, c_, 4, 0, 0, MX_ONE, 0, MX_ONE); \
            keep = (m == j) ? c_ : keep; } \
        { const bool ok_ = (m < 8) && ((t_) < T); bf16* dst_ = ok_ ? F.PARTB + ((size_t)sl * T + (t_)) * NSEL + 16 * m + 4 * g : F.PARTB + (size_t)8 * T * NSEL + 4 * lane; \
          v2u w_; w_.x = pk2(keep[0], keep[1]); w_.y = pk2(keep[2], keep[3]); *(GAS v2u*)dst_ = w_; } } while (0)
DI int peer_next(volatile LAS unsigned* ctr, int lane) { unsigned k = 0u; if (lane == 0) k = __hip_atomic_fetch_add((LAS unsigned*)ctr, 1u, __ATOMIC_RELAXED, __HIP_MEMORY_SCOPE_WORKGROUP); return __builtin_amdgcn_readfirstlane((int)k); }
DI int peer_tok(int tbase, int tstride, int k) { return tbase + (k & 7) + (k >> 3) * tstride; }
DI void p7_udot(Frame& F, const XccInfo& I) {
    const int lane = F.lane, g = lane >> 4, m = lane & 15, row8 = lane >> 3, c8 = lane & 7;
    LAS unsigned char* wl = F.lds + F.wave * PEER_WAVE_LDS;
    const unsigned char* U4 = (const unsigned char*)F.UB;
    const int tstride = I.nloc * NWAVES, tbase = I.rank * NWAVES;
    int it = 0;
    for (int share = I.q; share < 8; share += I.nx, ++it) {
        const int sl = share >> 1, half = share & 1;
        const unsigned char* Us = U4 + (size_t)sl * NEXP * 128;
        volatile LAS unsigned* ctr = F.MISC + 16 + it;
#define CL(t_) ((t_) < T ? (t_) : T - 1)
#define TOK(k_) (2 * peer_tok(tbase, tstride, (k_)) + half)
        v4u uqA[16], uqB[16]; int iA0, iA1, iB0, iB1;
        int kk = peer_next(ctr, lane); int tA = TOK(kk); kk = peer_next(ctr, lane); int tB = TOK(kk);
        {
            v4u xA[4], xB[4];
            P7_IDS(CL(tA), iA0, iA1);
            P7_ISSUE(CL(tA), iA0, iA1, uqA, xA);
            P7_IDS(CL(tB), iB0, iB1);
#pragma unroll 1
            while (tA < T) {
                kk = peer_next(ctr, lane); const int tC = TOK(kk); kk = peer_next(ctr, lane); const int tD = TOK(kk);
                P7_IDS(CL(tC), iA0, iA1);
                P7_ISSUE(CL(tB), iB0, iB1, uqB, xB);
                P7_COMPUTE(tA, uqA, xA);
                P7_IDS(CL(tD), iB0, iB1);
                P7_ISSUE(CL(tC), iA0, iA1, uqA, xA);
                P7_COMPUTE(tB, uqB, xB);
                tA = tC; tB = tD;
            }
        }
#undef TOK
#undef CL
    }
}
DI void p8_act(Frame& F) {
    const size_t NT_ = (size_t)F.G * NWAVES * 64;
    for (size_t item = (size_t)F.vcu * NWAVES * 64 + F.tid; item < (size_t)T * NSEL / 4; item += NT_) {
        const int t = (int)(item >> 5);
        f32x4 s = {0.f, 0.f, 0.f, 0.f}, vs4;
#pragma unroll
        for (int sl = 0; sl < 4; ++sl) { const v2u p = *(const GAS v2u*)(F.PARTB + (size_t)sl * T * NSEL + item * 4); s = s + (f32x4){bf_lo(p.x), bf_hi(p.x), bf_lo(p.y), bf_hi(p.y)}; }
        { const v2u ids = *(const GAS v2u*)(F.IDX + item * 4);
          s[0] *= F.SU[ids.x & 0xffffu]; s[1] *= F.SU[ids.x >> 16]; s[2] *= F.SU[ids.y & 0xffffu]; s[3] *= F.SU[ids.y >> 16];
          vs4 = (f32x4){F.SV[ids.x & 0xffffu], F.SV[ids.x >> 16], F.SV[ids.y & 0xffffu], F.SV[ids.y >> 16]}; }
        const float rs2 = pg8::rstd2_of(F.SSQ, t);
        const f32x4 g = *(const GAS f32x4*)(F.GATE + item * 4);
        f32x4 o;
#pragma unroll
        for (int e = 0; e < 4; ++e) { const float pre = s[e] * rs2; o[e] = 0.5f * pre * (1.f + erff(pre * 0.70710678118f)) * g[e] * vs4[e] * A_SCALE; }
        ((GAS unsigned*)F.ACT)[item] = pk4_fp8(o);
    }
}
typedef int v2i_t __attribute__((ext_vector_type(2)));
#define P9_IDS(t_, ia_, ib_, ak_) do { ia_ = (int)F.IDX[(size_t)(t_) * NSEL + lane]; ib_ = (int)F.IDX[(size_t)(t_) * NSEL + 64 + lane]; \
        const unsigned char* ap_ = (const unsigned char*)F.ACT + (size_t)(t_) * NSEL + 16 * g; \
        ak_[0] = *(const GAS v4u*)(ap_); ak_[1] = *(const GAS v4u*)(ap_ + 64); } while (0)
#define P9_ISSUE(ia_, ib_, vq_) do { \
        _Pragma("unroll") for (int ld = 0; ld < 16; ++ld) { const int e_ = __shfl(ld < 8 ? ia_ : ib_, (8 * ld + row8) & 63); vq_[ld] = *(const GAS v4u*)(Vs + (unsigned)(e_ * 128 + 16 * c8)); } } while (0)
#define P9_COMPUTE(t_, vq_, ak_) do { \
        _Pragma("unroll") for (int ld = 0; ld < 16; ++ld) *(LAS v4u*)(wl + (8 * ld + row8) * PEER_ROW + 16 * c8) = vq_[ld]; \
        const v8i_t A_ = {(int)ak_[0].x, (int)ak_[0].y, (int)ak_[0].z, (int)ak_[0].w, (int)ak_[1].x, (int)ak_[1].y, (int)ak_[1].z, (int)ak_[1].w}; \
        float keep[4] = {0.f, 0.f, 0.f, 0.f}; \
        _Pragma("unroll") for (int ct = 0; ct < 16; ++ct) { \
            const v2i_t b0_ = __builtin_amdgcn_ds_read_tr4_b64_v2i32((LAS v2i_t*)(wl + (32 * g + n16) * PEER_ROW + 8 * ct)); \
            const v2i_t b1_ = __builtin_amdgcn_ds_read_tr4_b64_v2i32((LAS v2i_t*)(wl + (32 * g + 16 + n16) * PEER_ROW + 8 * ct)); \
            const v8i_t B_ = {b0_[0], b0_[1], b1_[0], b1_[1], 0, 0, 0, 0}; f32x4 c_ = {0.f, 0.f, 0.f, 0.f}; \
            c_ = __builtin_amdgcn_mfma_scale_f32_16x16x128_f8f6f4(A_, B_, c_, 0, 4, 0, MX_ONE, 0, MX_ONE); \
            keep[ct >> 2] = (g == (ct & 3)) ? c_[0] : keep[ct >> 2]; }   \
        { const bool ok_ = (t_) < T; const size_t oo_ = (size_t)(ok_ ? (t_) : T - 1) * D + sl * 256 + 16 * g + n16; \
          float* op_ = ok_ ? F.out + oo_ : (float*)F.PARTB + 4 * lane;                   \
          _Pragma("unroll") for (int q = 0; q < 4; ++q) op_[ok_ ? 64 * q : q] = __builtin_bit_cast(float, (unsigned)F.XB[oo_ + 64 * q] << 16) + keep[q] * (1.f / A_SCALE); } } while (0)
DI void p9_vacc(Frame& F, const XccInfo& I) {
    const int lane = F.lane, g = lane >> 4, n16 = lane & 15, row8 = lane >> 3, c8 = lane & 7;
    LAS unsigned char* wl = F.lds + F.wave * PEER_WAVE_LDS;
    const unsigned char* V4 = (const unsigned char*)F.VB;
    const int tstride = I.nloc * NWAVES, tfirst = I.rank * NWAVES + F.wave;
    for (int share = I.q; share < 8; share += I.nx) {
        const int sl = share >> 1, half = share & 1;
        const unsigned char* Vs = V4 + (size_t)sl * NEXP * 128;
        if (2 * tfirst + half >= T) continue;
        v4u vqA[16], vqB[16]; v4u akA[2], akB[2]; int iA0, iA1, iB0, iB1;
#define CL(t_) ((t_) < T ? (t_) : T - 1)
#define TK(k_) (2 * (tfirst + (k_) * tstride) + half)
        P9_IDS(TK(0), iA0, iA1, akA);
        P9_ISSUE(iA0, iA1, vqA);
        P9_IDS(CL(TK(1)), iB0, iB1, akB);
#pragma unroll 1
        for (int k = 0; TK(k) < T; k += 2) {
            const int t = TK(k), t1 = TK(k + 1), t2 = CL(TK(k + 2)), t3 = CL(TK(k + 3));
            v4u akN[2], akM[2];
            P9_IDS(t2, iA0, iA1, akN);
            P9_ISSUE(iB0, iB1, vqB);
            P9_COMPUTE(t, vqA, akA);
            P9_IDS(t3, iB0, iB1, akM);
            P9_ISSUE(iA0, iA1, vqA);
            P9_COMPUTE(t1, vqB, akB);
            akA[0] = akN[0]; akA[1] = akN[1]; akB[0] = akM[0]; akB[1] = akM[1];
        }
#undef TK
#undef CL
    }
}

struct Args { const float* in[17]; float* out; unsigned char* ws; int ph_lo, ph_hi, li, pad; };
__global__ void __launch_bounds__(NWAVES * 64, 2) hyb_fwd(Args args) {
    extern __shared__ __attribute__((aligned(16))) unsigned char lds[];
    Frame F;
    F.lds = (LAS unsigned char*)lds;
    F.MISC = (volatile LAS unsigned*)(F.lds + MISC_OFF);
    F.tid = threadIdx.x; F.lane = F.tid & 63; F.wave = __builtin_amdgcn_readfirstlane(F.tid >> 6);
    F.G = gridDim.x; { const int bx = blockIdx.x; F.vcu = (F.G % 8 == 0) ? (bx % 8) * (F.G / 8) + bx / 8 : bx; }
    unsigned char* ws = args.ws;
    F.ctl = (gu32*)(ws + WS_CTL);
    F.x = args.in[0]; F.norm_mix = args.in[1]; F.norm_ffn = args.in[2]; F.w_in = args.in[3]; F.b_gate = args.in[4]; F.w_conv = args.in[5]; F.q_norm = args.in[6]; F.k_norm = args.in[7];
    F.sinks = args.in[8]; F.rel_bias = args.in[9]; F.w_conv_out = args.in[10]; F.w_attn_out = args.in[11]; F.w_out = args.in[12]; F.w_query = args.in[13]; F.sub_keys = args.in[14];
    F.expert_u = args.in[15]; F.expert_v = args.in[16]; F.out = args.out;
    F.WIN = (bf16*)(ws + WS_WIN); F.WG8 = ws + WS_WG8; F.WC = (bf16*)(ws + WS_WC); F.WA = (bf16*)(ws + WS_WA); F.WO = (bf16*)(ws + WS_WO); F.WQ = (bf16*)(ws + WS_WQ); F.SK = (bf16*)(ws + WS_SK);
    F.UB = (bf16*)(ws + WS_UB); F.VB = (bf16*)(ws + WS_VB); F.XB = (bf16*)(ws + WS_XB); F.PA = (bf16*)(ws + WS_PA); F.MIX = (bf16*)(ws + WS_MIX); F.G_ = (bf16*)(ws + WS_G); F.QP = (bf16*)(ws + WS_QP);
    F.Z = (bf16*)(ws + WS_Z); F.ATT = (bf16*)(ws + WS_ATT); F.RSTD1 = (float*)(ws + WS_RSTD1); F.SSQ = (float*)(ws + WS_SSQ); F.GATE = (float*)(ws + WS_GATE); F.IDX = (unsigned short*)(ws + WS_IDX); F.PARTB = (bf16*)(ws + WS_PART); F.SU = (float*)(ws + WS_SU); F.SV = (float*)(ws + WS_SV); F.XB8 = (unsigned char*)(ws + WS_XB8); F.ACT = (float*)(ws + WS_ACT);
    for (int u = F.tid; u < (LDS_BYTES - LDSCTL_OFF) / 4; u += NWAVES * 64) ((LAS unsigned*)(F.lds + LDSCTL_OFF))[u] = 0u;
    __syncthreads();
    XcdBarrier bar; bar.bar = (unsigned*)(F.ctl + CW_BAR); bar.x = 0; bar.st = nullptr;
    const int lo = args.ph_lo, hi = args.ph_hi;
    if (hi - lo > 1) bar = xcd_barrier_post((unsigned*)(F.ctl + CW_BAR), F.MISC + 8);
#ifndef PH_MASK
#define PH_MASK 0x3ff
#endif
#define IN(k) (((PH_MASK >> (k)) & 1) && lo <= (k) && (k) < hi)
#define SEAM(k) do { if (IN(k) && IN((k) + 1)) xcd_barrier(bar); } while (0)
#ifndef PROBE_DUP
#define PROBE_DUP 0
#endif
#define REP(k) for (int rep_ = 0; rep_ < (((PROBE_DUP >> (k)) & 1) ? 2 : 1); ++rep_)

    if (IN(0)) { REP(0) p0_prologue(F); SEAM(0); }
    if (IN(1)) {
        pg8::Gemm g{F.XB, F.WIN, nullptr, nullptr, T, N16, D}; pg8::StaticOrder S; S.init(T, N16, F.G, (int)blockIdx.x);
        pg8::Gemm g8{(const pg8::bf16_t*)F.XB8, (const pg8::bf16_t*)F.WG8, nullptr, nullptr, T, N8, D / 2}; pg8::StaticOrder S8; S8.init(T, N8, F.G, (int)blockIdx.x);
        { LAS float* bgl = (LAS float*)(F.lds + RING_BYTES); for (int i = F.tid; i < 2 * D; i += NWAVES * 64) bgl[i] = F.b_gate[i]; __syncthreads(); }
        pg8::EpiProj E{F.PA, F.G_, (const PG8_LAS float*)(F.lds + RING_BYTES), 0, 1 << 20, 1.f}, E8{F.PA, F.G_, (const PG8_LAS float*)(F.lds + RING_BYTES), N16, 3, 1.f / WG_SCALE};
        REP(1) { pg8::gemm_phase<pg8::EpiProj, pg8::StaticOrder, PG8_ALIGN, PG8_SP2, true>(F.lds + RING_OFF, g8, S8, E8);
                 pg8::gemm_phase<pg8::EpiProj, pg8::StaticOrder, PG8_ALIGN, PG8_SP2>(F.lds + RING_OFF, g, S, E); }
        {
            const int nwg = (T / 256) * (N8 / 256), rem = nwg % F.G, c = (int)blockIdx.x; const int nshort = rem ? F.G - rem : F.G, sidx = rem ? c - rem : c;
            (void)sidx; (void)nshort;
            constexpr int CH = 64, NCH = 2 * NEXP / CH;
            for (;;) {
                if (F.tid == 0) F.MISC[14] = __hip_atomic_fetch_add((unsigned*)(F.ctl + 2048), 1u, __ATOMIC_RELAXED, __HIP_MEMORY_SCOPE_AGENT);
                __syncthreads();
                const int ch = __builtin_amdgcn_readfirstlane((int)F.MISC[14]);
                __syncthreads();
                if (ch >= NCH) break;
                if (ch < NCH / 2) p0_convert_fp4(F, F.expert_u, F.norm_ffn, (unsigned char*)F.UB, F.SU, ch * CH, ch * CH + CH);
                else p0_convert_fp4(F, F.expert_v, nullptr, (unsigned char*)F.VB, F.SV, (ch - NCH / 2) * CH, (ch - NCH / 2) * CH + CH);
            } }
        SEAM(1);
    }
    if (IN(2)) {
        REP(2) { p2_conv(F); p2_attention(F); }
        SEAM(2); }
    if (IN(3)) {
        pg8::Gemm g{F.Z, F.WC, F.ATT, F.WA, T, D, CONV}; pg8::PairOrder S; S.init(T, D, F.G, (int)blockIdx.x);
        pg8::EpiMix E{F.MIX, F.G_};
        REP(3) pg8::gemm_phase<pg8::EpiMix, pg8::PairOrder, PG8_ALIGN, PG8_SP2>(F.lds + RING_OFF, g, S, E);
        SEAM(3);
    }
    if (IN(4)) {
        pg8::Gemm g{F.MIX, F.WO, nullptr, nullptr, T, D, D}; pg8::FragOrder S; S.init(T, D, F.G, (int)blockIdx.x);
        pg8::EpiX1 E{F.RSTD1, F.XB, F.SSQ, F.XB8};
        REP(4) pg8::gemm_phase<pg8::EpiX1, pg8::FragOrder, PG8_ALIGN, PG8_SP2>(F.lds + RING_OFF, g, S, E);
        SEAM(4);
    }
    if (IN(5)) {
        pg8::Gemm g{F.XB, F.WQ, nullptr, nullptr, T, PQ, D}; pg8::StaticOrder S; S.init(T, PQ, F.G, (int)blockIdx.x);
        pg8::EpiQP E{F.QP};
        REP(5) pg8::gemm_phase<pg8::EpiQP, pg8::StaticOrder, PG8_ALIGN, PG8_SP2>(F.lds + RING_OFF, g, S, E);
    }
    if (IN(6)) { REP(6) p6_topk(F); SEAM(6); }
    if (IN(7)) { xcc_info_build(bar); const XccInfo I = xcc_info(bar); REP(7) p7_udot(F, I); SEAM(7); }
    if (IN(8)) { REP(8) p8_act(F); SEAM(8); }
    if (IN(9)) { const XccInfo I = xcc_info(bar); p9_vacc(F, I); }
#undef IN
#undef SEAM
}

extern "C" void kernel_launch(void* const* d_in, const int* in_sizes, int n_in, void* d_out, int out_size, void* d_ws, size_t ws_size, hipStream_t stream) {
    static int grid = 0;
    if (grid == 0) {
        if (n_in != 17 || in_sizes[0] != T * D || out_size != T * D || ws_size < WS_END) { fprintf(stderr, "kernel_launch: unexpected shapes (n_in %d, in0 %d, out %d, ws %zu)\n", n_in, n_in > 0 ? in_sizes[0] : -1, out_size, ws_size); grid = -1; return; }
        int dev = 0, cus = 0, per_cu = 0;
        if (hipGetDevice(&dev) != hipSuccess || hipDeviceGetAttribute(&cus, hipDeviceAttributeMultiprocessorCount, dev) != hipSuccess) { grid = -1; return; }
        if (hipFuncSetAttribute((const void*)hyb_fwd, hipFuncAttributeMaxDynamicSharedMemorySize, LDS_BYTES) != hipSuccess) { fprintf(stderr, "kernel_launch: hipFuncSetAttribute failed\n"); grid = -1; return; }
        if (hipOccupancyMaxActiveBlocksPerMultiprocessor(&per_cu, (const void*)hyb_fwd, NWAVES * 64, LDS_BYTES) != hipSuccess || per_cu < 1) { fprintf(stderr, "kernel_launch: occupancy query says %d blocks per CU\n", per_cu); (void)hipGetLastError(); grid = -1; return; }
        grid = cus * 1;
    }
    if (grid < 0) return;
    if (hipMemsetAsync((char*)d_ws + WS_CTL, 0, CTL_ZERO_BYTES, stream) != hipSuccess) { fprintf(stderr, "kernel_launch: memset failed\n"); return; }
    Args a{};
    for (int i = 0; i < 17; ++i) a.in[i] = (const float*)d_in[i];
    a.out = (float*)d_out; a.ws = (unsigned char*)d_ws;
#if MK_ONE_LAUNCH
    a.ph_lo = 0; a.ph_hi = N_PHASES; a.li = 0;
    void* kargs[] = {&a};
    const hipError_t le = hipLaunchCooperativeKernel((const void*)hyb_fwd, dim3(grid), dim3(NWAVES * 64), kargs, LDS_BYTES, stream);
    if (le != hipSuccess) fprintf(stderr, "kernel_launch: cooperative launch failed: %s (grid %d)\n", hipGetErrorName(le), grid);
#else
    for (int li = 0; li < N_PHASES; ++li) {
        a.ph_lo = li; a.ph_hi = li + 1; a.li = li;
        hipLaunchKernelGGL(hyb_fwd, dim3(grid), dim3(NWAVES * 64), LDS_BYTES, stream, a);
        const hipError_t le = hipPeekAtLastError();
        if (le != hipSuccess) { fprintf(stderr, "kernel_launch: launch %d failed: %s\n", li, hipGetErrorName(le)); break; }
    }
#endif
}
```

```cpp
#include <hip/hip_runtime.h>
#include <hip/hip_cooperative_groups.h>
#include <cstdio>
#include <cstdint>
namespace pg8 {
#define PG8_LAS __attribute__((address_space(3)))
typedef unsigned short bf16_t;
typedef short bf16x8 __attribute__((ext_vector_type(8)));
typedef float f32x4 __attribute__((ext_vector_type(4)));
typedef unsigned u32x4 __attribute__((ext_vector_type(4)));
typedef unsigned u32x2 __attribute__((ext_vector_type(2)));
constexpr int BM = 256, BK = 64, HALF = 128, HTB = HALF * BK * 2  , STAGE_BYTES = 8 * HTB, NXCD = 8, WGM = 8;

__host__ __device__ __forceinline__ int lds_byte(int r, int c) { const int st = (r >> 4) * 2 + (c >> 5), rr = r & 15, cc = c & 31, ob = rr * 64 + cc * 2; return st * 1024 + (ob ^ (((ob >> 9) & 1) << 5)); }
__host__ __device__ __forceinline__ void stage_rc(int b, int& R, int& C) { const int st = b / 1024, sb = b % 1024, swz = sb ^ (((sb >> 9) & 1) << 5); R = (st >> 1) * 16 + swz / 64; C = (st & 1) * 32 + (swz % 64) / 2; }
__host__ __device__ __forceinline__ int perm32(int rho) { const int n = rho >> 4, i = rho & 15; return 8 * (i >> 2) + 4 * n + (i & 3); }

struct Unit { int pm, pn, which; };
struct Gemm { const bf16_t* A; const bf16_t* Bt; const bf16_t* A2; const bf16_t* Bt2; int M, N, K; };

struct StaticOrder {
    static constexpr bool AFRAG = false;
    int nM, nN, nwg, G, c;
    __host__ __device__ void init(int M, int N, int G_, int c_) { nM = M / BM; nN = N / BM; nwg = nM * nN; G = G_; c = c_; }
    __host__ __device__ bool next(int i, Unit& u) const {
        const long L = (long)i * G + c; if (L >= nwg) return false;
        int wgid = (int)L; { const int q = nwg / NXCD, r = nwg % NXCD, xcd = wgid % NXCD, off = wgid / NXCD; wgid = (xcd < r ? xcd * (q + 1) : r * (q + 1) + (xcd - r) * q) + off; }
        const int nig = WGM * nN, gid = wgid / nig, fm = gid * WGM, gsz = (nM - fm) < WGM ? (nM - fm) : WGM;
        u.pm = fm + ((wgid % nig) % gsz); u.pn = (wgid % nig) / gsz; u.which = 0; return true;
    }
    __device__ __forceinline__ const char* a_base(const Gemm& g, const Unit& u, size_t tstep) const { return (const char*)g.A + (size_t)u.pm * tstep; }
    __device__ __forceinline__ const char* b_base(const Gemm& g, const Unit& u, size_t tstep) const { return (const char*)g.Bt + (size_t)u.pn * tstep; }
    __device__ __forceinline__ void a_ready(const Unit&) const {}
    __device__ __forceinline__ void done(const Unit&) const {}
};

__device__ __forceinline__ unsigned cvt_pk_bf16(float lo, float hi) { unsigned r; asm volatile("v_cvt_pk_bf16_f32 %0, %1, %2" : "=v"(r) : "v"(lo), "v"(hi)); return r; }
__device__ __forceinline__ void store16_wt(void* p, u32x4 v) { asm volatile("global_store_dwordx4 %0, %1, off sc1\n\ts_nop 1" :: "v"(p), "v"(v) : "memory"); }
__device__ __forceinline__ void store8_wt(void* p, u32x2 v) { asm volatile("global_store_dwordx2 %0, %1, off sc1\n\ts_nop 1" :: "v"(p), "v"(v) : "memory"); }
typedef float f32x2 __attribute__((ext_vector_type(2)));
__device__ __forceinline__ f32x2 gelu_pk(f32x2 v) {
    const f32x2 av = __builtin_elementwise_abs(v), d = av * 0.2316418882f + 1.0f;
    f32x2 t; t.x = __builtin_amdgcn_rcpf(d.x); t.y = __builtin_amdgcn_rcpf(d.y);
    f32x2 q = t * 0.5307027145f + (-0.7265760135f); q = q * t + 0.7107068705f; q = q * t + (-0.142248368f); q = q * t + 0.127414796f; q = q * t;
    const f32x2 s = (v * v) * (-0.72134752044f);
    f32x2 e; e.x = __builtin_amdgcn_exp2f(s.x); e.y = __builtin_amdgcn_exp2f(s.y);
    const f32x2 m = v * (q * e), r = v - m;
    f32x2 o; o.x = v.x < 0.f ? m.x : r.x; o.y = v.y < 0.f ? m.y : r.y; return o;
}

template <class Epi, class Sched, bool ALIGN_EPI = false, bool SP2 = false, bool FP8 = false>
__device__ __forceinline__ void gemm_phase(PG8_LAS unsigned char* lds, const Gemm g, const Sched& S, const Epi& E) {
    const int tid = threadIdx.x, wid = __builtin_amdgcn_readfirstlane(tid >> 6), lane = tid & 63, wr = wid >> 2, wc = wid & 3, fr = lane & 15, fq = lane >> 4;
    const int K = g.K, nt = K / BK;
    unsigned voffA[2], voffB[2];
#pragma unroll
    for (int i = 0; i < 2; ++i) { int R, C; stage_rc(tid * 16 + i * 8192, R, C); const int Rb = Epi::PERM ? ((R & ~31) + perm32(R & 31)) : R;
        voffA[i] = Sched::AFRAG ? (unsigned)((((((R >> 6) * 4 + (C >> 5)) * 16 + ((R >> 4) & 3) * 2) * 64) + ((C & 31) >> 3) * 16 + (R & 15)) * 16) : (unsigned)(R * K + C) * 2u;
        voffB[i] = (unsigned)(Rb * K + C) * 2u; }
#define PG8_AP(base, h, kt) (Sched::AFRAG ? (base) + ((((size_t)((kt) >> 2) * 8 + ((kt) & 1) * 2) * 16 + (h) * 8 + (((kt) >> 1) & 1)) * 64) * 16 : (base) + (size_t)(h) * hstep + (size_t)(kt) * kstep)
    const size_t kstep = (size_t)(BK * 2);
    const size_t hstep = (size_t)HALF * K * 2;
    const size_t tstep = 2 * hstep;
    const unsigned ldsw = (unsigned)wid * 1024u;
    const int aoff = lds_byte(wr * 64 + fr, fq * 8), boff = lds_byte(wc * 32 + fr, fq * 8);
#define PG8_SA(b, h) (((b) * 2 + (h)) * HTB)
#define PG8_SB(b, h) ((4 + (b) * 2 + (h)) * HTB)
#define PG8_STAGE(bufoff, gbase, voff) do { _Pragma("unroll") for (int _i = 0; _i < 2; ++_i) \
        __builtin_amdgcn_global_load_lds((const unsigned*)((const char*)(gbase) + (voff)[_i]), (PG8_LAS unsigned*)(lds + (bufoff) + ldsw + _i * 8192), 16, 0, 0); } while (0)
#define PG8_LDA(dst, b, h) do { _Pragma("unroll") for (int m = 0; m < 4; ++m) dst[m] = __builtin_shufflevector(*(const PG8_LAS bf16x8*)(lds + PG8_SA(b, h) + aoff + m * 2048), *(const PG8_LAS bf16x8*)(lds + PG8_SA(b, h) + aoff + m * 2048 + 1024), 0, 1, 2, 3, 4, 5, 6, 7, 8, 9, 10, 11, 12, 13, 14, 15); } while (0)
#define PG8_LDB(dst, b, h) do { _Pragma("unroll") for (int n = 0; n < 2; ++n) dst[n] = __builtin_shufflevector(*(const PG8_LAS bf16x8*)(lds + PG8_SB(b, h) + boff + n * 2048), *(const PG8_LAS bf16x8*)(lds + PG8_SB(b, h) + boff + n * 2048 + 1024), 0, 1, 2, 3, 4, 5, 6, 7, 8, 9, 10, 11, 12, 13, 14, 15); } while (0)
#define PG8_MMA(ai, bj, At, Bt) do { __builtin_amdgcn_s_setprio(1); _Pragma("unroll") for (int m = 0; m < 4; ++m) _Pragma("unroll") for (int n = 0; n < 2; ++n) { \
        if constexpr (FP8) { typedef int v8i_ __attribute__((ext_vector_type(8)));   \
            asm volatile("v_mfma_scale_f32_16x16x128_f8f6f4 %0, %1, %2, %0, %3, %3 op_sel_hi:[0,0,0]" : "+v"(acc[ai][bj][m][n]) : "v"(__builtin_bit_cast(v8i_, Bt[n])), "v"(__builtin_bit_cast(v8i_, At[m])), "v"(mx_one)); \
        } else { \
            acc[ai][bj][m][n] = __builtin_amdgcn_mfma_f32_16x16x32_bf16(__builtin_shufflevector(Bt[n], Bt[n], 0, 1, 2, 3, 4, 5, 6, 7), __builtin_shufflevector(At[m], At[m], 0, 1, 2, 3, 4, 5, 6, 7), acc[ai][bj][m][n], 0, 0, 0); \
            acc[ai][bj][m][n] = __builtin_amdgcn_mfma_f32_16x16x32_bf16(__builtin_shufflevector(Bt[n], Bt[n], 8, 9, 10, 11, 12, 13, 14, 15), __builtin_shufflevector(At[m], At[m], 8, 9, 10, 11, 12, 13, 14, 15), acc[ai][bj][m][n], 0, 0, 0); } } \
        __builtin_amdgcn_s_setprio(0); } while (0)
#define PG8_WAIT_V(n) asm volatile("s_waitcnt vmcnt(" #n ")" ::: "memory")
#define PG8_WAIT_L(n) asm volatile("s_waitcnt lgkmcnt(" #n ")" ::: "memory")
#define PG8_BAR __builtin_amdgcn_s_barrier()
#define PG8_SCHED __builtin_amdgcn_sched_barrier(0)
    Unit cur, nxt; int ui = 0;
    if (!S.next(0, cur)) return;
    f32x4 acc[2][2][4][2];
#pragma unroll
    for (int a = 0; a < 2; ++a)
#pragma unroll
        for (int b = 0; b < 2; ++b)
#pragma unroll
            for (int m = 0; m < 4; ++m)
#pragma unroll
                for (int n = 0; n < 2; ++n) acc[a][b][m][n] = (f32x4){0.f, 0.f, 0.f, 0.f};
    if constexpr (Epi::HAS_INIT) E.init(acc, cur, wr, wc, fr, fq);
    const int mx_one = 0x7f7f7f7f;
    typedef short bf16x16 __attribute__((ext_vector_type(16)));
    bf16x16 At[4], B0[2], B1[2];
    const char* cA = S.a_base(g, cur, tstep); const char* cB = S.b_base(g, cur, tstep);
    S.a_ready(cur);
    if constexpr (SP2) {
        PG8_STAGE(PG8_SB(0, 0), cB, voffB); PG8_STAGE(PG8_SB(0, 1), cB + hstep, voffB); PG8_STAGE(PG8_SA(0, 0), PG8_AP(cA, 0, 0), voffA); PG8_STAGE(PG8_SA(0, 1), PG8_AP(cA, 1, 0), voffA);
        if (wr == 1) PG8_BAR;
        PG8_WAIT_V(2); PG8_BAR;
        PG8_STAGE(PG8_SB(1, 0), cB + kstep, voffB); PG8_STAGE(PG8_SA(1, 0), PG8_AP(cA, 0, 1), voffA); PG8_STAGE(PG8_SB(1, 1), cB + hstep + kstep, voffB);
        PG8_WAIT_V(6); PG8_BAR;
    } else {
        PG8_STAGE(PG8_SB(0, 0), cB, voffB); PG8_STAGE(PG8_SA(0, 0), PG8_AP(cA, 0, 0), voffA); PG8_STAGE(PG8_SB(0, 1), cB + hstep, voffB); PG8_STAGE(PG8_SA(0, 1), PG8_AP(cA, 1, 0), voffA);
        if (wr == 1) PG8_BAR;
        PG8_WAIT_V(4); PG8_BAR;
        PG8_STAGE(PG8_SB(1, 0), cB + kstep, voffB); PG8_STAGE(PG8_SA(1, 0), PG8_AP(cA, 0, 1), voffA); PG8_STAGE(PG8_SB(1, 1), cB + hstep + kstep, voffB);
        PG8_WAIT_V(6); PG8_BAR;
    }
    for (;;) {
        const bool has_next = S.next(ui + 1, nxt);
        const char* nA = has_next ? S.a_base(g, nxt, tstep) : cA; const char* nB = has_next ? S.b_base(g, nxt, tstep) : cB;
        for (int t = 0; t < nt; t += 2) {
            const bool last = (t == nt - 2);
            const char* a2b = last ? nA : cA; const int a2k = last ? 0 : t + 2; const char* b2 = last ? nB : cB + (size_t)(t + 2) * kstep;
            const char* b3 = b2 + kstep;
            const char* a1h = PG8_AP(cA, 1, t + 1); const char* a2 = PG8_AP(a2b, 0, a2k); const char* a2h = PG8_AP(a2b, 1, a2k); const char* a3 = PG8_AP(a2b, 0, a2k + 1);
            if (last && has_next) S.a_ready(nxt);
            if constexpr (SP2) {
            PG8_LDB(B0, 0, 0); PG8_LDB(B1, 0, 1); PG8_SCHED; PG8_LDA(At, 0, 0); PG8_STAGE(PG8_SA(1, 1), a1h, voffA);
            PG8_WAIT_V(8); PG8_WAIT_L(0); PG8_BAR; PG8_MMA(0, 0, At, B0); PG8_MMA(0, 1, At, B1); PG8_BAR; PG8_SCHED;
            PG8_LDA(At, 0, 1); PG8_STAGE(PG8_SB(0, 0), b2, voffB); PG8_STAGE(PG8_SB(0, 1), b2 + hstep, voffB); PG8_STAGE(PG8_SA(0, 0), a2, voffA);
            PG8_WAIT_V(8); PG8_WAIT_L(0); PG8_BAR; PG8_MMA(1, 0, At, B0); PG8_MMA(1, 1, At, B1); PG8_BAR; PG8_SCHED;
            PG8_LDB(B0, 1, 0); PG8_LDB(B1, 1, 1); PG8_SCHED; PG8_LDA(At, 1, 0); PG8_STAGE(PG8_SA(0, 1), a2h, voffA);
            PG8_WAIT_V(8); PG8_WAIT_L(0); PG8_BAR; PG8_MMA(0, 0, At, B0); PG8_MMA(0, 1, At, B1); PG8_BAR; PG8_SCHED;
            PG8_LDA(At, 1, 1); PG8_STAGE(PG8_SB(1, 0), b3, voffB); PG8_STAGE(PG8_SB(1, 1), b3 + hstep, voffB); PG8_STAGE(PG8_SA(1, 0), a3, voffA);
            PG8_WAIT_V(8); PG8_WAIT_L(0); PG8_BAR; PG8_MMA(1, 0, At, B0); PG8_MMA(1, 1, At, B1); PG8_BAR; PG8_SCHED;
            } else {
            PG8_LDB(B0, 0, 0); PG8_SCHED; PG8_LDA(At, 0, 0); PG8_STAGE(PG8_SA(1, 1), a1h, voffA);
            PG8_WAIT_L(8); PG8_BAR; PG8_WAIT_L(0); PG8_MMA(0, 0, At, B0); PG8_BAR; PG8_SCHED;
            PG8_LDB(B1, 0, 1); PG8_STAGE(PG8_SB(0, 0), b2, voffB);
            PG8_BAR; PG8_WAIT_L(0); PG8_MMA(0, 1, At, B1); PG8_BAR;
            PG8_LDA(At, 0, 1); PG8_STAGE(PG8_SA(0, 0), a2, voffA);
            PG8_BAR; PG8_WAIT_L(0); PG8_MMA(1, 0, At, B0); PG8_BAR; PG8_SCHED;
            PG8_STAGE(PG8_SB(0, 1), b2 + hstep, voffB);
            PG8_WAIT_V(6); PG8_BAR; PG8_MMA(1, 1, At, B1); PG8_BAR;
            PG8_LDB(B0, 1, 0); PG8_SCHED; PG8_LDA(At, 1, 0); PG8_STAGE(PG8_SA(0, 1), a2h, voffA);
            PG8_WAIT_L(8); PG8_BAR; PG8_WAIT_L(0); PG8_MMA(0, 0, At, B0); PG8_BAR; PG8_SCHED;
            PG8_LDB(B1, 1, 1); PG8_STAGE(PG8_SB(1, 0), b3, voffB);
            PG8_BAR; PG8_WAIT_L(0); PG8_MMA(0, 1, At, B1); PG8_BAR;
            PG8_LDA(At, 1, 1); PG8_STAGE(PG8_SA(1, 0), a3, voffA);
            PG8_BAR; PG8_WAIT_L(0); PG8_MMA(1, 0, At, B0); PG8_BAR; PG8_SCHED;
            PG8_STAGE(PG8_SB(1, 1), b3 + hstep, voffB);
            PG8_WAIT_V(6); PG8_BAR; PG8_MMA(1, 1, At, B1); PG8_BAR;
            }
        }
        if constexpr (ALIGN_EPI) { if (wr == 0) PG8_BAR; }
        if constexpr (!Epi::AFTER_DRAIN) { E(acc, cur, wr, wc, fr, fq); S.done(cur); }
        if (!has_next) break;
        if (!(Epi::CARRY && cur.which == 0)) {
#pragma unroll
        for (int a = 0; a < 2; ++a)
#pragma unroll
            for (int b = 0; b < 2; ++b)
#pragma unroll
                for (int m = 0; m < 4; ++m)
#pragma unroll
                    for (int n = 0; n < 2; ++n) acc[a][b][m][n] = (f32x4){0.f, 0.f, 0.f, 0.f};
        }
        if constexpr (Epi::HAS_INIT) E.init(acc, nxt, wr, wc, fr, fq);
        cur = nxt; cA = nA; cB = nB; ++ui;
        if constexpr (ALIGN_EPI) { if (wr == 1) PG8_BAR; }
    }
    PG8_WAIT_V(0);
    if constexpr (!ALIGN_EPI) { if (wr == 0) PG8_BAR; }
    PG8_BAR;
    if constexpr (Epi::AFTER_DRAIN) { E.fused(acc, cur, wr, wc, fr, fq, lds, wid, lane); S.done(cur); }
#undef PG8_AP
#undef PG8_SA
#undef PG8_SB
#undef PG8_STAGE
#undef PG8_LDA
#undef PG8_LDB
#undef PG8_MMA
#undef PG8_WAIT_V
#undef PG8_WAIT_L
#undef PG8_BAR
#undef PG8_SCHED
}
}

#ifndef PG8_SP2
#define PG8_SP2 true
#endif
#ifndef PG8_ALIGN
#define PG8_ALIGN true
#endif
#ifndef MK_ONE_LAUNCH
#define MK_ONE_LAUNCH 1
#endif

constexpr int NWAVES = 8;
constexpr int T = 32768, D = 1024, SEQ = 4096;
constexpr int IN_DIM = 4352, PA_W = 2304, G_W = 2048;
constexpr int N16 = 1536, N8 = IN_DIM - N16;
constexpr int C_U = 0, C_B = 512, C_C = 1024, C_Q = 1536, C_K = 2048, C_V = 2176;
constexpr int CONV = 512, HD = 64, NH = 8, NKV = 2;
constexpr int PH = 8, NKEYS = 128, PQ = 2048, TOPK = 16, NEXP = 16384, NSEL = 128;
constexpr float EPS = 1e-6f;
constexpr int N_PHASES = 10;

constexpr size_t MiB = 1u << 20;
constexpr size_t WS_CTL = 0, CTL_ZERO_BYTES = 1 * MiB;
constexpr size_t WS_WIN = 2 * MiB;
constexpr size_t WS_WG8 = WS_WIN + 3072 * 1024;
constexpr size_t WS_WC = 11 * MiB;
constexpr size_t WS_WA = 12 * MiB;
constexpr size_t WS_WO = 13 * MiB;
constexpr size_t WS_WQ = 15 * MiB;
constexpr size_t WS_SK = 19 * MiB;
constexpr size_t WS_RSTD1 = 20 * MiB;
constexpr size_t WS_SSQ = 21 * MiB;
constexpr size_t WS_UB = 24 * MiB;
constexpr size_t WS_SU = 32 * MiB;
constexpr size_t WS_VB = 40 * MiB;
constexpr size_t WS_SV = 48 * MiB;
constexpr size_t WS_XB8 = 56 * MiB;
constexpr size_t WS_XB = 88 * MiB;
constexpr size_t WS_PA = 152 * MiB;
constexpr size_t WS_MIX = WS_PA;
constexpr size_t WS_G = 296 * MiB;
constexpr size_t WS_QP = WS_G;
constexpr size_t WS_Z = 424 * MiB;
constexpr size_t WS_ATT = 456 * MiB;
constexpr size_t WS_IDX = WS_Z, WS_GATE = WS_ATT;
constexpr size_t WS_PART = WS_PA;
constexpr size_t WS_ACT = WS_G;
constexpr size_t WS_END = 488 * MiB;
constexpr int CW_BAR = 4096;

constexpr int RING_OFF = 0, RING_BYTES = 131072;
constexpr int LDSCTL_OFF = 147456, MISC_OFF = LDSCTL_OFF + 320;
constexpr int LDS_BYTES = 148480;
#define GAS __attribute__((address_space(1)))
#define LAS __attribute__((address_space(3)))
typedef unsigned short bf16;
typedef unsigned v4u __attribute__((ext_vector_type(4)));
typedef float f32x4 __attribute__((ext_vector_type(4)));
typedef short bf16x8 __attribute__((ext_vector_type(8)));
typedef GAS unsigned gu32;
typedef GAS unsigned long long gu64;
#define RLX_AGENT __ATOMIC_RELAXED, __HIP_MEMORY_SCOPE_AGENT
#define LDS_WAIT() asm volatile("s_waitcnt lgkmcnt(0)" ::: "memory")
#define VM_WAIT() asm volatile("s_waitcnt vmcnt(0)" ::: "memory")
__device__ __forceinline__ unsigned long long rt() { return __builtin_amdgcn_s_memrealtime(); }
__device__ __forceinline__ unsigned f2bf(float f) { unsigned u = __builtin_bit_cast(unsigned, f); return (u + 0x7fffu + ((u >> 16) & 1u)) >> 16; }
__device__ __forceinline__ unsigned pk2(float lo, float hi) { return f2bf(lo) | (f2bf(hi) << 16); }

#define XB_TMO      128
#define XB_XCNT(j)  (256  + 64 * (j))
#define XB_XSUB(j)  (1280 + 64 * (j))
#define XB_XGEN(j)  (2304 + 64 * (j))
#define XB_TOP      3328
#define XB_TOPGEN   3392
#define XCD_BAR_WORDS 3456
#define XB_LSUB(j)  (3456 + 64 * (j))
#define XB_LGEN(j)  (4480 + 64 * (j))
#define XB_SPIN_CAP (1u << 18)

__device__ __forceinline__ unsigned xb_ld(unsigned* p)              { return __hip_atomic_load(p, __ATOMIC_RELAXED, __HIP_MEMORY_SCOPE_AGENT); }
__device__ __forceinline__ unsigned xb_add(unsigned* p, unsigned v) { return __hip_atomic_fetch_add(p, v, __ATOMIC_RELAXED, __HIP_MEMORY_SCOPE_AGENT); }
__device__ __forceinline__ unsigned xb_xcc_id() { return (unsigned)__builtin_amdgcn_s_getreg((3 << 11) | 20) & 0xFu; }
#define XB_SPIN(cond, bar) do { unsigned _sp = 0; while (cond) { __builtin_amdgcn_s_sleep(1); \
    if ((++_sp & 255u) == 0u) { if (xb_ld(&(bar)[XB_TMO])) break; if (_sp > XB_SPIN_CAP) { atomicAdd(&(bar)[XB_TMO], 1u); break; } } } } while (0)

struct XcdBarrier {
    unsigned* bar; unsigned x;
    volatile LAS unsigned* st;
};

__device__ __forceinline__ XcdBarrier xcd_barrier_post(unsigned* bar, volatile LAS unsigned* st) {
    XcdBarrier b; b.bar = bar; b.x = xb_xcc_id(); b.st = st;
    if (threadIdx.x == 0) st[2] = xb_add(&bar[XB_XCNT(b.x)], 1u);
    return b;
}
__device__ __forceinline__ void xcd_barrier_complete(unsigned* bar, unsigned x, unsigned& nloc, unsigned& nx) {
    const unsigned G = gridDim.x * gridDim.y * gridDim.z;
    unsigned sum, cnt, mine, sp = 0u;
    for (;;) {
        sum = 0u; cnt = 0u; mine = 0u;
#pragma unroll
        for (unsigned j = 0; j < 16; ++j) { const unsigned c = xb_ld(&bar[XB_XCNT(j)]); sum += c; cnt += (c > 0u) ? 1u : 0u; mine = (j == x) ? c : mine; }
        if (sum == G) break;
        __builtin_amdgcn_s_sleep(1);
        if ((++sp & 255u) == 0u) { if (xb_ld(&bar[XB_TMO])) break; if (sp > XB_SPIN_CAP) { atomicAdd(&bar[XB_TMO], 1u); break; } }
    }
    nloc = mine > 0u ? mine : 1u; nx = cnt > 0u ? cnt : 1u;
}

__device__ __forceinline__ void xcd_barrier(const XcdBarrier& b) {
    asm volatile("s_waitcnt vmcnt(0)" ::: "memory");
    __syncthreads();
    if (threadIdx.x == 0) {
        unsigned* bar = b.bar;
        __builtin_amdgcn_s_waitcnt(0);
        unsigned nloc = b.st[0], nx = b.st[1];
        if (nloc == 0u) { xcd_barrier_complete(bar, b.x, nloc, nx); b.st[0] = nloc; b.st[1] = nx; }
        const unsigned old = xb_add(&bar[XB_XSUB(b.x)], 1u);
        const unsigned gen = old / nloc;
        if (old + 1u == (gen + 1u) * nloc) {
            __builtin_amdgcn_fence(__ATOMIC_RELEASE, "agent");
            asm volatile("s_waitcnt vmcnt(0)" ::: "memory");
            const unsigned og = xb_add(&bar[XB_TOP], 1u);
            const unsigned tg = og / nx;
            if (og + 1u == (tg + 1u) * nx) xb_add(&bar[XB_TOPGEN], 1u);
            else XB_SPIN(xb_ld(&bar[XB_TOPGEN]) == tg, bar);
            __builtin_amdgcn_fence(__ATOMIC_ACQUIRE, "agent");
            xb_add(&bar[XB_XGEN(b.x)], 1u);
            asm volatile("s_waitcnt vmcnt(0)" ::: "memory");
        } else {
            XB_SPIN(xb_ld(&bar[XB_XGEN(b.x)]) == gen, bar);
            __builtin_amdgcn_fence(__ATOMIC_ACQUIRE, "agent");
            asm volatile("s_waitcnt vmcnt(0)" ::: "memory");
        }
    }
    __syncthreads();
}

__device__ __forceinline__ void xcd_local_barrier(const XcdBarrier& b) {
    asm volatile("s_waitcnt vmcnt(0)" ::: "memory");
    __syncthreads();
    if (threadIdx.x == 0) {
        unsigned* bar = b.bar;
        __builtin_amdgcn_s_waitcnt(0);
        const unsigned nloc = b.st[0];
        const unsigned old = xb_add(&bar[XB_LSUB(b.x)], 1u);
        const unsigned gen = old / nloc;
        if (old + 1u == (gen + 1u) * nloc) xb_add(&bar[XB_LGEN(b.x)], 1u);
        else XB_SPIN(xb_ld(&bar[XB_LGEN(b.x)]) == gen, bar);
        __builtin_amdgcn_fence(__ATOMIC_ACQUIRE, "agent");
        asm volatile("s_waitcnt vmcnt(0)" ::: "memory");
    }
    __syncthreads();
}

typedef float f32x16 __attribute__((ext_vector_type(16)));
typedef unsigned v2u __attribute__((ext_vector_type(2)));
typedef int v4i __attribute__((ext_vector_type(4)));
typedef __bf16 bf2_t __attribute__((ext_vector_type(2)));
#define DI __device__ __forceinline__
struct Frame {
    LAS unsigned char* lds;
    volatile LAS unsigned* MISC;
    gu32* ctl;
    int tid, lane, wave, vcu, G;
    int xlocal, xq, xrank, cvirt;
    const float *x, *norm_mix, *norm_ffn, *w_in, *b_gate, *w_conv, *q_norm, *k_norm, *sinks, *rel_bias, *w_conv_out, *w_attn_out, *w_out, *w_query, *sub_keys, *expert_u, *expert_v;
    float* out;
    unsigned char* WG8; bf16 *WIN, *WC, *WA, *WO, *WQ, *SK, *UB, *VB, *XB, *PA, *MIX, *G_, *QP, *Z, *ATT;
    float *RSTD1, *SSQ, *GATE, *ACT, *SU, *SV; bf16* PARTB; unsigned char* XB8; unsigned short* IDX;
};
DI float wave_sum(float v) {
#pragma unroll
    for (int o = 1; o < 64; o <<= 1) v += __shfl_xor(v, o);
    return v;
}
DI float bf_lo(unsigned u) { return __builtin_bit_cast(float, u << 16); }
DI float bf_hi(unsigned u) { return __builtin_bit_cast(float, u & 0xffff0000u); }

constexpr float WG_SCALE = 32.f;
DI void p0_transpose_item(const float* W, int K, int N, bf16* WT, const float* gsc, LAS float* scr, int item, int lane, int n8 = 1 << 30, unsigned char* W8 = nullptr) {
    const int nblk = N / 32, kb = item / nblk, nb = item % nblk, k0 = 64 * kb, n0 = 32 * nb;
#pragma unroll 8
    for (int i = 0; i < 32; ++i) { const int kk = 2 * i + (lane >> 5); float v = W[(size_t)(k0 + kk) * N + n0 + (lane & 31)]; if (gsc) v *= gsc[k0 + kk]; scr[kk * 33 + (lane & 31)] = v; }
    LDS_WAIT(); asm volatile("" ::: "memory");
    const int c = lane & 7;
#pragma unroll
    for (int j = 0; j < 4; ++j) { const int n = (lane >> 3) + 8 * j; const LAS float* s = scr + (8 * c) * 33 + n;
        if (n0 >= n8) {
            int p0_ = 0, p1_ = 0;
            p0_ = __builtin_amdgcn_cvt_pk_fp8_f32(s[0 * 33] * WG_SCALE, s[1 * 33] * WG_SCALE, p0_, false); p0_ = __builtin_amdgcn_cvt_pk_fp8_f32(s[2 * 33] * WG_SCALE, s[3 * 33] * WG_SCALE, p0_, true);
            p1_ = __builtin_amdgcn_cvt_pk_fp8_f32(s[4 * 33] * WG_SCALE, s[5 * 33] * WG_SCALE, p1_, false); p1_ = __builtin_amdgcn_cvt_pk_fp8_f32(s[6 * 33] * WG_SCALE, s[7 * 33] * WG_SCALE, p1_, true);
            v2u o8; o8.x = (unsigned)p0_; o8.y = (unsigned)p1_; *(GAS v2u*)(W8 + (size_t)(n0 + n - n8) * K + k0 + 8 * c) = o8; continue; }
        v4u o; o.x = pk2(s[0 * 33], s[1 * 33]); o.y = pk2(s[2 * 33], s[3 * 33]); o.z = pk2(s[4 * 33], s[5 * 33]); o.w = pk2(s[6 * 33], s[7 * 33]);
        *(GAS v4u*)(WT + (size_t)(n0 + n) * K + k0 + 8 * c) = o; }
    LDS_WAIT(); asm volatile("" ::: "memory");
}
DI void p0_convert(Frame& F, const float* src, bf16* dst, size_t n, const float* colscale) {
    const size_t n8 = n / 8, stride = (size_t)F.G * NWAVES * 64;
    for (size_t i = (size_t)F.vcu * NWAVES * 64 + F.tid; i < n8; i += stride) {
        f32x4 a = *(const GAS f32x4*)(src + i * 8), b = *(const GAS f32x4*)(src + i * 8 + 4);
        if (colscale) { const int c = (int)((i * 8) & 1023); const f32x4 s0 = *(const GAS f32x4*)(colscale + c), s1 = *(const GAS f32x4*)(colscale + c + 4); a = a * s0; b = b * s1; }
        v4u o; o.x = pk2(a.x, a.y); o.y = pk2(a.z, a.w); o.z = pk2(b.x, b.y); o.w = pk2(b.z, b.w);
        *(GAS v4u*)(dst + i * 8) = o;
    }
}
constexpr float A_SCALE = 128.f;
DI unsigned pk4_fp8(f32x4 v) { int r = 0; r = __builtin_amdgcn_cvt_pk_fp8_f32(v[0], v[1], r, false); r = __builtin_amdgcn_cvt_pk_fp8_f32(v[2], v[3], r, true); return (unsigned)r; }
DI void p0_convert_fp8(Frame& F, const float* src, unsigned char* dst, size_t n, const float* colscale, float scale, int bidx, int nblk) {
    const int gw = bidx * NWAVES + F.wave, NGW = nblk * NWAVES, lane = F.lane;
    f32x4 cs[4];
#pragma unroll
    for (int q = 0; q < 4; ++q) cs[q] = colscale ? *(const GAS f32x4*)(colscale + 4 * lane + 256 * q) * scale : (f32x4){scale, scale, scale, scale};
    const int nrows = (int)(n / D);
    for (int e = gw; e < nrows; e += NGW) {
        const GAS f32x4* rp = (const GAS f32x4*)(src + (size_t)e * D) + lane;
        f32x4 v[4];
#pragma unroll
        for (int q = 0; q < 4; ++q) v[q] = rp[64 * q];
#pragma unroll
        for (int q = 0; q < 4; ++q) *(GAS unsigned*)(dst + ((size_t)(2 * q + (lane >> 5)) * NEXP + e) * 128 + ((4 * lane) & 127)) = pk4_fp8(v[q] * cs[q]);
    }
}
DI void p0_convert_fp4(Frame& F, const float* src, const float* gain, unsigned char* dst, float* scl, int e0, int e1) {
    const int gw = F.wave, NGW = NWAVES, lane = F.lane;
    f32x4 cs[4];
#pragma unroll
    for (int q = 0; q < 4; ++q) cs[q] = gain ? *(const GAS f32x4*)(gain + 4 * lane + 256 * q) : (f32x4){1.f, 1.f, 1.f, 1.f};
    for (int e = e0 + gw; e < e1; e += NGW) {
        const GAS f32x4* rp = (const GAS f32x4*)(src + (size_t)e * D) + lane;
        f32x4 v[4]; float mx = 0.f;
#pragma unroll
        for (int q = 0; q < 4; ++q) { v[q] = rp[64 * q] * cs[q]; mx = fmaxf(mx, fmaxf(fmaxf(fabsf(v[q][0]), fabsf(v[q][1])), fmaxf(fabsf(v[q][2]), fabsf(v[q][3])))); }
#pragma unroll
        for (int o = 1; o < 64; o <<= 1) mx = fmaxf(mx, __shfl_xor(mx, o));
        const float inv = mx > 0.f ? 6.f / mx : 0.f;
        if (lane == 0) scl[e] = mx * (1.f / 6.f);
#pragma unroll
        for (int q = 0; q < 4; ++q) { unsigned r = 0u;
            r = __builtin_amdgcn_cvt_scalef32_pk_fp4_f32(r, v[q][0] * inv, v[q][1] * inv, 1.0f, 0);
            r = __builtin_amdgcn_cvt_scalef32_pk_fp4_f32(r, v[q][2] * inv, v[q][3] * inv, 1.0f, 1);
            *(GAS unsigned short*)(dst + ((size_t)q * NEXP + e) * 128 + 2 * lane) = (unsigned short)r; }
    }
}
template <int RB> DI void p0_rows(Frame& F, const float* xrow, bf16* orow, float* rms_out, unsigned char* o8row) {
    f32x4 v[RB][4]; float s[RB];
#pragma unroll
    for (int r = 0; r < RB; ++r) { const GAS f32x4* xr = (const GAS f32x4*)(xrow + (size_t)r * D) + F.lane;
#pragma unroll
        for (int j = 0; j < 4; ++j) v[r][j] = xr[64 * j]; }
#pragma unroll
    for (int r = 0; r < RB; ++r) { s[r] = 0.f;
#pragma unroll
        for (int j = 0; j < 4; ++j) s[r] += (v[r][j].x * v[r][j].x + v[r][j].y * v[r][j].y) + (v[r][j].z * v[r][j].z + v[r][j].w * v[r][j].w); }
#pragma unroll
    for (int o = 1; o < 64; o <<= 1)
#pragma unroll
        for (int r = 0; r < RB; ++r) s[r] += __shfl_xor(s[r], o);
#pragma unroll
    for (int r = 0; r < RB; ++r) { const float rms = sqrtf(s[r] * (1.f / D) + EPS), rs = 1.f / rms; if (F.lane == 0) rms_out[r] = rms;
        GAS unsigned long long* o8 = (GAS unsigned long long*)(orow + (size_t)r * D) + F.lane;
#pragma unroll
        for (int j = 0; j < 4; ++j) { o8[64 * j] = (unsigned long long)pk2(v[r][j].x * rs, v[r][j].y * rs) | ((unsigned long long)pk2(v[r][j].z * rs, v[r][j].w * rs) << 32);
            *(GAS unsigned*)(o8row + (size_t)r * D + 4 * F.lane + 256 * j) = pk4_fp8(v[r][j] * rs); } }
}
DI void p0_prologue(Frame& F) {
    LAS float* scr = (LAS float*)(F.lds + RING_OFF + F.wave * 16384);
    const int gw = F.vcu * NWAVES + F.wave, NGW = F.G * NWAVES;
    constexpr int I_IN = (D / 64) * (IN_DIM / 32), I_C = (CONV / 64) * (D / 32), I_O = (D / 64) * (D / 32), I_Q = (D / 64) * (PQ / 32);
    constexpr int NITEMS = I_IN + 2 * I_C + I_O + I_Q;
    for (int it = gw; it < NITEMS; it += NGW) {
        int r = it;
        if (r < I_IN) { p0_transpose_item(F.w_in, D, IN_DIM, F.WIN, F.norm_mix, scr, r, F.lane, N16, F.WG8); continue; } r -= I_IN;
        if (r < I_C) { p0_transpose_item(F.w_conv_out, CONV, D, F.WC, nullptr, scr, r, F.lane); continue; } r -= I_C;
        if (r < I_C) { p0_transpose_item(F.w_attn_out, CONV, D, F.WA, nullptr, scr, r, F.lane); continue; } r -= I_C;
        if (r < I_O) { p0_transpose_item(F.w_out, D, D, F.WO, nullptr, scr, r, F.lane); continue; } r -= I_O;
        p0_transpose_item(F.w_query, D, PQ, F.WQ, F.norm_ffn, scr, r, F.lane);
    }
    p0_convert(F, F.sub_keys, F.SK, (size_t)PH * 2 * NKEYS * 128, nullptr);
    for (int m = 4 * gw; m < T; m += 4 * NGW) p0_rows<4>(F, F.x + (size_t)m * D, F.XB + (size_t)m * D, F.RSTD1 + m, F.XB8 + (size_t)m * D);
}

namespace pg8 {
DI float sigmoidf_(float v) { return __builtin_amdgcn_rcpf(1.f + __expf(-v)); }
DI size_t frag_off(int pm, int pn, int NT, int wave, int q, int lane) { return (((((size_t)pm * NT + pn) * 8 + wave) * 16 + q) * 64 + lane) * 8; }
struct EpiProj {
    static constexpr bool PERM = true, AFTER_DRAIN = false, HAS_INIT = false, CARRY = false;
    bf16_t* PA; bf16_t* G; const PG8_LAS float* bgl; int pa_col0, pn_gate0; float gsc;
    DI void operator()(const f32x4 (&acc)[2][2][4][2], const Unit& u, int wr, int wc, int fr, int fq) const {
        const int row0 = u.pm * BM + wr * 64 + fr; const bool gate = u.pn >= pn_gate0;
        const int col0 = (gate ? (u.pn - pn_gate0) * BM : pa_col0 + u.pn * BM) + wc * 32 + 8 * fq;
        if (!gate) {
#pragma unroll
            for (int ai = 0; ai < 2; ++ai)
#pragma unroll
                for (int m = 0; m < 4; ++m) { bf16_t* rowp = PA + (size_t)(row0 + ai * HALF + m * 16) * PA_W + col0;
#pragma unroll
                    for (int bj = 0; bj < 2; ++bj) { const f32x4 v0 = acc[ai][bj][m][0] * gsc, v1 = acc[ai][bj][m][1] * gsc;
                        u32x4 w; w.x = cvt_pk_bf16(v0[0], v0[1]); w.y = cvt_pk_bf16(v0[2], v0[3]); w.z = cvt_pk_bf16(v1[0], v1[1]); w.w = cvt_pk_bf16(v1[2], v1[3]);
                        store16_wt(rowp + bj * HALF, w); } }
        } else {
            f32x4 bv[2][2];
#pragma unroll
            for (int bj = 0; bj < 2; ++bj)
#pragma unroll
                for (int n = 0; n < 2; ++n) bv[bj][n] = *(const PG8_LAS f32x4*)(bgl + col0 + bj * HALF + 4 * n);
#pragma unroll
            for (int ai = 0; ai < 2; ++ai)
#pragma unroll
                for (int m = 0; m < 4; ++m)
#pragma unroll
                    for (int bj = 0; bj < 2; ++bj) { f32x4 v0 = acc[ai][bj][m][0] * gsc + bv[bj][0], v1 = acc[ai][bj][m][1] * gsc + bv[bj][1];
#pragma unroll
                        for (int j = 0; j < 4; ++j) { v0[j] = fmaxf(sigmoidf_(v0[j]) * 255.f, 1.f); v1[j] = fmaxf(sigmoidf_(v1[j]) * 255.f, 1.f); }
                        unsigned g0 = 0u, g1 = 0u;
                        g0 = __builtin_amdgcn_cvt_pk_u8_f32(v0[0], 0, g0); g0 = __builtin_amdgcn_cvt_pk_u8_f32(v0[1], 1, g0); g0 = __builtin_amdgcn_cvt_pk_u8_f32(v0[2], 2, g0); g0 = __builtin_amdgcn_cvt_pk_u8_f32(v0[3], 3, g0);
                        g1 = __builtin_amdgcn_cvt_pk_u8_f32(v1[0], 0, g1); g1 = __builtin_amdgcn_cvt_pk_u8_f32(v1[1], 1, g1); g1 = __builtin_amdgcn_cvt_pk_u8_f32(v1[2], 2, g1); g1 = __builtin_amdgcn_cvt_pk_u8_f32(v1[3], 3, g1);
                        u32x2 gw; gw.x = g0; gw.y = g1;
                        *(u32x2*)((unsigned char*)G + frag_off(u.pm, u.pn - pn_gate0, 8, wr * 4 + wc, ai * 8 + m * 2 + bj, fq * 16 + fr)) = gw; }
        }
    }
};
struct EpiMix {
    static constexpr bool PERM = true, AFTER_DRAIN = false, HAS_INIT = false, CARRY = true;
    bf16_t* MIX; const bf16_t* G;
    DI void operator()(f32x4 (&acc)[2][2][4][2], const Unit& u, int wr, int wc, int fr, int fq) const {
        const int wave = wr * 4 + wc, lane = fq * 16 + fr;
        const unsigned char* gc = (const unsigned char*)G + frag_off(u.pm, u.pn, 8, wave, 0, lane); const unsigned char* ga = (const unsigned char*)G + frag_off(u.pm, u.pn + 4, 8, wave, 0, lane);
        bf16_t* mp = MIX + frag_off(u.pm, u.pn, 4, wave, 0, lane);
#pragma unroll
        for (int ai = 0; ai < 2; ++ai) {
            u32x2 gav[8], gcv[8];
#pragma unroll
            for (int q = 0; q < 8; ++q) gav[q] = *(const u32x2*)(ga + (ai * 8 + q) * 512);
            if (!u.which) {
#pragma unroll
                for (int q = 0; q < 8; ++q) gcv[q] = *(const u32x2*)(gc + (ai * 8 + q) * 512); }
#pragma unroll
            for (int m = 0; m < 4; ++m)
#pragma unroll
                for (int bj = 0; bj < 2; ++bj) { const int q = m * 2 + bj; const u32x2 a2 = gav[q];
                    float fa[8] = {(float)(a2.x & 0xffu), (float)((a2.x >> 8) & 0xffu), (float)((a2.x >> 16) & 0xffu), (float)(a2.x >> 24), (float)(a2.y & 0xffu), (float)((a2.y >> 8) & 0xffu), (float)((a2.y >> 16) & 0xffu), (float)(a2.y >> 24)};
                    if (!u.which) { const u32x2 c2 = gcv[q];
                        const float fc[8] = {(float)(c2.x & 0xffu), (float)((c2.x >> 8) & 0xffu), (float)((c2.x >> 16) & 0xffu), (float)(c2.x >> 24), (float)(c2.y & 0xffu), (float)((c2.y >> 8) & 0xffu), (float)((c2.y >> 16) & 0xffu), (float)(c2.y >> 24)};
#pragma unroll
                        for (int e = 0; e < 4; ++e) { acc[ai][bj][m][0][e] *= fc[e] * __builtin_amdgcn_rcpf(fa[e]); acc[ai][bj][m][1][e] *= fc[4 + e] * __builtin_amdgcn_rcpf(fa[4 + e]); }
                    } else { constexpr float GI = 1.f / 255.f;
                        const f32x4 v0 = acc[ai][bj][m][0], v1 = acc[ai][bj][m][1];
                        u32x4 w; w.x = cvt_pk_bf16(v0[0] * fa[0] * GI, v0[1] * fa[1] * GI); w.y = cvt_pk_bf16(v0[2] * fa[2] * GI, v0[3] * fa[3] * GI);
                        w.z = cvt_pk_bf16(v1[0] * fa[4] * GI, v1[1] * fa[5] * GI); w.w = cvt_pk_bf16(v1[2] * fa[6] * GI, v1[3] * fa[7] * GI);
                        store16_wt(mp + (ai * 8 + q) * 512, w); } }
        }
    }
};
struct FragOrder : StaticOrder { static constexpr bool AFRAG = true; };
struct PairOrder : StaticOrder {
    __device__ bool next(int i, Unit& u) const { const bool ok = StaticOrder::next(i >> 1, u); u.which = i & 1; return ok; }
    DI const char* a_base(const Gemm& g, const Unit& u, size_t tstep) const { return (const char*)(u.which ? g.A2 : g.A) + (size_t)u.pm * tstep; }
    DI const char* b_base(const Gemm& g, const Unit& u, size_t tstep) const { return (const char*)(u.which ? g.Bt2 : g.Bt) + (size_t)u.pn * tstep; }
};
struct EpiX1 {
    static constexpr bool PERM = true, AFTER_DRAIN = false, HAS_INIT = true, CARRY = false;
    const float* RMS; bf16_t* XB; float* SSQ; unsigned char* XB8;
    DI void init(f32x4 (&acc)[2][2][4][2], const Unit& u, int wr, int wc, int fr, int fq) const {
        const int row0 = u.pm * BM + wr * 64 + fr, col0 = u.pn * BM + wc * 32 + 8 * fq;
#pragma unroll
        for (int ai = 0; ai < 2; ++ai)
#pragma unroll
            for (int m = 0; m < 4; ++m)
#pragma unroll
                for (int bj = 0; bj < 2; ++bj) { const int row = row0 + ai * HALF + m * 16; const float rm = RMS[row];
                    const u32x4 xn = *(const u32x4*)(XB + (size_t)row * D + col0 + bj * HALF);
                    acc[ai][bj][m][0] = (f32x4){__builtin_bit_cast(float, xn.x << 16), __builtin_bit_cast(float, xn.x & 0xffff0000u), __builtin_bit_cast(float, xn.y << 16), __builtin_bit_cast(float, xn.y & 0xffff0000u)} * rm;
                    acc[ai][bj][m][1] = (f32x4){__builtin_bit_cast(float, xn.z << 16), __builtin_bit_cast(float, xn.z & 0xffff0000u), __builtin_bit_cast(float, xn.w << 16), __builtin_bit_cast(float, xn.w & 0xffff0000u)} * rm; }
    }
    DI void operator()(const f32x4 (&acc)[2][2][4][2], const Unit& u, int wr, int wc, int fr, int fq) const {
        const int row0 = u.pm * BM + wr * 64 + fr, col0 = u.pn * BM + wc * 32 + 8 * fq;
#pragma unroll
        for (int ai = 0; ai < 2; ++ai)
#pragma unroll
            for (int m = 0; m < 4; ++m) { const int row = row0 + ai * HALF + m * 16; float ss = 0.f;
#pragma unroll
                for (int bj = 0; bj < 2; ++bj) { const f32x4 v0 = acc[ai][bj][m][0], v1 = acc[ai][bj][m][1];
                    ss += ((v0[0] * v0[0] + v0[1] * v0[1]) + (v0[2] * v0[2] + v0[3] * v0[3])) + ((v1[0] * v1[0] + v1[1] * v1[1]) + (v1[2] * v1[2] + v1[3] * v1[3]));
                    u32x4 w; w.x = cvt_pk_bf16(v0[0], v0[1]); w.y = cvt_pk_bf16(v0[2], v0[3]); w.z = cvt_pk_bf16(v1[0], v1[1]); w.w = cvt_pk_bf16(v1[2], v1[3]);
                    store16_wt(XB + (size_t)row * D + col0 + bj * HALF, w);
                    { int p0_ = 0, p1_ = 0;
                      p0_ = __builtin_amdgcn_cvt_pk_fp8_f32(v0[0], v0[1], p0_, false); p0_ = __builtin_amdgcn_cvt_pk_fp8_f32(v0[2], v0[3], p0_, true);
                      p1_ = __builtin_amdgcn_cvt_pk_fp8_f32(v1[0], v1[1], p1_, false); p1_ = __builtin_amdgcn_cvt_pk_fp8_f32(v1[2], v1[3], p1_, true);
                      u32x2 w8; w8.x = (unsigned)p0_; w8.y = (unsigned)p1_; *(u32x2*)(XB8 + (size_t)row * D + col0 + bj * HALF) = w8; } }
                ss += __shfl_xor(ss, 16); ss += __shfl_xor(ss, 32);
                if (fq == 0) SSQ[(size_t)row * 16 + u.pn * 4 + wc] = ss; }
    }
};
DI float rstd2_of(const float* SSQ, int row) {
    const f32x4 a = *(const f32x4*)(SSQ + (size_t)row * 16), b = *(const f32x4*)(SSQ + (size_t)row * 16 + 4), c = *(const f32x4*)(SSQ + (size_t)row * 16 + 8), d = *(const f32x4*)(SSQ + (size_t)row * 16 + 12);
    const float s = ((a[0] + a[1]) + (a[2] + a[3])) + ((b[0] + b[1]) + (b[2] + b[3])) + ((c[0] + c[1]) + (c[2] + c[3])) + ((d[0] + d[1]) + (d[2] + d[3]));
    return 1.f / sqrtf(s * (1.f / D) + EPS);
}
struct EpiQP {
    static constexpr bool PERM = true, AFTER_DRAIN = false, HAS_INIT = false, CARRY = false;
    bf16_t* QP;
    DI void operator()(const f32x4 (&acc)[2][2][4][2], const Unit& u, int wr, int wc, int fr, int fq) const {
        const int row0 = u.pm * BM + wr * 64 + fr, col0 = u.pn * BM + wc * 32 + 8 * fq;
#pragma unroll
        for (int ai = 0; ai < 2; ++ai)
#pragma unroll
            for (int m = 0; m < 4; ++m) {
#pragma unroll
                for (int bj = 0; bj < 2; ++bj) { const f32x4 v0 = acc[ai][bj][m][0], v1 = acc[ai][bj][m][1];
                    u32x4 w; w.x = cvt_pk_bf16(v0[0], v0[1]); w.y = cvt_pk_bf16(v0[2], v0[3]); w.z = cvt_pk_bf16(v1[0], v1[1]); w.w = cvt_pk_bf16(v1[2], v1[3]);
                    *(u32x4*)(QP + frag_off(u.pm, u.pn, 8, wr * 4 + wc, ai * 8 + m * 2 + bj, fq * 16 + fr)) = w; } }
    }
};
}

#define MFMA32(a, b, c) __builtin_amdgcn_mfma_f32_32x32x16_bf16((a), (b), (c), 0, 0, 0)
DI void p2_conv(Frame& F) {
    constexpr int CT = 4;
    const size_t NT_ = (size_t)F.G * NWAVES * 64;
    constexpr size_t PERB = (size_t)(SEQ / CT) * 64;
    const size_t it0 = F.xlocal ? (size_t)F.xq * PERB + (size_t)F.xrank * NWAVES * 64 + F.tid : (size_t)F.vcu * NWAVES * 64 + F.tid;
    const size_t itend = F.xlocal ? (size_t)(F.xq + 1) * PERB : (size_t)(T / CT) * 64, itstep = F.xlocal ? (size_t)(F.G / 8) * NWAVES * 64 : NT_;
    for (size_t item = it0; item < itend; item += itstep) {
        const int tb = (int)(item >> 6) * CT, c0 = (int)(item & 63) * 8, tl = tb & (SEQ - 1);
        v4u cg[CT + 2], uu[CT + 2], bg[CT];
#pragma unroll
        for (int r = 0; r < CT + 2; ++r) { const bool ok = (tl + r - 2) >= 0; const bf16* rowp = F.PA + (size_t)(tb + (ok ? r - 2 : 0)) * PA_W;
            cg[r] = *(const GAS v4u*)(rowp + C_C + c0); uu[r] = *(const GAS v4u*)(rowp + C_U + c0);
            if (!ok) { cg[r] = (v4u){0u, 0u, 0u, 0u}; } }
#pragma unroll
        for (int r = 0; r < CT; ++r) bg[r] = *(const GAS v4u*)(F.PA + (size_t)(tb + r) * PA_W + C_B + c0);
        f32x4 w[3][2];
#pragma unroll
        for (int j = 0; j < 3; ++j) { w[j][0] = *(const GAS f32x4*)(F.w_conv + j * CONV + c0); w[j][1] = *(const GAS f32x4*)(F.w_conv + j * CONV + c0 + 4); }
        float h[CT + 2][8];
#pragma unroll
        for (int r = 0; r < CT + 2; ++r) { h[r][0] = bf_lo(cg[r].x) * bf_lo(uu[r].x); h[r][1] = bf_hi(cg[r].x) * bf_hi(uu[r].x); h[r][2] = bf_lo(cg[r].y) * bf_lo(uu[r].y); h[r][3] = bf_hi(cg[r].y) * bf_hi(uu[r].y);
            h[r][4] = bf_lo(cg[r].z) * bf_lo(uu[r].z); h[r][5] = bf_hi(cg[r].z) * bf_hi(uu[r].z); h[r][6] = bf_lo(cg[r].w) * bf_lo(uu[r].w); h[r][7] = bf_hi(cg[r].w) * bf_hi(uu[r].w); }
#pragma unroll
        for (int r = 0; r < CT; ++r) {
            float a[8];
#pragma unroll
            for (int e = 0; e < 8; ++e) a[e] = w[0][e >> 2][e & 3] * h[r][e] + w[1][e >> 2][e & 3] * h[r + 1][e] + w[2][e >> 2][e & 3] * h[r + 2][e];
            v4u o; o.x = pk2(a[0] * bf_lo(bg[r].x), a[1] * bf_hi(bg[r].x)); o.y = pk2(a[2] * bf_lo(bg[r].y), a[3] * bf_hi(bg[r].y));
            o.z = pk2(a[4] * bf_lo(bg[r].z), a[5] * bf_hi(bg[r].z)); o.w = pk2(a[6] * bf_lo(bg[r].w), a[7] * bf_hi(bg[r].w));
            *(GAS v4u*)(F.Z + (size_t)(tb + r) * CONV + c0) = o;
        }
    }
}
DI int t5_bucket(int d) {
    if (d < 16) return d;
    const int large = 16 + (int)(logf((float)d / 16.f) / logf(8.f) * 16.f);
    return large < 31 ? large : 31;
}
constexpr int KS_STRIDE = 72, VT_STRIDE = 264;
constexpr int ATT_KS = 0, ATT_VT = 256 * KS_STRIDE * 2, ATT_BIAS = ATT_VT + 64 * VT_STRIDE * 2, ATT_END = ATT_BIAS + 4 * 128 * 4;
static_assert(ATT_END <= RING_BYTES, "attention LDS");
DI void p2_attention(Frame& F) {
    LAS bf16* KS = (LAS bf16*)(F.lds + ATT_KS); LAS bf16* VT = (LAS bf16*)(F.lds + ATT_VT); LAS float* BIAS = (LAS float*)(F.lds + ATT_BIAS);
    const int lane = F.lane, r = lane & 31, hh = lane >> 5;
#pragma unroll 1
    for (int unit = F.xlocal ? F.xq * 32 * NKV + F.xrank : F.vcu, uend = F.xlocal ? (F.xq + 1) * 32 * NKV : 8 * 32 * NKV, ustep = F.xlocal ? F.G / 8 : F.G; unit < uend; unit += ustep) {
        const int kv = unit & 1, n = (unit >> 1) & 31, b = unit >> 6;
        const int t0 = b * SEQ + n * 128;
        __syncthreads();
        {
            const int j = F.tid >> 1, hf = F.tid & 1; const bool valid = (n > 0) || (j >= 128);
            const bf16* rowp = F.PA + (size_t)(t0 - 128 + j) * PA_W;
            v4u kq[4], vq[4];
#pragma unroll
            for (int i = 0; i < 4; ++i) { kq[i] = (v4u){0u, 0u, 0u, 0u}; vq[i] = kq[i]; }
            if (valid) {
#pragma unroll
                for (int i = 0; i < 4; ++i) { kq[i] = *(const GAS v4u*)(rowp + C_K + kv * HD + hf * 32 + i * 8); vq[i] = *(const GAS v4u*)(rowp + C_V + kv * HD + hf * 32 + i * 8); }
            }
            float kf[32]; float ss = 0.f;
#pragma unroll
            for (int i = 0; i < 4; ++i) { kf[8 * i + 0] = bf_lo(kq[i].x); kf[8 * i + 1] = bf_hi(kq[i].x); kf[8 * i + 2] = bf_lo(kq[i].y); kf[8 * i + 3] = bf_hi(kq[i].y);
                kf[8 * i + 4] = bf_lo(kq[i].z); kf[8 * i + 5] = bf_hi(kq[i].z); kf[8 * i + 6] = bf_lo(kq[i].w); kf[8 * i + 7] = bf_hi(kq[i].w); }
#pragma unroll
            for (int e = 0; e < 32; ++e) ss += kf[e] * kf[e];
            ss += __shfl_xor(ss, 1);
            const float rs = 1.f / sqrtf(ss * (1.f / HD) + EPS);
#pragma unroll
            for (int i = 0; i < 4; ++i) { const f32x4 g0 = *(const GAS f32x4*)(F.k_norm + hf * 32 + 8 * i), g1 = *(const GAS f32x4*)(F.k_norm + hf * 32 + 8 * i + 4);
                v4u o; o.x = pk2(kf[8 * i + 0] * rs * g0[0], kf[8 * i + 1] * rs * g0[1]); o.y = pk2(kf[8 * i + 2] * rs * g0[2], kf[8 * i + 3] * rs * g0[3]);
                o.z = pk2(kf[8 * i + 4] * rs * g1[0], kf[8 * i + 5] * rs * g1[1]); o.w = pk2(kf[8 * i + 6] * rs * g1[2], kf[8 * i + 7] * rs * g1[3]);
                *(LAS v4u*)(KS + j * KS_STRIDE + hf * 32 + 8 * i) = o; }
#pragma unroll
            for (int i = 0; i < 4; ++i) { const int d0 = hf * 32 + 8 * i;
                VT[(d0 + 0) * VT_STRIDE + j] = (bf16)(vq[i].x & 0xffffu); VT[(d0 + 1) * VT_STRIDE + j] = (bf16)(vq[i].x >> 16);
                VT[(d0 + 2) * VT_STRIDE + j] = (bf16)(vq[i].y & 0xffffu); VT[(d0 + 3) * VT_STRIDE + j] = (bf16)(vq[i].y >> 16);
                VT[(d0 + 4) * VT_STRIDE + j] = (bf16)(vq[i].z & 0xffffu); VT[(d0 + 5) * VT_STRIDE + j] = (bf16)(vq[i].z >> 16);
                VT[(d0 + 6) * VT_STRIDE + j] = (bf16)(vq[i].w & 0xffffu); VT[(d0 + 7) * VT_STRIDE + j] = (bf16)(vq[i].w >> 16); }
            { const int g = F.tid >> 7, dist = F.tid & 127; BIAS[F.tid] = F.rel_bias[t5_bucket(dist) * NH + kv * 4 + g]; }
        }
        __syncthreads();
#pragma unroll 1
        for (int task = F.wave; task < 16; task += NWAVES) {
            const int g = task >> 2, c = task & 3, head = kv * 4 + g, r0 = 32 * c;
            bf16x8 qf[4];
            {
                const bf16* qp = F.PA + (size_t)(t0 + r0 + r) * PA_W + C_Q + head * HD + 8 * hh;
                v4u qq[4]; float qv[32]; float ss = 0.f;
#pragma unroll
                for (int s = 0; s < 4; ++s) qq[s] = *(const GAS v4u*)(qp + 16 * s);
#pragma unroll
                for (int s = 0; s < 4; ++s) { qv[8 * s + 0] = bf_lo(qq[s].x); qv[8 * s + 1] = bf_hi(qq[s].x); qv[8 * s + 2] = bf_lo(qq[s].y); qv[8 * s + 3] = bf_hi(qq[s].y);
                    qv[8 * s + 4] = bf_lo(qq[s].z); qv[8 * s + 5] = bf_hi(qq[s].z); qv[8 * s + 6] = bf_lo(qq[s].w); qv[8 * s + 7] = bf_hi(qq[s].w); }
#pragma unroll
                for (int e = 0; e < 32; ++e) ss += qv[e] * qv[e];
                ss += __shfl_xor(ss, 32);
                const float rs = 0.125f / sqrtf(ss * (1.f / HD) + EPS);
#pragma unroll
                for (int s = 0; s < 4; ++s) { const f32x4 g0 = *(const GAS f32x4*)(F.q_norm + 16 * s + 8 * hh), g1 = *(const GAS f32x4*)(F.q_norm + 16 * s + 8 * hh + 4);
                    v4u o; o.x = pk2(qv[8 * s + 0] * rs * g0[0], qv[8 * s + 1] * rs * g0[1]); o.y = pk2(qv[8 * s + 2] * rs * g0[2], qv[8 * s + 3] * rs * g0[3]);
                    o.z = pk2(qv[8 * s + 4] * rs * g1[0], qv[8 * s + 5] * rs * g1[1]); o.w = pk2(qv[8 * s + 6] * rs * g1[2], qv[8 * s + 7] * rs * g1[3]);
                    qf[s] = __builtin_bit_cast(bf16x8, o); }
            }
            f32x16 sacc[5];
#pragma unroll
            for (int i5 = 0; i5 < 5; ++i5) {
#pragma unroll
                for (int e = 0; e < 16; ++e) sacc[i5][e] = 0.f;
                const int kt = c + i5;
#pragma unroll
                for (int s = 0; s < 4; ++s) { const bf16x8 ka = *(const LAS bf16x8*)(KS + (32 * kt + r) * KS_STRIDE + 16 * s + 8 * hh); sacc[i5] = MFMA32(ka, qf[s], sacc[i5]); }
            }
            const float sink = F.sinks[head];
            const int dbase = r - 4 * hh + 128;
            const LAS float* bl = BIAS + g * 128;
            float mx = sink;
#pragma unroll
            for (int i5 = 0; i5 < 5; ++i5) {
                const bool tile_ok = (n > 0) || (c + i5 >= 4);
#pragma unroll
                for (int e = 0; e < 16; ++e) { const int dist = dbase - 32 * i5 - ((e & 3) + 8 * (e >> 2));
                    bool valid = tile_ok; if (i5 == 0) valid = valid && (dist < 128); if (i5 == 4) valid = valid && (dist >= 0);
                    const float lg = sacc[i5][e] + bl[dist & 127];
                    sacc[i5][e] = valid ? lg : -INFINITY; mx = fmaxf(mx, sacc[i5][e]); }
                __builtin_amdgcn_sched_barrier(0);
            }
            mx = fmaxf(mx, __shfl_xor(mx, 32));
            float sum = 0.f;
#pragma unroll
            for (int i5 = 0; i5 < 5; ++i5)
#pragma unroll
                for (int e = 0; e < 16; ++e) { const float p = __expf(sacc[i5][e] - mx); sacc[i5][e] = p; sum += p; }
            sum += __shfl_xor(sum, 32);
            const float inv = 1.f / (sum + __expf(sink - mx));
            f32x16 oacc[2];
#pragma unroll
            for (int dt = 0; dt < 2; ++dt)
#pragma unroll
                for (int e = 0; e < 16; ++e) oacc[dt][e] = 0.f;
#pragma unroll
            for (int i5 = 0; i5 < 5; ++i5)
#pragma unroll
                for (int s2 = 0; s2 < 2; ++s2) {
                    v4u pp; pp.x = pk2(sacc[i5][8 * s2 + 0] * inv, sacc[i5][8 * s2 + 1] * inv); pp.y = pk2(sacc[i5][8 * s2 + 2] * inv, sacc[i5][8 * s2 + 3] * inv);
                    pp.z = pk2(sacc[i5][8 * s2 + 4] * inv, sacc[i5][8 * s2 + 5] * inv); pp.w = pk2(sacc[i5][8 * s2 + 6] * inv, sacc[i5][8 * s2 + 7] * inv);
                    const bf16x8 pb = __builtin_bit_cast(bf16x8, pp);
                    const int kb = 32 * (c + i5) + 16 * s2 + 4 * hh;
#pragma unroll
                    for (int dt = 0; dt < 2; ++dt) {
                        const v2u lo = *(const LAS v2u*)(VT + (32 * dt + r) * VT_STRIDE + kb), hi = *(const LAS v2u*)(VT + (32 * dt + r) * VT_STRIDE + kb + 8);
                        v4u va; va.x = lo.x; va.y = lo.y; va.z = hi.x; va.w = hi.y;
                        oacc[dt] = MFMA32(__builtin_bit_cast(bf16x8, va), pb, oacc[dt]);
                    }
                    __builtin_amdgcn_sched_barrier(0);
                }
            bf16* op = F.ATT + (size_t)(t0 + r0 + r) * CONV + head * HD;
#pragma unroll
            for (int dt = 0; dt < 2; ++dt)
#pragma unroll
                for (int g4 = 0; g4 < 4; ++g4) { v2u w; w.x = pk2(oacc[dt][4 * g4 + 0], oacc[dt][4 * g4 + 1]); w.y = pk2(oacc[dt][4 * g4 + 2], oacc[dt][4 * g4 + 3]);
#ifdef ZERO_ATT
                    w.x = 0u; w.y = 0u;
#endif
                    *(GAS v2u*)(op + 32 * dt + 8 * g4 + 4 * hh) = w; }
        }
    }
}

DI unsigned f2ord(float f) { const unsigned b = __builtin_bit_cast(unsigned, f); return b ^ ((b >> 31) ? 0xffffffffu : 0x80000000u); }
DI float ord2f(unsigned k) { const unsigned b = k ^ ((k >> 31) ? 0x80000000u : 0xffffffffu); return __builtin_bit_cast(float, b); }
DI unsigned umax_(unsigned a, unsigned b) { return a > b ? a : b; }
DI unsigned umin_(unsigned a, unsigned b) { return a < b ? a : b; }
DI void sort16_desc(unsigned (&v)[16]) {
#pragma unroll
    for (int k = 2; k <= 16; k <<= 1)
#pragma unroll
        for (int j = k >> 1; j > 0; j >>= 1)
#pragma unroll
            for (int i = 0; i < 16; ++i) { const int l = i ^ j; if (l > i) { const bool desc = ((i & k) == 0) || (k == 16); const unsigned a = v[i], b = v[l], hi = umax_(a, b), lo = umin_(a, b); v[i] = desc ? hi : lo; v[l] = desc ? lo : hi; } }
}
DI void merge_top16(unsigned (&a)[16], const unsigned (&b)[16]) {
#pragma unroll
    for (int i = 0; i < 16; ++i) a[i] = umax_(a[i], b[15 - i]);
#pragma unroll
    for (int j = 8; j > 0; j >>= 1)
#pragma unroll
        for (int i = 0; i < 16; ++i) { const int l = i ^ j; if (l > i) { const unsigned x = a[i], y = a[l]; a[i] = umax_(x, y); a[l] = umin_(x, y); } }
}
constexpr int SK_STRIDE = 136;
constexpr int P6_KEYS = 0, P6_IB = 2 * NKEYS * SK_STRIDE * 2, P6_END = P6_IB + NWAVES * 64 * 32;
static_assert(P6_END <= RING_BYTES, "topk LDS");
DI void p6_topk(Frame& F) {
    LAS bf16* KL = (LAS bf16*)(F.lds + P6_KEYS); LAS unsigned char* IB = F.lds + P6_IB + (F.wave * 64 + F.lane) * 32;
    const int lane = F.lane, r = lane & 31, hh = lane >> 5;
    pg8::StaticOrder S; S.init(T, PQ, F.G, F.cvirt);
    pg8::Unit pu;
    for (int ui = 0; S.next(ui, pu); ++ui) {
        const int h = pu.pn, tile = pu.pm;
        __syncthreads();
        {
            const bf16* src = F.SK + (size_t)h * 2 * NKEYS * 128;
#pragma unroll
            for (int i = 0; i < 8; ++i) { const int ch = F.tid + 512 * i; const int row = ch >> 4, c8 = (ch & 15) * 8;
                *(LAS v4u*)(KL + row * SK_STRIDE + c8) = *(const GAS v4u*)(src + (size_t)row * 128 + c8); }
        }
        __syncthreads();
        const int t = tile * 256 + F.wave * 32 + r;
        unsigned S[2][16];
#pragma unroll
        for (int p = 0; p < 2; ++p) {
            bf16x8 qf[8];
            const int rt = F.wave * 32 + r, q_ai = rt >> 7, q_wr = (rt >> 6) & 1, q_m = (rt >> 4) & 3, q_fr = rt & 15;
#pragma unroll
            for (int s = 0; s < 8; ++s) qf[s] = __builtin_bit_cast(bf16x8, *(const GAS v4u*)(F.QP + pg8::frag_off(tile, h, 8, q_wr * 4 + (s >> 1), q_ai * 8 + q_m * 2 + p, (2 * (s & 1) + hh) * 16 + q_fr)));
            unsigned key[4][16];
#pragma unroll
            for (int kt = 0; kt < 4; ++kt) {
                f32x16 acc;
#pragma unroll
                for (int e = 0; e < 16; ++e) acc[e] = 0.f;
#pragma unroll
                for (int s = 0; s < 8; ++s) { const bf16x8 ka = *(const LAS bf16x8*)(KL + (p * NKEYS + 32 * kt + r) * SK_STRIDE + 16 * s + 8 * hh); acc = MFMA32(ka, qf[s], acc); }
#pragma unroll
                for (int e = 0; e < 16; ++e) { const int nk = 32 * kt + (e & 3) + 8 * (e >> 2) + 4 * hh; key[kt][e] = (f2ord(acc[e]) & ~127u) | (unsigned)(127 - nk); }
            }
#pragma unroll
            for (int kt = 0; kt < 4; ++kt) sort16_desc(key[kt]);
            merge_top16(key[0], key[1]); merge_top16(key[2], key[3]); merge_top16(key[0], key[2]);
            unsigned other[16];
#pragma unroll
            for (int i = 0; i < 16; ++i) other[i] = (unsigned)__shfl_xor((int)key[0][i], 32);
            merge_top16(key[0], other);
#pragma unroll
            for (int i = 0; i < 16; ++i) S[p][i] = key[0][i];
        }
        float s0[16], s1[16]; const float rs2 = pg8::rstd2_of(F.SSQ, t);
#pragma unroll
        for (int i = 0; i < 16; ++i) { s0[i] = ord2f(S[0][i] & ~127u) * rs2; s1[i] = ord2f(S[1][i] & ~127u) * rs2; }
        {
#pragma unroll
            for (int q4 = 0; q4 < 4; ++q4) { unsigned w0 = 0, w1 = 0;
#pragma unroll
                for (int e = 0; e < 4; ++e) { w0 |= (127u - (S[0][4 * q4 + e] & 127u)) << (8 * e); w1 |= (127u - (S[1][4 * q4 + e] & 127u)) << (8 * e); }
                *(LAS unsigned*)(IB + 4 * q4) = w0; *(LAS unsigned*)(IB + 16 + 4 * q4) = w1; }
        }
        unsigned cand[2][16];
#pragma unroll
        for (int i = 0; i < 2; ++i)
#pragma unroll
            for (int e = 0; e < 16; ++e) cand[i][e] = 0u;
        {
            int cnt = 0; float ea = 0.f, eb = 0.f; int ep = 0;
#pragma unroll
            for (int a = 0; a < 16; ++a)
#pragma unroll
                for (int b = 0; b < 16; ++b)
                    if ((a + 1) * (b + 1) <= 16) {
                        if ((cnt & 1) == 0) { ea = s0[a]; eb = s1[b]; ep = 255 - (a * 16 + b); }
                        else { const int slot = cnt >> 1; const float sa = hh ? s0[a] : ea, sb = hh ? s1[b] : eb; const int pp = hh ? 255 - (a * 16 + b) : ep;
                            cand[slot & 1][slot >> 1] = (f2ord(sa + sb) & ~255u) | (unsigned)pp; }
                        ++cnt; }
        }
        sort16_desc(cand[0]); sort16_desc(cand[1]); merge_top16(cand[0], cand[1]);
        {
            unsigned other[16];
#pragma unroll
            for (int i = 0; i < 16; ++i) other[i] = (unsigned)__shfl_xor((int)cand[0][i], 32);
            merge_top16(cand[0], other);
        }
        float gv[16]; int ev[16]; float gsum = 0.f; const float gmx = ord2f(cand[0][0] & ~255u);
#pragma unroll
        for (int i = 0; i < 16; ++i) { const unsigned k = cand[0][i]; const int pos = 255 - (int)(k & 255u); const int a = pos >> 4, b = pos & 15;
            ev[i] = (int)IB[a] * NKEYS + (int)IB[16 + b]; gv[i] = __expf(ord2f(k & ~255u) - gmx); gsum += gv[i]; }
        float ginv = 1.f / gsum;
#ifdef UNIFORM_GATES
#pragma unroll
        for (int i = 0; i < 16; ++i) gv[i] = 1.f;
        ginv = 1.f / 16.f;
#endif
        if (hh == 0) {
            unsigned short* ip = F.IDX + (size_t)t * NSEL + h * TOPK; float* gp = F.GATE + (size_t)t * NSEL + h * TOPK;
#pragma unroll
            for (int i = 0; i < 2; ++i) *(GAS v4i*)(ip + 8 * i) = (v4i){ev[8 * i] | (ev[8 * i + 1] << 16), ev[8 * i + 2] | (ev[8 * i + 3] << 16), ev[8 * i + 4] | (ev[8 * i + 5] << 16), ev[8 * i + 6] | (ev[8 * i + 7] << 16)};
#pragma unroll
            for (int i = 0; i < 4; ++i) *(GAS f32x4*)(gp + 4 * i) = (f32x4){gv[4 * i] * ginv, gv[4 * i + 1] * ginv, gv[4 * i + 2] * ginv, gv[4 * i + 3] * ginv};
        }
    }
}

typedef float f32x2_t __attribute__((ext_vector_type(2)));
DI void fp8x16_to_f32(v4u q, float (&f)[16]) {
#pragma unroll
    for (int w = 0; w < 4; ++w) { const f32x2_t lo = __builtin_amdgcn_cvt_pk_f32_fp8((int)q[w], false), hi = __builtin_amdgcn_cvt_pk_f32_fp8((int)q[w], true);
        f[4 * w + 0] = lo.x; f[4 * w + 1] = lo.y; f[4 * w + 2] = hi.x; f[4 * w + 3] = hi.y; }
}
struct XccInfo { int q, nx, nloc, rank, uni; };
DI void xcc_info_build(const XcdBarrier& b) {
    if (threadIdx.x == 0) {
        unsigned q = 0, nx = 0, nloc = 1, uni = 1; const unsigned G8 = gridDim.x / 8u;
        for (unsigned j = 0; j < 16; ++j) { const unsigned c = xb_ld(&b.bar[XB_XCNT(j)]); if (c > 0u) { if (j < b.x) ++q; ++nx; if (c != G8) uni = 0u; } if (j == b.x) nloc = c; }
        b.st[3] = q; b.st[4] = nx > 0u ? nx : 1u; b.st[5] = nloc > 0u ? nloc : 1u;
        b.st[7] = (uni && nx == 8u && (gridDim.x % 8u) == 0u && b.st[0] == G8) ? 1u : 0u;
    }
    __syncthreads();
}
DI XccInfo xcc_info(const XcdBarrier& b) {
    XccInfo I; I.rank = __builtin_amdgcn_readfirstlane((int)b.st[2]); I.q = __builtin_amdgcn_readfirstlane((int)b.st[3]); I.nx = __builtin_amdgcn_readfirstlane((int)b.st[4]); I.nloc = __builtin_amdgcn_readfirstlane((int)b.st[5]); I.uni = __builtin_amdgcn_readfirstlane((int)b.st[7]);
    return I;
}
DI float dpp_sum8(float s) {
    s += __builtin_bit_cast(float, __builtin_amdgcn_update_dpp(0, __builtin_bit_cast(int, s), 0xB1, 0xf, 0xf, false));
    s += __builtin_bit_cast(float, __builtin_amdgcn_update_dpp(0, __builtin_bit_cast(int, s), 0x4E, 0xf, 0xf, false));
    s += __builtin_bit_cast(float, __builtin_amdgcn_update_dpp(0, __builtin_bit_cast(int, s), 0x141, 0xf, 0xf, false));
    return s;
}
typedef long i64_t;
typedef long i64x2 __attribute__((ext_vector_type(2)));
typedef int v4i_t __attribute__((ext_vector_type(4)));
typedef int v8i_t __attribute__((ext_vector_type(8)));
constexpr int PEER_ROW = 144, PEER_WAVE_LDS = 128 * PEER_ROW;
constexpr int MX_ONE = 0x7f7f7f7f;
#define P7_IDS(t_, ia_, ib_) do { ia_ = (int)F.IDX[(size_t)(t_) * NSEL + lane]; ib_ = (int)F.IDX[(size_t)(t_) * NSEL + 64 + lane]; } while (0)
#define P7_ISSUE(t_, ia_, ib_, uq_, x_) do { \
        const unsigned char* xr_ = F.XB8 + (size_t)(t_) * D + sl * 256 + 16 * g;   \
        x_[0] = *(const GAS v4u*)(xr_); x_[1] = *(const GAS v4u*)(xr_ + 64); x_[2] = *(const GAS v4u*)(xr_ + 128); x_[3] = *(const GAS v4u*)(xr_ + 192); \
        _Pragma("unroll") for (int ld = 0; ld < 16; ++ld) { const int e_ = __shfl(ld < 8 ? ia_ : ib_, (8 * ld + row8) & 63); uq_[ld] = *(const GAS v4u*)(Us + (unsigned)(e_ * 128 + 16 * c8)); } } while (0)
#define P7_COMPUTE(t_, uq_, x_) do { \
        _Pragma("unroll") for (int ld = 0; ld < 16; ++ld) *(LAS v4u*)(wl + (8 * ld + row8) * PEER_ROW + 16 * c8) = uq_[ld]; \
        v8i_t xb0_, xb1_; \
        xb0_[0] = (int)x_[0].x; xb0_[1] = (int)x_[0].y; xb0_[2] = (int)x_[0].z; xb0_[3] = (int)x_[0].w; xb0_[4] = (int)x_[1].x; xb0_[5] = (int)x_[1].y; xb0_[6] = (int)x_[1].z; xb0_[7] = (int)x_[1].w; \
        xb1_[0] = (int)x_[2].x; xb1_[1] = (int)x_[2].y; xb1_[2] = (int)x_[2].z; xb1_[3] = (int)x_[2].w; xb1_[4] = (int)x_[3].x; xb1_[5] = (int)x_[3].y; xb1_[6] = (int)x_[3].z; xb1_[7] = (int)x_[3].w; \
        f32x4 keep = {0.f, 0.f, 0.f, 0.f}; \
        _Pragma("unroll") for (int j = 0; j < 8; ++j) { f32x4 c_ = {0.f, 0.f, 0.f, 0.f}; \
            const v4i_t a0_ = *(const LAS v4i_t*)(wl + (16 * j + m) * PEER_ROW + 16 * g), a1_ = *(const LAS v4i_t*)(wl + (16 * j + m) * PEER_ROW + 64 + 16 * g); \
            v8i_t A0_ = {a0_[0], a0_[1], a0_[2], a0_[3], 0, 0, 0, 0}, A1_ = {a1_[0], a1_[1], a1_[2], a1_[3], 0, 0, 0, 0}; \
            c_ = __builtin_amdgcn_mfma_scale_f32_16x16x128_f8f6f4(A0_, xb0_, c_, 4, 0, 0, MX_ONE, 0, MX_ONE); \
            c_ = __builtin_amdgcn_mfma_scale_f32_16x16x128_f8f6f4(A1_, xb1_, c_, 4, 0, 0, MX_ONE, 0, MX_ONE); \
            keep = (m == j) ? c_ : keep; } \
        { const bool ok_ = (m < 8) && ((t_) < T); bf16* dst_ = ok_ ? F.PARTB + ((size_t)sl * T + (t_)) * NSEL + 16 * m + 4 * g : F.PARTB + (size_t)8 * T * NSEL + 4 * lane; \
          v2u w_; w_.x = pk2(keep[0], keep[1]); w_.y = pk2(keep[2], keep[3]); *(GAS v2u*)dst_ = w_; } } while (0)
DI int peer_next(volatile LAS unsigned* ctr, int lane) { unsigned k = 0u; if (lane == 0) k = __hip_atomic_fetch_add((LAS unsigned*)ctr, 1u, __ATOMIC_RELAXED, __HIP_MEMORY_SCOPE_WORKGROUP); return __builtin_amdgcn_readfirstlane((int)k); }
DI int peer_tok(int tbase, int tstride, int k) { return tbase + (k & 7) + (k >> 3) * tstride; }
DI void p7_udot(Frame& F, const XccInfo& I) {
    const int lane = F.lane, g = lane >> 4, m = lane & 15, row8 = lane >> 3, c8 = lane & 7;
    LAS unsigned char* wl = F.lds + F.wave * PEER_WAVE_LDS;
    const unsigned char* U4 = (const unsigned char*)F.UB;
    const int tstride = I.nloc * NWAVES, tbase = I.rank * NWAVES;
    int it = 0;
    for (int share = I.q; share < 8; share += I.nx, ++it) {
        const int sl = share >> 1, half = share & 1;
        const unsigned char* Us = U4 + (size_t)sl * NEXP * 128;
        volatile LAS unsigned* ctr = F.MISC + 16 + it;
#define CL(t_) ((t_) < T ? (t_) : T - 1)
#define TOK(k_) (2 * peer_tok(tbase, tstride, (k_)) + half)
        v4u uqA[16], uqB[16]; int iA0, iA1, iB0, iB1;
        int kk = peer_next(ctr, lane); int tA = TOK(kk); kk = peer_next(ctr, lane); int tB = TOK(kk);
        {
            v4u xA[4], xB[4];
            P7_IDS(CL(tA), iA0, iA1);
            P7_ISSUE(CL(tA), iA0, iA1, uqA, xA);
            P7_IDS(CL(tB), iB0, iB1);
#pragma unroll 1
            while (tA < T) {
                kk = peer_next(ctr, lane); const int tC = TOK(kk); kk = peer_next(ctr, lane); const int tD = TOK(kk);
                P7_IDS(CL(tC), iA0, iA1);
                P7_ISSUE(CL(tB), iB0, iB1, uqB, xB);
                P7_COMPUTE(tA, uqA, xA);
                P7_IDS(CL(tD), iB0, iB1);
                P7_ISSUE(CL(tC), iA0, iA1, uqA, xA);
                P7_COMPUTE(tB, uqB, xB);
                tA = tC; tB = tD;
            }
        }
#undef TOK
#undef CL
    }
}
DI void p8_act(Frame& F) {
    const size_t NT_ = (size_t)F.G * NWAVES * 64;
    for (size_t item = (size_t)F.vcu * NWAVES * 64 + F.tid; item < (size_t)T * NSEL / 4; item += NT_) {
        const int t = (int)(item >> 5);
        f32x4 s = {0.f, 0.f, 0.f, 0.f}, vs4;
#pragma unroll
        for (int sl = 0; sl < 4; ++sl) { const v2u p = *(const GAS v2u*)(F.PARTB + (size_t)sl * T * NSEL + item * 4); s = s + (f32x4){bf_lo(p.x), bf_hi(p.x), bf_lo(p.y), bf_hi(p.y)}; }
        { const v2u ids = *(const GAS v2u*)(F.IDX + item * 4);
          s[0] *= F.SU[ids.x & 0xffffu]; s[1] *= F.SU[ids.x >> 16]; s[2] *= F.SU[ids.y & 0xffffu]; s[3] *= F.SU[ids.y >> 16];
          vs4 = (f32x4){F.SV[ids.x & 0xffffu], F.SV[ids.x >> 16], F.SV[ids.y & 0xffffu], F.SV[ids.y >> 16]}; }
        const float rs2 = pg8::rstd2_of(F.SSQ, t);
        const f32x4 g = *(const GAS f32x4*)(F.GATE + item * 4);
        f32x4 o;
#pragma unroll
        for (int e = 0; e < 4; ++e) { const float pre = s[e] * rs2; o[e] = 0.5f * pre * (1.f + erff(pre * 0.70710678118f)) * g[e] * vs4[e] * A_SCALE; }
        ((GAS unsigned*)F.ACT)[item] = pk4_fp8(o);
    }
}
typedef int v2i_t __attribute__((ext_vector_type(2)));
#define P9_IDS(t_, ia_, ib_, ak_) do { ia_ = (int)F.IDX[(size_t)(t_) * NSEL + lane]; ib_ = (int)F.IDX[(size_t)(t_) * NSEL + 64 + lane]; \
        const unsigned char* ap_ = (const unsigned char*)F.ACT + (size_t)(t_) * NSEL + 16 * g; \
        ak_[0] = *(const GAS v4u*)(ap_); ak_[1] = *(const GAS v4u*)(ap_ + 64); } while (0)
#define P9_ISSUE(ia_, ib_, vq_) do { \
        _Pragma("unroll") for (int ld = 0; ld < 16; ++ld) { const int e_ = __shfl(ld < 8 ? ia_ : ib_, (8 * ld + row8) & 63); vq_[ld] = *(const GAS v4u*)(Vs + (unsigned)(e_ * 128 + 16 * c8)); } } while (0)
#define P9_COMPUTE(t_, vq_, ak_) do { \
        _Pragma("unroll") for (int ld = 0; ld < 16; ++ld) *(LAS v4u*)(wl + (8 * ld + row8) * PEER_ROW + 16 * c8) = vq_[ld]; \
        const v8i_t A_ = {(int)ak_[0].x, (int)ak_[0].y, (int)ak_[0].z, (int)ak_[0].w, (int)ak_[1].x, (int)ak_[1].y, (int)ak_[1].z, (int)ak_[1].w}; \
        float keep[4] = {0.f, 0.f, 0.f, 0.f}; \
        _Pragma("unroll") for (int ct = 0; ct < 16; ++ct) { \
            const v2i_t b0_ = __builtin_amdgcn_ds_read_tr4_b64_v2i32((LAS v2i_t*)(wl + (32 * g + n16) * PEER_ROW + 8 * ct)); \
            const v2i_t b1_ = __builtin_amdgcn_ds_read_tr4_b64_v2i32((LAS v2i_t*)(wl + (32 * g + 16 + n16) * PEER_ROW + 8 * ct)); \
            const v8i_t B_ = {b0_[0], b0_[1], b1_[0], b1_[1], 0, 0, 0, 0}; f32x4 c_ = {0.f, 0.f, 0.f, 0.f}; \
            c_ = __builtin_amdgcn_mfma_scale_f32_16x16x128_f8f6f4(A_, B_, c_, 0, 4, 0, MX_ONE, 0, MX_ONE); \
            keep[ct >> 2] = (g == (ct & 3)) ? c_[0] : keep[ct >> 2]; }   \
        { const bool ok_ = (t_) < T; const size_t oo_ = (size_t)(ok_ ? (t_) : T - 1) * D + sl * 256 + 16 * g + n16; \
          float* op_ = ok_ ? F.out + oo_ : (float*)F.PARTB + 4 * lane;                   \
          _Pragma("unroll") for (int q = 0; q < 4; ++q) op_[ok_ ? 64 * q : q] = __builtin_bit_cast(float, (unsigned)F.XB[oo_ + 64 * q] << 16) + keep[q] * (1.f / A_SCALE); } } while (0)
DI void p9_vacc(Frame& F, const XccInfo& I) {
    const int lane = F.lane, g = lane >> 4, n16 = lane & 15, row8 = lane >> 3, c8 = lane & 7;
    LAS unsigned char* wl = F.lds + F.wave * PEER_WAVE_LDS;
    const unsigned char* V4 = (const unsigned char*)F.VB;
    const int tstride = I.nloc * NWAVES, tfirst = I.rank * NWAVES + F.wave;
    for (int share = I.q; share < 8; share += I.nx) {
        const int sl = share >> 1, half = share & 1;
        const unsigned char* Vs = V4 + (size_t)sl * NEXP * 128;
        if (2 * tfirst + half >= T) continue;
        v4u vqA[16], vqB[16]; v4u akA[2], akB[2]; int iA0, iA1, iB0, iB1;
#define CL(t_) ((t_) < T ? (t_) : T - 1)
#define TK(k_) (2 * (tfirst + (k_) * tstride) + half)
        P9_IDS(TK(0), iA0, iA1, akA);
        P9_ISSUE(iA0, iA1, vqA);
        P9_IDS(CL(TK(1)), iB0, iB1, akB);
#pragma unroll 1
        for (int k = 0; TK(k) < T; k += 2) {
            const int t = TK(k), t1 = TK(k + 1), t2 = CL(TK(k + 2)), t3 = CL(TK(k + 3));
            v4u akN[2], akM[2];
            P9_IDS(t2, iA0, iA1, akN);
            P9_ISSUE(iB0, iB1, vqB);
            P9_COMPUTE(t, vqA, akA);
            P9_IDS(t3, iB0, iB1, akM);
            P9_ISSUE(iA0, iA1, vqA);
            P9_COMPUTE(t1, vqB, akB);
            akA[0] = akN[0]; akA[1] = akN[1]; akB[0] = akM[0]; akB[1] = akM[1];
        }
#undef TK
#undef CL
    }
}

struct Args { const float* in[17]; float* out; unsigned char* ws; int ph_lo, ph_hi, li, pad; };
__global__ void __launch_bounds__(NWAVES * 64, 2) hyb_fwd(Args args) {
    extern __shared__ __attribute__((aligned(16))) unsigned char lds[];
    Frame F;
    F.lds = (LAS unsigned char*)lds;
    F.MISC = (volatile LAS unsigned*)(F.lds + MISC_OFF);
    F.tid = threadIdx.x; F.lane = F.tid & 63; F.wave = __builtin_amdgcn_readfirstlane(F.tid >> 6);
    F.G = gridDim.x; { const int bx = blockIdx.x; F.vcu = (F.G % 8 == 0) ? (bx % 8) * (F.G / 8) + bx / 8 : bx; }
    unsigned char* ws = args.ws;
    F.ctl = (gu32*)(ws + WS_CTL);
    F.x = args.in[0]; F.norm_mix = args.in[1]; F.norm_ffn = args.in[2]; F.w_in = args.in[3]; F.b_gate = args.in[4]; F.w_conv = args.in[5]; F.q_norm = args.in[6]; F.k_norm = args.in[7];
    F.sinks = args.in[8]; F.rel_bias = args.in[9]; F.w_conv_out = args.in[10]; F.w_attn_out = args.in[11]; F.w_out = args.in[12]; F.w_query = args.in[13]; F.sub_keys = args.in[14];
    F.expert_u = args.in[15]; F.expert_v = args.in[16]; F.out = args.out;
    F.WIN = (bf16*)(ws + WS_WIN); F.WG8 = ws + WS_WG8; F.WC = (bf16*)(ws + WS_WC); F.WA = (bf16*)(ws + WS_WA); F.WO = (bf16*)(ws + WS_WO); F.WQ = (bf16*)(ws + WS_WQ); F.SK = (bf16*)(ws + WS_SK);
    F.UB = (bf16*)(ws + WS_UB); F.VB = (bf16*)(ws + WS_VB); F.XB = (bf16*)(ws + WS_XB); F.PA = (bf16*)(ws + WS_PA); F.MIX = (bf16*)(ws + WS_MIX); F.G_ = (bf16*)(ws + WS_G); F.QP = (bf16*)(ws + WS_QP);
    F.Z = (bf16*)(ws + WS_Z); F.ATT = (bf16*)(ws + WS_ATT); F.RSTD1 = (float*)(ws + WS_RSTD1); F.SSQ = (float*)(ws + WS_SSQ); F.GATE = (float*)(ws + WS_GATE); F.IDX = (unsigned short*)(ws + WS_IDX); F.PARTB = (bf16*)(ws + WS_PART); F.SU = (float*)(ws + WS_SU); F.SV = (float*)(ws + WS_SV); F.XB8 = (unsigned char*)(ws + WS_XB8); F.ACT = (float*)(ws + WS_ACT);
    for (int u = F.tid; u < (LDS_BYTES - LDSCTL_OFF) / 4; u += NWAVES * 64) ((LAS unsigned*)(F.lds + LDSCTL_OFF))[u] = 0u;
    __syncthreads();
    XcdBarrier bar; bar.bar = (unsigned*)(F.ctl + CW_BAR); bar.x = 0; bar.st = nullptr;
    const int lo = args.ph_lo, hi = args.ph_hi;
    if (hi - lo > 1) bar = xcd_barrier_post((unsigned*)(F.ctl + CW_BAR), F.MISC + 8);
#ifndef PH_MASK
#define PH_MASK 0x3ff
#endif
#define IN(k) (((PH_MASK >> (k)) & 1) && lo <= (k) && (k) < hi)
#define SEAM(k) do { if (IN(k) && IN((k) + 1)) xcd_barrier(bar); } while (0)
#ifndef PROBE_DUP
#define PROBE_DUP 0
#endif
#define REP(k) for (int rep_ = 0; rep_ < (((PROBE_DUP >> (k)) & 1) ? 2 : 1); ++rep_)

    F.xlocal = 0; F.xq = 0; F.xrank = 0; F.cvirt = (int)blockIdx.x;
    if (IN(0)) { REP(0) p0_prologue(F); SEAM(0); }
    if (hi - lo > 1 && IN(0) && IN(1)) { xcc_info_build(bar); const XccInfo I = xcc_info(bar);
        if (I.uni) { F.xlocal = 1; F.xq = I.q; F.xrank = I.rank; F.cvirt = I.q + 8 * I.rank; } }
#define SEAML(k) do { if (IN(k) && IN((k) + 1)) { if (F.xlocal) xcd_local_barrier(bar); else xcd_barrier(bar); } } while (0)
    if (IN(1)) {
        pg8::Gemm g{F.XB, F.WIN, nullptr, nullptr, T, N16, D}; pg8::StaticOrder S; S.init(T, N16, F.G, F.cvirt);
        pg8::Gemm g8{(const pg8::bf16_t*)F.XB8, (const pg8::bf16_t*)F.WG8, nullptr, nullptr, T, N8, D / 2}; pg8::StaticOrder S8; S8.init(T, N8, F.G, F.cvirt);
        { LAS float* bgl = (LAS float*)(F.lds + RING_BYTES); for (int i = F.tid; i < 2 * D; i += NWAVES * 64) bgl[i] = F.b_gate[i]; __syncthreads(); }
        pg8::EpiProj E{F.PA, F.G_, (const PG8_LAS float*)(F.lds + RING_BYTES), 0, 1 << 20, 1.f}, E8{F.PA, F.G_, (const PG8_LAS float*)(F.lds + RING_BYTES), N16, 3, 1.f / WG_SCALE};
        REP(1) { pg8::gemm_phase<pg8::EpiProj, pg8::StaticOrder, PG8_ALIGN, PG8_SP2, true>(F.lds + RING_OFF, g8, S8, E8);
                 pg8::gemm_phase<pg8::EpiProj, pg8::StaticOrder, PG8_ALIGN, PG8_SP2>(F.lds + RING_OFF, g, S, E); }
        {
            const int nwg = (T / 256) * (N8 / 256), rem = nwg % F.G, c = (int)blockIdx.x; const int nshort = rem ? F.G - rem : F.G, sidx = rem ? c - rem : c;
            (void)sidx; (void)nshort;
            constexpr int CH = 64, NCH = 2 * NEXP / CH;
            for (;;) {
                if (F.tid == 0) F.MISC[14] = __hip_atomic_fetch_add((unsigned*)(F.ctl + 2048), 1u, __ATOMIC_RELAXED, __HIP_MEMORY_SCOPE_AGENT);
                __syncthreads();
                const int ch = __builtin_amdgcn_readfirstlane((int)F.MISC[14]);
                __syncthreads();
                if (ch >= NCH) break;
                if (ch < NCH / 2) p0_convert_fp4(F, F.expert_u, F.norm_ffn, (unsigned char*)F.UB, F.SU, ch * CH, ch * CH + CH);
                else p0_convert_fp4(F, F.expert_v, nullptr, (unsigned char*)F.VB, F.SV, (ch - NCH / 2) * CH, (ch - NCH / 2) * CH + CH);
            } }
        SEAML(1);
    }
    if (IN(2)) {
        REP(2) { p2_conv(F); p2_attention(F); }
        SEAML(2); }
    if (IN(3)) {
        pg8::Gemm g{F.Z, F.WC, F.ATT, F.WA, T, D, CONV}; pg8::PairOrder S; S.init(T, D, F.G, F.cvirt);
        pg8::EpiMix E{F.MIX, F.G_};
        REP(3) pg8::gemm_phase<pg8::EpiMix, pg8::PairOrder, PG8_ALIGN, PG8_SP2>(F.lds + RING_OFF, g, S, E);
        SEAML(3);
    }
    if (IN(4)) {
        pg8::Gemm g{F.MIX, F.WO, nullptr, nullptr, T, D, D}; pg8::FragOrder S; S.init(T, D, F.G, F.cvirt);
        pg8::EpiX1 E{F.RSTD1, F.XB, F.SSQ, F.XB8};
        REP(4) pg8::gemm_phase<pg8::EpiX1, pg8::FragOrder, PG8_ALIGN, PG8_SP2>(F.lds + RING_OFF, g, S, E);
        SEAML(4);
    }
    if (IN(5)) {
        pg8::Gemm g{F.XB, F.WQ, nullptr, nullptr, T, PQ, D}; pg8::StaticOrder S; S.init(T, PQ, F.G, F.cvirt);
        pg8::EpiQP E{F.QP};
        REP(5) pg8::gemm_phase<pg8::EpiQP, pg8::StaticOrder, PG8_ALIGN, PG8_SP2>(F.lds + RING_OFF, g, S, E);
    }
    if (IN(6)) { REP(6) p6_topk(F); SEAM(6); }
    if (IN(7)) { if (!(hi - lo > 1 && IN(0) && IN(1))) xcc_info_build(bar); const XccInfo I = xcc_info(bar); REP(7) p7_udot(F, I); SEAM(7); }
    if (IN(8)) { REP(8) p8_act(F); SEAM(8); }
    if (IN(9)) { const XccInfo I = xcc_info(bar); p9_vacc(F, I); }
#undef IN
#undef SEAM
#undef SEAML
}

extern "C" void kernel_launch(void* const* d_in, const int* in_sizes, int n_in, void* d_out, int out_size, void* d_ws, size_t ws_size, hipStream_t stream) {
    static int grid = 0;
    if (grid == 0) {
        if (n_in != 17 || in_sizes[0] != T * D || out_size != T * D || ws_size < WS_END) { fprintf(stderr, "kernel_launch: unexpected shapes (n_in %d, in0 %d, out %d, ws %zu)\n", n_in, n_in > 0 ? in_sizes[0] : -1, out_size, ws_size); grid = -1; return; }
        int dev = 0, cus = 0, per_cu = 0;
        if (hipGetDevice(&dev) != hipSuccess || hipDeviceGetAttribute(&cus, hipDeviceAttributeMultiprocessorCount, dev) != hipSuccess) { grid = -1; return; }
        if (hipFuncSetAttribute((const void*)hyb_fwd, hipFuncAttributeMaxDynamicSharedMemorySize, LDS_BYTES) != hipSuccess) { fprintf(stderr, "kernel_launch: hipFuncSetAttribute failed\n"); grid = -1; return; }
        if (hipOccupancyMaxActiveBlocksPerMultiprocessor(&per_cu, (const void*)hyb_fwd, NWAVES * 64, LDS_BYTES) != hipSuccess || per_cu < 1) { fprintf(stderr, "kernel_launch: occupancy query says %d blocks per CU\n", per_cu); (void)hipGetLastError(); grid = -1; return; }
        grid = cus * 1;
    }
    if (grid < 0) return;
    if (hipMemsetAsync((char*)d_ws + WS_CTL, 0, CTL_ZERO_BYTES, stream) != hipSuccess) { fprintf(stderr, "kernel_launch: memset failed\n"); return; }
    Args a{};
    for (int i = 0; i < 17; ++i) a.in[i] = (const float*)d_in[i];
    a.out = (float*)d_out; a.ws = (unsigned char*)d_ws;
#if MK_ONE_LAUNCH
    a.ph_lo = 0; a.ph_hi = N_PHASES; a.li = 0;
    void* kargs[] = {&a};
    const hipError_t le = hipLaunchCooperativeKernel((const void*)hyb_fwd, dim3(grid), dim3(NWAVES * 64), kargs, LDS_BYTES, stream);
    if (le != hipSuccess) fprintf(stderr, "kernel_launch: cooperative launch failed: %s (grid %d)\n", hipGetErrorName(le), grid);
#else
    for (int li = 0; li < N_PHASES; ++li) {
        a.ph_lo = li; a.ph_hi = li + 1; a.li = li;
        hipLaunchKernelGGL(hyb_fwd, dim3(grid), dim3(NWAVES * 64), LDS_BYTES, stream, a);
        const hipError_t le = hipPeekAtLastError();
        if (le != hipSuccess) { fprintf(stderr, "kernel_launch: launch %d failed: %s\n", li, hipGetErrorName(le)); break; }
    }
#endif
}
```

```cpp
#include <hip/hip_runtime.h>
#include <hip/hip_cooperative_groups.h>
#include <cstdio>
#include <cstdint>
namespace pg8 {
#define PG8_LAS __attribute__((address_space(3)))
typedef unsigned short bf16_t;
typedef short bf16x8 __attribute__((ext_vector_type(8)));
typedef float f32x4 __attribute__((ext_vector_type(4)));
typedef unsigned u32x4 __attribute__((ext_vector_type(4)));
typedef unsigned u32x2 __attribute__((ext_vector_type(2)));
constexpr int BM = 256, BK = 64, HALF = 128, HTB = HALF * BK * 2  , STAGE_BYTES = 8 * HTB, NXCD = 8, WGM = 8;

__host__ __device__ __forceinline__ int lds_byte(int r, int c) { const int st = (r >> 4) * 2 + (c >> 5), rr = r & 15, cc = c & 31, ob = rr * 64 + cc * 2; return st * 1024 + (ob ^ (((ob >> 9) & 1) << 5)); }
__host__ __device__ __forceinline__ void stage_rc(int b, int& R, int& C) { const int st = b / 1024, sb = b % 1024, swz = sb ^ (((sb >> 9) & 1) << 5); R = (st >> 1) * 16 + swz / 64; C = (st & 1) * 32 + (swz % 64) / 2; }
__host__ __device__ __forceinline__ int perm32(int rho) { const int n = rho >> 4, i = rho & 15; return 8 * (i >> 2) + 4 * n + (i & 3); }

struct Unit { int pm, pn, which; };
struct Gemm { const bf16_t* A; const bf16_t* Bt; const bf16_t* A2; const bf16_t* Bt2; int M, N, K; };

struct StaticOrder {
    static constexpr bool AFRAG = false;
    int nM, nN, nwg, G, c;
    __host__ __device__ void init(int M, int N, int G_, int c_) { nM = M / BM; nN = N / BM; nwg = nM * nN; G = G_; c = c_; }
    __host__ __device__ bool next(int i, Unit& u) const {
        const long L = (long)i * G + c; if (L >= nwg) return false;
        int wgid = (int)L; { const int q = nwg / NXCD, r = nwg % NXCD, xcd = wgid % NXCD, off = wgid / NXCD; wgid = (xcd < r ? xcd * (q + 1) : r * (q + 1) + (xcd - r) * q) + off; }
        const int nig = WGM * nN, gid = wgid / nig, fm = gid * WGM, gsz = (nM - fm) < WGM ? (nM - fm) : WGM;
        u.pm = fm + ((wgid % nig) % gsz); u.pn = (wgid % nig) / gsz; u.which = 0; return true;
    }
    __device__ __forceinline__ const char* a_base(const Gemm& g, const Unit& u, size_t tstep) const { return (const char*)g.A + (size_t)u.pm * tstep; }
    __device__ __forceinline__ const char* b_base(const Gemm& g, const Unit& u, size_t tstep) const { return (const char*)g.Bt + (size_t)u.pn * tstep; }
    __device__ __forceinline__ void a_ready(const Unit&) const {}
    __device__ __forceinline__ void done(const Unit&) const {}
};

__device__ __forceinline__ unsigned cvt_pk_bf16(float lo, float hi) { unsigned r; asm volatile("v_cvt_pk_bf16_f32 %0, %1, %2" : "=v"(r) : "v"(lo), "v"(hi)); return r; }
__device__ __forceinline__ void store16_wt(void* p, u32x4 v) { asm volatile("global_store_dwordx4 %0, %1, off sc1\n\ts_nop 1" :: "v"(p), "v"(v) : "memory"); }
__device__ __forceinline__ void store8_wt(void* p, u32x2 v) { asm volatile("global_store_dwordx2 %0, %1, off sc1\n\ts_nop 1" :: "v"(p), "v"(v) : "memory"); }
typedef float f32x2 __attribute__((ext_vector_type(2)));
__device__ __forceinline__ f32x2 gelu_pk(f32x2 v) {
    const f32x2 av = __builtin_elementwise_abs(v), d = av * 0.2316418882f + 1.0f;
    f32x2 t; t.x = __builtin_amdgcn_rcpf(d.x); t.y = __builtin_amdgcn_rcpf(d.y);
    f32x2 q = t * 0.5307027145f + (-0.7265760135f); q = q * t + 0.7107068705f; q = q * t + (-0.142248368f); q = q * t + 0.127414796f; q = q * t;
    const f32x2 s = (v * v) * (-0.72134752044f);
    f32x2 e; e.x = __builtin_amdgcn_exp2f(s.x); e.y = __builtin_amdgcn_exp2f(s.y);
    const f32x2 m = v * (q * e), r = v - m;
    f32x2 o; o.x = v.x < 0.f ? m.x : r.x; o.y = v.y < 0.f ? m.y : r.y; return o;
}

template <class Epi, class Sched, bool ALIGN_EPI = false, bool SP2 = false, bool FP8 = false>
__device__ __forceinline__ void gemm_phase(PG8_LAS unsigned char* lds, const Gemm g, const Sched& S, const Epi& E) {
    const int tid = threadIdx.x, wid = __builtin_amdgcn_readfirstlane(tid >> 6), lane = tid & 63, wr = wid >> 2, wc = wid & 3, fr = lane & 15, fq = lane >> 4;
    const int K = g.K, nt = K / BK;
    unsigned voffA[2], voffB[2];
#pragma unroll
    for (int i = 0; i < 2; ++i) { int R, C; stage_rc(tid * 16 + i * 8192, R, C); const int Rb = Epi::PERM ? ((R & ~31) + perm32(R & 31)) : R;
        voffA[i] = Sched::AFRAG ? (unsigned)((((((R >> 6) * 4 + (C >> 5)) * 16 + ((R >> 4) & 3) * 2) * 64) + ((C & 31) >> 3) * 16 + (R & 15)) * 16) : (unsigned)(R * K + C) * 2u;
        voffB[i] = (unsigned)(Rb * K + C) * 2u; }
#define PG8_AP(base, h, kt) (Sched::AFRAG ? (base) + ((((size_t)((kt) >> 2) * 8 + ((kt) & 1) * 2) * 16 + (h) * 8 + (((kt) >> 1) & 1)) * 64) * 16 : (base) + (size_t)(h) * hstep + (size_t)(kt) * kstep)
    const size_t kstep = (size_t)(BK * 2);
    const size_t hstep = (size_t)HALF * K * 2;
    const size_t tstep = 2 * hstep;
    const unsigned ldsw = (unsigned)wid * 1024u;
    const int aoff = lds_byte(wr * 64 + fr, fq * 8), boff = lds_byte(wc * 32 + fr, fq * 8);
#define PG8_SA(b, h) (((b) * 2 + (h)) * HTB)
#define PG8_SB(b, h) ((4 + (b) * 2 + (h)) * HTB)
#define PG8_STAGE(bufoff, gbase, voff) do { _Pragma("unroll") for (int _i = 0; _i < 2; ++_i) \
        __builtin_amdgcn_global_load_lds((const unsigned*)((const char*)(gbase) + (voff)[_i]), (PG8_LAS unsigned*)(lds + (bufoff) + ldsw + _i * 8192), 16, 0, 0); } while (0)
#define PG8_LDA(dst, b, h) do { _Pragma("unroll") for (int m = 0; m < 4; ++m) dst[m] = __builtin_shufflevector(*(const PG8_LAS bf16x8*)(lds + PG8_SA(b, h) + aoff + m * 2048), *(const PG8_LAS bf16x8*)(lds + PG8_SA(b, h) + aoff + m * 2048 + 1024), 0, 1, 2, 3, 4, 5, 6, 7, 8, 9, 10, 11, 12, 13, 14, 15); } while (0)
#define PG8_LDB(dst, b, h) do { _Pragma("unroll") for (int n = 0; n < 2; ++n) dst[n] = __builtin_shufflevector(*(const PG8_LAS bf16x8*)(lds + PG8_SB(b, h) + boff + n * 2048), *(const PG8_LAS bf16x8*)(lds + PG8_SB(b, h) + boff + n * 2048 + 1024), 0, 1, 2, 3, 4, 5, 6, 7, 8, 9, 10, 11, 12, 13, 14, 15); } while (0)
#define PG8_MMA(ai, bj, At, Bt) do { __builtin_amdgcn_s_setprio(1); _Pragma("unroll") for (int m = 0; m < 4; ++m) _Pragma("unroll") for (int n = 0; n < 2; ++n) { \
        if constexpr (FP8) { typedef int v8i_ __attribute__((ext_vector_type(8)));   \
            asm volatile("v_mfma_scale_f32_16x16x128_f8f6f4 %0, %1, %2, %0, %3, %3 op_sel_hi:[0,0,0]" : "+v"(acc[ai][bj][m][n]) : "v"(__builtin_bit_cast(v8i_, Bt[n])), "v"(__builtin_bit_cast(v8i_, At[m])), "v"(mx_one)); \
        } else { \
            acc[ai][bj][m][n] = __builtin_amdgcn_mfma_f32_16x16x32_bf16(__builtin_shufflevector(Bt[n], Bt[n], 0, 1, 2, 3, 4, 5, 6, 7), __builtin_shufflevector(At[m], At[m], 0, 1, 2, 3, 4, 5, 6, 7), acc[ai][bj][m][n], 0, 0, 0); \
            acc[ai][bj][m][n] = __builtin_amdgcn_mfma_f32_16x16x32_bf16(__builtin_shufflevector(Bt[n], Bt[n], 8, 9, 10, 11, 12, 13, 14, 15), __builtin_shufflevector(At[m], At[m], 8, 9, 10, 11, 12, 13, 14, 15), acc[ai][bj][m][n], 0, 0, 0); } } \
        __builtin_amdgcn_s_setprio(0); } while (0)
#define PG8_WAIT_V(n) asm volatile("s_waitcnt vmcnt(" #n ")" ::: "memory")
#define PG8_WAIT_L(n) asm volatile("s_waitcnt lgkmcnt(" #n ")" ::: "memory")
#define PG8_BAR __builtin_amdgcn_s_barrier()
#define PG8_SCHED __builtin_amdgcn_sched_barrier(0)
    Unit cur, nxt; int ui = 0;
    if (!S.next(0, cur)) return;
    f32x4 acc[2][2][4][2];
#pragma unroll
    for (int a = 0; a < 2; ++a)
#pragma unroll
        for (int b = 0; b < 2; ++b)
#pragma unroll
            for (int m = 0; m < 4; ++m)
#pragma unroll
                for (int n = 0; n < 2; ++n) acc[a][b][m][n] = (f32x4){0.f, 0.f, 0.f, 0.f};
    if constexpr (Epi::HAS_INIT) E.init(acc, cur, wr, wc, fr, fq);
    const int mx_one = 0x7f7f7f7f;
    typedef short bf16x16 __attribute__((ext_vector_type(16)));
    bf16x16 At[4], B0[2], B1[2];
    const char* cA = S.a_base(g, cur, tstep); const char* cB = S.b_base(g, cur, tstep);
    S.a_ready(cur);
    if constexpr (SP2) {
        PG8_STAGE(PG8_SB(0, 0), cB, voffB); PG8_STAGE(PG8_SB(0, 1), cB + hstep, voffB); PG8_STAGE(PG8_SA(0, 0), PG8_AP(cA, 0, 0), voffA); PG8_STAGE(PG8_SA(0, 1), PG8_AP(cA, 1, 0), voffA);
        if (wr == 1) PG8_BAR;
        PG8_WAIT_V(2); PG8_BAR;
        PG8_STAGE(PG8_SB(1, 0), cB + kstep, voffB); PG8_STAGE(PG8_SA(1, 0), PG8_AP(cA, 0, 1), voffA); PG8_STAGE(PG8_SB(1, 1), cB + hstep + kstep, voffB);
        PG8_WAIT_V(6); PG8_BAR;
    } else {
        PG8_STAGE(PG8_SB(0, 0), cB, voffB); PG8_STAGE(PG8_SA(0, 0), PG8_AP(cA, 0, 0), voffA); PG8_STAGE(PG8_SB(0, 1), cB + hstep, voffB); PG8_STAGE(PG8_SA(0, 1), PG8_AP(cA, 1, 0), voffA);
        if (wr == 1) PG8_BAR;
        PG8_WAIT_V(4); PG8_BAR;
        PG8_STAGE(PG8_SB(1, 0), cB + kstep, voffB); PG8_STAGE(PG8_SA(1, 0), PG8_AP(cA, 0, 1), voffA); PG8_STAGE(PG8_SB(1, 1), cB + hstep + kstep, voffB);
        PG8_WAIT_V(6); PG8_BAR;
    }
    for (;;) {
        const bool has_next = S.next(ui + 1, nxt);
        const char* nA = has_next ? S.a_base(g, nxt, tstep) : cA; const char* nB = has_next ? S.b_base(g, nxt, tstep) : cB;
        for (int t = 0; t < nt; t += 2) {
            const bool last = (t == nt - 2);
            const char* a2b = last ? nA : cA; const int a2k = last ? 0 : t + 2; const char* b2 = last ? nB : cB + (size_t)(t + 2) * kstep;
            const char* b3 = b2 + kstep;
            const char* a1h = PG8_AP(cA, 1, t + 1); const char* a2 = PG8_AP(a2b, 0, a2k); const char* a2h = PG8_AP(a2b, 1, a2k); const char* a3 = PG8_AP(a2b, 0, a2k + 1);
            if (last && has_next) S.a_ready(nxt);
            if constexpr (SP2) {
            PG8_LDB(B0, 0, 0); PG8_LDB(B1, 0, 1); PG8_SCHED; PG8_LDA(At, 0, 0); PG8_STAGE(PG8_SA(1, 1), a1h, voffA);
            PG8_WAIT_V(8); PG8_WAIT_L(0); PG8_BAR; PG8_MMA(0, 0, At, B0); PG8_MMA(0, 1, At, B1); PG8_BAR; PG8_SCHED;
            PG8_LDA(At, 0, 1); PG8_STAGE(PG8_SB(0, 0), b2, voffB); PG8_STAGE(PG8_SB(0, 1), b2 + hstep, voffB); PG8_STAGE(PG8_SA(0, 0), a2, voffA);
            PG8_WAIT_V(8); PG8_WAIT_L(0); PG8_BAR; PG8_MMA(1, 0, At, B0); PG8_MMA(1, 1, At, B1); PG8_BAR; PG8_SCHED;
            PG8_LDB(B0, 1, 0); PG8_LDB(B1, 1, 1); PG8_SCHED; PG8_LDA(At, 1, 0); PG8_STAGE(PG8_SA(0, 1), a2h, voffA);
            PG8_WAIT_V(8); PG8_WAIT_L(0); PG8_BAR; PG8_MMA(0, 0, At, B0); PG8_MMA(0, 1, At, B1); PG8_BAR; PG8_SCHED;
            PG8_LDA(At, 1, 1); PG8_STAGE(PG8_SB(1, 0), b3, voffB); PG8_STAGE(PG8_SB(1, 1), b3 + hstep, voffB); PG8_STAGE(PG8_SA(1, 0), a3, voffA);
            PG8_WAIT_V(8); PG8_WAIT_L(0); PG8_BAR; PG8_MMA(1, 0, At, B0); PG8_MMA(1, 1, At, B1); PG8_BAR; PG8_SCHED;
            } else {
            PG8_LDB(B0, 0, 0); PG8_SCHED; PG8_LDA(At, 0, 0); PG8_STAGE(PG8_SA(1, 1), a1h, voffA);
            PG8_WAIT_L(8); PG8_BAR; PG8_WAIT_L(0); PG8_MMA(0, 0, At, B0); PG8_BAR; PG8_SCHED;
            PG8_LDB(B1, 0, 1); PG8_STAGE(PG8_SB(0, 0), b2, voffB);
            PG8_BAR; PG8_WAIT_L(0); PG8_MMA(0, 1, At, B1); PG8_BAR;
            PG8_LDA(At, 0, 1); PG8_STAGE(PG8_SA(0, 0), a2, voffA);
            PG8_BAR; PG8_WAIT_L(0); PG8_MMA(1, 0, At, B0); PG8_BAR; PG8_SCHED;
            PG8_STAGE(PG8_SB(0, 1), b2 + hstep, voffB);
            PG8_WAIT_V(6); PG8_BAR; PG8_MMA(1, 1, At, B1); PG8_BAR;
            PG8_LDB(B0, 1, 0); PG8_SCHED; PG8_LDA(At, 1, 0); PG8_STAGE(PG8_SA(0, 1), a2h, voffA);
            PG8_WAIT_L(8); PG8_BAR; PG8_WAIT_L(0); PG8_MMA(0, 0, At, B0); PG8_BAR; PG8_SCHED;
            PG8_LDB(B1, 1, 1); PG8_STAGE(PG8_SB(1, 0), b3, voffB);
            PG8_BAR; PG8_WAIT_L(0); PG8_MMA(0, 1, At, B1); PG8_BAR;
            PG8_LDA(At, 1, 1); PG8_STAGE(PG8_SA(1, 0), a3, voffA);
            PG8_BAR; PG8_WAIT_L(0); PG8_MMA(1, 0, At, B0); PG8_BAR; PG8_SCHED;
            PG8_STAGE(PG8_SB(1, 1), b3 + hstep, voffB);
            PG8_WAIT_V(6); PG8_BAR; PG8_MMA(1, 1, At, B1); PG8_BAR;
            }
        }
        if constexpr (ALIGN_EPI) { if (wr == 0) PG8_BAR; }
        if constexpr (!Epi::AFTER_DRAIN) { E(acc, cur, wr, wc, fr, fq); S.done(cur); }
        if (!has_next) break;
        if (!(Epi::CARRY && cur.which == 0)) {
#pragma unroll
        for (int a = 0; a < 2; ++a)
#pragma unroll
            for (int b = 0; b < 2; ++b)
#pragma unroll
                for (int m = 0; m < 4; ++m)
#pragma unroll
                    for (int n = 0; n < 2; ++n) acc[a][b][m][n] = (f32x4){0.f, 0.f, 0.f, 0.f};
        }
        if constexpr (Epi::HAS_INIT) E.init(acc, nxt, wr, wc, fr, fq);
        cur = nxt; cA = nA; cB = nB; ++ui;
        if constexpr (ALIGN_EPI) { if (wr == 1) PG8_BAR; }
    }
    PG8_WAIT_V(0);
    if constexpr (!ALIGN_EPI) { if (wr == 0) PG8_BAR; }
    PG8_BAR;
    if constexpr (Epi::AFTER_DRAIN) { E.fused(acc, cur, wr, wc, fr, fq, lds, wid, lane); S.done(cur); }
#undef PG8_AP
#undef PG8_SA
#undef PG8_SB
#undef PG8_STAGE
#undef PG8_LDA
#undef PG8_LDB
#undef PG8_MMA
#undef PG8_WAIT_V
#undef PG8_WAIT_L
#undef PG8_BAR
#undef PG8_SCHED
}
}

#ifndef PG8_SP2
#define PG8_SP2 true
#endif
#ifndef PG8_ALIGN
#define PG8_ALIGN true
#endif
#ifndef MK_ONE_LAUNCH
#define MK_ONE_LAUNCH 1
#endif

constexpr int NWAVES = 8;
constexpr int T = 32768, D = 1024, SEQ = 4096;
constexpr int IN_DIM = 4352, PA_W = 2304, G_W = 2048;
constexpr int N16 = 1536, N8 = IN_DIM - N16;
constexpr int C_U = 0, C_B = 512, C_C = 1024, C_Q = 1536, C_K = 2048, C_V = 2176;
constexpr int CONV = 512, HD = 64, NH = 8, NKV = 2;
constexpr int PH = 8, NKEYS = 128, PQ = 2048, TOPK = 16, NEXP = 16384, NSEL = 128;
constexpr float EPS = 1e-6f;
constexpr int N_PHASES = 10;

constexpr size_t MiB = 1u << 20;
constexpr size_t WS_CTL = 0, CTL_ZERO_BYTES = 1 * MiB;
constexpr size_t WS_WIN = 2 * MiB;
constexpr size_t WS_WG8 = WS_WIN + 3072 * 1024;
constexpr size_t WS_WC = 11 * MiB;
constexpr size_t WS_WA = 12 * MiB;
constexpr size_t WS_WO = 13 * MiB;
constexpr size_t WS_WQ = 15 * MiB;
constexpr size_t WS_SK = 19 * MiB;
constexpr size_t WS_RSTD1 = 20 * MiB;
constexpr size_t WS_SSQ = 21 * MiB;
constexpr size_t WS_UB = 24 * MiB;
constexpr size_t WS_SU = 32 * MiB;
constexpr size_t WS_VB = 40 * MiB;
constexpr size_t WS_SV = 48 * MiB;
constexpr size_t WS_XB8 = 56 * MiB;
constexpr size_t WS_XB = 88 * MiB;
constexpr size_t WS_PA = 152 * MiB;
constexpr size_t WS_MIX = WS_PA;
constexpr size_t WS_G = 296 * MiB;
constexpr size_t WS_QP = WS_G;
constexpr size_t WS_Z = 424 * MiB;
constexpr size_t WS_ATT = 456 * MiB;
constexpr size_t WS_IDX = WS_Z, WS_GATE = WS_ATT;
constexpr size_t WS_PART = WS_PA;
constexpr size_t WS_ACT = WS_G;
constexpr size_t WS_END = 488 * MiB;
constexpr int CW_BAR = 4096;

constexpr int RING_OFF = 0, RING_BYTES = 131072;
constexpr int LDSCTL_OFF = 147456, MISC_OFF = LDSCTL_OFF + 320;
constexpr int P9_OUT_OFF = 148480;
constexpr int LDS_BYTES = 156672;
#define GAS __attribute__((address_space(1)))
#define LAS __attribute__((address_space(3)))
typedef unsigned short bf16;
typedef unsigned v4u __attribute__((ext_vector_type(4)));
typedef float f32x4 __attribute__((ext_vector_type(4)));
typedef short bf16x8 __attribute__((ext_vector_type(8)));
typedef GAS unsigned gu32;
typedef GAS unsigned long long gu64;
#define RLX_AGENT __ATOMIC_RELAXED, __HIP_MEMORY_SCOPE_AGENT
#define LDS_WAIT() asm volatile("s_waitcnt lgkmcnt(0)" ::: "memory")
#define VM_WAIT() asm volatile("s_waitcnt vmcnt(0)" ::: "memory")
__device__ __forceinline__ unsigned long long rt() { return __builtin_amdgcn_s_memrealtime(); }
__device__ __forceinline__ unsigned f2bf(float f) { unsigned u = __builtin_bit_cast(unsigned, f); return (u + 0x7fffu + ((u >> 16) & 1u)) >> 16; }
__device__ __forceinline__ unsigned pk2(float lo, float hi) { return f2bf(lo) | (f2bf(hi) << 16); }

#define XB_TMO      128
#define XB_XCNT(j)  (256  + 64 * (j))
#define XB_XSUB(j)  (1280 + 64 * (j))
#define XB_XGEN(j)  (2304 + 64 * (j))
#define XB_TOP      3328
#define XB_TOPGEN   3392
#define XCD_BAR_WORDS 3456
#define XB_LSUB(j)  (3456 + 64 * (j))
#define XB_LGEN(j)  (4480 + 64 * (j))
#define XB_SPIN_CAP (1u << 18)

__device__ __forceinline__ unsigned xb_ld(unsigned* p)              { return __hip_atomic_load(p, __ATOMIC_RELAXED, __HIP_MEMORY_SCOPE_AGENT); }
__device__ __forceinline__ unsigned xb_add(unsigned* p, unsigned v) { return __hip_atomic_fetch_add(p, v, __ATOMIC_RELAXED, __HIP_MEMORY_SCOPE_AGENT); }
__device__ __forceinline__ unsigned xb_xcc_id() { return (unsigned)__builtin_amdgcn_s_getreg((3 << 11) | 20) & 0xFu; }
#define XB_SPIN(cond, bar) do { unsigned _sp = 0; while (cond) { __builtin_amdgcn_s_sleep(1); \
    if ((++_sp & 255u) == 0u) { if (xb_ld(&(bar)[XB_TMO])) break; if (_sp > XB_SPIN_CAP) { atomicAdd(&(bar)[XB_TMO], 1u); break; } } } } while (0)

struct XcdBarrier {
    unsigned* bar; unsigned x;
    volatile LAS unsigned* st;
};

__device__ __forceinline__ XcdBarrier xcd_barrier_post(unsigned* bar, volatile LAS unsigned* st) {
    XcdBarrier b; b.bar = bar; b.x = xb_xcc_id(); b.st = st;
    if (threadIdx.x == 0) st[2] = xb_add(&bar[XB_XCNT(b.x)], 1u);
    return b;
}
__device__ __forceinline__ void xcd_barrier_complete(unsigned* bar, unsigned x, unsigned& nloc, unsigned& nx) {
    const unsigned G = gridDim.x * gridDim.y * gridDim.z;
    unsigned sum, cnt, mine, sp = 0u;
    for (;;) {
        sum = 0u; cnt = 0u; mine = 0u;
#pragma unroll
        for (unsigned j = 0; j < 16; ++j) { const unsigned c = xb_ld(&bar[XB_XCNT(j)]); sum += c; cnt += (c > 0u) ? 1u : 0u; mine = (j == x) ? c : mine; }
        if (sum == G) break;
        __builtin_amdgcn_s_sleep(1);
        if ((++sp & 255u) == 0u) { if (xb_ld(&bar[XB_TMO])) break; if (sp > XB_SPIN_CAP) { atomicAdd(&bar[XB_TMO], 1u); break; } }
    }
    nloc = mine > 0u ? mine : 1u; nx = cnt > 0u ? cnt : 1u;
}

__device__ __forceinline__ void xcd_barrier(const XcdBarrier& b) {
    asm volatile("s_waitcnt vmcnt(0)" ::: "memory");
    __syncthreads();
    if (threadIdx.x == 0) {
        unsigned* bar = b.bar;
        __builtin_amdgcn_s_waitcnt(0);
        unsigned nloc = b.st[0], nx = b.st[1];
        if (nloc == 0u) { xcd_barrier_complete(bar, b.x, nloc, nx); b.st[0] = nloc; b.st[1] = nx; }
        const unsigned old = xb_add(&bar[XB_XSUB(b.x)], 1u);
        const unsigned gen = old / nloc;
        if (old + 1u == (gen + 1u) * nloc) {
            __builtin_amdgcn_fence(__ATOMIC_RELEASE, "agent");
            asm volatile("s_waitcnt vmcnt(0)" ::: "memory");
            const unsigned og = xb_add(&bar[XB_TOP], 1u);
            const unsigned tg = og / nx;
            if (og + 1u == (tg + 1u) * nx) xb_add(&bar[XB_TOPGEN], 1u);
            else XB_SPIN(xb_ld(&bar[XB_TOPGEN]) == tg, bar);
            __builtin_amdgcn_fence(__ATOMIC_ACQUIRE, "agent");
            xb_add(&bar[XB_XGEN(b.x)], 1u);
            asm volatile("s_waitcnt vmcnt(0)" ::: "memory");
        } else {
            XB_SPIN(xb_ld(&bar[XB_XGEN(b.x)]) == gen, bar);
            __builtin_amdgcn_fence(__ATOMIC_ACQUIRE, "agent");
            asm volatile("s_waitcnt vmcnt(0)" ::: "memory");
        }
    }
    __syncthreads();
}

__device__ __forceinline__ void xcd_local_barrier(const XcdBarrier& b) {
    asm volatile("s_waitcnt vmcnt(0)" ::: "memory");
    __syncthreads();
    if (threadIdx.x == 0) {
        unsigned* bar = b.bar;
        __builtin_amdgcn_s_waitcnt(0);
        const unsigned nloc = b.st[0];
        const unsigned old = xb_add(&bar[XB_LSUB(b.x)], 1u);
        const unsigned gen = old / nloc;
        if (old + 1u == (gen + 1u) * nloc) xb_add(&bar[XB_LGEN(b.x)], 1u);
        else XB_SPIN(xb_ld(&bar[XB_LGEN(b.x)]) == gen, bar);
        __builtin_amdgcn_fence(__ATOMIC_ACQUIRE, "agent");
        asm volatile("s_waitcnt vmcnt(0)" ::: "memory");
    }
    __syncthreads();
}

typedef float f32x16 __attribute__((ext_vector_type(16)));
typedef unsigned v2u __attribute__((ext_vector_type(2)));
typedef int v4i __attribute__((ext_vector_type(4)));
typedef __bf16 bf2_t __attribute__((ext_vector_type(2)));
#define DI __device__ __forceinline__
struct Frame {
    LAS unsigned char* lds;
    volatile LAS unsigned* MISC;
    gu32* ctl;
    int tid, lane, wave, vcu, G;
    int xlocal, xq, xrank, cvirt;
    const float *x, *norm_mix, *norm_ffn, *w_in, *b_gate, *w_conv, *q_norm, *k_norm, *sinks, *rel_bias, *w_conv_out, *w_attn_out, *w_out, *w_query, *sub_keys, *expert_u, *expert_v;
    float* out;
    unsigned char* WG8; bf16 *WIN, *WC, *WA, *WO, *WQ, *SK, *UB, *VB, *XB, *PA, *MIX, *G_, *QP, *Z, *ATT;
    float *RSTD1, *SSQ, *GATE, *ACT, *SU, *SV; bf16* PARTB; unsigned char* XB8; unsigned short* IDX;
};
DI float wave_sum(float v) {
#pragma unroll
    for (int o = 1; o < 64; o <<= 1) v += __shfl_xor(v, o);
    return v;
}
DI float bf_lo(unsigned u) { return __builtin_bit_cast(float, u << 16); }
DI float bf_hi(unsigned u) { return __builtin_bit_cast(float, u & 0xffff0000u); }

constexpr float WG_SCALE = 32.f;
DI void p0_transpose_item(const float* W, int K, int N, bf16* WT, const float* gsc, LAS float* scr, int item, int lane, int n8 = 1 << 30, unsigned char* W8 = nullptr) {
    const int nblk = N / 32, kb = item / nblk, nb = item % nblk, k0 = 64 * kb, n0 = 32 * nb;
#pragma unroll 8
    for (int i = 0; i < 32; ++i) { const int kk = 2 * i + (lane >> 5); float v = W[(size_t)(k0 + kk) * N + n0 + (lane & 31)]; if (gsc) v *= gsc[k0 + kk]; scr[kk * 33 + (lane & 31)] = v; }
    LDS_WAIT(); asm volatile("" ::: "memory");
    const int c = lane & 7;
#pragma unroll
    for (int j = 0; j < 4; ++j) { const int n = (lane >> 3) + 8 * j; const LAS float* s = scr + (8 * c) * 33 + n;
        if (n0 >= n8) {
            int p0_ = 0, p1_ = 0;
            p0_ = __builtin_amdgcn_cvt_pk_fp8_f32(s[0 * 33] * WG_SCALE, s[1 * 33] * WG_SCALE, p0_, false); p0_ = __builtin_amdgcn_cvt_pk_fp8_f32(s[2 * 33] * WG_SCALE, s[3 * 33] * WG_SCALE, p0_, true);
            p1_ = __builtin_amdgcn_cvt_pk_fp8_f32(s[4 * 33] * WG_SCALE, s[5 * 33] * WG_SCALE, p1_, false); p1_ = __builtin_amdgcn_cvt_pk_fp8_f32(s[6 * 33] * WG_SCALE, s[7 * 33] * WG_SCALE, p1_, true);
            v2u o8; o8.x = (unsigned)p0_; o8.y = (unsigned)p1_; *(GAS v2u*)(W8 + (size_t)(n0 + n - n8) * K + k0 + 8 * c) = o8; continue; }
        v4u o; o.x = pk2(s[0 * 33], s[1 * 33]); o.y = pk2(s[2 * 33], s[3 * 33]); o.z = pk2(s[4 * 33], s[5 * 33]); o.w = pk2(s[6 * 33], s[7 * 33]);
        *(GAS v4u*)(WT + (size_t)(n0 + n) * K + k0 + 8 * c) = o; }
    LDS_WAIT(); asm volatile("" ::: "memory");
}
DI void p0_convert(Frame& F, const float* src, bf16* dst, size_t n, const float* colscale) {
    const size_t n8 = n / 8, stride = (size_t)F.G * NWAVES * 64;
    for (size_t i = (size_t)F.vcu * NWAVES * 64 + F.tid; i < n8; i += stride) {
        f32x4 a = *(const GAS f32x4*)(src + i * 8), b = *(const GAS f32x4*)(src + i * 8 + 4);
        if (colscale) { const int c = (int)((i * 8) & 1023); const f32x4 s0 = *(const GAS f32x4*)(colscale + c), s1 = *(const GAS f32x4*)(colscale + c + 4); a = a * s0; b = b * s1; }
        v4u o; o.x = pk2(a.x, a.y); o.y = pk2(a.z, a.w); o.z = pk2(b.x, b.y); o.w = pk2(b.z, b.w);
        *(GAS v4u*)(dst + i * 8) = o;
    }
}
constexpr float A_SCALE = 128.f;
DI unsigned pk4_fp8(f32x4 v) { int r = 0; r = __builtin_amdgcn_cvt_pk_fp8_f32(v[0], v[1], r, false); r = __builtin_amdgcn_cvt_pk_fp8_f32(v[2], v[3], r, true); return (unsigned)r; }
DI void p0_convert_fp8(Frame& F, const float* src, unsigned char* dst, size_t n, const float* colscale, float scale, int bidx, int nblk) {
    const int gw = bidx * NWAVES + F.wave, NGW = nblk * NWAVES, lane = F.lane;
    f32x4 cs[4];
#pragma unroll
    for (int q = 0; q < 4; ++q) cs[q] = colscale ? *(const GAS f32x4*)(colscale + 4 * lane + 256 * q) * scale : (f32x4){scale, scale, scale, scale};
    const int nrows = (int)(n / D);
    for (int e = gw; e < nrows; e += NGW) {
        const GAS f32x4* rp = (const GAS f32x4*)(src + (size_t)e * D) + lane;
        f32x4 v[4];
#pragma unroll
        for (int q = 0; q < 4; ++q) v[q] = rp[64 * q];
#pragma unroll
        for (int q = 0; q < 4; ++q) *(GAS unsigned*)(dst + ((size_t)(2 * q + (lane >> 5)) * NEXP + e) * 128 + ((4 * lane) & 127)) = pk4_fp8(v[q] * cs[q]);
    }
}
DI void p0_convert_fp4(Frame& F, const float* src, const float* gain, unsigned char* dst, float* scl, int e0, int e1) {
    const int gw = F.wave, NGW = NWAVES, lane = F.lane;
    f32x4 cs[4];
#pragma unroll
    for (int q = 0; q < 4; ++q) cs[q] = gain ? *(const GAS f32x4*)(gain + 4 * lane + 256 * q) : (f32x4){1.f, 1.f, 1.f, 1.f};
    for (int e = e0 + gw; e < e1; e += NGW) {
        const GAS f32x4* rp = (const GAS f32x4*)(src + (size_t)e * D) + lane;
        f32x4 v[4]; float mx = 0.f;
#pragma unroll
        for (int q = 0; q < 4; ++q) { v[q] = rp[64 * q] * cs[q]; mx = fmaxf(mx, fmaxf(fmaxf(fabsf(v[q][0]), fabsf(v[q][1])), fmaxf(fabsf(v[q][2]), fabsf(v[q][3])))); }
#pragma unroll
        for (int o = 1; o < 64; o <<= 1) mx = fmaxf(mx, __shfl_xor(mx, o));
        const float inv = mx > 0.f ? 6.f / mx : 0.f;
        if (lane == 0) scl[e] = mx * (1.f / 6.f);
#pragma unroll
        for (int q = 0; q < 4; ++q) { unsigned r = 0u;
            r = __builtin_amdgcn_cvt_scalef32_pk_fp4_f32(r, v[q][0] * inv, v[q][1] * inv, 1.0f, 0);
            r = __builtin_amdgcn_cvt_scalef32_pk_fp4_f32(r, v[q][2] * inv, v[q][3] * inv, 1.0f, 1);
            *(GAS unsigned short*)(dst + ((size_t)q * NEXP + e) * 128 + 2 * lane) = (unsigned short)r; }
    }
}
template <int RB> DI void p0_rows(Frame& F, const float* xrow, bf16* orow, float* rms_out, unsigned char* o8row) {
    f32x4 v[RB][4]; float s[RB];
#pragma unroll
    for (int r = 0; r < RB; ++r) { const GAS f32x4* xr = (const GAS f32x4*)(xrow + (size_t)r * D) + F.lane;
#pragma unroll
        for (int j = 0; j < 4; ++j) v[r][j] = xr[64 * j]; }
#pragma unroll
    for (int r = 0; r < RB; ++r) { s[r] = 0.f;
#pragma unroll
        for (int j = 0; j < 4; ++j) s[r] += (v[r][j].x * v[r][j].x + v[r][j].y * v[r][j].y) + (v[r][j].z * v[r][j].z + v[r][j].w * v[r][j].w); }
#pragma unroll
    for (int o = 1; o < 64; o <<= 1)
#pragma unroll
        for (int r = 0; r < RB; ++r) s[r] += __shfl_xor(s[r], o);
#pragma unroll
    for (int r = 0; r < RB; ++r) { const float rms = sqrtf(s[r] * (1.f / D) + EPS), rs = 1.f / rms; if (F.lane == 0) rms_out[r] = rms;
        GAS unsigned long long* o8 = (GAS unsigned long long*)(orow + (size_t)r * D) + F.lane;
#pragma unroll
        for (int j = 0; j < 4; ++j) { o8[64 * j] = (unsigned long long)pk2(v[r][j].x * rs, v[r][j].y * rs) | ((unsigned long long)pk2(v[r][j].z * rs, v[r][j].w * rs) << 32);
            *(GAS unsigned*)(o8row + (size_t)r * D + 4 * F.lane + 256 * j) = pk4_fp8(v[r][j] * rs); } }
}
DI void p0_prologue(Frame& F) {
    LAS float* scr = (LAS float*)(F.lds + RING_OFF + F.wave * 16384);
    const int gw = F.vcu * NWAVES + F.wave, NGW = F.G * NWAVES;
    constexpr int I_IN = (D / 64) * (IN_DIM / 32), I_C = (CONV / 64) * (D / 32), I_O = (D / 64) * (D / 32), I_Q = (D / 64) * (PQ / 32);
    constexpr int NITEMS = I_IN + 2 * I_C + I_O + I_Q;
    for (int it = gw; it < NITEMS; it += NGW) {
        int r = it;
        if (r < I_IN) { p0_transpose_item(F.w_in, D, IN_DIM, F.WIN, F.norm_mix, scr, r, F.lane, N16, F.WG8); continue; } r -= I_IN;
        if (r < I_C) { p0_transpose_item(F.w_conv_out, CONV, D, F.WC, nullptr, scr, r, F.lane); continue; } r -= I_C;
        if (r < I_C) { p0_transpose_item(F.w_attn_out, CONV, D, F.WA, nullptr, scr, r, F.lane); continue; } r -= I_C;
        if (r < I_O) { p0_transpose_item(F.w_out, D, D, F.WO, nullptr, scr, r, F.lane); continue; } r -= I_O;
        p0_transpose_item(F.w_query, D, PQ, F.WQ, F.norm_ffn, scr, r, F.lane);
    }
    p0_convert(F, F.sub_keys, F.SK, (size_t)PH * 2 * NKEYS * 128, nullptr);
    for (int m = 4 * gw; m < T; m += 4 * NGW) p0_rows<4>(F, F.x + (size_t)m * D, F.XB + (size_t)m * D, F.RSTD1 + m, F.XB8 + (size_t)m * D);
}

namespace pg8 {
DI float sigmoidf_(float v) { return __builtin_amdgcn_rcpf(1.f + __expf(-v)); }
DI size_t frag_off(int pm, int pn, int NT, int wave, int q, int lane) { return (((((size_t)pm * NT + pn) * 8 + wave) * 16 + q) * 64 + lane) * 8; }
struct EpiProj {
    static constexpr bool PERM = true, AFTER_DRAIN = false, HAS_INIT = false, CARRY = false;
    bf16_t* PA; bf16_t* G; const PG8_LAS float* bgl; int pa_col0, pn_gate0; float gsc;
    DI void operator()(const f32x4 (&acc)[2][2][4][2], const Unit& u, int wr, int wc, int fr, int fq) const {
        const int row0 = u.pm * BM + wr * 64 + fr; const bool gate = u.pn >= pn_gate0;
        const int col0 = (gate ? (u.pn - pn_gate0) * BM : pa_col0 + u.pn * BM) + wc * 32 + 8 * fq;
        if (!gate) {
#pragma unroll
            for (int ai = 0; ai < 2; ++ai)
#pragma unroll
                for (int m = 0; m < 4; ++m) { bf16_t* rowp = PA + (size_t)(row0 + ai * HALF + m * 16) * PA_W + col0;
#pragma unroll
                    for (int bj = 0; bj < 2; ++bj) { const f32x4 v0 = acc[ai][bj][m][0] * gsc, v1 = acc[ai][bj][m][1] * gsc;
                        u32x4 w; w.x = cvt_pk_bf16(v0[0], v0[1]); w.y = cvt_pk_bf16(v0[2], v0[3]); w.z = cvt_pk_bf16(v1[0], v1[1]); w.w = cvt_pk_bf16(v1[2], v1[3]);
                        store16_wt(rowp + bj * HALF, w); } }
        } else {
            f32x4 bv[2][2];
#pragma unroll
            for (int bj = 0; bj < 2; ++bj)
#pragma unroll
                for (int n = 0; n < 2; ++n) bv[bj][n] = *(const PG8_LAS f32x4*)(bgl + col0 + bj * HALF + 4 * n);
#pragma unroll
            for (int ai = 0; ai < 2; ++ai)
#pragma unroll
                for (int m = 0; m < 4; ++m)
#pragma unroll
                    for (int bj = 0; bj < 2; ++bj) { f32x4 v0 = acc[ai][bj][m][0] * gsc + bv[bj][0], v1 = acc[ai][bj][m][1] * gsc + bv[bj][1];
#pragma unroll
                        for (int j = 0; j < 4; ++j) { v0[j] = fmaxf(sigmoidf_(v0[j]) * 255.f, 1.f); v1[j] = fmaxf(sigmoidf_(v1[j]) * 255.f, 1.f); }
                        unsigned g0 = 0u, g1 = 0u;
                        g0 = __builtin_amdgcn_cvt_pk_u8_f32(v0[0], 0, g0); g0 = __builtin_amdgcn_cvt_pk_u8_f32(v0[1], 1, g0); g0 = __builtin_amdgcn_cvt_pk_u8_f32(v0[2], 2, g0); g0 = __builtin_amdgcn_cvt_pk_u8_f32(v0[3], 3, g0);
                        g1 = __builtin_amdgcn_cvt_pk_u8_f32(v1[0], 0, g1); g1 = __builtin_amdgcn_cvt_pk_u8_f32(v1[1], 1, g1); g1 = __builtin_amdgcn_cvt_pk_u8_f32(v1[2], 2, g1); g1 = __builtin_amdgcn_cvt_pk_u8_f32(v1[3], 3, g1);
                        u32x2 gw; gw.x = g0; gw.y = g1;
                        *(u32x2*)((unsigned char*)G + frag_off(u.pm, u.pn - pn_gate0, 8, wr * 4 + wc, ai * 8 + m * 2 + bj, fq * 16 + fr)) = gw; }
        }
    }
};
struct EpiMix {
    static constexpr bool PERM = true, AFTER_DRAIN = false, HAS_INIT = false, CARRY = true;
    bf16_t* MIX; const bf16_t* G;
    DI void operator()(f32x4 (&acc)[2][2][4][2], const Unit& u, int wr, int wc, int fr, int fq) const {
        const int wave = wr * 4 + wc, lane = fq * 16 + fr;
        const unsigned char* gc = (const unsigned char*)G + frag_off(u.pm, u.pn, 8, wave, 0, lane); const unsigned char* ga = (const unsigned char*)G + frag_off(u.pm, u.pn + 4, 8, wave, 0, lane);
        bf16_t* mp = MIX + frag_off(u.pm, u.pn, 4, wave, 0, lane);
#pragma unroll
        for (int ai = 0; ai < 2; ++ai) {
            u32x2 gav[8], gcv[8];
#pragma unroll
            for (int q = 0; q < 8; ++q) gav[q] = *(const u32x2*)(ga + (ai * 8 + q) * 512);
            if (!u.which) {
#pragma unroll
                for (int q = 0; q < 8; ++q) gcv[q] = *(const u32x2*)(gc + (ai * 8 + q) * 512); }
#pragma unroll
            for (int m = 0; m < 4; ++m)
#pragma unroll
                for (int bj = 0; bj < 2; ++bj) { const int q = m * 2 + bj; const u32x2 a2 = gav[q];
                    float fa[8] = {(float)(a2.x & 0xffu), (float)((a2.x >> 8) & 0xffu), (float)((a2.x >> 16) & 0xffu), (float)(a2.x >> 24), (float)(a2.y & 0xffu), (float)((a2.y >> 8) & 0xffu), (float)((a2.y >> 16) & 0xffu), (float)(a2.y >> 24)};
                    if (!u.which) { const u32x2 c2 = gcv[q];
                        const float fc[8] = {(float)(c2.x & 0xffu), (float)((c2.x >> 8) & 0xffu), (float)((c2.x >> 16) & 0xffu), (float)(c2.x >> 24), (float)(c2.y & 0xffu), (float)((c2.y >> 8) & 0xffu), (float)((c2.y >> 16) & 0xffu), (float)(c2.y >> 24)};
#pragma unroll
                        for (int e = 0; e < 4; ++e) { acc[ai][bj][m][0][e] *= fc[e] * __builtin_amdgcn_rcpf(fa[e]); acc[ai][bj][m][1][e] *= fc[4 + e] * __builtin_amdgcn_rcpf(fa[4 + e]); }
                    } else { constexpr float GI = 1.f / 255.f;
                        const f32x4 v0 = acc[ai][bj][m][0], v1 = acc[ai][bj][m][1];
                        u32x4 w; w.x = cvt_pk_bf16(v0[0] * fa[0] * GI, v0[1] * fa[1] * GI); w.y = cvt_pk_bf16(v0[2] * fa[2] * GI, v0[3] * fa[3] * GI);
                        w.z = cvt_pk_bf16(v1[0] * fa[4] * GI, v1[1] * fa[5] * GI); w.w = cvt_pk_bf16(v1[2] * fa[6] * GI, v1[3] * fa[7] * GI);
                        store16_wt(mp + (ai * 8 + q) * 512, w); } }
        }
    }
};
struct FragOrder : StaticOrder { static constexpr bool AFRAG = true; };
struct PairOrder : StaticOrder {
    __device__ bool next(int i, Unit& u) const { const bool ok = StaticOrder::next(i >> 1, u); u.which = i & 1; return ok; }
    DI const char* a_base(const Gemm& g, const Unit& u, size_t tstep) const { return (const char*)(u.which ? g.A2 : g.A) + (size_t)u.pm * tstep; }
    DI const char* b_base(const Gemm& g, const Unit& u, size_t tstep) const { return (const char*)(u.which ? g.Bt2 : g.Bt) + (size_t)u.pn * tstep; }
};
struct EpiX1 {
    static constexpr bool PERM = true, AFTER_DRAIN = false, HAS_INIT = true, CARRY = false;
    const float* RMS; bf16_t* XB; float* SSQ; unsigned char* XB8;
    DI void init(f32x4 (&acc)[2][2][4][2], const Unit& u, int wr, int wc, int fr, int fq) const {
        const int row0 = u.pm * BM + wr * 64 + fr, col0 = u.pn * BM + wc * 32 + 8 * fq;
#pragma unroll
        for (int ai = 0; ai < 2; ++ai)
#pragma unroll
            for (int m = 0; m < 4; ++m)
#pragma unroll
                for (int bj = 0; bj < 2; ++bj) { const int row = row0 + ai * HALF + m * 16; const float rm = RMS[row];
                    const u32x4 xn = *(const u32x4*)(XB + (size_t)row * D + col0 + bj * HALF);
                    acc[ai][bj][m][0] = (f32x4){__builtin_bit_cast(float, xn.x << 16), __builtin_bit_cast(float, xn.x & 0xffff0000u), __builtin_bit_cast(float, xn.y << 16), __builtin_bit_cast(float, xn.y & 0xffff0000u)} * rm;
                    acc[ai][bj][m][1] = (f32x4){__builtin_bit_cast(float, xn.z << 16), __builtin_bit_cast(float, xn.z & 0xffff0000u), __builtin_bit_cast(float, xn.w << 16), __builtin_bit_cast(float, xn.w & 0xffff0000u)} * rm; }
    }
    DI void operator()(const f32x4 (&acc)[2][2][4][2], const Unit& u, int wr, int wc, int fr, int fq) const {
        const int row0 = u.pm * BM + wr * 64 + fr, col0 = u.pn * BM + wc * 32 + 8 * fq;
#pragma unroll
        for (int ai = 0; ai < 2; ++ai)
#pragma unroll
            for (int m = 0; m < 4; ++m) { const int row = row0 + ai * HALF + m * 16; float ss = 0.f;
#pragma unroll
                for (int bj = 0; bj < 2; ++bj) { const f32x4 v0 = acc[ai][bj][m][0], v1 = acc[ai][bj][m][1];
                    ss += ((v0[0] * v0[0] + v0[1] * v0[1]) + (v0[2] * v0[2] + v0[3] * v0[3])) + ((v1[0] * v1[0] + v1[1] * v1[1]) + (v1[2] * v1[2] + v1[3] * v1[3]));
                    u32x4 w; w.x = cvt_pk_bf16(v0[0], v0[1]); w.y = cvt_pk_bf16(v0[2], v0[3]); w.z = cvt_pk_bf16(v1[0], v1[1]); w.w = cvt_pk_bf16(v1[2], v1[3]);
                    store16_wt(XB + (size_t)row * D + col0 + bj * HALF, w);
                    { int p0_ = 0, p1_ = 0;
                      p0_ = __builtin_amdgcn_cvt_pk_fp8_f32(v0[0], v0[1], p0_, false); p0_ = __builtin_amdgcn_cvt_pk_fp8_f32(v0[2], v0[3], p0_, true);
                      p1_ = __builtin_amdgcn_cvt_pk_fp8_f32(v1[0], v1[1], p1_, false); p1_ = __builtin_amdgcn_cvt_pk_fp8_f32(v1[2], v1[3], p1_, true);
                      u32x2 w8; w8.x = (unsigned)p0_; w8.y = (unsigned)p1_; *(u32x2*)(XB8 + (size_t)row * D + col0 + bj * HALF) = w8; } }
                ss += __shfl_xor(ss, 16); ss += __shfl_xor(ss, 32);
                if (fq == 0) SSQ[(size_t)row * 16 + u.pn * 4 + wc] = ss; }
    }
};
DI float rstd2_of(const float* SSQ, int row) {
    const f32x4 a = *(const f32x4*)(SSQ + (size_t)row * 16), b = *(const f32x4*)(SSQ + (size_t)row * 16 + 4), c = *(const f32x4*)(SSQ + (size_t)row * 16 + 8), d = *(const f32x4*)(SSQ + (size_t)row * 16 + 12);
    const float s = ((a[0] + a[1]) + (a[2] + a[3])) + ((b[0] + b[1]) + (b[2] + b[3])) + ((c[0] + c[1]) + (c[2] + c[3])) + ((d[0] + d[1]) + (d[2] + d[3]));
    return 1.f / sqrtf(s * (1.f / D) + EPS);
}
struct EpiQP {
    static constexpr bool PERM = true, AFTER_DRAIN = false, HAS_INIT = false, CARRY = false;
    bf16_t* QP;
    DI void operator()(const f32x4 (&acc)[2][2][4][2], const Unit& u, int wr, int wc, int fr, int fq) const {
        const int row0 = u.pm * BM + wr * 64 + fr, col0 = u.pn * BM + wc * 32 + 8 * fq;
#pragma unroll
        for (int ai = 0; ai < 2; ++ai)
#pragma unroll
            for (int m = 0; m < 4; ++m) {
#pragma unroll
                for (int bj = 0; bj < 2; ++bj) { const f32x4 v0 = acc[ai][bj][m][0], v1 = acc[ai][bj][m][1];
                    u32x4 w; w.x = cvt_pk_bf16(v0[0], v0[1]); w.y = cvt_pk_bf16(v0[2], v0[3]); w.z = cvt_pk_bf16(v1[0], v1[1]); w.w = cvt_pk_bf16(v1[2], v1[3]);
                    *(u32x4*)(QP + frag_off(u.pm, u.pn, 8, wr * 4 + wc, ai * 8 + m * 2 + bj, fq * 16 + fr)) = w; } }
    }
};
}

#define MFMA32(a, b, c) __builtin_amdgcn_mfma_f32_32x32x16_bf16((a), (b), (c), 0, 0, 0)
DI void p2_conv(Frame& F) {
    constexpr int CT = 4;
    const size_t NT_ = (size_t)F.G * NWAVES * 64;
    constexpr size_t PERB = (size_t)(SEQ / CT) * 64;
    const size_t it0 = F.xlocal ? (size_t)F.xq * PERB + (size_t)F.xrank * NWAVES * 64 + F.tid : (size_t)F.vcu * NWAVES * 64 + F.tid;
    const size_t itend = F.xlocal ? (size_t)(F.xq + 1) * PERB : (size_t)(T / CT) * 64, itstep = F.xlocal ? (size_t)(F.G / 8) * NWAVES * 64 : NT_;
    for (size_t item = it0; item < itend; item += itstep) {
        const int tb = (int)(item >> 6) * CT, c0 = (int)(item & 63) * 8, tl = tb & (SEQ - 1);
        v4u cg[CT + 2], uu[CT + 2], bg[CT];
#pragma unroll
        for (int r = 0; r < CT + 2; ++r) { const bool ok = (tl + r - 2) >= 0; const bf16* rowp = F.PA + (size_t)(tb + (ok ? r - 2 : 0)) * PA_W;
            cg[r] = *(const GAS v4u*)(rowp + C_C + c0); uu[r] = *(const GAS v4u*)(rowp + C_U + c0);
            if (!ok) { cg[r] = (v4u){0u, 0u, 0u, 0u}; } }
#pragma unroll
        for (int r = 0; r < CT; ++r) bg[r] = *(const GAS v4u*)(F.PA + (size_t)(tb + r) * PA_W + C_B + c0);
        f32x4 w[3][2];
#pragma unroll
        for (int j = 0; j < 3; ++j) { w[j][0] = *(const GAS f32x4*)(F.w_conv + j * CONV + c0); w[j][1] = *(const GAS f32x4*)(F.w_conv + j * CONV + c0 + 4); }
        float h[CT + 2][8];
#pragma unroll
        for (int r = 0; r < CT + 2; ++r) { h[r][0] = bf_lo(cg[r].x) * bf_lo(uu[r].x); h[r][1] = bf_hi(cg[r].x) * bf_hi(uu[r].x); h[r][2] = bf_lo(cg[r].y) * bf_lo(uu[r].y); h[r][3] = bf_hi(cg[r].y) * bf_hi(uu[r].y);
            h[r][4] = bf_lo(cg[r].z) * bf_lo(uu[r].z); h[r][5] = bf_hi(cg[r].z) * bf_hi(uu[r].z); h[r][6] = bf_lo(cg[r].w) * bf_lo(uu[r].w); h[r][7] = bf_hi(cg[r].w) * bf_hi(uu[r].w); }
#pragma unroll
        for (int r = 0; r < CT; ++r) {
            float a[8];
#pragma unroll
            for (int e = 0; e < 8; ++e) a[e] = w[0][e >> 2][e & 3] * h[r][e] + w[1][e >> 2][e & 3] * h[r + 1][e] + w[2][e >> 2][e & 3] * h[r + 2][e];
            v4u o; o.x = pk2(a[0] * bf_lo(bg[r].x), a[1] * bf_hi(bg[r].x)); o.y = pk2(a[2] * bf_lo(bg[r].y), a[3] * bf_hi(bg[r].y));
            o.z = pk2(a[4] * bf_lo(bg[r].z), a[5] * bf_hi(bg[r].z)); o.w = pk2(a[6] * bf_lo(bg[r].w), a[7] * bf_hi(bg[r].w));
            *(GAS v4u*)(F.Z + (size_t)(tb + r) * CONV + c0) = o;
        }
    }
}
DI int t5_bucket(int d) {
    if (d < 16) return d;
    const int large = 16 + (int)(logf((float)d / 16.f) / logf(8.f) * 16.f);
    return large < 31 ? large : 31;
}
constexpr int KS_STRIDE = 72, VT_STRIDE = 264;
constexpr int ATT_KS = 0, ATT_VT = 256 * KS_STRIDE * 2, ATT_BIAS = ATT_VT + 64 * VT_STRIDE * 2, ATT_END = ATT_BIAS + 4 * 128 * 4;
static_assert(ATT_END <= RING_BYTES, "attention LDS");
DI void p2_attention(Frame& F) {
    LAS bf16* KS = (LAS bf16*)(F.lds + ATT_KS); LAS bf16* VT = (LAS bf16*)(F.lds + ATT_VT); LAS float* BIAS = (LAS float*)(F.lds + ATT_BIAS);
    const int lane = F.lane, r = lane & 31, hh = lane >> 5;
#pragma unroll 1
    for (int unit = F.xlocal ? F.xq * 32 * NKV + F.xrank : F.vcu, uend = F.xlocal ? (F.xq + 1) * 32 * NKV : 8 * 32 * NKV, ustep = F.xlocal ? F.G / 8 : F.G; unit < uend; unit += ustep) {
        const int kv = unit & 1, n = (unit >> 1) & 31, b = unit >> 6;
        const int t0 = b * SEQ + n * 128;
        __syncthreads();
        {
            const int j = F.tid >> 1, hf = F.tid & 1; const bool valid = (n > 0) || (j >= 128);
            const bf16* rowp = F.PA + (size_t)(t0 - 128 + j) * PA_W;
            v4u kq[4], vq[4];
#pragma unroll
            for (int i = 0; i < 4; ++i) { kq[i] = (v4u){0u, 0u, 0u, 0u}; vq[i] = kq[i]; }
            if (valid) {
#pragma unroll
                for (int i = 0; i < 4; ++i) { kq[i] = *(const GAS v4u*)(rowp + C_K + kv * HD + hf * 32 + i * 8); vq[i] = *(const GAS v4u*)(rowp + C_V + kv * HD + hf * 32 + i * 8); }
            }
            float kf[32]; float ss = 0.f;
#pragma unroll
            for (int i = 0; i < 4; ++i) { kf[8 * i + 0] = bf_lo(kq[i].x); kf[8 * i + 1] = bf_hi(kq[i].x); kf[8 * i + 2] = bf_lo(kq[i].y); kf[8 * i + 3] = bf_hi(kq[i].y);
                kf[8 * i + 4] = bf_lo(kq[i].z); kf[8 * i + 5] = bf_hi(kq[i].z); kf[8 * i + 6] = bf_lo(kq[i].w); kf[8 * i + 7] = bf_hi(kq[i].w); }
#pragma unroll
            for (int e = 0; e < 32; ++e) ss += kf[e] * kf[e];
            ss += __shfl_xor(ss, 1);
            const float rs = 1.f / sqrtf(ss * (1.f / HD) + EPS);
#pragma unroll
            for (int i = 0; i < 4; ++i) { const f32x4 g0 = *(const GAS f32x4*)(F.k_norm + hf * 32 + 8 * i), g1 = *(const GAS f32x4*)(F.k_norm + hf * 32 + 8 * i + 4);
                v4u o; o.x = pk2(kf[8 * i + 0] * rs * g0[0], kf[8 * i + 1] * rs * g0[1]); o.y = pk2(kf[8 * i + 2] * rs * g0[2], kf[8 * i + 3] * rs * g0[3]);
                o.z = pk2(kf[8 * i + 4] * rs * g1[0], kf[8 * i + 5] * rs * g1[1]); o.w = pk2(kf[8 * i + 6] * rs * g1[2], kf[8 * i + 7] * rs * g1[3]);
                *(LAS v4u*)(KS + j * KS_STRIDE + hf * 32 + 8 * i) = o; }
#pragma unroll
            for (int i = 0; i < 4; ++i) { const int d0 = hf * 32 + 8 * i;
                VT[(d0 + 0) * VT_STRIDE + j] = (bf16)(vq[i].x & 0xffffu); VT[(d0 + 1) * VT_STRIDE + j] = (bf16)(vq[i].x >> 16);
                VT[(d0 + 2) * VT_STRIDE + j] = (bf16)(vq[i].y & 0xffffu); VT[(d0 + 3) * VT_STRIDE + j] = (bf16)(vq[i].y >> 16);
                VT[(d0 + 4) * VT_STRIDE + j] = (bf16)(vq[i].z & 0xffffu); VT[(d0 + 5) * VT_STRIDE + j] = (bf16)(vq[i].z >> 16);
                VT[(d0 + 6) * VT_STRIDE + j] = (bf16)(vq[i].w & 0xffffu); VT[(d0 + 7) * VT_STRIDE + j] = (bf16)(vq[i].w >> 16); }
            { const int g = F.tid >> 7, dist = F.tid & 127; BIAS[F.tid] = F.rel_bias[t5_bucket(dist) * NH + kv * 4 + g]; }
        }
        __syncthreads();
#pragma unroll 1
        for (int task = F.wave; task < 16; task += NWAVES) {
            const int g = task >> 2, c = task & 3, head = kv * 4 + g, r0 = 32 * c;
            bf16x8 qf[4];
            {
                const bf16* qp = F.PA + (size_t)(t0 + r0 + r) * PA_W + C_Q + head * HD + 8 * hh;
                v4u qq[4]; float qv[32]; float ss = 0.f;
#pragma unroll
                for (int s = 0; s < 4; ++s) qq[s] = *(const GAS v4u*)(qp + 16 * s);
#pragma unroll
                for (int s = 0; s < 4; ++s) { qv[8 * s + 0] = bf_lo(qq[s].x); qv[8 * s + 1] = bf_hi(qq[s].x); qv[8 * s + 2] = bf_lo(qq[s].y); qv[8 * s + 3] = bf_hi(qq[s].y);
                    qv[8 * s + 4] = bf_lo(qq[s].z); qv[8 * s + 5] = bf_hi(qq[s].z); qv[8 * s + 6] = bf_lo(qq[s].w); qv[8 * s + 7] = bf_hi(qq[s].w); }
#pragma unroll
                for (int e = 0; e < 32; ++e) ss += qv[e] * qv[e];
                ss += __shfl_xor(ss, 32);
                const float rs = 0.125f / sqrtf(ss * (1.f / HD) + EPS);
#pragma unroll
                for (int s = 0; s < 4; ++s) { const f32x4 g0 = *(const GAS f32x4*)(F.q_norm + 16 * s + 8 * hh), g1 = *(const GAS f32x4*)(F.q_norm + 16 * s + 8 * hh + 4);
                    v4u o; o.x = pk2(qv[8 * s + 0] * rs * g0[0], qv[8 * s + 1] * rs * g0[1]); o.y = pk2(qv[8 * s + 2] * rs * g0[2], qv[8 * s + 3] * rs * g0[3]);
                    o.z = pk2(qv[8 * s + 4] * rs * g1[0], qv[8 * s + 5] * rs * g1[1]); o.w = pk2(qv[8 * s + 6] * rs * g1[2], qv[8 * s + 7] * rs * g1[3]);
                    qf[s] = __builtin_bit_cast(bf16x8, o); }
            }
            f32x16 sacc[5];
#pragma unroll
            for (int i5 = 0; i5 < 5; ++i5) {
#pragma unroll
                for (int e = 0; e < 16; ++e) sacc[i5][e] = 0.f;
                const int kt = c + i5;
#pragma unroll
                for (int s = 0; s < 4; ++s) { const bf16x8 ka = *(const LAS bf16x8*)(KS + (32 * kt + r) * KS_STRIDE + 16 * s + 8 * hh); sacc[i5] = MFMA32(ka, qf[s], sacc[i5]); }
            }
            const float sink = F.sinks[head];
            const int dbase = r - 4 * hh + 128;
            const LAS float* bl = BIAS + g * 128;
            float mx = sink;
#pragma unroll
            for (int i5 = 0; i5 < 5; ++i5) {
                const bool tile_ok = (n > 0) || (c + i5 >= 4);
#pragma unroll
                for (int e = 0; e < 16; ++e) { const int dist = dbase - 32 * i5 - ((e & 3) + 8 * (e >> 2));
                    bool valid = tile_ok; if (i5 == 0) valid = valid && (dist < 128); if (i5 == 4) valid = valid && (dist >= 0);
                    const float lg = sacc[i5][e] + bl[dist & 127];
                    sacc[i5][e] = valid ? lg : -INFINITY; mx = fmaxf(mx, sacc[i5][e]); }
                __builtin_amdgcn_sched_barrier(0);
            }
            mx = fmaxf(mx, __shfl_xor(mx, 32));
            float sum = 0.f;
#pragma unroll
            for (int i5 = 0; i5 < 5; ++i5)
#pragma unroll
                for (int e = 0; e < 16; ++e) { const float p = __expf(sacc[i5][e] - mx); sacc[i5][e] = p; sum += p; }
            sum += __shfl_xor(sum, 32);
            const float inv = 1.f / (sum + __expf(sink - mx));
            f32x16 oacc[2];
#pragma unroll
            for (int dt = 0; dt < 2; ++dt)
#pragma unroll
                for (int e = 0; e < 16; ++e) oacc[dt][e] = 0.f;
#pragma unroll
            for (int i5 = 0; i5 < 5; ++i5)
#pragma unroll
                for (int s2 = 0; s2 < 2; ++s2) {
                    v4u pp; pp.x = pk2(sacc[i5][8 * s2 + 0] * inv, sacc[i5][8 * s2 + 1] * inv); pp.y = pk2(sacc[i5][8 * s2 + 2] * inv, sacc[i5][8 * s2 + 3] * inv);
                    pp.z = pk2(sacc[i5][8 * s2 + 4] * inv, sacc[i5][8 * s2 + 5] * inv); pp.w = pk2(sacc[i5][8 * s2 + 6] * inv, sacc[i5][8 * s2 + 7] * inv);
                    const bf16x8 pb = __builtin_bit_cast(bf16x8, pp);
                    const int kb = 32 * (c + i5) + 16 * s2 + 4 * hh;
#pragma unroll
                    for (int dt = 0; dt < 2; ++dt) {
                        const v2u lo = *(const LAS v2u*)(VT + (32 * dt + r) * VT_STRIDE + kb), hi = *(const LAS v2u*)(VT + (32 * dt + r) * VT_STRIDE + kb + 8);
                        v4u va; va.x = lo.x; va.y = lo.y; va.z = hi.x; va.w = hi.y;
                        oacc[dt] = MFMA32(__builtin_bit_cast(bf16x8, va), pb, oacc[dt]);
                    }
                    __builtin_amdgcn_sched_barrier(0);
                }
            bf16* op = F.ATT + (size_t)(t0 + r0 + r) * CONV + head * HD;
#pragma unroll
            for (int dt = 0; dt < 2; ++dt)
#pragma unroll
                for (int g4 = 0; g4 < 4; ++g4) { v2u w; w.x = pk2(oacc[dt][4 * g4 + 0], oacc[dt][4 * g4 + 1]); w.y = pk2(oacc[dt][4 * g4 + 2], oacc[dt][4 * g4 + 3]);
#ifdef ZERO_ATT
                    w.x = 0u; w.y = 0u;
#endif
                    *(GAS v2u*)(op + 32 * dt + 8 * g4 + 4 * hh) = w; }
        }
    }
}

DI unsigned f2ord(float f) { const unsigned b = __builtin_bit_cast(unsigned, f); return b ^ ((b >> 31) ? 0xffffffffu : 0x80000000u); }
DI float ord2f(unsigned k) { const unsigned b = k ^ ((k >> 31) ? 0x80000000u : 0xffffffffu); return __builtin_bit_cast(float, b); }
DI unsigned umax_(unsigned a, unsigned b) { return a > b ? a : b; }
DI unsigned umin_(unsigned a, unsigned b) { return a < b ? a : b; }
DI void sort16_desc(unsigned (&v)[16]) {
#pragma unroll
    for (int k = 2; k <= 16; k <<= 1)
#pragma unroll
        for (int j = k >> 1; j > 0; j >>= 1)
#pragma unroll
            for (int i = 0; i < 16; ++i) { const int l = i ^ j; if (l > i) { const bool desc = ((i & k) == 0) || (k == 16); const unsigned a = v[i], b = v[l], hi = umax_(a, b), lo = umin_(a, b); v[i] = desc ? hi : lo; v[l] = desc ? lo : hi; } }
}
DI void merge_top16(unsigned (&a)[16], const unsigned (&b)[16]) {
#pragma unroll
    for (int i = 0; i < 16; ++i) a[i] = umax_(a[i], b[15 - i]);
#pragma unroll
    for (int j = 8; j > 0; j >>= 1)
#pragma unroll
        for (int i = 0; i < 16; ++i) { const int l = i ^ j; if (l > i) { const unsigned x = a[i], y = a[l]; a[i] = umax_(x, y); a[l] = umin_(x, y); } }
}
constexpr int SK_STRIDE = 136;
constexpr int P6_KEYS = 0, P6_IB = 2 * NKEYS * SK_STRIDE * 2, P6_END = P6_IB + NWAVES * 64 * 32;
static_assert(P6_END <= RING_BYTES, "topk LDS");
DI void p6_topk(Frame& F) {
    LAS bf16* KL = (LAS bf16*)(F.lds + P6_KEYS); LAS unsigned char* IB = F.lds + P6_IB + (F.wave * 64 + F.lane) * 32;
    const int lane = F.lane, r = lane & 31, hh = lane >> 5;
    pg8::StaticOrder S; S.init(T, PQ, F.G, F.cvirt);
    pg8::Unit pu;
    for (int ui = 0; S.next(ui, pu); ++ui) {
        const int h = pu.pn, tile = pu.pm;
        __syncthreads();
        {
            const bf16* src = F.SK + (size_t)h * 2 * NKEYS * 128;
#pragma unroll
            for (int i = 0; i < 8; ++i) { const int ch = F.tid + 512 * i; const int row = ch >> 4, c8 = (ch & 15) * 8;
                *(LAS v4u*)(KL + row * SK_STRIDE + c8) = *(const GAS v4u*)(src + (size_t)row * 128 + c8); }
        }
        __syncthreads();
        const int t = tile * 256 + F.wave * 32 + r;
        unsigned S[2][16];
#pragma unroll
        for (int p = 0; p < 2; ++p) {
            bf16x8 qf[8];
            const int rt = F.wave * 32 + r, q_ai = rt >> 7, q_wr = (rt >> 6) & 1, q_m = (rt >> 4) & 3, q_fr = rt & 15;
#pragma unroll
            for (int s = 0; s < 8; ++s) qf[s] = __builtin_bit_cast(bf16x8, *(const GAS v4u*)(F.QP + pg8::frag_off(tile, h, 8, q_wr * 4 + (s >> 1), q_ai * 8 + q_m * 2 + p, (2 * (s & 1) + hh) * 16 + q_fr)));
            unsigned key[4][16];
#pragma unroll
            for (int kt = 0; kt < 4; ++kt) {
                f32x16 acc;
#pragma unroll
                for (int e = 0; e < 16; ++e) acc[e] = 0.f;
#pragma unroll
                for (int s = 0; s < 8; ++s) { const bf16x8 ka = *(const LAS bf16x8*)(KL + (p * NKEYS + 32 * kt + r) * SK_STRIDE + 16 * s + 8 * hh); acc = MFMA32(ka, qf[s], acc); }
#pragma unroll
                for (int e = 0; e < 16; ++e) { const int nk = 32 * kt + (e & 3) + 8 * (e >> 2) + 4 * hh; key[kt][e] = (f2ord(acc[e]) & ~127u) | (unsigned)(127 - nk); }
            }
#pragma unroll
            for (int kt = 0; kt < 4; ++kt) sort16_desc(key[kt]);
            merge_top16(key[0], key[1]); merge_top16(key[2], key[3]); merge_top16(key[0], key[2]);
            unsigned other[16];
#pragma unroll
            for (int i = 0; i < 16; ++i) other[i] = (unsigned)__shfl_xor((int)key[0][i], 32);
            merge_top16(key[0], other);
#pragma unroll
            for (int i = 0; i < 16; ++i) S[p][i] = key[0][i];
        }
        float s0[16], s1[16]; const float rs2 = pg8::rstd2_of(F.SSQ, t);
#pragma unroll
        for (int i = 0; i < 16; ++i) { s0[i] = ord2f(S[0][i] & ~127u) * rs2; s1[i] = ord2f(S[1][i] & ~127u) * rs2; }
        {
#pragma unroll
            for (int q4 = 0; q4 < 4; ++q4) { unsigned w0 = 0, w1 = 0;
#pragma unroll
                for (int e = 0; e < 4; ++e) { w0 |= (127u - (S[0][4 * q4 + e] & 127u)) << (8 * e); w1 |= (127u - (S[1][4 * q4 + e] & 127u)) << (8 * e); }
                *(LAS unsigned*)(IB + 4 * q4) = w0; *(LAS unsigned*)(IB + 16 + 4 * q4) = w1; }
        }
        unsigned cand[2][16];
#pragma unroll
        for (int i = 0; i < 2; ++i)
#pragma unroll
            for (int e = 0; e < 16; ++e) cand[i][e] = 0u;
        {
            int cnt = 0; float ea = 0.f, eb = 0.f; int ep = 0;
#pragma unroll
            for (int a = 0; a < 16; ++a)
#pragma unroll
                for (int b = 0; b < 16; ++b)
                    if ((a + 1) * (b + 1) <= 16) {
                        if ((cnt & 1) == 0) { ea = s0[a]; eb = s1[b]; ep = 255 - (a * 16 + b); }
                        else { const int slot = cnt >> 1; const float sa = hh ? s0[a] : ea, sb = hh ? s1[b] : eb; const int pp = hh ? 255 - (a * 16 + b) : ep;
                            cand[slot & 1][slot >> 1] = (f2ord(sa + sb) & ~255u) | (unsigned)pp; }
                        ++cnt; }
        }
        sort16_desc(cand[0]); sort16_desc(cand[1]); merge_top16(cand[0], cand[1]);
        {
            unsigned other[16];
#pragma unroll
            for (int i = 0; i < 16; ++i) other[i] = (unsigned)__shfl_xor((int)cand[0][i], 32);
            merge_top16(cand[0], other);
        }
        float gv[16]; int ev[16]; float gsum = 0.f; const float gmx = ord2f(cand[0][0] & ~255u);
#pragma unroll
        for (int i = 0; i < 16; ++i) { const unsigned k = cand[0][i]; const int pos = 255 - (int)(k & 255u); const int a = pos >> 4, b = pos & 15;
            ev[i] = (int)IB[a] * NKEYS + (int)IB[16 + b]; gv[i] = __expf(ord2f(k & ~255u) - gmx); gsum += gv[i]; }
        float ginv = 1.f / gsum;
#ifdef UNIFORM_GATES
#pragma unroll
        for (int i = 0; i < 16; ++i) gv[i] = 1.f;
        ginv = 1.f / 16.f;
#endif
        if (hh == 0) {
            unsigned short* ip = F.IDX + (size_t)t * NSEL + h * TOPK; float* gp = F.GATE + (size_t)t * NSEL + h * TOPK;
#pragma unroll
            for (int i = 0; i < 2; ++i) *(GAS v4i*)(ip + 8 * i) = (v4i){ev[8 * i] | (ev[8 * i + 1] << 16), ev[8 * i + 2] | (ev[8 * i + 3] << 16), ev[8 * i + 4] | (ev[8 * i + 5] << 16), ev[8 * i + 6] | (ev[8 * i + 7] << 16)};
#pragma unroll
            for (int i = 0; i < 4; ++i) *(GAS f32x4*)(gp + 4 * i) = (f32x4){gv[4 * i] * ginv, gv[4 * i + 1] * ginv, gv[4 * i + 2] * ginv, gv[4 * i + 3] * ginv};
        }
    }
}

typedef float f32x2_t __attribute__((ext_vector_type(2)));
DI void fp8x16_to_f32(v4u q, float (&f)[16]) {
#pragma unroll
    for (int w = 0; w < 4; ++w) { const f32x2_t lo = __builtin_amdgcn_cvt_pk_f32_fp8((int)q[w], false), hi = __builtin_amdgcn_cvt_pk_f32_fp8((int)q[w], true);
        f[4 * w + 0] = lo.x; f[4 * w + 1] = lo.y; f[4 * w + 2] = hi.x; f[4 * w + 3] = hi.y; }
}
struct XccInfo { int q, nx, nloc, rank, uni; };
DI void xcc_info_build(const XcdBarrier& b) {
    if (threadIdx.x == 0) {
        unsigned q = 0, nx = 0, nloc = 1, uni = 1; const unsigned G8 = gridDim.x / 8u;
        for (unsigned j = 0; j < 16; ++j) { const unsigned c = xb_ld(&b.bar[XB_XCNT(j)]); if (c > 0u) { if (j < b.x) ++q; ++nx; if (c != G8) uni = 0u; } if (j == b.x) nloc = c; }
        b.st[3] = q; b.st[4] = nx > 0u ? nx : 1u; b.st[5] = nloc > 0u ? nloc : 1u;
        b.st[7] = (uni && nx == 8u && (gridDim.x % 8u) == 0u && b.st[0] == G8) ? 1u : 0u;
    }
    __syncthreads();
}
DI XccInfo xcc_info(const XcdBarrier& b) {
    XccInfo I; I.rank = __builtin_amdgcn_readfirstlane((int)b.st[2]); I.q = __builtin_amdgcn_readfirstlane((int)b.st[3]); I.nx = __builtin_amdgcn_readfirstlane((int)b.st[4]); I.nloc = __builtin_amdgcn_readfirstlane((int)b.st[5]); I.uni = __builtin_amdgcn_readfirstlane((int)b.st[7]);
    return I;
}
DI float dpp_sum8(float s) {
    s += __builtin_bit_cast(float, __builtin_amdgcn_update_dpp(0, __builtin_bit_cast(int, s), 0xB1, 0xf, 0xf, false));
    s += __builtin_bit_cast(float, __builtin_amdgcn_update_dpp(0, __builtin_bit_cast(int, s), 0x4E, 0xf, 0xf, false));
    s += __builtin_bit_cast(float, __builtin_amdgcn_update_dpp(0, __builtin_bit_cast(int, s), 0x141, 0xf, 0xf, false));
    return s;
}
typedef long i64_t;
typedef long i64x2 __attribute__((ext_vector_type(2)));
typedef int v4i_t __attribute__((ext_vector_type(4)));
typedef int v8i_t __attribute__((ext_vector_type(8)));
constexpr int PEER_ROW = 144, PEER_WAVE_LDS = 128 * PEER_ROW;
constexpr int MX_ONE = 0x7f7f7f7f;
#define PEER_ID(ia_, ib_, ld_) ((((ld_) < 8 ? ia_ : ib_)[((ld_) & 7) >> 1] >> (16 * ((ld_) & 1))) & 0xffffu)
#define P7_IDS(t_, ia_, ib_) do { const unsigned short* ip_ = F.IDX + (size_t)(t_) * NSEL + 16 * row8; ia_ = *(const GAS v4u*)(ip_); ib_ = *(const GAS v4u*)(ip_ + 8); } while (0)
#define P7_ISSUE(t_, ia_, ib_, uq_, x_) do { \
        const unsigned char* xr_ = F.XB8 + (size_t)(t_) * D + sl * 256 + 16 * g;   \
        x_[0] = *(const GAS v4u*)(xr_); x_[1] = *(const GAS v4u*)(xr_ + 64); x_[2] = *(const GAS v4u*)(xr_ + 128); x_[3] = *(const GAS v4u*)(xr_ + 192); \
        _Pragma("unroll") for (int ld = 0; ld < 16; ++ld) { const unsigned e_ = PEER_ID(ia_, ib_, ld); uq_[ld] = *(const GAS v4u*)(Us + (unsigned)(e_ * 128u + 16u * c8)); } } while (0)
#define P7_COMPUTE(t_, uq_, x_) do { \
        _Pragma("unroll") for (int ld = 0; ld < 16; ++ld) *(LAS v4u*)(wl + (16 * row8 + ld) * PEER_ROW + 16 * c8) = uq_[ld]; \
        v8i_t xb0_, xb1_; \
        xb0_[0] = (int)x_[0].x; xb0_[1] = (int)x_[0].y; xb0_[2] = (int)x_[0].z; xb0_[3] = (int)x_[0].w; xb0_[4] = (int)x_[1].x; xb0_[5] = (int)x_[1].y; xb0_[6] = (int)x_[1].z; xb0_[7] = (int)x_[1].w; \
        xb1_[0] = (int)x_[2].x; xb1_[1] = (int)x_[2].y; xb1_[2] = (int)x_[2].z; xb1_[3] = (int)x_[2].w; xb1_[4] = (int)x_[3].x; xb1_[5] = (int)x_[3].y; xb1_[6] = (int)x_[3].z; xb1_[7] = (int)x_[3].w; \
        f32x4 keep = {0.f, 0.f, 0.f, 0.f}; \
        _Pragma("unroll") for (int j = 0; j < 8; ++j) { f32x4 c_ = {0.f, 0.f, 0.f, 0.f}; \
            const v4i_t a0_ = *(const LAS v4i_t*)(wl + (16 * j + m) * PEER_ROW + 16 * g), a1_ = *(const LAS v4i_t*)(wl + (16 * j + m) * PEER_ROW + 64 + 16 * g); \
            v8i_t A0_ = {a0_[0], a0_[1], a0_[2], a0_[3], 0, 0, 0, 0}, A1_ = {a1_[0], a1_[1], a1_[2], a1_[3], 0, 0, 0, 0}; \
            c_ = __builtin_amdgcn_mfma_scale_f32_16x16x128_f8f6f4(A0_, xb0_, c_, 4, 0, 0, MX_ONE, 0, MX_ONE); \
            c_ = __builtin_amdgcn_mfma_scale_f32_16x16x128_f8f6f4(A1_, xb1_, c_, 4, 0, 0, MX_ONE, 0, MX_ONE); \
            keep = (m == j) ? c_ : keep; } \
        { const bool ok_ = (m < 8) && ((t_) < T); bf16* dst_ = ok_ ? F.PARTB + ((size_t)sl * T + (t_)) * NSEL + 16 * m + 4 * g : F.PARTB + (size_t)8 * T * NSEL + 4 * lane; \
          v2u w_; w_.x = pk2(keep[0], keep[1]); w_.y = pk2(keep[2], keep[3]); *(GAS v2u*)dst_ = w_; } } while (0)
DI int peer_next(volatile LAS unsigned* ctr, int lane) { unsigned k = 0u; if (lane == 0) k = __hip_atomic_fetch_add((LAS unsigned*)ctr, 1u, __ATOMIC_RELAXED, __HIP_MEMORY_SCOPE_WORKGROUP); return __builtin_amdgcn_readfirstlane((int)k); }
DI int peer_tok(int tbase, int tstride, int k) { return tbase + (k & 7) + (k >> 3) * tstride; }
DI void p7_udot(Frame& F, const XccInfo& I) {
    const int lane = F.lane, g = lane >> 4, m = lane & 15, row8 = lane >> 3, c8 = lane & 7;
    LAS unsigned char* wl = F.lds + F.wave * PEER_WAVE_LDS;
    const unsigned char* U4 = (const unsigned char*)F.UB;
    const int tstride = I.nloc * NWAVES, tbase = I.rank * NWAVES;
    int it = 0;
    for (int share = I.q; share < 8; share += I.nx, ++it) {
        const int sl = share >> 1, half = share & 1;
        const unsigned char* Us = U4 + (size_t)sl * NEXP * 128;
        volatile LAS unsigned* ctr = F.MISC + 16 + it;
#define CL(t_) ((t_) < T ? (t_) : T - 1)
#define TOK(k_) (2 * peer_tok(tbase, tstride, (k_)) + half)
        v4u uqA[16], uqB[16]; v4u iA0, iA1, iB0, iB1;
        int kk = peer_next(ctr, lane); int tA = TOK(kk); kk = peer_next(ctr, lane); int tB = TOK(kk);
        {
            v4u xA[4], xB[4];
            P7_IDS(CL(tA), iA0, iA1);
            P7_ISSUE(CL(tA), iA0, iA1, uqA, xA);
            P7_IDS(CL(tB), iB0, iB1);
#pragma unroll 1
            while (tA < T) {
                kk = peer_next(ctr, lane); const int tC = TOK(kk); kk = peer_next(ctr, lane); const int tD = TOK(kk);
                P7_IDS(CL(tC), iA0, iA1);
                P7_ISSUE(CL(tB), iB0, iB1, uqB, xB);
                P7_COMPUTE(tA, uqA, xA);
                P7_IDS(CL(tD), iB0, iB1);
                P7_ISSUE(CL(tC), iA0, iA1, uqA, xA);
                P7_COMPUTE(tB, uqB, xB);
                tA = tC; tB = tD;
            }
        }
#undef TOK
#undef CL
    }
}
DI void p8_act(Frame& F) {
    const size_t NT_ = (size_t)F.G * NWAVES * 64;
    for (size_t item = (size_t)F.vcu * NWAVES * 64 + F.tid; item < (size_t)T * NSEL / 4; item += NT_) {
        const int t = (int)(item >> 5);
        f32x4 s = {0.f, 0.f, 0.f, 0.f}, vs4;
#pragma unroll
        for (int sl = 0; sl < 4; ++sl) { const v2u p = *(const GAS v2u*)(F.PARTB + (size_t)sl * T * NSEL + item * 4); s = s + (f32x4){bf_lo(p.x), bf_hi(p.x), bf_lo(p.y), bf_hi(p.y)}; }
        { const v2u ids = *(const GAS v2u*)(F.IDX + item * 4);
          s[0] *= F.SU[ids.x & 0xffffu]; s[1] *= F.SU[ids.x >> 16]; s[2] *= F.SU[ids.y & 0xffffu]; s[3] *= F.SU[ids.y >> 16];
          vs4 = (f32x4){F.SV[ids.x & 0xffffu], F.SV[ids.x >> 16], F.SV[ids.y & 0xffffu], F.SV[ids.y >> 16]}; }
        const float rs2 = pg8::rstd2_of(F.SSQ, t);
        const f32x4 g = *(const GAS f32x4*)(F.GATE + item * 4);
        f32x4 o;
#pragma unroll
        for (int e = 0; e < 4; ++e) { const float pre = s[e] * rs2; o[e] = 0.5f * pre * (1.f + erff(pre * 0.70710678118f)) * g[e] * vs4[e] * A_SCALE; }
        ((GAS unsigned*)F.ACT)[item] = pk4_fp8(o);
    }
}
typedef int v2i_t __attribute__((ext_vector_type(2)));
#define P9_IDS(t_, ia_, ib_, ak_, xr_) do { { const unsigned short* ip_ = F.IDX + (size_t)(t_) * NSEL + 16 * row8; ia_ = *(const GAS v4u*)(ip_); ib_ = *(const GAS v4u*)(ip_ + 8); } \
        const unsigned char* ap_ = (const unsigned char*)F.ACT + (size_t)(t_) * NSEL + 16 * g; \
        ak_[0] = *(const GAS v4u*)(ap_); ak_[1] = *(const GAS v4u*)(ap_ + 64); \
        xr_ = *(const GAS v2u*)(F.XB + (size_t)(t_) * D + sl * 256 + 4 * lane); } while (0)
#define P9_ISSUE(ia_, ib_, vq_) do { \
        _Pragma("unroll") for (int ld = 0; ld < 16; ++ld) { const unsigned e_ = PEER_ID(ia_, ib_, ld); vq_[ld] = *(const GAS v4u*)(Vs + (unsigned)(e_ * 128u + 16u * c8)); } } while (0)
#define P9_COMPUTE(t_, vq_, ak_, xr_) do { \
        _Pragma("unroll") for (int ld = 0; ld < 16; ++ld) *(LAS v4u*)(wl + (16 * row8 + ld) * PEER_ROW + 16 * c8) = vq_[ld]; \
        const v8i_t A_ = {(int)ak_[0].x, (int)ak_[0].y, (int)ak_[0].z, (int)ak_[0].w, (int)ak_[1].x, (int)ak_[1].y, (int)ak_[1].z, (int)ak_[1].w}; \
        float keep[4] = {0.f, 0.f, 0.f, 0.f}; \
        _Pragma("unroll") for (int ct = 0; ct < 16; ++ct) { \
            const v2i_t b0_ = __builtin_amdgcn_ds_read_tr4_b64_v2i32((LAS v2i_t*)(wl + (32 * g + n16) * PEER_ROW + 8 * ct)); \
            const v2i_t b1_ = __builtin_amdgcn_ds_read_tr4_b64_v2i32((LAS v2i_t*)(wl + (32 * g + 16 + n16) * PEER_ROW + 8 * ct)); \
            const v8i_t B_ = {b0_[0], b0_[1], b1_[0], b1_[1], 0, 0, 0, 0}; f32x4 c_ = {0.f, 0.f, 0.f, 0.f}; \
            c_ = __builtin_amdgcn_mfma_scale_f32_16x16x128_f8f6f4(A_, B_, c_, 0, 4, 0, MX_ONE, 0, MX_ONE); \
            keep[ct >> 2] = (g == (ct & 3)) ? c_[0] : keep[ct >> 2]; }   \
          \
        { _Pragma("unroll") for (int q = 0; q < 4; ++q) ob[64 * q + lane] = keep[q]; \
          const f32x4 kv_ = *(const LAS f32x4*)(ob + 4 * lane); \
          const bool ok_ = (t_) < T; \
          float* op_ = ok_ ? F.out + (size_t)(t_) * D + sl * 256 + 4 * lane : (float*)F.PARTB + 4 * lane;     \
          f32x4 o_; o_[0] = bf_lo(xr_.x) + kv_[0] * (1.f / A_SCALE); o_[1] = bf_hi(xr_.x) + kv_[1] * (1.f / A_SCALE); o_[2] = bf_lo(xr_.y) + kv_[2] * (1.f / A_SCALE); o_[3] = bf_hi(xr_.y) + kv_[3] * (1.f / A_SCALE); \
          *(GAS f32x4*)op_ = o_; } } while (0)
DI void p9_vacc(Frame& F, const XccInfo& I) {
    const int lane = F.lane, g = lane >> 4, n16 = lane & 15, row8 = lane >> 3, c8 = lane & 7;
    LAS unsigned char* wl = F.lds + F.wave * PEER_WAVE_LDS;
    LAS float* ob = (LAS float*)(F.lds + P9_OUT_OFF + F.wave * 1024);
    const unsigned char* V4 = (const unsigned char*)F.VB;
    const int tstride = I.nloc * NWAVES, tfirst = I.rank * NWAVES + F.wave;
    for (int share = I.q; share < 8; share += I.nx) {
        const int sl = share >> 1, half = share & 1;
        const unsigned char* Vs = V4 + (size_t)sl * NEXP * 128;
        if (2 * tfirst + half >= T) continue;
        v4u vqA[16], vqB[16]; v4u akA[2], akB[2]; v4u iA0, iA1, iB0, iB1; v2u xrA, xrB;
#define CL(t_) ((t_) < T ? (t_) : T - 1)
#define TK(k_) (2 * (tfirst + (k_) * tstride) + half)
        P9_IDS(TK(0), iA0, iA1, akA, xrA);
        P9_ISSUE(iA0, iA1, vqA);
        P9_IDS(CL(TK(1)), iB0, iB1, akB, xrB);
#pragma unroll 1
        for (int k = 0; TK(k) < T; k += 2) {
            const int t = TK(k), t1 = TK(k + 1), t2 = CL(TK(k + 2)), t3 = CL(TK(k + 3));
            v4u akN[2], akM[2]; v2u xrN, xrM;
            P9_IDS(t2, iA0, iA1, akN, xrN);
            P9_ISSUE(iB0, iB1, vqB);
            __builtin_amdgcn_sched_barrier(0);
            P9_COMPUTE(t, vqA, akA, xrA);
            P9_IDS(t3, iB0, iB1, akM, xrM);
            P9_ISSUE(iA0, iA1, vqA);
            __builtin_amdgcn_sched_barrier(0);
            P9_COMPUTE(t1, vqB, akB, xrB);
            akA[0] = akN[0]; akA[1] = akN[1]; akB[0] = akM[0]; akB[1] = akM[1]; xrA = xrN; xrB = xrM;
        }
#undef TK
#undef CL
    }
}

struct Args { const float* in[17]; float* out; unsigned char* ws; int ph_lo, ph_hi, li, pad; };
__global__ void __launch_bounds__(NWAVES * 64, 2) hyb_fwd(Args args) {
    extern __shared__ __attribute__((aligned(16))) unsigned char lds[];
    Frame F;
    F.lds = (LAS unsigned char*)lds;
    F.MISC = (volatile LAS unsigned*)(F.lds + MISC_OFF);
    F.tid = threadIdx.x; F.lane = F.tid & 63; F.wave = __builtin_amdgcn_readfirstlane(F.tid >> 6);
    F.G = gridDim.x; { const int bx = blockIdx.x; F.vcu = (F.G % 8 == 0) ? (bx % 8) * (F.G / 8) + bx / 8 : bx; }
    unsigned char* ws = args.ws;
    F.ctl = (gu32*)(ws + WS_CTL);
    F.x = args.in[0]; F.norm_mix = args.in[1]; F.norm_ffn = args.in[2]; F.w_in = args.in[3]; F.b_gate = args.in[4]; F.w_conv = args.in[5]; F.q_norm = args.in[6]; F.k_norm = args.in[7];
    F.sinks = args.in[8]; F.rel_bias = args.in[9]; F.w_conv_out = args.in[10]; F.w_attn_out = args.in[11]; F.w_out = args.in[12]; F.w_query = args.in[13]; F.sub_keys = args.in[14];
    F.expert_u = args.in[15]; F.expert_v = args.in[16]; F.out = args.out;
    F.WIN = (bf16*)(ws + WS_WIN); F.WG8 = ws + WS_WG8; F.WC = (bf16*)(ws + WS_WC); F.WA = (bf16*)(ws + WS_WA); F.WO = (bf16*)(ws + WS_WO); F.WQ = (bf16*)(ws + WS_WQ); F.SK = (bf16*)(ws + WS_SK);
    F.UB = (bf16*)(ws + WS_UB); F.VB = (bf16*)(ws + WS_VB); F.XB = (bf16*)(ws + WS_XB); F.PA = (bf16*)(ws + WS_PA); F.MIX = (bf16*)(ws + WS_MIX); F.G_ = (bf16*)(ws + WS_G); F.QP = (bf16*)(ws + WS_QP);
    F.Z = (bf16*)(ws + WS_Z); F.ATT = (bf16*)(ws + WS_ATT); F.RSTD1 = (float*)(ws + WS_RSTD1); F.SSQ = (float*)(ws + WS_SSQ); F.GATE = (float*)(ws + WS_GATE); F.IDX = (unsigned short*)(ws + WS_IDX); F.PARTB = (bf16*)(ws + WS_PART); F.SU = (float*)(ws + WS_SU); F.SV = (float*)(ws + WS_SV); F.XB8 = (unsigned char*)(ws + WS_XB8); F.ACT = (float*)(ws + WS_ACT);
    for (int u = F.tid; u < (LDS_BYTES - LDSCTL_OFF) / 4; u += NWAVES * 64) ((LAS unsigned*)(F.lds + LDSCTL_OFF))[u] = 0u;
    __syncthreads();
    XcdBarrier bar; bar.bar = (unsigned*)(F.ctl + CW_BAR); bar.x = 0; bar.st = nullptr;
    const int lo = args.ph_lo, hi = args.ph_hi;
    if (hi - lo > 1) bar = xcd_barrier_post((unsigned*)(F.ctl + CW_BAR), F.MISC + 8);
#ifndef PH_MASK
#define PH_MASK 0x3ff
#endif
#define IN(k) (((PH_MASK >> (k)) & 1) && lo <= (k) && (k) < hi)
#define SEAM(k) do { if (IN(k) && IN((k) + 1)) xcd_barrier(bar); } while (0)
#ifndef PROBE_DUP
#define PROBE_DUP 0
#endif
#define REP(k) for (int rep_ = 0; rep_ < (((PROBE_DUP >> (k)) & 1) ? 2 : 1); ++rep_)

    F.xlocal = 0; F.xq = 0; F.xrank = 0; F.cvirt = (int)blockIdx.x;
    if (IN(0)) { REP(0) p0_prologue(F); SEAM(0); }
    if (hi - lo > 1 && IN(0) && IN(1)) { xcc_info_build(bar); const XccInfo I = xcc_info(bar);
        if (I.uni) { F.xlocal = 1; F.xq = I.q; F.xrank = I.rank; F.cvirt = I.q + 8 * I.rank; } }
#define SEAML(k) do { if (IN(k) && IN((k) + 1)) { if (F.xlocal) xcd_local_barrier(bar); else xcd_barrier(bar); } } while (0)
    if (IN(1)) {
        pg8::Gemm g{F.XB, F.WIN, nullptr, nullptr, T, N16, D}; pg8::StaticOrder S; S.init(T, N16, F.G, F.cvirt);
        pg8::Gemm g8{(const pg8::bf16_t*)F.XB8, (const pg8::bf16_t*)F.WG8, nullptr, nullptr, T, N8, D / 2}; pg8::StaticOrder S8; S8.init(T, N8, F.G, F.cvirt);
        { LAS float* bgl = (LAS float*)(F.lds + RING_BYTES); for (int i = F.tid; i < 2 * D; i += NWAVES * 64) bgl[i] = F.b_gate[i]; __syncthreads(); }
        pg8::EpiProj E{F.PA, F.G_, (const PG8_LAS float*)(F.lds + RING_BYTES), 0, 1 << 20, 1.f}, E8{F.PA, F.G_, (const PG8_LAS float*)(F.lds + RING_BYTES), N16, 3, 1.f / WG_SCALE};
        REP(1) { pg8::gemm_phase<pg8::EpiProj, pg8::StaticOrder, PG8_ALIGN, PG8_SP2, true>(F.lds + RING_OFF, g8, S8, E8);
                 pg8::gemm_phase<pg8::EpiProj, pg8::StaticOrder, PG8_ALIGN, PG8_SP2>(F.lds + RING_OFF, g, S, E); }
        {
            const int nwg = (T / 256) * (N8 / 256), rem = nwg % F.G, c = (int)blockIdx.x; const int nshort = rem ? F.G - rem : F.G, sidx = rem ? c - rem : c;
            (void)sidx; (void)nshort;
            constexpr int CH = 64, NCH = 2 * NEXP / CH;
            for (;;) {
                if (F.tid == 0) F.MISC[14] = __hip_atomic_fetch_add((unsigned*)(F.ctl + 2048), 1u, __ATOMIC_RELAXED, __HIP_MEMORY_SCOPE_AGENT);
                __syncthreads();
                const int ch = __builtin_amdgcn_readfirstlane((int)F.MISC[14]);
                __syncthreads();
                if (ch >= NCH) break;
                if (ch < NCH / 2) p0_convert_fp4(F, F.expert_u, F.norm_ffn, (unsigned char*)F.UB, F.SU, ch * CH, ch * CH + CH);
                else p0_convert_fp4(F, F.expert_v, nullptr, (unsigned char*)F.VB, F.SV, (ch - NCH / 2) * CH, (ch - NCH / 2) * CH + CH);
            } }
        SEAML(1);
    }
    if (IN(2)) {
        REP(2) { p2_conv(F); p2_attention(F); }
        SEAML(2); }
    if (IN(3)) {
        pg8::Gemm g{F.Z, F.WC, F.ATT, F.WA, T, D, CONV}; pg8::PairOrder S; S.init(T, D, F.G, F.cvirt);
        pg8::EpiMix E{F.MIX, F.G_};
        REP(3) pg8::gemm_phase<pg8::EpiMix, pg8::PairOrder, PG8_ALIGN, PG8_SP2>(F.lds + RING_OFF, g, S, E);
        SEAML(3);
    }
    if (IN(4)) {
        pg8::Gemm g{F.MIX, F.WO, nullptr, nullptr, T, D, D}; pg8::FragOrder S; S.init(T, D, F.G, F.cvirt);
        pg8::EpiX1 E{F.RSTD1, F.XB, F.SSQ, F.XB8};
        REP(4) pg8::gemm_phase<pg8::EpiX1, pg8::FragOrder, PG8_ALIGN, PG8_SP2>(F.lds + RING_OFF, g, S, E);
        SEAML(4);
    }
    if (IN(5)) {
        pg8::Gemm g{F.XB, F.WQ, nullptr, nullptr, T, PQ, D}; pg8::StaticOrder S; S.init(T, PQ, F.G, F.cvirt);
        pg8::EpiQP E{F.QP};
        REP(5) pg8::gemm_phase<pg8::EpiQP, pg8::StaticOrder, PG8_ALIGN, PG8_SP2>(F.lds + RING_OFF, g, S, E);
    }
    if (IN(6)) { REP(6) p6_topk(F); SEAM(6); }
    if (IN(7)) { if (!(hi - lo > 1 && IN(0) && IN(1))) xcc_info_build(bar); const XccInfo I = xcc_info(bar); REP(7) p7_udot(F, I); SEAM(7); }
    if (IN(8)) { REP(8) p8_act(F); SEAM(8); }
    if (IN(9)) { const XccInfo I = xcc_info(bar); p9_vacc(F, I); }
#undef IN
#undef SEAM
#undef SEAML
}

extern "C" void kernel_launch(void* const* d_in, const int* in_sizes, int n_in, void* d_out, int out_size, void* d_ws, size_t ws_size, hipStream_t stream) {
    static int grid = 0;
    if (grid == 0) {
        if (n_in != 17 || in_sizes[0] != T * D || out_size != T * D || ws_size < WS_END) { fprintf(stderr, "kernel_launch: unexpected shapes (n_in %d, in0 %d, out %d, ws %zu)\n", n_in, n_in > 0 ? in_sizes[0] : -1, out_size, ws_size); grid = -1; return; }
        int dev = 0, cus = 0, per_cu = 0;
        if (hipGetDevice(&dev) != hipSuccess || hipDeviceGetAttribute(&cus, hipDeviceAttributeMultiprocessorCount, dev) != hipSuccess) { grid = -1; return; }
        if (hipFuncSetAttribute((const void*)hyb_fwd, hipFuncAttributeMaxDynamicSharedMemorySize, LDS_BYTES) != hipSuccess) { fprintf(stderr, "kernel_launch: hipFuncSetAttribute failed\n"); grid = -1; return; }
        if (hipOccupancyMaxActiveBlocksPerMultiprocessor(&per_cu, (const void*)hyb_fwd, NWAVES * 64, LDS_BYTES) != hipSuccess || per_cu < 1) { fprintf(stderr, "kernel_launch: occupancy query says %d blocks per CU\n", per_cu); (void)hipGetLastError(); grid = -1; return; }
        grid = cus * 1;
    }
    if (grid < 0) return;
    if (hipMemsetAsync((char*)d_ws + WS_CTL, 0, CTL_ZERO_BYTES, stream) != hipSuccess) { fprintf(stderr, "kernel_launch: memset failed\n"); return; }
    Args a{};
    for (int i = 0; i < 17; ++i) a.in[i] = (const float*)d_in[i];
    a.out = (float*)d_out; a.ws = (unsigned char*)d_ws;
#if MK_ONE_LAUNCH
    a.ph_lo = 0; a.ph_hi = N_PHASES; a.li = 0;
    void* kargs[] = {&a};
    const hipError_t le = hipLaunchCooperativeKernel((const void*)hyb_fwd, dim3(grid), dim3(NWAVES * 64), kargs, LDS_BYTES, stream);
    if (le != hipSuccess) fprintf(stderr, "kernel_launch: cooperative launch failed: %s (grid %d)\n", hipGetErrorName(le), grid);
#else
    for (int li = 0; li < N_PHASES; ++li) {
        a.ph_lo = li; a.ph_hi = li + 1; a.li = li;
        hipLaunchKernelGGL(hyb_fwd, dim3(grid), dim3(NWAVES * 64), LDS_BYTES, stream, a);
        const hipError_t le = hipPeekAtLastError();
        if (le != hipSuccess) { fprintf(stderr, "kernel_launch: launch %d failed: %s\n", li, hipGetErrorName(le)); break; }
    }
#endif
}
```

```cpp
#include <hip/hip_runtime.h>
#include <hip/hip_cooperative_groups.h>
#include <cstdio>
#include <cstdint>
namespace pg8 {
#define PG8_LAS __attribute__((address_space(3)))
typedef unsigned short bf16_t;
typedef short bf16x8 __attribute__((ext_vector_type(8)));
typedef float f32x4 __attribute__((ext_vector_type(4)));
typedef unsigned u32x4 __attribute__((ext_vector_type(4)));
typedef unsigned u32x2 __attribute__((ext_vector_type(2)));
constexpr int BM = 256, BK = 64, HALF = 128, HTB = HALF * BK * 2  , STAGE_BYTES = 8 * HTB, NXCD = 8, WGM = 8;

__host__ __device__ __forceinline__ int lds_byte(int r, int c) { const int st = (r >> 4) * 2 + (c >> 5), rr = r & 15, cc = c & 31, ob = rr * 64 + cc * 2; return st * 1024 + (ob ^ (((ob >> 9) & 1) << 5)); }
__host__ __device__ __forceinline__ void stage_rc(int b, int& R, int& C) { const int st = b / 1024, sb = b % 1024, swz = sb ^ (((sb >> 9) & 1) << 5); R = (st >> 1) * 16 + swz / 64; C = (st & 1) * 32 + (swz % 64) / 2; }
__host__ __device__ __forceinline__ int perm32(int rho) { const int n = rho >> 4, i = rho & 15; return 8 * (i >> 2) + 4 * n + (i & 3); }

struct Unit { int pm, pn, which; };
struct Gemm { const bf16_t* A; const bf16_t* Bt; const bf16_t* A2; const bf16_t* Bt2; int M, N, K; };

struct StaticOrder {
    static constexpr bool AFRAG = false;
    int nM, nN, nwg, G, c;
    __host__ __device__ void init(int M, int N, int G_, int c_) { nM = M / BM; nN = N / BM; nwg = nM * nN; G = G_; c = c_; }
    __host__ __device__ bool next(int i, Unit& u) const {
        const long L = (long)i * G + c; if (L >= nwg) return false;
        int wgid = (int)L; { const int q = nwg / NXCD, r = nwg % NXCD, xcd = wgid % NXCD, off = wgid / NXCD; wgid = (xcd < r ? xcd * (q + 1) : r * (q + 1) + (xcd - r) * q) + off; }
        const int nig = WGM * nN, gid = wgid / nig, fm = gid * WGM, gsz = (nM - fm) < WGM ? (nM - fm) : WGM;
        u.pm = fm + ((wgid % nig) % gsz); u.pn = (wgid % nig) / gsz; u.which = 0; return true;
    }
    __device__ __forceinline__ const char* a_base(const Gemm& g, const Unit& u, size_t tstep) const { return (const char*)g.A + (size_t)u.pm * tstep; }
    __device__ __forceinline__ const char* b_base(const Gemm& g, const Unit& u, size_t tstep) const { return (const char*)g.Bt + (size_t)u.pn * tstep; }
    __device__ __forceinline__ void a_ready(const Unit&) const {}
    __device__ __forceinline__ void done(const Unit&) const {}
};

__device__ __forceinline__ unsigned cvt_pk_bf16(float lo, float hi) { unsigned r; asm volatile("v_cvt_pk_bf16_f32 %0, %1, %2" : "=v"(r) : "v"(lo), "v"(hi)); return r; }
__device__ __forceinline__ void store16_wt(void* p, u32x4 v) { asm volatile("global_store_dwordx4 %0, %1, off sc1\n\ts_nop 1" :: "v"(p), "v"(v) : "memory"); }
__device__ __forceinline__ void store8_wt(void* p, u32x2 v) { asm volatile("global_store_dwordx2 %0, %1, off sc1\n\ts_nop 1" :: "v"(p), "v"(v) : "memory"); }
typedef float f32x2 __attribute__((ext_vector_type(2)));
__device__ __forceinline__ f32x2 gelu_pk(f32x2 v) {
    const f32x2 av = __builtin_elementwise_abs(v), d = av * 0.2316418882f + 1.0f;
    f32x2 t; t.x = __builtin_amdgcn_rcpf(d.x); t.y = __builtin_amdgcn_rcpf(d.y);
    f32x2 q = t * 0.5307027145f + (-0.7265760135f); q = q * t + 0.7107068705f; q = q * t + (-0.142248368f); q = q * t + 0.127414796f; q = q * t;
    const f32x2 s = (v * v) * (-0.72134752044f);
    f32x2 e; e.x = __builtin_amdgcn_exp2f(s.x); e.y = __builtin_amdgcn_exp2f(s.y);
    const f32x2 m = v * (q * e), r = v - m;
    f32x2 o; o.x = v.x < 0.f ? m.x : r.x; o.y = v.y < 0.f ? m.y : r.y; return o;
}

template <class Epi, class Sched, bool ALIGN_EPI = false, bool SP2 = false, bool FP8 = false>
__device__ __forceinline__ void gemm_phase(PG8_LAS unsigned char* lds, const Gemm g, const Sched& S, const Epi& E) {
    const int tid = threadIdx.x, wid = __builtin_amdgcn_readfirstlane(tid >> 6), lane = tid & 63, wr = wid >> 2, wc = wid & 3, fr = lane & 15, fq = lane >> 4;
    const int K = g.K, nt = K / BK;
    unsigned voffA[2], voffB[2];
#pragma unroll
    for (int i = 0; i < 2; ++i) { int R, C; stage_rc(tid * 16 + i * 8192, R, C); const int Rb = Epi::PERM ? ((R & ~31) + perm32(R & 31)) : R;
        voffA[i] = Sched::AFRAG ? (unsigned)((((((R >> 6) * 4 + (C >> 5)) * 16 + ((R >> 4) & 3) * 2) * 64) + ((C & 31) >> 3) * 16 + (R & 15)) * 16) : (unsigned)(R * K + C) * 2u;
        voffB[i] = (unsigned)(Rb * K + C) * 2u; }
#define PG8_AP(base, h, kt) (Sched::AFRAG ? (base) + ((((size_t)((kt) >> 2) * 8 + ((kt) & 1) * 2) * 16 + (h) * 8 + (((kt) >> 1) & 1)) * 64) * 16 : (base) + (size_t)(h) * hstep + (size_t)(kt) * kstep)
    const size_t kstep = (size_t)(BK * 2);
    const size_t hstep = (size_t)HALF * K * 2;
    const size_t tstep = 2 * hstep;
    const unsigned ldsw = (unsigned)wid * 1024u;
    const int aoff = lds_byte(wr * 64 + fr, fq * 8), boff = lds_byte(wc * 32 + fr, fq * 8);
#define PG8_SA(b, h) (((b) * 2 + (h)) * HTB)
#define PG8_SB(b, h) ((4 + (b) * 2 + (h)) * HTB)
#define PG8_STAGE(bufoff, gbase, voff) do { _Pragma("unroll") for (int _i = 0; _i < 2; ++_i) \
        __builtin_amdgcn_global_load_lds((const unsigned*)((const char*)(gbase) + (voff)[_i]), (PG8_LAS unsigned*)(lds + (bufoff) + ldsw + _i * 8192), 16, 0, 0); } while (0)
#define PG8_LDA(dst, b, h) do { _Pragma("unroll") for (int m = 0; m < 4; ++m) dst[m] = __builtin_shufflevector(*(const PG8_LAS bf16x8*)(lds + PG8_SA(b, h) + aoff + m * 2048), *(const PG8_LAS bf16x8*)(lds + PG8_SA(b, h) + aoff + m * 2048 + 1024), 0, 1, 2, 3, 4, 5, 6, 7, 8, 9, 10, 11, 12, 13, 14, 15); } while (0)
#define PG8_LDB(dst, b, h) do { _Pragma("unroll") for (int n = 0; n < 2; ++n) dst[n] = __builtin_shufflevector(*(const PG8_LAS bf16x8*)(lds + PG8_SB(b, h) + boff + n * 2048), *(const PG8_LAS bf16x8*)(lds + PG8_SB(b, h) + boff + n * 2048 + 1024), 0, 1, 2, 3, 4, 5, 6, 7, 8, 9, 10, 11, 12, 13, 14, 15); } while (0)
#define PG8_MMA(ai, bj, At, Bt) do { __builtin_amdgcn_s_setprio(1); _Pragma("unroll") for (int m = 0; m < 4; ++m) _Pragma("unroll") for (int n = 0; n < 2; ++n) { \
        if constexpr (FP8) { typedef int v8i_ __attribute__((ext_vector_type(8)));   \
            asm volatile("v_mfma_scale_f32_16x16x128_f8f6f4 %0, %1, %2, %0, %3, %3 op_sel_hi:[0,0,0]" : "+v"(acc[ai][bj][m][n]) : "v"(__builtin_bit_cast(v8i_, Bt[n])), "v"(__builtin_bit_cast(v8i_, At[m])), "v"(mx_one)); \
        } else { \
            acc[ai][bj][m][n] = __builtin_amdgcn_mfma_f32_16x16x32_bf16(__builtin_shufflevector(Bt[n], Bt[n], 0, 1, 2, 3, 4, 5, 6, 7), __builtin_shufflevector(At[m], At[m], 0, 1, 2, 3, 4, 5, 6, 7), acc[ai][bj][m][n], 0, 0, 0); \
            acc[ai][bj][m][n] = __builtin_amdgcn_mfma_f32_16x16x32_bf16(__builtin_shufflevector(Bt[n], Bt[n], 8, 9, 10, 11, 12, 13, 14, 15), __builtin_shufflevector(At[m], At[m], 8, 9, 10, 11, 12, 13, 14, 15), acc[ai][bj][m][n], 0, 0, 0); } } \
        __builtin_amdgcn_s_setprio(0); } while (0)
#define PG8_WAIT_V(n) asm volatile("s_waitcnt vmcnt(" #n ")" ::: "memory")
#define PG8_WAIT_L(n) asm volatile("s_waitcnt lgkmcnt(" #n ")" ::: "memory")
#define PG8_BAR __builtin_amdgcn_s_barrier()
#define PG8_SCHED __builtin_amdgcn_sched_barrier(0)
    Unit cur, nxt; int ui = 0;
    if (!S.next(0, cur)) return;
    f32x4 acc[2][2][4][2];
#pragma unroll
    for (int a = 0; a < 2; ++a)
#pragma unroll
        for (int b = 0; b < 2; ++b)
#pragma unroll
            for (int m = 0; m < 4; ++m)
#pragma unroll
                for (int n = 0; n < 2; ++n) acc[a][b][m][n] = (f32x4){0.f, 0.f, 0.f, 0.f};
    if constexpr (Epi::HAS_INIT) E.init(acc, cur, wr, wc, fr, fq);
    const int mx_one = 0x7f7f7f7f;
    typedef short bf16x16 __attribute__((ext_vector_type(16)));
    bf16x16 At[4], B0[2], B1[2];
    const char* cA = S.a_base(g, cur, tstep); const char* cB = S.b_base(g, cur, tstep);
    S.a_ready(cur);
    if constexpr (SP2) {
        PG8_STAGE(PG8_SB(0, 0), cB, voffB); PG8_STAGE(PG8_SB(0, 1), cB + hstep, voffB); PG8_STAGE(PG8_SA(0, 0), PG8_AP(cA, 0, 0), voffA); PG8_STAGE(PG8_SA(0, 1), PG8_AP(cA, 1, 0), voffA);
        if (wr == 1) PG8_BAR;
        PG8_WAIT_V(2); PG8_BAR;
        PG8_STAGE(PG8_SB(1, 0), cB + kstep, voffB); PG8_STAGE(PG8_SA(1, 0), PG8_AP(cA, 0, 1), voffA); PG8_STAGE(PG8_SB(1, 1), cB + hstep + kstep, voffB);
        PG8_WAIT_V(6); PG8_BAR;
    } else {
        PG8_STAGE(PG8_SB(0, 0), cB, voffB); PG8_STAGE(PG8_SA(0, 0), PG8_AP(cA, 0, 0), voffA); PG8_STAGE(PG8_SB(0, 1), cB + hstep, voffB); PG8_STAGE(PG8_SA(0, 1), PG8_AP(cA, 1, 0), voffA);
        if (wr == 1) PG8_BAR;
        PG8_WAIT_V(4); PG8_BAR;
        PG8_STAGE(PG8_SB(1, 0), cB + kstep, voffB); PG8_STAGE(PG8_SA(1, 0), PG8_AP(cA, 0, 1), voffA); PG8_STAGE(PG8_SB(1, 1), cB + hstep + kstep, voffB);
        PG8_WAIT_V(6); PG8_BAR;
    }
    for (;;) {
        const bool has_next = S.next(ui + 1, nxt);
        const char* nA = has_next ? S.a_base(g, nxt, tstep) : cA; const char* nB = has_next ? S.b_base(g, nxt, tstep) : cB;
        for (int t = 0; t < nt; t += 2) {
            const bool last = (t == nt - 2);
            const char* a2b = last ? nA : cA; const int a2k = last ? 0 : t + 2; const char* b2 = last ? nB : cB + (size_t)(t + 2) * kstep;
            const char* b3 = b2 + kstep;
            const char* a1h = PG8_AP(cA, 1, t + 1); const char* a2 = PG8_AP(a2b, 0, a2k); const char* a2h = PG8_AP(a2b, 1, a2k); const char* a3 = PG8_AP(a2b, 0, a2k + 1);
            if (last && has_next) S.a_ready(nxt);
            if constexpr (SP2) {
            PG8_LDB(B0, 0, 0); PG8_LDB(B1, 0, 1); PG8_SCHED; PG8_LDA(At, 0, 0); PG8_STAGE(PG8_SA(1, 1), a1h, voffA);
            PG8_WAIT_V(8); PG8_WAIT_L(0); PG8_BAR; PG8_MMA(0, 0, At, B0); PG8_MMA(0, 1, At, B1); PG8_BAR; PG8_SCHED;
            PG8_LDA(At, 0, 1); PG8_STAGE(PG8_SB(0, 0), b2, voffB); PG8_STAGE(PG8_SB(0, 1), b2 + hstep, voffB); PG8_STAGE(PG8_SA(0, 0), a2, voffA);
            PG8_WAIT_V(8); PG8_WAIT_L(0); PG8_BAR; PG8_MMA(1, 0, At, B0); PG8_MMA(1, 1, At, B1); PG8_BAR; PG8_SCHED;
            PG8_LDB(B0, 1, 0); PG8_LDB(B1, 1, 1); PG8_SCHED; PG8_LDA(At, 1, 0); PG8_STAGE(PG8_SA(0, 1), a2h, voffA);
            PG8_WAIT_V(8); PG8_WAIT_L(0); PG8_BAR; PG8_MMA(0, 0, At, B0); PG8_MMA(0, 1, At, B1); PG8_BAR; PG8_SCHED;
            PG8_LDA(At, 1, 1); PG8_STAGE(PG8_SB(1, 0), b3, voffB); PG8_STAGE(PG8_SB(1, 1), b3 + hstep, voffB); PG8_STAGE(PG8_SA(1, 0), a3, voffA);
            PG8_WAIT_V(8); PG8_WAIT_L(0); PG8_BAR; PG8_MMA(1, 0, At, B0); PG8_MMA(1, 1, At, B1); PG8_BAR; PG8_SCHED;
            } else {
            PG8_LDB(B0, 0, 0); PG8_SCHED; PG8_LDA(At, 0, 0); PG8_STAGE(PG8_SA(1, 1), a1h, voffA);
            PG8_WAIT_L(8); PG8_BAR; PG8_WAIT_L(0); PG8_MMA(0, 0, At, B0); PG8_BAR; PG8_SCHED;
            PG8_LDB(B1, 0, 1); PG8_STAGE(PG8_SB(0, 0), b2, voffB);
            PG8_BAR; PG8_WAIT_L(0); PG8_MMA(0, 1, At, B1); PG8_BAR;
            PG8_LDA(At, 0, 1); PG8_STAGE(PG8_SA(0, 0), a2, voffA);
            PG8_BAR; PG8_WAIT_L(0); PG8_MMA(1, 0, At, B0); PG8_BAR; PG8_SCHED;
            PG8_STAGE(PG8_SB(0, 1), b2 + hstep, voffB);
            PG8_WAIT_V(6); PG8_BAR; PG8_MMA(1, 1, At, B1); PG8_BAR;
            PG8_LDB(B0, 1, 0); PG8_SCHED; PG8_LDA(At, 1, 0); PG8_STAGE(PG8_SA(0, 1), a2h, voffA);
            PG8_WAIT_L(8); PG8_BAR; PG8_WAIT_L(0); PG8_MMA(0, 0, At, B0); PG8_BAR; PG8_SCHED;
            PG8_LDB(B1, 1, 1); PG8_STAGE(PG8_SB(1, 0), b3, voffB);
            PG8_BAR; PG8_WAIT_L(0); PG8_MMA(0, 1, At, B1); PG8_BAR;
            PG8_LDA(At, 1, 1); PG8_STAGE(PG8_SA(1, 0), a3, voffA);
            PG8_BAR; PG8_WAIT_L(0); PG8_MMA(1, 0, At, B0); PG8_BAR; PG8_SCHED;
            PG8_STAGE(PG8_SB(1, 1), b3 + hstep, voffB);
            PG8_WAIT_V(6); PG8_BAR; PG8_MMA(1, 1, At, B1); PG8_BAR;
            }
        }
        if constexpr (ALIGN_EPI) { if (wr == 0) PG8_BAR; }
        if constexpr (!Epi::AFTER_DRAIN) { E(acc, cur, wr, wc, fr, fq); S.done(cur); }
        if (!has_next) break;
        if (!(Epi::CARRY && cur.which == 0)) {
#pragma unroll
        for (int a = 0; a < 2; ++a)
#pragma unroll
            for (int b = 0; b < 2; ++b)
#pragma unroll
                for (int m = 0; m < 4; ++m)
#pragma unroll
                    for (int n = 0; n < 2; ++n) acc[a][b][m][n] = (f32x4){0.f, 0.f, 0.f, 0.f};
        }
        if constexpr (Epi::HAS_INIT) E.init(acc, nxt, wr, wc, fr, fq);
        cur = nxt; cA = nA; cB = nB; ++ui;
        if constexpr (ALIGN_EPI) { if (wr == 1) PG8_BAR; }
    }
    PG8_WAIT_V(0);
    if constexpr (!ALIGN_EPI) { if (wr == 0) PG8_BAR; }
    PG8_BAR;
    if constexpr (Epi::AFTER_DRAIN) { E.fused(acc, cur, wr, wc, fr, fq, lds, wid, lane); S.done(cur); }
#undef PG8_AP
#undef PG8_SA
#undef PG8_SB
#undef PG8_STAGE
#undef PG8_LDA
#undef PG8_LDB
#undef PG8_MMA
#undef PG8_WAIT_V
#undef PG8_WAIT_L
#undef PG8_BAR
#undef PG8_SCHED
}
}

#ifndef PG8_SP2
#define PG8_SP2 true
#endif
#ifndef PG8_ALIGN
#define PG8_ALIGN true
#endif
#ifndef MK_ONE_LAUNCH
#define MK_ONE_LAUNCH 1
#endif

constexpr int NWAVES = 8;
constexpr int T = 32768, D = 1024, SEQ = 4096;
constexpr int IN_DIM = 4352, PA_W = 2304, G_W = 2048;
constexpr int N16 = 1536, N8 = IN_DIM - N16;
constexpr int C_U = 0, C_B = 512, C_C = 1024, C_Q = 1536, C_K = 2048, C_V = 2176;
constexpr int CONV = 512, HD = 64, NH = 8, NKV = 2;
constexpr int PH = 8, NKEYS = 128, PQ = 2048, TOPK = 16, NEXP = 16384, NSEL = 128;
constexpr float EPS = 1e-6f;
constexpr int N_PHASES = 10;

constexpr size_t MiB = 1u << 20;
constexpr size_t WS_CTL = 0, CTL_ZERO_BYTES = 1 * MiB;
constexpr size_t WS_WIN = 2 * MiB;
constexpr size_t WS_WG8 = WS_WIN + 3072 * 1024;
constexpr size_t WS_WC = 11 * MiB;
constexpr size_t WS_WA = 12 * MiB;
constexpr size_t WS_WO = 13 * MiB;
constexpr size_t WS_WQ = 15 * MiB;
constexpr size_t WS_SK = 19 * MiB;
constexpr size_t WS_RSTD1 = 20 * MiB;
constexpr size_t WS_SSQ = 21 * MiB;
constexpr size_t WS_UB = 24 * MiB;
constexpr size_t WS_SU = 32 * MiB;
constexpr size_t WS_VB = 40 * MiB;
constexpr size_t WS_SV = 48 * MiB;
constexpr size_t WS_XB8 = 56 * MiB;
constexpr size_t WS_XB = 88 * MiB;
constexpr size_t WS_PA = 152 * MiB;
constexpr size_t WS_MIX = WS_PA;
constexpr size_t WS_G = 296 * MiB;
constexpr size_t WS_QP = WS_G;
constexpr size_t WS_Z = 424 * MiB;
constexpr size_t WS_ATT = 456 * MiB;
constexpr size_t WS_IDX = WS_Z, WS_GATE = WS_ATT;
constexpr size_t WS_PART = WS_PA;
constexpr size_t WS_ACT = WS_G;
constexpr size_t WS_END = 488 * MiB;
constexpr int CW_BAR = 4096;

constexpr int RING_OFF = 0, RING_BYTES = 131072;
constexpr int LDSCTL_OFF = 147456, MISC_OFF = LDSCTL_OFF + 320;
constexpr int P9_OUT_OFF = 148480;
constexpr int LDS_BYTES = 156672;
#define GAS __attribute__((address_space(1)))
#define LAS __attribute__((address_space(3)))
typedef unsigned short bf16;
typedef unsigned v4u __attribute__((ext_vector_type(4)));
typedef float f32x4 __attribute__((ext_vector_type(4)));
typedef short bf16x8 __attribute__((ext_vector_type(8)));
typedef GAS unsigned gu32;
typedef GAS unsigned long long gu64;
#define RLX_AGENT __ATOMIC_RELAXED, __HIP_MEMORY_SCOPE_AGENT
#define LDS_WAIT() asm volatile("s_waitcnt lgkmcnt(0)" ::: "memory")
#define VM_WAIT() asm volatile("s_waitcnt vmcnt(0)" ::: "memory")
__device__ __forceinline__ unsigned long long rt() { return __builtin_amdgcn_s_memrealtime(); }
__device__ __forceinline__ unsigned f2bf(float f) { unsigned u = __builtin_bit_cast(unsigned, f); return (u + 0x7fffu + ((u >> 16) & 1u)) >> 16; }
__device__ __forceinline__ unsigned pk2(float lo, float hi) { return f2bf(lo) | (f2bf(hi) << 16); }

#define XB_TMO      128
#define XB_XCNT(j)  (256  + 64 * (j))
#define XB_XSUB(j)  (1280 + 64 * (j))
#define XB_XGEN(j)  (2304 + 64 * (j))
#define XB_TOP      3328
#define XB_TOPGEN   3392
#define XCD_BAR_WORDS 3456
#define XB_LSUB(j)  (3456 + 64 * (j))
#define XB_LGEN(j)  (4480 + 64 * (j))
#define XB_SPIN_CAP (1u << 18)

__device__ __forceinline__ unsigned xb_ld(unsigned* p)              { return __hip_atomic_load(p, __ATOMIC_RELAXED, __HIP_MEMORY_SCOPE_AGENT); }
__device__ __forceinline__ unsigned xb_add(unsigned* p, unsigned v) { return __hip_atomic_fetch_add(p, v, __ATOMIC_RELAXED, __HIP_MEMORY_SCOPE_AGENT); }
__device__ __forceinline__ unsigned xb_xcc_id() { return (unsigned)__builtin_amdgcn_s_getreg((3 << 11) | 20) & 0xFu; }
#define XB_SPIN(cond, bar) do { unsigned _sp = 0; while (cond) { __builtin_amdgcn_s_sleep(1); \
    if ((++_sp & 255u) == 0u) { if (xb_ld(&(bar)[XB_TMO])) break; if (_sp > XB_SPIN_CAP) { atomicAdd(&(bar)[XB_TMO], 1u); break; } } } } while (0)

struct XcdBarrier {
    unsigned* bar; unsigned x;
    volatile LAS unsigned* st;
};

__device__ __forceinline__ XcdBarrier xcd_barrier_post(unsigned* bar, volatile LAS unsigned* st) {
    XcdBarrier b; b.bar = bar; b.x = xb_xcc_id(); b.st = st;
    if (threadIdx.x == 0) st[2] = xb_add(&bar[XB_XCNT(b.x)], 1u);
    return b;
}
__device__ __forceinline__ void xcd_barrier_complete(unsigned* bar, unsigned x, unsigned& nloc, unsigned& nx) {
    const unsigned G = gridDim.x * gridDim.y * gridDim.z;
    unsigned sum, cnt, mine, sp = 0u;
    for (;;) {
        sum = 0u; cnt = 0u; mine = 0u;
#pragma unroll
        for (unsigned j = 0; j < 16; ++j) { const unsigned c = xb_ld(&bar[XB_XCNT(j)]); sum += c; cnt += (c > 0u) ? 1u : 0u; mine = (j == x) ? c : mine; }
        if (sum == G) break;
        __builtin_amdgcn_s_sleep(1);
        if ((++sp & 255u) == 0u) { if (xb_ld(&bar[XB_TMO])) break; if (sp > XB_SPIN_CAP) { atomicAdd(&bar[XB_TMO], 1u); break; } }
    }
    nloc = mine > 0u ? mine : 1u; nx = cnt > 0u ? cnt : 1u;
}

__device__ __forceinline__ void xcd_barrier(const XcdBarrier& b) {
    asm volatile("s_waitcnt vmcnt(0)" ::: "memory");
    __syncthreads();
    if (threadIdx.x == 0) {
        unsigned* bar = b.bar;
        __builtin_amdgcn_s_waitcnt(0);
        unsigned nloc = b.st[0], nx = b.st[1];
        if (nloc == 0u) { xcd_barrier_complete(bar, b.x, nloc, nx); b.st[0] = nloc; b.st[1] = nx; }
        const unsigned old = xb_add(&bar[XB_XSUB(b.x)], 1u);
        const unsigned gen = old / nloc;
        if (old + 1u == (gen + 1u) * nloc) {
            __builtin_amdgcn_fence(__ATOMIC_RELEASE, "agent");
            asm volatile("s_waitcnt vmcnt(0)" ::: "memory");
            const unsigned og = xb_add(&bar[XB_TOP], 1u);
            const unsigned tg = og / nx;
            if (og + 1u == (tg + 1u) * nx) xb_add(&bar[XB_TOPGEN], 1u);
            else XB_SPIN(xb_ld(&bar[XB_TOPGEN]) == tg, bar);
            __builtin_amdgcn_fence(__ATOMIC_ACQUIRE, "agent");
            xb_add(&bar[XB_XGEN(b.x)], 1u);
            asm volatile("s_waitcnt vmcnt(0)" ::: "memory");
        } else {
            XB_SPIN(xb_ld(&bar[XB_XGEN(b.x)]) == gen, bar);
            __builtin_amdgcn_fence(__ATOMIC_ACQUIRE, "agent");
            asm volatile("s_waitcnt vmcnt(0)" ::: "memory");
        }
    }
    __syncthreads();
}

__device__ __forceinline__ void xcd_local_barrier(const XcdBarrier& b) {
    asm volatile("s_waitcnt vmcnt(0)" ::: "memory");
    __syncthreads();
    if (threadIdx.x == 0) {
        unsigned* bar = b.bar;
        __builtin_amdgcn_s_waitcnt(0);
        const unsigned nloc = b.st[0];
        const unsigned old = xb_add(&bar[XB_LSUB(b.x)], 1u);
        const unsigned gen = old / nloc;
        if (old + 1u == (gen + 1u) * nloc) xb_add(&bar[XB_LGEN(b.x)], 1u);
        else XB_SPIN(xb_ld(&bar[XB_LGEN(b.x)]) == gen, bar);
        __builtin_amdgcn_fence(__ATOMIC_ACQUIRE, "agent");
        asm volatile("s_waitcnt vmcnt(0)" ::: "memory");
    }
    __syncthreads();
}

typedef float f32x16 __attribute__((ext_vector_type(16)));
typedef unsigned v2u __attribute__((ext_vector_type(2)));
typedef int v4i __attribute__((ext_vector_type(4)));
typedef __bf16 bf2_t __attribute__((ext_vector_type(2)));
#define DI __device__ __forceinline__
struct Frame {
    LAS unsigned char* lds;
    volatile LAS unsigned* MISC;
    gu32* ctl;
    int tid, lane, wave, vcu, G;
    int xlocal, xq, xrank, cvirt;
    const float *x, *norm_mix, *norm_ffn, *w_in, *b_gate, *w_conv, *q_norm, *k_norm, *sinks, *rel_bias, *w_conv_out, *w_attn_out, *w_out, *w_query, *sub_keys, *expert_u, *expert_v;
    float* out;
    unsigned char* WG8; bf16 *WIN, *WC, *WA, *WO, *WQ, *SK, *UB, *VB, *XB, *PA, *MIX, *G_, *QP, *Z, *ATT;
    float *RSTD1, *SSQ, *GATE, *ACT, *SU, *SV; bf16* PARTB; unsigned char* XB8; unsigned short* IDX;
};
DI float wave_sum(float v) {
#pragma unroll
    for (int o = 1; o < 64; o <<= 1) v += __shfl_xor(v, o);
    return v;
}
DI float bf_lo(unsigned u) { return __builtin_bit_cast(float, u << 16); }
DI float bf_hi(unsigned u) { return __builtin_bit_cast(float, u & 0xffff0000u); }

constexpr float WG_SCALE = 32.f;
DI void p0_transpose_item(const float* W, int K, int N, bf16* WT, const float* gsc, LAS float* scr, int item, int lane, int n8 = 1 << 30, unsigned char* W8 = nullptr) {
    const int nblk = N / 32, kb = item / nblk, nb = item % nblk, k0 = 64 * kb, n0 = 32 * nb;
#pragma unroll 8
    for (int i = 0; i < 32; ++i) { const int kk = 2 * i + (lane >> 5); float v = W[(size_t)(k0 + kk) * N + n0 + (lane & 31)]; if (gsc) v *= gsc[k0 + kk]; scr[kk * 33 + (lane & 31)] = v; }
    LDS_WAIT(); asm volatile("" ::: "memory");
    const int c = lane & 7;
#pragma unroll
    for (int j = 0; j < 4; ++j) { const int n = (lane >> 3) + 8 * j; const LAS float* s = scr + (8 * c) * 33 + n;
        if (n0 >= n8) {
            int p0_ = 0, p1_ = 0;
            p0_ = __builtin_amdgcn_cvt_pk_fp8_f32(s[0 * 33] * WG_SCALE, s[1 * 33] * WG_SCALE, p0_, false); p0_ = __builtin_amdgcn_cvt_pk_fp8_f32(s[2 * 33] * WG_SCALE, s[3 * 33] * WG_SCALE, p0_, true);
            p1_ = __builtin_amdgcn_cvt_pk_fp8_f32(s[4 * 33] * WG_SCALE, s[5 * 33] * WG_SCALE, p1_, false); p1_ = __builtin_amdgcn_cvt_pk_fp8_f32(s[6 * 33] * WG_SCALE, s[7 * 33] * WG_SCALE, p1_, true);
            v2u o8; o8.x = (unsigned)p0_; o8.y = (unsigned)p1_; *(GAS v2u*)(W8 + (size_t)(n0 + n - n8) * K + k0 + 8 * c) = o8; continue; }
        v4u o; o.x = pk2(s[0 * 33], s[1 * 33]); o.y = pk2(s[2 * 33], s[3 * 33]); o.z = pk2(s[4 * 33], s[5 * 33]); o.w = pk2(s[6 * 33], s[7 * 33]);
        *(GAS v4u*)(WT + (size_t)(n0 + n) * K + k0 + 8 * c) = o; }
    LDS_WAIT(); asm volatile("" ::: "memory");
}
DI void p0_convert(Frame& F, const float* src, bf16* dst, size_t n, const float* colscale) {
    const size_t n8 = n / 8, stride = (size_t)F.G * NWAVES * 64;
    for (size_t i = (size_t)F.vcu * NWAVES * 64 + F.tid; i < n8; i += stride) {
        f32x4 a = *(const GAS f32x4*)(src + i * 8), b = *(const GAS f32x4*)(src + i * 8 + 4);
        if (colscale) { const int c = (int)((i * 8) & 1023); const f32x4 s0 = *(const GAS f32x4*)(colscale + c), s1 = *(const GAS f32x4*)(colscale + c + 4); a = a * s0; b = b * s1; }
        v4u o; o.x = pk2(a.x, a.y); o.y = pk2(a.z, a.w); o.z = pk2(b.x, b.y); o.w = pk2(b.z, b.w);
        *(GAS v4u*)(dst + i * 8) = o;
    }
}
constexpr float A_SCALE = 128.f;
DI unsigned pk4_fp8(f32x4 v) { int r = 0; r = __builtin_amdgcn_cvt_pk_fp8_f32(v[0], v[1], r, false); r = __builtin_amdgcn_cvt_pk_fp8_f32(v[2], v[3], r, true); return (unsigned)r; }
DI void p0_convert_fp8(Frame& F, const float* src, unsigned char* dst, size_t n, const float* colscale, float scale, int bidx, int nblk) {
    const int gw = bidx * NWAVES + F.wave, NGW = nblk * NWAVES, lane = F.lane;
    f32x4 cs[4];
#pragma unroll
    for (int q = 0; q < 4; ++q) cs[q] = colscale ? *(const GAS f32x4*)(colscale + 4 * lane + 256 * q) * scale : (f32x4){scale, scale, scale, scale};
    const int nrows = (int)(n / D);
    for (int e = gw; e < nrows; e += NGW) {
        const GAS f32x4* rp = (const GAS f32x4*)(src + (size_t)e * D) + lane;
        f32x4 v[4];
#pragma unroll
        for (int q = 0; q < 4; ++q) v[q] = rp[64 * q];
#pragma unroll
        for (int q = 0; q < 4; ++q) *(GAS unsigned*)(dst + ((size_t)(2 * q + (lane >> 5)) * NEXP + e) * 128 + ((4 * lane) & 127)) = pk4_fp8(v[q] * cs[q]);
    }
}
DI void p0_convert_fp4(Frame& F, const float* src, const float* gain, unsigned char* dst, float* scl, int e0, int e1) {
    const int gw = F.wave, NGW = NWAVES, lane = F.lane;
    f32x4 cs[4];
#pragma unroll
    for (int q = 0; q < 4; ++q) cs[q] = gain ? *(const GAS f32x4*)(gain + 4 * lane + 256 * q) : (f32x4){1.f, 1.f, 1.f, 1.f};
    for (int e = e0 + gw; e < e1; e += NGW) {
        const GAS f32x4* rp = (const GAS f32x4*)(src + (size_t)e * D) + lane;
        f32x4 v[4]; float mx = 0.f;
#pragma unroll
        for (int q = 0; q < 4; ++q) { v[q] = rp[64 * q] * cs[q]; mx = fmaxf(mx, fmaxf(fmaxf(fabsf(v[q][0]), fabsf(v[q][1])), fmaxf(fabsf(v[q][2]), fabsf(v[q][3])))); }
#pragma unroll
        for (int o = 1; o < 64; o <<= 1) mx = fmaxf(mx, __shfl_xor(mx, o));
        const float inv = mx > 0.f ? 6.f / mx : 0.f;
        if (lane == 0) scl[e] = mx * (1.f / 6.f);
#pragma unroll
        for (int q = 0; q < 4; ++q) { unsigned r = 0u;
            r = __builtin_amdgcn_cvt_scalef32_pk_fp4_f32(r, v[q][0] * inv, v[q][1] * inv, 1.0f, 0);
            r = __builtin_amdgcn_cvt_scalef32_pk_fp4_f32(r, v[q][2] * inv, v[q][3] * inv, 1.0f, 1);
            *(GAS unsigned short*)(dst + ((size_t)q * NEXP + e) * 128 + 2 * lane) = (unsigned short)r; }
    }
}
template <int RB> DI void p0_rows(Frame& F, const float* xrow, bf16* orow, float* rms_out, unsigned char* o8row) {
    f32x4 v[RB][4]; float s[RB];
#pragma unroll
    for (int r = 0; r < RB; ++r) { const GAS f32x4* xr = (const GAS f32x4*)(xrow + (size_t)r * D) + F.lane;
#pragma unroll
        for (int j = 0; j < 4; ++j) v[r][j] = xr[64 * j]; }
#pragma unroll
    for (int r = 0; r < RB; ++r) { s[r] = 0.f;
#pragma unroll
        for (int j = 0; j < 4; ++j) s[r] += (v[r][j].x * v[r][j].x + v[r][j].y * v[r][j].y) + (v[r][j].z * v[r][j].z + v[r][j].w * v[r][j].w); }
#pragma unroll
    for (int o = 1; o < 64; o <<= 1)
#pragma unroll
        for (int r = 0; r < RB; ++r) s[r] += __shfl_xor(s[r], o);
#pragma unroll
    for (int r = 0; r < RB; ++r) { const float rms = sqrtf(s[r] * (1.f / D) + EPS), rs = 1.f / rms; if (F.lane == 0) rms_out[r] = rms;
        GAS unsigned long long* o8 = (GAS unsigned long long*)(orow + (size_t)r * D) + F.lane;
#pragma unroll
        for (int j = 0; j < 4; ++j) { o8[64 * j] = (unsigned long long)pk2(v[r][j].x * rs, v[r][j].y * rs) | ((unsigned long long)pk2(v[r][j].z * rs, v[r][j].w * rs) << 32);
            *(GAS unsigned*)(o8row + (size_t)r * D + 4 * F.lane + 256 * j) = pk4_fp8(v[r][j] * rs); } }
}
DI void p0_prologue(Frame& F) {
    LAS float* scr = (LAS float*)(F.lds + RING_OFF + F.wave * 16384);
    const int gw = F.vcu * NWAVES + F.wave, NGW = F.G * NWAVES;
    constexpr int I_IN = (D / 64) * (IN_DIM / 32), I_C = (CONV / 64) * (D / 32), I_O = (D / 64) * (D / 32), I_Q = (D / 64) * (PQ / 32);
    constexpr int NITEMS = I_IN + 2 * I_C + I_O + I_Q;
    for (int it = gw; it < NITEMS; it += NGW) {
        int r = it;
        if (r < I_IN) { p0_transpose_item(F.w_in, D, IN_DIM, F.WIN, F.norm_mix, scr, r, F.lane, N16, F.WG8); continue; } r -= I_IN;
        if (r < I_C) { p0_transpose_item(F.w_conv_out, CONV, D, F.WC, nullptr, scr, r, F.lane); continue; } r -= I_C;
        if (r < I_C) { p0_transpose_item(F.w_attn_out, CONV, D, F.WA, nullptr, scr, r, F.lane); continue; } r -= I_C;
        if (r < I_O) { p0_transpose_item(F.w_out, D, D, F.WO, nullptr, scr, r, F.lane); continue; } r -= I_O;
        p0_transpose_item(F.w_query, D, PQ, F.WQ, F.norm_ffn, scr, r, F.lane);
    }
    p0_convert(F, F.sub_keys, F.SK, (size_t)PH * 2 * NKEYS * 128, nullptr);
    for (int m = 4 * gw; m < T; m += 4 * NGW) p0_rows<4>(F, F.x + (size_t)m * D, F.XB + (size_t)m * D, F.RSTD1 + m, F.XB8 + (size_t)m * D);
}

namespace pg8 {
DI float sigmoidf_(float v) { return __builtin_amdgcn_rcpf(1.f + __expf(-v)); }
DI size_t frag_off(int pm, int pn, int NT, int wave, int q, int lane) { return (((((size_t)pm * NT + pn) * 8 + wave) * 16 + q) * 64 + lane) * 8; }
struct EpiProj {
    static constexpr bool PERM = true, AFTER_DRAIN = false, HAS_INIT = false, CARRY = false;
    bf16_t* PA; bf16_t* G; const PG8_LAS float* bgl; int pa_col0, pn_gate0; float gsc;
    DI void operator()(const f32x4 (&acc)[2][2][4][2], const Unit& u, int wr, int wc, int fr, int fq) const {
        const int row0 = u.pm * BM + wr * 64 + fr; const bool gate = u.pn >= pn_gate0;
        const int col0 = (gate ? (u.pn - pn_gate0) * BM : pa_col0 + u.pn * BM) + wc * 32 + 8 * fq;
        if (!gate) {
#pragma unroll
            for (int ai = 0; ai < 2; ++ai)
#pragma unroll
                for (int m = 0; m < 4; ++m) { bf16_t* rowp = PA + (size_t)(row0 + ai * HALF + m * 16) * PA_W + col0;
#pragma unroll
                    for (int bj = 0; bj < 2; ++bj) { const f32x4 v0 = acc[ai][bj][m][0] * gsc, v1 = acc[ai][bj][m][1] * gsc;
                        u32x4 w; w.x = cvt_pk_bf16(v0[0], v0[1]); w.y = cvt_pk_bf16(v0[2], v0[3]); w.z = cvt_pk_bf16(v1[0], v1[1]); w.w = cvt_pk_bf16(v1[2], v1[3]);
                        store16_wt(rowp + bj * HALF, w); } }
        } else {
            f32x4 bv[2][2];
#pragma unroll
            for (int bj = 0; bj < 2; ++bj)
#pragma unroll
                for (int n = 0; n < 2; ++n) bv[bj][n] = *(const PG8_LAS f32x4*)(bgl + col0 + bj * HALF + 4 * n);
#pragma unroll
            for (int ai = 0; ai < 2; ++ai)
#pragma unroll
                for (int m = 0; m < 4; ++m)
#pragma unroll
                    for (int bj = 0; bj < 2; ++bj) { f32x4 v0 = acc[ai][bj][m][0] * gsc + bv[bj][0], v1 = acc[ai][bj][m][1] * gsc + bv[bj][1];
#pragma unroll
                        for (int j = 0; j < 4; ++j) { v0[j] = fmaxf(sigmoidf_(v0[j]) * 255.f, 1.f); v1[j] = fmaxf(sigmoidf_(v1[j]) * 255.f, 1.f); }
                        unsigned g0 = 0u, g1 = 0u;
                        g0 = __builtin_amdgcn_cvt_pk_u8_f32(v0[0], 0, g0); g0 = __builtin_amdgcn_cvt_pk_u8_f32(v0[1], 1, g0); g0 = __builtin_amdgcn_cvt_pk_u8_f32(v0[2], 2, g0); g0 = __builtin_amdgcn_cvt_pk_u8_f32(v0[3], 3, g0);
                        g1 = __builtin_amdgcn_cvt_pk_u8_f32(v1[0], 0, g1); g1 = __builtin_amdgcn_cvt_pk_u8_f32(v1[1], 1, g1); g1 = __builtin_amdgcn_cvt_pk_u8_f32(v1[2], 2, g1); g1 = __builtin_amdgcn_cvt_pk_u8_f32(v1[3], 3, g1);
                        u32x2 gw; gw.x = g0; gw.y = g1;
                        *(u32x2*)((unsigned char*)G + frag_off(u.pm, u.pn - pn_gate0, 8, wr * 4 + wc, ai * 8 + m * 2 + bj, fq * 16 + fr)) = gw; }
        }
    }
};
struct EpiMix {
    static constexpr bool PERM = true, AFTER_DRAIN = false, HAS_INIT = false, CARRY = true;
    bf16_t* MIX; const bf16_t* G;
    DI void operator()(f32x4 (&acc)[2][2][4][2], const Unit& u, int wr, int wc, int fr, int fq) const {
        const int wave = wr * 4 + wc, lane = fq * 16 + fr;
        const unsigned char* gc = (const unsigned char*)G + frag_off(u.pm, u.pn, 8, wave, 0, lane); const unsigned char* ga = (const unsigned char*)G + frag_off(u.pm, u.pn + 4, 8, wave, 0, lane);
        bf16_t* mp = MIX + frag_off(u.pm, u.pn, 4, wave, 0, lane);
#pragma unroll
        for (int ai = 0; ai < 2; ++ai) {
            u32x2 gav[8], gcv[8];
#pragma unroll
            for (int q = 0; q < 8; ++q) gav[q] = *(const u32x2*)(ga + (ai * 8 + q) * 512);
            if (!u.which) {
#pragma unroll
                for (int q = 0; q < 8; ++q) gcv[q] = *(const u32x2*)(gc + (ai * 8 + q) * 512); }
#pragma unroll
            for (int m = 0; m < 4; ++m)
#pragma unroll
                for (int bj = 0; bj < 2; ++bj) { const int q = m * 2 + bj; const u32x2 a2 = gav[q];
                    float fa[8] = {(float)(a2.x & 0xffu), (float)((a2.x >> 8) & 0xffu), (float)((a2.x >> 16) & 0xffu), (float)(a2.x >> 24), (float)(a2.y & 0xffu), (float)((a2.y >> 8) & 0xffu), (float)((a2.y >> 16) & 0xffu), (float)(a2.y >> 24)};
                    if (!u.which) { const u32x2 c2 = gcv[q];
                        const float fc[8] = {(float)(c2.x & 0xffu), (float)((c2.x >> 8) & 0xffu), (float)((c2.x >> 16) & 0xffu), (float)(c2.x >> 24), (float)(c2.y & 0xffu), (float)((c2.y >> 8) & 0xffu), (float)((c2.y >> 16) & 0xffu), (float)(c2.y >> 24)};
#pragma unroll
                        for (int e = 0; e < 4; ++e) { acc[ai][bj][m][0][e] *= fc[e] * __builtin_amdgcn_rcpf(fa[e]); acc[ai][bj][m][1][e] *= fc[4 + e] * __builtin_amdgcn_rcpf(fa[4 + e]); }
                    } else { constexpr float GI = 1.f / 255.f;
                        const f32x4 v0 = acc[ai][bj][m][0], v1 = acc[ai][bj][m][1];
                        u32x4 w; w.x = cvt_pk_bf16(v0[0] * fa[0] * GI, v0[1] * fa[1] * GI); w.y = cvt_pk_bf16(v0[2] * fa[2] * GI, v0[3] * fa[3] * GI);
                        w.z = cvt_pk_bf16(v1[0] * fa[4] * GI, v1[1] * fa[5] * GI); w.w = cvt_pk_bf16(v1[2] * fa[6] * GI, v1[3] * fa[7] * GI);
                        store16_wt(mp + (ai * 8 + q) * 512, w); } }
        }
    }
};
struct FragOrder : StaticOrder { static constexpr bool AFRAG = true; };
struct PairOrder : StaticOrder {
    __device__ bool next(int i, Unit& u) const { const bool ok = StaticOrder::next(i >> 1, u); u.which = i & 1; return ok; }
    DI const char* a_base(const Gemm& g, const Unit& u, size_t tstep) const { return (const char*)(u.which ? g.A2 : g.A) + (size_t)u.pm * tstep; }
    DI const char* b_base(const Gemm& g, const Unit& u, size_t tstep) const { return (const char*)(u.which ? g.Bt2 : g.Bt) + (size_t)u.pn * tstep; }
};
struct EpiX1 {
    static constexpr bool PERM = true, AFTER_DRAIN = false, HAS_INIT = true, CARRY = false;
    const float* RMS; bf16_t* XB; float* SSQ; unsigned char* XB8;
    DI void init(f32x4 (&acc)[2][2][4][2], const Unit& u, int wr, int wc, int fr, int fq) const {
        const int row0 = u.pm * BM + wr * 64 + fr, col0 = u.pn * BM + wc * 32 + 8 * fq;
#pragma unroll
        for (int ai = 0; ai < 2; ++ai)
#pragma unroll
            for (int m = 0; m < 4; ++m)
#pragma unroll
                for (int bj = 0; bj < 2; ++bj) { const int row = row0 + ai * HALF + m * 16; const float rm = RMS[row];
                    const u32x4 xn = *(const u32x4*)(XB + (size_t)row * D + col0 + bj * HALF);
                    acc[ai][bj][m][0] = (f32x4){__builtin_bit_cast(float, xn.x << 16), __builtin_bit_cast(float, xn.x & 0xffff0000u), __builtin_bit_cast(float, xn.y << 16), __builtin_bit_cast(float, xn.y & 0xffff0000u)} * rm;
                    acc[ai][bj][m][1] = (f32x4){__builtin_bit_cast(float, xn.z << 16), __builtin_bit_cast(float, xn.z & 0xffff0000u), __builtin_bit_cast(float, xn.w << 16), __builtin_bit_cast(float, xn.w & 0xffff0000u)} * rm; }
    }
    DI void operator()(const f32x4 (&acc)[2][2][4][2], const Unit& u, int wr, int wc, int fr, int fq) const {
        const int row0 = u.pm * BM + wr * 64 + fr, col0 = u.pn * BM + wc * 32 + 8 * fq;
#pragma unroll
        for (int ai = 0; ai < 2; ++ai)
#pragma unroll
            for (int m = 0; m < 4; ++m) { const int row = row0 + ai * HALF + m * 16; float ss = 0.f;
#pragma unroll
                for (int bj = 0; bj < 2; ++bj) { const f32x4 v0 = acc[ai][bj][m][0], v1 = acc[ai][bj][m][1];
                    ss += ((v0[0] * v0[0] + v0[1] * v0[1]) + (v0[2] * v0[2] + v0[3] * v0[3])) + ((v1[0] * v1[0] + v1[1] * v1[1]) + (v1[2] * v1[2] + v1[3] * v1[3]));
                    u32x4 w; w.x = cvt_pk_bf16(v0[0], v0[1]); w.y = cvt_pk_bf16(v0[2], v0[3]); w.z = cvt_pk_bf16(v1[0], v1[1]); w.w = cvt_pk_bf16(v1[2], v1[3]);
                    store16_wt(XB + (size_t)row * D + col0 + bj * HALF, w);
                    { int p0_ = 0, p1_ = 0;
                      p0_ = __builtin_amdgcn_cvt_pk_fp8_f32(v0[0], v0[1], p0_, false); p0_ = __builtin_amdgcn_cvt_pk_fp8_f32(v0[2], v0[3], p0_, true);
                      p1_ = __builtin_amdgcn_cvt_pk_fp8_f32(v1[0], v1[1], p1_, false); p1_ = __builtin_amdgcn_cvt_pk_fp8_f32(v1[2], v1[3], p1_, true);
                      u32x2 w8; w8.x = (unsigned)p0_; w8.y = (unsigned)p1_; *(u32x2*)(XB8 + (size_t)row * D + col0 + bj * HALF) = w8; } }
                ss += __shfl_xor(ss, 16); ss += __shfl_xor(ss, 32);
                if (fq == 0) SSQ[(size_t)row * 16 + u.pn * 4 + wc] = ss; }
    }
};
DI float rstd2_of(const float* SSQ, int row) {
    const f32x4 a = *(const f32x4*)(SSQ + (size_t)row * 16), b = *(const f32x4*)(SSQ + (size_t)row * 16 + 4), c = *(const f32x4*)(SSQ + (size_t)row * 16 + 8), d = *(const f32x4*)(SSQ + (size_t)row * 16 + 12);
    const float s = ((a[0] + a[1]) + (a[2] + a[3])) + ((b[0] + b[1]) + (b[2] + b[3])) + ((c[0] + c[1]) + (c[2] + c[3])) + ((d[0] + d[1]) + (d[2] + d[3]));
    return 1.f / sqrtf(s * (1.f / D) + EPS);
}
struct EpiQP {
    static constexpr bool PERM = true, AFTER_DRAIN = false, HAS_INIT = false, CARRY = false;
    bf16_t* QP;
    DI void operator()(const f32x4 (&acc)[2][2][4][2], const Unit& u, int wr, int wc, int fr, int fq) const {
        const int row0 = u.pm * BM + wr * 64 + fr, col0 = u.pn * BM + wc * 32 + 8 * fq;
#pragma unroll
        for (int ai = 0; ai < 2; ++ai)
#pragma unroll
            for (int m = 0; m < 4; ++m) {
#pragma unroll
                for (int bj = 0; bj < 2; ++bj) { const f32x4 v0 = acc[ai][bj][m][0], v1 = acc[ai][bj][m][1];
                    u32x4 w; w.x = cvt_pk_bf16(v0[0], v0[1]); w.y = cvt_pk_bf16(v0[2], v0[3]); w.z = cvt_pk_bf16(v1[0], v1[1]); w.w = cvt_pk_bf16(v1[2], v1[3]);
                    *(u32x4*)(QP + frag_off(u.pm, u.pn, 8, wr * 4 + wc, ai * 8 + m * 2 + bj, fq * 16 + fr)) = w; } }
    }
};
}

#define MFMA32(a, b, c) __builtin_amdgcn_mfma_f32_32x32x16_bf16((a), (b), (c), 0, 0, 0)
DI void p2_conv(Frame& F) {
    constexpr int CT = 4;
    const size_t NT_ = (size_t)F.G * NWAVES * 64;
    constexpr size_t PERB = (size_t)(SEQ / CT) * 64;
    const size_t it0 = F.xlocal ? (size_t)F.xq * PERB + (size_t)F.xrank * NWAVES * 64 + F.tid : (size_t)F.vcu * NWAVES * 64 + F.tid;
    const size_t itend = F.xlocal ? (size_t)(F.xq + 1) * PERB : (size_t)(T / CT) * 64, itstep = F.xlocal ? (size_t)(F.G / 8) * NWAVES * 64 : NT_;
    for (size_t item = it0; item < itend; item += itstep) {
        const int tb = (int)(item >> 6) * CT, c0 = (int)(item & 63) * 8, tl = tb & (SEQ - 1);
        v4u cg[CT + 2], uu[CT + 2], bg[CT];
#pragma unroll
        for (int r = 0; r < CT + 2; ++r) { const bool ok = (tl + r - 2) >= 0; const bf16* rowp = F.PA + (size_t)(tb + (ok ? r - 2 : 0)) * PA_W;
            cg[r] = *(const GAS v4u*)(rowp + C_C + c0); uu[r] = *(const GAS v4u*)(rowp + C_U + c0);
            if (!ok) { cg[r] = (v4u){0u, 0u, 0u, 0u}; } }
#pragma unroll
        for (int r = 0; r < CT; ++r) bg[r] = *(const GAS v4u*)(F.PA + (size_t)(tb + r) * PA_W + C_B + c0);
        f32x4 w[3][2];
#pragma unroll
        for (int j = 0; j < 3; ++j) { w[j][0] = *(const GAS f32x4*)(F.w_conv + j * CONV + c0); w[j][1] = *(const GAS f32x4*)(F.w_conv + j * CONV + c0 + 4); }
        float h[CT + 2][8];
#pragma unroll
        for (int r = 0; r < CT + 2; ++r) { h[r][0] = bf_lo(cg[r].x) * bf_lo(uu[r].x); h[r][1] = bf_hi(cg[r].x) * bf_hi(uu[r].x); h[r][2] = bf_lo(cg[r].y) * bf_lo(uu[r].y); h[r][3] = bf_hi(cg[r].y) * bf_hi(uu[r].y);
            h[r][4] = bf_lo(cg[r].z) * bf_lo(uu[r].z); h[r][5] = bf_hi(cg[r].z) * bf_hi(uu[r].z); h[r][6] = bf_lo(cg[r].w) * bf_lo(uu[r].w); h[r][7] = bf_hi(cg[r].w) * bf_hi(uu[r].w); }
#pragma unroll
        for (int r = 0; r < CT; ++r) {
            float a[8];
#pragma unroll
            for (int e = 0; e < 8; ++e) a[e] = w[0][e >> 2][e & 3] * h[r][e] + w[1][e >> 2][e & 3] * h[r + 1][e] + w[2][e >> 2][e & 3] * h[r + 2][e];
            v4u o; o.x = pk2(a[0] * bf_lo(bg[r].x), a[1] * bf_hi(bg[r].x)); o.y = pk2(a[2] * bf_lo(bg[r].y), a[3] * bf_hi(bg[r].y));
            o.z = pk2(a[4] * bf_lo(bg[r].z), a[5] * bf_hi(bg[r].z)); o.w = pk2(a[6] * bf_lo(bg[r].w), a[7] * bf_hi(bg[r].w));
            *(GAS v4u*)(F.Z + (size_t)(tb + r) * CONV + c0) = o;
        }
    }
}
DI int t5_bucket(int d) {
    if (d < 16) return d;
    const int large = 16 + (int)(logf((float)d / 16.f) / logf(8.f) * 16.f);
    return large < 31 ? large : 31;
}
constexpr int KS_STRIDE = 72, VT_STRIDE = 264;
constexpr int ATT_KS = 0, ATT_VT = 256 * KS_STRIDE * 2, ATT_BIAS = ATT_VT + 64 * VT_STRIDE * 2, ATT_END = ATT_BIAS + 4 * 128 * 4;
static_assert(ATT_END <= RING_BYTES, "attention LDS");
DI void p2_attention(Frame& F) {
    LAS bf16* KS = (LAS bf16*)(F.lds + ATT_KS); LAS bf16* VT = (LAS bf16*)(F.lds + ATT_VT); LAS float* BIAS = (LAS float*)(F.lds + ATT_BIAS);
    const int lane = F.lane, r = lane & 31, hh = lane >> 5;
#pragma unroll 1
    for (int unit = F.xlocal ? F.xq * 32 * NKV + F.xrank : F.vcu, uend = F.xlocal ? (F.xq + 1) * 32 * NKV : 8 * 32 * NKV, ustep = F.xlocal ? F.G / 8 : F.G; unit < uend; unit += ustep) {
        const int kv = unit & 1, n = (unit >> 1) & 31, b = unit >> 6;
        const int t0 = b * SEQ + n * 128;
        __syncthreads();
        {
            const int j = F.tid >> 1, hf = F.tid & 1; const bool valid = (n > 0) || (j >= 128);
            const bf16* rowp = F.PA + (size_t)(t0 - 128 + j) * PA_W;
            v4u kq[4], vq[4];
#pragma unroll
            for (int i = 0; i < 4; ++i) { kq[i] = (v4u){0u, 0u, 0u, 0u}; vq[i] = kq[i]; }
            if (valid) {
#pragma unroll
                for (int i = 0; i < 4; ++i) { kq[i] = *(const GAS v4u*)(rowp + C_K + kv * HD + hf * 32 + i * 8); vq[i] = *(const GAS v4u*)(rowp + C_V + kv * HD + hf * 32 + i * 8); }
            }
            float kf[32]; float ss = 0.f;
#pragma unroll
            for (int i = 0; i < 4; ++i) { kf[8 * i + 0] = bf_lo(kq[i].x); kf[8 * i + 1] = bf_hi(kq[i].x); kf[8 * i + 2] = bf_lo(kq[i].y); kf[8 * i + 3] = bf_hi(kq[i].y);
                kf[8 * i + 4] = bf_lo(kq[i].z); kf[8 * i + 5] = bf_hi(kq[i].z); kf[8 * i + 6] = bf_lo(kq[i].w); kf[8 * i + 7] = bf_hi(kq[i].w); }
#pragma unroll
            for (int e = 0; e < 32; ++e) ss += kf[e] * kf[e];
            ss += __shfl_xor(ss, 1);
            const float rs = 1.f / sqrtf(ss * (1.f / HD) + EPS);
#pragma unroll
            for (int i = 0; i < 4; ++i) { const f32x4 g0 = *(const GAS f32x4*)(F.k_norm + hf * 32 + 8 * i), g1 = *(const GAS f32x4*)(F.k_norm + hf * 32 + 8 * i + 4);
                v4u o; o.x = pk2(kf[8 * i + 0] * rs * g0[0], kf[8 * i + 1] * rs * g0[1]); o.y = pk2(kf[8 * i + 2] * rs * g0[2], kf[8 * i + 3] * rs * g0[3]);
                o.z = pk2(kf[8 * i + 4] * rs * g1[0], kf[8 * i + 5] * rs * g1[1]); o.w = pk2(kf[8 * i + 6] * rs * g1[2], kf[8 * i + 7] * rs * g1[3]);
                *(LAS v4u*)(KS + j * KS_STRIDE + hf * 32 + 8 * i) = o; }
#pragma unroll
            for (int i = 0; i < 4; ++i) { const int d0 = hf * 32 + 8 * i;
                VT[(d0 + 0) * VT_STRIDE + j] = (bf16)(vq[i].x & 0xffffu); VT[(d0 + 1) * VT_STRIDE + j] = (bf16)(vq[i].x >> 16);
                VT[(d0 + 2) * VT_STRIDE + j] = (bf16)(vq[i].y & 0xffffu); VT[(d0 + 3) * VT_STRIDE + j] = (bf16)(vq[i].y >> 16);
                VT[(d0 + 4) * VT_STRIDE + j] = (bf16)(vq[i].z & 0xffffu); VT[(d0 + 5) * VT_STRIDE + j] = (bf16)(vq[i].z >> 16);
                VT[(d0 + 6) * VT_STRIDE + j] = (bf16)(vq[i].w & 0xffffu); VT[(d0 + 7) * VT_STRIDE + j] = (bf16)(vq[i].w >> 16); }
            { const int g = F.tid >> 7, dist = F.tid & 127; BIAS[F.tid] = F.rel_bias[t5_bucket(dist) * NH + kv * 4 + g]; }
        }
        __syncthreads();
#pragma unroll 1
        for (int task = F.wave; task < 16; task += NWAVES) {
            const int g = task >> 2, c = task & 3, head = kv * 4 + g, r0 = 32 * c;
            bf16x8 qf[4];
            {
                const bf16* qp = F.PA + (size_t)(t0 + r0 + r) * PA_W + C_Q + head * HD + 8 * hh;
                v4u qq[4]; float qv[32]; float ss = 0.f;
#pragma unroll
                for (int s = 0; s < 4; ++s) qq[s] = *(const GAS v4u*)(qp + 16 * s);
#pragma unroll
                for (int s = 0; s < 4; ++s) { qv[8 * s + 0] = bf_lo(qq[s].x); qv[8 * s + 1] = bf_hi(qq[s].x); qv[8 * s + 2] = bf_lo(qq[s].y); qv[8 * s + 3] = bf_hi(qq[s].y);
                    qv[8 * s + 4] = bf_lo(qq[s].z); qv[8 * s + 5] = bf_hi(qq[s].z); qv[8 * s + 6] = bf_lo(qq[s].w); qv[8 * s + 7] = bf_hi(qq[s].w); }
#pragma unroll
                for (int e = 0; e < 32; ++e) ss += qv[e] * qv[e];
                ss += __shfl_xor(ss, 32);
                const float rs = 0.125f / sqrtf(ss * (1.f / HD) + EPS);
#pragma unroll
                for (int s = 0; s < 4; ++s) { const f32x4 g0 = *(const GAS f32x4*)(F.q_norm + 16 * s + 8 * hh), g1 = *(const GAS f32x4*)(F.q_norm + 16 * s + 8 * hh + 4);
                    v4u o; o.x = pk2(qv[8 * s + 0] * rs * g0[0], qv[8 * s + 1] * rs * g0[1]); o.y = pk2(qv[8 * s + 2] * rs * g0[2], qv[8 * s + 3] * rs * g0[3]);
                    o.z = pk2(qv[8 * s + 4] * rs * g1[0], qv[8 * s + 5] * rs * g1[1]); o.w = pk2(qv[8 * s + 6] * rs * g1[2], qv[8 * s + 7] * rs * g1[3]);
                    qf[s] = __builtin_bit_cast(bf16x8, o); }
            }
            f32x16 sacc[5];
#pragma unroll
            for (int i5 = 0; i5 < 5; ++i5) {
#pragma unroll
                for (int e = 0; e < 16; ++e) sacc[i5][e] = 0.f;
                const int kt = c + i5;
#pragma unroll
                for (int s = 0; s < 4; ++s) { const bf16x8 ka = *(const LAS bf16x8*)(KS + (32 * kt + r) * KS_STRIDE + 16 * s + 8 * hh); sacc[i5] = MFMA32(ka, qf[s], sacc[i5]); }
            }
            const float sink = F.sinks[head];
            const int dbase = r - 4 * hh + 128;
            const LAS float* bl = BIAS + g * 128;
            float mx = sink;
#pragma unroll
            for (int i5 = 0; i5 < 5; ++i5) {
                const bool tile_ok = (n > 0) || (c + i5 >= 4);
#pragma unroll
                for (int e = 0; e < 16; ++e) { const int dist = dbase - 32 * i5 - ((e & 3) + 8 * (e >> 2));
                    bool valid = tile_ok; if (i5 == 0) valid = valid && (dist < 128); if (i5 == 4) valid = valid && (dist >= 0);
                    const float lg = sacc[i5][e] + bl[dist & 127];
                    sacc[i5][e] = valid ? lg : -INFINITY; mx = fmaxf(mx, sacc[i5][e]); }
                __builtin_amdgcn_sched_barrier(0);
            }
            mx = fmaxf(mx, __shfl_xor(mx, 32));
            float sum = 0.f;
#pragma unroll
            for (int i5 = 0; i5 < 5; ++i5)
#pragma unroll
                for (int e = 0; e < 16; ++e) { const float p = __expf(sacc[i5][e] - mx); sacc[i5][e] = p; sum += p; }
            sum += __shfl_xor(sum, 32);
            const float inv = 1.f / (sum + __expf(sink - mx));
            f32x16 oacc[2];
#pragma unroll
            for (int dt = 0; dt < 2; ++dt)
#pragma unroll
                for (int e = 0; e < 16; ++e) oacc[dt][e] = 0.f;
#pragma unroll
            for (int i5 = 0; i5 < 5; ++i5)
#pragma unroll
                for (int s2 = 0; s2 < 2; ++s2) {
                    v4u pp; pp.x = pk2(sacc[i5][8 * s2 + 0] * inv, sacc[i5][8 * s2 + 1] * inv); pp.y = pk2(sacc[i5][8 * s2 + 2] * inv, sacc[i5][8 * s2 + 3] * inv);
                    pp.z = pk2(sacc[i5][8 * s2 + 4] * inv, sacc[i5][8 * s2 + 5] * inv); pp.w = pk2(sacc[i5][8 * s2 + 6] * inv, sacc[i5][8 * s2 + 7] * inv);
                    const bf16x8 pb = __builtin_bit_cast(bf16x8, pp);
                    const int kb = 32 * (c + i5) + 16 * s2 + 4 * hh;
#pragma unroll
                    for (int dt = 0; dt < 2; ++dt) {
                        const v2u lo = *(const LAS v2u*)(VT + (32 * dt + r) * VT_STRIDE + kb), hi = *(const LAS v2u*)(VT + (32 * dt + r) * VT_STRIDE + kb + 8);
                        v4u va; va.x = lo.x; va.y = lo.y; va.z = hi.x; va.w = hi.y;
                        oacc[dt] = MFMA32(__builtin_bit_cast(bf16x8, va), pb, oacc[dt]);
                    }
                    __builtin_amdgcn_sched_barrier(0);
                }
            bf16* op = F.ATT + (size_t)(t0 + r0 + r) * CONV + head * HD;
#pragma unroll
            for (int dt = 0; dt < 2; ++dt)
#pragma unroll
                for (int g4 = 0; g4 < 4; ++g4) { v2u w; w.x = pk2(oacc[dt][4 * g4 + 0], oacc[dt][4 * g4 + 1]); w.y = pk2(oacc[dt][4 * g4 + 2], oacc[dt][4 * g4 + 3]);
#ifdef ZERO_ATT
                    w.x = 0u; w.y = 0u;
#endif
                    *(GAS v2u*)(op + 32 * dt + 8 * g4 + 4 * hh) = w; }
        }
    }
}

DI unsigned f2ord(float f) { const unsigned b = __builtin_bit_cast(unsigned, f); return b ^ ((b >> 31) ? 0xffffffffu : 0x80000000u); }
DI float ord2f(unsigned k) { const unsigned b = k ^ ((k >> 31) ? 0x80000000u : 0xffffffffu); return __builtin_bit_cast(float, b); }
DI unsigned umax_(unsigned a, unsigned b) { return a > b ? a : b; }
DI unsigned umin_(unsigned a, unsigned b) { return a < b ? a : b; }
DI void sort16_desc(unsigned (&v)[16]) {
#pragma unroll
    for (int k = 2; k <= 16; k <<= 1)
#pragma unroll
        for (int j = k >> 1; j > 0; j >>= 1)
#pragma unroll
            for (int i = 0; i < 16; ++i) { const int l = i ^ j; if (l > i) { const bool desc = ((i & k) == 0) || (k == 16); const unsigned a = v[i], b = v[l], hi = umax_(a, b), lo = umin_(a, b); v[i] = desc ? hi : lo; v[l] = desc ? lo : hi; } }
}
DI void merge_top16(unsigned (&a)[16], const unsigned (&b)[16]) {
#pragma unroll
    for (int i = 0; i < 16; ++i) a[i] = umax_(a[i], b[15 - i]);
#pragma unroll
    for (int j = 8; j > 0; j >>= 1)
#pragma unroll
        for (int i = 0; i < 16; ++i) { const int l = i ^ j; if (l > i) { const unsigned x = a[i], y = a[l]; a[i] = umax_(x, y); a[l] = umin_(x, y); } }
}
constexpr int SK_STRIDE = 136;
constexpr int P6_KEYS = 0, P6_IB = 2 * NKEYS * SK_STRIDE * 2, P6_END = P6_IB + NWAVES * 64 * 32;
static_assert(P6_END <= RING_BYTES, "topk LDS");
DI void p6_topk(Frame& F) {
    LAS bf16* KL = (LAS bf16*)(F.lds + P6_KEYS); LAS unsigned char* IB = F.lds + P6_IB + (F.wave * 64 + F.lane) * 32;
    const int lane = F.lane, r = lane & 31, hh = lane >> 5;
    pg8::StaticOrder S; S.init(T, PQ, F.G, F.cvirt);
    pg8::Unit pu;
    for (int ui = 0; S.next(ui, pu); ++ui) {
        const int h = pu.pn, tile = pu.pm;
        __syncthreads();
        {
            const bf16* src = F.SK + (size_t)h * 2 * NKEYS * 128;
#pragma unroll
            for (int i = 0; i < 8; ++i) { const int ch = F.tid + 512 * i; const int row = ch >> 4, c8 = (ch & 15) * 8;
                *(LAS v4u*)(KL + row * SK_STRIDE + c8) = *(const GAS v4u*)(src + (size_t)row * 128 + c8); }
        }
        __syncthreads();
        const int t = tile * 256 + F.wave * 32 + r;
        unsigned S[2][16];
#pragma unroll
        for (int p = 0; p < 2; ++p) {
            bf16x8 qf[8];
            const int rt = F.wave * 32 + r, q_ai = rt >> 7, q_wr = (rt >> 6) & 1, q_m = (rt >> 4) & 3, q_fr = rt & 15;
#pragma unroll
            for (int s = 0; s < 8; ++s) qf[s] = __builtin_bit_cast(bf16x8, *(const GAS v4u*)(F.QP + pg8::frag_off(tile, h, 8, q_wr * 4 + (s >> 1), q_ai * 8 + q_m * 2 + p, (2 * (s & 1) + hh) * 16 + q_fr)));
            unsigned key[4][16];
#pragma unroll
            for (int kt = 0; kt < 4; ++kt) {
                f32x16 acc;
#pragma unroll
                for (int e = 0; e < 16; ++e) acc[e] = 0.f;
#pragma unroll
                for (int s = 0; s < 8; ++s) { const bf16x8 ka = *(const LAS bf16x8*)(KL + (p * NKEYS + 32 * kt + r) * SK_STRIDE + 16 * s + 8 * hh); acc = MFMA32(ka, qf[s], acc); }
#pragma unroll
                for (int e = 0; e < 16; ++e) { const int nk = 32 * kt + (e & 3) + 8 * (e >> 2) + 4 * hh; key[kt][e] = (f2ord(acc[e]) & ~127u) | (unsigned)(127 - nk); }
            }
#pragma unroll
            for (int kt = 0; kt < 4; ++kt) sort16_desc(key[kt]);
            merge_top16(key[0], key[1]); merge_top16(key[2], key[3]); merge_top16(key[0], key[2]);
            unsigned other[16];
#pragma unroll
            for (int i = 0; i < 16; ++i) other[i] = (unsigned)__shfl_xor((int)key[0][i], 32);
            merge_top16(key[0], other);
#pragma unroll
            for (int i = 0; i < 16; ++i) S[p][i] = key[0][i];
        }
        float s0[16], s1[16]; const float rs2 = pg8::rstd2_of(F.SSQ, t);
#pragma unroll
        for (int i = 0; i < 16; ++i) { s0[i] = ord2f(S[0][i] & ~127u) * rs2; s1[i] = ord2f(S[1][i] & ~127u) * rs2; }
        {
#pragma unroll
            for (int q4 = 0; q4 < 4; ++q4) { unsigned w0 = 0, w1 = 0;
#pragma unroll
                for (int e = 0; e < 4; ++e) { w0 |= (127u - (S[0][4 * q4 + e] & 127u)) << (8 * e); w1 |= (127u - (S[1][4 * q4 + e] & 127u)) << (8 * e); }
                *(LAS unsigned*)(IB + 4 * q4) = w0; *(LAS unsigned*)(IB + 16 + 4 * q4) = w1; }
        }
        unsigned cand[2][16];
#pragma unroll
        for (int i = 0; i < 2; ++i)
#pragma unroll
            for (int e = 0; e < 16; ++e) cand[i][e] = 0u;
        {
            int cnt = 0; float ea = 0.f, eb = 0.f; int ep = 0;
#pragma unroll
            for (int a = 0; a < 16; ++a)
#pragma unroll
                for (int b = 0; b < 16; ++b)
                    if ((a + 1) * (b + 1) <= 16) {
                        if ((cnt & 1) == 0) { ea = s0[a]; eb = s1[b]; ep = 255 - (a * 16 + b); }
                        else { const int slot = cnt >> 1; const float sa = hh ? s0[a] : ea, sb = hh ? s1[b] : eb; const int pp = hh ? 255 - (a * 16 + b) : ep;
                            cand[slot & 1][slot >> 1] = (f2ord(sa + sb) & ~255u) | (unsigned)pp; }
                        ++cnt; }
        }
        sort16_desc(cand[0]); sort16_desc(cand[1]); merge_top16(cand[0], cand[1]);
        {
            unsigned other[16];
#pragma unroll
            for (int i = 0; i < 16; ++i) other[i] = (unsigned)__shfl_xor((int)cand[0][i], 32);
            merge_top16(cand[0], other);
        }
        float gv[16]; int ev[16]; float gsum = 0.f; const float gmx = ord2f(cand[0][0] & ~255u);
#pragma unroll
        for (int i = 0; i < 16; ++i) { const unsigned k = cand[0][i]; const int pos = 255 - (int)(k & 255u); const int a = pos >> 4, b = pos & 15;
            ev[i] = (int)IB[a] * NKEYS + (int)IB[16 + b]; gv[i] = __expf(ord2f(k & ~255u) - gmx); gsum += gv[i]; }
        float ginv = 1.f / gsum;
#ifdef UNIFORM_GATES
#pragma unroll
        for (int i = 0; i < 16; ++i) gv[i] = 1.f;
        ginv = 1.f / 16.f;
#endif
        if (hh == 0) {
            unsigned short* ip = F.IDX + (size_t)t * NSEL + h * TOPK; float* gp = F.GATE + (size_t)t * NSEL + h * TOPK;
#pragma unroll
            for (int i = 0; i < 2; ++i) *(GAS v4i*)(ip + 8 * i) = (v4i){ev[8 * i] | (ev[8 * i + 1] << 16), ev[8 * i + 2] | (ev[8 * i + 3] << 16), ev[8 * i + 4] | (ev[8 * i + 5] << 16), ev[8 * i + 6] | (ev[8 * i + 7] << 16)};
#pragma unroll
            for (int i = 0; i < 4; ++i) *(GAS f32x4*)(gp + 4 * i) = (f32x4){gv[4 * i] * ginv, gv[4 * i + 1] * ginv, gv[4 * i + 2] * ginv, gv[4 * i + 3] * ginv};
        }
    }
}

typedef float f32x2_t __attribute__((ext_vector_type(2)));
DI void fp8x16_to_f32(v4u q, float (&f)[16]) {
#pragma unroll
    for (int w = 0; w < 4; ++w) { const f32x2_t lo = __builtin_amdgcn_cvt_pk_f32_fp8((int)q[w], false), hi = __builtin_amdgcn_cvt_pk_f32_fp8((int)q[w], true);
        f[4 * w + 0] = lo.x; f[4 * w + 1] = lo.y; f[4 * w + 2] = hi.x; f[4 * w + 3] = hi.y; }
}
struct XccInfo { int q, nx, nloc, rank, uni; };
DI void xcc_info_build(const XcdBarrier& b) {
    if (threadIdx.x == 0) {
        unsigned q = 0, nx = 0, nloc = 1, uni = 1; const unsigned G8 = gridDim.x / 8u;
        for (unsigned j = 0; j < 16; ++j) { const unsigned c = xb_ld(&b.bar[XB_XCNT(j)]); if (c > 0u) { if (j < b.x) ++q; ++nx; if (c != G8) uni = 0u; } if (j == b.x) nloc = c; }
        b.st[3] = q; b.st[4] = nx > 0u ? nx : 1u; b.st[5] = nloc > 0u ? nloc : 1u;
        b.st[7] = (uni && nx == 8u && (gridDim.x % 8u) == 0u && b.st[0] == G8) ? 1u : 0u;
    }
    __syncthreads();
}
DI XccInfo xcc_info(const XcdBarrier& b) {
    XccInfo I; I.rank = __builtin_amdgcn_readfirstlane((int)b.st[2]); I.q = __builtin_amdgcn_readfirstlane((int)b.st[3]); I.nx = __builtin_amdgcn_readfirstlane((int)b.st[4]); I.nloc = __builtin_amdgcn_readfirstlane((int)b.st[5]); I.uni = __builtin_amdgcn_readfirstlane((int)b.st[7]);
    return I;
}
DI float dpp_sum8(float s) {
    s += __builtin_bit_cast(float, __builtin_amdgcn_update_dpp(0, __builtin_bit_cast(int, s), 0xB1, 0xf, 0xf, false));
    s += __builtin_bit_cast(float, __builtin_amdgcn_update_dpp(0, __builtin_bit_cast(int, s), 0x4E, 0xf, 0xf, false));
    s += __builtin_bit_cast(float, __builtin_amdgcn_update_dpp(0, __builtin_bit_cast(int, s), 0x141, 0xf, 0xf, false));
    return s;
}
typedef long i64_t;
typedef long i64x2 __attribute__((ext_vector_type(2)));
typedef int v4i_t __attribute__((ext_vector_type(4)));
typedef int v8i_t __attribute__((ext_vector_type(8)));
constexpr int PEER_ROW = 144, PEER_WAVE_LDS = 128 * PEER_ROW;
constexpr int MX_ONE = 0x7f7f7f7f;
#define PEER_ID(ia_, ib_, ld_) ((((ld_) < 8 ? ia_ : ib_)[((ld_) & 7) >> 1] >> (16 * ((ld_) & 1))) & 0xffffu)
#define P7_IDS(t_, ia_, ib_) do { const unsigned short* ip_ = F.IDX + (size_t)(t_) * NSEL + 16 * row8; ia_ = *(const GAS v4u*)(ip_); ib_ = *(const GAS v4u*)(ip_ + 8); } while (0)
#define P7_ISSUE(t_, ia_, ib_, uq_, x_) do { \
        const unsigned char* xr_ = F.XB8 + (size_t)(t_) * D + sl * 256 + 16 * g;   \
        x_[0] = *(const GAS v4u*)(xr_); x_[1] = *(const GAS v4u*)(xr_ + 64); x_[2] = *(const GAS v4u*)(xr_ + 128); x_[3] = *(const GAS v4u*)(xr_ + 192); \
        _Pragma("unroll") for (int ld = 0; ld < 16; ++ld) { const unsigned e_ = PEER_ID(ia_, ib_, ld); uq_[ld] = *(const GAS v4u*)(Us + (unsigned)(e_ * 128u + 16u * c8)); } } while (0)
#define P7_COMPUTE(t_, uq_, x_) do { \
        _Pragma("unroll") for (int ld = 0; ld < 16; ++ld) *(LAS v4u*)(wl + (16 * row8 + ld) * PEER_ROW + 16 * c8) = uq_[ld]; \
        v8i_t xb0_, xb1_; \
        xb0_[0] = (int)x_[0].x; xb0_[1] = (int)x_[0].y; xb0_[2] = (int)x_[0].z; xb0_[3] = (int)x_[0].w; xb0_[4] = (int)x_[1].x; xb0_[5] = (int)x_[1].y; xb0_[6] = (int)x_[1].z; xb0_[7] = (int)x_[1].w; \
        xb1_[0] = (int)x_[2].x; xb1_[1] = (int)x_[2].y; xb1_[2] = (int)x_[2].z; xb1_[3] = (int)x_[2].w; xb1_[4] = (int)x_[3].x; xb1_[5] = (int)x_[3].y; xb1_[6] = (int)x_[3].z; xb1_[7] = (int)x_[3].w; \
        f32x4 keep = {0.f, 0.f, 0.f, 0.f}; \
        _Pragma("unroll") for (int j = 0; j < 8; ++j) { f32x4 c_ = {0.f, 0.f, 0.f, 0.f}; \
            const v4i_t a0_ = *(const LAS v4i_t*)(wl + (16 * j + m) * PEER_ROW + 16 * g), a1_ = *(const LAS v4i_t*)(wl + (16 * j + m) * PEER_ROW + 64 + 16 * g); \
            v8i_t A0_ = {a0_[0], a0_[1], a0_[2], a0_[3], 0, 0, 0, 0}, A1_ = {a1_[0], a1_[1], a1_[2], a1_[3], 0, 0, 0, 0}; \
            c_ = __builtin_amdgcn_mfma_scale_f32_16x16x128_f8f6f4(A0_, xb0_, c_, 4, 0, 0, MX_ONE, 0, MX_ONE); \
            c_ = __builtin_amdgcn_mfma_scale_f32_16x16x128_f8f6f4(A1_, xb1_, c_, 4, 0, 0, MX_ONE, 0, MX_ONE); \
            keep = (m == j) ? c_ : keep; } \
        { const bool ok_ = (m < 8) && ((t_) < T); bf16* dst_ = ok_ ? F.PARTB + ((size_t)sl * T + (t_)) * NSEL + 16 * m + 4 * g : F.PARTB + (size_t)8 * T * NSEL + 4 * lane; \
          v2u w_; w_.x = pk2(keep[0], keep[1]); w_.y = pk2(keep[2], keep[3]); *(GAS v2u*)dst_ = w_; } } while (0)
DI int peer_next(volatile LAS unsigned* ctr, int lane) { unsigned k = 0u; if (lane == 0) k = __hip_atomic_fetch_add((LAS unsigned*)ctr, 1u, __ATOMIC_RELAXED, __HIP_MEMORY_SCOPE_WORKGROUP); return __builtin_amdgcn_readfirstlane((int)k); }
DI int peer_tok(int tbase, int tstride, int k) { return tbase + (k & 7) + (k >> 3) * tstride; }
DI void p7_udot(Frame& F, const XccInfo& I) {
    const int lane = F.lane, g = lane >> 4, m = lane & 15, row8 = lane >> 3, c8 = lane & 7;
    LAS unsigned char* wl = F.lds + F.wave * PEER_WAVE_LDS;
    const unsigned char* U4 = (const unsigned char*)F.UB;
    const int tstride = I.nloc * NWAVES, tbase = I.rank * NWAVES;
    int it = 0;
    for (int share = I.q; share < 8; share += I.nx, ++it) {
        const int sl = share >> 1, half = share & 1;
        const unsigned char* Us = U4 + (size_t)sl * NEXP * 128;
        volatile LAS unsigned* ctr = F.MISC + 16 + it;
#define CL(t_) ((t_) < T ? (t_) : T - 1)
#define TOK(k_) (2 * peer_tok(tbase, tstride, (k_)) + half)
        v4u uqA[16], uqB[16]; v4u iA0, iA1, iB0, iB1;
        int kk = peer_next(ctr, lane); int tA = TOK(kk); kk = peer_next(ctr, lane); int tB = TOK(kk);
        {
            v4u xA[4], xB[4];
            P7_IDS(CL(tA), iA0, iA1);
            P7_ISSUE(CL(tA), iA0, iA1, uqA, xA);
            P7_IDS(CL(tB), iB0, iB1);
#pragma unroll 1
            while (tA < T) {
                kk = peer_next(ctr, lane); const int tC = TOK(kk); kk = peer_next(ctr, lane); const int tD = TOK(kk);
                P7_IDS(CL(tC), iA0, iA1);
                P7_ISSUE(CL(tB), iB0, iB1, uqB, xB);
                P7_COMPUTE(tA, uqA, xA);
                P7_IDS(CL(tD), iB0, iB1);
                P7_ISSUE(CL(tC), iA0, iA1, uqA, xA);
                P7_COMPUTE(tB, uqB, xB);
                tA = tC; tB = tD;
            }
        }
#undef TOK
#undef CL
    }
}
DI void p8_act(Frame& F) {
    const size_t NT_ = (size_t)F.G * NWAVES * 64;
    for (size_t item = (size_t)F.vcu * NWAVES * 64 + F.tid; item < (size_t)T * NSEL / 4; item += NT_) {
        const int t = (int)(item >> 5);
        f32x4 s = {0.f, 0.f, 0.f, 0.f}, vs4;
#pragma unroll
        for (int sl = 0; sl < 4; ++sl) { const v2u p = *(const GAS v2u*)(F.PARTB + (size_t)sl * T * NSEL + item * 4); s = s + (f32x4){bf_lo(p.x), bf_hi(p.x), bf_lo(p.y), bf_hi(p.y)}; }
        { const v2u ids = *(const GAS v2u*)(F.IDX + item * 4);
          s[0] *= F.SU[ids.x & 0xffffu]; s[1] *= F.SU[ids.x >> 16]; s[2] *= F.SU[ids.y & 0xffffu]; s[3] *= F.SU[ids.y >> 16];
          vs4 = (f32x4){F.SV[ids.x & 0xffffu], F.SV[ids.x >> 16], F.SV[ids.y & 0xffffu], F.SV[ids.y >> 16]}; }
        const float rs2 = pg8::rstd2_of(F.SSQ, t);
        const f32x4 g = *(const GAS f32x4*)(F.GATE + item * 4);
        f32x4 o;
#pragma unroll
        for (int e = 0; e < 4; ++e) { const float pre = s[e] * rs2; o[e] = 0.5f * pre * (1.f + erff(pre * 0.70710678118f)) * g[e] * vs4[e] * A_SCALE; }
        ((GAS unsigned*)F.ACT)[item] = pk4_fp8(o);
    }
}
typedef int v2i_t __attribute__((ext_vector_type(2)));
#define P9_IDS(t_, ia_, ib_, ak_, xr_) do { { const unsigned short* ip_ = F.IDX + (size_t)(t_) * NSEL + 16 * row8; ia_ = *(const GAS v4u*)(ip_); ib_ = *(const GAS v4u*)(ip_ + 8); } \
        const unsigned char* ap_ = (const unsigned char*)F.ACT + (size_t)(t_) * NSEL + 16 * g; \
        ak_[0] = *(const GAS v4u*)(ap_); ak_[1] = *(const GAS v4u*)(ap_ + 64); \
        xr_ = *(const GAS v2u*)(F.XB + (size_t)(t_) * D + sl * 256 + 4 * lane); } while (0)
#define P9_ISSUE(ia_, ib_, vq_) do { \
        _Pragma("unroll") for (int ld = 0; ld < 16; ++ld) { const unsigned e_ = PEER_ID(ia_, ib_, ld); vq_[ld] = *(const GAS v4u*)(Vs + (unsigned)(e_ * 128u + 16u * c8)); } } while (0)
#define P9_WRITE(vq_) do { _Pragma("unroll") for (int ld = 0; ld < 16; ++ld) *(LAS v4u*)(wl + (16 * row8 + ld) * PEER_ROW + 16 * c8) = vq_[ld]; } while (0)
#define P9_MATH(t_, ak_, xr_) do { \
        const v8i_t A_ = {(int)ak_[0].x, (int)ak_[0].y, (int)ak_[0].z, (int)ak_[0].w, (int)ak_[1].x, (int)ak_[1].y, (int)ak_[1].z, (int)ak_[1].w}; \
        float keep[4] = {0.f, 0.f, 0.f, 0.f}; \
        _Pragma("unroll") for (int ct = 0; ct < 16; ++ct) { \
            const v2i_t b0_ = __builtin_amdgcn_ds_read_tr4_b64_v2i32((LAS v2i_t*)(wl + (32 * g + n16) * PEER_ROW + 8 * ct)); \
            const v2i_t b1_ = __builtin_amdgcn_ds_read_tr4_b64_v2i32((LAS v2i_t*)(wl + (32 * g + 16 + n16) * PEER_ROW + 8 * ct)); \
            const v8i_t B_ = {b0_[0], b0_[1], b1_[0], b1_[1], 0, 0, 0, 0}; f32x4 c_ = {0.f, 0.f, 0.f, 0.f}; \
            c_ = __builtin_amdgcn_mfma_scale_f32_16x16x128_f8f6f4(A_, B_, c_, 0, 4, 0, MX_ONE, 0, MX_ONE); \
            keep[ct >> 2] = (g == (ct & 3)) ? c_[0] : keep[ct >> 2]; }   \
          \
        { _Pragma("unroll") for (int q = 0; q < 4; ++q) ob[64 * q + lane] = keep[q]; \
          const f32x4 kv_ = *(const LAS f32x4*)(ob + 4 * lane); \
          const bool ok_ = (t_) < T; \
          float* op_ = ok_ ? F.out + (size_t)(t_) * D + sl * 256 + 4 * lane : (float*)F.PARTB + 4 * lane;     \
          f32x4 o_; o_[0] = bf_lo(xr_.x) + kv_[0] * (1.f / A_SCALE); o_[1] = bf_hi(xr_.x) + kv_[1] * (1.f / A_SCALE); o_[2] = bf_lo(xr_.y) + kv_[2] * (1.f / A_SCALE); o_[3] = bf_hi(xr_.y) + kv_[3] * (1.f / A_SCALE); \
          *(GAS f32x4*)op_ = o_; } } while (0)
DI void p9_vacc(Frame& F, const XccInfo& I) {
    const int lane = F.lane, g = lane >> 4, n16 = lane & 15, row8 = lane >> 3, c8 = lane & 7;
    LAS unsigned char* wl = F.lds + F.wave * PEER_WAVE_LDS;
    LAS float* ob = (LAS float*)(F.lds + P9_OUT_OFF + F.wave * 1024);
    const unsigned char* V4 = (const unsigned char*)F.VB;
    const int tstride = I.nloc * NWAVES, tfirst = I.rank * NWAVES + F.wave;
    for (int share = I.q; share < 8; share += I.nx) {
        const int sl = share >> 1, half = share & 1;
        const unsigned char* Vs = V4 + (size_t)sl * NEXP * 128;
        if (2 * tfirst + half >= T) continue;
        v4u vqA[16], vqB[16]; v4u akA[2], akB[2], akC[2]; v4u iA0, iA1, iB0, iB1; v2u xrA, xrB, xrC;
#define CL(t_) ((t_) < T ? (t_) : T - 1)
#define TK(k_) (2 * (tfirst + (k_) * tstride) + half)
#define SB __builtin_amdgcn_sched_barrier(0)
        P9_IDS(TK(0), iA0, iA1, akA, xrA);
        P9_ISSUE(iA0, iA1, vqA);
        P9_IDS(CL(TK(1)), iB0, iB1, akB, xrB);
        P9_ISSUE(iB0, iB1, vqB);
        P9_IDS(CL(TK(2)), iA0, iA1, akC, xrC);
#pragma unroll 1
        for (int k = 0; TK(k) < T; k += 2) {
            const int t = TK(k), t1 = TK(k + 1), t3 = CL(TK(k + 3)), t4 = CL(TK(k + 4));
            v4u akD[2], akE[2]; v2u xrD, xrE;
            P9_IDS(t3, iB0, iB1, akD, xrD);
            P9_WRITE(vqA); SB;
            P9_ISSUE(iA0, iA1, vqA); SB;
            P9_MATH(t, akA, xrA);
            P9_IDS(t4, iA0, iA1, akE, xrE);
            P9_WRITE(vqB); SB;
            P9_ISSUE(iB0, iB1, vqB); SB;
            P9_MATH(t1, akB, xrB);
            akA[0] = akC[0]; akA[1] = akC[1]; xrA = xrC; akB[0] = akD[0]; akB[1] = akD[1]; xrB = xrD; akC[0] = akE[0]; akC[1] = akE[1]; xrC = xrE;
        }
#undef SB
#undef TK
#undef CL
    }
}

struct Args { const float* in[17]; float* out; unsigned char* ws; int ph_lo, ph_hi, li, pad; };
__global__ void __launch_bounds__(NWAVES * 64, 2) hyb_fwd(Args args) {
    extern __shared__ __attribute__((aligned(16))) unsigned char lds[];
    Frame F;
    F.lds = (LAS unsigned char*)lds;
    F.MISC = (volatile LAS unsigned*)(F.lds + MISC_OFF);
    F.tid = threadIdx.x; F.lane = F.tid & 63; F.wave = __builtin_amdgcn_readfirstlane(F.tid >> 6);
    F.G = gridDim.x; { const int bx = blockIdx.x; F.vcu = (F.G % 8 == 0) ? (bx % 8) * (F.G / 8) + bx / 8 : bx; }
    unsigned char* ws = args.ws;
    F.ctl = (gu32*)(ws + WS_CTL);
    F.x = args.in[0]; F.norm_mix = args.in[1]; F.norm_ffn = args.in[2]; F.w_in = args.in[3]; F.b_gate = args.in[4]; F.w_conv = args.in[5]; F.q_norm = args.in[6]; F.k_norm = args.in[7];
    F.sinks = args.in[8]; F.rel_bias = args.in[9]; F.w_conv_out = args.in[10]; F.w_attn_out = args.in[11]; F.w_out = args.in[12]; F.w_query = args.in[13]; F.sub_keys = args.in[14];
    F.expert_u = args.in[15]; F.expert_v = args.in[16]; F.out = args.out;
    F.WIN = (bf16*)(ws + WS_WIN); F.WG8 = ws + WS_WG8; F.WC = (bf16*)(ws + WS_WC); F.WA = (bf16*)(ws + WS_WA); F.WO = (bf16*)(ws + WS_WO); F.WQ = (bf16*)(ws + WS_WQ); F.SK = (bf16*)(ws + WS_SK);
    F.UB = (bf16*)(ws + WS_UB); F.VB = (bf16*)(ws + WS_VB); F.XB = (bf16*)(ws + WS_XB); F.PA = (bf16*)(ws + WS_PA); F.MIX = (bf16*)(ws + WS_MIX); F.G_ = (bf16*)(ws + WS_G); F.QP = (bf16*)(ws + WS_QP);
    F.Z = (bf16*)(ws + WS_Z); F.ATT = (bf16*)(ws + WS_ATT); F.RSTD1 = (float*)(ws + WS_RSTD1); F.SSQ = (float*)(ws + WS_SSQ); F.GATE = (float*)(ws + WS_GATE); F.IDX = (unsigned short*)(ws + WS_IDX); F.PARTB = (bf16*)(ws + WS_PART); F.SU = (float*)(ws + WS_SU); F.SV = (float*)(ws + WS_SV); F.XB8 = (unsigned char*)(ws + WS_XB8); F.ACT = (float*)(ws + WS_ACT);
    for (int u = F.tid; u < (LDS_BYTES - LDSCTL_OFF) / 4; u += NWAVES * 64) ((LAS unsigned*)(F.lds + LDSCTL_OFF))[u] = 0u;
    __syncthreads();
    XcdBarrier bar; bar.bar = (unsigned*)(F.ctl + CW_BAR); bar.x = 0; bar.st = nullptr;
    const int lo = args.ph_lo, hi = args.ph_hi;
    if (hi - lo > 1) bar = xcd_barrier_post((unsigned*)(F.ctl + CW_BAR), F.MISC + 8);
#ifndef PH_MASK
#define PH_MASK 0x3ff
#endif
#define IN(k) (((PH_MASK >> (k)) & 1) && lo <= (k) && (k) < hi)
#define SEAM(k) do { if (IN(k) && IN((k) + 1)) xcd_barrier(bar); } while (0)
#ifndef PROBE_DUP
#define PROBE_DUP 0
#endif
#define REP(k) for (int rep_ = 0; rep_ < (((PROBE_DUP >> (k)) & 1) ? 2 : 1); ++rep_)

    F.xlocal = 0; F.xq = 0; F.xrank = 0; F.cvirt = (int)blockIdx.x;
    if (IN(0)) { REP(0) p0_prologue(F); SEAM(0); }
    if (hi - lo > 1 && IN(0) && IN(1)) { xcc_info_build(bar); const XccInfo I = xcc_info(bar);
        if (I.uni) { F.xlocal = 1; F.xq = I.q; F.xrank = I.rank; F.cvirt = I.q + 8 * I.rank; } }
#define SEAML(k) do { if (IN(k) && IN((k) + 1)) { if (F.xlocal) xcd_local_barrier(bar); else xcd_barrier(bar); } } while (0)
    if (IN(1)) {
        pg8::Gemm g{F.XB, F.WIN, nullptr, nullptr, T, N16, D}; pg8::StaticOrder S; S.init(T, N16, F.G, F.cvirt);
        pg8::Gemm g8{(const pg8::bf16_t*)F.XB8, (const pg8::bf16_t*)F.WG8, nullptr, nullptr, T, N8, D / 2}; pg8::StaticOrder S8; S8.init(T, N8, F.G, F.cvirt);
        { LAS float* bgl = (LAS float*)(F.lds + RING_BYTES); for (int i = F.tid; i < 2 * D; i += NWAVES * 64) bgl[i] = F.b_gate[i]; __syncthreads(); }
        pg8::EpiProj E{F.PA, F.G_, (const PG8_LAS float*)(F.lds + RING_BYTES), 0, 1 << 20, 1.f}, E8{F.PA, F.G_, (const PG8_LAS float*)(F.lds + RING_BYTES), N16, 3, 1.f / WG_SCALE};
        REP(1) { pg8::gemm_phase<pg8::EpiProj, pg8::StaticOrder, PG8_ALIGN, PG8_SP2, true>(F.lds + RING_OFF, g8, S8, E8);
                 pg8::gemm_phase<pg8::EpiProj, pg8::StaticOrder, PG8_ALIGN, PG8_SP2>(F.lds + RING_OFF, g, S, E); }
        {
            const int nwg = (T / 256) * (N8 / 256), rem = nwg % F.G, c = (int)blockIdx.x; const int nshort = rem ? F.G - rem : F.G, sidx = rem ? c - rem : c;
            (void)sidx; (void)nshort;
            constexpr int CH = 64, NCH = 2 * NEXP / CH;
            for (;;) {
                if (F.tid == 0) F.MISC[14] = __hip_atomic_fetch_add((unsigned*)(F.ctl + 2048), 1u, __ATOMIC_RELAXED, __HIP_MEMORY_SCOPE_AGENT);
                __syncthreads();
                const int ch = __builtin_amdgcn_readfirstlane((int)F.MISC[14]);
                __syncthreads();
                if (ch >= NCH) break;
                if (ch < NCH / 2) p0_convert_fp4(F, F.expert_u, F.norm_ffn, (unsigned char*)F.UB, F.SU, ch * CH, ch * CH + CH);
                else p0_convert_fp4(F, F.expert_v, nullptr, (unsigned char*)F.VB, F.SV, (ch - NCH / 2) * CH, (ch - NCH / 2) * CH + CH);
            } }
        SEAML(1);
    }
    if (IN(2)) {
        REP(2) { p2_conv(F); p2_attention(F); }
        SEAML(2); }
    if (IN(3)) {
        pg8::Gemm g{F.Z, F.WC, F.ATT, F.WA, T, D, CONV}; pg8::PairOrder S; S.init(T, D, F.G, F.cvirt);
        pg8::EpiMix E{F.MIX, F.G_};
        REP(3) pg8::gemm_phase<pg8::EpiMix, pg8::PairOrder, PG8_ALIGN, PG8_SP2>(F.lds + RING_OFF, g, S, E);
        SEAML(3);
    }
    if (IN(4)) {
        pg8::Gemm g{F.MIX, F.WO, nullptr, nullptr, T, D, D}; pg8::FragOrder S; S.init(T, D, F.G, F.cvirt);
        pg8::EpiX1 E{F.RSTD1, F.XB, F.SSQ, F.XB8};
        REP(4) pg8::gemm_phase<pg8::EpiX1, pg8::FragOrder, PG8_ALIGN, PG8_SP2>(F.lds + RING_OFF, g, S, E);
        SEAML(4);
    }
    if (IN(5)) {
        pg8::Gemm g{F.XB, F.WQ, nullptr, nullptr, T, PQ, D}; pg8::StaticOrder S; S.init(T, PQ, F.G, F.cvirt);
        pg8::EpiQP E{F.QP};
        REP(5) pg8::gemm_phase<pg8::EpiQP, pg8::StaticOrder, PG8_ALIGN, PG8_SP2>(F.lds + RING_OFF, g, S, E);
    }
    if (IN(6)) { REP(6) p6_topk(F); SEAM(6); }
    if (IN(7)) { if (!(hi - lo > 1 && IN(0) && IN(1))) xcc_info_build(bar); const XccInfo I = xcc_info(bar); REP(7) p7_udot(F, I); SEAM(7); }
    if (IN(8)) { REP(8) p8_act(F); SEAM(8); }
    if (IN(9)) { const XccInfo I = xcc_info(bar); p9_vacc(F, I); }
#undef IN
#undef SEAM
#undef SEAML
}

extern "C" void kernel_launch(void* const* d_in, const int* in_sizes, int n_in, void* d_out, int out_size, void* d_ws, size_t ws_size, hipStream_t stream) {
    static int grid = 0;
    if (grid == 0) {
        if (n_in != 17 || in_sizes[0] != T * D || out_size != T * D || ws_size < WS_END) { fprintf(stderr, "kernel_launch: unexpected shapes (n_in %d, in0 %d, out %d, ws %zu)\n", n_in, n_in > 0 ? in_sizes[0] : -1, out_size, ws_size); grid = -1; return; }
        int dev = 0, cus = 0, per_cu = 0;
        if (hipGetDevice(&dev) != hipSuccess || hipDeviceGetAttribute(&cus, hipDeviceAttributeMultiprocessorCount, dev) != hipSuccess) { grid = -1; return; }
        if (hipFuncSetAttribute((const void*)hyb_fwd, hipFuncAttributeMaxDynamicSharedMemorySize, LDS_BYTES) != hipSuccess) { fprintf(stderr, "kernel_launch: hipFuncSetAttribute failed\n"); grid = -1; return; }
        if (hipOccupancyMaxActiveBlocksPerMultiprocessor(&per_cu, (const void*)hyb_fwd, NWAVES * 64, LDS_BYTES) != hipSuccess || per_cu < 1) { fprintf(stderr, "kernel_launch: occupancy query says %d blocks per CU\n", per_cu); (void)hipGetLastError(); grid = -1; return; }
        grid = cus * 1;
    }
    if (grid < 0) return;
    if (hipMemsetAsync((char*)d_ws + WS_CTL, 0, CTL_ZERO_BYTES, stream) != hipSuccess) { fprintf(stderr, "kernel_launch: memset failed\n"); return; }
    Args a{};
    for (int i = 0; i < 17; ++i) a.in[i] = (const float*)d_in[i];
    a.out = (float*)d_out; a.ws = (unsigned char*)d_ws;
#if MK_ONE_LAUNCH
    a.ph_lo = 0; a.ph_hi = N_PHASES; a.li = 0;
    void* kargs[] = {&a};
    const hipError_t le = hipLaunchCooperativeKernel((const void*)hyb_fwd, dim3(grid), dim3(NWAVES * 64), kargs, LDS_BYTES, stream);
    if (le != hipSuccess) fprintf(stderr, "kernel_launch: cooperative launch failed: %s (grid %d)\n", hipGetErrorName(le), grid);
#else
    for (int li = 0; li < N_PHASES; ++li) {
        a.ph_lo = li; a.ph_hi = li + 1; a.li = li;
        hipLaunchKernelGGL(hyb_fwd, dim3(grid), dim3(NWAVES * 64), LDS_BYTES, stream, a);
        const hipError_t le = hipPeekAtLastError();
        if (le != hipSuccess) { fprintf(stderr, "kernel_launch: launch %d failed: %s\n", li, hipGetErrorName(le)); break; }
    }
#endif
}
```

```cpp
#include <hip/hip_runtime.h>
#include <hip/hip_cooperative_groups.h>
#include <cstdio>
#include <cstdint>
namespace pg8 {
#define PG8_LAS __attribute__((address_space(3)))
typedef unsigned short bf16_t;
typedef short bf16x8 __attribute__((ext_vector_type(8)));
typedef float f32x4 __attribute__((ext_vector_type(4)));
typedef unsigned u32x4 __attribute__((ext_vector_type(4)));
typedef unsigned u32x2 __attribute__((ext_vector_type(2)));
constexpr int BM = 256, BK = 64, HALF = 128, HTB = HALF * BK * 2  , STAGE_BYTES = 8 * HTB, NXCD = 8, WGM = 8;

__host__ __device__ __forceinline__ int lds_byte(int r, int c) { const int st = (r >> 4) * 2 + (c >> 5), rr = r & 15, cc = c & 31, ob = rr * 64 + cc * 2; return st * 1024 + (ob ^ (((ob >> 9) & 1) << 5)); }
__host__ __device__ __forceinline__ void stage_rc(int b, int& R, int& C) { const int st = b / 1024, sb = b % 1024, swz = sb ^ (((sb >> 9) & 1) << 5); R = (st >> 1) * 16 + swz / 64; C = (st & 1) * 32 + (swz % 64) / 2; }
__host__ __device__ __forceinline__ int perm32(int rho) { const int n = rho >> 4, i = rho & 15; return 8 * (i >> 2) + 4 * n + (i & 3); }

struct Unit { int pm, pn, which; };
struct Gemm { const bf16_t* A; const bf16_t* Bt; const bf16_t* A2; const bf16_t* Bt2; int M, N, K; };

struct StaticOrder {
    static constexpr bool AFRAG = false;
    int nM, nN, nwg, G, c;
    __host__ __device__ void init(int M, int N, int G_, int c_) { nM = M / BM; nN = N / BM; nwg = nM * nN; G = G_; c = c_; }
    __host__ __device__ bool next(int i, Unit& u) const {
        const long L = (long)i * G + c; if (L >= nwg) return false;
        int wgid = (int)L; { const int q = nwg / NXCD, r = nwg % NXCD, xcd = wgid % NXCD, off = wgid / NXCD; wgid = (xcd < r ? xcd * (q + 1) : r * (q + 1) + (xcd - r) * q) + off; }
        const int nig = WGM * nN, gid = wgid / nig, fm = gid * WGM, gsz = (nM - fm) < WGM ? (nM - fm) : WGM;
        u.pm = fm + ((wgid % nig) % gsz); u.pn = (wgid % nig) / gsz; u.which = 0; return true;
    }
    __device__ __forceinline__ const char* a_base(const Gemm& g, const Unit& u, size_t tstep) const { return (const char*)g.A + (size_t)u.pm * tstep; }
    __device__ __forceinline__ const char* b_base(const Gemm& g, const Unit& u, size_t tstep) const { return (const char*)g.Bt + (size_t)u.pn * tstep; }
    __device__ __forceinline__ void a_ready(const Unit&) const {}
    __device__ __forceinline__ void done(const Unit&) const {}
};

__device__ __forceinline__ unsigned cvt_pk_bf16(float lo, float hi) { unsigned r; asm volatile("v_cvt_pk_bf16_f32 %0, %1, %2" : "=v"(r) : "v"(lo), "v"(hi)); return r; }
__device__ __forceinline__ void store16_wt(void* p, u32x4 v) { asm volatile("global_store_dwordx4 %0, %1, off sc1\n\ts_nop 1" :: "v"(p), "v"(v) : "memory"); }
__device__ __forceinline__ void store8_wt(void* p, u32x2 v) { asm volatile("global_store_dwordx2 %0, %1, off sc1\n\ts_nop 1" :: "v"(p), "v"(v) : "memory"); }
typedef float f32x2 __attribute__((ext_vector_type(2)));
__device__ __forceinline__ f32x2 gelu_pk(f32x2 v) {
    const f32x2 av = __builtin_elementwise_abs(v), d = av * 0.2316418882f + 1.0f;
    f32x2 t; t.x = __builtin_amdgcn_rcpf(d.x); t.y = __builtin_amdgcn_rcpf(d.y);
    f32x2 q = t * 0.5307027145f + (-0.7265760135f); q = q * t + 0.7107068705f; q = q * t + (-0.142248368f); q = q * t + 0.127414796f; q = q * t;
    const f32x2 s = (v * v) * (-0.72134752044f);
    f32x2 e; e.x = __builtin_amdgcn_exp2f(s.x); e.y = __builtin_amdgcn_exp2f(s.y);
    const f32x2 m = v * (q * e), r = v - m;
    f32x2 o; o.x = v.x < 0.f ? m.x : r.x; o.y = v.y < 0.f ? m.y : r.y; return o;
}

template <class Epi, class Sched, bool ALIGN_EPI = false, bool SP2 = false, bool FP8 = false>
__device__ __forceinline__ void gemm_phase(PG8_LAS unsigned char* lds, const Gemm g, const Sched& S, const Epi& E) {
    const int tid = threadIdx.x, wid = __builtin_amdgcn_readfirstlane(tid >> 6), lane = tid & 63, wr = wid >> 2, wc = wid & 3, fr = lane & 15, fq = lane >> 4;
    const int K = g.K, nt = K / BK;
    unsigned voffA[2], voffB[2];
#pragma unroll
    for (int i = 0; i < 2; ++i) { int R, C; stage_rc(tid * 16 + i * 8192, R, C); const int Rb = Epi::PERM ? ((R & ~31) + perm32(R & 31)) : R;
        voffA[i] = Sched::AFRAG ? (unsigned)((((((R >> 6) * 4 + (C >> 5)) * 16 + ((R >> 4) & 3) * 2) * 64) + ((C & 31) >> 3) * 16 + (R & 15)) * 16) : (unsigned)(R * K + C) * 2u;
        voffB[i] = (unsigned)(Rb * K + C) * 2u; }
#define PG8_AP(base, h, kt) (Sched::AFRAG ? (base) + ((((size_t)((kt) >> 2) * 8 + ((kt) & 1) * 2) * 16 + (h) * 8 + (((kt) >> 1) & 1)) * 64) * 16 : (base) + (size_t)(h) * hstep + (size_t)(kt) * kstep)
    const size_t kstep = (size_t)(BK * 2);
    const size_t hstep = (size_t)HALF * K * 2;
    const size_t tstep = 2 * hstep;
    const unsigned ldsw = (unsigned)wid * 1024u;
    const int aoff = lds_byte(wr * 64 + fr, fq * 8), boff = lds_byte(wc * 32 + fr, fq * 8);
#define PG8_SA(b, h) (((b) * 2 + (h)) * HTB)
#define PG8_SB(b, h) ((4 + (b) * 2 + (h)) * HTB)
#define PG8_STAGE(bufoff, gbase, voff) do { _Pragma("unroll") for (int _i = 0; _i < 2; ++_i) \
        __builtin_amdgcn_global_load_lds((const unsigned*)((const char*)(gbase) + (voff)[_i]), (PG8_LAS unsigned*)(lds + (bufoff) + ldsw + _i * 8192), 16, 0, 0); } while (0)
#define PG8_LDA(dst, b, h) do { _Pragma("unroll") for (int m = 0; m < 4; ++m) dst[m] = __builtin_shufflevector(*(const PG8_LAS bf16x8*)(lds + PG8_SA(b, h) + aoff + m * 2048), *(const PG8_LAS bf16x8*)(lds + PG8_SA(b, h) + aoff + m * 2048 + 1024), 0, 1, 2, 3, 4, 5, 6, 7, 8, 9, 10, 11, 12, 13, 14, 15); } while (0)
#define PG8_LDB(dst, b, h) do { _Pragma("unroll") for (int n = 0; n < 2; ++n) dst[n] = __builtin_shufflevector(*(const PG8_LAS bf16x8*)(lds + PG8_SB(b, h) + boff + n * 2048), *(const PG8_LAS bf16x8*)(lds + PG8_SB(b, h) + boff + n * 2048 + 1024), 0, 1, 2, 3, 4, 5, 6, 7, 8, 9, 10, 11, 12, 13, 14, 15); } while (0)
#define PG8_MMA(ai, bj, At, Bt) do { __builtin_amdgcn_s_setprio(1); _Pragma("unroll") for (int m = 0; m < 4; ++m) _Pragma("unroll") for (int n = 0; n < 2; ++n) { \
        if constexpr (FP8) { typedef int v8i_ __attribute__((ext_vector_type(8)));   \
            asm volatile("v_mfma_scale_f32_16x16x128_f8f6f4 %0, %1, %2, %0, %3, %3 op_sel_hi:[0,0,0]" : "+v"(acc[ai][bj][m][n]) : "v"(__builtin_bit_cast(v8i_, Bt[n])), "v"(__builtin_bit_cast(v8i_, At[m])), "v"(mx_one)); \
        } else { \
            acc[ai][bj][m][n] = __builtin_amdgcn_mfma_f32_16x16x32_bf16(__builtin_shufflevector(Bt[n], Bt[n], 0, 1, 2, 3, 4, 5, 6, 7), __builtin_shufflevector(At[m], At[m], 0, 1, 2, 3, 4, 5, 6, 7), acc[ai][bj][m][n], 0, 0, 0); \
            acc[ai][bj][m][n] = __builtin_amdgcn_mfma_f32_16x16x32_bf16(__builtin_shufflevector(Bt[n], Bt[n], 8, 9, 10, 11, 12, 13, 14, 15), __builtin_shufflevector(At[m], At[m], 8, 9, 10, 11, 12, 13, 14, 15), acc[ai][bj][m][n], 0, 0, 0); } } \
        __builtin_amdgcn_s_setprio(0); } while (0)
#define PG8_WAIT_V(n) asm volatile("s_waitcnt vmcnt(" #n ")" ::: "memory")
#define PG8_WAIT_L(n) asm volatile("s_waitcnt lgkmcnt(" #n ")" ::: "memory")
#define PG8_BAR __builtin_amdgcn_s_barrier()
#define PG8_SCHED __builtin_amdgcn_sched_barrier(0)
    Unit cur, nxt; int ui = 0;
    if (!S.next(0, cur)) return;
    f32x4 acc[2][2][4][2];
#pragma unroll
    for (int a = 0; a < 2; ++a)
#pragma unroll
        for (int b = 0; b < 2; ++b)
#pragma unroll
            for (int m = 0; m < 4; ++m)
#pragma unroll
                for (int n = 0; n < 2; ++n) acc[a][b][m][n] = (f32x4){0.f, 0.f, 0.f, 0.f};
    if constexpr (Epi::HAS_INIT) E.init(acc, cur, wr, wc, fr, fq);
    const int mx_one = 0x7f7f7f7f;
    typedef short bf16x16 __attribute__((ext_vector_type(16)));
    bf16x16 At[4], B0[2], B1[2];
    const char* cA = S.a_base(g, cur, tstep); const char* cB = S.b_base(g, cur, tstep);
    S.a_ready(cur);
    if constexpr (SP2) {
        PG8_STAGE(PG8_SB(0, 0), cB, voffB); PG8_STAGE(PG8_SB(0, 1), cB + hstep, voffB); PG8_STAGE(PG8_SA(0, 0), PG8_AP(cA, 0, 0), voffA); PG8_STAGE(PG8_SA(0, 1), PG8_AP(cA, 1, 0), voffA);
        if (wr == 1) PG8_BAR;
        PG8_WAIT_V(2); PG8_BAR;
        PG8_STAGE(PG8_SB(1, 0), cB + kstep, voffB); PG8_STAGE(PG8_SA(1, 0), PG8_AP(cA, 0, 1), voffA); PG8_STAGE(PG8_SB(1, 1), cB + hstep + kstep, voffB);
        PG8_WAIT_V(6); PG8_BAR;
    } else {
        PG8_STAGE(PG8_SB(0, 0), cB, voffB); PG8_STAGE(PG8_SA(0, 0), PG8_AP(cA, 0, 0), voffA); PG8_STAGE(PG8_SB(0, 1), cB + hstep, voffB); PG8_STAGE(PG8_SA(0, 1), PG8_AP(cA, 1, 0), voffA);
        if (wr == 1) PG8_BAR;
        PG8_WAIT_V(4); PG8_BAR;
        PG8_STAGE(PG8_SB(1, 0), cB + kstep, voffB); PG8_STAGE(PG8_SA(1, 0), PG8_AP(cA, 0, 1), voffA); PG8_STAGE(PG8_SB(1, 1), cB + hstep + kstep, voffB);
        PG8_WAIT_V(6); PG8_BAR;
    }
    for (;;) {
        const bool has_next = S.next(ui + 1, nxt);
        const char* nA = has_next ? S.a_base(g, nxt, tstep) : cA; const char* nB = has_next ? S.b_base(g, nxt, tstep) : cB;
        for (int t = 0; t < nt; t += 2) {
            const bool last = (t == nt - 2);
            const char* a2b = last ? nA : cA; const int a2k = last ? 0 : t + 2; const char* b2 = last ? nB : cB + (size_t)(t + 2) * kstep;
            const char* b3 = b2 + kstep;
            const char* a1h = PG8_AP(cA, 1, t + 1); const char* a2 = PG8_AP(a2b, 0, a2k); const char* a2h = PG8_AP(a2b, 1, a2k); const char* a3 = PG8_AP(a2b, 0, a2k + 1);
            if (last && has_next) S.a_ready(nxt);
            if constexpr (SP2) {
            PG8_LDB(B0, 0, 0); PG8_LDB(B1, 0, 1); PG8_SCHED; PG8_LDA(At, 0, 0); PG8_STAGE(PG8_SA(1, 1), a1h, voffA);
            PG8_WAIT_V(8); PG8_WAIT_L(0); PG8_BAR; PG8_MMA(0, 0, At, B0); PG8_MMA(0, 1, At, B1); PG8_BAR; PG8_SCHED;
            PG8_LDA(At, 0, 1); PG8_STAGE(PG8_SB(0, 0), b2, voffB); PG8_STAGE(PG8_SB(0, 1), b2 + hstep, voffB); PG8_STAGE(PG8_SA(0, 0), a2, voffA);
            PG8_WAIT_V(8); PG8_WAIT_L(0); PG8_BAR; PG8_MMA(1, 0, At, B0); PG8_MMA(1, 1, At, B1); PG8_BAR; PG8_SCHED;
            PG8_LDB(B0, 1, 0); PG8_LDB(B1, 1, 1); PG8_SCHED; PG8_LDA(At, 1, 0); PG8_STAGE(PG8_SA(0, 1), a2h, voffA);
            PG8_WAIT_V(8); PG8_WAIT_L(0); PG8_BAR; PG8_MMA(0, 0, At, B0); PG8_MMA(0, 1, At, B1); PG8_BAR; PG8_SCHED;
            PG8_LDA(At, 1, 1); PG8_STAGE(PG8_SB(1, 0), b3, voffB); PG8_STAGE(PG8_SB(1, 1), b3 + hstep, voffB); PG8_STAGE(PG8_SA(1, 0), a3, voffA);
            PG8_WAIT_V(8); PG8_WAIT_L(0); PG8_BAR; PG8_MMA(1, 0, At, B0); PG8_MMA(1, 1, At, B1); PG8_BAR; PG8_SCHED;
            } else {
            PG8_LDB(B0, 0, 0); PG8_SCHED; PG8_LDA(At, 0, 0); PG8_STAGE(PG8_SA(1, 1), a1h, voffA);
            PG8_WAIT_L(8); PG8_BAR; PG8_WAIT_L(0); PG8_MMA(0, 0, At, B0); PG8_BAR; PG8_SCHED;
            PG8_LDB(B1, 0, 1); PG8_STAGE(PG8_SB(0, 0), b2, voffB);
            PG8_BAR; PG8_WAIT_L(0); PG8_MMA(0, 1, At, B1); PG8_BAR;
            PG8_LDA(At, 0, 1); PG8_STAGE(PG8_SA(0, 0), a2, voffA);
            PG8_BAR; PG8_WAIT_L(0); PG8_MMA(1, 0, At, B0); PG8_BAR; PG8_SCHED;
            PG8_STAGE(PG8_SB(0, 1), b2 + hstep, voffB);
            PG8_WAIT_V(6); PG8_BAR; PG8_MMA(1, 1, At, B1); PG8_BAR;
            PG8_LDB(B0, 1, 0); PG8_SCHED; PG8_LDA(At, 1, 0); PG8_STAGE(PG8_SA(0, 1), a2h, voffA);
            PG8_WAIT_L(8); PG8_BAR; PG8_WAIT_L(0); PG8_MMA(0, 0, At, B0); PG8_BAR; PG8_SCHED;
            PG8_LDB(B1, 1, 1); PG8_STAGE(PG8_SB(1, 0), b3, voffB);
            PG8_BAR; PG8_WAIT_L(0); PG8_MMA(0, 1, At, B1); PG8_BAR;
            PG8_LDA(At, 1, 1); PG8_STAGE(PG8_SA(1, 0), a3, voffA);
            PG8_BAR; PG8_WAIT_L(0); PG8_MMA(1, 0, At, B0); PG8_BAR; PG8_SCHED;
            PG8_STAGE(PG8_SB(1, 1), b3 + hstep, voffB);
            PG8_WAIT_V(6); PG8_BAR; PG8_MMA(1, 1, At, B1); PG8_BAR;
            }
        }
        if constexpr (ALIGN_EPI) { if (wr == 0) PG8_BAR; }
        if constexpr (!Epi::AFTER_DRAIN) { E(acc, cur, wr, wc, fr, fq); S.done(cur); }
        if (!has_next) break;
        if (!(Epi::CARRY && cur.which == 0)) {
#pragma unroll
        for (int a = 0; a < 2; ++a)
#pragma unroll
            for (int b = 0; b < 2; ++b)
#pragma unroll
                for (int m = 0; m < 4; ++m)
#pragma unroll
                    for (int n = 0; n < 2; ++n) acc[a][b][m][n] = (f32x4){0.f, 0.f, 0.f, 0.f};
        }
        if constexpr (Epi::HAS_INIT) E.init(acc, nxt, wr, wc, fr, fq);
        cur = nxt; cA = nA; cB = nB; ++ui;
        if constexpr (ALIGN_EPI) { if (wr == 1) PG8_BAR; }
    }
    PG8_WAIT_V(0);
    if constexpr (!ALIGN_EPI) { if (wr == 0) PG8_BAR; }
    PG8_BAR;
    if constexpr (Epi::AFTER_DRAIN) { E.fused(acc, cur, wr, wc, fr, fq, lds, wid, lane); S.done(cur); }
#undef PG8_AP
#undef PG8_SA
#undef PG8_SB
#undef PG8_STAGE
#undef PG8_LDA
#undef PG8_LDB
#undef PG8_MMA
#undef PG8_WAIT_V
#undef PG8_WAIT_L
#undef PG8_BAR
#undef PG8_SCHED
}
}

#ifndef PG8_SP2
#define PG8_SP2 true
#endif
#ifndef PG8_ALIGN
#define PG8_ALIGN true
#endif
#ifndef MK_ONE_LAUNCH
#define MK_ONE_LAUNCH 1
#endif

constexpr int NWAVES = 8;
constexpr int T = 32768, D = 1024, SEQ = 4096;
constexpr int IN_DIM = 4352, PA_W = 2304, G_W = 2048;
constexpr int N16 = 1536, N8 = IN_DIM - N16;
constexpr int C_U = 0, C_B = 512, C_C = 1024, C_Q = 1536, C_K = 2048, C_V = 2176;
constexpr int CONV = 512, HD = 64, NH = 8, NKV = 2;
constexpr int PH = 8, NKEYS = 128, PQ = 2048, TOPK = 16, NEXP = 16384, NSEL = 128;
constexpr float EPS = 1e-6f;
constexpr int N_PHASES = 10;

constexpr size_t MiB = 1u << 20;
constexpr size_t WS_CTL = 0, CTL_ZERO_BYTES = 1 * MiB;
constexpr size_t WS_WIN = 2 * MiB;
constexpr size_t WS_WG8 = WS_WIN + 3072 * 1024;
constexpr size_t WS_WC = 11 * MiB;
constexpr size_t WS_WA = 12 * MiB;
constexpr size_t WS_WO = 13 * MiB;
constexpr size_t WS_WQ = 15 * MiB;
constexpr size_t WS_SK = 19 * MiB;
constexpr size_t WS_RSTD1 = 20 * MiB;
constexpr size_t WS_SSQ = 21 * MiB;
constexpr size_t WS_UB = 24 * MiB;
constexpr size_t WS_SU = 32 * MiB;
constexpr size_t WS_VB = 40 * MiB;
constexpr size_t WS_SV = 48 * MiB;
constexpr size_t WS_XB8 = 56 * MiB;
constexpr size_t WS_XB = 88 * MiB;
constexpr size_t WS_PA = 152 * MiB;
constexpr size_t WS_MIX = WS_PA;
constexpr size_t WS_G = 296 * MiB;
constexpr size_t WS_QP = WS_G;
constexpr size_t WS_Z = 424 * MiB;
constexpr size_t WS_ATT = 456 * MiB;
constexpr size_t WS_IDX = WS_Z, WS_GATE = WS_ATT;
constexpr size_t WS_PART = WS_PA;
constexpr size_t WS_ACT = WS_G;
constexpr size_t WS_END = 488 * MiB;
constexpr int CW_BAR = 4096;

constexpr int RING_OFF = 0, RING_BYTES = 131072;
constexpr int LDSCTL_OFF = 147456, MISC_OFF = LDSCTL_OFF + 320;
constexpr int P9_OUT_OFF = 148480;
constexpr int LDS_BYTES = 156672;
#define GAS __attribute__((address_space(1)))
#define LAS __attribute__((address_space(3)))
typedef unsigned short bf16;
typedef unsigned v4u __attribute__((ext_vector_type(4)));
typedef float f32x4 __attribute__((ext_vector_type(4)));
typedef short bf16x8 __attribute__((ext_vector_type(8)));
typedef GAS unsigned gu32;
typedef GAS unsigned long long gu64;
#define RLX_AGENT __ATOMIC_RELAXED, __HIP_MEMORY_SCOPE_AGENT
#define LDS_WAIT() asm volatile("s_waitcnt lgkmcnt(0)" ::: "memory")
#define VM_WAIT() asm volatile("s_waitcnt vmcnt(0)" ::: "memory")
__device__ __forceinline__ unsigned long long rt() { return __builtin_amdgcn_s_memrealtime(); }
__device__ __forceinline__ unsigned f2bf(float f) { unsigned u = __builtin_bit_cast(unsigned, f); return (u + 0x7fffu + ((u >> 16) & 1u)) >> 16; }
__device__ __forceinline__ unsigned pk2(float lo, float hi) { return f2bf(lo) | (f2bf(hi) << 16); }

#define XB_TMO      128
#define XB_XCNT(j)  (256  + 64 * (j))
#define XB_XSUB(j)  (1280 + 64 * (j))
#define XB_XGEN(j)  (2304 + 64 * (j))
#define XB_TOP      3328
#define XB_TOPGEN   3392
#define XCD_BAR_WORDS 3456
#define XB_LSUB(j)  (3456 + 64 * (j))
#define XB_LGEN(j)  (4480 + 64 * (j))
#define XB_SPIN_CAP (1u << 18)

__device__ __forceinline__ unsigned xb_ld(unsigned* p)              { return __hip_atomic_load(p, __ATOMIC_RELAXED, __HIP_MEMORY_SCOPE_AGENT); }
__device__ __forceinline__ unsigned xb_add(unsigned* p, unsigned v) { return __hip_atomic_fetch_add(p, v, __ATOMIC_RELAXED, __HIP_MEMORY_SCOPE_AGENT); }
__device__ __forceinline__ unsigned xb_xcc_id() { return (unsigned)__builtin_amdgcn_s_getreg((3 << 11) | 20) & 0xFu; }
#define XB_SPIN(cond, bar) do { unsigned _sp = 0; while (cond) { __builtin_amdgcn_s_sleep(1); \
    if ((++_sp & 255u) == 0u) { if (xb_ld(&(bar)[XB_TMO])) break; if (_sp > XB_SPIN_CAP) { atomicAdd(&(bar)[XB_TMO], 1u); break; } } } } while (0)

struct XcdBarrier {
    unsigned* bar; unsigned x;
    volatile LAS unsigned* st;
};

__device__ __forceinline__ XcdBarrier xcd_barrier_post(unsigned* bar, volatile LAS unsigned* st) {
    XcdBarrier b; b.bar = bar; b.x = xb_xcc_id(); b.st = st;
    if (threadIdx.x == 0) st[2] = xb_add(&bar[XB_XCNT(b.x)], 1u);
    return b;
}
__device__ __forceinline__ void xcd_barrier_complete(unsigned* bar, unsigned x, unsigned& nloc, unsigned& nx) {
    const unsigned G = gridDim.x * gridDim.y * gridDim.z;
    unsigned sum, cnt, mine, sp = 0u;
    for (;;) {
        sum = 0u; cnt = 0u; mine = 0u;
#pragma unroll
        for (unsigned j = 0; j < 16; ++j) { const unsigned c = xb_ld(&bar[XB_XCNT(j)]); sum += c; cnt += (c > 0u) ? 1u : 0u; mine = (j == x) ? c : mine; }
        if (sum == G) break;
        __builtin_amdgcn_s_sleep(1);
        if ((++sp & 255u) == 0u) { if (xb_ld(&bar[XB_TMO])) break; if (sp > XB_SPIN_CAP) { atomicAdd(&bar[XB_TMO], 1u); break; } }
    }
    nloc = mine > 0u ? mine : 1u; nx = cnt > 0u ? cnt : 1u;
}

__device__ __forceinline__ void xcd_barrier(const XcdBarrier& b) {
    asm volatile("s_waitcnt vmcnt(0)" ::: "memory");
    __syncthreads();
    if (threadIdx.x == 0) {
        unsigned* bar = b.bar;
        __builtin_amdgcn_s_waitcnt(0);
        unsigned nloc = b.st[0], nx = b.st[1];
        if (nloc == 0u) { xcd_barrier_complete(bar, b.x, nloc, nx); b.st[0] = nloc; b.st[1] = nx; }
        const unsigned old = xb_add(&bar[XB_XSUB(b.x)], 1u);
        const unsigned gen = old / nloc;
        if (old + 1u == (gen + 1u) * nloc) {
            __builtin_amdgcn_fence(__ATOMIC_RELEASE, "agent");
            asm volatile("s_waitcnt vmcnt(0)" ::: "memory");
            const unsigned og = xb_add(&bar[XB_TOP], 1u);
            const unsigned tg = og / nx;
            if (og + 1u == (tg + 1u) * nx) xb_add(&bar[XB_TOPGEN], 1u);
            else XB_SPIN(xb_ld(&bar[XB_TOPGEN]) == tg, bar);
            __builtin_amdgcn_fence(__ATOMIC_ACQUIRE, "agent");
            xb_add(&bar[XB_XGEN(b.x)], 1u);
            asm volatile("s_waitcnt vmcnt(0)" ::: "memory");
        } else {
            XB_SPIN(xb_ld(&bar[XB_XGEN(b.x)]) == gen, bar);
            __builtin_amdgcn_fence(__ATOMIC_ACQUIRE, "agent");
            asm volatile("s_waitcnt vmcnt(0)" ::: "memory");
        }
    }
    __syncthreads();
}

__device__ __forceinline__ void xcd_local_barrier(const XcdBarrier& b) {
    asm volatile("s_waitcnt vmcnt(0)" ::: "memory");
    __syncthreads();
    if (threadIdx.x == 0) {
        unsigned* bar = b.bar;
        __builtin_amdgcn_s_waitcnt(0);
        const unsigned nloc = b.st[0];
        const unsigned old = xb_add(&bar[XB_LSUB(b.x)], 1u);
        const unsigned gen = old / nloc;
        if (old + 1u == (gen + 1u) * nloc) xb_add(&bar[XB_LGEN(b.x)], 1u);
        else XB_SPIN(xb_ld(&bar[XB_LGEN(b.x)]) == gen, bar);
        __builtin_amdgcn_fence(__ATOMIC_ACQUIRE, "agent");
        asm volatile("s_waitcnt vmcnt(0)" ::: "memory");
    }
    __syncthreads();
}

typedef float f32x16 __attribute__((ext_vector_type(16)));
typedef unsigned v2u __attribute__((ext_vector_type(2)));
typedef int v4i __attribute__((ext_vector_type(4)));
typedef __bf16 bf2_t __attribute__((ext_vector_type(2)));
#define DI __device__ __forceinline__
struct Frame {
    LAS unsigned char* lds;
    volatile LAS unsigned* MISC;
    gu32* ctl;
    int tid, lane, wave, vcu, G;
    int xlocal, xq, xrank, cvirt;
    const float *x, *norm_mix, *norm_ffn, *w_in, *b_gate, *w_conv, *q_norm, *k_norm, *sinks, *rel_bias, *w_conv_out, *w_attn_out, *w_out, *w_query, *sub_keys, *expert_u, *expert_v;
    float* out;
    unsigned char* WG8; bf16 *WIN, *WC, *WA, *WO, *WQ, *SK, *UB, *VB, *XB, *PA, *MIX, *G_, *QP, *Z, *ATT;
    float *RSTD1, *SSQ, *GATE, *ACT, *SU, *SV; bf16* PARTB; unsigned char* XB8; unsigned short* IDX;
};
DI float wave_sum(float v) {
#pragma unroll
    for (int o = 1; o < 64; o <<= 1) v += __shfl_xor(v, o);
    return v;
}
DI float bf_lo(unsigned u) { return __builtin_bit_cast(float, u << 16); }
DI float bf_hi(unsigned u) { return __builtin_bit_cast(float, u & 0xffff0000u); }

constexpr float WG_SCALE = 32.f;
DI void p0_transpose_item(const float* W, int K, int N, bf16* WT, const float* gsc, LAS float* scr, int item, int lane, int n8 = 1 << 30, unsigned char* W8 = nullptr) {
    const int nblk = N / 32, kb = item / nblk, nb = item % nblk, k0 = 64 * kb, n0 = 32 * nb;
    float wv[32];
#pragma unroll
    for (int i = 0; i < 32; ++i) wv[i] = W[(size_t)(k0 + 2 * i + (lane >> 5)) * N + n0 + (lane & 31)];
#pragma unroll
    for (int i = 0; i < 32; ++i) { const int kk = 2 * i + (lane >> 5); float v = wv[i]; if (gsc) v *= gsc[k0 + kk]; scr[kk * 33 + (lane & 31)] = v; }
    LDS_WAIT(); asm volatile("" ::: "memory");
    const int c = lane & 7;
#pragma unroll
    for (int j = 0; j < 4; ++j) { const int n = (lane >> 3) + 8 * j; const LAS float* s = scr + (8 * c) * 33 + n;
        if (n0 >= n8) {
            int p0_ = 0, p1_ = 0;
            p0_ = __builtin_amdgcn_cvt_pk_fp8_f32(s[0 * 33] * WG_SCALE, s[1 * 33] * WG_SCALE, p0_, false); p0_ = __builtin_amdgcn_cvt_pk_fp8_f32(s[2 * 33] * WG_SCALE, s[3 * 33] * WG_SCALE, p0_, true);
            p1_ = __builtin_amdgcn_cvt_pk_fp8_f32(s[4 * 33] * WG_SCALE, s[5 * 33] * WG_SCALE, p1_, false); p1_ = __builtin_amdgcn_cvt_pk_fp8_f32(s[6 * 33] * WG_SCALE, s[7 * 33] * WG_SCALE, p1_, true);
            v2u o8; o8.x = (unsigned)p0_; o8.y = (unsigned)p1_; *(GAS v2u*)(W8 + (size_t)(n0 + n - n8) * K + k0 + 8 * c) = o8; continue; }
        v4u o; o.x = pk2(s[0 * 33], s[1 * 33]); o.y = pk2(s[2 * 33], s[3 * 33]); o.z = pk2(s[4 * 33], s[5 * 33]); o.w = pk2(s[6 * 33], s[7 * 33]);
        *(GAS v4u*)(WT + (size_t)(n0 + n) * K + k0 + 8 * c) = o; }
    LDS_WAIT(); asm volatile("" ::: "memory");
}
DI void p0_convert(Frame& F, const float* src, bf16* dst, size_t n, const float* colscale) {
    const size_t n8 = n / 8, stride = (size_t)F.G * NWAVES * 64;
    for (size_t i = (size_t)F.vcu * NWAVES * 64 + F.tid; i < n8; i += stride) {
        f32x4 a = *(const GAS f32x4*)(src + i * 8), b = *(const GAS f32x4*)(src + i * 8 + 4);
        if (colscale) { const int c = (int)((i * 8) & 1023); const f32x4 s0 = *(const GAS f32x4*)(colscale + c), s1 = *(const GAS f32x4*)(colscale + c + 4); a = a * s0; b = b * s1; }
        v4u o; o.x = pk2(a.x, a.y); o.y = pk2(a.z, a.w); o.z = pk2(b.x, b.y); o.w = pk2(b.z, b.w);
        *(GAS v4u*)(dst + i * 8) = o;
    }
}
constexpr float A_SCALE = 128.f;
DI unsigned pk4_fp8(f32x4 v) { int r = 0; r = __builtin_amdgcn_cvt_pk_fp8_f32(v[0], v[1], r, false); r = __builtin_amdgcn_cvt_pk_fp8_f32(v[2], v[3], r, true); return (unsigned)r; }
DI void p0_convert_fp8(Frame& F, const float* src, unsigned char* dst, size_t n, const float* colscale, float scale, int bidx, int nblk) {
    const int gw = bidx * NWAVES + F.wave, NGW = nblk * NWAVES, lane = F.lane;
    f32x4 cs[4];
#pragma unroll
    for (int q = 0; q < 4; ++q) cs[q] = colscale ? *(const GAS f32x4*)(colscale + 4 * lane + 256 * q) * scale : (f32x4){scale, scale, scale, scale};
    const int nrows = (int)(n / D);
    for (int e = gw; e < nrows; e += NGW) {
        const GAS f32x4* rp = (const GAS f32x4*)(src + (size_t)e * D) + lane;
        f32x4 v[4];
#pragma unroll
        for (int q = 0; q < 4; ++q) v[q] = rp[64 * q];
#pragma unroll
        for (int q = 0; q < 4; ++q) *(GAS unsigned*)(dst + ((size_t)(2 * q + (lane >> 5)) * NEXP + e) * 128 + ((4 * lane) & 127)) = pk4_fp8(v[q] * cs[q]);
    }
}
DI void p0_convert_fp4(Frame& F, const float* src, const float* gain, unsigned char* dst, float* scl, int e0, int e1) {
    const int gw = F.wave, NGW = NWAVES, lane = F.lane;
    f32x4 cs[4];
#pragma unroll
    for (int q = 0; q < 4; ++q) cs[q] = gain ? *(const GAS f32x4*)(gain + 4 * lane + 256 * q) : (f32x4){1.f, 1.f, 1.f, 1.f};
    for (int e = e0 + gw; e < e1; e += NGW) {
        const GAS f32x4* rp = (const GAS f32x4*)(src + (size_t)e * D) + lane;
        f32x4 v[4]; float mx = 0.f;
#pragma unroll
        for (int q = 0; q < 4; ++q) { v[q] = rp[64 * q] * cs[q]; mx = fmaxf(mx, fmaxf(fmaxf(fabsf(v[q][0]), fabsf(v[q][1])), fmaxf(fabsf(v[q][2]), fabsf(v[q][3])))); }
#pragma unroll
        for (int o = 1; o < 64; o <<= 1) mx = fmaxf(mx, __shfl_xor(mx, o));
        const float inv = mx > 0.f ? 6.f / mx : 0.f;
        if (lane == 0) scl[e] = mx * (1.f / 6.f);
#pragma unroll
        for (int q = 0; q < 4; ++q) { unsigned r = 0u;
            r = __builtin_amdgcn_cvt_scalef32_pk_fp4_f32(r, v[q][0] * inv, v[q][1] * inv, 1.0f, 0);
            r = __builtin_amdgcn_cvt_scalef32_pk_fp4_f32(r, v[q][2] * inv, v[q][3] * inv, 1.0f, 1);
            *(GAS unsigned short*)(dst + ((size_t)q * NEXP + e) * 128 + 2 * lane) = (unsigned short)r; }
    }
}
template <int RB> DI void p0_rows(Frame& F, const float* xrow, bf16* orow, float* rms_out, unsigned char* o8row) {
    f32x4 v[RB][4]; float s[RB];
#pragma unroll
    for (int r = 0; r < RB; ++r) { const GAS f32x4* xr = (const GAS f32x4*)(xrow + (size_t)r * D) + F.lane;
#pragma unroll
        for (int j = 0; j < 4; ++j) v[r][j] = xr[64 * j]; }
#pragma unroll
    for (int r = 0; r < RB; ++r) { s[r] = 0.f;
#pragma unroll
        for (int j = 0; j < 4; ++j) s[r] += (v[r][j].x * v[r][j].x + v[r][j].y * v[r][j].y) + (v[r][j].z * v[r][j].z + v[r][j].w * v[r][j].w); }
#pragma unroll
    for (int o = 1; o < 64; o <<= 1)
#pragma unroll
        for (int r = 0; r < RB; ++r) s[r] += __shfl_xor(s[r], o);
#pragma unroll
    for (int r = 0; r < RB; ++r) { const float rms = sqrtf(s[r] * (1.f / D) + EPS), rs = 1.f / rms; if (F.lane == 0) rms_out[r] = rms;
        GAS unsigned long long* o8 = (GAS unsigned long long*)(orow + (size_t)r * D) + F.lane;
#pragma unroll
        for (int j = 0; j < 4; ++j) { o8[64 * j] = (unsigned long long)pk2(v[r][j].x * rs, v[r][j].y * rs) | ((unsigned long long)pk2(v[r][j].z * rs, v[r][j].w * rs) << 32);
            *(GAS unsigned*)(o8row + (size_t)r * D + 4 * F.lane + 256 * j) = pk4_fp8(v[r][j] * rs); } }
}
DI void p0_prologue(Frame& F) {
    LAS float* scr = (LAS float*)(F.lds + RING_OFF + F.wave * 16384);
    const int gw = F.vcu * NWAVES + F.wave, NGW = F.G * NWAVES;
    constexpr int I_IN = (D / 64) * (IN_DIM / 32), I_C = (CONV / 64) * (D / 32), I_O = (D / 64) * (D / 32), I_Q = (D / 64) * (PQ / 32);
    constexpr int NITEMS = I_IN + 2 * I_C + I_O + I_Q;
    for (int it = gw; it < NITEMS; it += NGW) {
        int r = it;
        if (r < I_IN) { p0_transpose_item(F.w_in, D, IN_DIM, F.WIN, F.norm_mix, scr, r, F.lane, N16, F.WG8); continue; } r -= I_IN;
        if (r < I_C) { p0_transpose_item(F.w_conv_out, CONV, D, F.WC, nullptr, scr, r, F.lane); continue; } r -= I_C;
        if (r < I_C) { p0_transpose_item(F.w_attn_out, CONV, D, F.WA, nullptr, scr, r, F.lane); continue; } r -= I_C;
        if (r < I_O) { p0_transpose_item(F.w_out, D, D, F.WO, nullptr, scr, r, F.lane); continue; } r -= I_O;
        p0_transpose_item(F.w_query, D, PQ, F.WQ, F.norm_ffn, scr, r, F.lane);
    }
    p0_convert(F, F.sub_keys, F.SK, (size_t)PH * 2 * NKEYS * 128, nullptr);
    for (int m = 4 * gw; m < T; m += 4 * NGW) p0_rows<4>(F, F.x + (size_t)m * D, F.XB + (size_t)m * D, F.RSTD1 + m, F.XB8 + (size_t)m * D);
}

namespace pg8 {
DI float sigmoidf_(float v) { return __builtin_amdgcn_rcpf(1.f + __expf(-v)); }
DI size_t frag_off(int pm, int pn, int NT, int wave, int q, int lane) { return (((((size_t)pm * NT + pn) * 8 + wave) * 16 + q) * 64 + lane) * 8; }
struct EpiProj {
    static constexpr bool PERM = true, AFTER_DRAIN = false, HAS_INIT = false, CARRY = false;
    bf16_t* PA; bf16_t* G; const PG8_LAS float* bgl; int pa_col0, pn_gate0; float gsc;
    DI void operator()(const f32x4 (&acc)[2][2][4][2], const Unit& u, int wr, int wc, int fr, int fq) const {
        const int row0 = u.pm * BM + wr * 64 + fr; const bool gate = u.pn >= pn_gate0;
        const int col0 = (gate ? (u.pn - pn_gate0) * BM : pa_col0 + u.pn * BM) + wc * 32 + 8 * fq;
        if (!gate) {
#pragma unroll
            for (int ai = 0; ai < 2; ++ai)
#pragma unroll
                for (int m = 0; m < 4; ++m) { bf16_t* rowp = PA + (size_t)(row0 + ai * HALF + m * 16) * PA_W + col0;
#pragma unroll
                    for (int bj = 0; bj < 2; ++bj) { const f32x4 v0 = acc[ai][bj][m][0] * gsc, v1 = acc[ai][bj][m][1] * gsc;
                        u32x4 w; w.x = cvt_pk_bf16(v0[0], v0[1]); w.y = cvt_pk_bf16(v0[2], v0[3]); w.z = cvt_pk_bf16(v1[0], v1[1]); w.w = cvt_pk_bf16(v1[2], v1[3]);
                        store16_wt(rowp + bj * HALF, w); } }
        } else {
            f32x4 bv[2][2];
#pragma unroll
            for (int bj = 0; bj < 2; ++bj)
#pragma unroll
                for (int n = 0; n < 2; ++n) bv[bj][n] = *(const PG8_LAS f32x4*)(bgl + col0 + bj * HALF + 4 * n);
#pragma unroll
            for (int ai = 0; ai < 2; ++ai)
#pragma unroll
                for (int m = 0; m < 4; ++m)
#pragma unroll
                    for (int bj = 0; bj < 2; ++bj) { f32x4 v0 = acc[ai][bj][m][0] * gsc + bv[bj][0], v1 = acc[ai][bj][m][1] * gsc + bv[bj][1];
#pragma unroll
                        for (int j = 0; j < 4; ++j) { v0[j] = fmaxf(sigmoidf_(v0[j]) * 255.f, 1.f); v1[j] = fmaxf(sigmoidf_(v1[j]) * 255.f, 1.f); }
                        unsigned g0 = 0u, g1 = 0u;
                        g0 = __builtin_amdgcn_cvt_pk_u8_f32(v0[0], 0, g0); g0 = __builtin_amdgcn_cvt_pk_u8_f32(v0[1], 1, g0); g0 = __builtin_amdgcn_cvt_pk_u8_f32(v0[2], 2, g0); g0 = __builtin_amdgcn_cvt_pk_u8_f32(v0[3], 3, g0);
                        g1 = __builtin_amdgcn_cvt_pk_u8_f32(v1[0], 0, g1); g1 = __builtin_amdgcn_cvt_pk_u8_f32(v1[1], 1, g1); g1 = __builtin_amdgcn_cvt_pk_u8_f32(v1[2], 2, g1); g1 = __builtin_amdgcn_cvt_pk_u8_f32(v1[3], 3, g1);
                        u32x2 gw; gw.x = g0; gw.y = g1;
                        *(u32x2*)((unsigned char*)G + frag_off(u.pm, u.pn - pn_gate0, 8, wr * 4 + wc, ai * 8 + m * 2 + bj, fq * 16 + fr)) = gw; }
        }
    }
};
struct EpiMix {
    static constexpr bool PERM = true, AFTER_DRAIN = false, HAS_INIT = false, CARRY = true;
    bf16_t* MIX; const bf16_t* G;
    DI void operator()(f32x4 (&acc)[2][2][4][2], const Unit& u, int wr, int wc, int fr, int fq) const {
        const int wave = wr * 4 + wc, lane = fq * 16 + fr;
        const unsigned char* gc = (const unsigned char*)G + frag_off(u.pm, u.pn, 8, wave, 0, lane); const unsigned char* ga = (const unsigned char*)G + frag_off(u.pm, u.pn + 4, 8, wave, 0, lane);
        bf16_t* mp = MIX + frag_off(u.pm, u.pn, 4, wave, 0, lane);
#pragma unroll
        for (int ai = 0; ai < 2; ++ai) {
            u32x2 gav[8], gcv[8];
#pragma unroll
            for (int q = 0; q < 8; ++q) gav[q] = *(const u32x2*)(ga + (ai * 8 + q) * 512);
            if (!u.which) {
#pragma unroll
                for (int q = 0; q < 8; ++q) gcv[q] = *(const u32x2*)(gc + (ai * 8 + q) * 512); }
#pragma unroll
            for (int m = 0; m < 4; ++m)
#pragma unroll
                for (int bj = 0; bj < 2; ++bj) { const int q = m * 2 + bj; const u32x2 a2 = gav[q];
                    float fa[8] = {(float)(a2.x & 0xffu), (float)((a2.x >> 8) & 0xffu), (float)((a2.x >> 16) & 0xffu), (float)(a2.x >> 24), (float)(a2.y & 0xffu), (float)((a2.y >> 8) & 0xffu), (float)((a2.y >> 16) & 0xffu), (float)(a2.y >> 24)};
                    if (!u.which) { const u32x2 c2 = gcv[q];
                        const float fc[8] = {(float)(c2.x & 0xffu), (float)((c2.x >> 8) & 0xffu), (float)((c2.x >> 16) & 0xffu), (float)(c2.x >> 24), (float)(c2.y & 0xffu), (float)((c2.y >> 8) & 0xffu), (float)((c2.y >> 16) & 0xffu), (float)(c2.y >> 24)};
#pragma unroll
                        for (int e = 0; e < 4; ++e) { acc[ai][bj][m][0][e] *= fc[e] * __builtin_amdgcn_rcpf(fa[e]); acc[ai][bj][m][1][e] *= fc[4 + e] * __builtin_amdgcn_rcpf(fa[4 + e]); }
                    } else { constexpr float GI = 1.f / 255.f;
                        const f32x4 v0 = acc[ai][bj][m][0], v1 = acc[ai][bj][m][1];
                        u32x4 w; w.x = cvt_pk_bf16(v0[0] * fa[0] * GI, v0[1] * fa[1] * GI); w.y = cvt_pk_bf16(v0[2] * fa[2] * GI, v0[3] * fa[3] * GI);
                        w.z = cvt_pk_bf16(v1[0] * fa[4] * GI, v1[1] * fa[5] * GI); w.w = cvt_pk_bf16(v1[2] * fa[6] * GI, v1[3] * fa[7] * GI);
                        store16_wt(mp + (ai * 8 + q) * 512, w); } }
        }
    }
};
struct FragOrder : StaticOrder { static constexpr bool AFRAG = true; };
struct PairOrder : StaticOrder {
    __device__ bool next(int i, Unit& u) const { const bool ok = StaticOrder::next(i >> 1, u); u.which = i & 1; return ok; }
    DI const char* a_base(const Gemm& g, const Unit& u, size_t tstep) const { return (const char*)(u.which ? g.A2 : g.A) + (size_t)u.pm * tstep; }
    DI const char* b_base(const Gemm& g, const Unit& u, size_t tstep) const { return (const char*)(u.which ? g.Bt2 : g.Bt) + (size_t)u.pn * tstep; }
};
struct EpiX1 {
    static constexpr bool PERM = true, AFTER_DRAIN = false, HAS_INIT = true, CARRY = false;
    const float* RMS; bf16_t* XB; float* SSQ; unsigned char* XB8;
    DI void init(f32x4 (&acc)[2][2][4][2], const Unit& u, int wr, int wc, int fr, int fq) const {
        const int row0 = u.pm * BM + wr * 64 + fr, col0 = u.pn * BM + wc * 32 + 8 * fq;
#pragma unroll
        for (int ai = 0; ai < 2; ++ai)
#pragma unroll
            for (int m = 0; m < 4; ++m)
#pragma unroll
                for (int bj = 0; bj < 2; ++bj) { const int row = row0 + ai * HALF + m * 16; const float rm = RMS[row];
                    const u32x4 xn = *(const u32x4*)(XB + (size_t)row * D + col0 + bj * HALF);
                    acc[ai][bj][m][0] = (f32x4){__builtin_bit_cast(float, xn.x << 16), __builtin_bit_cast(float, xn.x & 0xffff0000u), __builtin_bit_cast(float, xn.y << 16), __builtin_bit_cast(float, xn.y & 0xffff0000u)} * rm;
                    acc[ai][bj][m][1] = (f32x4){__builtin_bit_cast(float, xn.z << 16), __builtin_bit_cast(float, xn.z & 0xffff0000u), __builtin_bit_cast(float, xn.w << 16), __builtin_bit_cast(float, xn.w & 0xffff0000u)} * rm; }
    }
    DI void operator()(const f32x4 (&acc)[2][2][4][2], const Unit& u, int wr, int wc, int fr, int fq) const {
        const int row0 = u.pm * BM + wr * 64 + fr, col0 = u.pn * BM + wc * 32 + 8 * fq;
#pragma unroll
        for (int ai = 0; ai < 2; ++ai)
#pragma unroll
            for (int m = 0; m < 4; ++m) { const int row = row0 + ai * HALF + m * 16; float ss = 0.f;
#pragma unroll
                for (int bj = 0; bj < 2; ++bj) { const f32x4 v0 = acc[ai][bj][m][0], v1 = acc[ai][bj][m][1];
                    ss += ((v0[0] * v0[0] + v0[1] * v0[1]) + (v0[2] * v0[2] + v0[3] * v0[3])) + ((v1[0] * v1[0] + v1[1] * v1[1]) + (v1[2] * v1[2] + v1[3] * v1[3]));
                    u32x4 w; w.x = cvt_pk_bf16(v0[0], v0[1]); w.y = cvt_pk_bf16(v0[2], v0[3]); w.z = cvt_pk_bf16(v1[0], v1[1]); w.w = cvt_pk_bf16(v1[2], v1[3]);
                    store16_wt(XB + (size_t)row * D + col0 + bj * HALF, w);
                    { int p0_ = 0, p1_ = 0;
                      p0_ = __builtin_amdgcn_cvt_pk_fp8_f32(v0[0], v0[1], p0_, false); p0_ = __builtin_amdgcn_cvt_pk_fp8_f32(v0[2], v0[3], p0_, true);
                      p1_ = __builtin_amdgcn_cvt_pk_fp8_f32(v1[0], v1[1], p1_, false); p1_ = __builtin_amdgcn_cvt_pk_fp8_f32(v1[2], v1[3], p1_, true);
                      u32x2 w8; w8.x = (unsigned)p0_; w8.y = (unsigned)p1_; *(u32x2*)(XB8 + (size_t)row * D + col0 + bj * HALF) = w8; } }
                ss += __shfl_xor(ss, 16); ss += __shfl_xor(ss, 32);
                if (fq == 0) SSQ[(size_t)row * 16 + u.pn * 4 + wc] = ss; }
    }
};
DI float rstd2_of(const float* SSQ, int row) {
    const f32x4 a = *(const f32x4*)(SSQ + (size_t)row * 16), b = *(const f32x4*)(SSQ + (size_t)row * 16 + 4), c = *(const f32x4*)(SSQ + (size_t)row * 16 + 8), d = *(const f32x4*)(SSQ + (size_t)row * 16 + 12);
    const float s = ((a[0] + a[1]) + (a[2] + a[3])) + ((b[0] + b[1]) + (b[2] + b[3])) + ((c[0] + c[1]) + (c[2] + c[3])) + ((d[0] + d[1]) + (d[2] + d[3]));
    return 1.f / sqrtf(s * (1.f / D) + EPS);
}
struct EpiQP {
    static constexpr bool PERM = true, AFTER_DRAIN = false, HAS_INIT = false, CARRY = false;
    bf16_t* QP;
    DI void operator()(const f32x4 (&acc)[2][2][4][2], const Unit& u, int wr, int wc, int fr, int fq) const {
        const int row0 = u.pm * BM + wr * 64 + fr, col0 = u.pn * BM + wc * 32 + 8 * fq;
#pragma unroll
        for (int ai = 0; ai < 2; ++ai)
#pragma unroll
            for (int m = 0; m < 4; ++m) {
#pragma unroll
                for (int bj = 0; bj < 2; ++bj) { const f32x4 v0 = acc[ai][bj][m][0], v1 = acc[ai][bj][m][1];
                    u32x4 w; w.x = cvt_pk_bf16(v0[0], v0[1]); w.y = cvt_pk_bf16(v0[2], v0[3]); w.z = cvt_pk_bf16(v1[0], v1[1]); w.w = cvt_pk_bf16(v1[2], v1[3]);
                    *(u32x4*)(QP + frag_off(u.pm, u.pn, 8, wr * 4 + wc, ai * 8 + m * 2 + bj, fq * 16 + fr)) = w; } }
    }
};
}

#define MFMA32(a, b, c) __builtin_amdgcn_mfma_f32_32x32x16_bf16((a), (b), (c), 0, 0, 0)
DI void p2_conv(Frame& F) {
    constexpr int CT = 4;
    const size_t NT_ = (size_t)F.G * NWAVES * 64;
    constexpr size_t PERB = (size_t)(SEQ / CT) * 64;
    const size_t it0 = F.xlocal ? (size_t)F.xq * PERB + (size_t)F.xrank * NWAVES * 64 + F.tid : (size_t)F.vcu * NWAVES * 64 + F.tid;
    const size_t itend = F.xlocal ? (size_t)(F.xq + 1) * PERB : (size_t)(T / CT) * 64, itstep = F.xlocal ? (size_t)(F.G / 8) * NWAVES * 64 : NT_;
    for (size_t item = it0; item < itend; item += itstep) {
        const int tb = (int)(item >> 6) * CT, c0 = (int)(item & 63) * 8, tl = tb & (SEQ - 1);
        v4u cg[CT + 2], uu[CT + 2], bg[CT];
#pragma unroll
        for (int r = 0; r < CT + 2; ++r) { const bool ok = (tl + r - 2) >= 0; const bf16* rowp = F.PA + (size_t)(tb + (ok ? r - 2 : 0)) * PA_W;
            cg[r] = *(const GAS v4u*)(rowp + C_C + c0); uu[r] = *(const GAS v4u*)(rowp + C_U + c0);
            if (!ok) { cg[r] = (v4u){0u, 0u, 0u, 0u}; } }
#pragma unroll
        for (int r = 0; r < CT; ++r) bg[r] = *(const GAS v4u*)(F.PA + (size_t)(tb + r) * PA_W + C_B + c0);
        f32x4 w[3][2];
#pragma unroll
        for (int j = 0; j < 3; ++j) { w[j][0] = *(const GAS f32x4*)(F.w_conv + j * CONV + c0); w[j][1] = *(const GAS f32x4*)(F.w_conv + j * CONV + c0 + 4); }
        float h[CT + 2][8];
#pragma unroll
        for (int r = 0; r < CT + 2; ++r) { h[r][0] = bf_lo(cg[r].x) * bf_lo(uu[r].x); h[r][1] = bf_hi(cg[r].x) * bf_hi(uu[r].x); h[r][2] = bf_lo(cg[r].y) * bf_lo(uu[r].y); h[r][3] = bf_hi(cg[r].y) * bf_hi(uu[r].y);
            h[r][4] = bf_lo(cg[r].z) * bf_lo(uu[r].z); h[r][5] = bf_hi(cg[r].z) * bf_hi(uu[r].z); h[r][6] = bf_lo(cg[r].w) * bf_lo(uu[r].w); h[r][7] = bf_hi(cg[r].w) * bf_hi(uu[r].w); }
#pragma unroll
        for (int r = 0; r < CT; ++r) {
            float a[8];
#pragma unroll
            for (int e = 0; e < 8; ++e) a[e] = w[0][e >> 2][e & 3] * h[r][e] + w[1][e >> 2][e & 3] * h[r + 1][e] + w[2][e >> 2][e & 3] * h[r + 2][e];
            v4u o; o.x = pk2(a[0] * bf_lo(bg[r].x), a[1] * bf_hi(bg[r].x)); o.y = pk2(a[2] * bf_lo(bg[r].y), a[3] * bf_hi(bg[r].y));
            o.z = pk2(a[4] * bf_lo(bg[r].z), a[5] * bf_hi(bg[r].z)); o.w = pk2(a[6] * bf_lo(bg[r].w), a[7] * bf_hi(bg[r].w));
            *(GAS v4u*)(F.Z + (size_t)(tb + r) * CONV + c0) = o;
        }
    }
}
DI int t5_bucket(int d) {
    if (d < 16) return d;
    const int large = 16 + (int)(logf((float)d / 16.f) / logf(8.f) * 16.f);
    return large < 31 ? large : 31;
}
constexpr int KS_STRIDE = 72, VT_STRIDE = 264;
constexpr int ATT_KS = 0, ATT_VT = 256 * KS_STRIDE * 2, ATT_BIAS = ATT_VT + 64 * VT_STRIDE * 2, ATT_END = ATT_BIAS + 4 * 128 * 4;
static_assert(ATT_END <= RING_BYTES, "attention LDS");
DI void p2_attention(Frame& F) {
    LAS bf16* KS = (LAS bf16*)(F.lds + ATT_KS); LAS bf16* VT = (LAS bf16*)(F.lds + ATT_VT); LAS float* BIAS = (LAS float*)(F.lds + ATT_BIAS);
    const int lane = F.lane, r = lane & 31, hh = lane >> 5;
#pragma unroll 1
    for (int unit = F.xlocal ? F.xq * 32 * NKV + F.xrank : F.vcu, uend = F.xlocal ? (F.xq + 1) * 32 * NKV : 8 * 32 * NKV, ustep = F.xlocal ? F.G / 8 : F.G; unit < uend; unit += ustep) {
        const int kv = unit & 1, n = (unit >> 1) & 31, b = unit >> 6;
        const int t0 = b * SEQ + n * 128;
        __syncthreads();
        {
            const int j = F.tid >> 1, hf = F.tid & 1; const bool valid = (n > 0) || (j >= 128);
            const bf16* rowp = F.PA + (size_t)(t0 - 128 + j) * PA_W;
            v4u kq[4], vq[4];
#pragma unroll
            for (int i = 0; i < 4; ++i) { kq[i] = (v4u){0u, 0u, 0u, 0u}; vq[i] = kq[i]; }
            if (valid) {
#pragma unroll
                for (int i = 0; i < 4; ++i) { kq[i] = *(const GAS v4u*)(rowp + C_K + kv * HD + hf * 32 + i * 8); vq[i] = *(const GAS v4u*)(rowp + C_V + kv * HD + hf * 32 + i * 8); }
            }
            float kf[32]; float ss = 0.f;
#pragma unroll
            for (int i = 0; i < 4; ++i) { kf[8 * i + 0] = bf_lo(kq[i].x); kf[8 * i + 1] = bf_hi(kq[i].x); kf[8 * i + 2] = bf_lo(kq[i].y); kf[8 * i + 3] = bf_hi(kq[i].y);
                kf[8 * i + 4] = bf_lo(kq[i].z); kf[8 * i + 5] = bf_hi(kq[i].z); kf[8 * i + 6] = bf_lo(kq[i].w); kf[8 * i + 7] = bf_hi(kq[i].w); }
#pragma unroll
            for (int e = 0; e < 32; ++e) ss += kf[e] * kf[e];
            ss += __shfl_xor(ss, 1);
            const float rs = 1.f / sqrtf(ss * (1.f / HD) + EPS);
#pragma unroll
            for (int i = 0; i < 4; ++i) { const f32x4 g0 = *(const GAS f32x4*)(F.k_norm + hf * 32 + 8 * i), g1 = *(const GAS f32x4*)(F.k_norm + hf * 32 + 8 * i + 4);
                v4u o; o.x = pk2(kf[8 * i + 0] * rs * g0[0], kf[8 * i + 1] * rs * g0[1]); o.y = pk2(kf[8 * i + 2] * rs * g0[2], kf[8 * i + 3] * rs * g0[3]);
                o.z = pk2(kf[8 * i + 4] * rs * g1[0], kf[8 * i + 5] * rs * g1[1]); o.w = pk2(kf[8 * i + 6] * rs * g1[2], kf[8 * i + 7] * rs * g1[3]);
                *(LAS v4u*)(KS + j * KS_STRIDE + hf * 32 + 8 * i) = o; }
#pragma unroll
            for (int i = 0; i < 4; ++i) { const int d0 = hf * 32 + 8 * i;
                VT[(d0 + 0) * VT_STRIDE + j] = (bf16)(vq[i].x & 0xffffu); VT[(d0 + 1) * VT_STRIDE + j] = (bf16)(vq[i].x >> 16);
                VT[(d0 + 2) * VT_STRIDE + j] = (bf16)(vq[i].y & 0xffffu); VT[(d0 + 3) * VT_STRIDE + j] = (bf16)(vq[i].y >> 16);
                VT[(d0 + 4) * VT_STRIDE + j] = (bf16)(vq[i].z & 0xffffu); VT[(d0 + 5) * VT_STRIDE + j] = (bf16)(vq[i].z >> 16);
                VT[(d0 + 6) * VT_STRIDE + j] = (bf16)(vq[i].w & 0xffffu); VT[(d0 + 7) * VT_STRIDE + j] = (bf16)(vq[i].w >> 16); }
            { const int g = F.tid >> 7, dist = F.tid & 127; BIAS[F.tid] = F.rel_bias[t5_bucket(dist) * NH + kv * 4 + g]; }
        }
        __syncthreads();
#pragma unroll 1
        for (int task = F.wave; task < 16; task += NWAVES) {
            const int g = task >> 2, c = task & 3, head = kv * 4 + g, r0 = 32 * c;
            bf16x8 qf[4];
            {
                const bf16* qp = F.PA + (size_t)(t0 + r0 + r) * PA_W + C_Q + head * HD + 8 * hh;
                v4u qq[4]; float qv[32]; float ss = 0.f;
#pragma unroll
                for (int s = 0; s < 4; ++s) qq[s] = *(const GAS v4u*)(qp + 16 * s);
#pragma unroll
                for (int s = 0; s < 4; ++s) { qv[8 * s + 0] = bf_lo(qq[s].x); qv[8 * s + 1] = bf_hi(qq[s].x); qv[8 * s + 2] = bf_lo(qq[s].y); qv[8 * s + 3] = bf_hi(qq[s].y);
                    qv[8 * s + 4] = bf_lo(qq[s].z); qv[8 * s + 5] = bf_hi(qq[s].z); qv[8 * s + 6] = bf_lo(qq[s].w); qv[8 * s + 7] = bf_hi(qq[s].w); }
#pragma unroll
                for (int e = 0; e < 32; ++e) ss += qv[e] * qv[e];
                ss += __shfl_xor(ss, 32);
                const float rs = 0.125f / sqrtf(ss * (1.f / HD) + EPS);
#pragma unroll
                for (int s = 0; s < 4; ++s) { const f32x4 g0 = *(const GAS f32x4*)(F.q_norm + 16 * s + 8 * hh), g1 = *(const GAS f32x4*)(F.q_norm + 16 * s + 8 * hh + 4);
                    v4u o; o.x = pk2(qv[8 * s + 0] * rs * g0[0], qv[8 * s + 1] * rs * g0[1]); o.y = pk2(qv[8 * s + 2] * rs * g0[2], qv[8 * s + 3] * rs * g0[3]);
                    o.z = pk2(qv[8 * s + 4] * rs * g1[0], qv[8 * s + 5] * rs * g1[1]); o.w = pk2(qv[8 * s + 6] * rs * g1[2], qv[8 * s + 7] * rs * g1[3]);
                    qf[s] = __builtin_bit_cast(bf16x8, o); }
            }
            f32x16 sacc[5];
#pragma unroll
            for (int i5 = 0; i5 < 5; ++i5) {
#pragma unroll
                for (int e = 0; e < 16; ++e) sacc[i5][e] = 0.f;
                const int kt = c + i5;
#pragma unroll
                for (int s = 0; s < 4; ++s) { const bf16x8 ka = *(const LAS bf16x8*)(KS + (32 * kt + r) * KS_STRIDE + 16 * s + 8 * hh); sacc[i5] = MFMA32(ka, qf[s], sacc[i5]); }
            }
            const float sink = F.sinks[head];
            const int dbase = r - 4 * hh + 128;
            const LAS float* bl = BIAS + g * 128;
            float mx = sink;
#pragma unroll
            for (int i5 = 0; i5 < 5; ++i5) {
                const bool tile_ok = (n > 0) || (c + i5 >= 4);
#pragma unroll
                for (int e = 0; e < 16; ++e) { const int dist = dbase - 32 * i5 - ((e & 3) + 8 * (e >> 2));
                    bool valid = tile_ok; if (i5 == 0) valid = valid && (dist < 128); if (i5 == 4) valid = valid && (dist >= 0);
                    const float lg = sacc[i5][e] + bl[dist & 127];
                    sacc[i5][e] = valid ? lg : -INFINITY; mx = fmaxf(mx, sacc[i5][e]); }
                __builtin_amdgcn_sched_barrier(0);
            }
            mx = fmaxf(mx, __shfl_xor(mx, 32));
            float sum = 0.f;
#pragma unroll
            for (int i5 = 0; i5 < 5; ++i5)
#pragma unroll
                for (int e = 0; e < 16; ++e) { const float p = __expf(sacc[i5][e] - mx); sacc[i5][e] = p; sum += p; }
            sum += __shfl_xor(sum, 32);
            const float inv = 1.f / (sum + __expf(sink - mx));
            f32x16 oacc[2];
#pragma unroll
            for (int dt = 0; dt < 2; ++dt)
#pragma unroll
                for (int e = 0; e < 16; ++e) oacc[dt][e] = 0.f;
#pragma unroll
            for (int i5 = 0; i5 < 5; ++i5)
#pragma unroll
                for (int s2 = 0; s2 < 2; ++s2) {
                    v4u pp; pp.x = pk2(sacc[i5][8 * s2 + 0] * inv, sacc[i5][8 * s2 + 1] * inv); pp.y = pk2(sacc[i5][8 * s2 + 2] * inv, sacc[i5][8 * s2 + 3] * inv);
                    pp.z = pk2(sacc[i5][8 * s2 + 4] * inv, sacc[i5][8 * s2 + 5] * inv); pp.w = pk2(sacc[i5][8 * s2 + 6] * inv, sacc[i5][8 * s2 + 7] * inv);
                    const bf16x8 pb = __builtin_bit_cast(bf16x8, pp);
                    const int kb = 32 * (c + i5) + 16 * s2 + 4 * hh;
#pragma unroll
                    for (int dt = 0; dt < 2; ++dt) {
                        const v2u lo = *(const LAS v2u*)(VT + (32 * dt + r) * VT_STRIDE + kb), hi = *(const LAS v2u*)(VT + (32 * dt + r) * VT_STRIDE + kb + 8);
                        v4u va; va.x = lo.x; va.y = lo.y; va.z = hi.x; va.w = hi.y;
                        oacc[dt] = MFMA32(__builtin_bit_cast(bf16x8, va), pb, oacc[dt]);
                    }
                    __builtin_amdgcn_sched_barrier(0);
                }
            bf16* op = F.ATT + (size_t)(t0 + r0 + r) * CONV + head * HD;
#pragma unroll
            for (int dt = 0; dt < 2; ++dt)
#pragma unroll
                for (int g4 = 0; g4 < 4; ++g4) { v2u w; w.x = pk2(oacc[dt][4 * g4 + 0], oacc[dt][4 * g4 + 1]); w.y = pk2(oacc[dt][4 * g4 + 2], oacc[dt][4 * g4 + 3]);
#ifdef ZERO_ATT
                    w.x = 0u; w.y = 0u;
#endif
                    *(GAS v2u*)(op + 32 * dt + 8 * g4 + 4 * hh) = w; }
        }
    }
}

DI unsigned f2ord(float f) { const unsigned b = __builtin_bit_cast(unsigned, f); return b ^ ((b >> 31) ? 0xffffffffu : 0x80000000u); }
DI float ord2f(unsigned k) { const unsigned b = k ^ ((k >> 31) ? 0x80000000u : 0xffffffffu); return __builtin_bit_cast(float, b); }
DI unsigned umax_(unsigned a, unsigned b) { return a > b ? a : b; }
DI unsigned umin_(unsigned a, unsigned b) { return a < b ? a : b; }
DI void sort16_desc(unsigned (&v)[16]) {
#pragma unroll
    for (int k = 2; k <= 16; k <<= 1)
#pragma unroll
        for (int j = k >> 1; j > 0; j >>= 1)
#pragma unroll
            for (int i = 0; i < 16; ++i) { const int l = i ^ j; if (l > i) { const bool desc = ((i & k) == 0) || (k == 16); const unsigned a = v[i], b = v[l], hi = umax_(a, b), lo = umin_(a, b); v[i] = desc ? hi : lo; v[l] = desc ? lo : hi; } }
}
DI void merge_top16(unsigned (&a)[16], const unsigned (&b)[16]) {
#pragma unroll
    for (int i = 0; i < 16; ++i) a[i] = umax_(a[i], b[15 - i]);
#pragma unroll
    for (int j = 8; j > 0; j >>= 1)
#pragma unroll
        for (int i = 0; i < 16; ++i) { const int l = i ^ j; if (l > i) { const unsigned x = a[i], y = a[l]; a[i] = umax_(x, y); a[l] = umin_(x, y); } }
}
constexpr int SK_STRIDE = 136;
constexpr int P6_KEYS = 0, P6_IB = 2 * NKEYS * SK_STRIDE * 2, P6_END = P6_IB + NWAVES * 64 * 32;
static_assert(P6_END <= RING_BYTES, "topk LDS");
DI void p6_topk(Frame& F) {
    LAS bf16* KL = (LAS bf16*)(F.lds + P6_KEYS); LAS unsigned char* IB = F.lds + P6_IB + (F.wave * 64 + F.lane) * 32;
    const int lane = F.lane, r = lane & 31, hh = lane >> 5;
    pg8::StaticOrder S; S.init(T, PQ, F.G, F.cvirt);
    pg8::Unit pu;
    for (int ui = 0; S.next(ui, pu); ++ui) {
        const int h = pu.pn, tile = pu.pm;
        __syncthreads();
        {
            const bf16* src = F.SK + (size_t)h * 2 * NKEYS * 128;
#pragma unroll
            for (int i = 0; i < 8; ++i) { const int ch = F.tid + 512 * i; const int row = ch >> 4, c8 = (ch & 15) * 8;
                *(LAS v4u*)(KL + row * SK_STRIDE + c8) = *(const GAS v4u*)(src + (size_t)row * 128 + c8); }
        }
        __syncthreads();
        const int t = tile * 256 + F.wave * 32 + r;
        unsigned S[2][16];
#pragma unroll
        for (int p = 0; p < 2; ++p) {
            bf16x8 qf[8];
            const int rt = F.wave * 32 + r, q_ai = rt >> 7, q_wr = (rt >> 6) & 1, q_m = (rt >> 4) & 3, q_fr = rt & 15;
#pragma unroll
            for (int s = 0; s < 8; ++s) qf[s] = __builtin_bit_cast(bf16x8, *(const GAS v4u*)(F.QP + pg8::frag_off(tile, h, 8, q_wr * 4 + (s >> 1), q_ai * 8 + q_m * 2 + p, (2 * (s & 1) + hh) * 16 + q_fr)));
            unsigned key[4][16];
#pragma unroll
            for (int kt = 0; kt < 4; ++kt) {
                f32x16 acc;
#pragma unroll
                for (int e = 0; e < 16; ++e) acc[e] = 0.f;
#pragma unroll
                for (int s = 0; s < 8; ++s) { const bf16x8 ka = *(const LAS bf16x8*)(KL + (p * NKEYS + 32 * kt + r) * SK_STRIDE + 16 * s + 8 * hh); acc = MFMA32(ka, qf[s], acc); }
#pragma unroll
                for (int e = 0; e < 16; ++e) { const int nk = 32 * kt + (e & 3) + 8 * (e >> 2) + 4 * hh; key[kt][e] = (f2ord(acc[e]) & ~127u) | (unsigned)(127 - nk); }
            }
#pragma unroll
            for (int kt = 0; kt < 4; ++kt) sort16_desc(key[kt]);
            merge_top16(key[0], key[1]); merge_top16(key[2], key[3]); merge_top16(key[0], key[2]);
            unsigned other[16];
#pragma unroll
            for (int i = 0; i < 16; ++i) other[i] = (unsigned)__shfl_xor((int)key[0][i], 32);
            merge_top16(key[0], other);
#pragma unroll
            for (int i = 0; i < 16; ++i) S[p][i] = key[0][i];
        }
        float s0[16], s1[16]; const float rs2 = pg8::rstd2_of(F.SSQ, t);
#pragma unroll
        for (int i = 0; i < 16; ++i) { s0[i] = ord2f(S[0][i] & ~127u) * rs2; s1[i] = ord2f(S[1][i] & ~127u) * rs2; }
        {
#pragma unroll
            for (int q4 = 0; q4 < 4; ++q4) { unsigned w0 = 0, w1 = 0;
#pragma unroll
                for (int e = 0; e < 4; ++e) { w0 |= (127u - (S[0][4 * q4 + e] & 127u)) << (8 * e); w1 |= (127u - (S[1][4 * q4 + e] & 127u)) << (8 * e); }
                *(LAS unsigned*)(IB + 4 * q4) = w0; *(LAS unsigned*)(IB + 16 + 4 * q4) = w1; }
        }
        unsigned cand[2][16];
#pragma unroll
        for (int i = 0; i < 2; ++i)
#pragma unroll
            for (int e = 0; e < 16; ++e) cand[i][e] = 0u;
        {
            int cnt = 0; float ea = 0.f, eb = 0.f; int ep = 0;
#pragma unroll
            for (int a = 0; a < 16; ++a)
#pragma unroll
                for (int b = 0; b < 16; ++b)
                    if ((a + 1) * (b + 1) <= 16) {
                        if ((cnt & 1) == 0) { ea = s0[a]; eb = s1[b]; ep = 255 - (a * 16 + b); }
                        else { const int slot = cnt >> 1; const float sa = hh ? s0[a] : ea, sb = hh ? s1[b] : eb; const int pp = hh ? 255 - (a * 16 + b) : ep;
                            cand[slot & 1][slot >> 1] = (f2ord(sa + sb) & ~255u) | (unsigned)pp; }
                        ++cnt; }
        }
        sort16_desc(cand[0]); sort16_desc(cand[1]); merge_top16(cand[0], cand[1]);
        {
            unsigned other[16];
#pragma unroll
            for (int i = 0; i < 16; ++i) other[i] = (unsigned)__shfl_xor((int)cand[0][i], 32);
            merge_top16(cand[0], other);
        }
        float gv[16]; int ev[16]; float gsum = 0.f; const float gmx = ord2f(cand[0][0] & ~255u);
#pragma unroll
        for (int i = 0; i < 16; ++i) { const unsigned k = cand[0][i]; const int pos = 255 - (int)(k & 255u); const int a = pos >> 4, b = pos & 15;
            ev[i] = (int)IB[a] * NKEYS + (int)IB[16 + b]; gv[i] = __expf(ord2f(k & ~255u) - gmx); gsum += gv[i]; }
        float ginv = 1.f / gsum;
#ifdef UNIFORM_GATES
#pragma unroll
        for (int i = 0; i < 16; ++i) gv[i] = 1.f;
        ginv = 1.f / 16.f;
#endif
        if (hh == 0) {
            unsigned short* ip = F.IDX + (size_t)t * NSEL + h * TOPK; float* gp = F.GATE + (size_t)t * NSEL + h * TOPK;
#pragma unroll
            for (int i = 0; i < 2; ++i) *(GAS v4i*)(ip + 8 * i) = (v4i){ev[8 * i] | (ev[8 * i + 1] << 16), ev[8 * i + 2] | (ev[8 * i + 3] << 16), ev[8 * i + 4] | (ev[8 * i + 5] << 16), ev[8 * i + 6] | (ev[8 * i + 7] << 16)};
#pragma unroll
            for (int i = 0; i < 4; ++i) *(GAS f32x4*)(gp + 4 * i) = (f32x4){gv[4 * i] * ginv, gv[4 * i + 1] * ginv, gv[4 * i + 2] * ginv, gv[4 * i + 3] * ginv};
        }
    }
}

typedef float f32x2_t __attribute__((ext_vector_type(2)));
DI void fp8x16_to_f32(v4u q, float (&f)[16]) {
#pragma unroll
    for (int w = 0; w < 4; ++w) { const f32x2_t lo = __builtin_amdgcn_cvt_pk_f32_fp8((int)q[w], false), hi = __builtin_amdgcn_cvt_pk_f32_fp8((int)q[w], true);
        f[4 * w + 0] = lo.x; f[4 * w + 1] = lo.y; f[4 * w + 2] = hi.x; f[4 * w + 3] = hi.y; }
}
struct XccInfo { int q, nx, nloc, rank, uni; };
DI void xcc_info_build(const XcdBarrier& b) {
    if (threadIdx.x == 0) {
        unsigned q = 0, nx = 0, nloc = 1, uni = 1; const unsigned G8 = gridDim.x / 8u;
        for (unsigned j = 0; j < 16; ++j) { const unsigned c = xb_ld(&b.bar[XB_XCNT(j)]); if (c > 0u) { if (j < b.x) ++q; ++nx; if (c != G8) uni = 0u; } if (j == b.x) nloc = c; }
        b.st[3] = q; b.st[4] = nx > 0u ? nx : 1u; b.st[5] = nloc > 0u ? nloc : 1u;
        b.st[7] = (uni && nx == 8u && (gridDim.x % 8u) == 0u && b.st[0] == G8) ? 1u : 0u;
    }
    __syncthreads();
}
DI XccInfo xcc_info(const XcdBarrier& b) {
    XccInfo I; I.rank = __builtin_amdgcn_readfirstlane((int)b.st[2]); I.q = __builtin_amdgcn_readfirstlane((int)b.st[3]); I.nx = __builtin_amdgcn_readfirstlane((int)b.st[4]); I.nloc = __builtin_amdgcn_readfirstlane((int)b.st[5]); I.uni = __builtin_amdgcn_readfirstlane((int)b.st[7]);
    return I;
}
DI float dpp_sum8(float s) {
    s += __builtin_bit_cast(float, __builtin_amdgcn_update_dpp(0, __builtin_bit_cast(int, s), 0xB1, 0xf, 0xf, false));
    s += __builtin_bit_cast(float, __builtin_amdgcn_update_dpp(0, __builtin_bit_cast(int, s), 0x4E, 0xf, 0xf, false));
    s += __builtin_bit_cast(float, __builtin_amdgcn_update_dpp(0, __builtin_bit_cast(int, s), 0x141, 0xf, 0xf, false));
    return s;
}
typedef long i64_t;
typedef long i64x2 __attribute__((ext_vector_type(2)));
typedef int v4i_t __attribute__((ext_vector_type(4)));
typedef int v8i_t __attribute__((ext_vector_type(8)));
constexpr int PEER_ROW = 144, PEER_WAVE_LDS = 128 * PEER_ROW;
constexpr int MX_ONE = 0x7f7f7f7f;
#define PEER_ID(ia_, ib_, ld_) ((((ld_) < 8 ? ia_ : ib_)[((ld_) & 7) >> 1] >> (16 * ((ld_) & 1))) & 0xffffu)
#define P7_IDS(t_, ia_, ib_) do { const unsigned short* ip_ = F.IDX + (size_t)(t_) * NSEL + 16 * row8; ia_ = *(const GAS v4u*)(ip_); ib_ = *(const GAS v4u*)(ip_ + 8); } while (0)
#define P7_ISSUE(t_, ia_, ib_, uq_, x_) do { \
        const unsigned char* xr_ = F.XB8 + (size_t)(t_) * D + sl * 256 + 16 * g;   \
        x_[0] = *(const GAS v4u*)(xr_); x_[1] = *(const GAS v4u*)(xr_ + 64); x_[2] = *(const GAS v4u*)(xr_ + 128); x_[3] = *(const GAS v4u*)(xr_ + 192); \
        _Pragma("unroll") for (int ld = 0; ld < 16; ++ld) { const unsigned e_ = PEER_ID(ia_, ib_, ld); uq_[ld] = *(const GAS v4u*)(Us + (unsigned)(e_ * 128u + 16u * c8)); } } while (0)
#define P7_COMPUTE(t_, uq_, x_) do { \
        _Pragma("unroll") for (int ld = 0; ld < 16; ++ld) *(LAS v4u*)(wl + (16 * row8 + ld) * PEER_ROW + 16 * c8) = uq_[ld]; \
        v8i_t xb0_, xb1_; \
        xb0_[0] = (int)x_[0].x; xb0_[1] = (int)x_[0].y; xb0_[2] = (int)x_[0].z; xb0_[3] = (int)x_[0].w; xb0_[4] = (int)x_[1].x; xb0_[5] = (int)x_[1].y; xb0_[6] = (int)x_[1].z; xb0_[7] = (int)x_[1].w; \
        xb1_[0] = (int)x_[2].x; xb1_[1] = (int)x_[2].y; xb1_[2] = (int)x_[2].z; xb1_[3] = (int)x_[2].w; xb1_[4] = (int)x_[3].x; xb1_[5] = (int)x_[3].y; xb1_[6] = (int)x_[3].z; xb1_[7] = (int)x_[3].w; \
        f32x4 keep = {0.f, 0.f, 0.f, 0.f}; \
        _Pragma("unroll") for (int j = 0; j < 8; ++j) { f32x4 c_ = {0.f, 0.f, 0.f, 0.f}; \
            const v4i_t a0_ = *(const LAS v4i_t*)(wl + (16 * j + m) * PEER_ROW + 16 * g), a1_ = *(const LAS v4i_t*)(wl + (16 * j + m) * PEER_ROW + 64 + 16 * g); \
            v8i_t A0_ = {a0_[0], a0_[1], a0_[2], a0_[3], 0, 0, 0, 0}, A1_ = {a1_[0], a1_[1], a1_[2], a1_[3], 0, 0, 0, 0}; \
            c_ = __builtin_amdgcn_mfma_scale_f32_16x16x128_f8f6f4(A0_, xb0_, c_, 4, 0, 0, MX_ONE, 0, MX_ONE); \
            c_ = __builtin_amdgcn_mfma_scale_f32_16x16x128_f8f6f4(A1_, xb1_, c_, 4, 0, 0, MX_ONE, 0, MX_ONE); \
            keep = (m == j) ? c_ : keep; } \
        { const bool ok_ = (m < 8) && ((t_) < T); bf16* dst_ = ok_ ? F.PARTB + ((size_t)sl * T + (t_)) * NSEL + 16 * m + 4 * g : F.PARTB + (size_t)8 * T * NSEL + 4 * lane; \
          v2u w_; w_.x = pk2(keep[0], keep[1]); w_.y = pk2(keep[2], keep[3]); *(GAS v2u*)dst_ = w_; } } while (0)
DI int peer_next(volatile LAS unsigned* ctr, int lane) { unsigned k = 0u; if (lane == 0) k = __hip_atomic_fetch_add((LAS unsigned*)ctr, 1u, __ATOMIC_RELAXED, __HIP_MEMORY_SCOPE_WORKGROUP); return __builtin_amdgcn_readfirstlane((int)k); }
DI int peer_tok(int tbase, int tstride, int k) { return tbase + (k & 7) + (k >> 3) * tstride; }
DI void p7_udot(Frame& F, const XccInfo& I) {
    const int lane = F.lane, g = lane >> 4, m = lane & 15, row8 = lane >> 3, c8 = lane & 7;
    LAS unsigned char* wl = F.lds + F.wave * PEER_WAVE_LDS;
    const unsigned char* U4 = (const unsigned char*)F.UB;
    const int tstride = I.nloc * NWAVES, tbase = I.rank * NWAVES;
    int it = 0;
    for (int share = I.q; share < 8; share += I.nx, ++it) {
        const int sl = share >> 1, half = share & 1;
        const unsigned char* Us = U4 + (size_t)sl * NEXP * 128;
        volatile LAS unsigned* ctr = F.MISC + 16 + it;
#define CL(t_) ((t_) < T ? (t_) : T - 1)
#define TOK(k_) (2 * peer_tok(tbase, tstride, (k_)) + half)
        v4u uqA[16], uqB[16]; v4u iA0, iA1, iB0, iB1;
        int kk = peer_next(ctr, lane); int tA = TOK(kk); kk = peer_next(ctr, lane); int tB = TOK(kk);
        {
            v4u xA[4], xB[4];
            P7_IDS(CL(tA), iA0, iA1);
            P7_ISSUE(CL(tA), iA0, iA1, uqA, xA);
            P7_IDS(CL(tB), iB0, iB1);
#pragma unroll 1
            while (tA < T) {
                kk = peer_next(ctr, lane); const int tC = TOK(kk); kk = peer_next(ctr, lane); const int tD = TOK(kk);
                P7_IDS(CL(tC), iA0, iA1);
                P7_ISSUE(CL(tB), iB0, iB1, uqB, xB);
                P7_COMPUTE(tA, uqA, xA);
                P7_IDS(CL(tD), iB0, iB1);
                P7_ISSUE(CL(tC), iA0, iA1, uqA, xA);
                P7_COMPUTE(tB, uqB, xB);
                tA = tC; tB = tD;
            }
        }
#undef TOK
#undef CL
    }
}
DI void p8_act(Frame& F) {
    const size_t NT_ = (size_t)F.G * NWAVES * 64;
    for (size_t item = (size_t)F.vcu * NWAVES * 64 + F.tid; item < (size_t)T * NSEL / 4; item += NT_) {
        const int t = (int)(item >> 5);
        f32x4 s = {0.f, 0.f, 0.f, 0.f}, vs4;
#pragma unroll
        for (int sl = 0; sl < 4; ++sl) { const v2u p = *(const GAS v2u*)(F.PARTB + (size_t)sl * T * NSEL + item * 4); s = s + (f32x4){bf_lo(p.x), bf_hi(p.x), bf_lo(p.y), bf_hi(p.y)}; }
        { const v2u ids = *(const GAS v2u*)(F.IDX + item * 4);
          s[0] *= F.SU[ids.x & 0xffffu]; s[1] *= F.SU[ids.x >> 16]; s[2] *= F.SU[ids.y & 0xffffu]; s[3] *= F.SU[ids.y >> 16];
          vs4 = (f32x4){F.SV[ids.x & 0xffffu], F.SV[ids.x >> 16], F.SV[ids.y & 0xffffu], F.SV[ids.y >> 16]}; }
        const float rs2 = pg8::rstd2_of(F.SSQ, t);
        const f32x4 g = *(const GAS f32x4*)(F.GATE + item * 4);
        f32x4 o;
#pragma unroll
        for (int e = 0; e < 4; ++e) { const float pre = s[e] * rs2; o[e] = 0.5f * pre * (1.f + erff(pre * 0.70710678118f)) * g[e] * vs4[e] * A_SCALE; }
        ((GAS unsigned*)F.ACT)[item] = pk4_fp8(o);
    }
}
typedef int v2i_t __attribute__((ext_vector_type(2)));
#define P9_IDS(t_, ia_, ib_, ak_, xr_) do { { const unsigned short* ip_ = F.IDX + (size_t)(t_) * NSEL + 16 * row8; ia_ = *(const GAS v4u*)(ip_); ib_ = *(const GAS v4u*)(ip_ + 8); } \
        const unsigned char* ap_ = (const unsigned char*)F.ACT + (size_t)(t_) * NSEL + 16 * g; \
        ak_[0] = *(const GAS v4u*)(ap_); ak_[1] = *(const GAS v4u*)(ap_ + 64); \
        xr_ = *(const GAS v2u*)(F.XB + (size_t)(t_) * D + sl * 256 + 4 * lane); } while (0)
#define P9_ISSUE(ia_, ib_, vq_) do { \
        _Pragma("unroll") for (int ld = 0; ld < 16; ++ld) { const unsigned e_ = PEER_ID(ia_, ib_, ld); vq_[ld] = *(const GAS v4u*)(Vs + (unsigned)(e_ * 128u + 16u * c8)); } } while (0)
#define P9_WRITE(vq_) do { _Pragma("unroll") for (int ld = 0; ld < 16; ++ld) *(LAS v4u*)(wl + (16 * row8 + ld) * PEER_ROW + 16 * c8) = vq_[ld]; } while (0)
#define P9_MATH(t_, ak_, xr_) do { \
        const v8i_t A_ = {(int)ak_[0].x, (int)ak_[0].y, (int)ak_[0].z, (int)ak_[0].w, (int)ak_[1].x, (int)ak_[1].y, (int)ak_[1].z, (int)ak_[1].w}; \
        float keep[4] = {0.f, 0.f, 0.f, 0.f}; \
        _Pragma("unroll") for (int ct = 0; ct < 16; ++ct) { \
            const v2i_t b0_ = __builtin_amdgcn_ds_read_tr4_b64_v2i32((LAS v2i_t*)(wl + (32 * g + n16) * PEER_ROW + 8 * ct)); \
            const v2i_t b1_ = __builtin_amdgcn_ds_read_tr4_b64_v2i32((LAS v2i_t*)(wl + (32 * g + 16 + n16) * PEER_ROW + 8 * ct)); \
            const v8i_t B_ = {b0_[0], b0_[1], b1_[0], b1_[1], 0, 0, 0, 0}; f32x4 c_ = {0.f, 0.f, 0.f, 0.f}; \
            c_ = __builtin_amdgcn_mfma_scale_f32_16x16x128_f8f6f4(A_, B_, c_, 0, 4, 0, MX_ONE, 0, MX_ONE); \
            keep[ct >> 2] = (g == (ct & 3)) ? c_[0] : keep[ct >> 2]; }   \
          \
        { _Pragma("unroll") for (int q = 0; q < 4; ++q) ob[64 * q + lane] = keep[q]; \
          const f32x4 kv_ = *(const LAS f32x4*)(ob + 4 * lane); \
          const bool ok_ = (t_) < T; \
          float* op_ = ok_ ? F.out + (size_t)(t_) * D + sl * 256 + 4 * lane : (float*)F.PARTB + 4 * lane;     \
          f32x4 o_; o_[0] = bf_lo(xr_.x) + kv_[0] * (1.f / A_SCALE); o_[1] = bf_hi(xr_.x) + kv_[1] * (1.f / A_SCALE); o_[2] = bf_lo(xr_.y) + kv_[2] * (1.f / A_SCALE); o_[3] = bf_hi(xr_.y) + kv_[3] * (1.f / A_SCALE); \
          *(GAS f32x4*)op_ = o_; } } while (0)
DI void p9_vacc(Frame& F, const XccInfo& I) {
    const int lane = F.lane, g = lane >> 4, n16 = lane & 15, row8 = lane >> 3, c8 = lane & 7;
    LAS unsigned char* wl = F.lds + F.wave * PEER_WAVE_LDS;
    LAS float* ob = (LAS float*)(F.lds + P9_OUT_OFF + F.wave * 1024);
    const unsigned char* V4 = (const unsigned char*)F.VB;
    const int tstride = I.nloc * NWAVES, tfirst = I.rank * NWAVES + F.wave;
    for (int share = I.q; share < 8; share += I.nx) {
        const int sl = share >> 1, half = share & 1;
        const unsigned char* Vs = V4 + (size_t)sl * NEXP * 128;
        if (2 * tfirst + half >= T) continue;
        v4u vqA[16], vqB[16]; v4u akA[2], akB[2], akC[2]; v4u iA0, iA1, iB0, iB1; v2u xrA, xrB, xrC;
#define CL(t_) ((t_) < T ? (t_) : T - 1)
#define TK(k_) (2 * (tfirst + (k_) * tstride) + half)
#define SB __builtin_amdgcn_sched_barrier(0)
        P9_IDS(TK(0), iA0, iA1, akA, xrA);
        P9_ISSUE(iA0, iA1, vqA);
        P9_IDS(CL(TK(1)), iB0, iB1, akB, xrB);
        P9_ISSUE(iB0, iB1, vqB);
        P9_IDS(CL(TK(2)), iA0, iA1, akC, xrC);
#pragma unroll 1
        for (int k = 0; TK(k) < T; k += 2) {
            const int t = TK(k), t1 = TK(k + 1), t3 = CL(TK(k + 3)), t4 = CL(TK(k + 4));
            v4u akD[2], akE[2]; v2u xrD, xrE;
            P9_IDS(t3, iB0, iB1, akD, xrD);
            P9_WRITE(vqA); SB;
            P9_ISSUE(iA0, iA1, vqA); SB;
            P9_MATH(t, akA, xrA);
            P9_IDS(t4, iA0, iA1, akE, xrE);
            P9_WRITE(vqB); SB;
            P9_ISSUE(iB0, iB1, vqB); SB;
            P9_MATH(t1, akB, xrB);
            akA[0] = akC[0]; akA[1] = akC[1]; xrA = xrC; akB[0] = akD[0]; akB[1] = akD[1]; xrB = xrD; akC[0] = akE[0]; akC[1] = akE[1]; xrC = xrE;
        }
#undef SB
#undef TK
#undef CL
    }
}

struct Args { const float* in[17]; float* out; unsigned char* ws; int ph_lo, ph_hi, li, pad; };
__global__ void __launch_bounds__(NWAVES * 64, 2) hyb_fwd(Args args) {
    extern __shared__ __attribute__((aligned(16))) unsigned char lds[];
    Frame F;
    F.lds = (LAS unsigned char*)lds;
    F.MISC = (volatile LAS unsigned*)(F.lds + MISC_OFF);
    F.tid = threadIdx.x; F.lane = F.tid & 63; F.wave = __builtin_amdgcn_readfirstlane(F.tid >> 6);
    F.G = gridDim.x; { const int bx = blockIdx.x; F.vcu = (F.G % 8 == 0) ? (bx % 8) * (F.G / 8) + bx / 8 : bx; }
    unsigned char* ws = args.ws;
    F.ctl = (gu32*)(ws + WS_CTL);
    F.x = args.in[0]; F.norm_mix = args.in[1]; F.norm_ffn = args.in[2]; F.w_in = args.in[3]; F.b_gate = args.in[4]; F.w_conv = args.in[5]; F.q_norm = args.in[6]; F.k_norm = args.in[7];
    F.sinks = args.in[8]; F.rel_bias = args.in[9]; F.w_conv_out = args.in[10]; F.w_attn_out = args.in[11]; F.w_out = args.in[12]; F.w_query = args.in[13]; F.sub_keys = args.in[14];
    F.expert_u = args.in[15]; F.expert_v = args.in[16]; F.out = args.out;
    F.WIN = (bf16*)(ws + WS_WIN); F.WG8 = ws + WS_WG8; F.WC = (bf16*)(ws + WS_WC); F.WA = (bf16*)(ws + WS_WA); F.WO = (bf16*)(ws + WS_WO); F.WQ = (bf16*)(ws + WS_WQ); F.SK = (bf16*)(ws + WS_SK);
    F.UB = (bf16*)(ws + WS_UB); F.VB = (bf16*)(ws + WS_VB); F.XB = (bf16*)(ws + WS_XB); F.PA = (bf16*)(ws + WS_PA); F.MIX = (bf16*)(ws + WS_MIX); F.G_ = (bf16*)(ws + WS_G); F.QP = (bf16*)(ws + WS_QP);
    F.Z = (bf16*)(ws + WS_Z); F.ATT = (bf16*)(ws + WS_ATT); F.RSTD1 = (float*)(ws + WS_RSTD1); F.SSQ = (float*)(ws + WS_SSQ); F.GATE = (float*)(ws + WS_GATE); F.IDX = (unsigned short*)(ws + WS_IDX); F.PARTB = (bf16*)(ws + WS_PART); F.SU = (float*)(ws + WS_SU); F.SV = (float*)(ws + WS_SV); F.XB8 = (unsigned char*)(ws + WS_XB8); F.ACT = (float*)(ws + WS_ACT);
    for (int u = F.tid; u < (LDS_BYTES - LDSCTL_OFF) / 4; u += NWAVES * 64) ((LAS unsigned*)(F.lds + LDSCTL_OFF))[u] = 0u;
    __syncthreads();
    XcdBarrier bar; bar.bar = (unsigned*)(F.ctl + CW_BAR); bar.x = 0; bar.st = nullptr;
    const int lo = args.ph_lo, hi = args.ph_hi;
    if (hi - lo > 1) bar = xcd_barrier_post((unsigned*)(F.ctl + CW_BAR), F.MISC + 8);
#ifndef PH_MASK
#define PH_MASK 0x3ff
#endif
#define IN(k) (((PH_MASK >> (k)) & 1) && lo <= (k) && (k) < hi)
#define SEAM(k) do { if (IN(k) && IN((k) + 1)) xcd_barrier(bar); } while (0)
#ifndef PROBE_DUP
#define PROBE_DUP 0
#endif
#define REP(k) for (int rep_ = 0; rep_ < (((PROBE_DUP >> (k)) & 1) ? 2 : 1); ++rep_)

    F.xlocal = 0; F.xq = 0; F.xrank = 0; F.cvirt = (int)blockIdx.x;
    if (IN(0)) { REP(0) p0_prologue(F); SEAM(0); }
    if (hi - lo > 1 && IN(0) && IN(1)) { xcc_info_build(bar); const XccInfo I = xcc_info(bar);
        if (I.uni) { F.xlocal = 1; F.xq = I.q; F.xrank = I.rank; F.cvirt = I.q + 8 * I.rank; } }
#define SEAML(k) do { if (IN(k) && IN((k) + 1)) { if (F.xlocal) xcd_local_barrier(bar); else xcd_barrier(bar); } } while (0)
    if (IN(1)) {
        pg8::Gemm g{F.XB, F.WIN, nullptr, nullptr, T, N16, D}; pg8::StaticOrder S; S.init(T, N16, F.G, F.cvirt);
        pg8::Gemm g8{(const pg8::bf16_t*)F.XB8, (const pg8::bf16_t*)F.WG8, nullptr, nullptr, T, N8, D / 2}; pg8::StaticOrder S8; S8.init(T, N8, F.G, F.cvirt);
        { LAS float* bgl = (LAS float*)(F.lds + RING_BYTES); for (int i = F.tid; i < 2 * D; i += NWAVES * 64) bgl[i] = F.b_gate[i]; __syncthreads(); }
        pg8::EpiProj E{F.PA, F.G_, (const PG8_LAS float*)(F.lds + RING_BYTES), 0, 1 << 20, 1.f}, E8{F.PA, F.G_, (const PG8_LAS float*)(F.lds + RING_BYTES), N16, 3, 1.f / WG_SCALE};
        REP(1) { pg8::gemm_phase<pg8::EpiProj, pg8::StaticOrder, PG8_ALIGN, PG8_SP2, true>(F.lds + RING_OFF, g8, S8, E8);
                 pg8::gemm_phase<pg8::EpiProj, pg8::StaticOrder, PG8_ALIGN, PG8_SP2>(F.lds + RING_OFF, g, S, E); }
        {
            const int nwg = (T / 256) * (N8 / 256), rem = nwg % F.G, c = (int)blockIdx.x; const int nshort = rem ? F.G - rem : F.G, sidx = rem ? c - rem : c;
            (void)sidx; (void)nshort;
            constexpr int CH = 64, NCH = 2 * NEXP / CH;
            for (;;) {
                if (F.tid == 0) F.MISC[14] = __hip_atomic_fetch_add((unsigned*)(F.ctl + 2048), 1u, __ATOMIC_RELAXED, __HIP_MEMORY_SCOPE_AGENT);
                __syncthreads();
                const int ch = __builtin_amdgcn_readfirstlane((int)F.MISC[14]);
                __syncthreads();
                if (ch >= NCH) break;
                if (ch < NCH / 2) p0_convert_fp4(F, F.expert_u, F.norm_ffn, (unsigned char*)F.UB, F.SU, ch * CH, ch * CH + CH);
                else p0_convert_fp4(F, F.expert_v, nullptr, (unsigned char*)F.VB, F.SV, (ch - NCH / 2) * CH, (ch - NCH / 2) * CH + CH);
            } }
        SEAML(1);
    }
    if (IN(2)) {
        REP(2) { p2_conv(F); p2_attention(F); }
        SEAML(2); }
    if (IN(3)) {
        pg8::Gemm g{F.Z, F.WC, F.ATT, F.WA, T, D, CONV}; pg8::PairOrder S; S.init(T, D, F.G, F.cvirt);
        pg8::EpiMix E{F.MIX, F.G_};
        REP(3) pg8::gemm_phase<pg8::EpiMix, pg8::PairOrder, PG8_ALIGN, PG8_SP2>(F.lds + RING_OFF, g, S, E);
        SEAML(3);
    }
    if (IN(4)) {
        pg8::Gemm g{F.MIX, F.WO, nullptr, nullptr, T, D, D}; pg8::FragOrder S; S.init(T, D, F.G, F.cvirt);
        pg8::EpiX1 E{F.RSTD1, F.XB, F.SSQ, F.XB8};
        REP(4) pg8::gemm_phase<pg8::EpiX1, pg8::FragOrder, PG8_ALIGN, PG8_SP2>(F.lds + RING_OFF, g, S, E);
        SEAML(4);
    }
    if (IN(5)) {
        pg8::Gemm g{F.XB, F.WQ, nullptr, nullptr, T, PQ, D}; pg8::StaticOrder S; S.init(T, PQ, F.G, F.cvirt);
        pg8::EpiQP E{F.QP};
        REP(5) pg8::gemm_phase<pg8::EpiQP, pg8::StaticOrder, PG8_ALIGN, PG8_SP2>(F.lds + RING_OFF, g, S, E);
    }
    if (IN(6)) { REP(6) p6_topk(F); SEAM(6); }
    if (IN(7)) { if (!(hi - lo > 1 && IN(0) && IN(1))) xcc_info_build(bar); const XccInfo I = xcc_info(bar); REP(7) p7_udot(F, I); SEAM(7); }
    if (IN(8)) { REP(8) p8_act(F); SEAM(8); }
    if (IN(9)) { const XccInfo I = xcc_info(bar); p9_vacc(F, I); }
#undef IN
#undef SEAM
#undef SEAML
}

extern "C" void kernel_launch(void* const* d_in, const int* in_sizes, int n_in, void* d_out, int out_size, void* d_ws, size_t ws_size, hipStream_t stream) {
    static int grid = 0;
    if (grid == 0) {
        if (n_in != 17 || in_sizes[0] != T * D || out_size != T * D || ws_size < WS_END) { fprintf(stderr, "kernel_launch: unexpected shapes (n_in %d, in0 %d, out %d, ws %zu)\n", n_in, n_in > 0 ? in_sizes[0] : -1, out_size, ws_size); grid = -1; return; }
        int dev = 0, cus = 0, per_cu = 0;
        if (hipGetDevice(&dev) != hipSuccess || hipDeviceGetAttribute(&cus, hipDeviceAttributeMultiprocessorCount, dev) != hipSuccess) { grid = -1; return; }
        if (hipFuncSetAttribute((const void*)hyb_fwd, hipFuncAttributeMaxDynamicSharedMemorySize, LDS_BYTES) != hipSuccess) { fprintf(stderr, "kernel_launch: hipFuncSetAttribute failed\n"); grid = -1; return; }
        if (hipOccupancyMaxActiveBlocksPerMultiprocessor(&per_cu, (const void*)hyb_fwd, NWAVES * 64, LDS_BYTES) != hipSuccess || per_cu < 1) { fprintf(stderr, "kernel_launch: occupancy query says %d blocks per CU\n", per_cu); (void)hipGetLastError(); grid = -1; return; }
        grid = cus * 1;
    }
    if (grid < 0) return;
    if (hipMemsetAsync((char*)d_ws + WS_CTL, 0, CTL_ZERO_BYTES, stream) != hipSuccess) { fprintf(stderr, "kernel_launch: memset failed\n"); return; }
    Args a{};
    for (int i = 0; i < 17; ++i) a.in[i] = (const float*)d_in[i];
    a.out = (float*)d_out; a.ws = (unsigned char*)d_ws;
#if MK_ONE_LAUNCH
    a.ph_lo = 0; a.ph_hi = N_PHASES; a.li = 0;
    void* kargs[] = {&a};
    const hipError_t le = hipLaunchCooperativeKernel((const void*)hyb_fwd, dim3(grid), dim3(NWAVES * 64), kargs, LDS_BYTES, stream);
    if (le != hipSuccess) fprintf(stderr, "kernel_launch: cooperative launch failed: %s (grid %d)\n", hipGetErrorName(le), grid);
#else
    for (int li = 0; li < N_PHASES; ++li) {
        a.ph_lo = li; a.ph_hi = li + 1; a.li = li;
        hipLaunchKernelGGL(hyb_fwd, dim3(grid), dim3(NWAVES * 64), LDS_BYTES, stream, a);
        const hipError_t le = hipPeekAtLastError();
        if (le != hipSuccess) { fprintf(stderr, "kernel_launch: launch %d failed: %s\n", li, hipGetErrorName(le)); break; }
    }
#endif
}
```

```cpp
#include <hip/hip_runtime.h>
#include <hip/hip_cooperative_groups.h>
#include <cstdio>
#include <cstdint>
namespace pg8 {
#define PG8_LAS __attribute__((address_space(3)))
typedef unsigned short bf16_t;
typedef short bf16x8 __attribute__((ext_vector_type(8)));
typedef float f32x4 __attribute__((ext_vector_type(4)));
typedef unsigned u32x4 __attribute__((ext_vector_type(4)));
typedef unsigned u32x2 __attribute__((ext_vector_type(2)));
constexpr int BM = 256, BK = 64, HALF = 128, HTB = HALF * BK * 2  , STAGE_BYTES = 8 * HTB, NXCD = 8, WGM = 8;

__host__ __device__ __forceinline__ int lds_byte(int r, int c) { const int st = (r >> 4) * 2 + (c >> 5), rr = r & 15, cc = c & 31, ob = rr * 64 + cc * 2; return st * 1024 + (ob ^ (((ob >> 9) & 1) << 5)); }
__host__ __device__ __forceinline__ void stage_rc(int b, int& R, int& C) { const int st = b / 1024, sb = b % 1024, swz = sb ^ (((sb >> 9) & 1) << 5); R = (st >> 1) * 16 + swz / 64; C = (st & 1) * 32 + (swz % 64) / 2; }
__host__ __device__ __forceinline__ int perm32(int rho) { const int n = rho >> 4, i = rho & 15; return 8 * (i >> 2) + 4 * n + (i & 3); }

struct Unit { int pm, pn, which; };
struct Gemm { const bf16_t* A; const bf16_t* Bt; const bf16_t* A2; const bf16_t* Bt2; int M, N, K; };

struct StaticOrder {
    static constexpr bool AFRAG = false;
    int nM, nN, nwg, G, c;
    __host__ __device__ void init(int M, int N, int G_, int c_) { nM = M / BM; nN = N / BM; nwg = nM * nN; G = G_; c = c_; }
    __host__ __device__ bool next(int i, Unit& u) const {
        const long L = (long)i * G + c; if (L >= nwg) return false;
        int wgid = (int)L; { const int q = nwg / NXCD, r = nwg % NXCD, xcd = wgid % NXCD, off = wgid / NXCD; wgid = (xcd < r ? xcd * (q + 1) : r * (q + 1) + (xcd - r) * q) + off; }
        const int nig = WGM * nN, gid = wgid / nig, fm = gid * WGM, gsz = (nM - fm) < WGM ? (nM - fm) : WGM;
        u.pm = fm + ((wgid % nig) % gsz); u.pn = (wgid % nig) / gsz; u.which = 0; return true;
    }
    __device__ __forceinline__ const char* a_base(const Gemm& g, const Unit& u, size_t tstep) const { return (const char*)g.A + (size_t)u.pm * tstep; }
    __device__ __forceinline__ const char* b_base(const Gemm& g, const Unit& u, size_t tstep) const { return (const char*)g.Bt + (size_t)u.pn * tstep; }
    __device__ __forceinline__ void a_ready(const Unit&) const {}
    __device__ __forceinline__ void done(const Unit&) const {}
};

__device__ __forceinline__ unsigned cvt_pk_bf16(float lo, float hi) { unsigned r; asm volatile("v_cvt_pk_bf16_f32 %0, %1, %2" : "=v"(r) : "v"(lo), "v"(hi)); return r; }
__device__ __forceinline__ void store16_wt(void* p, u32x4 v) { *(u32x4*)p = v; }
__device__ __forceinline__ void store8_wt(void* p, u32x2 v) { asm volatile("global_store_dwordx2 %0, %1, off sc1\n\ts_nop 1" :: "v"(p), "v"(v) : "memory"); }
typedef float f32x2 __attribute__((ext_vector_type(2)));
__device__ __forceinline__ f32x2 gelu_pk(f32x2 v) {
    const f32x2 av = __builtin_elementwise_abs(v), d = av * 0.2316418882f + 1.0f;
    f32x2 t; t.x = __builtin_amdgcn_rcpf(d.x); t.y = __builtin_amdgcn_rcpf(d.y);
    f32x2 q = t * 0.5307027145f + (-0.7265760135f); q = q * t + 0.7107068705f; q = q * t + (-0.142248368f); q = q * t + 0.127414796f; q = q * t;
    const f32x2 s = (v * v) * (-0.72134752044f);
    f32x2 e; e.x = __builtin_amdgcn_exp2f(s.x); e.y = __builtin_amdgcn_exp2f(s.y);
    const f32x2 m = v * (q * e), r = v - m;
    f32x2 o; o.x = v.x < 0.f ? m.x : r.x; o.y = v.y < 0.f ? m.y : r.y; return o;
}

template <class Epi, class Sched, bool ALIGN_EPI = false, bool SP2 = false, bool FP8 = false>
__device__ __forceinline__ void gemm_phase(PG8_LAS unsigned char* lds, const Gemm g, const Sched& S, const Epi& E) {
    const int tid = threadIdx.x, wid = __builtin_amdgcn_readfirstlane(tid >> 6), lane = tid & 63, wr = wid >> 2, wc = wid & 3, fr = lane & 15, fq = lane >> 4;
    const int K = g.K, nt = K / BK;
    unsigned voffA[2], voffB[2];
#pragma unroll
    for (int i = 0; i < 2; ++i) { int R, C; stage_rc(tid * 16 + i * 8192, R, C); const int Rb = Epi::PERM ? ((R & ~31) + perm32(R & 31)) : R;
        voffA[i] = Sched::AFRAG ? (unsigned)((((((R >> 6) * 4 + (C >> 5)) * 16 + ((R >> 4) & 3) * 2) * 64) + ((C & 31) >> 3) * 16 + (R & 15)) * 16) : (unsigned)(R * K + C) * 2u;
        voffB[i] = (unsigned)(Rb * K + C) * 2u; }
#define PG8_AP(base, h, kt) (Sched::AFRAG ? (base) + ((((size_t)((kt) >> 2) * 8 + ((kt) & 1) * 2) * 16 + (h) * 8 + (((kt) >> 1) & 1)) * 64) * 16 : (base) + (size_t)(h) * hstep + (size_t)(kt) * kstep)
    const size_t kstep = (size_t)(BK * 2);
    const size_t hstep = (size_t)HALF * K * 2;
    const size_t tstep = 2 * hstep;
    const unsigned ldsw = (unsigned)wid * 1024u;
    const int aoff = lds_byte(wr * 64 + fr, fq * 8), boff = lds_byte(wc * 32 + fr, fq * 8);
#define PG8_SA(b, h) (((b) * 2 + (h)) * HTB)
#define PG8_SB(b, h) ((4 + (b) * 2 + (h)) * HTB)
#define PG8_STAGE(bufoff, gbase, voff) do { _Pragma("unroll") for (int _i = 0; _i < 2; ++_i) \
        __builtin_amdgcn_global_load_lds((const unsigned*)((const char*)(gbase) + (voff)[_i]), (PG8_LAS unsigned*)(lds + (bufoff) + ldsw + _i * 8192), 16, 0, 0); } while (0)
#define PG8_LDA(dst, b, h) do { _Pragma("unroll") for (int m = 0; m < 4; ++m) dst[m] = __builtin_shufflevector(*(const PG8_LAS bf16x8*)(lds + PG8_SA(b, h) + aoff + m * 2048), *(const PG8_LAS bf16x8*)(lds + PG8_SA(b, h) + aoff + m * 2048 + 1024), 0, 1, 2, 3, 4, 5, 6, 7, 8, 9, 10, 11, 12, 13, 14, 15); } while (0)
#define PG8_LDB(dst, b, h) do { _Pragma("unroll") for (int n = 0; n < 2; ++n) dst[n] = __builtin_shufflevector(*(const PG8_LAS bf16x8*)(lds + PG8_SB(b, h) + boff + n * 2048), *(const PG8_LAS bf16x8*)(lds + PG8_SB(b, h) + boff + n * 2048 + 1024), 0, 1, 2, 3, 4, 5, 6, 7, 8, 9, 10, 11, 12, 13, 14, 15); } while (0)
#define PG8_MMA(ai, bj, At, Bt) do { __builtin_amdgcn_s_setprio(1); _Pragma("unroll") for (int m = 0; m < 4; ++m) _Pragma("unroll") for (int n = 0; n < 2; ++n) { \
        if constexpr (FP8) { typedef int v8i_ __attribute__((ext_vector_type(8)));   \
            asm volatile("v_mfma_scale_f32_16x16x128_f8f6f4 %0, %1, %2, %0, %3, %3 op_sel_hi:[0,0,0]" : "+v"(acc[ai][bj][m][n]) : "v"(__builtin_bit_cast(v8i_, Bt[n])), "v"(__builtin_bit_cast(v8i_, At[m])), "v"(mx_one)); \
        } else { \
            acc[ai][bj][m][n] = __builtin_amdgcn_mfma_f32_16x16x32_bf16(__builtin_shufflevector(Bt[n], Bt[n], 0, 1, 2, 3, 4, 5, 6, 7), __builtin_shufflevector(At[m], At[m], 0, 1, 2, 3, 4, 5, 6, 7), acc[ai][bj][m][n], 0, 0, 0); \
            acc[ai][bj][m][n] = __builtin_amdgcn_mfma_f32_16x16x32_bf16(__builtin_shufflevector(Bt[n], Bt[n], 8, 9, 10, 11, 12, 13, 14, 15), __builtin_shufflevector(At[m], At[m], 8, 9, 10, 11, 12, 13, 14, 15), acc[ai][bj][m][n], 0, 0, 0); } } \
        __builtin_amdgcn_s_setprio(0); } while (0)
#define PG8_WAIT_V(n) asm volatile("s_waitcnt vmcnt(" #n ")" ::: "memory")
#define PG8_WAIT_L(n) asm volatile("s_waitcnt lgkmcnt(" #n ")" ::: "memory")
#define PG8_BAR __builtin_amdgcn_s_barrier()
#define PG8_SCHED __builtin_amdgcn_sched_barrier(0)
    Unit cur, nxt; int ui = 0;
    if (!S.next(0, cur)) return;
    f32x4 acc[2][2][4][2];
#pragma unroll
    for (int a = 0; a < 2; ++a)
#pragma unroll
        for (int b = 0; b < 2; ++b)
#pragma unroll
            for (int m = 0; m < 4; ++m)
#pragma unroll
                for (int n = 0; n < 2; ++n) acc[a][b][m][n] = (f32x4){0.f, 0.f, 0.f, 0.f};
    if constexpr (Epi::HAS_INIT) E.init(acc, cur, wr, wc, fr, fq);
    const int mx_one = 0x7f7f7f7f;
    typedef short bf16x16 __attribute__((ext_vector_type(16)));
    bf16x16 At[4], B0[2], B1[2];
    const char* cA = S.a_base(g, cur, tstep); const char* cB = S.b_base(g, cur, tstep);
    S.a_ready(cur);
    if constexpr (SP2) {
        PG8_STAGE(PG8_SB(0, 0), cB, voffB); PG8_STAGE(PG8_SB(0, 1), cB + hstep, voffB); PG8_STAGE(PG8_SA(0, 0), PG8_AP(cA, 0, 0), voffA); PG8_STAGE(PG8_SA(0, 1), PG8_AP(cA, 1, 0), voffA);
        if (wr == 1) PG8_BAR;
        PG8_WAIT_V(2); PG8_BAR;
        PG8_STAGE(PG8_SB(1, 0), cB + kstep, voffB); PG8_STAGE(PG8_SA(1, 0), PG8_AP(cA, 0, 1), voffA); PG8_STAGE(PG8_SB(1, 1), cB + hstep + kstep, voffB);
        PG8_WAIT_V(6); PG8_BAR;
    } else {
        PG8_STAGE(PG8_SB(0, 0), cB, voffB); PG8_STAGE(PG8_SA(0, 0), PG8_AP(cA, 0, 0), voffA); PG8_STAGE(PG8_SB(0, 1), cB + hstep, voffB); PG8_STAGE(PG8_SA(0, 1), PG8_AP(cA, 1, 0), voffA);
        if (wr == 1) PG8_BAR;
        PG8_WAIT_V(4); PG8_BAR;
        PG8_STAGE(PG8_SB(1, 0), cB + kstep, voffB); PG8_STAGE(PG8_SA(1, 0), PG8_AP(cA, 0, 1), voffA); PG8_STAGE(PG8_SB(1, 1), cB + hstep + kstep, voffB);
        PG8_WAIT_V(6); PG8_BAR;
    }
    for (;;) {
        const bool has_next = S.next(ui + 1, nxt);
        const char* nA = has_next ? S.a_base(g, nxt, tstep) : cA; const char* nB = has_next ? S.b_base(g, nxt, tstep) : cB;
        for (int t = 0; t < nt; t += 2) {
            const bool last = (t == nt - 2);
            const char* a2b = last ? nA : cA; const int a2k = last ? 0 : t + 2; const char* b2 = last ? nB : cB + (size_t)(t + 2) * kstep;
            const char* b3 = b2 + kstep;
            const char* a1h = PG8_AP(cA, 1, t + 1); const char* a2 = PG8_AP(a2b, 0, a2k); const char* a2h = PG8_AP(a2b, 1, a2k); const char* a3 = PG8_AP(a2b, 0, a2k + 1);
            if (last && has_next) S.a_ready(nxt);
            if constexpr (SP2) {
            PG8_LDB(B0, 0, 0); PG8_LDB(B1, 0, 1); PG8_SCHED; PG8_LDA(At, 0, 0); PG8_STAGE(PG8_SA(1, 1), a1h, voffA);
            PG8_WAIT_V(8); PG8_WAIT_L(0); PG8_BAR; PG8_MMA(0, 0, At, B0); PG8_MMA(0, 1, At, B1); PG8_BAR; PG8_SCHED;
            PG8_LDA(At, 0, 1); PG8_STAGE(PG8_SB(0, 0), b2, voffB); PG8_STAGE(PG8_SB(0, 1), b2 + hstep, voffB); PG8_STAGE(PG8_SA(0, 0), a2, voffA);
            PG8_WAIT_V(8); PG8_WAIT_L(0); PG8_BAR; PG8_MMA(1, 0, At, B0); PG8_MMA(1, 1, At, B1); PG8_BAR; PG8_SCHED;
            PG8_LDB(B0, 1, 0); PG8_LDB(B1, 1, 1); PG8_SCHED; PG8_LDA(At, 1, 0); PG8_STAGE(PG8_SA(0, 1), a2h, voffA);
            PG8_WAIT_V(8); PG8_WAIT_L(0); PG8_BAR; PG8_MMA(0, 0, At, B0); PG8_MMA(0, 1, At, B1); PG8_BAR; PG8_SCHED;
            PG8_LDA(At, 1, 1); PG8_STAGE(PG8_SB(1, 0), b3, voffB); PG8_STAGE(PG8_SB(1, 1), b3 + hstep, voffB); PG8_STAGE(PG8_SA(1, 0), a3, voffA);
            PG8_WAIT_V(8); PG8_WAIT_L(0); PG8_BAR; PG8_MMA(1, 0, At, B0); PG8_MMA(1, 1, At, B1); PG8_BAR; PG8_SCHED;
            } else {
            PG8_LDB(B0, 0, 0); PG8_SCHED; PG8_LDA(At, 0, 0); PG8_STAGE(PG8_SA(1, 1), a1h, voffA);
            PG8_WAIT_L(8); PG8_BAR; PG8_WAIT_L(0); PG8_MMA(0, 0, At, B0); PG8_BAR; PG8_SCHED;
            PG8_LDB(B1, 0, 1); PG8_STAGE(PG8_SB(0, 0), b2, voffB);
            PG8_BAR; PG8_WAIT_L(0); PG8_MMA(0, 1, At, B1); PG8_BAR;
            PG8_LDA(At, 0, 1); PG8_STAGE(PG8_SA(0, 0), a2, voffA);
            PG8_BAR; PG8_WAIT_L(0); PG8_MMA(1, 0, At, B0); PG8_BAR; PG8_SCHED;
            PG8_STAGE(PG8_SB(0, 1), b2 + hstep, voffB);
            PG8_WAIT_V(6); PG8_BAR; PG8_MMA(1, 1, At, B1); PG8_BAR;
            PG8_LDB(B0, 1, 0); PG8_SCHED; PG8_LDA(At, 1, 0); PG8_STAGE(PG8_SA(0, 1), a2h, voffA);
            PG8_WAIT_L(8); PG8_BAR; PG8_WAIT_L(0); PG8_MMA(0, 0, At, B0); PG8_BAR; PG8_SCHED;
            PG8_LDB(B1, 1, 1); PG8_STAGE(PG8_SB(1, 0), b3, voffB);
            PG8_BAR; PG8_WAIT_L(0); PG8_MMA(0, 1, At, B1); PG8_BAR;
            PG8_LDA(At, 1, 1); PG8_STAGE(PG8_SA(1, 0), a3, voffA);
            PG8_BAR; PG8_WAIT_L(0); PG8_MMA(1, 0, At, B0); PG8_BAR; PG8_SCHED;
            PG8_STAGE(PG8_SB(1, 1), b3 + hstep, voffB);
            PG8_WAIT_V(6); PG8_BAR; PG8_MMA(1, 1, At, B1); PG8_BAR;
            }
        }
        if constexpr (ALIGN_EPI) { if (wr == 0) PG8_BAR; }
        if constexpr (!Epi::AFTER_DRAIN) { E(acc, cur, wr, wc, fr, fq); S.done(cur); }
        if (!has_next) break;
        if (!(Epi::CARRY && cur.which == 0)) {
#pragma unroll
        for (int a = 0; a < 2; ++a)
#pragma unroll
            for (int b = 0; b < 2; ++b)
#pragma unroll
                for (int m = 0; m < 4; ++m)
#pragma unroll
                    for (int n = 0; n < 2; ++n) acc[a][b][m][n] = (f32x4){0.f, 0.f, 0.f, 0.f};
        }
        if constexpr (Epi::HAS_INIT) E.init(acc, nxt, wr, wc, fr, fq);
        cur = nxt; cA = nA; cB = nB; ++ui;
        if constexpr (ALIGN_EPI) { if (wr == 1) PG8_BAR; }
    }
    PG8_WAIT_V(0);
    if constexpr (!ALIGN_EPI) { if (wr == 0) PG8_BAR; }
    PG8_BAR;
    if constexpr (Epi::AFTER_DRAIN) { E.fused(acc, cur, wr, wc, fr, fq, lds, wid, lane); S.done(cur); }
#undef PG8_AP
#undef PG8_SA
#undef PG8_SB
#undef PG8_STAGE
#undef PG8_LDA
#undef PG8_LDB
#undef PG8_MMA
#undef PG8_WAIT_V
#undef PG8_WAIT_L
#undef PG8_BAR
#undef PG8_SCHED
}
}

#ifndef PG8_SP2
#define PG8_SP2 true
#endif
#ifndef PG8_ALIGN
#define PG8_ALIGN true
#endif
#ifndef MK_ONE_LAUNCH
#define MK_ONE_LAUNCH 1
#endif

constexpr int NWAVES = 8;
constexpr int T = 32768, D = 1024, SEQ = 4096;
constexpr int IN_DIM = 4352, PA_W = 2304, G_W = 2048;
constexpr int N16 = 1536, N8 = IN_DIM - N16;
constexpr int C_U = 0, C_B = 512, C_C = 1024, C_Q = 1536, C_K = 2048, C_V = 2176;
constexpr int CONV = 512, HD = 64, NH = 8, NKV = 2;
constexpr int PH = 8, NKEYS = 128, PQ = 2048, TOPK = 16, NEXP = 16384, NSEL = 128;
constexpr float EPS = 1e-6f;
constexpr int N_PHASES = 10;

constexpr size_t MiB = 1u << 20;
constexpr size_t WS_CTL = 0, CTL_ZERO_BYTES = 1 * MiB;
constexpr size_t WS_WIN = 2 * MiB;
constexpr size_t WS_WG8 = WS_WIN + 3072 * 1024;
constexpr size_t WS_WC = 11 * MiB;
constexpr size_t WS_WA = 12 * MiB;
constexpr size_t WS_WO = 13 * MiB;
constexpr size_t WS_WQ = 15 * MiB;
constexpr size_t WS_SK = 19 * MiB;
constexpr size_t WS_RSTD1 = 20 * MiB;
constexpr size_t WS_SSQ = 21 * MiB;
constexpr size_t WS_UB = 24 * MiB;
constexpr size_t WS_SU = 32 * MiB;
constexpr size_t WS_VB = 40 * MiB;
constexpr size_t WS_SV = 48 * MiB;
constexpr size_t WS_XB8 = 56 * MiB;
constexpr size_t WS_XB = 88 * MiB;
constexpr size_t WS_PA = 152 * MiB;
constexpr size_t WS_MIX = WS_PA;
constexpr size_t WS_G = 296 * MiB;
constexpr size_t WS_QP = WS_G;
constexpr size_t WS_Z = 424 * MiB;
constexpr size_t WS_ATT = 456 * MiB;
constexpr size_t WS_IDX = WS_Z, WS_GATE = WS_ATT;
constexpr size_t WS_PART = WS_PA;
constexpr size_t WS_ACT = WS_G;
constexpr size_t WS_END = 488 * MiB;
constexpr int CW_BAR = 4096;

constexpr int RING_OFF = 0, RING_BYTES = 131072;
constexpr int LDSCTL_OFF = 147456, MISC_OFF = LDSCTL_OFF + 320;
constexpr int P9_OUT_OFF = 148480;
constexpr int LDS_BYTES = 156672;
#define GAS __attribute__((address_space(1)))
#define LAS __attribute__((address_space(3)))
typedef unsigned short bf16;
typedef unsigned v4u __attribute__((ext_vector_type(4)));
typedef float f32x4 __attribute__((ext_vector_type(4)));
typedef short bf16x8 __attribute__((ext_vector_type(8)));
typedef GAS unsigned gu32;
typedef GAS unsigned long long gu64;
#define RLX_AGENT __ATOMIC_RELAXED, __HIP_MEMORY_SCOPE_AGENT
#define LDS_WAIT() asm volatile("s_waitcnt lgkmcnt(0)" ::: "memory")
#define VM_WAIT() asm volatile("s_waitcnt vmcnt(0)" ::: "memory")
__device__ __forceinline__ unsigned long long rt() { return __builtin_amdgcn_s_memrealtime(); }
__device__ __forceinline__ unsigned f2bf(float f) { unsigned u = __builtin_bit_cast(unsigned, f); return (u + 0x7fffu + ((u >> 16) & 1u)) >> 16; }
typedef __bf16 bf2h_t __attribute__((ext_vector_type(2)));
typedef float f32x2h_t __attribute__((ext_vector_type(2)));
__device__ __forceinline__ unsigned pk2(float lo, float hi) { const f32x2h_t v = {lo, hi}; return __builtin_bit_cast(unsigned, __builtin_convertvector(v, bf2h_t)); }

#define XB_TMO      128
#define XB_XCNT(j)  (256  + 64 * (j))
#define XB_XSUB(j)  (1280 + 64 * (j))
#define XB_XGEN(j)  (2304 + 64 * (j))
#define XB_TOP      3328
#define XB_TOPGEN   3392
#define XCD_BAR_WORDS 3456
#define XB_LSUB(j)  (3456 + 64 * (j))
#define XB_LGEN(j)  (4480 + 64 * (j))
#define XB_SPIN_CAP (1u << 18)

__device__ __forceinline__ unsigned xb_ld(unsigned* p)              { return __hip_atomic_load(p, __ATOMIC_RELAXED, __HIP_MEMORY_SCOPE_AGENT); }
__device__ __forceinline__ unsigned xb_add(unsigned* p, unsigned v) { return __hip_atomic_fetch_add(p, v, __ATOMIC_RELAXED, __HIP_MEMORY_SCOPE_AGENT); }
__device__ __forceinline__ unsigned xb_xcc_id() { return (unsigned)__builtin_amdgcn_s_getreg((3 << 11) | 20) & 0xFu; }
#define XB_SPIN(cond, bar) do { unsigned _sp = 0; while (cond) { __builtin_amdgcn_s_sleep(1); \
    if ((++_sp & 255u) == 0u) { if (xb_ld(&(bar)[XB_TMO])) break; if (_sp > XB_SPIN_CAP) { atomicAdd(&(bar)[XB_TMO], 1u); break; } } } } while (0)

struct XcdBarrier {
    unsigned* bar; unsigned x;
    volatile LAS unsigned* st;
};

__device__ __forceinline__ XcdBarrier xcd_barrier_post(unsigned* bar, volatile LAS unsigned* st) {
    XcdBarrier b; b.bar = bar; b.x = xb_xcc_id(); b.st = st;
    if (threadIdx.x == 0) st[2] = xb_add(&bar[XB_XCNT(b.x)], 1u);
    return b;
}
__device__ __forceinline__ void xcd_barrier_complete(unsigned* bar, unsigned x, unsigned& nloc, unsigned& nx) {
    const unsigned G = gridDim.x * gridDim.y * gridDim.z;
    unsigned sum, cnt, mine, sp = 0u;
    for (;;) {
        sum = 0u; cnt = 0u; mine = 0u;
#pragma unroll
        for (unsigned j = 0; j < 16; ++j) { const unsigned c = xb_ld(&bar[XB_XCNT(j)]); sum += c; cnt += (c > 0u) ? 1u : 0u; mine = (j == x) ? c : mine; }
        if (sum == G) break;
        __builtin_amdgcn_s_sleep(1);
        if ((++sp & 255u) == 0u) { if (xb_ld(&bar[XB_TMO])) break; if (sp > XB_SPIN_CAP) { atomicAdd(&bar[XB_TMO], 1u); break; } }
    }
    nloc = mine > 0u ? mine : 1u; nx = cnt > 0u ? cnt : 1u;
}

__device__ __forceinline__ void xcd_barrier(const XcdBarrier& b) {
    asm volatile("s_waitcnt vmcnt(0)" ::: "memory");
    __syncthreads();
    if (threadIdx.x == 0) {
        unsigned* bar = b.bar;
        __builtin_amdgcn_s_waitcnt(0);
        unsigned nloc = b.st[0], nx = b.st[1];
        if (nloc == 0u) { xcd_barrier_complete(bar, b.x, nloc, nx); b.st[0] = nloc; b.st[1] = nx; }
        const unsigned old = xb_add(&bar[XB_XSUB(b.x)], 1u);
        const unsigned gen = old / nloc;
        if (old + 1u == (gen + 1u) * nloc) {
            __builtin_amdgcn_fence(__ATOMIC_RELEASE, "agent");
            asm volatile("s_waitcnt vmcnt(0)" ::: "memory");
            const unsigned og = xb_add(&bar[XB_TOP], 1u);
            const unsigned tg = og / nx;
            if (og + 1u == (tg + 1u) * nx) xb_add(&bar[XB_TOPGEN], 1u);
            else XB_SPIN(xb_ld(&bar[XB_TOPGEN]) == tg, bar);
            __builtin_amdgcn_fence(__ATOMIC_ACQUIRE, "agent");
            xb_add(&bar[XB_XGEN(b.x)], 1u);
            asm volatile("s_waitcnt vmcnt(0)" ::: "memory");
        } else {
            XB_SPIN(xb_ld(&bar[XB_XGEN(b.x)]) == gen, bar);
            __builtin_amdgcn_fence(__ATOMIC_ACQUIRE, "agent");
            asm volatile("s_waitcnt vmcnt(0)" ::: "memory");
        }
    }
    __syncthreads();
}

__device__ __forceinline__ void xcd_local_barrier(const XcdBarrier& b) {
    asm volatile("s_waitcnt vmcnt(0)" ::: "memory");
    __syncthreads();
    if (threadIdx.x == 0) {
        unsigned* bar = b.bar;
        __builtin_amdgcn_s_waitcnt(0);
        const unsigned nloc = b.st[0];
        const unsigned old = xb_add(&bar[XB_LSUB(b.x)], 1u);
        const unsigned gen = old / nloc;
        if (old + 1u == (gen + 1u) * nloc) xb_add(&bar[XB_LGEN(b.x)], 1u);
        else XB_SPIN(xb_ld(&bar[XB_LGEN(b.x)]) == gen, bar);
        __builtin_amdgcn_fence(__ATOMIC_ACQUIRE, "agent");
        asm volatile("s_waitcnt vmcnt(0)" ::: "memory");
    }
    __syncthreads();
}

typedef float f32x16 __attribute__((ext_vector_type(16)));
typedef unsigned v2u __attribute__((ext_vector_type(2)));
typedef int v4i __attribute__((ext_vector_type(4)));
typedef __bf16 bf2_t __attribute__((ext_vector_type(2)));
#define DI __device__ __forceinline__
struct Frame {
    LAS unsigned char* lds;
    volatile LAS unsigned* MISC;
    gu32* ctl;
    int tid, lane, wave, vcu, G;
    int xlocal, xq, xrank, cvirt;
    const float *x, *norm_mix, *norm_ffn, *w_in, *b_gate, *w_conv, *q_norm, *k_norm, *sinks, *rel_bias, *w_conv_out, *w_attn_out, *w_out, *w_query, *sub_keys, *expert_u, *expert_v;
    float* out;
    unsigned char* WG8; bf16 *WIN, *WC, *WA, *WO, *WQ, *SK, *UB, *VB, *XB, *PA, *MIX, *G_, *QP, *Z, *ATT;
    float *RSTD1, *SSQ, *GATE, *ACT, *SU, *SV; bf16* PARTB; unsigned char* XB8; unsigned short* IDX;
};
DI float wave_sum(float v) {
#pragma unroll
    for (int o = 1; o < 64; o <<= 1) v += __shfl_xor(v, o);
    return v;
}
DI float bf_lo(unsigned u) { return __builtin_bit_cast(float, u << 16); }
DI float bf_hi(unsigned u) { return __builtin_bit_cast(float, u & 0xffff0000u); }

constexpr float WG_SCALE = 32.f;
DI void p0_transpose_item(const float* W, int K, int N, bf16* WT, const float* gsc, LAS float* scr, int item, int lane, int n8 = 1 << 30, unsigned char* W8 = nullptr) {
    const int nblk = N / 32, kb = item / nblk, nb = item % nblk, k0 = 64 * kb, n0 = 32 * nb;
    float wv[32];
#pragma unroll
    for (int i = 0; i < 32; ++i) wv[i] = W[(size_t)(k0 + 2 * i + (lane >> 5)) * N + n0 + (lane & 31)];
#pragma unroll
    for (int i = 0; i < 32; ++i) { const int kk = 2 * i + (lane >> 5); float v = wv[i]; if (gsc) v *= gsc[k0 + kk]; scr[kk * 33 + (lane & 31)] = v; }
    LDS_WAIT(); asm volatile("" ::: "memory");
    const int c = lane & 7;
#pragma unroll
    for (int j = 0; j < 4; ++j) { const int n = (lane >> 3) + 8 * j; const LAS float* s = scr + (8 * c) * 33 + n;
        if (n0 >= n8) {
            int p0_ = 0, p1_ = 0;
            p0_ = __builtin_amdgcn_cvt_pk_fp8_f32(s[0 * 33] * WG_SCALE, s[1 * 33] * WG_SCALE, p0_, false); p0_ = __builtin_amdgcn_cvt_pk_fp8_f32(s[2 * 33] * WG_SCALE, s[3 * 33] * WG_SCALE, p0_, true);
            p1_ = __builtin_amdgcn_cvt_pk_fp8_f32(s[4 * 33] * WG_SCALE, s[5 * 33] * WG_SCALE, p1_, false); p1_ = __builtin_amdgcn_cvt_pk_fp8_f32(s[6 * 33] * WG_SCALE, s[7 * 33] * WG_SCALE, p1_, true);
            v2u o8; o8.x = (unsigned)p0_; o8.y = (unsigned)p1_; *(GAS v2u*)(W8 + (size_t)(n0 + n - n8) * K + k0 + 8 * c) = o8; continue; }
        v4u o; o.x = pk2(s[0 * 33], s[1 * 33]); o.y = pk2(s[2 * 33], s[3 * 33]); o.z = pk2(s[4 * 33], s[5 * 33]); o.w = pk2(s[6 * 33], s[7 * 33]);
        *(GAS v4u*)(WT + (size_t)(n0 + n) * K + k0 + 8 * c) = o; }
    LDS_WAIT(); asm volatile("" ::: "memory");
}
DI void p0_convert(Frame& F, const float* src, bf16* dst, size_t n, const float* colscale) {
    const size_t n8 = n / 8, stride = (size_t)F.G * NWAVES * 64;
    for (size_t i = (size_t)F.vcu * NWAVES * 64 + F.tid; i < n8; i += stride) {
        f32x4 a = *(const GAS f32x4*)(src + i * 8), b = *(const GAS f32x4*)(src + i * 8 + 4);
        if (colscale) { const int c = (int)((i * 8) & 1023); const f32x4 s0 = *(const GAS f32x4*)(colscale + c), s1 = *(const GAS f32x4*)(colscale + c + 4); a = a * s0; b = b * s1; }
        v4u o; o.x = pk2(a.x, a.y); o.y = pk2(a.z, a.w); o.z = pk2(b.x, b.y); o.w = pk2(b.z, b.w);
        *(GAS v4u*)(dst + i * 8) = o;
    }
}
constexpr float A_SCALE = 128.f;
DI unsigned pk4_fp8(f32x4 v) { int r = 0; r = __builtin_amdgcn_cvt_pk_fp8_f32(v[0], v[1], r, false); r = __builtin_amdgcn_cvt_pk_fp8_f32(v[2], v[3], r, true); return (unsigned)r; }
DI void p0_convert_fp8(Frame& F, const float* src, unsigned char* dst, size_t n, const float* colscale, float scale, int bidx, int nblk) {
    const int gw = bidx * NWAVES + F.wave, NGW = nblk * NWAVES, lane = F.lane;
    f32x4 cs[4];
#pragma unroll
    for (int q = 0; q < 4; ++q) cs[q] = colscale ? *(const GAS f32x4*)(colscale + 4 * lane + 256 * q) * scale : (f32x4){scale, scale, scale, scale};
    const int nrows = (int)(n / D);
    for (int e = gw; e < nrows; e += NGW) {
        const GAS f32x4* rp = (const GAS f32x4*)(src + (size_t)e * D) + lane;
        f32x4 v[4];
#pragma unroll
        for (int q = 0; q < 4; ++q) v[q] = rp[64 * q];
#pragma unroll
        for (int q = 0; q < 4; ++q) *(GAS unsigned*)(dst + ((size_t)(2 * q + (lane >> 5)) * NEXP + e) * 128 + ((4 * lane) & 127)) = pk4_fp8(v[q] * cs[q]);
    }
}
DI void p0_convert_fp4(Frame& F, const float* src, const float* gain, unsigned char* dst, float* scl, int e0, int e1) {
    const int gw = F.wave, NGW = NWAVES, lane = F.lane;
    f32x4 cs[4];
#pragma unroll
    for (int q = 0; q < 4; ++q) cs[q] = gain ? *(const GAS f32x4*)(gain + 4 * lane + 256 * q) : (f32x4){1.f, 1.f, 1.f, 1.f};
    for (int e = e0 + gw; e < e1; e += NGW) {
        const GAS f32x4* rp = (const GAS f32x4*)(src + (size_t)e * D) + lane;
        f32x4 v[4]; float mx = 0.f;
#pragma unroll
        for (int q = 0; q < 4; ++q) { v[q] = rp[64 * q] * cs[q]; mx = fmaxf(mx, fmaxf(fmaxf(fabsf(v[q][0]), fabsf(v[q][1])), fmaxf(fabsf(v[q][2]), fabsf(v[q][3])))); }
#pragma unroll
        for (int o = 1; o < 64; o <<= 1) mx = fmaxf(mx, __shfl_xor(mx, o));
        const float inv = mx > 0.f ? 6.f / mx : 0.f;
        if (lane == 0) scl[e] = mx * (1.f / 6.f);
#pragma unroll
        for (int q = 0; q < 4; ++q) { unsigned r = 0u;
            r = __builtin_amdgcn_cvt_scalef32_pk_fp4_f32(r, v[q][0] * inv, v[q][1] * inv, 1.0f, 0);
            r = __builtin_amdgcn_cvt_scalef32_pk_fp4_f32(r, v[q][2] * inv, v[q][3] * inv, 1.0f, 1);
            *(GAS unsigned short*)(dst + ((size_t)q * NEXP + e) * 128 + 2 * lane) = (unsigned short)r; }
    }
}
template <int RB> DI void p0_rows(Frame& F, const float* xrow, bf16* orow, float* rms_out, unsigned char* o8row) {
    f32x4 v[RB][4]; float s[RB];
#pragma unroll
    for (int r = 0; r < RB; ++r) { const GAS f32x4* xr = (const GAS f32x4*)(xrow + (size_t)r * D) + F.lane;
#pragma unroll
        for (int j = 0; j < 4; ++j) v[r][j] = xr[64 * j]; }
#pragma unroll
    for (int r = 0; r < RB; ++r) { s[r] = 0.f;
#pragma unroll
        for (int j = 0; j < 4; ++j) s[r] += (v[r][j].x * v[r][j].x + v[r][j].y * v[r][j].y) + (v[r][j].z * v[r][j].z + v[r][j].w * v[r][j].w); }
#pragma unroll
    for (int o = 1; o < 64; o <<= 1)
#pragma unroll
        for (int r = 0; r < RB; ++r) s[r] += __shfl_xor(s[r], o);
#pragma unroll
    for (int r = 0; r < RB; ++r) { const float rms = sqrtf(s[r] * (1.f / D) + EPS), rs = 1.f / rms; if (F.lane == 0) rms_out[r] = rms;
        GAS unsigned long long* o8 = (GAS unsigned long long*)(orow + (size_t)r * D) + F.lane;
#pragma unroll
        for (int j = 0; j < 4; ++j) { o8[64 * j] = (unsigned long long)pk2(v[r][j].x * rs, v[r][j].y * rs) | ((unsigned long long)pk2(v[r][j].z * rs, v[r][j].w * rs) << 32);
            *(GAS unsigned*)(o8row + (size_t)r * D + 4 * F.lane + 256 * j) = pk4_fp8(v[r][j] * rs); } }
}
DI void p0_prologue(Frame& F) {
    LAS float* scr = (LAS float*)(F.lds + RING_OFF + F.wave * 16384);
    const int gw = F.vcu * NWAVES + F.wave, NGW = F.G * NWAVES;
    constexpr int I_IN = (D / 64) * (IN_DIM / 32), I_C = (CONV / 64) * (D / 32), I_O = (D / 64) * (D / 32), I_Q = (D / 64) * (PQ / 32);
    constexpr int NITEMS = I_IN + 2 * I_C + I_O + I_Q;
    for (int it = gw; it < NITEMS; it += NGW) {
        int r = it;
        if (r < I_IN) { p0_transpose_item(F.w_in, D, IN_DIM, F.WIN, F.norm_mix, scr, r, F.lane, N16, F.WG8); continue; } r -= I_IN;
        if (r < I_C) { p0_transpose_item(F.w_conv_out, CONV, D, F.WC, nullptr, scr, r, F.lane); continue; } r -= I_C;
        if (r < I_C) { p0_transpose_item(F.w_attn_out, CONV, D, F.WA, nullptr, scr, r, F.lane); continue; } r -= I_C;
        if (r < I_O) { p0_transpose_item(F.w_out, D, D, F.WO, nullptr, scr, r, F.lane); continue; } r -= I_O;
        p0_transpose_item(F.w_query, D, PQ, F.WQ, F.norm_ffn, scr, r, F.lane);
    }
    p0_convert(F, F.sub_keys, F.SK, (size_t)PH * 2 * NKEYS * 128, nullptr);
    for (int m = 4 * gw; m < T; m += 4 * NGW) p0_rows<4>(F, F.x + (size_t)m * D, F.XB + (size_t)m * D, F.RSTD1 + m, F.XB8 + (size_t)m * D);
}

namespace pg8 {
DI float sigmoidf_(float v) { return __builtin_amdgcn_rcpf(1.f + __expf(-v)); }
DI size_t frag_off(int pm, int pn, int NT, int wave, int q, int lane) { return (((((size_t)pm * NT + pn) * 8 + wave) * 16 + q) * 64 + lane) * 8; }
struct EpiProj {
    static constexpr bool PERM = true, AFTER_DRAIN = false, HAS_INIT = false, CARRY = false;
    bf16_t* PA; bf16_t* G; const PG8_LAS float* bgl; int pa_col0, pn_gate0; float gsc;
    DI void operator()(const f32x4 (&acc)[2][2][4][2], const Unit& u, int wr, int wc, int fr, int fq) const {
        const int row0 = u.pm * BM + wr * 64 + fr; const bool gate = u.pn >= pn_gate0;
        const int col0 = (gate ? (u.pn - pn_gate0) * BM : pa_col0 + u.pn * BM) + wc * 32 + 8 * fq;
        if (!gate) {
#pragma unroll
            for (int ai = 0; ai < 2; ++ai)
#pragma unroll
                for (int m = 0; m < 4; ++m) { bf16_t* rowp = PA + (size_t)(row0 + ai * HALF + m * 16) * PA_W + col0;
#pragma unroll
                    for (int bj = 0; bj < 2; ++bj) { const f32x4 v0 = acc[ai][bj][m][0] * gsc, v1 = acc[ai][bj][m][1] * gsc;
                        u32x4 w; w.x = cvt_pk_bf16(v0[0], v0[1]); w.y = cvt_pk_bf16(v0[2], v0[3]); w.z = cvt_pk_bf16(v1[0], v1[1]); w.w = cvt_pk_bf16(v1[2], v1[3]);
                        store16_wt(rowp + bj * HALF, w); } }
        } else {
            f32x4 bv[2][2];
#pragma unroll
            for (int bj = 0; bj < 2; ++bj)
#pragma unroll
                for (int n = 0; n < 2; ++n) bv[bj][n] = *(const PG8_LAS f32x4*)(bgl + col0 + bj * HALF + 4 * n);
#pragma unroll
            for (int ai = 0; ai < 2; ++ai)
#pragma unroll
                for (int m = 0; m < 4; ++m)
#pragma unroll
                    for (int bj = 0; bj < 2; ++bj) { f32x4 v0 = acc[ai][bj][m][0] * gsc + bv[bj][0], v1 = acc[ai][bj][m][1] * gsc + bv[bj][1];
#pragma unroll
                        for (int j = 0; j < 4; ++j) { v0[j] = fmaxf(sigmoidf_(v0[j]) * 255.f, 1.f); v1[j] = fmaxf(sigmoidf_(v1[j]) * 255.f, 1.f); }
                        unsigned g0 = 0u, g1 = 0u;
                        g0 = __builtin_amdgcn_cvt_pk_u8_f32(v0[0], 0, g0); g0 = __builtin_amdgcn_cvt_pk_u8_f32(v0[1], 1, g0); g0 = __builtin_amdgcn_cvt_pk_u8_f32(v0[2], 2, g0); g0 = __builtin_amdgcn_cvt_pk_u8_f32(v0[3], 3, g0);
                        g1 = __builtin_amdgcn_cvt_pk_u8_f32(v1[0], 0, g1); g1 = __builtin_amdgcn_cvt_pk_u8_f32(v1[1], 1, g1); g1 = __builtin_amdgcn_cvt_pk_u8_f32(v1[2], 2, g1); g1 = __builtin_amdgcn_cvt_pk_u8_f32(v1[3], 3, g1);
                        u32x2 gw; gw.x = g0; gw.y = g1;
                        *(u32x2*)((unsigned char*)G + frag_off(u.pm, u.pn - pn_gate0, 8, wr * 4 + wc, ai * 8 + m * 2 + bj, fq * 16 + fr)) = gw; }
        }
    }
};
struct EpiMix {
    static constexpr bool PERM = true, AFTER_DRAIN = false, HAS_INIT = false, CARRY = true;
    bf16_t* MIX; const bf16_t* G;
    DI void operator()(f32x4 (&acc)[2][2][4][2], const Unit& u, int wr, int wc, int fr, int fq) const {
        const int wave = wr * 4 + wc, lane = fq * 16 + fr;
        const unsigned char* gc = (const unsigned char*)G + frag_off(u.pm, u.pn, 8, wave, 0, lane); const unsigned char* ga = (const unsigned char*)G + frag_off(u.pm, u.pn + 4, 8, wave, 0, lane);
        bf16_t* mp = MIX + frag_off(u.pm, u.pn, 4, wave, 0, lane);
#pragma unroll
        for (int ai = 0; ai < 2; ++ai) {
            u32x2 gav[8], gcv[8];
#pragma unroll
            for (int q = 0; q < 8; ++q) gav[q] = *(const u32x2*)(ga + (ai * 8 + q) * 512);
            if (!u.which) {
#pragma unroll
                for (int q = 0; q < 8; ++q) gcv[q] = *(const u32x2*)(gc + (ai * 8 + q) * 512); }
#pragma unroll
            for (int m = 0; m < 4; ++m)
#pragma unroll
                for (int bj = 0; bj < 2; ++bj) { const int q = m * 2 + bj; const u32x2 a2 = gav[q];
                    float fa[8] = {(float)(a2.x & 0xffu), (float)((a2.x >> 8) & 0xffu), (float)((a2.x >> 16) & 0xffu), (float)(a2.x >> 24), (float)(a2.y & 0xffu), (float)((a2.y >> 8) & 0xffu), (float)((a2.y >> 16) & 0xffu), (float)(a2.y >> 24)};
                    if (!u.which) { const u32x2 c2 = gcv[q];
                        const float fc[8] = {(float)(c2.x & 0xffu), (float)((c2.x >> 8) & 0xffu), (float)((c2.x >> 16) & 0xffu), (float)(c2.x >> 24), (float)(c2.y & 0xffu), (float)((c2.y >> 8) & 0xffu), (float)((c2.y >> 16) & 0xffu), (float)(c2.y >> 24)};
#pragma unroll
                        for (int e = 0; e < 4; ++e) { acc[ai][bj][m][0][e] *= fc[e] * __builtin_amdgcn_rcpf(fa[e]); acc[ai][bj][m][1][e] *= fc[4 + e] * __builtin_amdgcn_rcpf(fa[4 + e]); }
                    } else { constexpr float GI = 1.f / 255.f;
                        const f32x4 v0 = acc[ai][bj][m][0], v1 = acc[ai][bj][m][1];
                        u32x4 w; w.x = cvt_pk_bf16(v0[0] * fa[0] * GI, v0[1] * fa[1] * GI); w.y = cvt_pk_bf16(v0[2] * fa[2] * GI, v0[3] * fa[3] * GI);
                        w.z = cvt_pk_bf16(v1[0] * fa[4] * GI, v1[1] * fa[5] * GI); w.w = cvt_pk_bf16(v1[2] * fa[6] * GI, v1[3] * fa[7] * GI);
                        store16_wt(mp + (ai * 8 + q) * 512, w); } }
        }
    }
};
struct FragOrder : StaticOrder { static constexpr bool AFRAG = true; };
struct PairOrder : StaticOrder {
    __device__ bool next(int i, Unit& u) const { const bool ok = StaticOrder::next(i >> 1, u); u.which = i & 1; return ok; }
    DI const char* a_base(const Gemm& g, const Unit& u, size_t tstep) const { return (const char*)(u.which ? g.A2 : g.A) + (size_t)u.pm * tstep; }
    DI const char* b_base(const Gemm& g, const Unit& u, size_t tstep) const { return (const char*)(u.which ? g.Bt2 : g.Bt) + (size_t)u.pn * tstep; }
};
struct EpiX1 {
    static constexpr bool PERM = true, AFTER_DRAIN = false, HAS_INIT = true, CARRY = false;
    const float* RMS; bf16_t* XB; float* SSQ; unsigned char* XB8;
    DI void init(f32x4 (&acc)[2][2][4][2], const Unit& u, int wr, int wc, int fr, int fq) const {
        const int row0 = u.pm * BM + wr * 64 + fr, col0 = u.pn * BM + wc * 32 + 8 * fq;
#pragma unroll
        for (int ai = 0; ai < 2; ++ai)
#pragma unroll
            for (int m = 0; m < 4; ++m)
#pragma unroll
                for (int bj = 0; bj < 2; ++bj) { const int row = row0 + ai * HALF + m * 16; const float rm = RMS[row];
                    const u32x4 xn = *(const u32x4*)(XB + (size_t)row * D + col0 + bj * HALF);
                    acc[ai][bj][m][0] = (f32x4){__builtin_bit_cast(float, xn.x << 16), __builtin_bit_cast(float, xn.x & 0xffff0000u), __builtin_bit_cast(float, xn.y << 16), __builtin_bit_cast(float, xn.y & 0xffff0000u)} * rm;
                    acc[ai][bj][m][1] = (f32x4){__builtin_bit_cast(float, xn.z << 16), __builtin_bit_cast(float, xn.z & 0xffff0000u), __builtin_bit_cast(float, xn.w << 16), __builtin_bit_cast(float, xn.w & 0xffff0000u)} * rm; }
    }
    DI void operator()(const f32x4 (&acc)[2][2][4][2], const Unit& u, int wr, int wc, int fr, int fq) const {
        const int row0 = u.pm * BM + wr * 64 + fr, col0 = u.pn * BM + wc * 32 + 8 * fq;
#pragma unroll
        for (int ai = 0; ai < 2; ++ai)
#pragma unroll
            for (int m = 0; m < 4; ++m) { const int row = row0 + ai * HALF + m * 16; float ss = 0.f;
#pragma unroll
                for (int bj = 0; bj < 2; ++bj) { const f32x4 v0 = acc[ai][bj][m][0], v1 = acc[ai][bj][m][1];
                    ss += ((v0[0] * v0[0] + v0[1] * v0[1]) + (v0[2] * v0[2] + v0[3] * v0[3])) + ((v1[0] * v1[0] + v1[1] * v1[1]) + (v1[2] * v1[2] + v1[3] * v1[3]));
                    u32x4 w; w.x = cvt_pk_bf16(v0[0], v0[1]); w.y = cvt_pk_bf16(v0[2], v0[3]); w.z = cvt_pk_bf16(v1[0], v1[1]); w.w = cvt_pk_bf16(v1[2], v1[3]);
                    store16_wt(XB + (size_t)row * D + col0 + bj * HALF, w);
                    { int p0_ = 0, p1_ = 0;
                      p0_ = __builtin_amdgcn_cvt_pk_fp8_f32(v0[0], v0[1], p0_, false); p0_ = __builtin_amdgcn_cvt_pk_fp8_f32(v0[2], v0[3], p0_, true);
                      p1_ = __builtin_amdgcn_cvt_pk_fp8_f32(v1[0], v1[1], p1_, false); p1_ = __builtin_amdgcn_cvt_pk_fp8_f32(v1[2], v1[3], p1_, true);
                      u32x2 w8; w8.x = (unsigned)p0_; w8.y = (unsigned)p1_; *(u32x2*)(XB8 + (size_t)row * D + col0 + bj * HALF) = w8; } }
                ss += __shfl_xor(ss, 16); ss += __shfl_xor(ss, 32);
                if (fq == 0) SSQ[(size_t)row * 16 + u.pn * 4 + wc] = ss; }
    }
};
DI float rstd2_of(const float* SSQ, int row) {
    const f32x4 a = *(const f32x4*)(SSQ + (size_t)row * 16), b = *(const f32x4*)(SSQ + (size_t)row * 16 + 4), c = *(const f32x4*)(SSQ + (size_t)row * 16 + 8), d = *(const f32x4*)(SSQ + (size_t)row * 16 + 12);
    const float s = ((a[0] + a[1]) + (a[2] + a[3])) + ((b[0] + b[1]) + (b[2] + b[3])) + ((c[0] + c[1]) + (c[2] + c[3])) + ((d[0] + d[1]) + (d[2] + d[3]));
    return 1.f / sqrtf(s * (1.f / D) + EPS);
}
struct EpiQP {
    static constexpr bool PERM = true, AFTER_DRAIN = false, HAS_INIT = false, CARRY = false;
    bf16_t* QP;
    DI void operator()(const f32x4 (&acc)[2][2][4][2], const Unit& u, int wr, int wc, int fr, int fq) const {
        const int row0 = u.pm * BM + wr * 64 + fr, col0 = u.pn * BM + wc * 32 + 8 * fq;
#pragma unroll
        for (int ai = 0; ai < 2; ++ai)
#pragma unroll
            for (int m = 0; m < 4; ++m) {
#pragma unroll
                for (int bj = 0; bj < 2; ++bj) { const f32x4 v0 = acc[ai][bj][m][0], v1 = acc[ai][bj][m][1];
                    u32x4 w; w.x = cvt_pk_bf16(v0[0], v0[1]); w.y = cvt_pk_bf16(v0[2], v0[3]); w.z = cvt_pk_bf16(v1[0], v1[1]); w.w = cvt_pk_bf16(v1[2], v1[3]);
                    *(u32x4*)(QP + frag_off(u.pm, u.pn, 8, wr * 4 + wc, ai * 8 + m * 2 + bj, fq * 16 + fr)) = w; } }
    }
};
}

#define MFMA32(a, b, c) __builtin_amdgcn_mfma_f32_32x32x16_bf16((a), (b), (c), 0, 0, 0)
DI void p2_conv(Frame& F) {
    constexpr int CT = 4;
    const size_t NT_ = (size_t)F.G * NWAVES * 64;
    constexpr size_t PERB = (size_t)(SEQ / CT) * 64;
    const size_t it0 = F.xlocal ? (size_t)F.xq * PERB + (size_t)F.xrank * NWAVES * 64 + F.tid : (size_t)F.vcu * NWAVES * 64 + F.tid;
    const size_t itend = F.xlocal ? (size_t)(F.xq + 1) * PERB : (size_t)(T / CT) * 64, itstep = F.xlocal ? (size_t)(F.G / 8) * NWAVES * 64 : NT_;
    for (size_t item = it0; item < itend; item += itstep) {
        const int tb = (int)(item >> 6) * CT, c0 = (int)(item & 63) * 8, tl = tb & (SEQ - 1);
        v4u cg[CT + 2], uu[CT + 2], bg[CT];
#pragma unroll
        for (int r = 0; r < CT + 2; ++r) { const bool ok = (tl + r - 2) >= 0; const bf16* rowp = F.PA + (size_t)(tb + (ok ? r - 2 : 0)) * PA_W;
            cg[r] = *(const GAS v4u*)(rowp + C_C + c0); uu[r] = *(const GAS v4u*)(rowp + C_U + c0);
            if (!ok) { cg[r] = (v4u){0u, 0u, 0u, 0u}; } }
#pragma unroll
        for (int r = 0; r < CT; ++r) bg[r] = *(const GAS v4u*)(F.PA + (size_t)(tb + r) * PA_W + C_B + c0);
        f32x4 w[3][2];
#pragma unroll
        for (int j = 0; j < 3; ++j) { w[j][0] = *(const GAS f32x4*)(F.w_conv + j * CONV + c0); w[j][1] = *(const GAS f32x4*)(F.w_conv + j * CONV + c0 + 4); }
        float h[CT + 2][8];
#pragma unroll
        for (int r = 0; r < CT + 2; ++r) { h[r][0] = bf_lo(cg[r].x) * bf_lo(uu[r].x); h[r][1] = bf_hi(cg[r].x) * bf_hi(uu[r].x); h[r][2] = bf_lo(cg[r].y) * bf_lo(uu[r].y); h[r][3] = bf_hi(cg[r].y) * bf_hi(uu[r].y);
            h[r][4] = bf_lo(cg[r].z) * bf_lo(uu[r].z); h[r][5] = bf_hi(cg[r].z) * bf_hi(uu[r].z); h[r][6] = bf_lo(cg[r].w) * bf_lo(uu[r].w); h[r][7] = bf_hi(cg[r].w) * bf_hi(uu[r].w); }
#pragma unroll
        for (int r = 0; r < CT; ++r) {
            float a[8];
#pragma unroll
            for (int e = 0; e < 8; ++e) a[e] = w[0][e >> 2][e & 3] * h[r][e] + w[1][e >> 2][e & 3] * h[r + 1][e] + w[2][e >> 2][e & 3] * h[r + 2][e];
            v4u o; o.x = pk2(a[0] * bf_lo(bg[r].x), a[1] * bf_hi(bg[r].x)); o.y = pk2(a[2] * bf_lo(bg[r].y), a[3] * bf_hi(bg[r].y));
            o.z = pk2(a[4] * bf_lo(bg[r].z), a[5] * bf_hi(bg[r].z)); o.w = pk2(a[6] * bf_lo(bg[r].w), a[7] * bf_hi(bg[r].w));
            *(GAS v4u*)(F.Z + (size_t)(tb + r) * CONV + c0) = o;
        }
    }
}
DI int t5_bucket(int d) {
    if (d < 16) return d;
    const int large = 16 + (int)(logf((float)d / 16.f) / logf(8.f) * 16.f);
    return large < 31 ? large : 31;
}
constexpr int KS_STRIDE = 72, VT_STRIDE = 264;
constexpr int ATT_KS = 0, ATT_VT = 256 * KS_STRIDE * 2, ATT_BIAS = ATT_VT + 64 * VT_STRIDE * 2, ATT_END = ATT_BIAS + 4 * 128 * 4;
static_assert(ATT_END <= RING_BYTES, "attention LDS");
DI void p2_attention(Frame& F) {
    LAS bf16* KS = (LAS bf16*)(F.lds + ATT_KS); LAS bf16* VT = (LAS bf16*)(F.lds + ATT_VT); LAS float* BIAS = (LAS float*)(F.lds + ATT_BIAS);
    const int lane = F.lane, r = lane & 31, hh = lane >> 5;
#pragma unroll 1
    for (int unit = F.xlocal ? F.xq * 32 * NKV + F.xrank : F.vcu, uend = F.xlocal ? (F.xq + 1) * 32 * NKV : 8 * 32 * NKV, ustep = F.xlocal ? F.G / 8 : F.G; unit < uend; unit += ustep) {
        const int kv = unit & 1, n = (unit >> 1) & 31, b = unit >> 6;
        const int t0 = b * SEQ + n * 128;
        __syncthreads();
        {
            const int j = F.tid >> 1, hf = F.tid & 1; const bool valid = (n > 0) || (j >= 128);
            const bf16* rowp = F.PA + (size_t)(t0 - 128 + j) * PA_W;
            v4u kq[4], vq[4];
#pragma unroll
            for (int i = 0; i < 4; ++i) { kq[i] = (v4u){0u, 0u, 0u, 0u}; vq[i] = kq[i]; }
            if (valid) {
#pragma unroll
                for (int i = 0; i < 4; ++i) { kq[i] = *(const GAS v4u*)(rowp + C_K + kv * HD + hf * 32 + i * 8); vq[i] = *(const GAS v4u*)(rowp + C_V + kv * HD + hf * 32 + i * 8); }
            }
            float kf[32]; float ss = 0.f;
#pragma unroll
            for (int i = 0; i < 4; ++i) { kf[8 * i + 0] = bf_lo(kq[i].x); kf[8 * i + 1] = bf_hi(kq[i].x); kf[8 * i + 2] = bf_lo(kq[i].y); kf[8 * i + 3] = bf_hi(kq[i].y);
                kf[8 * i + 4] = bf_lo(kq[i].z); kf[8 * i + 5] = bf_hi(kq[i].z); kf[8 * i + 6] = bf_lo(kq[i].w); kf[8 * i + 7] = bf_hi(kq[i].w); }
#pragma unroll
            for (int e = 0; e < 32; ++e) ss += kf[e] * kf[e];
            ss += __shfl_xor(ss, 1);
            const float rs = 1.f / sqrtf(ss * (1.f / HD) + EPS);
#pragma unroll
            for (int i = 0; i < 4; ++i) { const f32x4 g0 = *(const GAS f32x4*)(F.k_norm + hf * 32 + 8 * i), g1 = *(const GAS f32x4*)(F.k_norm + hf * 32 + 8 * i + 4);
                v4u o; o.x = pk2(kf[8 * i + 0] * rs * g0[0], kf[8 * i + 1] * rs * g0[1]); o.y = pk2(kf[8 * i + 2] * rs * g0[2], kf[8 * i + 3] * rs * g0[3]);
                o.z = pk2(kf[8 * i + 4] * rs * g1[0], kf[8 * i + 5] * rs * g1[1]); o.w = pk2(kf[8 * i + 6] * rs * g1[2], kf[8 * i + 7] * rs * g1[3]);
                *(LAS v4u*)(KS + j * KS_STRIDE + hf * 32 + 8 * i) = o; }
#pragma unroll
            for (int i = 0; i < 4; ++i) { const int d0 = hf * 32 + 8 * i;
                VT[(d0 + 0) * VT_STRIDE + j] = (bf16)(vq[i].x & 0xffffu); VT[(d0 + 1) * VT_STRIDE + j] = (bf16)(vq[i].x >> 16);
                VT[(d0 + 2) * VT_STRIDE + j] = (bf16)(vq[i].y & 0xffffu); VT[(d0 + 3) * VT_STRIDE + j] = (bf16)(vq[i].y >> 16);
                VT[(d0 + 4) * VT_STRIDE + j] = (bf16)(vq[i].z & 0xffffu); VT[(d0 + 5) * VT_STRIDE + j] = (bf16)(vq[i].z >> 16);
                VT[(d0 + 6) * VT_STRIDE + j] = (bf16)(vq[i].w & 0xffffu); VT[(d0 + 7) * VT_STRIDE + j] = (bf16)(vq[i].w >> 16); }
            { const int g = F.tid >> 7, dist = F.tid & 127; BIAS[F.tid] = F.rel_bias[t5_bucket(dist) * NH + kv * 4 + g]; }
        }
        __syncthreads();
#pragma unroll 1
        for (int task = F.wave; task < 16; task += NWAVES) {
            const int g = task >> 2, c = task & 3, head = kv * 4 + g, r0 = 32 * c;
            bf16x8 qf[4];
            {
                const bf16* qp = F.PA + (size_t)(t0 + r0 + r) * PA_W + C_Q + head * HD + 8 * hh;
                v4u qq[4]; float qv[32]; float ss = 0.f;
#pragma unroll
                for (int s = 0; s < 4; ++s) qq[s] = *(const GAS v4u*)(qp + 16 * s);
#pragma unroll
                for (int s = 0; s < 4; ++s) { qv[8 * s + 0] = bf_lo(qq[s].x); qv[8 * s + 1] = bf_hi(qq[s].x); qv[8 * s + 2] = bf_lo(qq[s].y); qv[8 * s + 3] = bf_hi(qq[s].y);
                    qv[8 * s + 4] = bf_lo(qq[s].z); qv[8 * s + 5] = bf_hi(qq[s].z); qv[8 * s + 6] = bf_lo(qq[s].w); qv[8 * s + 7] = bf_hi(qq[s].w); }
#pragma unroll
                for (int e = 0; e < 32; ++e) ss += qv[e] * qv[e];
                ss += __shfl_xor(ss, 32);
                const float rs = 0.125f / sqrtf(ss * (1.f / HD) + EPS);
#pragma unroll
                for (int s = 0; s < 4; ++s) { const f32x4 g0 = *(const GAS f32x4*)(F.q_norm + 16 * s + 8 * hh), g1 = *(const GAS f32x4*)(F.q_norm + 16 * s + 8 * hh + 4);
                    v4u o; o.x = pk2(qv[8 * s + 0] * rs * g0[0], qv[8 * s + 1] * rs * g0[1]); o.y = pk2(qv[8 * s + 2] * rs * g0[2], qv[8 * s + 3] * rs * g0[3]);
                    o.z = pk2(qv[8 * s + 4] * rs * g1[0], qv[8 * s + 5] * rs * g1[1]); o.w = pk2(qv[8 * s + 6] * rs * g1[2], qv[8 * s + 7] * rs * g1[3]);
                    qf[s] = __builtin_bit_cast(bf16x8, o); }
            }
            f32x16 sacc[5];
#pragma unroll
            for (int i5 = 0; i5 < 5; ++i5) {
#pragma unroll
                for (int e = 0; e < 16; ++e) sacc[i5][e] = 0.f;
                const int kt = c + i5;
#pragma unroll
                for (int s = 0; s < 4; ++s) { const bf16x8 ka = *(const LAS bf16x8*)(KS + (32 * kt + r) * KS_STRIDE + 16 * s + 8 * hh); sacc[i5] = MFMA32(ka, qf[s], sacc[i5]); }
            }
            const float sink = F.sinks[head];
            const int dbase = r - 4 * hh + 128;
            const LAS float* bl = BIAS + g * 128;
            float mx = sink;
#pragma unroll
            for (int i5 = 0; i5 < 5; ++i5) {
                const bool tile_ok = (n > 0) || (c + i5 >= 4);
#pragma unroll
                for (int e = 0; e < 16; ++e) { const int dist = dbase - 32 * i5 - ((e & 3) + 8 * (e >> 2));
                    bool valid = tile_ok; if (i5 == 0) valid = valid && (dist < 128); if (i5 == 4) valid = valid && (dist >= 0);
                    const float lg = sacc[i5][e] + bl[dist & 127];
                    sacc[i5][e] = valid ? lg : -INFINITY; mx = fmaxf(mx, sacc[i5][e]); }
                __builtin_amdgcn_sched_barrier(0);
            }
            mx = fmaxf(mx, __shfl_xor(mx, 32));
            float sum = 0.f;
#pragma unroll
            for (int i5 = 0; i5 < 5; ++i5)
#pragma unroll
                for (int e = 0; e < 16; ++e) { const float p = __expf(sacc[i5][e] - mx); sacc[i5][e] = p; sum += p; }
            sum += __shfl_xor(sum, 32);
            const float inv = 1.f / (sum + __expf(sink - mx));
            f32x16 oacc[2];
#pragma unroll
            for (int dt = 0; dt < 2; ++dt)
#pragma unroll
                for (int e = 0; e < 16; ++e) oacc[dt][e] = 0.f;
#pragma unroll
            for (int i5 = 0; i5 < 5; ++i5)
#pragma unroll
                for (int s2 = 0; s2 < 2; ++s2) {
                    v4u pp; pp.x = pk2(sacc[i5][8 * s2 + 0] * inv, sacc[i5][8 * s2 + 1] * inv); pp.y = pk2(sacc[i5][8 * s2 + 2] * inv, sacc[i5][8 * s2 + 3] * inv);
                    pp.z = pk2(sacc[i5][8 * s2 + 4] * inv, sacc[i5][8 * s2 + 5] * inv); pp.w = pk2(sacc[i5][8 * s2 + 6] * inv, sacc[i5][8 * s2 + 7] * inv);
                    const bf16x8 pb = __builtin_bit_cast(bf16x8, pp);
                    const int kb = 32 * (c + i5) + 16 * s2 + 4 * hh;
#pragma unroll
                    for (int dt = 0; dt < 2; ++dt) {
                        const v2u lo = *(const LAS v2u*)(VT + (32 * dt + r) * VT_STRIDE + kb), hi = *(const LAS v2u*)(VT + (32 * dt + r) * VT_STRIDE + kb + 8);
                        v4u va; va.x = lo.x; va.y = lo.y; va.z = hi.x; va.w = hi.y;
                        oacc[dt] = MFMA32(__builtin_bit_cast(bf16x8, va), pb, oacc[dt]);
                    }
                    __builtin_amdgcn_sched_barrier(0);
                }
            bf16* op = F.ATT + (size_t)(t0 + r0 + r) * CONV + head * HD;
#pragma unroll
            for (int dt = 0; dt < 2; ++dt)
#pragma unroll
                for (int g4 = 0; g4 < 4; ++g4) { v2u w; w.x = pk2(oacc[dt][4 * g4 + 0], oacc[dt][4 * g4 + 1]); w.y = pk2(oacc[dt][4 * g4 + 2], oacc[dt][4 * g4 + 3]);
#ifdef ZERO_ATT
                    w.x = 0u; w.y = 0u;
#endif
                    *(GAS v2u*)(op + 32 * dt + 8 * g4 + 4 * hh) = w; }
        }
    }
}

DI unsigned f2ord(float f) { const unsigned b = __builtin_bit_cast(unsigned, f); return b ^ ((b >> 31) ? 0xffffffffu : 0x80000000u); }
DI float ord2f(unsigned k) { const unsigned b = k ^ ((k >> 31) ? 0x80000000u : 0xffffffffu); return __builtin_bit_cast(float, b); }
DI unsigned umax_(unsigned a, unsigned b) { return a > b ? a : b; }
DI unsigned umin_(unsigned a, unsigned b) { return a < b ? a : b; }
DI void sort16_desc(unsigned (&v)[16]) {
#pragma unroll
    for (int k = 2; k <= 16; k <<= 1)
#pragma unroll
        for (int j = k >> 1; j > 0; j >>= 1)
#pragma unroll
            for (int i = 0; i < 16; ++i) { const int l = i ^ j; if (l > i) { const bool desc = ((i & k) == 0) || (k == 16); const unsigned a = v[i], b = v[l], hi = umax_(a, b), lo = umin_(a, b); v[i] = desc ? hi : lo; v[l] = desc ? lo : hi; } }
}
DI void merge_top16(unsigned (&a)[16], const unsigned (&b)[16]) {
#pragma unroll
    for (int i = 0; i < 16; ++i) a[i] = umax_(a[i], b[15 - i]);
#pragma unroll
    for (int j = 8; j > 0; j >>= 1)
#pragma unroll
        for (int i = 0; i < 16; ++i) { const int l = i ^ j; if (l > i) { const unsigned x = a[i], y = a[l]; a[i] = umax_(x, y); a[l] = umin_(x, y); } }
}
constexpr int SK_STRIDE = 136;
constexpr int P6_KEYS = 0, P6_IB = 2 * NKEYS * SK_STRIDE * 2, P6_END = P6_IB + NWAVES * 64 * 32;
static_assert(P6_END <= RING_BYTES, "topk LDS");
DI void p6_topk(Frame& F) {
    LAS bf16* KL = (LAS bf16*)(F.lds + P6_KEYS); LAS unsigned char* IB = F.lds + P6_IB + (F.wave * 64 + F.lane) * 32;
    const int lane = F.lane, r = lane & 31, hh = lane >> 5;
    pg8::StaticOrder S; S.init(T, PQ, F.G, F.cvirt);
    pg8::Unit pu;
    for (int ui = 0; S.next(ui, pu); ++ui) {
        const int h = pu.pn, tile = pu.pm;
        __syncthreads();
        {
            const bf16* src = F.SK + (size_t)h * 2 * NKEYS * 128;
#pragma unroll
            for (int i = 0; i < 8; ++i) { const int ch = F.tid + 512 * i; const int row = ch >> 4, c8 = (ch & 15) * 8;
                *(LAS v4u*)(KL + row * SK_STRIDE + c8) = *(const GAS v4u*)(src + (size_t)row * 128 + c8); }
        }
        __syncthreads();
        const int t = tile * 256 + F.wave * 32 + r;
        unsigned S[2][16];
#pragma unroll
        for (int p = 0; p < 2; ++p) {
            bf16x8 qf[8];
            const int rt = F.wave * 32 + r, q_ai = rt >> 7, q_wr = (rt >> 6) & 1, q_m = (rt >> 4) & 3, q_fr = rt & 15;
#pragma unroll
            for (int s = 0; s < 8; ++s) qf[s] = __builtin_bit_cast(bf16x8, *(const GAS v4u*)(F.QP + pg8::frag_off(tile, h, 8, q_wr * 4 + (s >> 1), q_ai * 8 + q_m * 2 + p, (2 * (s & 1) + hh) * 16 + q_fr)));
            unsigned key[4][16];
#pragma unroll
            for (int kt = 0; kt < 4; ++kt) {
                f32x16 acc;
#pragma unroll
                for (int e = 0; e < 16; ++e) acc[e] = 0.f;
#pragma unroll
                for (int s = 0; s < 8; ++s) { const bf16x8 ka = *(const LAS bf16x8*)(KL + (p * NKEYS + 32 * kt + r) * SK_STRIDE + 16 * s + 8 * hh); acc = MFMA32(ka, qf[s], acc); }
#pragma unroll
                for (int e = 0; e < 16; ++e) { const int nk = 32 * kt + (e & 3) + 8 * (e >> 2) + 4 * hh; key[kt][e] = (f2ord(acc[e]) & ~127u) | (unsigned)(127 - nk); }
            }
#pragma unroll
            for (int kt = 0; kt < 4; ++kt) sort16_desc(key[kt]);
            merge_top16(key[0], key[1]); merge_top16(key[2], key[3]); merge_top16(key[0], key[2]);
            unsigned other[16];
#pragma unroll
            for (int i = 0; i < 16; ++i) other[i] = (unsigned)__shfl_xor((int)key[0][i], 32);
            merge_top16(key[0], other);
#pragma unroll
            for (int i = 0; i < 16; ++i) S[p][i] = key[0][i];
        }
        float s0[16], s1[16]; const float rs2 = pg8::rstd2_of(F.SSQ, t);
#pragma unroll
        for (int i = 0; i < 16; ++i) { s0[i] = ord2f(S[0][i] & ~127u) * rs2; s1[i] = ord2f(S[1][i] & ~127u) * rs2; }
        {
#pragma unroll
            for (int q4 = 0; q4 < 4; ++q4) { unsigned w0 = 0, w1 = 0;
#pragma unroll
                for (int e = 0; e < 4; ++e) { w0 |= (127u - (S[0][4 * q4 + e] & 127u)) << (8 * e); w1 |= (127u - (S[1][4 * q4 + e] & 127u)) << (8 * e); }
                *(LAS unsigned*)(IB + 4 * q4) = w0; *(LAS unsigned*)(IB + 16 + 4 * q4) = w1; }
        }
        unsigned cand[2][16];
#pragma unroll
        for (int i = 0; i < 2; ++i)
#pragma unroll
            for (int e = 0; e < 16; ++e) cand[i][e] = 0u;
        {
            int cnt = 0; float ea = 0.f, eb = 0.f; int ep = 0;
#pragma unroll
            for (int a = 0; a < 16; ++a)
#pragma unroll
                for (int b = 0; b < 16; ++b)
                    if ((a + 1) * (b + 1) <= 16) {
                        if ((cnt & 1) == 0) { ea = s0[a]; eb = s1[b]; ep = 255 - (a * 16 + b); }
                        else { const int slot = cnt >> 1; const float sa = hh ? s0[a] : ea, sb = hh ? s1[b] : eb; const int pp = hh ? 255 - (a * 16 + b) : ep;
                            cand[slot & 1][slot >> 1] = (f2ord(sa + sb) & ~255u) | (unsigned)pp; }
                        ++cnt; }
        }
        sort16_desc(cand[0]); sort16_desc(cand[1]); merge_top16(cand[0], cand[1]);
        {
            unsigned other[16];
#pragma unroll
            for (int i = 0; i < 16; ++i) other[i] = (unsigned)__shfl_xor((int)cand[0][i], 32);
            merge_top16(cand[0], other);
        }
        float gv[16]; int ev[16]; float gsum = 0.f; const float gmx = ord2f(cand[0][0] & ~255u);
#pragma unroll
        for (int i = 0; i < 16; ++i) { const unsigned k = cand[0][i]; const int pos = 255 - (int)(k & 255u); const int a = pos >> 4, b = pos & 15;
            ev[i] = (int)IB[a] * NKEYS + (int)IB[16 + b]; gv[i] = __expf(ord2f(k & ~255u) - gmx); gsum += gv[i]; }
        float ginv = 1.f / gsum;
#ifdef UNIFORM_GATES
#pragma unroll
        for (int i = 0; i < 16; ++i) gv[i] = 1.f;
        ginv = 1.f / 16.f;
#endif
        if (hh == 0) {
            unsigned short* ip = F.IDX + (size_t)t * NSEL + h * TOPK; float* gp = F.GATE + (size_t)t * NSEL + h * TOPK;
#pragma unroll
            for (int i = 0; i < 2; ++i) *(GAS v4i*)(ip + 8 * i) = (v4i){ev[8 * i] | (ev[8 * i + 1] << 16), ev[8 * i + 2] | (ev[8 * i + 3] << 16), ev[8 * i + 4] | (ev[8 * i + 5] << 16), ev[8 * i + 6] | (ev[8 * i + 7] << 16)};
#pragma unroll
            for (int i = 0; i < 4; ++i) *(GAS f32x4*)(gp + 4 * i) = (f32x4){gv[4 * i] * ginv, gv[4 * i + 1] * ginv, gv[4 * i + 2] * ginv, gv[4 * i + 3] * ginv};
        }
    }
}

typedef float f32x2_t __attribute__((ext_vector_type(2)));
DI void fp8x16_to_f32(v4u q, float (&f)[16]) {
#pragma unroll
    for (int w = 0; w < 4; ++w) { const f32x2_t lo = __builtin_amdgcn_cvt_pk_f32_fp8((int)q[w], false), hi = __builtin_amdgcn_cvt_pk_f32_fp8((int)q[w], true);
        f[4 * w + 0] = lo.x; f[4 * w + 1] = lo.y; f[4 * w + 2] = hi.x; f[4 * w + 3] = hi.y; }
}
struct XccInfo { int q, nx, nloc, rank, uni; };
DI void xcc_info_build(const XcdBarrier& b) {
    if (threadIdx.x == 0) {
        unsigned q = 0, nx = 0, nloc = 1, uni = 1; const unsigned G8 = gridDim.x / 8u;
        for (unsigned j = 0; j < 16; ++j) { const unsigned c = xb_ld(&b.bar[XB_XCNT(j)]); if (c > 0u) { if (j < b.x) ++q; ++nx; if (c != G8) uni = 0u; } if (j == b.x) nloc = c; }
        b.st[3] = q; b.st[4] = nx > 0u ? nx : 1u; b.st[5] = nloc > 0u ? nloc : 1u;
        b.st[7] = (uni && nx == 8u && (gridDim.x % 8u) == 0u && b.st[0] == G8) ? 1u : 0u;
    }
    __syncthreads();
}
DI XccInfo xcc_info(const XcdBarrier& b) {
    XccInfo I; I.rank = __builtin_amdgcn_readfirstlane((int)b.st[2]); I.q = __builtin_amdgcn_readfirstlane((int)b.st[3]); I.nx = __builtin_amdgcn_readfirstlane((int)b.st[4]); I.nloc = __builtin_amdgcn_readfirstlane((int)b.st[5]); I.uni = __builtin_amdgcn_readfirstlane((int)b.st[7]);
    return I;
}
DI float dpp_sum8(float s) {
    s += __builtin_bit_cast(float, __builtin_amdgcn_update_dpp(0, __builtin_bit_cast(int, s), 0xB1, 0xf, 0xf, false));
    s += __builtin_bit_cast(float, __builtin_amdgcn_update_dpp(0, __builtin_bit_cast(int, s), 0x4E, 0xf, 0xf, false));
    s += __builtin_bit_cast(float, __builtin_amdgcn_update_dpp(0, __builtin_bit_cast(int, s), 0x141, 0xf, 0xf, false));
    return s;
}
typedef long i64_t;
typedef long i64x2 __attribute__((ext_vector_type(2)));
typedef int v4i_t __attribute__((ext_vector_type(4)));
typedef int v8i_t __attribute__((ext_vector_type(8)));
constexpr int PEER_ROW = 144, PEER_WAVE_LDS = 128 * PEER_ROW;
constexpr int MX_ONE = 0x7f7f7f7f;
#define PEER_ID(ia_, ib_, ld_) ((((ld_) < 8 ? ia_ : ib_)[((ld_) & 7) >> 1] >> (16 * ((ld_) & 1))) & 0xffffu)
#define P7_IDS(t_, ia_, ib_) do { const unsigned short* ip_ = F.IDX + (size_t)(t_) * NSEL + 16 * row8; ia_ = *(const GAS v4u*)(ip_); ib_ = *(const GAS v4u*)(ip_ + 8); } while (0)
#define P7_ISSUE(t_, ia_, ib_, uq_, x_) do { \
        const unsigned char* xr_ = F.XB8 + (size_t)(t_) * D + sl * 256 + 16 * g;   \
        x_[0] = *(const GAS v4u*)(xr_); x_[1] = *(const GAS v4u*)(xr_ + 64); x_[2] = *(const GAS v4u*)(xr_ + 128); x_[3] = *(const GAS v4u*)(xr_ + 192); \
        _Pragma("unroll") for (int ld = 0; ld < 16; ++ld) { const unsigned e_ = PEER_ID(ia_, ib_, ld); uq_[ld] = *(const GAS v4u*)(Us + (unsigned)(e_ * 128u + 16u * c8)); } } while (0)
#define P7_COMPUTE(t_, uq_, x_) do { \
        _Pragma("unroll") for (int ld = 0; ld < 16; ++ld) *(LAS v4u*)(wl + (16 * row8 + ld) * PEER_ROW + 16 * c8) = uq_[ld]; \
        v8i_t xb0_, xb1_; \
        xb0_[0] = (int)x_[0].x; xb0_[1] = (int)x_[0].y; xb0_[2] = (int)x_[0].z; xb0_[3] = (int)x_[0].w; xb0_[4] = (int)x_[1].x; xb0_[5] = (int)x_[1].y; xb0_[6] = (int)x_[1].z; xb0_[7] = (int)x_[1].w; \
        xb1_[0] = (int)x_[2].x; xb1_[1] = (int)x_[2].y; xb1_[2] = (int)x_[2].z; xb1_[3] = (int)x_[2].w; xb1_[4] = (int)x_[3].x; xb1_[5] = (int)x_[3].y; xb1_[6] = (int)x_[3].z; xb1_[7] = (int)x_[3].w; \
        f32x4 keep = {0.f, 0.f, 0.f, 0.f}; \
        _Pragma("unroll") for (int j = 0; j < 8; ++j) { f32x4 c_ = {0.f, 0.f, 0.f, 0.f}; \
            const v4i_t a0_ = *(const LAS v4i_t*)(wl + (16 * j + m) * PEER_ROW + 16 * g), a1_ = *(const LAS v4i_t*)(wl + (16 * j + m) * PEER_ROW + 64 + 16 * g); \
            v8i_t A0_ = {a0_[0], a0_[1], a0_[2], a0_[3], 0, 0, 0, 0}, A1_ = {a1_[0], a1_[1], a1_[2], a1_[3], 0, 0, 0, 0}; \
            c_ = __builtin_amdgcn_mfma_scale_f32_16x16x128_f8f6f4(A0_, xb0_, c_, 4, 0, 0, MX_ONE, 0, MX_ONE); \
            c_ = __builtin_amdgcn_mfma_scale_f32_16x16x128_f8f6f4(A1_, xb1_, c_, 4, 0, 0, MX_ONE, 0, MX_ONE); \
            keep = (m == j) ? c_ : keep; } \
        { const bool ok_ = (m < 8) && ((t_) < T); bf16* dst_ = ok_ ? F.PARTB + ((size_t)sl * T + (t_)) * NSEL + 16 * m + 4 * g : F.PARTB + (size_t)8 * T * NSEL + 4 * lane; \
          v2u w_; w_.x = pk2(keep[0], keep[1]); w_.y = pk2(keep[2], keep[3]); *(GAS v2u*)dst_ = w_; } } while (0)
DI int peer_next(volatile LAS unsigned* ctr, int lane) { unsigned k = 0u; if (lane == 0) k = __hip_atomic_fetch_add((LAS unsigned*)ctr, 1u, __ATOMIC_RELAXED, __HIP_MEMORY_SCOPE_WORKGROUP); return __builtin_amdgcn_readfirstlane((int)k); }
DI int peer_tok(int tbase, int tstride, int k) { return tbase + (k & 7) + (k >> 3) * tstride; }
DI void p7_udot(Frame& F, const XccInfo& I) {
    const int lane = F.lane, g = lane >> 4, m = lane & 15, row8 = lane >> 3, c8 = lane & 7;
    LAS unsigned char* wl = F.lds + F.wave * PEER_WAVE_LDS;
    const unsigned char* U4 = (const unsigned char*)F.UB;
    const int tstride = I.nloc * NWAVES, tbase = I.rank * NWAVES;
    int it = 0;
    for (int share = I.q; share < 8; share += I.nx, ++it) {
        const int sl = share >> 1, half = share & 1;
        const unsigned char* Us = U4 + (size_t)sl * NEXP * 128;
        volatile LAS unsigned* ctr = F.MISC + 16 + it;
#define CL(t_) ((t_) < T ? (t_) : T - 1)
#define TOK(k_) (2 * peer_tok(tbase, tstride, (k_)) + half)
        v4u uqA[16], uqB[16]; v4u iA0, iA1, iB0, iB1;
        int kk = peer_next(ctr, lane); int tA = TOK(kk); kk = peer_next(ctr, lane); int tB = TOK(kk);
        {
            v4u xA[4], xB[4];
            P7_IDS(CL(tA), iA0, iA1);
            P7_ISSUE(CL(tA), iA0, iA1, uqA, xA);
            P7_IDS(CL(tB), iB0, iB1);
#pragma unroll 1
            while (tA < T) {
                kk = peer_next(ctr, lane); const int tC = TOK(kk); kk = peer_next(ctr, lane); const int tD = TOK(kk);
                P7_IDS(CL(tC), iA0, iA1);
                P7_ISSUE(CL(tB), iB0, iB1, uqB, xB);
                P7_COMPUTE(tA, uqA, xA);
                P7_IDS(CL(tD), iB0, iB1);
                P7_ISSUE(CL(tC), iA0, iA1, uqA, xA);
                P7_COMPUTE(tB, uqB, xB);
                tA = tC; tB = tD;
            }
        }
#undef TOK
#undef CL
    }
}
DI void p8_act(Frame& F) {
    const size_t NT_ = (size_t)F.G * NWAVES * 64;
    for (size_t item = (size_t)F.vcu * NWAVES * 64 + F.tid; item < (size_t)T * NSEL / 4; item += NT_) {
        const int t = (int)(item >> 5);
        f32x4 s = {0.f, 0.f, 0.f, 0.f}, vs4;
#pragma unroll
        for (int sl = 0; sl < 4; ++sl) { const v2u p = *(const GAS v2u*)(F.PARTB + (size_t)sl * T * NSEL + item * 4); s = s + (f32x4){bf_lo(p.x), bf_hi(p.x), bf_lo(p.y), bf_hi(p.y)}; }
        { const v2u ids = *(const GAS v2u*)(F.IDX + item * 4);
          s[0] *= F.SU[ids.x & 0xffffu]; s[1] *= F.SU[ids.x >> 16]; s[2] *= F.SU[ids.y & 0xffffu]; s[3] *= F.SU[ids.y >> 16];
          vs4 = (f32x4){F.SV[ids.x & 0xffffu], F.SV[ids.x >> 16], F.SV[ids.y & 0xffffu], F.SV[ids.y >> 16]}; }
        const float rs2 = pg8::rstd2_of(F.SSQ, t);
        const f32x4 g = *(const GAS f32x4*)(F.GATE + item * 4);
        f32x4 o;
#pragma unroll
        for (int e = 0; e < 4; e += 2) { pg8::f32x2 pre; pre.x = s[e] * rs2; pre.y = s[e + 1] * rs2; const pg8::f32x2 ge = pg8::gelu_pk(pre);
            o[e] = ge.x * g[e] * vs4[e] * A_SCALE; o[e + 1] = ge.y * g[e + 1] * vs4[e + 1] * A_SCALE; }
        ((GAS unsigned*)F.ACT)[item] = pk4_fp8(o);
    }
}
typedef int v2i_t __attribute__((ext_vector_type(2)));
#define P9_IDS(t_, ia_, ib_, ak_, xr_) do { { const unsigned short* ip_ = F.IDX + (size_t)(t_) * NSEL + 16 * row8; ia_ = *(const GAS v4u*)(ip_); ib_ = *(const GAS v4u*)(ip_ + 8); } \
        const unsigned char* ap_ = (const unsigned char*)F.ACT + (size_t)(t_) * NSEL + 16 * g; \
        ak_[0] = *(const GAS v4u*)(ap_); ak_[1] = *(const GAS v4u*)(ap_ + 64); \
        xr_ = *(const GAS v2u*)(F.XB + (size_t)(t_) * D + sl * 256 + 4 * lane); } while (0)
#define P9_ISSUE(ia_, ib_, vq_) do { \
        _Pragma("unroll") for (int ld = 0; ld < 16; ++ld) { const unsigned e_ = PEER_ID(ia_, ib_, ld); vq_[ld] = *(const GAS v4u*)(Vs + (unsigned)(e_ * 128u + 16u * c8)); } } while (0)
#define P9_WRITE(vq_) do { _Pragma("unroll") for (int ld = 0; ld < 16; ++ld) *(LAS v4u*)(wl + (16 * row8 + ld) * PEER_ROW + 16 * c8) = vq_[ld]; } while (0)
#define P9_MATH(t_, ak_, xr_) do { \
        const v8i_t A_ = {(int)ak_[0].x, (int)ak_[0].y, (int)ak_[0].z, (int)ak_[0].w, (int)ak_[1].x, (int)ak_[1].y, (int)ak_[1].z, (int)ak_[1].w}; \
        float keep[4] = {0.f, 0.f, 0.f, 0.f}; \
        _Pragma("unroll") for (int ct = 0; ct < 16; ++ct) { \
            const v2i_t b0_ = __builtin_amdgcn_ds_read_tr4_b64_v2i32((LAS v2i_t*)(wl + (32 * g + n16) * PEER_ROW + 8 * ct)); \
            const v2i_t b1_ = __builtin_amdgcn_ds_read_tr4_b64_v2i32((LAS v2i_t*)(wl + (32 * g + 16 + n16) * PEER_ROW + 8 * ct)); \
            const v8i_t B_ = {b0_[0], b0_[1], b1_[0], b1_[1], 0, 0, 0, 0}; f32x4 c_ = {0.f, 0.f, 0.f, 0.f}; \
            c_ = __builtin_amdgcn_mfma_scale_f32_16x16x128_f8f6f4(A_, B_, c_, 0, 4, 0, MX_ONE, 0, MX_ONE); \
            keep[ct >> 2] = (g == (ct & 3)) ? c_[0] : keep[ct >> 2]; }   \
          \
        { _Pragma("unroll") for (int q = 0; q < 4; ++q) ob[64 * q + lane] = keep[q]; \
          const f32x4 kv_ = *(const LAS f32x4*)(ob + 4 * lane); \
          const bool ok_ = (t_) < T; \
          float* op_ = ok_ ? F.out + (size_t)(t_) * D + sl * 256 + 4 * lane : (float*)F.PARTB + 4 * lane;     \
          f32x4 o_; o_[0] = bf_lo(xr_.x) + kv_[0] * (1.f / A_SCALE); o_[1] = bf_hi(xr_.x) + kv_[1] * (1.f / A_SCALE); o_[2] = bf_lo(xr_.y) + kv_[2] * (1.f / A_SCALE); o_[3] = bf_hi(xr_.y) + kv_[3] * (1.f / A_SCALE); \
          *(GAS f32x4*)op_ = o_; } } while (0)
DI void p9_vacc(Frame& F, const XccInfo& I) {
    const int lane = F.lane, g = lane >> 4, n16 = lane & 15, row8 = lane >> 3, c8 = lane & 7;
    LAS unsigned char* wl = F.lds + F.wave * PEER_WAVE_LDS;
    LAS float* ob = (LAS float*)(F.lds + P9_OUT_OFF + F.wave * 1024);
    const unsigned char* V4 = (const unsigned char*)F.VB;
    const int tstride = I.nloc * NWAVES, tfirst = I.rank * NWAVES + F.wave;
    for (int share = I.q; share < 8; share += I.nx) {
        const int sl = share >> 1, half = share & 1;
        const unsigned char* Vs = V4 + (size_t)sl * NEXP * 128;
        if (2 * tfirst + half >= T) continue;
        v4u vqA[16], vqB[16]; v4u akA[2], akB[2], akC[2]; v4u iA0, iA1, iB0, iB1; v2u xrA, xrB, xrC;
#define CL(t_) ((t_) < T ? (t_) : T - 1)
#define TK(k_) (2 * (tfirst + (k_) * tstride) + half)
#define SB __builtin_amdgcn_sched_barrier(0)
        P9_IDS(TK(0), iA0, iA1, akA, xrA);
        P9_ISSUE(iA0, iA1, vqA);
        P9_IDS(CL(TK(1)), iB0, iB1, akB, xrB);
        P9_ISSUE(iB0, iB1, vqB);
        P9_IDS(CL(TK(2)), iA0, iA1, akC, xrC);
#pragma unroll 1
        for (int k = 0; TK(k) < T; k += 2) {
            const int t = TK(k), t1 = TK(k + 1), t3 = CL(TK(k + 3)), t4 = CL(TK(k + 4));
            v4u akD[2], akE[2]; v2u xrD, xrE;
            P9_IDS(t3, iB0, iB1, akD, xrD);
            P9_WRITE(vqA); SB;
            P9_ISSUE(iA0, iA1, vqA); SB;
            P9_MATH(t, akA, xrA);
            P9_IDS(t4, iA0, iA1, akE, xrE);
            P9_WRITE(vqB); SB;
            P9_ISSUE(iB0, iB1, vqB); SB;
            P9_MATH(t1, akB, xrB);
            akA[0] = akC[0]; akA[1] = akC[1]; xrA = xrC; akB[0] = akD[0]; akB[1] = akD[1]; xrB = xrD; akC[0] = akE[0]; akC[1] = akE[1]; xrC = xrE;
        }
#undef SB
#undef TK
#undef CL
    }
}

struct Args { const float* in[17]; float* out; unsigned char* ws; int ph_lo, ph_hi, li, pad; };
__global__ void __launch_bounds__(NWAVES * 64, 2) hyb_fwd(Args args) {
    extern __shared__ __attribute__((aligned(16))) unsigned char lds[];
    Frame F;
    F.lds = (LAS unsigned char*)lds;
    F.MISC = (volatile LAS unsigned*)(F.lds + MISC_OFF);
    F.tid = threadIdx.x; F.lane = F.tid & 63; F.wave = __builtin_amdgcn_readfirstlane(F.tid >> 6);
    F.G = gridDim.x; { const int bx = blockIdx.x; F.vcu = (F.G % 8 == 0) ? (bx % 8) * (F.G / 8) + bx / 8 : bx; }
    unsigned char* ws = args.ws;
    F.ctl = (gu32*)(ws + WS_CTL);
    F.x = args.in[0]; F.norm_mix = args.in[1]; F.norm_ffn = args.in[2]; F.w_in = args.in[3]; F.b_gate = args.in[4]; F.w_conv = args.in[5]; F.q_norm = args.in[6]; F.k_norm = args.in[7];
    F.sinks = args.in[8]; F.rel_bias = args.in[9]; F.w_conv_out = args.in[10]; F.w_attn_out = args.in[11]; F.w_out = args.in[12]; F.w_query = args.in[13]; F.sub_keys = args.in[14];
    F.expert_u = args.in[15]; F.expert_v = args.in[16]; F.out = args.out;
    F.WIN = (bf16*)(ws + WS_WIN); F.WG8 = ws + WS_WG8; F.WC = (bf16*)(ws + WS_WC); F.WA = (bf16*)(ws + WS_WA); F.WO = (bf16*)(ws + WS_WO); F.WQ = (bf16*)(ws + WS_WQ); F.SK = (bf16*)(ws + WS_SK);
    F.UB = (bf16*)(ws + WS_UB); F.VB = (bf16*)(ws + WS_VB); F.XB = (bf16*)(ws + WS_XB); F.PA = (bf16*)(ws + WS_PA); F.MIX = (bf16*)(ws + WS_MIX); F.G_ = (bf16*)(ws + WS_G); F.QP = (bf16*)(ws + WS_QP);
    F.Z = (bf16*)(ws + WS_Z); F.ATT = (bf16*)(ws + WS_ATT); F.RSTD1 = (float*)(ws + WS_RSTD1); F.SSQ = (float*)(ws + WS_SSQ); F.GATE = (float*)(ws + WS_GATE); F.IDX = (unsigned short*)(ws + WS_IDX); F.PARTB = (bf16*)(ws + WS_PART); F.SU = (float*)(ws + WS_SU); F.SV = (float*)(ws + WS_SV); F.XB8 = (unsigned char*)(ws + WS_XB8); F.ACT = (float*)(ws + WS_ACT);
    for (int u = F.tid; u < (LDS_BYTES - LDSCTL_OFF) / 4; u += NWAVES * 64) ((LAS unsigned*)(F.lds + LDSCTL_OFF))[u] = 0u;
    __syncthreads();
    XcdBarrier bar; bar.bar = (unsigned*)(F.ctl + CW_BAR); bar.x = 0; bar.st = nullptr;
    const int lo = args.ph_lo, hi = args.ph_hi;
    if (hi - lo > 1) bar = xcd_barrier_post((unsigned*)(F.ctl + CW_BAR), F.MISC + 8);
#ifndef PH_MASK
#define PH_MASK 0x3ff
#endif
#define IN(k) (((PH_MASK >> (k)) & 1) && lo <= (k) && (k) < hi)
#define SEAM(k) do { if (IN(k) && IN((k) + 1)) xcd_barrier(bar); } while (0)
#ifndef PROBE_DUP
#define PROBE_DUP 0
#endif
#define REP(k) for (int rep_ = 0; rep_ < (((PROBE_DUP >> (k)) & 1) ? 2 : 1); ++rep_)

    F.xlocal = 0; F.xq = 0; F.xrank = 0; F.cvirt = (int)blockIdx.x;
    if (IN(0)) { REP(0) p0_prologue(F); SEAM(0); }
    if (hi - lo > 1 && IN(0) && IN(1)) { xcc_info_build(bar); const XccInfo I = xcc_info(bar);
        if (I.uni) { F.xlocal = 1; F.xq = I.q; F.xrank = I.rank; F.cvirt = I.q + 8 * I.rank; } }
#define SEAML(k) do { if (IN(k) && IN((k) + 1)) { if (F.xlocal) xcd_local_barrier(bar); else xcd_barrier(bar); } } while (0)
    if (IN(1)) {
        pg8::Gemm g{F.XB, F.WIN, nullptr, nullptr, T, N16, D}; pg8::StaticOrder S; S.init(T, N16, F.G, F.cvirt);
        pg8::Gemm g8{(const pg8::bf16_t*)F.XB8, (const pg8::bf16_t*)F.WG8, nullptr, nullptr, T, N8, D / 2}; pg8::StaticOrder S8; S8.init(T, N8, F.G, F.cvirt);
        { LAS float* bgl = (LAS float*)(F.lds + RING_BYTES); for (int i = F.tid; i < 2 * D; i += NWAVES * 64) bgl[i] = F.b_gate[i]; __syncthreads(); }
        pg8::EpiProj E{F.PA, F.G_, (const PG8_LAS float*)(F.lds + RING_BYTES), 0, 1 << 20, 1.f}, E8{F.PA, F.G_, (const PG8_LAS float*)(F.lds + RING_BYTES), N16, 3, 1.f / WG_SCALE};
        REP(1) { pg8::gemm_phase<pg8::EpiProj, pg8::StaticOrder, PG8_ALIGN, PG8_SP2, true>(F.lds + RING_OFF, g8, S8, E8);
                 pg8::gemm_phase<pg8::EpiProj, pg8::StaticOrder, PG8_ALIGN, PG8_SP2>(F.lds + RING_OFF, g, S, E); }
        {
            const int nwg = (T / 256) * (N8 / 256), rem = nwg % F.G, c = (int)blockIdx.x; const int nshort = rem ? F.G - rem : F.G, sidx = rem ? c - rem : c;
            (void)sidx; (void)nshort;
            constexpr int CH = 64, NCH = 2 * NEXP / CH;
            for (;;) {
                if (F.tid == 0) F.MISC[14] = __hip_atomic_fetch_add((unsigned*)(F.ctl + 2048), 1u, __ATOMIC_RELAXED, __HIP_MEMORY_SCOPE_AGENT);
                __syncthreads();
                const int ch = __builtin_amdgcn_readfirstlane((int)F.MISC[14]);
                __syncthreads();
                if (ch >= NCH) break;
                if (ch < NCH / 2) p0_convert_fp4(F, F.expert_u, F.norm_ffn, (unsigned char*)F.UB, F.SU, ch * CH, ch * CH + CH);
                else p0_convert_fp4(F, F.expert_v, nullptr, (unsigned char*)F.VB, F.SV, (ch - NCH / 2) * CH, (ch - NCH / 2) * CH + CH);
            } }
        SEAML(1);
    }
    if (IN(2)) {
        REP(2) { p2_conv(F); p2_attention(F); }
        SEAML(2); }
    if (IN(3)) {
        pg8::Gemm g{F.Z, F.WC, F.ATT, F.WA, T, D, CONV}; pg8::PairOrder S; S.init(T, D, F.G, F.cvirt);
        pg8::EpiMix E{F.MIX, F.G_};
        REP(3) pg8::gemm_phase<pg8::EpiMix, pg8::PairOrder, PG8_ALIGN, PG8_SP2>(F.lds + RING_OFF, g, S, E);
        SEAML(3);
    }
    if (IN(4)) {
        pg8::Gemm g{F.MIX, F.WO, nullptr, nullptr, T, D, D}; pg8::FragOrder S; S.init(T, D, F.G, F.cvirt);
        pg8::EpiX1 E{F.RSTD1, F.XB, F.SSQ, F.XB8};
        REP(4) pg8::gemm_phase<pg8::EpiX1, pg8::FragOrder, PG8_ALIGN, PG8_SP2>(F.lds + RING_OFF, g, S, E);
        SEAML(4);
    }
    if (IN(5)) {
        pg8::Gemm g{F.XB, F.WQ, nullptr, nullptr, T, PQ, D}; pg8::StaticOrder S; S.init(T, PQ, F.G, F.cvirt);
        pg8::EpiQP E{F.QP};
        REP(5) pg8::gemm_phase<pg8::EpiQP, pg8::StaticOrder, PG8_ALIGN, PG8_SP2>(F.lds + RING_OFF, g, S, E);
    }
    if (IN(6)) { REP(6) p6_topk(F); SEAM(6); }
    if (IN(7)) { if (!(hi - lo > 1 && IN(0) && IN(1))) xcc_info_build(bar); const XccInfo I = xcc_info(bar); REP(7) p7_udot(F, I); SEAM(7); }
    if (IN(8)) { REP(8) p8_act(F); SEAM(8); }
    if (IN(9)) { const XccInfo I = xcc_info(bar); p9_vacc(F, I); }
#undef IN
#undef SEAM
#undef SEAML
}

extern "C" void kernel_launch(void* const* d_in, const int* in_sizes, int n_in, void* d_out, int out_size, void* d_ws, size_t ws_size, hipStream_t stream) {
    static int grid = 0;
    if (grid == 0) {
        if (n_in != 17 || in_sizes[0] != T * D || out_size != T * D || ws_size < WS_END) { fprintf(stderr, "kernel_launch: unexpected shapes (n_in %d, in0 %d, out %d, ws %zu)\n", n_in, n_in > 0 ? in_sizes[0] : -1, out_size, ws_size); grid = -1; return; }
        int dev = 0, cus = 0, per_cu = 0;
        if (hipGetDevice(&dev) != hipSuccess || hipDeviceGetAttribute(&cus, hipDeviceAttributeMultiprocessorCount, dev) != hipSuccess) { grid = -1; return; }
        if (hipFuncSetAttribute((const void*)hyb_fwd, hipFuncAttributeMaxDynamicSharedMemorySize, LDS_BYTES) != hipSuccess) { fprintf(stderr, "kernel_launch: hipFuncSetAttribute failed\n"); grid = -1; return; }
        if (hipOccupancyMaxActiveBlocksPerMultiprocessor(&per_cu, (const void*)hyb_fwd, NWAVES * 64, LDS_BYTES) != hipSuccess || per_cu < 1) { fprintf(stderr, "kernel_launch: occupancy query says %d blocks per CU\n", per_cu); (void)hipGetLastError(); grid = -1; return; }
        grid = cus * 1;
    }
    if (grid < 0) return;
    if (hipMemsetAsync((char*)d_ws + WS_CTL, 0, CTL_ZERO_BYTES, stream) != hipSuccess) { fprintf(stderr, "kernel_launch: memset failed\n"); return; }
    Args a{};
    for (int i = 0; i < 17; ++i) a.in[i] = (const float*)d_in[i];
    a.out = (float*)d_out; a.ws = (unsigned char*)d_ws;
#if MK_ONE_LAUNCH
    a.ph_lo = 0; a.ph_hi = N_PHASES; a.li = 0;
    void* kargs[] = {&a};
    const hipError_t le = hipLaunchCooperativeKernel((const void*)hyb_fwd, dim3(grid), dim3(NWAVES * 64), kargs, LDS_BYTES, stream);
    if (le != hipSuccess) fprintf(stderr, "kernel_launch: cooperative launch failed: %s (grid %d)\n", hipGetErrorName(le), grid);
#else
    for (int li = 0; li < N_PHASES; ++li) {
        a.ph_lo = li; a.ph_hi = li + 1; a.li = li;
        hipLaunchKernelGGL(hyb_fwd, dim3(grid), dim3(NWAVES * 64), LDS_BYTES, stream, a);
        const hipError_t le = hipPeekAtLastError();
        if (le != hipSuccess) { fprintf(stderr, "kernel_launch: launch %d failed: %s\n", li, hipGetErrorName(le)); break; }
    }
#endif
}
```

```cpp
#include <hip/hip_runtime.h>
#include <hip/hip_cooperative_groups.h>
#include <cstdio>
#include <cstdint>
namespace pg8 {
#define PG8_LAS __attribute__((address_space(3)))
typedef unsigned short bf16_t;
typedef short bf16x8 __attribute__((ext_vector_type(8)));
typedef float f32x4 __attribute__((ext_vector_type(4)));
typedef unsigned u32x4 __attribute__((ext_vector_type(4)));
typedef unsigned u32x2 __attribute__((ext_vector_type(2)));
constexpr int BM = 256, BK = 64, HALF = 128, HTB = HALF * BK * 2  , STAGE_BYTES = 8 * HTB, NXCD = 8, WGM = 8;

__host__ __device__ __forceinline__ int lds_byte(int r, int c) { const int st = (r >> 4) * 2 + (c >> 5), rr = r & 15, cc = c & 31, ob = rr * 64 + cc * 2; return st * 1024 + (ob ^ (((ob >> 9) & 1) << 5)); }
__host__ __device__ __forceinline__ void stage_rc(int b, int& R, int& C) { const int st = b / 1024, sb = b % 1024, swz = sb ^ (((sb >> 9) & 1) << 5); R = (st >> 1) * 16 + swz / 64; C = (st & 1) * 32 + (swz % 64) / 2; }
__host__ __device__ __forceinline__ int perm32(int rho) { const int n = rho >> 4, i = rho & 15; return 8 * (i >> 2) + 4 * n + (i & 3); }

struct Unit { int pm, pn, which; };
struct Gemm { const bf16_t* A; const bf16_t* Bt; const bf16_t* A2; const bf16_t* Bt2; int M, N, K; };

struct StaticOrder {
    static constexpr bool AFRAG = false;
    int nM, nN, nwg, G, c;
    __host__ __device__ void init(int M, int N, int G_, int c_) { nM = M / BM; nN = N / BM; nwg = nM * nN; G = G_; c = c_; }
    __host__ __device__ bool next(int i, Unit& u) const {
        const long L = (long)i * G + c; if (L >= nwg) return false;
        int wgid = (int)L; { const int q = nwg / NXCD, r = nwg % NXCD, xcd = wgid % NXCD, off = wgid / NXCD; wgid = (xcd < r ? xcd * (q + 1) : r * (q + 1) + (xcd - r) * q) + off; }
        const int nig = WGM * nN, gid = wgid / nig, fm = gid * WGM, gsz = (nM - fm) < WGM ? (nM - fm) : WGM;
        u.pm = fm + ((wgid % nig) % gsz); u.pn = (wgid % nig) / gsz; u.which = 0; return true;
    }
    __device__ __forceinline__ const char* a_base(const Gemm& g, const Unit& u, size_t tstep) const { return (const char*)g.A + (size_t)u.pm * tstep; }
    __device__ __forceinline__ const char* b_base(const Gemm& g, const Unit& u, size_t tstep) const { return (const char*)g.Bt + (size_t)u.pn * tstep; }
    __device__ __forceinline__ void a_ready(const Unit&) const {}
    __device__ __forceinline__ void done(const Unit&) const {}
};

__device__ __forceinline__ unsigned cvt_pk_bf16(float lo, float hi) { unsigned r; asm volatile("v_cvt_pk_bf16_f32 %0, %1, %2" : "=v"(r) : "v"(lo), "v"(hi)); return r; }
__device__ __forceinline__ void store16_wt(void* p, u32x4 v) { *(u32x4*)p = v; }
__device__ __forceinline__ void store8_wt(void* p, u32x2 v) { asm volatile("global_store_dwordx2 %0, %1, off sc1\n\ts_nop 1" :: "v"(p), "v"(v) : "memory"); }
typedef float f32x2 __attribute__((ext_vector_type(2)));
__device__ __forceinline__ f32x2 gelu_pk(f32x2 v) {
    const f32x2 av = __builtin_elementwise_abs(v), d = av * 0.2316418882f + 1.0f;
    f32x2 t; t.x = __builtin_amdgcn_rcpf(d.x); t.y = __builtin_amdgcn_rcpf(d.y);
    f32x2 q = t * 0.5307027145f + (-0.7265760135f); q = q * t + 0.7107068705f; q = q * t + (-0.142248368f); q = q * t + 0.127414796f; q = q * t;
    const f32x2 s = (v * v) * (-0.72134752044f);
    f32x2 e; e.x = __builtin_amdgcn_exp2f(s.x); e.y = __builtin_amdgcn_exp2f(s.y);
    const f32x2 m = v * (q * e), r = v - m;
    f32x2 o; o.x = v.x < 0.f ? m.x : r.x; o.y = v.y < 0.f ? m.y : r.y; return o;
}

template <class Epi, class Sched, bool ALIGN_EPI = false, bool SP2 = false, bool FP8 = false>
__device__ __forceinline__ void gemm_phase(PG8_LAS unsigned char* lds, const Gemm g, const Sched& S, const Epi& E) {
    const int tid = threadIdx.x, wid = __builtin_amdgcn_readfirstlane(tid >> 6), lane = tid & 63, wr = wid >> 2, wc = wid & 3, fr = lane & 15, fq = lane >> 4;
    const int K = g.K, nt = K / BK;
    unsigned voffA[2], voffB[2];
#pragma unroll
    for (int i = 0; i < 2; ++i) { int R, C; stage_rc(tid * 16 + i * 8192, R, C); const int Rb = Epi::PERM ? ((R & ~31) + perm32(R & 31)) : R;
        voffA[i] = Sched::AFRAG ? (unsigned)((((((R >> 6) * 4 + (C >> 5)) * 16 + ((R >> 4) & 3) * 2) * 64) + ((C & 31) >> 3) * 16 + (R & 15)) * 16) : (unsigned)(R * K + C) * 2u;
        voffB[i] = (unsigned)(Rb * K + C) * 2u; }
#define PG8_AP(base, h, kt) (Sched::AFRAG ? (base) + ((((size_t)((kt) >> 2) * 8 + ((kt) & 1) * 2) * 16 + (h) * 8 + (((kt) >> 1) & 1)) * 64) * 16 : (base) + (size_t)(h) * hstep + (size_t)(kt) * kstep)
    const size_t kstep = (size_t)(BK * 2);
    const size_t hstep = (size_t)HALF * K * 2;
    const size_t tstep = 2 * hstep;
    const unsigned ldsw = (unsigned)wid * 1024u;
    const int aoff = lds_byte(wr * 64 + fr, fq * 8), boff = lds_byte(wc * 32 + fr, fq * 8);
#define PG8_SA(b, h) (((b) * 2 + (h)) * HTB)
#define PG8_SB(b, h) ((4 + (b) * 2 + (h)) * HTB)
#define PG8_STAGE(bufoff, gbase, voff) do { _Pragma("unroll") for (int _i = 0; _i < 2; ++_i) \
        __builtin_amdgcn_global_load_lds((const unsigned*)((const char*)(gbase) + (voff)[_i]), (PG8_LAS unsigned*)(lds + (bufoff) + ldsw + _i * 8192), 16, 0, 0); } while (0)
#define PG8_LDA(dst, b, h) do { _Pragma("unroll") for (int m = 0; m < 4; ++m) dst[m] = __builtin_shufflevector(*(const PG8_LAS bf16x8*)(lds + PG8_SA(b, h) + aoff + m * 2048), *(const PG8_LAS bf16x8*)(lds + PG8_SA(b, h) + aoff + m * 2048 + 1024), 0, 1, 2, 3, 4, 5, 6, 7, 8, 9, 10, 11, 12, 13, 14, 15); } while (0)
#define PG8_LDB(dst, b, h) do { _Pragma("unroll") for (int n = 0; n < 2; ++n) dst[n] = __builtin_shufflevector(*(const PG8_LAS bf16x8*)(lds + PG8_SB(b, h) + boff + n * 2048), *(const PG8_LAS bf16x8*)(lds + PG8_SB(b, h) + boff + n * 2048 + 1024), 0, 1, 2, 3, 4, 5, 6, 7, 8, 9, 10, 11, 12, 13, 14, 15); } while (0)
#define PG8_MMA(ai, bj, At, Bt) do { __builtin_amdgcn_s_setprio(1); _Pragma("unroll") for (int m = 0; m < 4; ++m) _Pragma("unroll") for (int n = 0; n < 2; ++n) { \
        if constexpr (FP8) { typedef int v8i_ __attribute__((ext_vector_type(8)));   \
            asm volatile("v_mfma_scale_f32_16x16x128_f8f6f4 %0, %1, %2, %0, %3, %3 op_sel_hi:[0,0,0]" : "+v"(acc[ai][bj][m][n]) : "v"(__builtin_bit_cast(v8i_, Bt[n])), "v"(__builtin_bit_cast(v8i_, At[m])), "v"(mx_one)); \
        } else { \
            acc[ai][bj][m][n] = __builtin_amdgcn_mfma_f32_16x16x32_bf16(__builtin_shufflevector(Bt[n], Bt[n], 0, 1, 2, 3, 4, 5, 6, 7), __builtin_shufflevector(At[m], At[m], 0, 1, 2, 3, 4, 5, 6, 7), acc[ai][bj][m][n], 0, 0, 0); \
            acc[ai][bj][m][n] = __builtin_amdgcn_mfma_f32_16x16x32_bf16(__builtin_shufflevector(Bt[n], Bt[n], 8, 9, 10, 11, 12, 13, 14, 15), __builtin_shufflevector(At[m], At[m], 8, 9, 10, 11, 12, 13, 14, 15), acc[ai][bj][m][n], 0, 0, 0); } } \
        __builtin_amdgcn_s_setprio(0); } while (0)
#define PG8_WAIT_V(n) asm volatile("s_waitcnt vmcnt(" #n ")" ::: "memory")
#define PG8_WAIT_L(n) asm volatile("s_waitcnt lgkmcnt(" #n ")" ::: "memory")
#define PG8_BAR __builtin_amdgcn_s_barrier()
#define PG8_SCHED __builtin_amdgcn_sched_barrier(0)
    Unit cur, nxt; int ui = 0;
    if (!S.next(0, cur)) return;
    f32x4 acc[2][2][4][2];
#pragma unroll
    for (int a = 0; a < 2; ++a)
#pragma unroll
        for (int b = 0; b < 2; ++b)
#pragma unroll
            for (int m = 0; m < 4; ++m)
#pragma unroll
                for (int n = 0; n < 2; ++n) acc[a][b][m][n] = (f32x4){0.f, 0.f, 0.f, 0.f};
    if constexpr (Epi::HAS_INIT) E.init(acc, cur, wr, wc, fr, fq);
    const int mx_one = 0x7f7f7f7f;
    typedef short bf16x16 __attribute__((ext_vector_type(16)));
    bf16x16 At[4], B0[2], B1[2];
    const char* cA = S.a_base(g, cur, tstep); const char* cB = S.b_base(g, cur, tstep);
    S.a_ready(cur);
    if constexpr (SP2) {
        PG8_STAGE(PG8_SB(0, 0), cB, voffB); PG8_STAGE(PG8_SB(0, 1), cB + hstep, voffB); PG8_STAGE(PG8_SA(0, 0), PG8_AP(cA, 0, 0), voffA); PG8_STAGE(PG8_SA(0, 1), PG8_AP(cA, 1, 0), voffA);
        if (wr == 1) PG8_BAR;
        PG8_WAIT_V(2); PG8_BAR;
        PG8_STAGE(PG8_SB(1, 0), cB + kstep, voffB); PG8_STAGE(PG8_SA(1, 0), PG8_AP(cA, 0, 1), voffA); PG8_STAGE(PG8_SB(1, 1), cB + hstep + kstep, voffB);
        PG8_WAIT_V(6); PG8_BAR;
    } else {
        PG8_STAGE(PG8_SB(0, 0), cB, voffB); PG8_STAGE(PG8_SA(0, 0), PG8_AP(cA, 0, 0), voffA); PG8_STAGE(PG8_SB(0, 1), cB + hstep, voffB); PG8_STAGE(PG8_SA(0, 1), PG8_AP(cA, 1, 0), voffA);
        if (wr == 1) PG8_BAR;
        PG8_WAIT_V(4); PG8_BAR;
        PG8_STAGE(PG8_SB(1, 0), cB + kstep, voffB); PG8_STAGE(PG8_SA(1, 0), PG8_AP(cA, 0, 1), voffA); PG8_STAGE(PG8_SB(1, 1), cB + hstep + kstep, voffB);
        PG8_WAIT_V(6); PG8_BAR;
    }
    for (;;) {
        const bool has_next = S.next(ui + 1, nxt);
        const char* nA = has_next ? S.a_base(g, nxt, tstep) : cA; const char* nB = has_next ? S.b_base(g, nxt, tstep) : cB;
        for (int t = 0; t < nt; t += 2) {
            const bool last = (t == nt - 2);
            const char* a2b = last ? nA : cA; const int a2k = last ? 0 : t + 2; const char* b2 = last ? nB : cB + (size_t)(t + 2) * kstep;
            const char* b3 = b2 + kstep;
            const char* a1h = PG8_AP(cA, 1, t + 1); const char* a2 = PG8_AP(a2b, 0, a2k); const char* a2h = PG8_AP(a2b, 1, a2k); const char* a3 = PG8_AP(a2b, 0, a2k + 1);
            if (last && has_next) S.a_ready(nxt);
            if constexpr (SP2) {
            PG8_LDB(B0, 0, 0); PG8_LDB(B1, 0, 1); PG8_SCHED; PG8_LDA(At, 0, 0); PG8_STAGE(PG8_SA(1, 1), a1h, voffA);
            PG8_WAIT_V(8); PG8_WAIT_L(0); PG8_BAR; PG8_MMA(0, 0, At, B0); PG8_MMA(0, 1, At, B1); PG8_BAR; PG8_SCHED;
            PG8_LDA(At, 0, 1); PG8_STAGE(PG8_SB(0, 0), b2, voffB); PG8_STAGE(PG8_SB(0, 1), b2 + hstep, voffB); PG8_STAGE(PG8_SA(0, 0), a2, voffA);
            PG8_WAIT_V(8); PG8_WAIT_L(0); PG8_BAR; PG8_MMA(1, 0, At, B0); PG8_MMA(1, 1, At, B1); PG8_BAR; PG8_SCHED;
            PG8_LDB(B0, 1, 0); PG8_LDB(B1, 1, 1); PG8_SCHED; PG8_LDA(At, 1, 0); PG8_STAGE(PG8_SA(0, 1), a2h, voffA);
            PG8_WAIT_V(8); PG8_WAIT_L(0); PG8_BAR; PG8_MMA(0, 0, At, B0); PG8_MMA(0, 1, At, B1); PG8_BAR; PG8_SCHED;
            PG8_LDA(At, 1, 1); PG8_STAGE(PG8_SB(1, 0), b3, voffB); PG8_STAGE(PG8_SB(1, 1), b3 + hstep, voffB); PG8_STAGE(PG8_SA(1, 0), a3, voffA);
            PG8_WAIT_V(8); PG8_WAIT_L(0); PG8_BAR; PG8_MMA(1, 0, At, B0); PG8_MMA(1, 1, At, B1); PG8_BAR; PG8_SCHED;
            } else {
            PG8_LDB(B0, 0, 0); PG8_SCHED; PG8_LDA(At, 0, 0); PG8_STAGE(PG8_SA(1, 1), a1h, voffA);
            PG8_WAIT_L(8); PG8_BAR; PG8_WAIT_L(0); PG8_MMA(0, 0, At, B0); PG8_BAR; PG8_SCHED;
            PG8_LDB(B1, 0, 1); PG8_STAGE(PG8_SB(0, 0), b2, voffB);
            PG8_BAR; PG8_WAIT_L(0); PG8_MMA(0, 1, At, B1); PG8_BAR;
            PG8_LDA(At, 0, 1); PG8_STAGE(PG8_SA(0, 0), a2, voffA);
            PG8_BAR; PG8_WAIT_L(0); PG8_MMA(1, 0, At, B0); PG8_BAR; PG8_SCHED;
            PG8_STAGE(PG8_SB(0, 1), b2 + hstep, voffB);
            PG8_WAIT_V(6); PG8_BAR; PG8_MMA(1, 1, At, B1); PG8_BAR;
            PG8_LDB(B0, 1, 0); PG8_SCHED; PG8_LDA(At, 1, 0); PG8_STAGE(PG8_SA(0, 1), a2h, voffA);
            PG8_WAIT_L(8); PG8_BAR; PG8_WAIT_L(0); PG8_MMA(0, 0, At, B0); PG8_BAR; PG8_SCHED;
            PG8_LDB(B1, 1, 1); PG8_STAGE(PG8_SB(1, 0), b3, voffB);
            PG8_BAR; PG8_WAIT_L(0); PG8_MMA(0, 1, At, B1); PG8_BAR;
            PG8_LDA(At, 1, 1); PG8_STAGE(PG8_SA(1, 0), a3, voffA);
            PG8_BAR; PG8_WAIT_L(0); PG8_MMA(1, 0, At, B0); PG8_BAR; PG8_SCHED;
            PG8_STAGE(PG8_SB(1, 1), b3 + hstep, voffB);
            PG8_WAIT_V(6); PG8_BAR; PG8_MMA(1, 1, At, B1); PG8_BAR;
            }
        }
        if constexpr (ALIGN_EPI) { if (wr == 0) PG8_BAR; }
        if constexpr (!Epi::AFTER_DRAIN) { E(acc, cur, wr, wc, fr, fq); S.done(cur); }
        if (!has_next) break;
        if (!(Epi::CARRY && cur.which == 0)) {
#pragma unroll
        for (int a = 0; a < 2; ++a)
#pragma unroll
            for (int b = 0; b < 2; ++b)
#pragma unroll
                for (int m = 0; m < 4; ++m)
#pragma unroll
                    for (int n = 0; n < 2; ++n) acc[a][b][m][n] = (f32x4){0.f, 0.f, 0.f, 0.f};
        }
        if constexpr (Epi::HAS_INIT) E.init(acc, nxt, wr, wc, fr, fq);
        cur = nxt; cA = nA; cB = nB; ++ui;
        if constexpr (ALIGN_EPI) { if (wr == 1) PG8_BAR; }
    }
    PG8_WAIT_V(0);
    if constexpr (!ALIGN_EPI) { if (wr == 0) PG8_BAR; }
    PG8_BAR;
    if constexpr (Epi::AFTER_DRAIN) { E.fused(acc, cur, wr, wc, fr, fq, lds, wid, lane); S.done(cur); }
#undef PG8_AP
#undef PG8_SA
#undef PG8_SB
#undef PG8_STAGE
#undef PG8_LDA
#undef PG8_LDB
#undef PG8_MMA
#undef PG8_WAIT_V
#undef PG8_WAIT_L
#undef PG8_BAR
#undef PG8_SCHED
}
}

#ifndef PG8_SP2
#define PG8_SP2 true
#endif
#ifndef PG8_ALIGN
#define PG8_ALIGN true
#endif
#ifndef MK_ONE_LAUNCH
#define MK_ONE_LAUNCH 1
#endif

constexpr int NWAVES = 8;
constexpr int T = 32768, D = 1024, SEQ = 4096;
constexpr int IN_DIM = 4352, PA_W = 2304, G_W = 2048;
constexpr int N16 = 1536, N8 = IN_DIM - N16;
constexpr int C_U = 0, C_B = 512, C_C = 1024, C_Q = 1536, C_K = 2048, C_V = 2176;
constexpr int CONV = 512, HD = 64, NH = 8, NKV = 2;
constexpr int PH = 8, NKEYS = 128, PQ = 2048, TOPK = 16, NEXP = 16384, NSEL = 128;
constexpr float EPS = 1e-6f;
constexpr int N_PHASES = 10;

constexpr size_t MiB = 1u << 20;
constexpr size_t WS_CTL = 0, CTL_ZERO_BYTES = 64 * 1024;
constexpr size_t WS_WIN = 2 * MiB;
constexpr size_t WS_WG8 = WS_WIN + 3072 * 1024;
constexpr size_t WS_WC = 11 * MiB;
constexpr size_t WS_WA = 12 * MiB;
constexpr size_t WS_WO = 13 * MiB;
constexpr size_t WS_WQ = 15 * MiB;
constexpr size_t WS_SK = 19 * MiB;
constexpr size_t WS_RSTD1 = 20 * MiB;
constexpr size_t WS_SSQ = 21 * MiB;
constexpr size_t WS_UB = 24 * MiB;
constexpr size_t WS_SU = 32 * MiB;
constexpr size_t WS_VB = 40 * MiB;
constexpr size_t WS_SV = 48 * MiB;
constexpr size_t WS_XB8 = 56 * MiB;
constexpr size_t WS_XB = 88 * MiB;
constexpr size_t WS_PA = 152 * MiB;
constexpr size_t WS_MIX = WS_PA;
constexpr size_t WS_G = 296 * MiB;
constexpr size_t WS_QP = WS_G;
constexpr size_t WS_Z = 424 * MiB;
constexpr size_t WS_ATT = 456 * MiB;
constexpr size_t WS_IDX = WS_Z, WS_GATE = WS_ATT;
constexpr size_t WS_PART = WS_PA;
constexpr size_t WS_ACT = WS_G;
constexpr size_t WS_END = 488 * MiB;
constexpr int CW_BAR = 4096;

constexpr int RING_OFF = 0, RING_BYTES = 131072;
constexpr int LDSCTL_OFF = 147456, MISC_OFF = LDSCTL_OFF + 320;
constexpr int P9_OUT_OFF = 148480;
constexpr int LDS_BYTES = 156672;
#define GAS __attribute__((address_space(1)))
#define LAS __attribute__((address_space(3)))
typedef unsigned short bf16;
typedef unsigned v4u __attribute__((ext_vector_type(4)));
typedef float f32x4 __attribute__((ext_vector_type(4)));
typedef short bf16x8 __attribute__((ext_vector_type(8)));
typedef GAS unsigned gu32;
typedef GAS unsigned long long gu64;
#define RLX_AGENT __ATOMIC_RELAXED, __HIP_MEMORY_SCOPE_AGENT
#define LDS_WAIT() asm volatile("s_waitcnt lgkmcnt(0)" ::: "memory")
#define VM_WAIT() asm volatile("s_waitcnt vmcnt(0)" ::: "memory")
__device__ __forceinline__ unsigned long long rt() { return __builtin_amdgcn_s_memrealtime(); }
__device__ __forceinline__ unsigned f2bf(float f) { unsigned u = __builtin_bit_cast(unsigned, f); return (u + 0x7fffu + ((u >> 16) & 1u)) >> 16; }
typedef __bf16 bf2h_t __attribute__((ext_vector_type(2)));
typedef float f32x2h_t __attribute__((ext_vector_type(2)));
__device__ __forceinline__ unsigned pk2(float lo, float hi) { const f32x2h_t v = {lo, hi}; return __builtin_bit_cast(unsigned, __builtin_convertvector(v, bf2h_t)); }

#define XB_TMO      128
#define XB_XCNT(j)  (256  + 64 * (j))
#define XB_XSUB(j)  (1280 + 64 * (j))
#define XB_XGEN(j)  (2304 + 64 * (j))
#define XB_TOP      3328
#define XB_TOPGEN   3392
#define XCD_BAR_WORDS 3456
#define XB_LSUB(j)  (3456 + 64 * (j))
#define XB_LGEN(j)  (4480 + 64 * (j))
#define XB_SPIN_CAP (1u << 18)

__device__ __forceinline__ unsigned xb_ld(unsigned* p)              { return __hip_atomic_load(p, __ATOMIC_RELAXED, __HIP_MEMORY_SCOPE_AGENT); }
__device__ __forceinline__ unsigned xb_add(unsigned* p, unsigned v) { return __hip_atomic_fetch_add(p, v, __ATOMIC_RELAXED, __HIP_MEMORY_SCOPE_AGENT); }
__device__ __forceinline__ unsigned xb_xcc_id() { return (unsigned)__builtin_amdgcn_s_getreg((3 << 11) | 20) & 0xFu; }
#define XB_SPIN(cond, bar) do { unsigned _sp = 0; while (cond) { __builtin_amdgcn_s_sleep(1); \
    if ((++_sp & 255u) == 0u) { if (xb_ld(&(bar)[XB_TMO])) break; if (_sp > XB_SPIN_CAP) { atomicAdd(&(bar)[XB_TMO], 1u); break; } } } } while (0)

struct XcdBarrier {
    unsigned* bar; unsigned x;
    volatile LAS unsigned* st;
};

__device__ __forceinline__ XcdBarrier xcd_barrier_post(unsigned* bar, volatile LAS unsigned* st) {
    XcdBarrier b; b.bar = bar; b.x = xb_xcc_id(); b.st = st;
    if (threadIdx.x == 0) st[2] = xb_add(&bar[XB_XCNT(b.x)], 1u);
    return b;
}
__device__ __forceinline__ void xcd_barrier_complete(unsigned* bar, unsigned x, unsigned& nloc, unsigned& nx) {
    const unsigned G = gridDim.x * gridDim.y * gridDim.z;
    unsigned sum, cnt, mine, sp = 0u;
    for (;;) {
        sum = 0u; cnt = 0u; mine = 0u;
#pragma unroll
        for (unsigned j = 0; j < 16; ++j) { const unsigned c = xb_ld(&bar[XB_XCNT(j)]); sum += c; cnt += (c > 0u) ? 1u : 0u; mine = (j == x) ? c : mine; }
        if (sum == G) break;
        __builtin_amdgcn_s_sleep(1);
        if ((++sp & 255u) == 0u) { if (xb_ld(&bar[XB_TMO])) break; if (sp > XB_SPIN_CAP) { atomicAdd(&bar[XB_TMO], 1u); break; } }
    }
    nloc = mine > 0u ? mine : 1u; nx = cnt > 0u ? cnt : 1u;
}

__device__ __forceinline__ void xcd_barrier(const XcdBarrier& b) {
    asm volatile("s_waitcnt vmcnt(0)" ::: "memory");
    __syncthreads();
    if (threadIdx.x == 0) {
        unsigned* bar = b.bar;
        __builtin_amdgcn_s_waitcnt(0);
        unsigned nloc = b.st[0], nx = b.st[1];
        if (nloc == 0u) { xcd_barrier_complete(bar, b.x, nloc, nx); b.st[0] = nloc; b.st[1] = nx; }
        const unsigned old = xb_add(&bar[XB_XSUB(b.x)], 1u);
        const unsigned gen = old / nloc;
        if (old + 1u == (gen + 1u) * nloc) {
            __builtin_amdgcn_fence(__ATOMIC_RELEASE, "agent");
            asm volatile("s_waitcnt vmcnt(0)" ::: "memory");
            const unsigned og = xb_add(&bar[XB_TOP], 1u);
            const unsigned tg = og / nx;
            if (og + 1u == (tg + 1u) * nx) xb_add(&bar[XB_TOPGEN], 1u);
            else XB_SPIN(xb_ld(&bar[XB_TOPGEN]) == tg, bar);
            __builtin_amdgcn_fence(__ATOMIC_ACQUIRE, "agent");
            xb_add(&bar[XB_XGEN(b.x)], 1u);
            asm volatile("s_waitcnt vmcnt(0)" ::: "memory");
        } else {
            XB_SPIN(xb_ld(&bar[XB_XGEN(b.x)]) == gen, bar);
            __builtin_amdgcn_fence(__ATOMIC_ACQUIRE, "agent");
            asm volatile("s_waitcnt vmcnt(0)" ::: "memory");
        }
    }
    __syncthreads();
}

__device__ __forceinline__ void xcd_local_barrier(const XcdBarrier& b) {
    asm volatile("s_waitcnt vmcnt(0)" ::: "memory");
    __syncthreads();
    if (threadIdx.x == 0) {
        unsigned* bar = b.bar;
        __builtin_amdgcn_s_waitcnt(0);
        const unsigned nloc = b.st[0];
        const unsigned old = xb_add(&bar[XB_LSUB(b.x)], 1u);
        const unsigned gen = old / nloc;
        if (old + 1u == (gen + 1u) * nloc) xb_add(&bar[XB_LGEN(b.x)], 1u);
        else XB_SPIN(xb_ld(&bar[XB_LGEN(b.x)]) == gen, bar);
        __builtin_amdgcn_fence(__ATOMIC_ACQUIRE, "agent");
        asm volatile("s_waitcnt vmcnt(0)" ::: "memory");
    }
    __syncthreads();
}

typedef float f32x16 __attribute__((ext_vector_type(16)));
typedef unsigned v2u __attribute__((ext_vector_type(2)));
typedef int v4i __attribute__((ext_vector_type(4)));
typedef __bf16 bf2_t __attribute__((ext_vector_type(2)));
#define DI __device__ __forceinline__
struct Frame {
    LAS unsigned char* lds;
    volatile LAS unsigned* MISC;
    gu32* ctl;
    int tid, lane, wave, vcu, G;
    int xlocal, xq, xrank, cvirt;
    const float *x, *norm_mix, *norm_ffn, *w_in, *b_gate, *w_conv, *q_norm, *k_norm, *sinks, *rel_bias, *w_conv_out, *w_attn_out, *w_out, *w_query, *sub_keys, *expert_u, *expert_v;
    float* out;
    unsigned char* WG8; bf16 *WIN, *WC, *WA, *WO, *WQ, *SK, *UB, *VB, *XB, *PA, *MIX, *G_, *QP, *Z, *ATT;
    float *RSTD1, *SSQ, *GATE, *ACT, *SU, *SV; bf16* PARTB; unsigned char* XB8; unsigned short* IDX;
};
DI float wave_sum(float v) {
#pragma unroll
    for (int o = 1; o < 64; o <<= 1) v += __shfl_xor(v, o);
    return v;
}
DI float bf_lo(unsigned u) { return __builtin_bit_cast(float, u << 16); }
DI float bf_hi(unsigned u) { return __builtin_bit_cast(float, u & 0xffff0000u); }

constexpr float WG_SCALE = 32.f;
DI void p0_transpose_item(const float* W, int K, int N, bf16* WT, const float* gsc, LAS float* scr, int item, int lane, int n8 = 1 << 30, unsigned char* W8 = nullptr) {
    const int nblk = N / 32, kb = item / nblk, nb = item % nblk, k0 = 64 * kb, n0 = 32 * nb;
    float wv[32];
#pragma unroll
    for (int i = 0; i < 32; ++i) wv[i] = W[(size_t)(k0 + 2 * i + (lane >> 5)) * N + n0 + (lane & 31)];
#pragma unroll
    for (int i = 0; i < 32; ++i) { const int kk = 2 * i + (lane >> 5); float v = wv[i]; if (gsc) v *= gsc[k0 + kk]; scr[kk * 33 + (lane & 31)] = v; }
    LDS_WAIT(); asm volatile("" ::: "memory");
    const int c = lane & 7;
#pragma unroll
    for (int j = 0; j < 4; ++j) { const int n = (lane >> 3) + 8 * j; const LAS float* s = scr + (8 * c) * 33 + n;
        if (n0 >= n8) {
            int p0_ = 0, p1_ = 0;
            p0_ = __builtin_amdgcn_cvt_pk_fp8_f32(s[0 * 33] * WG_SCALE, s[1 * 33] * WG_SCALE, p0_, false); p0_ = __builtin_amdgcn_cvt_pk_fp8_f32(s[2 * 33] * WG_SCALE, s[3 * 33] * WG_SCALE, p0_, true);
            p1_ = __builtin_amdgcn_cvt_pk_fp8_f32(s[4 * 33] * WG_SCALE, s[5 * 33] * WG_SCALE, p1_, false); p1_ = __builtin_amdgcn_cvt_pk_fp8_f32(s[6 * 33] * WG_SCALE, s[7 * 33] * WG_SCALE, p1_, true);
            v2u o8; o8.x = (unsigned)p0_; o8.y = (unsigned)p1_; *(GAS v2u*)(W8 + (size_t)(n0 + n - n8) * K + k0 + 8 * c) = o8; continue; }
        v4u o; o.x = pk2(s[0 * 33], s[1 * 33]); o.y = pk2(s[2 * 33], s[3 * 33]); o.z = pk2(s[4 * 33], s[5 * 33]); o.w = pk2(s[6 * 33], s[7 * 33]);
        *(GAS v4u*)(WT + (size_t)(n0 + n) * K + k0 + 8 * c) = o; }
    LDS_WAIT(); asm volatile("" ::: "memory");
}
DI void p0_convert(Frame& F, const float* src, bf16* dst, size_t n, const float* colscale) {
    const size_t n8 = n / 8, stride = (size_t)F.G * NWAVES * 64;
    for (size_t i = (size_t)F.vcu * NWAVES * 64 + F.tid; i < n8; i += stride) {
        f32x4 a = *(const GAS f32x4*)(src + i * 8), b = *(const GAS f32x4*)(src + i * 8 + 4);
        if (colscale) { const int c = (int)((i * 8) & 1023); const f32x4 s0 = *(const GAS f32x4*)(colscale + c), s1 = *(const GAS f32x4*)(colscale + c + 4); a = a * s0; b = b * s1; }
        v4u o; o.x = pk2(a.x, a.y); o.y = pk2(a.z, a.w); o.z = pk2(b.x, b.y); o.w = pk2(b.z, b.w);
        *(GAS v4u*)(dst + i * 8) = o;
    }
}
constexpr float A_SCALE = 128.f;
DI unsigned pk4_fp8(f32x4 v) { int r = 0; r = __builtin_amdgcn_cvt_pk_fp8_f32(v[0], v[1], r, false); r = __builtin_amdgcn_cvt_pk_fp8_f32(v[2], v[3], r, true); return (unsigned)r; }
DI void p0_convert_fp8(Frame& F, const float* src, unsigned char* dst, size_t n, const float* colscale, float scale, int bidx, int nblk) {
    const int gw = bidx * NWAVES + F.wave, NGW = nblk * NWAVES, lane = F.lane;
    f32x4 cs[4];
#pragma unroll
    for (int q = 0; q < 4; ++q) cs[q] = colscale ? *(const GAS f32x4*)(colscale + 4 * lane + 256 * q) * scale : (f32x4){scale, scale, scale, scale};
    const int nrows = (int)(n / D);
    for (int e = gw; e < nrows; e += NGW) {
        const GAS f32x4* rp = (const GAS f32x4*)(src + (size_t)e * D) + lane;
        f32x4 v[4];
#pragma unroll
        for (int q = 0; q < 4; ++q) v[q] = rp[64 * q];
#pragma unroll
        for (int q = 0; q < 4; ++q) *(GAS unsigned*)(dst + ((size_t)(2 * q + (lane >> 5)) * NEXP + e) * 128 + ((4 * lane) & 127)) = pk4_fp8(v[q] * cs[q]);
    }
}
DI void p0_convert_fp4(Frame& F, const float* src, const float* gain, unsigned char* dst, float* scl, int e0, int e1) {
    const int gw = F.wave, NGW = NWAVES, lane = F.lane;
    f32x4 cs[4];
#pragma unroll
    for (int q = 0; q < 4; ++q) cs[q] = gain ? *(const GAS f32x4*)(gain + 4 * lane + 256 * q) : (f32x4){1.f, 1.f, 1.f, 1.f};
    for (int e = e0 + gw; e < e1; e += NGW) {
        const GAS f32x4* rp = (const GAS f32x4*)(src + (size_t)e * D) + lane;
        f32x4 v[4]; float mx = 0.f;
#pragma unroll
        for (int q = 0; q < 4; ++q) { v[q] = rp[64 * q] * cs[q]; mx = fmaxf(mx, fmaxf(fmaxf(fabsf(v[q][0]), fabsf(v[q][1])), fmaxf(fabsf(v[q][2]), fabsf(v[q][3])))); }
#pragma unroll
        for (int o = 1; o < 64; o <<= 1) mx = fmaxf(mx, __shfl_xor(mx, o));
        const float inv = mx > 0.f ? 6.f / mx : 0.f;
        if (lane == 0) scl[e] = mx * (1.f / 6.f);
#pragma unroll
        for (int q = 0; q < 4; ++q) { unsigned r = 0u;
            r = __builtin_amdgcn_cvt_scalef32_pk_fp4_f32(r, v[q][0] * inv, v[q][1] * inv, 1.0f, 0);
            r = __builtin_amdgcn_cvt_scalef32_pk_fp4_f32(r, v[q][2] * inv, v[q][3] * inv, 1.0f, 1);
            *(GAS unsigned short*)(dst + ((size_t)q * NEXP + e) * 128 + 2 * lane) = (unsigned short)r; }
    }
}
template <int RB> DI void p0_rows(Frame& F, const float* xrow, bf16* orow, float* rms_out, unsigned char* o8row) {
    f32x4 v[RB][4]; float s[RB];
#pragma unroll
    for (int r = 0; r < RB; ++r) { const GAS f32x4* xr = (const GAS f32x4*)(xrow + (size_t)r * D) + F.lane;
#pragma unroll
        for (int j = 0; j < 4; ++j) v[r][j] = xr[64 * j]; }
#pragma unroll
    for (int r = 0; r < RB; ++r) { s[r] = 0.f;
#pragma unroll
        for (int j = 0; j < 4; ++j) s[r] += (v[r][j].x * v[r][j].x + v[r][j].y * v[r][j].y) + (v[r][j].z * v[r][j].z + v[r][j].w * v[r][j].w); }
#pragma unroll
    for (int o = 1; o < 64; o <<= 1)
#pragma unroll
        for (int r = 0; r < RB; ++r) s[r] += __shfl_xor(s[r], o);
#pragma unroll
    for (int r = 0; r < RB; ++r) { const float rms = sqrtf(s[r] * (1.f / D) + EPS), rs = 1.f / rms; if (F.lane == 0) rms_out[r] = rms;
        GAS unsigned long long* o8 = (GAS unsigned long long*)(orow + (size_t)r * D) + F.lane;
#pragma unroll
        for (int j = 0; j < 4; ++j) { o8[64 * j] = (unsigned long long)pk2(v[r][j].x * rs, v[r][j].y * rs) | ((unsigned long long)pk2(v[r][j].z * rs, v[r][j].w * rs) << 32);
            *(GAS unsigned*)(o8row + (size_t)r * D + 4 * F.lane + 256 * j) = pk4_fp8(v[r][j] * rs); } }
}
DI void p0_prologue(Frame& F) {
    LAS float* scr = (LAS float*)(F.lds + RING_OFF + F.wave * 16384);
    const int gw = F.vcu * NWAVES + F.wave, NGW = F.G * NWAVES;
    constexpr int I_IN = (D / 64) * (IN_DIM / 32), I_C = (CONV / 64) * (D / 32), I_O = (D / 64) * (D / 32), I_Q = (D / 64) * (PQ / 32);
    constexpr int NITEMS = I_IN + 2 * I_C + I_O + I_Q;
    for (int it = gw; it < NITEMS; it += NGW) {
        int r = it;
        if (r < I_IN) { p0_transpose_item(F.w_in, D, IN_DIM, F.WIN, F.norm_mix, scr, r, F.lane, N16, F.WG8); continue; } r -= I_IN;
        if (r < I_C) { p0_transpose_item(F.w_conv_out, CONV, D, F.WC, nullptr, scr, r, F.lane); continue; } r -= I_C;
        if (r < I_C) { p0_transpose_item(F.w_attn_out, CONV, D, F.WA, nullptr, scr, r, F.lane); continue; } r -= I_C;
        if (r < I_O) { p0_transpose_item(F.w_out, D, D, F.WO, nullptr, scr, r, F.lane); continue; } r -= I_O;
        p0_transpose_item(F.w_query, D, PQ, F.WQ, F.norm_ffn, scr, r, F.lane, 0, (unsigned char*)F.WQ);
    }
    p0_convert(F, F.sub_keys, F.SK, (size_t)PH * 2 * NKEYS * 128, nullptr);
    for (int m = 4 * gw; m < T; m += 4 * NGW) p0_rows<4>(F, F.x + (size_t)m * D, F.XB + (size_t)m * D, F.RSTD1 + m, F.XB8 + (size_t)m * D);
}

namespace pg8 {
DI float sigmoidf_(float v) { return __builtin_amdgcn_rcpf(1.f + __expf(-v)); }
DI size_t frag_off(int pm, int pn, int NT, int wave, int q, int lane) { return (((((size_t)pm * NT + pn) * 8 + wave) * 16 + q) * 64 + lane) * 8; }
DI size_t slab_pm(int pm, size_t slab, size_t panel) { return (size_t)(pm >> 4) * slab + (size_t)(pm & 15) * panel; }
constexpr size_t G_SLAB = (size_t)16 << 20, G_PANEL = 8 * 65536;
constexpr size_t MIX_SLAB = (size_t)4096 * 2304, MIX_PANEL = 256 * 1024;
struct EpiProj {
    static constexpr bool PERM = true, AFTER_DRAIN = false, HAS_INIT = false, CARRY = false;
    bf16_t* PA; bf16_t* G; const PG8_LAS float* bgl; int pa_col0, pn_gate0; float gsc;
    DI void operator()(const f32x4 (&acc)[2][2][4][2], const Unit& u, int wr, int wc, int fr, int fq) const {
        const int row0 = u.pm * BM + wr * 64 + fr; const bool gate = u.pn >= pn_gate0;
        const int col0 = (gate ? (u.pn - pn_gate0) * BM : pa_col0 + u.pn * BM) + wc * 32 + 8 * fq;
        if (!gate) {
#pragma unroll
            for (int ai = 0; ai < 2; ++ai)
#pragma unroll
                for (int m = 0; m < 4; ++m) { bf16_t* rowp = PA + (size_t)(row0 + ai * HALF + m * 16) * PA_W + col0;
#pragma unroll
                    for (int bj = 0; bj < 2; ++bj) { const f32x4 v0 = acc[ai][bj][m][0] * gsc, v1 = acc[ai][bj][m][1] * gsc;
                        u32x4 w; w.x = cvt_pk_bf16(v0[0], v0[1]); w.y = cvt_pk_bf16(v0[2], v0[3]); w.z = cvt_pk_bf16(v1[0], v1[1]); w.w = cvt_pk_bf16(v1[2], v1[3]);
                        store16_wt(rowp + bj * HALF, w); } }
        } else {
            f32x4 bv[2][2];
#pragma unroll
            for (int bj = 0; bj < 2; ++bj)
#pragma unroll
                for (int n = 0; n < 2; ++n) bv[bj][n] = *(const PG8_LAS f32x4*)(bgl + col0 + bj * HALF + 4 * n);
#pragma unroll
            for (int ai = 0; ai < 2; ++ai)
#pragma unroll
                for (int m = 0; m < 4; ++m)
#pragma unroll
                    for (int bj = 0; bj < 2; ++bj) { f32x4 v0 = acc[ai][bj][m][0] * gsc + bv[bj][0], v1 = acc[ai][bj][m][1] * gsc + bv[bj][1];
#pragma unroll
                        for (int j = 0; j < 4; ++j) { v0[j] = fmaxf(sigmoidf_(v0[j]) * 255.f, 1.f); v1[j] = fmaxf(sigmoidf_(v1[j]) * 255.f, 1.f); }
                        unsigned g0 = 0u, g1 = 0u;
                        g0 = __builtin_amdgcn_cvt_pk_u8_f32(v0[0], 0, g0); g0 = __builtin_amdgcn_cvt_pk_u8_f32(v0[1], 1, g0); g0 = __builtin_amdgcn_cvt_pk_u8_f32(v0[2], 2, g0); g0 = __builtin_amdgcn_cvt_pk_u8_f32(v0[3], 3, g0);
                        g1 = __builtin_amdgcn_cvt_pk_u8_f32(v1[0], 0, g1); g1 = __builtin_amdgcn_cvt_pk_u8_f32(v1[1], 1, g1); g1 = __builtin_amdgcn_cvt_pk_u8_f32(v1[2], 2, g1); g1 = __builtin_amdgcn_cvt_pk_u8_f32(v1[3], 3, g1);
                        u32x2 gw; gw.x = g0; gw.y = g1;
                        *(u32x2*)((unsigned char*)G + slab_pm(u.pm, G_SLAB, G_PANEL) + frag_off(0, u.pn - pn_gate0, 8, wr * 4 + wc, ai * 8 + m * 2 + bj, fq * 16 + fr)) = gw; }
        }
    }
};
struct EpiMix {
    static constexpr bool PERM = true, AFTER_DRAIN = false, HAS_INIT = false, CARRY = true;
    bf16_t* MIX; const bf16_t* G;
    DI void operator()(f32x4 (&acc)[2][2][4][2], const Unit& u, int wr, int wc, int fr, int fq) const {
        const int wave = wr * 4 + wc, lane = fq * 16 + fr;
        const unsigned char* gb = (const unsigned char*)G + slab_pm(u.pm, G_SLAB, G_PANEL);
        const unsigned char* gc = gb + frag_off(0, u.pn, 8, wave, 0, lane); const unsigned char* ga = gb + frag_off(0, u.pn + 4, 8, wave, 0, lane);
        bf16_t* mp = MIX + slab_pm(u.pm, MIX_SLAB, MIX_PANEL) + frag_off(0, u.pn, 4, wave, 0, lane);
#pragma unroll
        for (int ai = 0; ai < 2; ++ai) {
            u32x2 gav[8], gcv[8];
#pragma unroll
            for (int q = 0; q < 8; ++q) gav[q] = *(const u32x2*)(ga + (ai * 8 + q) * 512);
            if (!u.which) {
#pragma unroll
                for (int q = 0; q < 8; ++q) gcv[q] = *(const u32x2*)(gc + (ai * 8 + q) * 512); }
#pragma unroll
            for (int m = 0; m < 4; ++m)
#pragma unroll
                for (int bj = 0; bj < 2; ++bj) { const int q = m * 2 + bj; const u32x2 a2 = gav[q];
                    float fa[8] = {(float)(a2.x & 0xffu), (float)((a2.x >> 8) & 0xffu), (float)((a2.x >> 16) & 0xffu), (float)(a2.x >> 24), (float)(a2.y & 0xffu), (float)((a2.y >> 8) & 0xffu), (float)((a2.y >> 16) & 0xffu), (float)(a2.y >> 24)};
                    if (!u.which) { const u32x2 c2 = gcv[q];
                        const float fc[8] = {(float)(c2.x & 0xffu), (float)((c2.x >> 8) & 0xffu), (float)((c2.x >> 16) & 0xffu), (float)(c2.x >> 24), (float)(c2.y & 0xffu), (float)((c2.y >> 8) & 0xffu), (float)((c2.y >> 16) & 0xffu), (float)(c2.y >> 24)};
#pragma unroll
                        for (int e = 0; e < 4; ++e) { acc[ai][bj][m][0][e] *= fc[e] * __builtin_amdgcn_rcpf(fa[e]); acc[ai][bj][m][1][e] *= fc[4 + e] * __builtin_amdgcn_rcpf(fa[4 + e]); }
                    } else { constexpr float GI = 1.f / 255.f;
                        const f32x4 v0 = acc[ai][bj][m][0], v1 = acc[ai][bj][m][1];
                        u32x4 w; w.x = cvt_pk_bf16(v0[0] * fa[0] * GI, v0[1] * fa[1] * GI); w.y = cvt_pk_bf16(v0[2] * fa[2] * GI, v0[3] * fa[3] * GI);
                        w.z = cvt_pk_bf16(v1[0] * fa[4] * GI, v1[1] * fa[5] * GI); w.w = cvt_pk_bf16(v1[2] * fa[6] * GI, v1[3] * fa[7] * GI);
                        store16_wt(mp + (ai * 8 + q) * 512, w); } }
        }
    }
};
struct FragOrder : StaticOrder { static constexpr bool AFRAG = true;
    size_t slab;
    DI const char* a_base(const Gemm& g, const Unit& u, size_t tstep) const { return (const char*)g.A + slab_pm(u.pm, slab, tstep); } };
struct PairOrder : StaticOrder {
    __device__ bool next(int i, Unit& u) const { const bool ok = StaticOrder::next(i >> 1, u); u.which = i & 1; return ok; }
    DI const char* a_base(const Gemm& g, const Unit& u, size_t tstep) const { return (const char*)(u.which ? g.A2 : g.A) + (size_t)u.pm * tstep; }
    DI const char* b_base(const Gemm& g, const Unit& u, size_t tstep) const { return (const char*)(u.which ? g.Bt2 : g.Bt) + (size_t)u.pn * tstep; }
};
struct EpiX1 {
    static constexpr bool PERM = true, AFTER_DRAIN = false, HAS_INIT = true, CARRY = false;
    const float* RMS; bf16_t* XB; float* SSQ; unsigned char* XB8;
    DI void init(f32x4 (&acc)[2][2][4][2], const Unit& u, int wr, int wc, int fr, int fq) const {
        const int row0 = u.pm * BM + wr * 64 + fr, col0 = u.pn * BM + wc * 32 + 8 * fq;
#pragma unroll
        for (int ai = 0; ai < 2; ++ai)
#pragma unroll
            for (int m = 0; m < 4; ++m)
#pragma unroll
                for (int bj = 0; bj < 2; ++bj) { const int row = row0 + ai * HALF + m * 16; const float rm = RMS[row];
                    const u32x4 xn = *(const u32x4*)(XB + (size_t)row * D + col0 + bj * HALF);
                    acc[ai][bj][m][0] = (f32x4){__builtin_bit_cast(float, xn.x << 16), __builtin_bit_cast(float, xn.x & 0xffff0000u), __builtin_bit_cast(float, xn.y << 16), __builtin_bit_cast(float, xn.y & 0xffff0000u)} * rm;
                    acc[ai][bj][m][1] = (f32x4){__builtin_bit_cast(float, xn.z << 16), __builtin_bit_cast(float, xn.z & 0xffff0000u), __builtin_bit_cast(float, xn.w << 16), __builtin_bit_cast(float, xn.w & 0xffff0000u)} * rm; }
    }
    DI void operator()(const f32x4 (&acc)[2][2][4][2], const Unit& u, int wr, int wc, int fr, int fq) const {
        const int row0 = u.pm * BM + wr * 64 + fr, col0 = u.pn * BM + wc * 32 + 8 * fq;
        float ssv[8];
#pragma unroll
        for (int ai = 0; ai < 2; ++ai)
#pragma unroll
            for (int m = 0; m < 4; ++m) { const int row = row0 + ai * HALF + m * 16; float ss = 0.f;
#pragma unroll
                for (int bj = 0; bj < 2; ++bj) { const f32x4 v0 = acc[ai][bj][m][0], v1 = acc[ai][bj][m][1];
                    ss += ((v0[0] * v0[0] + v0[1] * v0[1]) + (v0[2] * v0[2] + v0[3] * v0[3])) + ((v1[0] * v1[0] + v1[1] * v1[1]) + (v1[2] * v1[2] + v1[3] * v1[3]));
                    u32x4 w; w.x = cvt_pk_bf16(v0[0], v0[1]); w.y = cvt_pk_bf16(v0[2], v0[3]); w.z = cvt_pk_bf16(v1[0], v1[1]); w.w = cvt_pk_bf16(v1[2], v1[3]);
                    store16_wt(XB + (size_t)row * D + col0 + bj * HALF, w);
                    { int p0_ = 0, p1_ = 0;
                      p0_ = __builtin_amdgcn_cvt_pk_fp8_f32(v0[0], v0[1], p0_, false); p0_ = __builtin_amdgcn_cvt_pk_fp8_f32(v0[2], v0[3], p0_, true);
                      p1_ = __builtin_amdgcn_cvt_pk_fp8_f32(v1[0], v1[1], p1_, false); p1_ = __builtin_amdgcn_cvt_pk_fp8_f32(v1[2], v1[3], p1_, true);
                      u32x2 w8; w8.x = (unsigned)p0_; w8.y = (unsigned)p1_; *(u32x2*)(XB8 + (size_t)row * D + col0 + bj * HALF) = w8; } }
                ssv[ai * 4 + m] = ss; }
#pragma unroll
        for (int i = 0; i < 8; ++i) ssv[i] += __shfl_xor(ssv[i], 16);
#pragma unroll
        for (int i = 0; i < 8; ++i) ssv[i] += __shfl_xor(ssv[i], 32);
        if (fq == 0) {
#pragma unroll
            for (int i = 0; i < 8; ++i) SSQ[(size_t)(row0 + (i >> 2) * HALF + (i & 3) * 16) * 16 + u.pn * 4 + wc] = ssv[i]; }
    }
};
DI float rstd2_of(const float* SSQ, int row) {
    const f32x4 a = *(const f32x4*)(SSQ + (size_t)row * 16), b = *(const f32x4*)(SSQ + (size_t)row * 16 + 4), c = *(const f32x4*)(SSQ + (size_t)row * 16 + 8), d = *(const f32x4*)(SSQ + (size_t)row * 16 + 12);
    const float s = ((a[0] + a[1]) + (a[2] + a[3])) + ((b[0] + b[1]) + (b[2] + b[3])) + ((c[0] + c[1]) + (c[2] + c[3])) + ((d[0] + d[1]) + (d[2] + d[3]));
    return 1.f / sqrtf(s * (1.f / D) + EPS);
}
struct EpiQP {
    static constexpr bool PERM = true, AFTER_DRAIN = false, HAS_INIT = false, CARRY = false;
    bf16_t* QP; float sc = 1.f;
    DI void operator()(const f32x4 (&acc)[2][2][4][2], const Unit& u, int wr, int wc, int fr, int fq) const {
        const int row0 = u.pm * BM + wr * 64 + fr, col0 = u.pn * BM + wc * 32 + 8 * fq;
#pragma unroll
        for (int ai = 0; ai < 2; ++ai)
#pragma unroll
            for (int m = 0; m < 4; ++m) {
#pragma unroll
                for (int bj = 0; bj < 2; ++bj) { const f32x4 v0 = acc[ai][bj][m][0] * sc, v1 = acc[ai][bj][m][1] * sc;
                    u32x4 w; w.x = cvt_pk_bf16(v0[0], v0[1]); w.y = cvt_pk_bf16(v0[2], v0[3]); w.z = cvt_pk_bf16(v1[0], v1[1]); w.w = cvt_pk_bf16(v1[2], v1[3]);
                    *(u32x4*)(QP + frag_off(u.pm, u.pn, 8, wr * 4 + wc, ai * 8 + m * 2 + bj, fq * 16 + fr)) = w; } }
    }
};
}

#define MFMA32(a, b, c) __builtin_amdgcn_mfma_f32_32x32x16_bf16((a), (b), (c), 0, 0, 0)
DI void p2_conv(Frame& F) {
    constexpr int CT = 8;
    const size_t NT_ = (size_t)F.G * NWAVES * 64;
    constexpr size_t PERB = (size_t)(SEQ / CT) * 64;
    const size_t it0 = F.xlocal ? (size_t)F.xq * PERB + (size_t)F.xrank * NWAVES * 64 + F.tid : (size_t)F.vcu * NWAVES * 64 + F.tid;
    const size_t itend = F.xlocal ? (size_t)(F.xq + 1) * PERB : (size_t)(T / CT) * 64, itstep = F.xlocal ? (size_t)(F.G / 8) * NWAVES * 64 : NT_;
    for (size_t item = it0; item < itend; item += itstep) {
        const int tb = (int)(item >> 6) * CT, c0 = (int)(item & 63) * 8, tl = tb & (SEQ - 1);
        v4u cg[CT + 2], uu[CT + 2], bg[CT];
#pragma unroll
        for (int r = 0; r < CT + 2; ++r) { const bool ok = (tl + r - 2) >= 0; const bf16* rowp = F.PA + (size_t)(tb + (ok ? r - 2 : 0)) * PA_W;
            cg[r] = *(const GAS v4u*)(rowp + C_C + c0); uu[r] = *(const GAS v4u*)(rowp + C_U + c0);
            if (!ok) { cg[r] = (v4u){0u, 0u, 0u, 0u}; } }
#pragma unroll
        for (int r = 0; r < CT; ++r) bg[r] = *(const GAS v4u*)(F.PA + (size_t)(tb + r) * PA_W + C_B + c0);
        f32x4 w[3][2];
#pragma unroll
        for (int j = 0; j < 3; ++j) { w[j][0] = *(const GAS f32x4*)(F.w_conv + j * CONV + c0); w[j][1] = *(const GAS f32x4*)(F.w_conv + j * CONV + c0 + 4); }
        float h[CT + 2][8];
#pragma unroll
        for (int r = 0; r < CT + 2; ++r) { h[r][0] = bf_lo(cg[r].x) * bf_lo(uu[r].x); h[r][1] = bf_hi(cg[r].x) * bf_hi(uu[r].x); h[r][2] = bf_lo(cg[r].y) * bf_lo(uu[r].y); h[r][3] = bf_hi(cg[r].y) * bf_hi(uu[r].y);
            h[r][4] = bf_lo(cg[r].z) * bf_lo(uu[r].z); h[r][5] = bf_hi(cg[r].z) * bf_hi(uu[r].z); h[r][6] = bf_lo(cg[r].w) * bf_lo(uu[r].w); h[r][7] = bf_hi(cg[r].w) * bf_hi(uu[r].w); }
#pragma unroll
        for (int r = 0; r < CT; ++r) {
            float a[8];
#pragma unroll
            for (int e = 0; e < 8; ++e) a[e] = w[0][e >> 2][e & 3] * h[r][e] + w[1][e >> 2][e & 3] * h[r + 1][e] + w[2][e >> 2][e & 3] * h[r + 2][e];
            v4u o; o.x = pk2(a[0] * bf_lo(bg[r].x), a[1] * bf_hi(bg[r].x)); o.y = pk2(a[2] * bf_lo(bg[r].y), a[3] * bf_hi(bg[r].y));
            o.z = pk2(a[4] * bf_lo(bg[r].z), a[5] * bf_hi(bg[r].z)); o.w = pk2(a[6] * bf_lo(bg[r].w), a[7] * bf_hi(bg[r].w));
            *(GAS v4u*)(F.Z + (size_t)(tb + r) * CONV + c0) = o;
        }
    }
}
DI int t5_bucket(int d) {
    if (d < 16) return d;
    const int large = 16 + (int)(logf((float)d / 16.f) / logf(8.f) * 16.f);
    return large < 31 ? large : 31;
}
constexpr float LOG2E = 1.4426950408889634f;
constexpr int KS_STRIDE = 72, VT_STRIDE = 264;
constexpr int ATT_KS = 0, ATT_VT = 256 * KS_STRIDE * 2, ATT_BIAS = ATT_VT + 64 * VT_STRIDE * 2, ATT_END = ATT_BIAS + 4 * 128 * 4;
static_assert(ATT_END <= RING_BYTES, "attention LDS");
DI void p2_attention(Frame& F) {
    LAS bf16* KS = (LAS bf16*)(F.lds + ATT_KS); LAS bf16* VT = (LAS bf16*)(F.lds + ATT_VT); LAS float* BIAS = (LAS float*)(F.lds + ATT_BIAS);
    const int lane = F.lane, r = lane & 31, hh = lane >> 5;
#pragma unroll 1
    for (int unit = F.xlocal ? F.xq * 32 * NKV + F.xrank : F.vcu, uend = F.xlocal ? (F.xq + 1) * 32 * NKV : 8 * 32 * NKV, ustep = F.xlocal ? F.G / 8 : F.G; unit < uend; unit += ustep) {
        const int kv = unit & 1, n = (unit >> 1) & 31, b = unit >> 6;
        const int t0 = b * SEQ + n * 128;
        __syncthreads();
        {
            const int j = F.tid >> 1, hf = F.tid & 1; const bool valid = (n > 0) || (j >= 128);
            const bf16* rowp = F.PA + (size_t)(t0 - 128 + j) * PA_W;
            v4u kq[4], vq[4];
#pragma unroll
            for (int i = 0; i < 4; ++i) { kq[i] = (v4u){0u, 0u, 0u, 0u}; vq[i] = kq[i]; }
            if (valid) {
#pragma unroll
                for (int i = 0; i < 4; ++i) { kq[i] = *(const GAS v4u*)(rowp + C_K + kv * HD + hf * 32 + i * 8); vq[i] = *(const GAS v4u*)(rowp + C_V + kv * HD + hf * 32 + i * 8); }
            }
            float kf[32]; float ss = 0.f;
#pragma unroll
            for (int i = 0; i < 4; ++i) { kf[8 * i + 0] = bf_lo(kq[i].x); kf[8 * i + 1] = bf_hi(kq[i].x); kf[8 * i + 2] = bf_lo(kq[i].y); kf[8 * i + 3] = bf_hi(kq[i].y);
                kf[8 * i + 4] = bf_lo(kq[i].z); kf[8 * i + 5] = bf_hi(kq[i].z); kf[8 * i + 6] = bf_lo(kq[i].w); kf[8 * i + 7] = bf_hi(kq[i].w); }
#pragma unroll
            for (int e = 0; e < 32; ++e) ss += kf[e] * kf[e];
            ss += __shfl_xor(ss, 1);
            const float rs = 1.f / sqrtf(ss * (1.f / HD) + EPS);
#pragma unroll
            for (int i = 0; i < 4; ++i) { const f32x4 g0 = *(const GAS f32x4*)(F.k_norm + hf * 32 + 8 * i), g1 = *(const GAS f32x4*)(F.k_norm + hf * 32 + 8 * i + 4);
                v4u o; o.x = pk2(kf[8 * i + 0] * rs * g0[0], kf[8 * i + 1] * rs * g0[1]); o.y = pk2(kf[8 * i + 2] * rs * g0[2], kf[8 * i + 3] * rs * g0[3]);
                o.z = pk2(kf[8 * i + 4] * rs * g1[0], kf[8 * i + 5] * rs * g1[1]); o.w = pk2(kf[8 * i + 6] * rs * g1[2], kf[8 * i + 7] * rs * g1[3]);
                *(LAS v4u*)(KS + j * KS_STRIDE + hf * 32 + 8 * i) = o; }
#pragma unroll
            for (int i = 0; i < 4; ++i) { const int d0 = hf * 32 + 8 * i;
                VT[(d0 + 0) * VT_STRIDE + j] = (bf16)(vq[i].x & 0xffffu); VT[(d0 + 1) * VT_STRIDE + j] = (bf16)(vq[i].x >> 16);
                VT[(d0 + 2) * VT_STRIDE + j] = (bf16)(vq[i].y & 0xffffu); VT[(d0 + 3) * VT_STRIDE + j] = (bf16)(vq[i].y >> 16);
                VT[(d0 + 4) * VT_STRIDE + j] = (bf16)(vq[i].z & 0xffffu); VT[(d0 + 5) * VT_STRIDE + j] = (bf16)(vq[i].z >> 16);
                VT[(d0 + 6) * VT_STRIDE + j] = (bf16)(vq[i].w & 0xffffu); VT[(d0 + 7) * VT_STRIDE + j] = (bf16)(vq[i].w >> 16); }
            { const int g = F.tid >> 7, dist = F.tid & 127; BIAS[F.tid] = F.rel_bias[t5_bucket(dist) * NH + kv * 4 + g] * LOG2E; }
        }
        __syncthreads();
#pragma unroll 1
        for (int task = F.wave; task < 16; task += NWAVES) {
            const int g = task >> 2, c = task & 3, head = kv * 4 + g, r0 = 32 * c;
            bf16x8 qf[4];
            {
                const bf16* qp = F.PA + (size_t)(t0 + r0 + r) * PA_W + C_Q + head * HD + 8 * hh;
                v4u qq[4]; float qv[32]; float ss = 0.f;
#pragma unroll
                for (int s = 0; s < 4; ++s) qq[s] = *(const GAS v4u*)(qp + 16 * s);
#pragma unroll
                for (int s = 0; s < 4; ++s) { qv[8 * s + 0] = bf_lo(qq[s].x); qv[8 * s + 1] = bf_hi(qq[s].x); qv[8 * s + 2] = bf_lo(qq[s].y); qv[8 * s + 3] = bf_hi(qq[s].y);
                    qv[8 * s + 4] = bf_lo(qq[s].z); qv[8 * s + 5] = bf_hi(qq[s].z); qv[8 * s + 6] = bf_lo(qq[s].w); qv[8 * s + 7] = bf_hi(qq[s].w); }
#pragma unroll
                for (int e = 0; e < 32; ++e) ss += qv[e] * qv[e];
                ss += __shfl_xor(ss, 32);
                const float rs = 0.125f * LOG2E / sqrtf(ss * (1.f / HD) + EPS);
#pragma unroll
                for (int s = 0; s < 4; ++s) { const f32x4 g0 = *(const GAS f32x4*)(F.q_norm + 16 * s + 8 * hh), g1 = *(const GAS f32x4*)(F.q_norm + 16 * s + 8 * hh + 4);
                    v4u o; o.x = pk2(qv[8 * s + 0] * rs * g0[0], qv[8 * s + 1] * rs * g0[1]); o.y = pk2(qv[8 * s + 2] * rs * g0[2], qv[8 * s + 3] * rs * g0[3]);
                    o.z = pk2(qv[8 * s + 4] * rs * g1[0], qv[8 * s + 5] * rs * g1[1]); o.w = pk2(qv[8 * s + 6] * rs * g1[2], qv[8 * s + 7] * rs * g1[3]);
                    qf[s] = __builtin_bit_cast(bf16x8, o); }
            }
            const int dbase = r - 4 * hh + 128;
            const LAS float* bl = BIAS + g * 128;
            f32x16 sacc[5];
#pragma unroll
            for (int i5 = 0; i5 < 5; ++i5) {
#pragma unroll
                for (int e = 0; e < 16; ++e) sacc[i5][e] = bl[(dbase - 32 * i5 - ((e & 3) + 8 * (e >> 2))) & 127];
                const int kt = c + i5;
#pragma unroll
                for (int s = 0; s < 4; ++s) { const bf16x8 ka = *(const LAS bf16x8*)(KS + (32 * kt + r) * KS_STRIDE + 16 * s + 8 * hh); sacc[i5] = MFMA32(ka, qf[s], sacc[i5]); }
            }
            const float sink = F.sinks[head] * LOG2E;
            float mx = sink;
#pragma unroll
            for (int i5 = 0; i5 < 5; ++i5) {
                const bool tile_ok = (n > 0) || (c + i5 >= 4);
#pragma unroll
                for (int e = 0; e < 16; ++e) { const int dist = dbase - 32 * i5 - ((e & 3) + 8 * (e >> 2));
                    bool valid = tile_ok; if (i5 == 0) valid = valid && (dist < 128); if (i5 == 4) valid = valid && (dist >= 0);
                    sacc[i5][e] = valid ? sacc[i5][e] : -INFINITY; mx = fmaxf(mx, sacc[i5][e]); }
                __builtin_amdgcn_sched_barrier(0);
            }
            mx = fmaxf(mx, __shfl_xor(mx, 32));
            float sum = 0.f;
#pragma unroll
            for (int i5 = 0; i5 < 5; ++i5)
#pragma unroll
                for (int e = 0; e < 16; ++e) { const float p = __builtin_amdgcn_exp2f(sacc[i5][e] - mx); sacc[i5][e] = p; sum += p; }
            sum += __shfl_xor(sum, 32);
            const float inv = 1.f / (sum + __builtin_amdgcn_exp2f(sink - mx));
            f32x16 oacc[2];
#pragma unroll
            for (int dt = 0; dt < 2; ++dt)
#pragma unroll
                for (int e = 0; e < 16; ++e) oacc[dt][e] = 0.f;
#pragma unroll
            for (int i5 = 0; i5 < 5; ++i5)
#pragma unroll
                for (int s2 = 0; s2 < 2; ++s2) {
                    v4u pp; pp.x = pk2(sacc[i5][8 * s2 + 0], sacc[i5][8 * s2 + 1]); pp.y = pk2(sacc[i5][8 * s2 + 2], sacc[i5][8 * s2 + 3]);
                    pp.z = pk2(sacc[i5][8 * s2 + 4], sacc[i5][8 * s2 + 5]); pp.w = pk2(sacc[i5][8 * s2 + 6], sacc[i5][8 * s2 + 7]);
                    const bf16x8 pb = __builtin_bit_cast(bf16x8, pp);
                    const int kb = 32 * (c + i5) + 16 * s2 + 4 * hh;
#pragma unroll
                    for (int dt = 0; dt < 2; ++dt) {
                        const v2u lo = *(const LAS v2u*)(VT + (32 * dt + r) * VT_STRIDE + kb), hi = *(const LAS v2u*)(VT + (32 * dt + r) * VT_STRIDE + kb + 8);
                        v4u va; va.x = lo.x; va.y = lo.y; va.z = hi.x; va.w = hi.y;
                        oacc[dt] = MFMA32(__builtin_bit_cast(bf16x8, va), pb, oacc[dt]);
                    }
                    __builtin_amdgcn_sched_barrier(0);
                }
            bf16* op = F.ATT + (size_t)(t0 + r0 + r) * CONV + head * HD;
#pragma unroll
            for (int dt = 0; dt < 2; ++dt)
#pragma unroll
                for (int g4 = 0; g4 < 4; ++g4) { v2u w; w.x = pk2(oacc[dt][4 * g4 + 0] * inv, oacc[dt][4 * g4 + 1] * inv); w.y = pk2(oacc[dt][4 * g4 + 2] * inv, oacc[dt][4 * g4 + 3] * inv);
#ifdef ZERO_ATT
                    w.x = 0u; w.y = 0u;
#endif
                    *(GAS v2u*)(op + 32 * dt + 8 * g4 + 4 * hh) = w; }
        }
    }
}

DI size_t tok_slab(int t, size_t slab, int row) { return (size_t)(t >> 12) * slab + (size_t)(t & (SEQ - 1)) * row; }
constexpr size_t IDX_SLAB = ((size_t)4 << 20) / 2, GATE_SLAB = ((size_t)4 << 20) / 4;
DI unsigned f2ord(float f) { const unsigned b = __builtin_bit_cast(unsigned, f); return b ^ ((unsigned)((int)b >> 31) | 0x80000000u); }
DI float ord2f(unsigned k) { const unsigned b = k ^ ((k >> 31) ? 0x80000000u : 0xffffffffu); return __builtin_bit_cast(float, b); }
DI unsigned umax_(unsigned a, unsigned b) { return a > b ? a : b; }
DI unsigned umin_(unsigned a, unsigned b) { return a < b ? a : b; }
DI void sort16_desc(unsigned (&v)[16]) {
#pragma unroll
    for (int p = 1; p < 16; p *= 2)
#pragma unroll
        for (int k = p; k >= 1; k /= 2)
#pragma unroll
            for (int j = k % p; j <= 16 - 1 - k; j += 2 * k)
#pragma unroll
                for (int i = 0; i <= (k - 1 < 16 - j - k - 1 ? k - 1 : 16 - j - k - 1); ++i)
                    if ((i + j) / (2 * p) == (i + j + k) / (2 * p)) { const unsigned a = v[i + j], b = v[i + j + k]; v[i + j] = umax_(a, b); v[i + j + k] = umin_(a, b); }
}
DI void merge_top16(unsigned (&a)[16], const unsigned (&b)[16]) {
#pragma unroll
    for (int i = 0; i < 16; ++i) a[i] = umax_(a[i], b[15 - i]);
#pragma unroll
    for (int j = 8; j > 0; j >>= 1)
#pragma unroll
        for (int i = 0; i < 16; ++i) { const int l = i ^ j; if (l > i) { const unsigned x = a[i], y = a[l]; a[i] = umax_(x, y); a[l] = umin_(x, y); } }
}
constexpr int SK_STRIDE = 136;
constexpr int P6_KEYS = 0, P6_IB = 2 * NKEYS * SK_STRIDE * 2, P6_END = P6_IB + NWAVES * 64 * 32;
static_assert(P6_END <= RING_BYTES, "topk LDS");
DI void p6_topk(Frame& F) {
    LAS bf16* KL = (LAS bf16*)(F.lds + P6_KEYS); LAS unsigned char* IB = F.lds + P6_IB + (F.wave * 64 + F.lane) * 32;
    const int lane = F.lane, r = lane & 31, hh = lane >> 5;
    pg8::StaticOrder S; S.init(T, PQ, F.G, F.cvirt);
    pg8::Unit pu;
    for (int ui = 0; S.next(ui, pu); ++ui) {
        const int h = pu.pn, tile = pu.pm;
        const int rt = F.wave * 32 + r, q_ai = rt >> 7, q_wr = (rt >> 6) & 1, q_m = (rt >> 4) & 3, q_fr = rt & 15;
        bf16x8 qf0[8];
#pragma unroll
        for (int s = 0; s < 8; ++s) qf0[s] = __builtin_bit_cast(bf16x8, *(const GAS v4u*)(F.QP + pg8::frag_off(tile, h, 8, q_wr * 4 + (s >> 1), q_ai * 8 + q_m * 2 + 0, (2 * (s & 1) + hh) * 16 + q_fr)));
        __syncthreads();
        {
            const bf16* src = F.SK + (size_t)h * 2 * NKEYS * 128;
#pragma unroll
            for (int i = 0; i < 8; ++i) { const int ch = F.tid + 512 * i; const int row = ch >> 4, c8 = (ch & 15) * 8;
                *(LAS v4u*)(KL + row * SK_STRIDE + c8) = *(const GAS v4u*)(src + (size_t)row * 128 + c8); }
        }
        __syncthreads();
        const int t = tile * 256 + F.wave * 32 + r;
        unsigned S[2][16];
#pragma unroll
        for (int p = 0; p < 2; ++p) {
            bf16x8 qf[8];
#pragma unroll
            for (int s = 0; s < 8; ++s) qf[s] = (p == 0) ? qf0[s] : __builtin_bit_cast(bf16x8, *(const GAS v4u*)(F.QP + pg8::frag_off(tile, h, 8, q_wr * 4 + (s >> 1), q_ai * 8 + q_m * 2 + p, (2 * (s & 1) + hh) * 16 + q_fr)));
            unsigned key[4][16];
#pragma unroll
            for (int kt = 0; kt < 4; ++kt) {
                f32x16 acc;
#pragma unroll
                for (int e = 0; e < 16; ++e) acc[e] = 0.f;
#pragma unroll
                for (int s = 0; s < 8; ++s) { const bf16x8 ka = *(const LAS bf16x8*)(KL + (p * NKEYS + 32 * kt + r) * SK_STRIDE + 16 * s + 8 * hh); acc = MFMA32(ka, qf[s], acc); }
#pragma unroll
                for (int e = 0; e < 16; ++e) { const int nk = 32 * kt + (e & 3) + 8 * (e >> 2) + 4 * hh; key[kt][e] = (f2ord(acc[e]) & ~127u) | (unsigned)(127 - nk); }
            }
#pragma unroll
            for (int kt = 0; kt < 4; ++kt) sort16_desc(key[kt]);
            merge_top16(key[0], key[1]); merge_top16(key[2], key[3]); merge_top16(key[0], key[2]);
            unsigned other[16];
#pragma unroll
            for (int i = 0; i < 16; ++i) other[i] = (unsigned)__shfl_xor((int)key[0][i], 32);
            merge_top16(key[0], other);
#pragma unroll
            for (int i = 0; i < 16; ++i) S[p][i] = key[0][i];
        }
        float s0[16], s1[16]; const float rs2 = pg8::rstd2_of(F.SSQ, t);
#pragma unroll
        for (int i = 0; i < 16; ++i) { s0[i] = ord2f(S[0][i] & ~127u) * rs2; s1[i] = ord2f(S[1][i] & ~127u) * rs2; }
        {
#pragma unroll
            for (int q4 = 0; q4 < 4; ++q4) { unsigned w0 = 0, w1 = 0;
#pragma unroll
                for (int e = 0; e < 4; ++e) { w0 |= (127u - (S[0][4 * q4 + e] & 127u)) << (8 * e); w1 |= (127u - (S[1][4 * q4 + e] & 127u)) << (8 * e); }
                *(LAS unsigned*)(IB + 4 * q4) = w0; *(LAS unsigned*)(IB + 16 + 4 * q4) = w1; }
        }
        unsigned cand[2][16];
#pragma unroll
        for (int i = 0; i < 2; ++i)
#pragma unroll
            for (int e = 0; e < 16; ++e) cand[i][e] = 0u;
        {
            int cnt = 0; float ea = 0.f, eb = 0.f; int ep = 0;
#pragma unroll
            for (int a = 0; a < 16; ++a)
#pragma unroll
                for (int b = 0; b < 16; ++b)
                    if ((a + 1) * (b + 1) <= 16) {
                        if ((cnt & 1) == 0) { ea = s0[a]; eb = s1[b]; ep = 255 - (a * 16 + b); }
                        else { const int slot = cnt >> 1; const float sa = hh ? s0[a] : ea, sb = hh ? s1[b] : eb; const int pp = hh ? 255 - (a * 16 + b) : ep;
                            cand[slot & 1][slot >> 1] = (f2ord(sa + sb) & ~255u) | (unsigned)pp; }
                        ++cnt; }
        }
        sort16_desc(cand[0]); sort16_desc(cand[1]); merge_top16(cand[0], cand[1]);
        {
            unsigned other[16];
#pragma unroll
            for (int i = 0; i < 16; ++i) other[i] = (unsigned)__shfl_xor((int)cand[0][i], 32);
            merge_top16(cand[0], other);
        }
        float gv[16]; int ev[16]; float gsum = 0.f; const float gmx = ord2f(cand[0][0] & ~255u);
#pragma unroll
        for (int i = 0; i < 16; ++i) { const unsigned k = cand[0][i]; const int pos = 255 - (int)(k & 255u); const int a = pos >> 4, b = pos & 15;
            ev[i] = (int)IB[a] * NKEYS + (int)IB[16 + b]; gv[i] = __expf(ord2f(k & ~255u) - gmx); gsum += gv[i]; }
        float ginv = 1.f / gsum;
#ifdef UNIFORM_GATES
#pragma unroll
        for (int i = 0; i < 16; ++i) gv[i] = 1.f;
        ginv = 1.f / 16.f;
#endif
        if (hh == 0) {
            unsigned short* ip = F.IDX + tok_slab(t, IDX_SLAB, NSEL) + h * TOPK; float* gp = F.GATE + tok_slab(t, GATE_SLAB, NSEL) + h * TOPK;
#pragma unroll
            for (int i = 0; i < 2; ++i) *(GAS v4i*)(ip + 8 * i) = (v4i){ev[8 * i] | (ev[8 * i + 1] << 16), ev[8 * i + 2] | (ev[8 * i + 3] << 16), ev[8 * i + 4] | (ev[8 * i + 5] << 16), ev[8 * i + 6] | (ev[8 * i + 7] << 16)};
#pragma unroll
            for (int i = 0; i < 4; ++i) *(GAS f32x4*)(gp + 4 * i) = (f32x4){gv[4 * i] * ginv, gv[4 * i + 1] * ginv, gv[4 * i + 2] * ginv, gv[4 * i + 3] * ginv};
        }
    }
}

typedef float f32x2_t __attribute__((ext_vector_type(2)));
DI void fp8x16_to_f32(v4u q, float (&f)[16]) {
#pragma unroll
    for (int w = 0; w < 4; ++w) { const f32x2_t lo = __builtin_amdgcn_cvt_pk_f32_fp8((int)q[w], false), hi = __builtin_amdgcn_cvt_pk_f32_fp8((int)q[w], true);
        f[4 * w + 0] = lo.x; f[4 * w + 1] = lo.y; f[4 * w + 2] = hi.x; f[4 * w + 3] = hi.y; }
}
struct XccInfo { int q, nx, nloc, rank, uni; };
DI void xcc_info_build(const XcdBarrier& b) {
    if (threadIdx.x == 0) {
        unsigned q = 0, nx = 0, nloc = 1, uni = 1; const unsigned G8 = gridDim.x / 8u;
        for (unsigned j = 0; j < 16; ++j) { const unsigned c = xb_ld(&b.bar[XB_XCNT(j)]); if (c > 0u) { if (j < b.x) ++q; ++nx; if (c != G8) uni = 0u; } if (j == b.x) nloc = c; }
        b.st[3] = q; b.st[4] = nx > 0u ? nx : 1u; b.st[5] = nloc > 0u ? nloc : 1u;
        b.st[7] = (uni && nx == 8u && (gridDim.x % 8u) == 0u && b.st[0] == G8) ? 1u : 0u;
    }
    __syncthreads();
}
DI XccInfo xcc_info(const XcdBarrier& b) {
    XccInfo I; I.rank = __builtin_amdgcn_readfirstlane((int)b.st[2]); I.q = __builtin_amdgcn_readfirstlane((int)b.st[3]); I.nx = __builtin_amdgcn_readfirstlane((int)b.st[4]); I.nloc = __builtin_amdgcn_readfirstlane((int)b.st[5]); I.uni = __builtin_amdgcn_readfirstlane((int)b.st[7]);
    return I;
}
DI float dpp_sum8(float s) {
    s += __builtin_bit_cast(float, __builtin_amdgcn_update_dpp(0, __builtin_bit_cast(int, s), 0xB1, 0xf, 0xf, false));
    s += __builtin_bit_cast(float, __builtin_amdgcn_update_dpp(0, __builtin_bit_cast(int, s), 0x4E, 0xf, 0xf, false));
    s += __builtin_bit_cast(float, __builtin_amdgcn_update_dpp(0, __builtin_bit_cast(int, s), 0x141, 0xf, 0xf, false));
    return s;
}
typedef long i64_t;
typedef long i64x2 __attribute__((ext_vector_type(2)));
typedef int v4i_t __attribute__((ext_vector_type(4)));
typedef int v8i_t __attribute__((ext_vector_type(8)));
constexpr int PEER_ROW = 144, PEER_WAVE_LDS = 128 * PEER_ROW;
constexpr int MX_ONE = 0x7f7f7f7f;
#define PEER_ID(ia_, ib_, ld_) ((((ld_) < 8 ? ia_ : ib_)[((ld_) & 7) >> 1] >> (16 * ((ld_) & 1))) & 0xffffu)
#define QB1(v_, c_) ((unsigned)__builtin_amdgcn_update_dpp(0, (int)(v_), (c_), 0xf, 0xf, false))
#define QB4(d_, s_, c_) do { d_.x = QB1(s_.x, c_); d_.y = QB1(s_.y, c_); d_.z = QB1(s_.z, c_); d_.w = QB1(s_.w, c_); } while (0)
#define P7_IDS(t_, ir_) do { const unsigned short* ip_ = F.IDX + tok_slab((t_), IDX_SLAB, NSEL) + 16 * row8 + 4 * (lane & 3); ir_ = *(const GAS v2u*)(ip_); } while (0)
#define P7_ISSUE(t_, ir_, uq_, x_) do { \
        const unsigned char* xr_ = F.XB8 + (size_t)(t_) * D + sl * 256 + 16 * g + 64 * (lane & 3);   \
        x_ = *(const GAS v4u*)(xr_); \
        v4u ia_, ib_; ia_.x = QB1(ir_.x, 0x00); ia_.y = QB1(ir_.y, 0x00); ia_.z = QB1(ir_.x, 0x55); ia_.w = QB1(ir_.y, 0x55); ib_.x = QB1(ir_.x, 0xAA); ib_.y = QB1(ir_.y, 0xAA); ib_.z = QB1(ir_.x, 0xFF); ib_.w = QB1(ir_.y, 0xFF); \
        _Pragma("unroll") for (int ld = 0; ld < 16; ++ld) { const unsigned e_ = PEER_ID(ia_, ib_, ld); uq_[ld] = *(const GAS v4u*)(Us + (unsigned)(e_ * 128u + 16u * c8)); } } while (0)
#define P7_COMPUTE(t_, uq_, x_) do { \
        _Pragma("unroll") for (int ld = 0; ld < 16; ++ld) *(LAS v4u*)(wl + (16 * row8 + ld) * PEER_ROW + 16 * c8) = uq_[ld]; \
        v8i_t xb0_, xb1_; \
        { v4u q0_, q1_, q2_, q3_; QB4(q0_, x_, 0x00); QB4(q1_, x_, 0x55); QB4(q2_, x_, 0xAA); QB4(q3_, x_, 0xFF); \
        xb0_[0] = (int)q0_.x; xb0_[1] = (int)q0_.y; xb0_[2] = (int)q0_.z; xb0_[3] = (int)q0_.w; xb0_[4] = (int)q1_.x; xb0_[5] = (int)q1_.y; xb0_[6] = (int)q1_.z; xb0_[7] = (int)q1_.w; \
        xb1_[0] = (int)q2_.x; xb1_[1] = (int)q2_.y; xb1_[2] = (int)q2_.z; xb1_[3] = (int)q2_.w; xb1_[4] = (int)q3_.x; xb1_[5] = (int)q3_.y; xb1_[6] = (int)q3_.z; xb1_[7] = (int)q3_.w; } \
        f32x4 keep = {0.f, 0.f, 0.f, 0.f}; \
        _Pragma("unroll") for (int j = 0; j < 8; ++j) { f32x4 c_ = {0.f, 0.f, 0.f, 0.f}; \
            const v4i_t a0_ = *(const LAS v4i_t*)(wl + (16 * j + m) * PEER_ROW + 16 * g), a1_ = *(const LAS v4i_t*)(wl + (16 * j + m) * PEER_ROW + 64 + 16 * g); \
            v8i_t A0_ = {a0_[0], a0_[1], a0_[2], a0_[3], 0, 0, 0, 0}, A1_ = {a1_[0], a1_[1], a1_[2], a1_[3], 0, 0, 0, 0}; \
            c_ = __builtin_amdgcn_mfma_scale_f32_16x16x128_f8f6f4(A0_, xb0_, c_, 4, 0, 0, MX_ONE, 0, MX_ONE); \
            c_ = __builtin_amdgcn_mfma_scale_f32_16x16x128_f8f6f4(A1_, xb1_, c_, 4, 0, 0, MX_ONE, 0, MX_ONE); \
            keep = (m == j) ? c_ : keep; } \
        { const bool ok_ = (m < 8) && ((t_) < T); bf16* dst_ = ok_ ? F.PARTB + ((size_t)sl * T + (t_)) * NSEL + 16 * m + 4 * g : F.PARTB + (size_t)8 * T * NSEL + 4 * lane; \
          v2u w_; w_.x = pk2(keep[0], keep[1]); w_.y = pk2(keep[2], keep[3]); *(GAS v2u*)dst_ = w_; } } while (0)
constexpr int CR = 8;
DI void convert_fp4_wave(const float* src, unsigned char* dst, float* scl, int e0, int e1, int lane) {
#pragma unroll 1
    for (int e = e0; e < e1; e += CR) {
        f32x4 v[CR][4]; float mx[CR];
#pragma unroll
        for (int r = 0; r < CR; ++r) { const f32x4* rp = (const f32x4*)(src + (size_t)(e + r) * D) + lane;
#pragma unroll
            for (int q = 0; q < 4; ++q) v[r][q] = __builtin_nontemporal_load(rp + 64 * q); }
#pragma unroll
        for (int r = 0; r < CR; ++r) { mx[r] = 0.f;
#pragma unroll
            for (int q = 0; q < 4; ++q) mx[r] = fmaxf(mx[r], fmaxf(fmaxf(fabsf(v[r][q][0]), fabsf(v[r][q][1])), fmaxf(fabsf(v[r][q][2]), fabsf(v[r][q][3])))); }
#pragma unroll
        for (int o = 1; o < 64; o <<= 1)
#pragma unroll
            for (int r = 0; r < CR; ++r) mx[r] = fmaxf(mx[r], __shfl_xor(mx[r], o));
#pragma unroll
        for (int r = 0; r < CR; ++r) { const float inv = mx[r] > 0.f ? 6.f / mx[r] : 0.f;
            if (lane == 0) scl[e + r] = mx[r] * (1.f / 6.f);
#pragma unroll
            for (int q = 0; q < 4; ++q) { unsigned rr = 0u;
                rr = __builtin_amdgcn_cvt_scalef32_pk_fp4_f32(rr, v[r][q][0] * inv, v[r][q][1] * inv, 1.0f, 0);
                rr = __builtin_amdgcn_cvt_scalef32_pk_fp4_f32(rr, v[r][q][2] * inv, v[r][q][3] * inv, 1.0f, 1);
                const unsigned pr = QB1(rr, 0xB1), ev = (lane & 1) ? pr : rr, od = (lane & 1) ? rr : pr; const int ja = (lane & 1) * 2;
                GAS unsigned char* bp = (GAS unsigned char*)(dst + ((size_t)q * NEXP + (e + r)) * 128 + 8 * (lane >> 4) + ((lane & 15) >> 1));
                bp[32 * ja] = (unsigned char)(((ev >> (4 * ja)) & 0xfu) | (((od >> (4 * ja)) & 0xfu) << 4));
                bp[32 * (ja + 1)] = (unsigned char)(((ev >> (4 * ja + 4)) & 0xfu) | (((od >> (4 * ja + 4)) & 0xfu) << 4)); } }
    }
}
DI int peer_next(volatile LAS unsigned* ctr, int lane) { unsigned k = 0u; if (lane == 0) k = __hip_atomic_fetch_add((LAS unsigned*)ctr, 1u, __ATOMIC_RELAXED, __HIP_MEMORY_SCOPE_WORKGROUP); return __builtin_amdgcn_readfirstlane((int)k); }
DI int peer_tok(int tbase, int tstride, int k) { return tbase + (k & 7) + (k >> 3) * tstride; }
DI void p7_udot(Frame& F, const XccInfo& I) {
    const int lane = F.lane, g = lane >> 4, m = lane & 15, row8 = lane >> 3, c8 = lane & 7;
    LAS unsigned char* wl = F.lds + F.wave * PEER_WAVE_LDS;
    const unsigned char* U4 = (const unsigned char*)F.UB;
    const int tstride = I.nloc * NWAVES, tbase = I.rank * NWAVES;
    if (F.wave == NWAVES - 1) for (int ch = (int)blockIdx.x; ch < NEXP / 64; ch += F.G) convert_fp4_wave(F.expert_v, (unsigned char*)F.VB, F.SV, ch * 64, ch * 64 + 64, lane);
    int it = 0;
    for (int share = I.q; share < 8; share += I.nx, ++it) {
        const int sl = share >> 1, half = share & 1;
        const unsigned char* Us = U4 + (size_t)sl * NEXP * 128;
        volatile LAS unsigned* ctr = F.MISC + 16 + it;
#define CL(t_) ((t_) < T ? (t_) : T - 1)
#define TOK(k_) (2 * peer_tok(tbase, tstride, (k_)) + half)
        v4u uqA[16], uqB[16]; v2u iA, iB;
        int kk = peer_next(ctr, lane); int tA = TOK(kk); kk = peer_next(ctr, lane); int tB = TOK(kk);
        {
            v4u xA, xB;
            P7_IDS(CL(tA), iA);
            P7_ISSUE(CL(tA), iA, uqA, xA);
            P7_IDS(CL(tB), iB);
#pragma unroll 1
            while (tA < T) {
                kk = peer_next(ctr, lane); const int tC = TOK(kk); kk = peer_next(ctr, lane); const int tD = TOK(kk);
                P7_IDS(CL(tC), iA);
                P7_ISSUE(CL(tB), iB, uqB, xB);
                P7_COMPUTE(tA, uqA, xA);
                P7_IDS(CL(tD), iB);
                P7_ISSUE(CL(tC), iA, uqA, xA);
                P7_COMPUTE(tB, uqB, xB);
                tA = tC; tB = tD;
            }
        }
#undef TOK
#undef CL
    }
}
DI void p8_act(Frame& F) {
    const size_t NT_ = (size_t)F.G * NWAVES * 64;
    LAS float* su = (LAS float*)F.lds; LAS float* sv = su + NEXP;
    { f32x4 fu[8], fv[8];
#pragma unroll
      for (int i = 0; i < 8; ++i) { fu[i] = *(const GAS f32x4*)(F.SU + 4 * (F.tid + 512 * i)); fv[i] = *(const GAS f32x4*)(F.SV + 4 * (F.tid + 512 * i)); }
#pragma unroll
      for (int i = 0; i < 8; ++i) { *(LAS f32x4*)(su + 4 * (F.tid + 512 * i)) = fu[i]; *(LAS f32x4*)(sv + 4 * (F.tid + 512 * i)) = fv[i]; } }
    __syncthreads();
    for (size_t item = (size_t)F.vcu * NWAVES * 64 + F.tid; item < (size_t)T * NSEL / 4; item += NT_) {
        const int t = (int)(item >> 5);
        f32x4 s = {0.f, 0.f, 0.f, 0.f}, vs4;
#pragma unroll
        for (int sl = 0; sl < 4; ++sl) { const v2u p = *(const GAS v2u*)(F.PARTB + (size_t)sl * T * NSEL + item * 4); s = s + (f32x4){bf_lo(p.x), bf_hi(p.x), bf_lo(p.y), bf_hi(p.y)}; }
        { const v2u ids = *(const GAS v2u*)(F.IDX + tok_slab(t, IDX_SLAB, NSEL) + (item & 31) * 4);
          s[0] *= su[ids.x & 0xffffu]; s[1] *= su[ids.x >> 16]; s[2] *= su[ids.y & 0xffffu]; s[3] *= su[ids.y >> 16];
          vs4 = (f32x4){sv[ids.x & 0xffffu], sv[ids.x >> 16], sv[ids.y & 0xffffu], sv[ids.y >> 16]}; }
        const float rs2 = pg8::rstd2_of(F.SSQ, t);
        const f32x4 g = *(const GAS f32x4*)(F.GATE + tok_slab(t, GATE_SLAB, NSEL) + (item & 31) * 4);
        f32x4 o;
#pragma unroll
        for (int e = 0; e < 4; e += 2) { pg8::f32x2 pre; pre.x = s[e] * rs2; pre.y = s[e + 1] * rs2; const pg8::f32x2 ge = pg8::gelu_pk(pre);
            o[e] = ge.x * g[e] * vs4[e] * A_SCALE; o[e + 1] = ge.y * g[e + 1] * vs4[e + 1] * A_SCALE; }
        ((GAS unsigned*)F.ACT)[item] = pk4_fp8(o);
    }
}
typedef int v2i_t __attribute__((ext_vector_type(2)));
#define P9_IDS(t_, ak_, xr_) do {   \
        const unsigned char* ip_ = (const unsigned char*)(F.IDX + tok_slab((t_), IDX_SLAB, NSEL) + 16 * row8 + 8 * (lane & 1)); \
        const unsigned char* ap_ = (const unsigned char*)F.ACT + (size_t)(t_) * NSEL + 16 * g + 64 * (lane & 1); \
        ak_ = *(const GAS v4u*)((lane & 2) ? ap_ : ip_); \
        xr_ = *(const GAS v2u*)(F.XB + (size_t)(t_) * D + sl * 256 + 4 * lane); } while (0)
#define P9_ISSUE(ir_, vq_) do { \
        v4u ia_, ib_; QB4(ia_, ir_, 0x00); QB4(ib_, ir_, 0x55); \
        _Pragma("unroll") for (int ld = 0; ld < 16; ++ld) { const unsigned e_ = PEER_ID(ia_, ib_, ld); vq_[ld] = *(const GAS v4u*)(Vs + (unsigned)(e_ * 128u + 16u * c8)); } } while (0)
#define P9_WRITE(vq_) do { _Pragma("unroll") for (int ld = 0; ld < 16; ++ld) *(LAS v4u*)(wl + (16 * row8 + ld) * PEER_ROW + 16 * c8) = vq_[ld]; } while (0)
#define P9_MATH(t_, ak_, xr_) do { \
        v4u k0_, k1_; QB4(k0_, ak_, 0xAA); QB4(k1_, ak_, 0xFF); \
        const v8i_t A_ = {(int)k0_.x, (int)k0_.y, (int)k0_.z, (int)k0_.w, (int)k1_.x, (int)k1_.y, (int)k1_.z, (int)k1_.w}; \
        float keep[4] = {0.f, 0.f, 0.f, 0.f}; \
        _Pragma("unroll") for (int ct = 0; ct < 16; ++ct) { \
            const v2i_t b0_ = __builtin_amdgcn_ds_read_tr4_b64_v2i32((LAS v2i_t*)(wl + (32 * g + n16) * PEER_ROW + 8 * ct)); \
            const v2i_t b1_ = __builtin_amdgcn_ds_read_tr4_b64_v2i32((LAS v2i_t*)(wl + (32 * g + 16 + n16) * PEER_ROW + 8 * ct)); \
            const v8i_t B_ = {b0_[0], b0_[1], b1_[0], b1_[1], 0, 0, 0, 0}; f32x4 c_ = {0.f, 0.f, 0.f, 0.f}; \
            c_ = __builtin_amdgcn_mfma_scale_f32_16x16x128_f8f6f4(A_, B_, c_, 0, 4, 0, MX_ONE, 0, MX_ONE); \
            keep[ct >> 2] = (g == (ct & 3)) ? c_[0] : keep[ct >> 2]; }   \
          \
        { const f32x4 kv_ = {keep[0], keep[1], keep[2], keep[3]}; \
          const bool ok_ = (t_) < T; \
          float* op_ = ok_ ? F.out + (size_t)(t_) * D + sl * 256 + 4 * lane : (float*)F.PARTB + 4 * lane;     \
          f32x4 o_; o_[0] = bf_lo(xr_.x) + kv_[0] * (1.f / A_SCALE); o_[1] = bf_hi(xr_.x) + kv_[1] * (1.f / A_SCALE); o_[2] = bf_lo(xr_.y) + kv_[2] * (1.f / A_SCALE); o_[3] = bf_hi(xr_.y) + kv_[3] * (1.f / A_SCALE); \
          *(GAS f32x4*)op_ = o_; } } while (0)
DI void p9_vacc(Frame& F, const XccInfo& I) {
    const int lane = F.lane, g = lane >> 4, n16 = lane & 15, row8 = lane >> 3, c8 = lane & 7;
    LAS unsigned char* wl = F.lds + F.wave * PEER_WAVE_LDS;
    const unsigned char* V4 = (const unsigned char*)F.VB;
    const int tstride = I.nloc * NWAVES, tfirst = I.rank * NWAVES + F.wave;
    for (int share = I.q; share < 8; share += I.nx) {
        const int sl = share >> 1, half = share & 1;
        const unsigned char* Vs = V4 + (size_t)sl * NEXP * 128;
        if (2 * tfirst + half >= T) continue;
        v4u vqA[16], vqB[16]; v4u akA, akB, akC; v2u xrA, xrB, xrC;
#define CL(t_) ((t_) < T ? (t_) : T - 1)
#define TK(k_) (2 * (tfirst + (k_) * tstride) + half)
#define SB __builtin_amdgcn_sched_barrier(0)
        P9_IDS(TK(0), akA, xrA);
        P9_ISSUE(akA, vqA);
        P9_IDS(CL(TK(1)), akB, xrB);
        P9_ISSUE(akB, vqB);
        P9_IDS(CL(TK(2)), akC, xrC);
#pragma unroll 1
        for (int k = 0; TK(k) < T; k += 2) {
            const int t = TK(k), t1 = TK(k + 1), t3 = CL(TK(k + 3)), t4 = CL(TK(k + 4));
            v4u akD, akE; v2u xrD, xrE;
            P9_IDS(t3, akD, xrD);
            P9_WRITE(vqA); SB;
            P9_ISSUE(akC, vqA); SB;
            P9_MATH(t, akA, xrA);
            P9_IDS(t4, akE, xrE);
            P9_WRITE(vqB); SB;
            P9_ISSUE(akD, vqB); SB;
            P9_MATH(t1, akB, xrB);
            akA = akC; xrA = xrC; akB = akD; xrB = xrD; akC = akE; xrC = xrE;
        }
#undef SB
#undef TK
#undef CL
    }
}

DI void convert_chunks(Frame& F, int which) {
    constexpr int CH = 64, NCH = NEXP / CH;
    for (;;) {
        if (F.tid == 0) F.MISC[14] = __hip_atomic_fetch_add((unsigned*)(F.ctl + 2048 + 64 * which), 1u, __ATOMIC_RELAXED, __HIP_MEMORY_SCOPE_AGENT);
        __syncthreads();
        const int ch = __builtin_amdgcn_readfirstlane((int)F.MISC[14]);
        __syncthreads();
        if (ch >= NCH) break;
        if (which == 0) p0_convert_fp4(F, F.expert_u, F.norm_ffn, (unsigned char*)F.UB, F.SU, ch * CH, ch * CH + CH);
        else p0_convert_fp4(F, F.expert_v, nullptr, (unsigned char*)F.VB, F.SV, ch * CH, ch * CH + CH);
    }
}
DI void mall_warm(Frame& F, const void* p, size_t bytes) {
    const size_t pieces = bytes / 1024, NGW = (size_t)F.G * NWAVES;
    for (size_t i = (size_t)F.vcu * NWAVES + F.wave; i < pieces; i += NGW)
        __builtin_amdgcn_global_load_lds((const unsigned*)((const char*)p + i * 1024 + F.lane * 16), (LAS unsigned*)(F.lds + P9_OUT_OFF + F.wave * 1024), 16, 0, 0);
}
struct Args { const float* in[17]; float* out; unsigned char* ws; int ph_lo, ph_hi, li, pad; };
__global__ void __launch_bounds__(NWAVES * 64, 2) hyb_fwd(Args args) {
    extern __shared__ __attribute__((aligned(16))) unsigned char lds[];
    Frame F;
    F.lds = (LAS unsigned char*)lds;
    F.MISC = (volatile LAS unsigned*)(F.lds + MISC_OFF);
    F.tid = threadIdx.x; F.lane = F.tid & 63; F.wave = __builtin_amdgcn_readfirstlane(F.tid >> 6);
    F.G = gridDim.x; { const int bx = blockIdx.x; F.vcu = (F.G % 8 == 0) ? (bx % 8) * (F.G / 8) + bx / 8 : bx; }
    unsigned char* ws = args.ws;
    F.ctl = (gu32*)(ws + WS_CTL);
    F.x = args.in[0]; F.norm_mix = args.in[1]; F.norm_ffn = args.in[2]; F.w_in = args.in[3]; F.b_gate = args.in[4]; F.w_conv = args.in[5]; F.q_norm = args.in[6]; F.k_norm = args.in[7];
    F.sinks = args.in[8]; F.rel_bias = args.in[9]; F.w_conv_out = args.in[10]; F.w_attn_out = args.in[11]; F.w_out = args.in[12]; F.w_query = args.in[13]; F.sub_keys = args.in[14];
    F.expert_u = args.in[15]; F.expert_v = args.in[16]; F.out = args.out;
    F.WIN = (bf16*)(ws + WS_WIN); F.WG8 = ws + WS_WG8; F.WC = (bf16*)(ws + WS_WC); F.WA = (bf16*)(ws + WS_WA); F.WO = (bf16*)(ws + WS_WO); F.WQ = (bf16*)(ws + WS_WQ); F.SK = (bf16*)(ws + WS_SK);
    F.UB = (bf16*)(ws + WS_UB); F.VB = (bf16*)(ws + WS_VB); F.XB = (bf16*)(ws + WS_XB); F.PA = (bf16*)(ws + WS_PA); F.MIX = (bf16*)(ws + WS_MIX); F.G_ = (bf16*)(ws + WS_G); F.QP = (bf16*)(ws + WS_QP);
    F.Z = (bf16*)(ws + WS_Z); F.ATT = (bf16*)(ws + WS_ATT); F.RSTD1 = (float*)(ws + WS_RSTD1); F.SSQ = (float*)(ws + WS_SSQ); F.GATE = (float*)(ws + WS_GATE); F.IDX = (unsigned short*)(ws + WS_IDX); F.PARTB = (bf16*)(ws + WS_PART); F.SU = (float*)(ws + WS_SU); F.SV = (float*)(ws + WS_SV); F.XB8 = (unsigned char*)(ws + WS_XB8); F.ACT = (float*)(ws + WS_ACT);
    for (int u = F.tid; u < (LDS_BYTES - LDSCTL_OFF) / 4; u += NWAVES * 64) ((LAS unsigned*)(F.lds + LDSCTL_OFF))[u] = 0u;
    __syncthreads();
    XcdBarrier bar; bar.bar = (unsigned*)(F.ctl + CW_BAR); bar.x = 0; bar.st = nullptr;
    const int lo = args.ph_lo, hi = args.ph_hi;
    if (hi - lo > 1) bar = xcd_barrier_post((unsigned*)(F.ctl + CW_BAR), F.MISC + 8);
#ifndef PH_MASK
#define PH_MASK 0x3ff
#endif
#define IN(k) (((PH_MASK >> (k)) & 1) && lo <= (k) && (k) < hi)
#define SEAM(k) do { if (IN(k) && IN((k) + 1)) xcd_barrier(bar); } while (0)
#ifndef PROBE_DUP
#define PROBE_DUP 0
#endif
#define REP(k) for (int rep_ = 0; rep_ < (((PROBE_DUP >> (k)) & 1) ? 2 : 1); ++rep_)

    F.xlocal = 0; F.xq = 0; F.xrank = 0; F.cvirt = (int)blockIdx.x;
    if (IN(0)) { REP(0) p0_prologue(F); SEAM(0); }
    if (hi - lo > 1 && IN(0) && IN(1)) { xcc_info_build(bar); const XccInfo I = xcc_info(bar);
        if (I.uni) { F.xlocal = 1; F.xq = I.q; F.xrank = I.rank; F.cvirt = I.q + 8 * I.rank; } }
#define SEAML(k) do { if (IN(k) && IN((k) + 1)) { if (F.xlocal) xcd_local_barrier(bar); else xcd_barrier(bar); } } while (0)
    if (IN(1)) {
        pg8::Gemm g{F.XB, F.WIN, nullptr, nullptr, T, N16, D}; pg8::StaticOrder S; S.init(T, N16, F.G, F.cvirt);
        pg8::Gemm g8{(const pg8::bf16_t*)F.XB8, (const pg8::bf16_t*)F.WG8, nullptr, nullptr, T, N8, D / 2}; pg8::StaticOrder S8; S8.init(T, N8, F.G, F.cvirt);
        { LAS float* bgl = (LAS float*)(F.lds + RING_BYTES); for (int i = F.tid; i < 2 * D; i += NWAVES * 64) bgl[i] = F.b_gate[i]; __syncthreads(); }
        pg8::EpiProj E{F.PA, F.G_, (const PG8_LAS float*)(F.lds + RING_BYTES), 0, 1 << 20, 1.f}, E8{F.PA, F.G_, (const PG8_LAS float*)(F.lds + RING_BYTES), N16, 3, 1.f / WG_SCALE};
        REP(1) { pg8::gemm_phase<pg8::EpiProj, pg8::StaticOrder, PG8_ALIGN, PG8_SP2, true>(F.lds + RING_OFF, g8, S8, E8);
                 pg8::gemm_phase<pg8::EpiProj, pg8::StaticOrder, PG8_ALIGN, PG8_SP2>(F.lds + RING_OFF, g, S, E); }
        {
            const int nwg = (T / 256) * (N8 / 256), rem = nwg % F.G, c = (int)blockIdx.x; const int nshort = rem ? F.G - rem : F.G, sidx = rem ? c - rem : c;
            (void)sidx; (void)nshort;
            convert_chunks(F, 0); }
        SEAML(1);
    }
    if (IN(2)) {
        mall_warm(F, F.WC, (size_t)2 * D * CONV * 2);
        REP(2) { p2_conv(F); p2_attention(F); }
        SEAML(2); }
    if (IN(3)) {
        mall_warm(F, F.WO, (size_t)D * D * 2);
        pg8::Gemm g{F.Z, F.WC, F.ATT, F.WA, T, D, CONV}; pg8::PairOrder S; S.init(T, D, F.G, F.cvirt);
        pg8::EpiMix E{F.MIX, F.G_};
        REP(3) pg8::gemm_phase<pg8::EpiMix, pg8::PairOrder, PG8_ALIGN, PG8_SP2>(F.lds + RING_OFF, g, S, E);
        SEAML(3);
    }
    if (IN(4)) {
        mall_warm(F, F.WQ, (size_t)PQ * D); mall_warm(F, F.SK, (size_t)PH * 2 * NKEYS * 128 * 2);
        pg8::Gemm g{F.MIX, F.WO, nullptr, nullptr, T, D, D}; pg8::FragOrder S; S.init(T, D, F.G, F.cvirt); S.slab = pg8::MIX_SLAB * 2;
        pg8::EpiX1 E{F.RSTD1, F.XB, F.SSQ, F.XB8};
        REP(4) pg8::gemm_phase<pg8::EpiX1, pg8::FragOrder, PG8_ALIGN, PG8_SP2>(F.lds + RING_OFF, g, S, E);
        SEAML(4);
    }
    if (IN(5)) {
        pg8::Gemm g{(const pg8::bf16_t*)F.XB8, F.WQ, nullptr, nullptr, T, PQ, D / 2}; pg8::StaticOrder S; S.init(T, PQ, F.G, F.cvirt);
        pg8::EpiQP E{F.QP, 1.f / WG_SCALE};
        REP(5) pg8::gemm_phase<pg8::EpiQP, pg8::StaticOrder, PG8_ALIGN, PG8_SP2, true>(F.lds + RING_OFF, g, S, E);
    }
    if (IN(6)) { REP(6) p6_topk(F); SEAM(6); }
    if (IN(7)) { if (!(hi - lo > 1 && IN(0) && IN(1))) xcc_info_build(bar); const XccInfo I = xcc_info(bar); REP(7) p7_udot(F, I); SEAM(7); }
    if (IN(8)) { REP(8) p8_act(F); SEAM(8); }
    if (IN(9)) { const XccInfo I = xcc_info(bar); p9_vacc(F, I); }
#undef IN
#undef SEAM
#undef SEAML
}

extern "C" void kernel_launch(void* const* d_in, const int* in_sizes, int n_in, void* d_out, int out_size, void* d_ws, size_t ws_size, hipStream_t stream) {
    static int grid = 0;
    if (grid == 0) {
        if (n_in != 17 || in_sizes[0] != T * D || out_size != T * D || ws_size < WS_END) { fprintf(stderr, "kernel_launch: unexpected shapes (n_in %d, in0 %d, out %d, ws %zu)\n", n_in, n_in > 0 ? in_sizes[0] : -1, out_size, ws_size); grid = -1; return; }
        int dev = 0, cus = 0, per_cu = 0;
        if (hipGetDevice(&dev) != hipSuccess || hipDeviceGetAttribute(&cus, hipDeviceAttributeMultiprocessorCount, dev) != hipSuccess) { grid = -1; return; }
        if (hipFuncSetAttribute((const void*)hyb_fwd, hipFuncAttributeMaxDynamicSharedMemorySize, LDS_BYTES) != hipSuccess) { fprintf(stderr, "kernel_launch: hipFuncSetAttribute failed\n"); grid = -1; return; }
        if (hipOccupancyMaxActiveBlocksPerMultiprocessor(&per_cu, (const void*)hyb_fwd, NWAVES * 64, LDS_BYTES) != hipSuccess || per_cu < 1) { fprintf(stderr, "kernel_launch: occupancy query says %d blocks per CU\n", per_cu); (void)hipGetLastError(); grid = -1; return; }
        grid = cus * 1;
    }
    if (grid < 0) return;
    if (hipMemsetAsync((char*)d_ws + WS_CTL, 0, CTL_ZERO_BYTES, stream) != hipSuccess) { fprintf(stderr, "kernel_launch: memset failed\n"); return; }
    Args a{};
    for (int i = 0; i < 17; ++i) a.in[i] = (const float*)d_in[i];
    a.out = (float*)d_out; a.ws = (unsigned char*)d_ws;
#if MK_ONE_LAUNCH
    a.ph_lo = 0; a.ph_hi = N_PHASES; a.li = 0;
    void* kargs[] = {&a};
    const hipError_t le = hipLaunchCooperativeKernel((const void*)hyb_fwd, dim3(grid), dim3(NWAVES * 64), kargs, LDS_BYTES, stream);
    if (le != hipSuccess) fprintf(stderr, "kernel_launch: cooperative launch failed: %s (grid %d)\n", hipGetErrorName(le), grid);
#else
    for (int li = 0; li < N_PHASES; ++li) {
        a.ph_lo = li; a.ph_hi = li + 1; a.li = li;
        hipLaunchKernelGGL(hyb_fwd, dim3(grid), dim3(NWAVES * 64), LDS_BYTES, stream, a);
        const hipError_t le = hipPeekAtLastError();
        if (le != hipSuccess) { fprintf(stderr, "kernel_launch: launch %d failed: %s\n", li, hipGetErrorName(le)); break; }
    }
#endif
}
```
